# Optimizing an MI355X kernel written in HIP

```python
import jax, jax.numpy as jnp
from jax import lax
import numpy as np

D_MODEL = 1024
BATCH = 4
SEQ = 4096
DEPTH = 1

PLE_DIM = 256
RET_HEADS = 4
RET_QK_DIM = 256
RET_V_DIM = 512
RET_CHUNK = 128
MLA_HEADS = 8
MLA_NOPE_DIM = 128
MLA_ROPE_DIM = 64
MLA_QK_DIM = MLA_NOPE_DIM + MLA_ROPE_DIM
MLA_V_DIM = 128
MLA_Q_LORA = 384
MLA_KV_LORA = 256
ATTN_BLOCK = 128
D_FF = 4 * D_MODEL
ROPE_BASE = 10000.0
RMS_EPS = 1e-6

RET_QK_W = RET_HEADS * RET_QK_DIM
RET_V_W = RET_HEADS * RET_V_DIM
MLA_V_W = MLA_HEADS * MLA_V_DIM
IN_SIZES = (RET_QK_W, RET_QK_W, RET_V_W, RET_V_W, MLA_Q_LORA, MLA_KV_LORA, MLA_ROPE_DIM, D_MODEL, D_MODEL)
IN_WIDTH = sum(IN_SIZES)

kernel_name = "hybrid_retention_mla_gated_block"


def rms_norm(x, gain):
    xf = x.astype(jnp.float32)
    y = xf * lax.rsqrt(jnp.mean(xf * xf, axis=-1, keepdims=True) + RMS_EPS)
    return (y * gain.astype(jnp.float32)).astype(x.dtype)


def rope(x, pos):
    half = x.shape[-1] // 2
    inv = ROPE_BASE ** (-jnp.arange(half, dtype=jnp.float32) / half)
    ang = pos.astype(jnp.float32)[:, :, None] * inv
    cos = jnp.cos(ang)[:, :, None, :]
    sin = jnp.sin(ang)[:, :, None, :]
    xf = x.astype(jnp.float32)
    x1, x2 = xf[..., :half], xf[..., half:]
    return jnp.concatenate([x1 * cos - x2 * sin, x2 * cos + x1 * sin], axis=-1).astype(x.dtype)


def retention(q, k, v):
    B, S, H, dk = q.shape
    dv = v.shape[-1]
    C = RET_CHUNK
    N = S // C
    log_g = jnp.log1p(-jnp.exp2(-5.0 - jnp.arange(H, dtype=jnp.float32)))
    idx = jnp.arange(C, dtype=jnp.float32)
    diff = idx[:, None] - idx[None, :]
    decay_in = jnp.where(diff >= 0, jnp.exp(jnp.maximum(diff, 0.0)[None] * log_g[:, None, None]), 0.0)
    q_dec = jnp.exp((idx + 1.0)[None, :] * log_g[:, None])
    k_dec = jnp.exp((C - 1.0 - idx)[None, :] * log_g[:, None])
    chunk_dec = jnp.exp(C * log_g)

    def to_chunks(t):
        return t.astype(jnp.float32).reshape(B, N, C, H, t.shape[-1]).transpose(1, 0, 3, 2, 4)

    def step(state, inp):
        qc, kc, vc = inp
        scores = jnp.einsum('bhnd,bhmd->bhnm', qc, kc) * decay_in
        o = (jnp.einsum('bhnm,bhmv->bhnv', scores, vc)
             + jnp.einsum('bhnd,bhdv->bhnv', qc, state) * q_dec[None, :, :, None])
        state = (state * chunk_dec[None, :, None, None]
                 + jnp.einsum('bhmd,bhmv->bhdv', kc * k_dec[None, :, :, None], vc))
        return state, o

    state0 = jnp.zeros((B, H, dk, dv), jnp.float32)
    _, o = lax.scan(step, state0, (to_chunks(q), to_chunks(k), to_chunks(v)))
    return o.transpose(1, 0, 3, 2, 4).reshape(B, S, H, dv).astype(v.dtype)


def causal_block_attention(q, k, v):
    B, S, H, D = q.shape
    nb = S // ATTN_BLOCK
    scale = D ** -0.5
    qb = q.reshape(B, nb, ATTN_BLOCK, H, D).transpose(1, 0, 2, 3, 4)
    key_pos = jnp.arange(S)

    def one(args):
        qi, bi = args
        s = jnp.einsum('bqhd,bkhd->bhqk', qi, k).astype(jnp.float32) * scale
        q_pos = bi * ATTN_BLOCK + jnp.arange(ATTN_BLOCK)
        s = jnp.where(key_pos[None, :] <= q_pos[:, None], s, -1e30)
        pr = jax.nn.softmax(s, axis=-1).astype(v.dtype)
        return jnp.einsum('bhqk,bkhv->bqhv', pr, v)

    o = lax.map(one, (qb, jnp.arange(nb)))
    return o.transpose(1, 0, 2, 3, 4).reshape(B, S, H, v.shape[-1])


def hybrid_layer(x, p_l, pos, norm_mix, w_in, ret_norm, q_lat_norm, kv_lat_norm, w_uq, w_ukv,
                 q_norm, k_norm, w_br, w_bm, w_o, norm_mlp, w_up, w_down, norm_ple, w_ple_gate, w_ple):
    B, S, _ = x.shape
    h = rms_norm(x, norm_mix)
    proj = h @ w_in
    offsets = np.cumsum(IN_SIZES)[:-1].tolist()
    rq, rk, rv, rg, cq, ckv, krope, gr, gm = jnp.split(proj, offsets, axis=-1)

    rq = rope(rq.reshape(B, S, RET_HEADS, RET_QK_DIM), pos)
    rk = rope(rk.reshape(B, S, RET_HEADS, RET_QK_DIM), pos) * (RET_QK_DIM ** -0.5)
    rv = rv.reshape(B, S, RET_HEADS, RET_V_DIM)
    ro = retention(rq, rk, rv)
    ro = rms_norm(ro, ret_norm.reshape(RET_HEADS, RET_V_DIM)).reshape(B, S, RET_V_W)
    a_ret = (ro * jax.nn.silu(rg)) @ w_br

    cq = rms_norm(cq, q_lat_norm)
    q = (cq @ w_uq).reshape(B, S, MLA_HEADS, MLA_QK_DIM)
    ckv = rms_norm(ckv, kv_lat_norm)
    kv = (ckv @ w_ukv).reshape(B, S, MLA_HEADS, MLA_NOPE_DIM + MLA_V_DIM)
    k_nope, v = kv[..., :MLA_NOPE_DIM], kv[..., MLA_NOPE_DIM:]
    k_rope = jnp.broadcast_to(krope[:, :, None, :], (B, S, MLA_HEADS, MLA_ROPE_DIM))
    k = jnp.concatenate([k_nope, k_rope], axis=-1)
    q = rms_norm(q, q_norm)
    k = rms_norm(k, k_norm)
    q = jnp.concatenate([q[..., :MLA_NOPE_DIM], rope(q[..., MLA_NOPE_DIM:], pos)], axis=-1)
    k = jnp.concatenate([k[..., :MLA_NOPE_DIM], rope(k[..., MLA_NOPE_DIM:], pos)], axis=-1)
    mo = causal_block_attention(q, k, v).reshape(B, S, MLA_V_W)
    a_mla = mo @ w_bm

    mixed = jax.nn.sigmoid(gr) * a_ret + jax.nn.sigmoid(gm) * a_mla
    x = x + mixed @ w_o

    h2 = rms_norm(x, norm_mlp)
    x = x + jnp.square(jax.nn.relu(h2 @ w_up)) @ w_down

    gate = jax.nn.sigmoid(rms_norm(x, norm_ple) @ w_ple_gate)
    x = x + gate * (p_l @ w_ple)
    return x


def setup_inputs(seed: int = 0) -> dict:
    key = jax.random.key(seed)
    ks = jax.random.split(key, 24)

    def dense(k, shape, fan_in):
        return jax.random.normal(k, shape, jnp.float32) * (fan_in ** -0.5)

    def gain(k, n):
        return 1.0 + 0.05 * jax.random.normal(k, (DEPTH, n), jnp.float32)

    x = jax.random.normal(ks[0], (BATCH, SEQ, D_MODEL), jnp.float32)
    p = jax.random.normal(ks[1], (DEPTH, BATCH, SEQ, PLE_DIM), jnp.float32)
    offset = jax.random.randint(ks[2], (BATCH, 1), 0, 1024, dtype=jnp.int32)
    positions = offset + jnp.arange(SEQ, dtype=jnp.int32)[None, :]
    return {
        "x": x,
        "p": p,
        "positions": positions,
        "norm_mix": gain(ks[3], D_MODEL),
        "w_in": dense(ks[4], (DEPTH, D_MODEL, IN_WIDTH), D_MODEL),
        "ret_norm": gain(ks[5], RET_V_W),
        "q_lat_norm": gain(ks[6], MLA_Q_LORA),
        "kv_lat_norm": gain(ks[7], MLA_KV_LORA),
        "w_uq": dense(ks[8], (DEPTH, MLA_Q_LORA, MLA_HEADS * MLA_QK_DIM), MLA_Q_LORA),
        "w_ukv": dense(ks[9], (DEPTH, MLA_KV_LORA, MLA_HEADS * (MLA_NOPE_DIM + MLA_V_DIM)), MLA_KV_LORA),
        "q_norm": gain(ks[10], MLA_QK_DIM),
        "k_norm": gain(ks[11], MLA_QK_DIM),
        "w_br": dense(ks[12], (DEPTH, RET_V_W, D_MODEL), RET_V_W),
        "w_bm": dense(ks[13], (DEPTH, MLA_V_W, D_MODEL), MLA_V_W),
        "w_o": dense(ks[14], (DEPTH, D_MODEL, D_MODEL), D_MODEL),
        "norm_mlp": gain(ks[15], D_MODEL),
        "w_up": dense(ks[16], (DEPTH, D_MODEL, D_FF), D_MODEL),
        "w_down": dense(ks[17], (DEPTH, D_FF, D_MODEL), D_FF),
        "norm_ple": gain(ks[18], D_MODEL),
        "w_ple_gate": dense(ks[19], (DEPTH, D_MODEL, D_MODEL), D_MODEL),
        "w_ple": dense(ks[20], (DEPTH, PLE_DIM, D_MODEL), PLE_DIM),
    }


def reference(x, p, positions, norm_mix, w_in, ret_norm, q_lat_norm, kv_lat_norm, w_uq, w_ukv,
              q_norm, k_norm, w_br, w_bm, w_o, norm_mlp, w_up, w_down, norm_ple, w_ple_gate, w_ple):
    for i in range(DEPTH):
        x = hybrid_layer(x, p[i], positions, norm_mix[i], w_in[i], ret_norm[i], q_lat_norm[i],
                         kv_lat_norm[i], w_uq[i], w_ukv[i], q_norm[i], k_norm[i], w_br[i], w_bm[i],
                         w_o[i], norm_mlp[i], w_up[i], w_down[i], norm_ple[i], w_ple_gate[i], w_ple[i])
    return x
```

```cpp
#define MK_N_LAUNCHES 1
#include <hip/hip_runtime.h>
#include <hip/hip_bf16.h>
#include <cstdio>
#include <cstdint>
namespace pg8 {
#define PG8_LAS __attribute__((address_space(3)))
typedef unsigned short bf16_t;
typedef short bf16x8 __attribute__((ext_vector_type(8)));
typedef float f32x4 __attribute__((ext_vector_type(4)));
typedef unsigned u32x4 __attribute__((ext_vector_type(4)));
constexpr int BM = 256, BK = 64, HALF = 128, HTB = HALF * BK * 2  , STAGE_BYTES = 8 * HTB, NXCD = 8, WGM = 8;

__host__ __device__ __forceinline__ int lds_byte(int r, int c) { const int st = (r >> 4) * 2 + (c >> 5), rr = r & 15, cc = c & 31, ob = rr * 64 + cc * 2; return st * 1024 + (ob ^ (((ob >> 9) & 1) << 5)); }
__host__ __device__ __forceinline__ void stage_rc(int b, int& R, int& C) { const int st = b / 1024, sb = b % 1024, swz = sb ^ (((sb >> 9) & 1) << 5); R = (st >> 1) * 16 + swz / 64; C = (st & 1) * 32 + (swz % 64) / 2; }
__host__ __device__ __forceinline__ int perm32(int rho) { const int n = rho >> 4, i = rho & 15; return 8 * (i >> 2) + 4 * n + (i & 3); }

struct Unit { int pm, pn; };
struct Gemm { const bf16_t* A; const bf16_t* Bt; int M, N, K, lda, ldb; };

struct StaticOrder {
    int nM, nN, nwg, G, c;
    __host__ __device__ void init(int M, int N, int G_, int c_) { nM = M / BM; nN = N / BM; nwg = nM * nN; G = G_; c = c_; }
    __host__ __device__ bool next(int i, Unit& u) const {
        const long L = (long)i * G + c; if (L >= nwg) return false;
        int wgid = (int)L; { const int q = nwg / NXCD, r = nwg % NXCD, xcd = wgid % NXCD, off = wgid / NXCD; wgid = (xcd < r ? xcd * (q + 1) : r * (q + 1) + (xcd - r) * q) + off; }
        const int nig = WGM * nN, gid = wgid / nig, fm = gid * WGM, gsz = (nM - fm) < WGM ? (nM - fm) : WGM;
        u.pm = fm + ((wgid % nig) % gsz); u.pn = (wgid % nig) / gsz; return true;
    }
    __device__ __forceinline__ void a_ready(const Unit&) const {}
    __device__ __forceinline__ void done(const Unit&) const {}
};


typedef float f32x2 __attribute__((ext_vector_type(2)));
typedef __bf16 bf16x2_t __attribute__((ext_vector_type(2)));
__device__ __forceinline__ unsigned cvt_pk_bf16(float lo, float hi) { f32x2 v = {lo, hi}; bf16x2_t b = __builtin_convertvector(v, bf16x2_t); return __builtin_bit_cast(unsigned, b); }
__device__ __forceinline__ float bflo(unsigned w) { return __uint_as_float(w << 16); }
__device__ __forceinline__ float bfhi(unsigned w) { return __uint_as_float(w & 0xffff0000u); }
__device__ __forceinline__ u32x4 pack8(const float (&v)[8]) { u32x4 w; w.x = cvt_pk_bf16(v[0], v[1]); w.y = cvt_pk_bf16(v[2], v[3]); w.z = cvt_pk_bf16(v[4], v[5]); w.w = cvt_pk_bf16(v[6], v[7]); return w; }
__device__ __forceinline__ void unpack8(const u32x4 w, float (&v)[8]) { v[0] = bflo(w.x); v[1] = bfhi(w.x); v[2] = bflo(w.y); v[3] = bfhi(w.y); v[4] = bflo(w.z); v[5] = bfhi(w.z); v[6] = bflo(w.w); v[7] = bfhi(w.w); }
__device__ __forceinline__ float sigmoidf_(float x) { return __builtin_amdgcn_rcpf(1.0f + __builtin_amdgcn_exp2f(-1.4426950408889634f * x)); }
constexpr float RMS_EPS_ = 1e-6f;

#define EPI_ACC8(v, ai, bj, m) float v[8]; { const f32x4 a0_ = acc[ai][bj][m][0], a1_ = acc[ai][bj][m][1]; v[0] = a0_[0]; v[1] = a0_[1]; v[2] = a0_[2]; v[3] = a0_[3]; v[4] = a1_[0]; v[5] = a1_[1]; v[6] = a1_[2]; v[7] = a1_[3]; }

__device__ __forceinline__ void xpose_store(PG8_LAS unsigned char* st, const unsigned (&pk)[4][4], bf16_t* dst, size_t cstride, int lane, int fr, int fq) {
#pragma unroll
    for (int pass = 0; pass < 2; ++pass) {
        if ((fq >> 1) == pass) {
#pragma unroll
            for (int m = 0; m < 4; ++m)
#pragma unroll
                for (int q = 0; q < 4; ++q) { const unsigned w = pk[m][q]; const int c = (fq & 1) * 8 + 2 * q;
                    *(PG8_LAS unsigned short*)(st + c * 144 + (16 * m + fr) * 2) = (unsigned short)(w & 0xffffu);
                    *(PG8_LAS unsigned short*)(st + (c + 1) * 144 + (16 * m + fr) * 2) = (unsigned short)(w >> 16); }
        }
        asm volatile("s_waitcnt lgkmcnt(0)" ::: "memory");
#pragma unroll
        for (int k = 0; k < 2; ++k) { const int idx = lane + 64 * k, c = idx >> 3, ch = idx & 7;
            const u32x4 v = *(const PG8_LAS u32x4*)(st + c * 144 + ch * 16);
            *(u32x4*)(dst + (size_t)(pass * 16 + c) * cstride + ch * 8) = v; }
        asm volatile("s_waitcnt lgkmcnt(0)" ::: "memory");
    }
}

struct EpiInProj {
    static constexpr bool PERM = true, AFTER_DRAIN = false;
    const float* rstdx; const f32x4* cs;
    bf16_t *RQ, *RK, *RKDT, *RVT, *LAT; float *ssq_lat;   PG8_LAS unsigned char* xs;
    __device__ __forceinline__ void operator()(const f32x4 (&acc)[2][2][4][2], const Unit& u, int wr, int wc, int fr, int fq) const {
        const int pn = u.pn, lane = fq * 16 + fr, wid = wr * 4 + wc;
        PG8_LAS unsigned char* st = xs + wid * 2304;
        const int rowt = u.pm * BM + wr * 64 + fr;
        const int bidx = (u.pm * BM) >> 12, s0 = (u.pm * BM) & 4095;
        if (pn < 8) {
            const bool isk = pn >= 4; const int head = pn & 3;
            const float lg2 = __builtin_amdgcn_logf(1.0f - __builtin_amdgcn_exp2f(-5.0f - (float)head));
            float kd[4];
#pragma unroll
            for (int m = 0; m < 4; ++m) kd[m] = __builtin_amdgcn_exp2f((float)(127 - (wr * 64 + m * 16 + fr)) * lg2);
            bf16_t* O = isk ? RK : RQ;
#pragma unroll
            for (int ai = 0; ai < 2; ++ai) {
                unsigned pk0[4][4], pk1[4][4];
#pragma unroll
                for (int m = 0; m < 4; ++m) {
                    const int row = rowt + ai * HALF + m * 16; const float rs = rstdx[row] * (isk ? 0.0625f : 1.0f);
                    const f32x4* cp = cs + (size_t)row * 64 + wc * 16 + fq * 4;
                    const f32x4 c0 = cp[0], c1 = cp[1], c2 = cp[2], c3 = cp[3];
                    const float cc[8] = {c0[0], c0[2], c1[0], c1[2], c2[0], c2[2], c3[0], c3[2]}, ss[8] = {c0[1], c0[3], c1[1], c1[3], c2[1], c2[3], c3[1], c3[3]};
                    EPI_ACC8(x1, ai, 0, m); EPI_ACC8(x2, ai, 1, m);
                    float o1[8], o2[8];
#pragma unroll
                    for (int e = 0; e < 8; ++e) { const float a = x1[e] * rs, b = x2[e] * rs; o1[e] = a * cc[e] - b * ss[e]; o2[e] = b * cc[e] + a * ss[e]; }
                    bf16_t* rp = O + (size_t)row * 1024 + head * 256 + wc * 32 + 8 * fq;
                    *(u32x4*)rp = pack8(o1); *(u32x4*)(rp + HALF) = pack8(o2);
                    if (isk) {
#pragma unroll
                        for (int q = 0; q < 4; ++q) { pk0[m][q] = cvt_pk_bf16(o1[2 * q] * kd[m], o1[2 * q + 1] * kd[m]); pk1[m][q] = cvt_pk_bf16(o2[2 * q] * kd[m], o2[2 * q + 1] * kd[m]); }
                    }
                }
                if (isk) {
                    bf16_t* d0 = RKDT + ((size_t)(bidx * 4 + head) * 256 + wc * 32) * 4096 + s0 + ai * HALF + wr * 64;
                    xpose_store(st, pk0, d0, 4096, lane, fr, fq);
                    xpose_store(st, pk1, d0 + (size_t)HALF * 4096, 4096, lane, fr, fq);
                }
            }
        } else if (pn < 16) {
            const int head = (pn - 8) >> 1, dvb = ((pn - 8) & 1) * 256;
#pragma unroll
            for (int ai = 0; ai < 2; ++ai)
#pragma unroll
                for (int bj = 0; bj < 2; ++bj) {
                    unsigned pk[4][4];
#pragma unroll
                    for (int m = 0; m < 4; ++m) { const float rs = rstdx[rowt + ai * HALF + m * 16]; EPI_ACC8(v, ai, bj, m);
#pragma unroll
                        for (int q = 0; q < 4; ++q) pk[m][q] = cvt_pk_bf16(v[2 * q] * rs, v[2 * q + 1] * rs); }
                    bf16_t* d0 = RVT + ((size_t)(bidx * 4 + head) * 512 + dvb + bj * HALF + wc * 32) * 4096 + s0 + ai * HALF + wr * 64;
                    xpose_store(st, pk, d0, 4096, lane, fr, fq);
                }
        } else {
            const int lt = pn - 16;
#pragma unroll
            for (int ai = 0; ai < 2; ++ai)
#pragma unroll
                for (int m = 0; m < 4; ++m) { const int row = rowt + ai * HALF + m * 16; const float rs = rstdx[row];
#pragma unroll
                    for (int bj = 0; bj < 2; ++bj) { EPI_ACC8(v, ai, bj, m); float q = 0.f;
#pragma unroll
                        for (int e = 0; e < 8; ++e) { v[e] *= rs; q += v[e] * v[e]; }
                        *(u32x4*)(LAT + (size_t)row * 768 + lt * 256 + bj * HALF + wc * 32 + 8 * fq) = pack8(v);
                        const int kind = (lt == 0) ? 0 : (lt == 1 ? (bj == 0 ? 0 : 1) : (bj == 0 ? 1 : 2));
                        if (kind < 2) { q += __shfl_xor(q, 16); q += __shfl_xor(q, 32); if (fq == 0) atomicAdd(ssq_lat + kind * 16384 + row, q); } } }
        }
    }
};

template <int MODE> struct EpiRowAct {
    static constexpr bool PERM = true, AFTER_DRAIN = false;
    bf16_t* O; int ldo; const float* rsrc; float inv_dim;
    __device__ __forceinline__ void operator()(const f32x4 (&acc)[2][2][4][2], const Unit& u, int wr, int wc, int fr, int fq) const {
        const int rowt = u.pm * BM + wr * 64 + fr, colt = u.pn * BM + wc * 32 + 8 * fq;
#pragma unroll
        for (int ai = 0; ai < 2; ++ai)
#pragma unroll
            for (int m = 0; m < 4; ++m) { const int row = rowt + ai * HALF + m * 16; const float r0 = rsrc[row]; const float rs = inv_dim == 0.f ? r0 : __builtin_amdgcn_rsqf(r0 * inv_dim + RMS_EPS_);
#pragma unroll
                for (int bj = 0; bj < 2; ++bj) { EPI_ACC8(v, ai, bj, m);
#pragma unroll
                    for (int e = 0; e < 8; ++e) { float x = v[e] * rs; if (MODE == 1) x = sigmoidf_(x); if (MODE == 2) { x = fmaxf(x, 0.f); x = x * x; } v[e] = x; }
                    *(u32x4*)(O + (size_t)row * ldo + colt + bj * HALF) = pack8(v); } }
    }
};
struct EpiRetGate {
    static constexpr bool PERM = true, AFTER_DRAIN = false;
    bf16_t* RO; const float* rstdx; const float* ssq_ro; const float* ret_norm;
    __device__ __forceinline__ void operator()(const f32x4 (&acc)[2][2][4][2], const Unit& u, int wr, int wc, int fr, int fq) const {
        const int rowt = u.pm * BM + wr * 64 + fr, colt = u.pn * BM + wc * 32 + 8 * fq, head = u.pn >> 1;
        f32x4 g[2][2];
#pragma unroll
        for (int bj = 0; bj < 2; ++bj) { g[bj][0] = *(const f32x4*)(ret_norm + colt + bj * HALF); g[bj][1] = *(const f32x4*)(ret_norm + colt + bj * HALF + 4); }
#pragma unroll
        for (int ai = 0; ai < 2; ++ai)
#pragma unroll
            for (int m = 0; m < 4; ++m) { const int row = rowt + ai * HALF + m * 16; const float rs = rstdx[row], rr = __builtin_amdgcn_rsqf(ssq_ro[row * 4 + head] * (1.0f / 512.0f) + RMS_EPS_);
#pragma unroll
                for (int bj = 0; bj < 2; ++bj) { EPI_ACC8(v, ai, bj, m); bf16_t* p = RO + (size_t)row * 2048 + colt + bj * HALF; float o[8]; unpack8(*(const u32x4*)p, o);
#pragma unroll
                    for (int e = 0; e < 8; ++e) { const float x = v[e] * rs; const float gg = e < 4 ? g[bj][0][e & 3] : g[bj][1][e & 3]; v[e] = o[e] * rr * gg * x * sigmoidf_(x); }
                    *(u32x4*)p = pack8(v); } }
    }
};
template <int MODE> struct EpiGateMix {
    static constexpr bool PERM = true, AFTER_DRAIN = false;
    bf16_t* TM; const bf16_t* SG; int sgoff;
    __device__ __forceinline__ void operator()(const f32x4 (&acc)[2][2][4][2], const Unit& u, int wr, int wc, int fr, int fq) const {
        const int rowt = u.pm * BM + wr * 64 + fr, colt = u.pn * BM + wc * 32 + 8 * fq;
#pragma unroll
        for (int ai = 0; ai < 2; ++ai)
#pragma unroll
            for (int m = 0; m < 4; ++m) { const int row = rowt + ai * HALF + m * 16;
#pragma unroll
                for (int bj = 0; bj < 2; ++bj) { EPI_ACC8(v, ai, bj, m); float s[8]; unpack8(*(const u32x4*)(SG + (size_t)row * 2048 + sgoff + colt + bj * HALF), s);
                    bf16_t* p = TM + (size_t)row * 1024 + colt + bj * HALF;
                    if (MODE == 1) { float t[8]; unpack8(*(const u32x4*)p, t);
#pragma unroll
                        for (int e = 0; e < 8; ++e) v[e] = t[e] + s[e] * v[e]; }
                    else {
#pragma unroll
                        for (int e = 0; e < 8; ++e) v[e] = s[e] * v[e]; }
                    *(u32x4*)p = pack8(v); } }
    }
};
struct EpiResid {
    static constexpr bool PERM = true, AFTER_DRAIN = false;
    const float* res; float* out; bf16_t* xb; float* ssq;
    __device__ __forceinline__ void operator()(const f32x4 (&acc)[2][2][4][2], const Unit& u, int wr, int wc, int fr, int fq) const {
        const int rowt = u.pm * BM + wr * 64 + fr, colt = u.pn * BM + wc * 32 + 8 * fq;
#pragma unroll
        for (int ai = 0; ai < 2; ++ai)
#pragma unroll
            for (int m = 0; m < 4; ++m) { const int row = rowt + ai * HALF + m * 16; float q = 0.f;
#pragma unroll
                for (int bj = 0; bj < 2; ++bj) { EPI_ACC8(v, ai, bj, m); const size_t off = (size_t)row * 1024 + colt + bj * HALF;
                    const f32x4 r0 = *(const f32x4*)(res + off), r1 = *(const f32x4*)(res + off + 4);
#pragma unroll
                    for (int e = 0; e < 8; ++e) { v[e] += e < 4 ? r0[e & 3] : r1[e & 3]; q += v[e] * v[e]; }
                    *(f32x4*)(out + off) = (f32x4){v[0], v[1], v[2], v[3]}; *(f32x4*)(out + off + 4) = (f32x4){v[4], v[5], v[6], v[7]};
                    *(u32x4*)(xb + off) = pack8(v); }
                q += __shfl_xor(q, 16); q += __shfl_xor(q, 32); if (fq == 0) atomicAdd(ssq + row, q);
                if (m & 1) asm volatile("" ::: "memory"); }
    }
};
struct EpiFinal {
    static constexpr bool PERM = true, AFTER_DRAIN = false;
    float* out; const bf16_t* GT;
    __device__ __forceinline__ void operator()(const f32x4 (&acc)[2][2][4][2], const Unit& u, int wr, int wc, int fr, int fq) const {
        const int rowt = u.pm * BM + wr * 64 + fr, colt = u.pn * BM + wc * 32 + 8 * fq;
#pragma unroll
        for (int ai = 0; ai < 2; ++ai)
#pragma unroll
            for (int m = 0; m < 4; ++m) { const int row = rowt + ai * HALF + m * 16;
#pragma unroll
                for (int bj = 0; bj < 2; ++bj) { EPI_ACC8(v, ai, bj, m); const size_t off = (size_t)row * 1024 + colt + bj * HALF; float gt[8]; unpack8(*(const u32x4*)(GT + off), gt);
                    const f32x4 r0 = *(const f32x4*)(out + off), r1 = *(const f32x4*)(out + off + 4);
#pragma unroll
                    for (int e = 0; e < 8; ++e) v[e] = (e < 4 ? r0[e & 3] : r1[e & 3]) + gt[e] * v[e];
                    *(f32x4*)(out + off) = (f32x4){v[0], v[1], v[2], v[3]}; *(f32x4*)(out + off + 4) = (f32x4){v[4], v[5], v[6], v[7]}; }
                if (m & 1) asm volatile("" ::: "memory"); }
    }
};
template <class Epi, class Sched, bool ALIGN_EPI = false, bool SP2 = false>
__device__ __forceinline__ void gemm_phase(PG8_LAS unsigned char* lds, const Gemm g, const Sched& S, const Epi& E) {
    const int tid = threadIdx.x, wid = __builtin_amdgcn_readfirstlane(tid >> 6), lane = tid & 63, wr = wid >> 2, wc = wid & 3, fr = lane & 15, fq = lane >> 4;
    const int K = g.K, nt = K / BK;
    unsigned voffA[2], voffB[2];
#pragma unroll
    for (int i = 0; i < 2; ++i) { int R, C; stage_rc(tid * 16 + i * 8192, R, C); const int Rb = Epi::PERM ? ((R & ~31) + perm32(R & 31)) : R;
        voffA[i] = (unsigned)(R * g.lda + C) * 2u; voffB[i] = (unsigned)(Rb * g.ldb + C) * 2u; }
    const size_t kstep = (size_t)(BK * 2);
    const size_t hstepA = (size_t)HALF * g.lda * 2, hstepB = (size_t)HALF * g.ldb * 2;
    const size_t tstepA = 2 * hstepA, tstepB = 2 * hstepB;
    const unsigned ldsw = (unsigned)wid * 1024u;
    const int aoff = lds_byte(wr * 64 + fr, fq * 8), boff = lds_byte(wc * 32 + fr, fq * 8);
#define PG8_SA(b, h) (((b) * 2 + (h)) * HTB)
#define PG8_SB(b, h) ((4 + (b) * 2 + (h)) * HTB)
#define PG8_STAGE(bufoff, gbase, voff) do { _Pragma("unroll") for (int _i = 0; _i < 2; ++_i) \
        __builtin_amdgcn_global_load_lds((const unsigned*)((const char*)(gbase) + (voff)[_i]), (PG8_LAS unsigned*)(lds + (bufoff) + ldsw + _i * 8192), 16, 0, 0); } while (0)
#define PG8_LDA(dst, b, h) do { _Pragma("unroll") for (int m = 0; m < 4; ++m) _Pragma("unroll") for (int k = 0; k < 2; ++k) dst[m][k] = *(const PG8_LAS bf16x8*)(lds + PG8_SA(b, h) + aoff + m * 2048 + k * 1024); } while (0)
#define PG8_LDB(dst, b, h) do { _Pragma("unroll") for (int n = 0; n < 2; ++n) _Pragma("unroll") for (int k = 0; k < 2; ++k) dst[n][k] = *(const PG8_LAS bf16x8*)(lds + PG8_SB(b, h) + boff + n * 2048 + k * 1024); } while (0)
#define PG8_MMA(ai, bj, At, Bt) do { __builtin_amdgcn_s_setprio(1); _Pragma("unroll") for (int m = 0; m < 4; ++m) _Pragma("unroll") for (int n = 0; n < 2; ++n) _Pragma("unroll") for (int k = 0; k < 2; ++k) \
        acc[ai][bj][m][n] = __builtin_amdgcn_mfma_f32_16x16x32_bf16(Bt[n][k], At[m][k], acc[ai][bj][m][n], 0, 0, 0); __builtin_amdgcn_s_setprio(0); } while (0)
#define PG8_WAIT_V(n) asm volatile("s_waitcnt vmcnt(" #n ")" ::: "memory")
#define PG8_WAIT_L(n) asm volatile("s_waitcnt lgkmcnt(" #n ")" ::: "memory")
#define PG8_BAR __builtin_amdgcn_s_barrier()
#define PG8_SCHED __builtin_amdgcn_sched_barrier(0)
    Unit cur, nxt; int ui = 0;
    if (!S.next(0, cur)) return;
    f32x4 acc[2][2][4][2];
#pragma unroll
    for (int a = 0; a < 2; ++a)
#pragma unroll
        for (int b = 0; b < 2; ++b)
#pragma unroll
            for (int m = 0; m < 4; ++m)
#pragma unroll
                for (int n = 0; n < 2; ++n) acc[a][b][m][n] = (f32x4){0.f, 0.f, 0.f, 0.f};
    bf16x8 At[4][2], B0[2][2], B1[2][2];
    const char* cA = (const char*)g.A + (size_t)cur.pm * tstepA; const char* cB = (const char*)g.Bt + (size_t)cur.pn * tstepB;
    S.a_ready(cur);
    if constexpr (SP2) {
        PG8_STAGE(PG8_SB(0, 0), cB, voffB); PG8_STAGE(PG8_SB(0, 1), cB + hstepB, voffB); PG8_STAGE(PG8_SA(0, 0), cA, voffA); PG8_STAGE(PG8_SA(0, 1), cA + hstepA, voffA);
        if (wr == 1) PG8_BAR;
        PG8_WAIT_V(2); PG8_BAR;
        PG8_STAGE(PG8_SB(1, 0), cB + kstep, voffB); PG8_STAGE(PG8_SA(1, 0), cA + kstep, voffA); PG8_STAGE(PG8_SB(1, 1), cB + hstepB + kstep, voffB);
        PG8_WAIT_V(6); PG8_BAR;
    } else {
        PG8_STAGE(PG8_SB(0, 0), cB, voffB); PG8_STAGE(PG8_SA(0, 0), cA, voffA); PG8_STAGE(PG8_SB(0, 1), cB + hstepB, voffB); PG8_STAGE(PG8_SA(0, 1), cA + hstepA, voffA);
        if (wr == 1) PG8_BAR;
        PG8_WAIT_V(4); PG8_BAR;
        PG8_STAGE(PG8_SB(1, 0), cB + kstep, voffB); PG8_STAGE(PG8_SA(1, 0), cA + kstep, voffA); PG8_STAGE(PG8_SB(1, 1), cB + hstepB + kstep, voffB);
        PG8_WAIT_V(6); PG8_BAR;
    }
    for (;;) {
        const bool has_next = S.next(ui + 1, nxt);
        const char* nA = has_next ? (const char*)g.A + (size_t)nxt.pm * tstepA : cA; const char* nB = has_next ? (const char*)g.Bt + (size_t)nxt.pn * tstepB : cB;
        for (int t = 0; t < nt; t += 2) {
            const bool last = (t == nt - 2);
            const char* a1 = cA + (size_t)(t + 1) * kstep;
            const char* a2 = last ? nA : cA + (size_t)(t + 2) * kstep; const char* b2 = last ? nB : cB + (size_t)(t + 2) * kstep;
            const char* a3 = a2 + kstep; const char* b3 = b2 + kstep;
            if (last && has_next) S.a_ready(nxt);
            if constexpr (SP2) {
            PG8_LDB(B0, 0, 0); PG8_LDB(B1, 0, 1); PG8_SCHED; PG8_LDA(At, 0, 0); PG8_STAGE(PG8_SA(1, 1), a1 + hstepA, voffA);
            PG8_WAIT_V(8); PG8_WAIT_L(0); PG8_BAR; PG8_MMA(0, 0, At, B0); PG8_MMA(0, 1, At, B1); PG8_BAR; PG8_SCHED;
            PG8_LDA(At, 0, 1); PG8_STAGE(PG8_SB(0, 0), b2, voffB); PG8_STAGE(PG8_SB(0, 1), b2 + hstepB, voffB); PG8_STAGE(PG8_SA(0, 0), a2, voffA);
            PG8_WAIT_V(8); PG8_WAIT_L(0); PG8_BAR; PG8_MMA(1, 0, At, B0); PG8_MMA(1, 1, At, B1); PG8_BAR; PG8_SCHED;
            PG8_LDB(B0, 1, 0); PG8_LDB(B1, 1, 1); PG8_SCHED; PG8_LDA(At, 1, 0); PG8_STAGE(PG8_SA(0, 1), a2 + hstepA, voffA);
            PG8_WAIT_V(8); PG8_WAIT_L(0); PG8_BAR; PG8_MMA(0, 0, At, B0); PG8_MMA(0, 1, At, B1); PG8_BAR; PG8_SCHED;
            PG8_LDA(At, 1, 1); PG8_STAGE(PG8_SB(1, 0), b3, voffB); PG8_STAGE(PG8_SB(1, 1), b3 + hstepB, voffB); PG8_STAGE(PG8_SA(1, 0), a3, voffA);
            PG8_WAIT_V(8); PG8_WAIT_L(0); PG8_BAR; PG8_MMA(1, 0, At, B0); PG8_MMA(1, 1, At, B1); PG8_BAR; PG8_SCHED;
            } else {
            PG8_LDB(B0, 0, 0); PG8_SCHED; PG8_LDA(At, 0, 0); PG8_STAGE(PG8_SA(1, 1), a1 + hstepA, voffA);
            PG8_WAIT_L(8); PG8_BAR; PG8_WAIT_L(0); PG8_MMA(0, 0, At, B0); PG8_BAR; PG8_SCHED;
            PG8_LDB(B1, 0, 1); PG8_STAGE(PG8_SB(0, 0), b2, voffB);
            PG8_BAR; PG8_WAIT_L(0); PG8_MMA(0, 1, At, B1); PG8_BAR;
            PG8_LDA(At, 0, 1); PG8_STAGE(PG8_SA(0, 0), a2, voffA);
            PG8_BAR; PG8_WAIT_L(0); PG8_MMA(1, 0, At, B0); PG8_BAR; PG8_SCHED;
            PG8_STAGE(PG8_SB(0, 1), b2 + hstepB, voffB);
            PG8_WAIT_V(6); PG8_BAR; PG8_MMA(1, 1, At, B1); PG8_BAR;
            PG8_LDB(B0, 1, 0); PG8_SCHED; PG8_LDA(At, 1, 0); PG8_STAGE(PG8_SA(0, 1), a2 + hstepA, voffA);
            PG8_WAIT_L(8); PG8_BAR; PG8_WAIT_L(0); PG8_MMA(0, 0, At, B0); PG8_BAR; PG8_SCHED;
            PG8_LDB(B1, 1, 1); PG8_STAGE(PG8_SB(1, 0), b3, voffB);
            PG8_BAR; PG8_WAIT_L(0); PG8_MMA(0, 1, At, B1); PG8_BAR;
            PG8_LDA(At, 1, 1); PG8_STAGE(PG8_SA(1, 0), a3, voffA);
            PG8_BAR; PG8_WAIT_L(0); PG8_MMA(1, 0, At, B0); PG8_BAR; PG8_SCHED;
            PG8_STAGE(PG8_SB(1, 1), b3 + hstepB, voffB);
            PG8_WAIT_V(6); PG8_BAR; PG8_MMA(1, 1, At, B1); PG8_BAR;
            }
        }
        if constexpr (ALIGN_EPI) { if (wr == 0) PG8_BAR; }
        if constexpr (!Epi::AFTER_DRAIN) { E(acc, cur, wr, wc, fr, fq); S.done(cur); }
        if (!has_next) break;
#pragma unroll
        for (int a = 0; a < 2; ++a)
#pragma unroll
            for (int b = 0; b < 2; ++b)
#pragma unroll
                for (int m = 0; m < 4; ++m)
#pragma unroll
                    for (int n = 0; n < 2; ++n) acc[a][b][m][n] = (f32x4){0.f, 0.f, 0.f, 0.f};
        cur = nxt; cA = nA; cB = nB; ++ui;
        if constexpr (ALIGN_EPI) { if (wr == 1) PG8_BAR; }
    }
    PG8_WAIT_V(0);
    if constexpr (!ALIGN_EPI) { if (wr == 0) PG8_BAR; }
    PG8_BAR;
    if constexpr (Epi::AFTER_DRAIN) { E.fused(acc, cur, wr, wc, fr, fq, lds, wid, lane); S.done(cur); }
#undef PG8_SA
#undef PG8_SB
#undef PG8_STAGE
#undef PG8_LDA
#undef PG8_LDB
#undef PG8_MMA
#undef PG8_WAIT_V
#undef PG8_WAIT_L
#undef PG8_BAR
#undef PG8_SCHED
}
}
#define GAS __attribute__((address_space(1)))
#define LAS __attribute__((address_space(3)))
typedef unsigned short bf16;
typedef unsigned v4u __attribute__((ext_vector_type(4)));
typedef float f32x4 __attribute__((ext_vector_type(4)));
typedef short bf16x8 __attribute__((ext_vector_type(8)));
typedef GAS unsigned gu32;
typedef GAS unsigned long long gu64;
#define RLX_AGENT __ATOMIC_RELAXED, __HIP_MEMORY_SCOPE_AGENT
#define LDS_WAIT() asm volatile("s_waitcnt lgkmcnt(0)" ::: "memory")
#define VM_WAIT() asm volatile("s_waitcnt vmcnt(0)" ::: "memory")
__device__ __forceinline__ unsigned long long rt() { return __builtin_amdgcn_s_memrealtime(); }
__device__ __forceinline__ unsigned f2bf(float f) { unsigned u = __builtin_bit_cast(unsigned, f); return (u + 0x7fffu + ((u >> 16) & 1u)) >> 16; }
__device__ __forceinline__ unsigned pk2(float lo, float hi) { return f2bf(lo) | (f2bf(hi) << 16); }

#define XB_TMO      128
#define XB_XCNT(j)  (256  + 64 * (j))
#define XB_XSUB(j)  (1280 + 64 * (j))
#define XB_XGEN(j)  (2304 + 64 * (j))
#define XB_TOP      3328
#define XB_TOPGEN   3392
#define XCD_BAR_WORDS 3456
#define XB_SPIN_CAP (1u << 18)

__device__ __forceinline__ unsigned xb_ld(unsigned* p)              { return __hip_atomic_load(p, __ATOMIC_RELAXED, __HIP_MEMORY_SCOPE_AGENT); }
__device__ __forceinline__ unsigned xb_add(unsigned* p, unsigned v) { return __hip_atomic_fetch_add(p, v, __ATOMIC_RELAXED, __HIP_MEMORY_SCOPE_AGENT); }
__device__ __forceinline__ unsigned xb_xcc_id() { return (unsigned)__builtin_amdgcn_s_getreg((3 << 11) | 20) & 0xFu; }
#define XB_SPIN(cond, bar) do { unsigned _sp = 0; while (cond) { __builtin_amdgcn_s_sleep(1); \
    if ((++_sp & 255u) == 0u) { if (xb_ld(&(bar)[XB_TMO])) break; if (_sp > XB_SPIN_CAP) { atomicAdd(&(bar)[XB_TMO], 1u); break; } } } } while (0)

struct XcdBarrier {
    unsigned* bar; unsigned x;
    volatile LAS unsigned* st;
};

__device__ __forceinline__ XcdBarrier xcd_barrier_post(unsigned* bar, volatile LAS unsigned* st) {
    XcdBarrier b; b.bar = bar; b.x = xb_xcc_id(); b.st = st;
    if (threadIdx.x == 0) (void)xb_add(&bar[XB_XCNT(b.x)], 1u);
    return b;
}
__device__ __forceinline__ void xcd_barrier_complete(unsigned* bar, unsigned x, unsigned& nloc, unsigned& nx) {
    const unsigned G = gridDim.x * gridDim.y * gridDim.z;
    unsigned sum, cnt, mine, sp = 0u;
    for (;;) {
        sum = 0u; cnt = 0u; mine = 0u;
#pragma unroll
        for (unsigned j = 0; j < 16; ++j) { const unsigned c = xb_ld(&bar[XB_XCNT(j)]); sum += c; cnt += (c > 0u) ? 1u : 0u; mine = (j == x) ? c : mine; }
        if (sum == G) break;
        __builtin_amdgcn_s_sleep(1);
        if ((++sp & 255u) == 0u) { if (xb_ld(&bar[XB_TMO])) break; if (sp > XB_SPIN_CAP) { atomicAdd(&bar[XB_TMO], 1u); break; } }
    }
    nloc = mine > 0u ? mine : 1u; nx = cnt > 0u ? cnt : 1u;
}

__device__ __forceinline__ void xcd_barrier(const XcdBarrier& b) {
    asm volatile("s_waitcnt vmcnt(0)" ::: "memory");
    __syncthreads();
    if (threadIdx.x == 0) {
        unsigned* bar = b.bar;
        __builtin_amdgcn_s_waitcnt(0);
        unsigned nloc = b.st[0], nx = b.st[1];
        if (nloc == 0u) { xcd_barrier_complete(bar, b.x, nloc, nx); b.st[0] = nloc; b.st[1] = nx; }
        const unsigned old = xb_add(&bar[XB_XSUB(b.x)], 1u);
        const unsigned gen = old / nloc;
        if (old + 1u == (gen + 1u) * nloc) {
            __builtin_amdgcn_fence(__ATOMIC_RELEASE, "agent");
            asm volatile("s_waitcnt vmcnt(0)" ::: "memory");
            const unsigned og = xb_add(&bar[XB_TOP], 1u);
            const unsigned tg = og / nx;
            if (og + 1u == (tg + 1u) * nx) xb_add(&bar[XB_TOPGEN], 1u);
            else XB_SPIN(xb_ld(&bar[XB_TOPGEN]) == tg, bar);
            __builtin_amdgcn_fence(__ATOMIC_ACQUIRE, "agent");
            xb_add(&bar[XB_XGEN(b.x)], 1u);
            asm volatile("s_waitcnt vmcnt(0)" ::: "memory");
        } else {
            XB_SPIN(xb_ld(&bar[XB_XGEN(b.x)]) == gen, bar);
            __builtin_amdgcn_fence(__ATOMIC_ACQUIRE, "agent");
            asm volatile("s_waitcnt vmcnt(0)" ::: "memory");
        }
    }
    __syncthreads();
}


typedef float f32x2 __attribute__((ext_vector_type(2)));
constexpr int NWAVES = 8;
constexpr int BATCH = 4, SEQ = 4096, DM = 1024, MTOK = BATCH * SEQ;
constexpr int NIN1 = 4864;
constexpr int LATW = 768;
constexpr float C2Q = 0.07216878364870323f * 1.4426950408889634f;

constexpr size_t MiB = 1u << 20, KiB = 1u << 10;
constexpr size_t WS_CTL = 0, CTL_ZERO_BYTES = 64 * KiB;
constexpr size_t WS_SMALL = 1 * MiB;
constexpr size_t SM_RSTDX = 0, SM_SSQ_CQ = 64 * KiB, SM_SSQ_CKV = 128 * KiB, SM_SSQ1 = 192 * KiB, SM_SSQ2 = 256 * KiB, SM_SSQ_RO = 320 * KiB, SM_END = 576 * KiB;
constexpr size_t WS_WIN = 2 * MiB;
constexpr size_t WS_WUQ = WS_WIN + (size_t)8960 * 1024 * 2;
constexpr size_t WS_WUKV = WS_WUQ + (size_t)1536 * 384 * 2;
constexpr size_t WS_XB = 22 * MiB;
constexpr size_t WS_CS = 54 * MiB;
constexpr size_t WS_LAT = 70 * MiB;
constexpr size_t WS_RQ = 94 * MiB, WS_RK = 126 * MiB, WS_RKDT = 158 * MiB, WS_RVT = 190 * MiB;
constexpr size_t WS_QP = 94 * MiB, WS_KVP = 142 * MiB, WS_KF = 206 * MiB;
constexpr size_t WS_MO = 54 * MiB;
constexpr size_t WS_SG = 94 * MiB, WS_TM = 158 * MiB;
constexpr size_t WS_WBR = 190 * MiB, WS_WBM = 194 * MiB, WS_WO = 196 * MiB, WS_WUP = 198 * MiB, WS_WDOWN = 206 * MiB, WS_WPG = 214 * MiB, WS_WPLE = 216 * MiB;
constexpr size_t WS_PB = 217 * MiB;
constexpr size_t WS_H = 54 * MiB;
constexpr size_t WS_GT = 54 * MiB;
constexpr size_t WS_END = 256 * MiB;
static_assert(SM_SSQ_CKV == SM_SSQ_CQ + 65536, "ssq_lat layout");
static_assert(WS_WUKV + (size_t)2048 * 256 * 2 <= WS_XB && WS_RVT + 64 * MiB <= WS_END && WS_KF + 48 * MiB <= WS_END && WS_H + 128 * MiB <= WS_WBR && WS_PB + 8 * MiB <= WS_END, "d_ws map");
constexpr int CW_BAR = 1024;

constexpr int RING_OFF = 0, RING_BYTES = 131072;
constexpr int XS_OFF = RING_BYTES, XS_BYTES = 8 * 2304;
constexpr int MISC_OFF = XS_OFF + XS_BYTES;
constexpr int LDS_BYTES = 160 * 1024;
static_assert(MISC_OFF + 128 <= LDS_BYTES, "LDS map");

struct Frame {
    LAS unsigned char* lds; volatile LAS unsigned* MISC; int tid, lane, wave, G, vcu;
    float* out; unsigned char* ws;
};
__device__ __forceinline__ float wave_sum(float v) {
#pragma unroll
    for (int o = 1; o < 64; o <<= 1) v += __shfl_xor(v, o);
    return v;
}
__device__ __forceinline__ void p0_transpose_item(const float* W, int ldw, int K, int src_col, bf16* WT, int dst_row, int ncols, const float* gain, LAS float* scr, int item, int lane) {
    const int nblk = ncols / 32, kb = item / nblk, nb = item % nblk, k0 = 64 * kb, n0 = 32 * nb;
#pragma unroll 8
    for (int i = 0; i < 32; ++i) { const int kk = 2 * i + (lane >> 5); const float gk = gain ? gain[k0 + kk] : 1.0f; scr[kk * 33 + (lane & 31)] = W[(size_t)(k0 + kk) * ldw + src_col + n0 + (lane & 31)] * gk; }
    LDS_WAIT(); asm volatile("" ::: "memory");
    const int c = lane & 7;
#pragma unroll
    for (int j = 0; j < 4; ++j) { const int n = (lane >> 3) + 8 * j; const LAS float* s = scr + (8 * c) * 33 + n;
        v4u o; o.x = pk2(s[0 * 33], s[1 * 33]); o.y = pk2(s[2 * 33], s[3 * 33]); o.z = pk2(s[4 * 33], s[5 * 33]); o.w = pk2(s[6 * 33], s[7 * 33]);
        *(GAS v4u*)(WT + (size_t)(dst_row + n0 + n) * K + k0 + 8 * c) = o; }
    LDS_WAIT(); asm volatile("" ::: "memory");
}
#define P0_SEG(W, ldw, K, src, WT, dst, ncols, gain) { const int n_ = ((K) / 64) * ((ncols) / 32); if (r < n_) { p0_transpose_item(W, ldw, K, src, WT, dst, ncols, gain, scr, r, F.lane); continue; } r -= n_; }
__device__ __forceinline__ void phase_p0(Frame& F, const float* x, const int* pos, const float* g_mix, const float* w_in, const float* g_qlat, const float* g_kvlat, const float* w_uq, const float* w_ukv) {
    LAS float* scr = (LAS float*)(F.lds + RING_OFF + F.wave * 16384);
    const int gw = F.vcu * NWAVES + F.wave, NGW = F.G * NWAVES;
    bf16* WinT = (bf16*)(F.ws + WS_WIN); bf16* WuqT = (bf16*)(F.ws + WS_WUQ); bf16* WukvT = (bf16*)(F.ws + WS_WUKV);
    constexpr int NIT = 16 * (2048 / 32) * 2 + 16 * (4096 / 32) + 16 * (704 / 32) + 6 * (1536 / 32) + 4 * (2048 / 32);
    for (int it = gw; it < NIT; it += NGW) {
        int r = it;
        P0_SEG(w_in, 8896, 1024, 6848, WinT, 0, 2048, g_mix)
        P0_SEG(w_in, 8896, 1024, 4096, WinT, 2048, 2048, g_mix)
        P0_SEG(w_in, 8896, 1024, 0, WinT, 4096, 4096, g_mix)
        P0_SEG(w_in, 8896, 1024, 6144, WinT, 8192, 704, g_mix)
        P0_SEG(w_uq, 1536, 384, 0, WuqT, 0, 1536, g_qlat)
        P0_SEG(w_ukv, 2048, 256, 0, WukvT, 0, 2048, g_kvlat)
    }
    { const int gt = F.vcu * 512 + F.tid; if (gt < 8192) *(GAS v4u*)((unsigned char*)(WinT + (size_t)8896 * 1024) + (size_t)gt * 16) = (v4u){0u, 0u, 0u, 0u}; }
    { bf16* XB = (bf16*)(F.ws + WS_XB); float* rstdx = (float*)(F.ws + WS_SMALL + SM_RSTDX);
      for (int m = gw; m < MTOK; m += NGW) {
          const GAS f32x4* xr = (const GAS f32x4*)(x + (size_t)m * DM) + F.lane; f32x4 v[4]; float s = 0.f;
#pragma unroll
          for (int j = 0; j < 4; ++j) { v[j] = xr[64 * j]; s += (v[j].x * v[j].x + v[j].y * v[j].y) + (v[j].z * v[j].z + v[j].w * v[j].w); }
          s = wave_sum(s);
          GAS unsigned long long* o8 = (GAS unsigned long long*)(XB + (size_t)m * DM) + F.lane;
#pragma unroll
          for (int j = 0; j < 4; ++j) o8[64 * j] = (unsigned long long)pk2(v[j].x, v[j].y) | ((unsigned long long)pk2(v[j].z, v[j].w) << 32);
          if (F.lane == 0) rstdx[m] = 1.0f / sqrtf(s * (1.0f / DM) + 1e-6f);
      } }
    { f32x2* cs = (f32x2*)(F.ws + WS_CS);
      for (int e = F.vcu * 512 + F.tid; e < MTOK * 128; e += F.G * 512) { const int row = e >> 7, i = e & 127;
          const float inv = __builtin_amdgcn_exp2f(-(float)i * (13.287712379549449f / 128.0f));
          double rev = (double)pos[row] * (double)inv * 0.15915494309189535; rev -= __builtin_rint(rev);
          const float rf = (float)rev; cs[e] = (f32x2){__builtin_amdgcn_cosf(rf), __builtin_amdgcn_sinf(rf)}; } }
    { float* z = (float*)(F.ws + WS_SMALL + SM_SSQ_CQ); for (int e = F.vcu * 512 + F.tid; e < (int)((SM_END - SM_SSQ_CQ) / 4); e += F.G * 512) z[e] = 0.f; }
}
__device__ __forceinline__ void phase_late_weights(Frame& F, const float* p, const float* w_br, const float* w_bm, const float* w_o, const float* g_mlp, const float* w_up, const float* w_down, const float* g_ple, const float* w_pg, const float* w_ple) {
    LAS float* scr = (LAS float*)(F.lds + RING_OFF + F.wave * 16384);
    const int gw = F.vcu * NWAVES + F.wave, NGW = F.G * NWAVES;
    constexpr int NIT = 32 * 32 + 16 * 32 + 16 * 32 + 16 * 128 + 64 * 32 + 16 * 32 + 4 * 32;
    for (int it = gw; it < NIT; it += NGW) {
        int r = it;
        P0_SEG(w_br, 1024, 2048, 0, (bf16*)(F.ws + WS_WBR), 0, 1024, (const float*)nullptr)
        P0_SEG(w_bm, 1024, 1024, 0, (bf16*)(F.ws + WS_WBM), 0, 1024, (const float*)nullptr)
        P0_SEG(w_o, 1024, 1024, 0, (bf16*)(F.ws + WS_WO), 0, 1024, (const float*)nullptr)
        P0_SEG(w_up, 4096, 1024, 0, (bf16*)(F.ws + WS_WUP), 0, 4096, g_mlp)
        P0_SEG(w_down, 1024, 4096, 0, (bf16*)(F.ws + WS_WDOWN), 0, 1024, (const float*)nullptr)
        P0_SEG(w_pg, 1024, 1024, 0, (bf16*)(F.ws + WS_WPG), 0, 1024, g_ple)
        P0_SEG(w_ple, 1024, 256, 0, (bf16*)(F.ws + WS_WPLE), 0, 1024, (const float*)nullptr)
    }
    { bf16* PB = (bf16*)(F.ws + WS_PB);
      for (int e = F.vcu * 512 + F.tid; e < MTOK * 256 / 8; e += F.G * 512) { const f32x4 a = *(const GAS f32x4*)(p + (size_t)e * 8), b = *(const GAS f32x4*)(p + (size_t)e * 8 + 4);
          *(GAS v4u*)(PB + (size_t)e * 8) = (v4u){pk2(a.x, a.y), pk2(a.z, a.w), pk2(b.x, b.y), pk2(b.z, b.w)}; } }
}

typedef float f32x16 __attribute__((ext_vector_type(16)));
typedef unsigned u32x2 __attribute__((ext_vector_type(2)));
typedef short v4i16_t __attribute__((ext_vector_type(4)));
__device__ __forceinline__ int crow(int r, int hi) { return (r & 3) + 8 * (r >> 2) + 4 * hi; }
typedef __bf16 bf16x2m_t __attribute__((ext_vector_type(2)));
__device__ __forceinline__ unsigned cvtpk(float lo, float hi) { f32x2 v = {lo, hi}; bf16x2m_t b = __builtin_convertvector(v, bf16x2m_t); return __builtin_bit_cast(unsigned, b); }
__device__ __forceinline__ bf16x8 pack8f(const f32x16& p, int b) { v4u w = {cvtpk(p[b], p[b + 1]), cvtpk(p[b + 2], p[b + 3]), cvtpk(p[b + 4], p[b + 5]), cvtpk(p[b + 6], p[b + 7])}; return __builtin_bit_cast(bf16x8, w); }
__device__ __forceinline__ float bf2f(bf16 v) { return __uint_as_float((unsigned)v << 16); }
__device__ __forceinline__ float log2_gamma(int h) { return __builtin_amdgcn_logf(1.0f - __builtin_amdgcn_exp2f(-5.0f - (float)h)); }

__device__ __forceinline__ void phase_r0(Frame& F) {
    const bf16* RQ = (const bf16*)(F.ws + WS_RQ); const bf16* RK = (const bf16*)(F.ws + WS_RK); const bf16* RVT = (const bf16*)(F.ws + WS_RVT); bf16* RO = (bf16*)F.out;
    const int lane = F.lane, w = F.wave, l31 = lane & 31, hi = lane >> 5, tq = w & 3, dh = w >> 2;
    for (int unit = F.vcu; unit < 512; unit += F.G) {
        const int bh = unit >> 5, c = unit & 31, b = bh >> 2, h = bh & 3; const size_t tok0 = (size_t)b * SEQ + c * 128;
        const float lg2 = log2_gamma(h);
        bf16x8 qf[16];
#pragma unroll
        for (int ks = 0; ks < 16; ++ks) qf[ks] = *(const bf16x8*)(RQ + (tok0 + 32 * tq + l31) * 1024 + h * 256 + 16 * ks + 8 * hi);
        bf16x8 pf[4][2];
#pragma unroll
        for (int tb = 0; tb < 4; ++tb) {
            pf[tb][0] = (bf16x8){0, 0, 0, 0, 0, 0, 0, 0}; pf[tb][1] = pf[tb][0];
            if (tb <= tq) {
                f32x16 s = {};
#pragma unroll
                for (int ks = 0; ks < 16; ++ks) { const bf16x8 kf = *(const bf16x8*)(RK + (tok0 + 32 * tb + l31) * 1024 + h * 256 + 16 * ks + 8 * hi); s = __builtin_amdgcn_mfma_f32_32x32x16_bf16(kf, qf[ks], s, 0, 0, 0); }
#pragma unroll
                for (int r = 0; r < 16; ++r) { const int d = (32 * tq + l31) - (32 * tb + crow(r, hi)); s[r] = d >= 0 ? s[r] * __builtin_amdgcn_exp2f((float)d * lg2) : 0.f; }
                pf[tb][0] = pack8f(s, 0); pf[tb][1] = pack8f(s, 8);
            }
        }
#pragma unroll 1
        for (int db = 0; db < 8; ++db) {
            f32x16 o = {};
#pragma unroll
            for (int tb = 0; tb < 4; ++tb)
                if (tb <= tq) {
#pragma unroll
                    for (int s2 = 0; s2 < 2; ++s2) { const bf16* vp = RVT + ((size_t)bh * 512 + 256 * dh + 32 * db + l31) * 4096 + c * 128 + 32 * tb + 16 * s2 + 4 * hi;
                        const u32x2 lo = *(const u32x2*)vp, hh = *(const u32x2*)(vp + 8); const v4u w4 = {lo.x, lo.y, hh.x, hh.y};
                        o = __builtin_amdgcn_mfma_f32_32x32x16_bf16(pf[tb][s2], __builtin_bit_cast(bf16x8, w4), o, 0, 0, 0); }
                }
#pragma unroll
            for (int r = 0; r < 16; ++r) RO[(tok0 + 32 * tq + crow(r, hi)) * 2048 + h * 512 + 256 * dh + 32 * db + l31] = (bf16)f2bf(o[r]);
        }
    }
}
__device__ __forceinline__ void phase_r1(Frame& F) {
    const bf16* RQ = (const bf16*)(F.ws + WS_RQ); const bf16* RKDT = (const bf16*)(F.ws + WS_RKDT); const bf16* RVT = (const bf16*)(F.ws + WS_RVT); bf16* RO = (bf16*)F.out;
    float* ssq_ro = (float*)(F.ws + WS_SMALL + SM_SSQ_RO);
    const int lane = F.lane, w = F.wave, l31 = lane & 31, hi = lane >> 5, l15 = lane & 15, lq = lane >> 4;
    constexpr int SROW = 528, SBUF = 32 * SROW;
    for (int unit = F.vcu; unit < 256; unit += F.G) {
        const int bh = unit >> 4, j = unit & 15, b = bh >> 2, h = bh & 3;
        const float lg2 = log2_gamma(h), gC = __builtin_amdgcn_exp2f(128.0f * lg2);
        f32x16 S = {};
        __syncthreads();
#pragma unroll
        for (int g = 0; g < 4; ++g) *(LAS u32x2*)(F.lds + l31 * SROW + (32 * w + 8 * g + 4 * hi) * 2) = (u32x2){0u, 0u};
        for (int c = 0; c < 32; ++c) {
            const int cur = c & 1; const size_t tok0 = (size_t)b * SEQ + c * 128;
            __syncthreads();
            f32x4 oi[2] = {(f32x4){0.f, 0.f, 0.f, 0.f}, (f32x4){0.f, 0.f, 0.f, 0.f}};
#pragma unroll
            for (int ks = 0; ks < 8; ++ks) { const bf16x8 a = *(const bf16x8*)(RQ + (tok0 + 16 * w + l15) * 1024 + h * 256 + 32 * ks + 8 * lq);
#pragma unroll
                for (int nb = 0; nb < 2; ++nb) { const bf16x8 bq = *(const LAS bf16x8*)(F.lds + cur * SBUF + (16 * nb + l15) * SROW + (32 * ks + 8 * lq) * 2);
                    oi[nb] = __builtin_amdgcn_mfma_f32_16x16x32_bf16(a, bq, oi[nb], 0, 0, 0); } }
#pragma unroll
            for (int i = 0; i < 4; ++i) { const int tt = 16 * w + 4 * lq + i; const float qd = __builtin_amdgcn_exp2f((float)(tt + 1) * lg2); float q = 0.f;
#pragma unroll
                for (int nb = 0; nb < 2; ++nb) { bf16* p = RO + (tok0 + tt) * 2048 + h * 512 + 32 * j + 16 * nb + l15; const float v = bf2f(*p) + qd * oi[nb][i]; *p = (bf16)f2bf(v); q += v * v; }
                q += __shfl_xor(q, 1); q += __shfl_xor(q, 2); q += __shfl_xor(q, 4); q += __shfl_xor(q, 8);
                if (l15 == 0) atomicAdd(ssq_ro + (tok0 + tt) * 4 + h, q); }
#pragma unroll
            for (int r = 0; r < 16; ++r) S[r] *= gC;
#pragma unroll
            for (int ks = 0; ks < 8; ++ks) { const bf16x8 a = *(const bf16x8*)(RKDT + ((size_t)bh * 256 + 32 * w + l31) * 4096 + c * 128 + 16 * ks + 8 * hi);
                const bf16x8 bv = *(const bf16x8*)(RVT + ((size_t)bh * 512 + 32 * j + l31) * 4096 + c * 128 + 16 * ks + 8 * hi);
                S = __builtin_amdgcn_mfma_f32_32x32x16_bf16(a, bv, S, 0, 0, 0); }
#pragma unroll
            for (int g = 0; g < 4; ++g) *(LAS u32x2*)(F.lds + (cur ^ 1) * SBUF + l31 * SROW + (32 * w + 8 * g + 4 * hi) * 2) = (u32x2){cvtpk(S[4 * g], S[4 * g + 1]), cvtpk(S[4 * g + 2], S[4 * g + 3])};
        }
    }
    __syncthreads();
}
__device__ __forceinline__ void phase_fin(Frame& F, const float* qn, const float* kn) {
    bf16* QP = (bf16*)(F.ws + WS_QP); const bf16* KVP = (const bf16*)(F.ws + WS_KVP); const bf16* LAT = (const bf16*)(F.ws + WS_LAT); bf16* KF = (bf16*)(F.ws + WS_KF);
    const f32x2* cs = (const f32x2*)(F.ws + WS_CS);
    const int gw = F.vcu * NWAVES + F.wave, NGW = F.G * NWAVES, lane = F.lane, h = lane >> 3, part = lane & 7;
    for (int tok = gw; tok < MTOK; tok += NGW) {
#pragma unroll
        for (int which = 0; which < 2; ++which) {
            float v[3][8]; float ssq = 0.f;
#pragma unroll
            for (int r = 0; r < 3; ++r) { v4u wv;
                if (which == 0) wv = *(const v4u*)(QP + (size_t)tok * 1536 + h * 192 + 64 * r + 8 * part);
                else if (r < 2) wv = *(const v4u*)(KVP + (size_t)tok * 2048 + h * 256 + 64 * r + 8 * part);
                else wv = *(const v4u*)(LAT + (size_t)tok * LATW + 640 + 8 * part);
                const unsigned ww[4] = {wv.x, wv.y, wv.z, wv.w};
#pragma unroll
                for (int e = 0; e < 4; ++e) { v[r][2 * e] = __uint_as_float(ww[e] << 16); v[r][2 * e + 1] = __uint_as_float(ww[e] & 0xffff0000u); }
#pragma unroll
                for (int e = 0; e < 8; ++e) ssq += v[r][e] * v[r][e]; }
            ssq += __shfl_xor(ssq, 1); ssq += __shfl_xor(ssq, 2); ssq += __shfl_xor(ssq, 4);
            const float sc = (1.0f / sqrtf(ssq * (1.0f / 192.0f) + 1e-6f)) * (which == 0 ? C2Q : 1.0f);
            const float* gn = which == 0 ? qn : kn;
            bf16* dst = which == 0 ? QP + (size_t)tok * 1536 + h * 192 : KF + (size_t)tok * 1536 + h * 192;
#pragma unroll
            for (int r = 0; r < 3; ++r) {
                float y[8];
#pragma unroll
                for (int e = 0; e < 8; ++e) y[e] = v[r][e] * sc * gn[64 * r + 8 * part + e];
                if (r == 2) {
#pragma unroll
                    for (int e = 0; e < 8; ++e) { const float pr = __shfl_xor(y[e], 4); const f32x2 c = cs[(size_t)tok * 128 + 4 * (8 * (part & 3) + e)];
                        y[e] = part < 4 ? y[e] * c.x - pr * c.y : y[e] * c.x + pr * c.y; }
                }
                *(v4u*)(dst + 64 * r + 8 * part) = (v4u){pk2(y[0], y[1]), pk2(y[2], y[3]), pk2(y[4], y[5]), pk2(y[6], y[7])};
            }
        }
    }
}
__device__ __forceinline__ void phase_attn(Frame& F) {
    const bf16* QP = (const bf16*)(F.ws + WS_QP); const bf16* KVP = (const bf16*)(F.ws + WS_KVP); const bf16* KF = (const bf16*)(F.ws + WS_KF); bf16* MO = (bf16*)(F.ws + WS_MO);
    const int lane = F.lane, w = F.wave, l31 = lane & 31, hi = lane >> 5;
    LAS unsigned char* vst = F.lds + w * 9216; LAS float* al = (LAS float*)(vst + 8704); LAS float* li = al + 32;
    constexpr int VROW = 272;
    const int trb = (4 * hi + ((lane & 15) >> 2)) * VROW + (16 * ((lane >> 4) & 1) + 4 * (lane & 3)) * 2;
    for (int v = F.vcu; v < 256; v += F.G) {
#pragma unroll 1
        for (int half = 0; half < 2; ++half) {
            const int qb = half == 0 ? 15 - (v >> 5) : (v >> 5), bh = v & 31, b = bh >> 3, h = bh & 7;
            const int q0 = qb * 256 + 32 * w; const size_t tb = (size_t)b * SEQ;
            bf16x8 qr[12];
#pragma unroll
            for (int d = 0; d < 12; ++d) qr[d] = *(const bf16x8*)(QP + (tb + q0 + l31) * 1536 + h * 192 + 16 * d + 8 * hi);
            float m_run = -1e30f, l_run = 0.f; f32x16 o[4] = {};
            const int nkt = q0 / 32 + 1;
#pragma unroll 1
            for (int kt = 0; kt < nkt; ++kt) {
                const int k0 = kt * 32;
#pragma unroll
                for (int i = 0; i < 8; ++i) { const int idx = lane + 64 * i, row = idx >> 4, ch = idx & 15;
                    const v4u vv = *(const v4u*)(KVP + (tb + k0 + row) * 2048 + h * 256 + 128 + ch * 8); *(LAS v4u*)(vst + row * VROW + ch * 16) = vv; }
                f32x16 p = {};
#pragma unroll
                for (int d = 0; d < 12; ++d) { const bf16x8 kf = *(const bf16x8*)(KF + (tb + k0 + l31) * 1536 + h * 192 + 16 * d + 8 * hi); p = __builtin_amdgcn_mfma_f32_32x32x16_bf16(kf, qr[d], p, 0, 0, 0); }
                if (kt == nkt - 1) {
#pragma unroll
                    for (int r = 0; r < 16; ++r) if (crow(r, hi) > l31) p[r] = -__builtin_inff();
                }
                float pmax = p[0];
#pragma unroll
                for (int r = 1; r < 16; ++r) pmax = fmaxf(pmax, p[r]);
                pmax = fmaxf(pmax, __shfl_xor(pmax, 32));
                const float mn = fmaxf(m_run, pmax), alpha = __builtin_amdgcn_exp2f(m_run - mn); m_run = mn;
                float ps = 0.f;
#pragma unroll
                for (int r = 0; r < 16; ++r) { p[r] = __builtin_amdgcn_exp2f(p[r] - mn); ps += p[r]; }
                ps += __shfl_xor(ps, 32); l_run = l_run * alpha + ps;
                if (hi == 0) al[l31] = alpha;
                const bf16x8 pa0 = pack8f(p, 0), pa1 = pack8f(p, 8);
                LDS_WAIT();
#pragma unroll
                for (int r = 0; r < 16; ++r) { const float a = al[crow(r, hi)];
#pragma unroll
                    for (int db = 0; db < 4; ++db) o[db][r] *= a; }
#pragma unroll
                for (int db = 0; db < 4; ++db)
#pragma unroll
                    for (int s2 = 0; s2 < 2; ++s2) { LAS unsigned char* ap = vst + trb + (16 * s2) * VROW + db * 64;
                        const v4i16_t lo = __builtin_amdgcn_ds_read_tr16_b64_v4i16((LAS v4i16_t*)ap), hh = __builtin_amdgcn_ds_read_tr16_b64_v4i16((LAS v4i16_t*)(ap + 8 * VROW));
                        const bf16x8 bfv = (bf16x8){lo[0], lo[1], lo[2], lo[3], hh[0], hh[1], hh[2], hh[3]};
                        o[db] = __builtin_amdgcn_mfma_f32_32x32x16_bf16(s2 == 0 ? pa0 : pa1, bfv, o[db], 0, 0, 0); }
                LDS_WAIT();
            }
            if (hi == 0) li[l31] = l_run;
            LDS_WAIT();
#pragma unroll
            for (int r = 0; r < 16; ++r) { const float il = 1.0f / li[crow(r, hi)];
#pragma unroll
                for (int db = 0; db < 4; ++db) MO[(tb + q0 + crow(r, hi)) * 1024 + h * 128 + 32 * db + l31] = (bf16)f2bf(o[db][r] * il); }
            LDS_WAIT();
        }
    }
}

#ifndef MK_N_LAUNCHES
#define MK_N_LAUNCHES 13
#endif
constexpr int N_PHASES = 13;
constexpr int N_LAUNCHES = MK_N_LAUNCHES;
struct Args { const float* in[21]; float* out; unsigned char* ws; int ph_lo, ph_hi; };
#define PG8_SP2 true
#define PG8_ALIGN true
template <class Epi> __device__ __forceinline__ void run_gemm(Frame& F, const pg8::bf16_t* A, int lda, const pg8::bf16_t* Bt, int ldb, int N, int K, const Epi& E) {
    __syncthreads();
    pg8::Gemm g{A, Bt, MTOK, N, K, lda, ldb}; pg8::StaticOrder S; S.init(MTOK, N, F.G, (int)blockIdx.x);
    pg8::gemm_phase<Epi, pg8::StaticOrder, PG8_ALIGN, PG8_SP2>(F.lds + RING_OFF, g, S, E);
}
__global__ void __launch_bounds__(NWAVES * 64, 2) mk_fwd(Args args) {
    extern __shared__ __attribute__((aligned(16))) unsigned char lds[];
    Frame F;
    F.lds = (LAS unsigned char*)lds; F.MISC = (volatile LAS unsigned*)(F.lds + MISC_OFF);
    F.tid = threadIdx.x; F.lane = F.tid & 63; F.wave = __builtin_amdgcn_readfirstlane(F.tid >> 6);
    F.G = gridDim.x; { const int bx = blockIdx.x; F.vcu = (F.G % 8 == 0) ? (bx % 8) * (F.G / 8) + bx / 8 : bx; }
    F.out = args.out; F.ws = args.ws;
    unsigned char* ws = args.ws;
    if (F.tid < 32) F.MISC[F.tid] = 0u;
    __syncthreads();
    XcdBarrier bar; bar.bar = (unsigned*)(ws + WS_CTL) + CW_BAR; bar.x = 0; bar.st = nullptr;
    if (N_LAUNCHES == 1) bar = xcd_barrier_post((unsigned*)(ws + WS_CTL) + CW_BAR, F.MISC + 8);
    const int lo = args.ph_lo, hi = args.ph_hi;
#ifndef PH_MASK
#define PH_MASK 0x1fff
#endif
#define IN(k) (((PH_MASK >> (k)) & 1) && lo <= (k) && (k) < hi)
#define SEAM(k) do { if (IN(k) && IN((k) + 1)) xcd_barrier(bar); } while (0)
    float* sm = (float*)(ws + WS_SMALL);
    const float* rstdx = sm + SM_RSTDX / 4; float* ssq_cq = sm + SM_SSQ_CQ / 4; float* ssq_ckv = sm + SM_SSQ_CKV / 4; float* ssq1 = sm + SM_SSQ1 / 4; float* ssq2 = sm + SM_SSQ2 / 4; float* ssq_ro = sm + SM_SSQ_RO / 4;
    typedef pg8::bf16_t b16;
    b16* WinT = (b16*)(ws + WS_WIN); b16* XB = (b16*)(ws + WS_XB); b16* LATb = (b16*)(ws + WS_LAT); b16* ROb = (b16*)args.out;

    if (IN(0)) { phase_p0(F, args.in[0], (const int*)args.in[2], args.in[3], args.in[4], args.in[6], args.in[7], args.in[8], args.in[9]); } SEAM(0);
    if (IN(1)) {
        pg8::EpiInProj E{rstdx, (const pg8::f32x4*)(ws + WS_CS), (b16*)(ws + WS_RQ), (b16*)(ws + WS_RK), (b16*)(ws + WS_RKDT), (b16*)(ws + WS_RVT), LATb, ssq_cq, (PG8_LAS unsigned char*)(F.lds + XS_OFF)};
        run_gemm(F, XB, 1024, WinT + (size_t)4096 * 1024, 1024, NIN1, 1024, E);
    } SEAM(1);
    if (IN(2)) { phase_r0(F); } SEAM(2);
    if (IN(3)) { phase_r1(F); } SEAM(3);
    if (IN(4)) {
        { pg8::EpiRetGate E{ROb, rstdx, ssq_ro, args.in[5]}; run_gemm(F, XB, 1024, WinT + (size_t)2048 * 1024, 1024, 2048, 1024, E); }
        { pg8::EpiRowAct<0> E{(b16*)(ws + WS_QP), 1536, ssq_cq, 1.0f / 384.0f}; run_gemm(F, LATb, LATW, (const b16*)(ws + WS_WUQ), 384, 1536, 384, E); }
        { pg8::EpiRowAct<0> E{(b16*)(ws + WS_KVP), 2048, ssq_ckv, 1.0f / 256.0f}; run_gemm(F, LATb + 384, LATW, (const b16*)(ws + WS_WUKV), 256, 2048, 256, E); }
    } SEAM(4);
    if (IN(5)) { phase_fin(F, args.in[10], args.in[11]); } SEAM(5);
    if (IN(6)) { phase_attn(F); } SEAM(6);
    if (IN(7)) {
#ifndef SKIP_LATE
        phase_late_weights(F, args.in[1], args.in[12], args.in[13], args.in[14], args.in[15], args.in[16], args.in[17], args.in[18], args.in[19], args.in[20]);
#endif
        { pg8::EpiRowAct<1> E{(b16*)(ws + WS_SG), 2048, rstdx, 0.f}; run_gemm(F, XB, 1024, WinT, 1024, 2048, 1024, E); }
    } SEAM(7);
    if (IN(8)) {
        { pg8::EpiGateMix<0> E{(b16*)(ws + WS_TM), (const b16*)(ws + WS_SG), 0}; run_gemm(F, ROb, 2048, (const b16*)(ws + WS_WBR), 2048, 1024, 2048, E); }
        VM_WAIT(); __syncthreads(); __builtin_amdgcn_fence(__ATOMIC_ACQUIRE, "agent"); VM_WAIT(); __syncthreads();
        { pg8::EpiGateMix<1> E{(b16*)(ws + WS_TM), (const b16*)(ws + WS_SG), 1024}; run_gemm(F, (const b16*)(ws + WS_MO), 1024, (const b16*)(ws + WS_WBM), 1024, 1024, 1024, E); }
    } SEAM(8);
    if (IN(9)) { pg8::EpiResid E{args.in[0], args.out, XB, ssq1}; run_gemm(F, (const b16*)(ws + WS_TM), 1024, (const b16*)(ws + WS_WO), 1024, 1024, 1024, E); } SEAM(9);
    if (IN(10)) { pg8::EpiRowAct<2> E{(b16*)(ws + WS_H), 4096, ssq1, 1.0f / 1024.0f}; run_gemm(F, XB, 1024, (const b16*)(ws + WS_WUP), 1024, 4096, 1024, E); } SEAM(10);
    if (IN(11)) { pg8::EpiResid E{args.out, args.out, XB, ssq2}; run_gemm(F, (const b16*)(ws + WS_H), 4096, (const b16*)(ws + WS_WDOWN), 4096, 1024, 4096, E); } SEAM(11);
    if (IN(12)) {
        { pg8::EpiRowAct<1> E{(b16*)(ws + WS_GT), 1024, ssq2, 1.0f / 1024.0f}; run_gemm(F, XB, 1024, (const b16*)(ws + WS_WPG), 1024, 1024, 1024, E); }
        VM_WAIT(); __syncthreads(); __builtin_amdgcn_fence(__ATOMIC_ACQUIRE, "agent"); VM_WAIT(); __syncthreads();
        { pg8::EpiFinal E{args.out, (const b16*)(ws + WS_GT)}; run_gemm(F, (const b16*)(ws + WS_PB), 256, (const b16*)(ws + WS_WPLE), 256, 1024, 256, E); }
    }
#undef IN
#undef SEAM
}


#ifdef DUMPK
struct DumpArgs { const unsigned* reg[6]; unsigned nw[6]; unsigned* out; int own; int pad; };
__global__ void dump_hash(DumpArgs d) {
    for (unsigned i = blockIdx.x * blockDim.x + threadIdx.x; i < (unsigned)MTOK * DM; i += gridDim.x * blockDim.x) {
        float s = 0.f;
        if (d.own) { const unsigned w = d.out[i]; s += __uint_as_float(w << 16) + __uint_as_float(w & 0xffff0000u); }
        for (int r = 0; r < 6; ++r) if (d.reg[r] && i < d.nw[r] * 2u) { const unsigned short v = ((const unsigned short*)d.reg[r])[i]; s += __uint_as_float((unsigned)v << 16); }
        ((float*)d.out)[i] = s;
    }
}
#endif
extern "C" void kernel_launch(void* const* d_in, const int* in_sizes, int n_in, void* d_out, int out_size, void* d_ws, size_t ws_size, hipStream_t stream) {
    static int grid = 0;
    if (grid == 0) {
        if (n_in != 21 || in_sizes[0] != MTOK * DM || out_size != MTOK * DM || ws_size < WS_END) { fprintf(stderr, "kernel_launch: unexpected shapes (n_in %d in0 %d out %d ws %zu)\n", n_in, n_in > 0 ? in_sizes[0] : -1, out_size, ws_size); grid = -1; return; }
        int dev = 0, cus = 0, per_cu = 0;
        if (hipGetDevice(&dev) != hipSuccess || hipDeviceGetAttribute(&cus, hipDeviceAttributeMultiprocessorCount, dev) != hipSuccess) { grid = -1; return; }
        if (hipFuncSetAttribute((const void*)mk_fwd, hipFuncAttributeMaxDynamicSharedMemorySize, LDS_BYTES) != hipSuccess) { fprintf(stderr, "kernel_launch: hipFuncSetAttribute failed\n"); grid = -1; return; }
        if (hipOccupancyMaxActiveBlocksPerMultiprocessor(&per_cu, (const void*)mk_fwd, NWAVES * 64, LDS_BYTES) != hipSuccess || per_cu < 1) { fprintf(stderr, "kernel_launch: occupancy query says %d workgroups per CU\n", per_cu); (void)hipGetLastError(); grid = -1; return; }
        grid = cus;
    }
    if (grid < 0) return;
    (void)hipMemsetAsync((char*)d_ws + WS_CTL, 0, CTL_ZERO_BYTES, stream);
    Args a{};
    for (int i = 0; i < 21; ++i) a.in[i] = (const float*)d_in[i];
    a.out = (float*)d_out; a.ws = (unsigned char*)d_ws;
    if (N_LAUNCHES == 1) { a.ph_lo = 0; a.ph_hi = N_PHASES; hipLaunchKernelGGL(mk_fwd, dim3(grid), dim3(NWAVES * 64), LDS_BYTES, stream, a); }
    else for (int ph = 0; ph < N_PHASES; ++ph) {
#ifdef DUMPK
        if (ph > DUMPK) break;
#endif
        a.ph_lo = ph; a.ph_hi = ph + 1; hipLaunchKernelGGL(mk_fwd, dim3(grid), dim3(NWAVES * 64), LDS_BYTES, stream, a); }
#ifdef DUMPK
    { DumpArgs d{}; d.out = (unsigned*)d_out; d.own = DUMP_OWN; const size_t offs[6] = DUMP_OFFS; const size_t len[6] = DUMP_LENS;
      for (int r = 0; r < 6; ++r) if (len[r]) { d.reg[r] = (const unsigned*)((const char*)d_ws + offs[r]); d.nw[r] = (unsigned)(len[r] / 4); }
      hipLaunchKernelGGL(dump_hash, dim3(2048), dim3(256), 0, stream, d); }
#endif
}
```

```cpp
#define MK_N_LAUNCHES 1
#include <hip/hip_runtime.h>
#include <hip/hip_bf16.h>
#include <cstdio>
#include <cstdint>
namespace pg8 {
#define PG8_LAS __attribute__((address_space(3)))
typedef unsigned short bf16_t;
typedef short bf16x8 __attribute__((ext_vector_type(8)));
typedef float f32x4 __attribute__((ext_vector_type(4)));
typedef unsigned u32x4 __attribute__((ext_vector_type(4)));
constexpr int BM = 256, BK = 64, HALF = 128, HTB = HALF * BK * 2  , STAGE_BYTES = 8 * HTB, NXCD = 8, WGM = 8;

__host__ __device__ __forceinline__ int lds_byte(int r, int c) { const int st = (r >> 4) * 2 + (c >> 5), rr = r & 15, cc = c & 31, ob = rr * 64 + cc * 2; return st * 1024 + (ob ^ (((ob >> 9) & 1) << 5)); }
__host__ __device__ __forceinline__ void stage_rc(int b, int& R, int& C) { const int st = b / 1024, sb = b % 1024, swz = sb ^ (((sb >> 9) & 1) << 5); R = (st >> 1) * 16 + swz / 64; C = (st & 1) * 32 + (swz % 64) / 2; }
__host__ __device__ __forceinline__ int perm32(int rho) { const int n = rho >> 4, i = rho & 15; return 8 * (i >> 2) + 4 * n + (i & 3); }

struct Unit { int pm, pn; };
struct Gemm { const bf16_t* A; const bf16_t* Bt; int M, N, K, lda, ldb; };

struct StaticOrder {
    int nM, nN, nwg, G, c;
    __host__ __device__ void init(int M, int N, int G_, int c_) { nM = M / BM; nN = N / BM; nwg = nM * nN; G = G_; c = c_; }
    __host__ __device__ bool next(int i, Unit& u) const {
        const long L = (long)i * G + c; if (L >= nwg) return false;
        int wgid = (int)L; { const int q = nwg / NXCD, r = nwg % NXCD, xcd = wgid % NXCD, off = wgid / NXCD; wgid = (xcd < r ? xcd * (q + 1) : r * (q + 1) + (xcd - r) * q) + off; }
        const int nig = WGM * nN, gid = wgid / nig, fm = gid * WGM, gsz = (nM - fm) < WGM ? (nM - fm) : WGM;
        u.pm = fm + ((wgid % nig) % gsz); u.pn = (wgid % nig) / gsz; return true;
    }
    __device__ __forceinline__ void a_ready(const Unit&) const {}
    __device__ __forceinline__ void done(const Unit&) const {}
};


typedef float f32x2 __attribute__((ext_vector_type(2)));
typedef __bf16 bf16x2_t __attribute__((ext_vector_type(2)));
__device__ __forceinline__ unsigned cvt_pk_bf16(float lo, float hi) { f32x2 v = {lo, hi}; bf16x2_t b = __builtin_convertvector(v, bf16x2_t); return __builtin_bit_cast(unsigned, b); }
__device__ __forceinline__ float bflo(unsigned w) { return __uint_as_float(w << 16); }
__device__ __forceinline__ float bfhi(unsigned w) { return __uint_as_float(w & 0xffff0000u); }
__device__ __forceinline__ u32x4 pack8(const float (&v)[8]) { u32x4 w; w.x = cvt_pk_bf16(v[0], v[1]); w.y = cvt_pk_bf16(v[2], v[3]); w.z = cvt_pk_bf16(v[4], v[5]); w.w = cvt_pk_bf16(v[6], v[7]); return w; }
__device__ __forceinline__ void unpack8(const u32x4 w, float (&v)[8]) { v[0] = bflo(w.x); v[1] = bfhi(w.x); v[2] = bflo(w.y); v[3] = bfhi(w.y); v[4] = bflo(w.z); v[5] = bfhi(w.z); v[6] = bflo(w.w); v[7] = bfhi(w.w); }
__device__ __forceinline__ float sigmoidf_(float x) { return __builtin_amdgcn_rcpf(1.0f + __builtin_amdgcn_exp2f(-1.4426950408889634f * x)); }
constexpr float RMS_EPS_ = 1e-6f;

#define EPI_ACC8(v, ai, bj, m) float v[8]; { const f32x4 a0_ = acc[ai][bj][m][0], a1_ = acc[ai][bj][m][1]; v[0] = a0_[0]; v[1] = a0_[1]; v[2] = a0_[2]; v[3] = a0_[3]; v[4] = a1_[0]; v[5] = a1_[1]; v[6] = a1_[2]; v[7] = a1_[3]; }

__device__ __forceinline__ void xpose_store(PG8_LAS unsigned char* st, const unsigned (&pk)[4][4], bf16_t* dst, size_t cstride, int lane, int fr, int fq) {
#pragma unroll
    for (int pass = 0; pass < 2; ++pass) {
        if ((fq >> 1) == pass) {
#pragma unroll
            for (int m = 0; m < 4; ++m)
#pragma unroll
                for (int q = 0; q < 4; ++q) { const unsigned w = pk[m][q]; const int c = (fq & 1) * 8 + 2 * q;
                    *(PG8_LAS unsigned short*)(st + c * 144 + (16 * m + fr) * 2) = (unsigned short)(w & 0xffffu);
                    *(PG8_LAS unsigned short*)(st + (c + 1) * 144 + (16 * m + fr) * 2) = (unsigned short)(w >> 16); }
        }
        asm volatile("s_waitcnt lgkmcnt(0)" ::: "memory");
#pragma unroll
        for (int k = 0; k < 2; ++k) { const int idx = lane + 64 * k, c = idx >> 3, ch = idx & 7;
            const u32x4 v = *(const PG8_LAS u32x4*)(st + c * 144 + ch * 16);
            *(u32x4*)(dst + (size_t)(pass * 16 + c) * cstride + ch * 8) = v; }
        asm volatile("s_waitcnt lgkmcnt(0)" ::: "memory");
    }
}

struct EpiInProj {
    static constexpr bool PERM = true, AFTER_DRAIN = false;
    const float* rstdx; const f32x4* cs;
    bf16_t *RQ, *RK, *RKDT, *RVT, *LAT; float *ssq_lat;   PG8_LAS unsigned char* xs;
    __device__ __forceinline__ void operator()(const f32x4 (&acc)[2][2][4][2], const Unit& u, int wr, int wc, int fr, int fq) const {
        const int pn = u.pn, lane = fq * 16 + fr, wid = wr * 4 + wc;
        PG8_LAS unsigned char* st = xs + wid * 2304;
        const int rowt = u.pm * BM + wr * 64 + fr;
        const int bidx = (u.pm * BM) >> 12, s0 = (u.pm * BM) & 4095;
        if (pn < 8) {
            const bool isk = pn >= 4; const int head = pn & 3;
            const float lg2 = __builtin_amdgcn_logf(1.0f - __builtin_amdgcn_exp2f(-5.0f - (float)head));
            float kd[4];
#pragma unroll
            for (int m = 0; m < 4; ++m) kd[m] = __builtin_amdgcn_exp2f((float)(127 - (wr * 64 + m * 16 + fr)) * lg2);
            bf16_t* O = isk ? RK : RQ;
#pragma unroll
            for (int ai = 0; ai < 2; ++ai) {
                unsigned pk0[4][4], pk1[4][4];
#pragma unroll
                for (int m = 0; m < 4; ++m) {
                    const int row = rowt + ai * HALF + m * 16; const float rs = rstdx[row] * (isk ? 0.0625f : 1.0f);
                    const f32x4* cp = cs + (size_t)row * 64 + wc * 16 + fq * 4;
                    const f32x4 c0 = cp[0], c1 = cp[1], c2 = cp[2], c3 = cp[3];
                    const float cc[8] = {c0[0], c0[2], c1[0], c1[2], c2[0], c2[2], c3[0], c3[2]}, ss[8] = {c0[1], c0[3], c1[1], c1[3], c2[1], c2[3], c3[1], c3[3]};
                    EPI_ACC8(x1, ai, 0, m); EPI_ACC8(x2, ai, 1, m);
                    float o1[8], o2[8];
#pragma unroll
                    for (int e = 0; e < 8; ++e) { const float a = x1[e] * rs, b = x2[e] * rs; o1[e] = a * cc[e] - b * ss[e]; o2[e] = b * cc[e] + a * ss[e]; }
                    bf16_t* rp = O + (size_t)row * 1024 + head * 256 + wc * 32 + 8 * fq;
                    *(u32x4*)rp = pack8(o1); *(u32x4*)(rp + HALF) = pack8(o2);
                    if (isk) {
#pragma unroll
                        for (int q = 0; q < 4; ++q) { pk0[m][q] = cvt_pk_bf16(o1[2 * q] * kd[m], o1[2 * q + 1] * kd[m]); pk1[m][q] = cvt_pk_bf16(o2[2 * q] * kd[m], o2[2 * q + 1] * kd[m]); }
                    }
                }
                if (isk) {
                    bf16_t* d0 = RKDT + ((size_t)(bidx * 4 + head) * 256 + wc * 32) * 4096 + s0 + ai * HALF + wr * 64;
                    xpose_store(st, pk0, d0, 4096, lane, fr, fq);
                    xpose_store(st, pk1, d0 + (size_t)HALF * 4096, 4096, lane, fr, fq);
                }
            }
        } else if (pn < 16) {
            const int head = (pn - 8) >> 1, dvb = ((pn - 8) & 1) * 256;
#pragma unroll
            for (int ai = 0; ai < 2; ++ai)
#pragma unroll
                for (int bj = 0; bj < 2; ++bj) {
                    unsigned pk[4][4];
#pragma unroll
                    for (int m = 0; m < 4; ++m) { const float rs = rstdx[rowt + ai * HALF + m * 16]; EPI_ACC8(v, ai, bj, m);
#pragma unroll
                        for (int q = 0; q < 4; ++q) pk[m][q] = cvt_pk_bf16(v[2 * q] * rs, v[2 * q + 1] * rs); }
                    bf16_t* d0 = RVT + ((size_t)(bidx * 4 + head) * 512 + dvb + bj * HALF + wc * 32) * 4096 + s0 + ai * HALF + wr * 64;
                    xpose_store(st, pk, d0, 4096, lane, fr, fq);
                }
        } else {
            const int lt = pn - 16;
#pragma unroll
            for (int ai = 0; ai < 2; ++ai)
#pragma unroll
                for (int m = 0; m < 4; ++m) { const int row = rowt + ai * HALF + m * 16; const float rs = rstdx[row];
#pragma unroll
                    for (int bj = 0; bj < 2; ++bj) { EPI_ACC8(v, ai, bj, m); float q = 0.f;
#pragma unroll
                        for (int e = 0; e < 8; ++e) { v[e] *= rs; q += v[e] * v[e]; }
                        *(u32x4*)(LAT + (size_t)row * 768 + lt * 256 + bj * HALF + wc * 32 + 8 * fq) = pack8(v);
                        const int kind = (lt == 0) ? 0 : (lt == 1 ? (bj == 0 ? 0 : 1) : (bj == 0 ? 1 : 2));
                        if (kind < 2) { q += __shfl_xor(q, 16); q += __shfl_xor(q, 32); if (fq == 0) atomicAdd(ssq_lat + kind * 16384 + row, q); } } }
        }
    }
};

template <int MODE> struct EpiRowAct {
    static constexpr bool PERM = true, AFTER_DRAIN = false;
    bf16_t* O; int ldo; const float* rsrc; float inv_dim;
    __device__ __forceinline__ void operator()(const f32x4 (&acc)[2][2][4][2], const Unit& u, int wr, int wc, int fr, int fq) const {
        const int rowt = u.pm * BM + wr * 64 + fr, colt = u.pn * BM + wc * 32 + 8 * fq;
#pragma unroll
        for (int ai = 0; ai < 2; ++ai)
#pragma unroll
            for (int m = 0; m < 4; ++m) { const int row = rowt + ai * HALF + m * 16; const float r0 = rsrc[row]; const float rs = inv_dim == 0.f ? r0 : __builtin_amdgcn_rsqf(r0 * inv_dim + RMS_EPS_);
#pragma unroll
                for (int bj = 0; bj < 2; ++bj) { EPI_ACC8(v, ai, bj, m);
#pragma unroll
                    for (int e = 0; e < 8; ++e) { float x = v[e] * rs; if (MODE == 1) x = sigmoidf_(x); if (MODE == 2) { x = fmaxf(x, 0.f); x = x * x; } v[e] = x; }
                    *(u32x4*)(O + (size_t)row * ldo + colt + bj * HALF) = pack8(v); } }
    }
};
struct EpiRetGate {
    static constexpr bool PERM = true, AFTER_DRAIN = false;
    bf16_t* RO; const float* rstdx; const float* ssq_ro; const float* ret_norm;
    __device__ __forceinline__ void operator()(const f32x4 (&acc)[2][2][4][2], const Unit& u, int wr, int wc, int fr, int fq) const {
        const int rowt = u.pm * BM + wr * 64 + fr, colt = u.pn * BM + wc * 32 + 8 * fq, head = u.pn >> 1;
        f32x4 g[2][2];
#pragma unroll
        for (int bj = 0; bj < 2; ++bj) { g[bj][0] = *(const f32x4*)(ret_norm + colt + bj * HALF); g[bj][1] = *(const f32x4*)(ret_norm + colt + bj * HALF + 4); }
#pragma unroll
        for (int ai = 0; ai < 2; ++ai)
#pragma unroll
            for (int m = 0; m < 4; ++m) { const int row = rowt + ai * HALF + m * 16; const float rs = rstdx[row], rr = __builtin_amdgcn_rsqf(ssq_ro[row * 4 + head] * (1.0f / 512.0f) + RMS_EPS_);
#pragma unroll
                for (int bj = 0; bj < 2; ++bj) { EPI_ACC8(v, ai, bj, m); bf16_t* p = RO + (size_t)row * 2048 + colt + bj * HALF; float o[8]; unpack8(*(const u32x4*)p, o);
#pragma unroll
                    for (int e = 0; e < 8; ++e) { const float x = v[e] * rs; const float gg = e < 4 ? g[bj][0][e & 3] : g[bj][1][e & 3]; v[e] = o[e] * rr * gg * x * sigmoidf_(x); }
                    *(u32x4*)p = pack8(v); } }
    }
};
template <int MODE> struct EpiGateMix {
    static constexpr bool PERM = true, AFTER_DRAIN = false;
    bf16_t* TM; const bf16_t* SG; int sgoff;
    __device__ __forceinline__ void operator()(const f32x4 (&acc)[2][2][4][2], const Unit& u, int wr, int wc, int fr, int fq) const {
        const int rowt = u.pm * BM + wr * 64 + fr, colt = u.pn * BM + wc * 32 + 8 * fq;
#pragma unroll
        for (int ai = 0; ai < 2; ++ai)
#pragma unroll
            for (int m = 0; m < 4; ++m) { const int row = rowt + ai * HALF + m * 16;
#pragma unroll
                for (int bj = 0; bj < 2; ++bj) { EPI_ACC8(v, ai, bj, m); float s[8]; unpack8(*(const u32x4*)(SG + (size_t)row * 2048 + sgoff + colt + bj * HALF), s);
                    bf16_t* p = TM + (size_t)row * 1024 + colt + bj * HALF;
                    if (MODE == 1) { float t[8]; unpack8(*(const u32x4*)p, t);
#pragma unroll
                        for (int e = 0; e < 8; ++e) v[e] = t[e] + s[e] * v[e]; }
                    else {
#pragma unroll
                        for (int e = 0; e < 8; ++e) v[e] = s[e] * v[e]; }
                    *(u32x4*)p = pack8(v); } }
    }
};
struct EpiResid {
    static constexpr bool PERM = true, AFTER_DRAIN = false;
    const float* res; float* out; bf16_t* xb; float* ssq;
    __device__ __forceinline__ void operator()(const f32x4 (&acc)[2][2][4][2], const Unit& u, int wr, int wc, int fr, int fq) const {
        const int rowt = u.pm * BM + wr * 64 + fr, colt = u.pn * BM + wc * 32 + 8 * fq;
#pragma unroll
        for (int ai = 0; ai < 2; ++ai)
#pragma unroll
            for (int m = 0; m < 4; ++m) { const int row = rowt + ai * HALF + m * 16; float q = 0.f;
#pragma unroll
                for (int bj = 0; bj < 2; ++bj) { EPI_ACC8(v, ai, bj, m); const size_t off = (size_t)row * 1024 + colt + bj * HALF;
                    const f32x4 r0 = *(const f32x4*)(res + off), r1 = *(const f32x4*)(res + off + 4);
#pragma unroll
                    for (int e = 0; e < 8; ++e) { v[e] += e < 4 ? r0[e & 3] : r1[e & 3]; q += v[e] * v[e]; }
                    *(f32x4*)(out + off) = (f32x4){v[0], v[1], v[2], v[3]}; *(f32x4*)(out + off + 4) = (f32x4){v[4], v[5], v[6], v[7]};
                    *(u32x4*)(xb + off) = pack8(v); }
                q += __shfl_xor(q, 16); q += __shfl_xor(q, 32); if (fq == 0) atomicAdd(ssq + row, q);
                if (m & 1) asm volatile("" ::: "memory"); }
    }
};
struct EpiFinal {
    static constexpr bool PERM = true, AFTER_DRAIN = false;
    float* out; const bf16_t* GT;
    __device__ __forceinline__ void operator()(const f32x4 (&acc)[2][2][4][2], const Unit& u, int wr, int wc, int fr, int fq) const {
        const int rowt = u.pm * BM + wr * 64 + fr, colt = u.pn * BM + wc * 32 + 8 * fq;
#pragma unroll
        for (int ai = 0; ai < 2; ++ai)
#pragma unroll
            for (int m = 0; m < 4; ++m) { const int row = rowt + ai * HALF + m * 16;
#pragma unroll
                for (int bj = 0; bj < 2; ++bj) { EPI_ACC8(v, ai, bj, m); const size_t off = (size_t)row * 1024 + colt + bj * HALF; float gt[8]; unpack8(*(const u32x4*)(GT + off), gt);
                    const f32x4 r0 = *(const f32x4*)(out + off), r1 = *(const f32x4*)(out + off + 4);
#pragma unroll
                    for (int e = 0; e < 8; ++e) v[e] = (e < 4 ? r0[e & 3] : r1[e & 3]) + gt[e] * v[e];
                    *(f32x4*)(out + off) = (f32x4){v[0], v[1], v[2], v[3]}; *(f32x4*)(out + off + 4) = (f32x4){v[4], v[5], v[6], v[7]}; }
                if (m & 1) asm volatile("" ::: "memory"); }
    }
};
template <class Epi, class Sched, bool ALIGN_EPI = false, bool SP2 = false>
__device__ __forceinline__ void gemm_phase(PG8_LAS unsigned char* lds, const Gemm g, const Sched& S, const Epi& E) {
    const int tid = threadIdx.x, wid = __builtin_amdgcn_readfirstlane(tid >> 6), lane = tid & 63, wr = wid >> 2, wc = wid & 3, fr = lane & 15, fq = lane >> 4;
    const int K = g.K, nt = K / BK;
    unsigned voffA[2], voffB[2];
#pragma unroll
    for (int i = 0; i < 2; ++i) { int R, C; stage_rc(tid * 16 + i * 8192, R, C); const int Rb = Epi::PERM ? ((R & ~31) + perm32(R & 31)) : R;
        voffA[i] = (unsigned)(R * g.lda + C) * 2u; voffB[i] = (unsigned)(Rb * g.ldb + C) * 2u; }
    const size_t kstep = (size_t)(BK * 2);
    const size_t hstepA = (size_t)HALF * g.lda * 2, hstepB = (size_t)HALF * g.ldb * 2;
    const size_t tstepA = 2 * hstepA, tstepB = 2 * hstepB;
    const unsigned ldsw = (unsigned)wid * 1024u;
    const int aoff = lds_byte(wr * 64 + fr, fq * 8), boff = lds_byte(wc * 32 + fr, fq * 8);
#define PG8_SA(b, h) (((b) * 2 + (h)) * HTB)
#define PG8_SB(b, h) ((4 + (b) * 2 + (h)) * HTB)
#define PG8_STAGE(bufoff, gbase, voff) do { _Pragma("unroll") for (int _i = 0; _i < 2; ++_i) \
        __builtin_amdgcn_global_load_lds((const unsigned*)((const char*)(gbase) + (voff)[_i]), (PG8_LAS unsigned*)(lds + (bufoff) + ldsw + _i * 8192), 16, 0, 0); } while (0)
#define PG8_LDA(dst, b, h) do { _Pragma("unroll") for (int m = 0; m < 4; ++m) _Pragma("unroll") for (int k = 0; k < 2; ++k) dst[m][k] = *(const PG8_LAS bf16x8*)(lds + PG8_SA(b, h) + aoff + m * 2048 + k * 1024); } while (0)
#define PG8_LDB(dst, b, h) do { _Pragma("unroll") for (int n = 0; n < 2; ++n) _Pragma("unroll") for (int k = 0; k < 2; ++k) dst[n][k] = *(const PG8_LAS bf16x8*)(lds + PG8_SB(b, h) + boff + n * 2048 + k * 1024); } while (0)
#define PG8_MMA(ai, bj, At, Bt) do { __builtin_amdgcn_s_setprio(1); _Pragma("unroll") for (int m = 0; m < 4; ++m) _Pragma("unroll") for (int n = 0; n < 2; ++n) _Pragma("unroll") for (int k = 0; k < 2; ++k) \
        acc[ai][bj][m][n] = __builtin_amdgcn_mfma_f32_16x16x32_bf16(Bt[n][k], At[m][k], acc[ai][bj][m][n], 0, 0, 0); __builtin_amdgcn_s_setprio(0); } while (0)
#define PG8_WAIT_V(n) asm volatile("s_waitcnt vmcnt(" #n ")" ::: "memory")
#define PG8_WAIT_L(n) asm volatile("s_waitcnt lgkmcnt(" #n ")" ::: "memory")
#define PG8_BAR __builtin_amdgcn_s_barrier()
#define PG8_SCHED __builtin_amdgcn_sched_barrier(0)
    Unit cur, nxt; int ui = 0;
    if (!S.next(0, cur)) return;
    f32x4 acc[2][2][4][2];
#pragma unroll
    for (int a = 0; a < 2; ++a)
#pragma unroll
        for (int b = 0; b < 2; ++b)
#pragma unroll
            for (int m = 0; m < 4; ++m)
#pragma unroll
                for (int n = 0; n < 2; ++n) acc[a][b][m][n] = (f32x4){0.f, 0.f, 0.f, 0.f};
    bf16x8 At[4][2], B0[2][2], B1[2][2];
    const char* cA = (const char*)g.A + (size_t)cur.pm * tstepA; const char* cB = (const char*)g.Bt + (size_t)cur.pn * tstepB;
    S.a_ready(cur);
    if constexpr (SP2) {
        PG8_STAGE(PG8_SB(0, 0), cB, voffB); PG8_STAGE(PG8_SB(0, 1), cB + hstepB, voffB); PG8_STAGE(PG8_SA(0, 0), cA, voffA); PG8_STAGE(PG8_SA(0, 1), cA + hstepA, voffA);
        if (wr == 1) PG8_BAR;
        PG8_WAIT_V(2); PG8_BAR;
        PG8_STAGE(PG8_SB(1, 0), cB + kstep, voffB); PG8_STAGE(PG8_SA(1, 0), cA + kstep, voffA); PG8_STAGE(PG8_SB(1, 1), cB + hstepB + kstep, voffB);
        PG8_WAIT_V(6); PG8_BAR;
    } else {
        PG8_STAGE(PG8_SB(0, 0), cB, voffB); PG8_STAGE(PG8_SA(0, 0), cA, voffA); PG8_STAGE(PG8_SB(0, 1), cB + hstepB, voffB); PG8_STAGE(PG8_SA(0, 1), cA + hstepA, voffA);
        if (wr == 1) PG8_BAR;
        PG8_WAIT_V(4); PG8_BAR;
        PG8_STAGE(PG8_SB(1, 0), cB + kstep, voffB); PG8_STAGE(PG8_SA(1, 0), cA + kstep, voffA); PG8_STAGE(PG8_SB(1, 1), cB + hstepB + kstep, voffB);
        PG8_WAIT_V(6); PG8_BAR;
    }
    for (;;) {
        const bool has_next = S.next(ui + 1, nxt);
        const char* nA = has_next ? (const char*)g.A + (size_t)nxt.pm * tstepA : cA; const char* nB = has_next ? (const char*)g.Bt + (size_t)nxt.pn * tstepB : cB;
        for (int t = 0; t < nt; t += 2) {
            const bool last = (t == nt - 2);
            const char* a1 = cA + (size_t)(t + 1) * kstep;
            const char* a2 = last ? nA : cA + (size_t)(t + 2) * kstep; const char* b2 = last ? nB : cB + (size_t)(t + 2) * kstep;
            const char* a3 = a2 + kstep; const char* b3 = b2 + kstep;
            if (last && has_next) S.a_ready(nxt);
            if constexpr (SP2) {
            PG8_LDB(B0, 0, 0); PG8_LDB(B1, 0, 1); PG8_SCHED; PG8_LDA(At, 0, 0); PG8_STAGE(PG8_SA(1, 1), a1 + hstepA, voffA);
            PG8_WAIT_V(8); PG8_WAIT_L(0); PG8_BAR; PG8_MMA(0, 0, At, B0); PG8_MMA(0, 1, At, B1); PG8_BAR; PG8_SCHED;
            PG8_LDA(At, 0, 1); PG8_STAGE(PG8_SB(0, 0), b2, voffB); PG8_STAGE(PG8_SB(0, 1), b2 + hstepB, voffB); PG8_STAGE(PG8_SA(0, 0), a2, voffA);
            PG8_WAIT_V(8); PG8_WAIT_L(0); PG8_BAR; PG8_MMA(1, 0, At, B0); PG8_MMA(1, 1, At, B1); PG8_BAR; PG8_SCHED;
            PG8_LDB(B0, 1, 0); PG8_LDB(B1, 1, 1); PG8_SCHED; PG8_LDA(At, 1, 0); PG8_STAGE(PG8_SA(0, 1), a2 + hstepA, voffA);
            PG8_WAIT_V(8); PG8_WAIT_L(0); PG8_BAR; PG8_MMA(0, 0, At, B0); PG8_MMA(0, 1, At, B1); PG8_BAR; PG8_SCHED;
            PG8_LDA(At, 1, 1); PG8_STAGE(PG8_SB(1, 0), b3, voffB); PG8_STAGE(PG8_SB(1, 1), b3 + hstepB, voffB); PG8_STAGE(PG8_SA(1, 0), a3, voffA);
            PG8_WAIT_V(8); PG8_WAIT_L(0); PG8_BAR; PG8_MMA(1, 0, At, B0); PG8_MMA(1, 1, At, B1); PG8_BAR; PG8_SCHED;
            } else {
            PG8_LDB(B0, 0, 0); PG8_SCHED; PG8_LDA(At, 0, 0); PG8_STAGE(PG8_SA(1, 1), a1 + hstepA, voffA);
            PG8_WAIT_L(8); PG8_BAR; PG8_WAIT_L(0); PG8_MMA(0, 0, At, B0); PG8_BAR; PG8_SCHED;
            PG8_LDB(B1, 0, 1); PG8_STAGE(PG8_SB(0, 0), b2, voffB);
            PG8_BAR; PG8_WAIT_L(0); PG8_MMA(0, 1, At, B1); PG8_BAR;
            PG8_LDA(At, 0, 1); PG8_STAGE(PG8_SA(0, 0), a2, voffA);
            PG8_BAR; PG8_WAIT_L(0); PG8_MMA(1, 0, At, B0); PG8_BAR; PG8_SCHED;
            PG8_STAGE(PG8_SB(0, 1), b2 + hstepB, voffB);
            PG8_WAIT_V(6); PG8_BAR; PG8_MMA(1, 1, At, B1); PG8_BAR;
            PG8_LDB(B0, 1, 0); PG8_SCHED; PG8_LDA(At, 1, 0); PG8_STAGE(PG8_SA(0, 1), a2 + hstepA, voffA);
            PG8_WAIT_L(8); PG8_BAR; PG8_WAIT_L(0); PG8_MMA(0, 0, At, B0); PG8_BAR; PG8_SCHED;
            PG8_LDB(B1, 1, 1); PG8_STAGE(PG8_SB(1, 0), b3, voffB);
            PG8_BAR; PG8_WAIT_L(0); PG8_MMA(0, 1, At, B1); PG8_BAR;
            PG8_LDA(At, 1, 1); PG8_STAGE(PG8_SA(1, 0), a3, voffA);
            PG8_BAR; PG8_WAIT_L(0); PG8_MMA(1, 0, At, B0); PG8_BAR; PG8_SCHED;
            PG8_STAGE(PG8_SB(1, 1), b3 + hstepB, voffB);
            PG8_WAIT_V(6); PG8_BAR; PG8_MMA(1, 1, At, B1); PG8_BAR;
            }
        }
        if constexpr (ALIGN_EPI) { if (wr == 0) PG8_BAR; }
        if constexpr (!Epi::AFTER_DRAIN) { E(acc, cur, wr, wc, fr, fq); S.done(cur); }
        if (!has_next) break;
#pragma unroll
        for (int a = 0; a < 2; ++a)
#pragma unroll
            for (int b = 0; b < 2; ++b)
#pragma unroll
                for (int m = 0; m < 4; ++m)
#pragma unroll
                    for (int n = 0; n < 2; ++n) acc[a][b][m][n] = (f32x4){0.f, 0.f, 0.f, 0.f};
        cur = nxt; cA = nA; cB = nB; ++ui;
        if constexpr (ALIGN_EPI) { if (wr == 1) PG8_BAR; }
    }
    PG8_WAIT_V(0);
    if constexpr (!ALIGN_EPI) { if (wr == 0) PG8_BAR; }
    PG8_BAR;
    if constexpr (Epi::AFTER_DRAIN) { E.fused(acc, cur, wr, wc, fr, fq, lds, wid, lane); S.done(cur); }
#undef PG8_SA
#undef PG8_SB
#undef PG8_STAGE
#undef PG8_LDA
#undef PG8_LDB
#undef PG8_MMA
#undef PG8_WAIT_V
#undef PG8_WAIT_L
#undef PG8_BAR
#undef PG8_SCHED
}
}
#define GAS __attribute__((address_space(1)))
#define LAS __attribute__((address_space(3)))
typedef unsigned short bf16;
typedef unsigned v4u __attribute__((ext_vector_type(4)));
typedef float f32x4 __attribute__((ext_vector_type(4)));
typedef short bf16x8 __attribute__((ext_vector_type(8)));
typedef GAS unsigned gu32;
typedef GAS unsigned long long gu64;
#define RLX_AGENT __ATOMIC_RELAXED, __HIP_MEMORY_SCOPE_AGENT
#define LDS_WAIT() asm volatile("s_waitcnt lgkmcnt(0)" ::: "memory")
#define VM_WAIT() asm volatile("s_waitcnt vmcnt(0)" ::: "memory")
__device__ __forceinline__ unsigned long long rt() { return __builtin_amdgcn_s_memrealtime(); }
__device__ __forceinline__ unsigned f2bf(float f) { unsigned u = __builtin_bit_cast(unsigned, f); return (u + 0x7fffu + ((u >> 16) & 1u)) >> 16; }
__device__ __forceinline__ unsigned pk2(float lo, float hi) { return f2bf(lo) | (f2bf(hi) << 16); }

#define XB_TMO      128
#define XB_XCNT(j)  (256  + 64 * (j))
#define XB_XSUB(j)  (1280 + 64 * (j))
#define XB_XGEN(j)  (2304 + 64 * (j))
#define XB_TOP      3328
#define XB_TOPGEN   3392
#define XCD_BAR_WORDS 3456
#define XB_SPIN_CAP (1u << 18)

__device__ __forceinline__ unsigned xb_ld(unsigned* p)              { return __hip_atomic_load(p, __ATOMIC_RELAXED, __HIP_MEMORY_SCOPE_AGENT); }
__device__ __forceinline__ unsigned xb_add(unsigned* p, unsigned v) { return __hip_atomic_fetch_add(p, v, __ATOMIC_RELAXED, __HIP_MEMORY_SCOPE_AGENT); }
__device__ __forceinline__ unsigned xb_xcc_id() { return (unsigned)__builtin_amdgcn_s_getreg((3 << 11) | 20) & 0xFu; }
#define XB_SPIN(cond, bar) do { unsigned _sp = 0; while (cond) { __builtin_amdgcn_s_sleep(1); \
    if ((++_sp & 255u) == 0u) { if (xb_ld(&(bar)[XB_TMO])) break; if (_sp > XB_SPIN_CAP) { atomicAdd(&(bar)[XB_TMO], 1u); break; } } } } while (0)

struct XcdBarrier {
    unsigned* bar; unsigned x;
    volatile LAS unsigned* st;
};

__device__ __forceinline__ XcdBarrier xcd_barrier_post(unsigned* bar, volatile LAS unsigned* st) {
    XcdBarrier b; b.bar = bar; b.x = xb_xcc_id(); b.st = st;
    if (threadIdx.x == 0) (void)xb_add(&bar[XB_XCNT(b.x)], 1u);
    return b;
}
__device__ __forceinline__ void xcd_barrier_complete(unsigned* bar, unsigned x, unsigned& nloc, unsigned& nx) {
    const unsigned G = gridDim.x * gridDim.y * gridDim.z;
    unsigned sum, cnt, mine, sp = 0u;
    for (;;) {
        sum = 0u; cnt = 0u; mine = 0u;
#pragma unroll
        for (unsigned j = 0; j < 16; ++j) { const unsigned c = xb_ld(&bar[XB_XCNT(j)]); sum += c; cnt += (c > 0u) ? 1u : 0u; mine = (j == x) ? c : mine; }
        if (sum == G) break;
        __builtin_amdgcn_s_sleep(1);
        if ((++sp & 255u) == 0u) { if (xb_ld(&bar[XB_TMO])) break; if (sp > XB_SPIN_CAP) { atomicAdd(&bar[XB_TMO], 1u); break; } }
    }
    nloc = mine > 0u ? mine : 1u; nx = cnt > 0u ? cnt : 1u;
}

__device__ __forceinline__ void xcd_barrier(const XcdBarrier& b) {
    asm volatile("s_waitcnt vmcnt(0)" ::: "memory");
    __syncthreads();
    if (threadIdx.x == 0) {
        unsigned* bar = b.bar;
        __builtin_amdgcn_s_waitcnt(0);
        unsigned nloc = b.st[0], nx = b.st[1];
        if (nloc == 0u) { xcd_barrier_complete(bar, b.x, nloc, nx); b.st[0] = nloc; b.st[1] = nx; }
        const unsigned old = xb_add(&bar[XB_XSUB(b.x)], 1u);
        const unsigned gen = old / nloc;
        if (old + 1u == (gen + 1u) * nloc) {
            __builtin_amdgcn_fence(__ATOMIC_RELEASE, "agent");
            asm volatile("s_waitcnt vmcnt(0)" ::: "memory");
            const unsigned og = xb_add(&bar[XB_TOP], 1u);
            const unsigned tg = og / nx;
            if (og + 1u == (tg + 1u) * nx) xb_add(&bar[XB_TOPGEN], 1u);
            else XB_SPIN(xb_ld(&bar[XB_TOPGEN]) == tg, bar);
            __builtin_amdgcn_fence(__ATOMIC_ACQUIRE, "agent");
            xb_add(&bar[XB_XGEN(b.x)], 1u);
            asm volatile("s_waitcnt vmcnt(0)" ::: "memory");
        } else {
            XB_SPIN(xb_ld(&bar[XB_XGEN(b.x)]) == gen, bar);
            __builtin_amdgcn_fence(__ATOMIC_ACQUIRE, "agent");
            asm volatile("s_waitcnt vmcnt(0)" ::: "memory");
        }
    }
    __syncthreads();
}


typedef float f32x2 __attribute__((ext_vector_type(2)));
constexpr int NWAVES = 8;
constexpr int BATCH = 4, SEQ = 4096, DM = 1024, MTOK = BATCH * SEQ;
constexpr int NIN1 = 4864;
constexpr int LATW = 768;
constexpr float C2Q = 0.07216878364870323f * 1.4426950408889634f;

constexpr size_t MiB = 1u << 20, KiB = 1u << 10;
constexpr size_t WS_CTL = 0, CTL_ZERO_BYTES = 64 * KiB;
constexpr size_t WS_SMALL = 1 * MiB;
constexpr size_t SM_RSTDX = 0, SM_SSQ_CQ = 64 * KiB, SM_SSQ_CKV = 128 * KiB, SM_SSQ1 = 192 * KiB, SM_SSQ2 = 256 * KiB, SM_SSQ_RO = 320 * KiB, SM_END = 576 * KiB;
constexpr size_t WS_WIN = 2 * MiB;
constexpr size_t WS_WUQ = WS_WIN + (size_t)8960 * 1024 * 2;
constexpr size_t WS_WUKV = WS_WUQ + (size_t)1536 * 384 * 2;
constexpr size_t WS_XB = 22 * MiB;
constexpr size_t WS_CS = 54 * MiB;
constexpr size_t WS_LAT = 70 * MiB;
constexpr size_t WS_RQ = 94 * MiB, WS_RK = 126 * MiB, WS_RKDT = 158 * MiB, WS_RVT = 190 * MiB;
constexpr size_t WS_QP = 94 * MiB, WS_KVP = 142 * MiB, WS_KF = 206 * MiB;
constexpr size_t WS_MO = 54 * MiB;
constexpr size_t WS_SG = 94 * MiB, WS_TM = 158 * MiB;
constexpr size_t WS_WBR = 190 * MiB, WS_WBM = 194 * MiB, WS_WO = 196 * MiB, WS_WUP = 198 * MiB, WS_WDOWN = 206 * MiB, WS_WPG = 214 * MiB, WS_WPLE = 216 * MiB;
constexpr size_t WS_PB = 217 * MiB;
constexpr size_t WS_H = 54 * MiB;
constexpr size_t WS_GT = 54 * MiB;
constexpr size_t WS_END = 256 * MiB;
static_assert(SM_SSQ_CKV == SM_SSQ_CQ + 65536, "ssq_lat layout");
static_assert(WS_WUKV + (size_t)2048 * 256 * 2 <= WS_XB && WS_RVT + 64 * MiB <= WS_END && WS_KF + 48 * MiB <= WS_END && WS_H + 128 * MiB <= WS_WBR && WS_PB + 8 * MiB <= WS_END, "d_ws map");
constexpr int CW_BAR = 1024;

constexpr int RING_OFF = 0, RING_BYTES = 131072;
constexpr int XS_OFF = RING_BYTES, XS_BYTES = 8 * 2304;
constexpr int MISC_OFF = XS_OFF + XS_BYTES;
constexpr int LDS_BYTES = 160 * 1024;
static_assert(MISC_OFF + 128 <= LDS_BYTES, "LDS map");

struct Frame {
    LAS unsigned char* lds; volatile LAS unsigned* MISC; int tid, lane, wave, G, vcu;
    float* out; unsigned char* ws;
};
__device__ __forceinline__ float wave_sum(float v) {
#pragma unroll
    for (int o = 1; o < 64; o <<= 1) v += __shfl_xor(v, o);
    return v;
}
__device__ __forceinline__ void p0_transpose_item(const float* W, int ldw, int K, int src_col, bf16* WT, int dst_row, int ncols, const float* gain, LAS float* scr, int item, int lane) {
    const int nblk = ncols / 32, kb = item / nblk, nb = item % nblk, k0 = 64 * kb, n0 = 32 * nb;
#pragma unroll 8
    for (int i = 0; i < 32; ++i) { const int kk = 2 * i + (lane >> 5); const float gk = gain ? gain[k0 + kk] : 1.0f; scr[kk * 33 + (lane & 31)] = W[(size_t)(k0 + kk) * ldw + src_col + n0 + (lane & 31)] * gk; }
    LDS_WAIT(); asm volatile("" ::: "memory");
    const int c = lane & 7;
#pragma unroll
    for (int j = 0; j < 4; ++j) { const int n = (lane >> 3) + 8 * j; const LAS float* s = scr + (8 * c) * 33 + n;
        v4u o; o.x = pk2(s[0 * 33], s[1 * 33]); o.y = pk2(s[2 * 33], s[3 * 33]); o.z = pk2(s[4 * 33], s[5 * 33]); o.w = pk2(s[6 * 33], s[7 * 33]);
        *(GAS v4u*)(WT + (size_t)(dst_row + n0 + n) * K + k0 + 8 * c) = o; }
    LDS_WAIT(); asm volatile("" ::: "memory");
}
#define P0_SEG(W, ldw, K, src, WT, dst, ncols, gain) { const int n_ = ((K) / 64) * ((ncols) / 32); if (r < n_) { p0_transpose_item(W, ldw, K, src, WT, dst, ncols, gain, scr, r, F.lane); continue; } r -= n_; }
__device__ __forceinline__ void phase_p0(Frame& F, const float* x, const int* pos, const float* g_mix, const float* w_in, const float* g_qlat, const float* g_kvlat, const float* w_uq, const float* w_ukv) {
    LAS float* scr = (LAS float*)(F.lds + RING_OFF + F.wave * 16384);
    const int gw = F.vcu * NWAVES + F.wave, NGW = F.G * NWAVES;
    bf16* WinT = (bf16*)(F.ws + WS_WIN); bf16* WuqT = (bf16*)(F.ws + WS_WUQ); bf16* WukvT = (bf16*)(F.ws + WS_WUKV);
    constexpr int NIT = 16 * (2048 / 32) * 2 + 16 * (4096 / 32) + 16 * (704 / 32) + 6 * (1536 / 32) + 4 * (2048 / 32);
    for (int it = gw; it < NIT; it += NGW) {
        int r = it;
        P0_SEG(w_in, 8896, 1024, 6848, WinT, 0, 2048, g_mix)
        P0_SEG(w_in, 8896, 1024, 4096, WinT, 2048, 2048, g_mix)
        P0_SEG(w_in, 8896, 1024, 0, WinT, 4096, 4096, g_mix)
        P0_SEG(w_in, 8896, 1024, 6144, WinT, 8192, 704, g_mix)
        P0_SEG(w_uq, 1536, 384, 0, WuqT, 0, 1536, g_qlat)
        P0_SEG(w_ukv, 2048, 256, 0, WukvT, 0, 2048, g_kvlat)
    }
    { const int gt = F.vcu * 512 + F.tid; if (gt < 8192) *(GAS v4u*)((unsigned char*)(WinT + (size_t)8896 * 1024) + (size_t)gt * 16) = (v4u){0u, 0u, 0u, 0u}; }
    { bf16* XB = (bf16*)(F.ws + WS_XB); float* rstdx = (float*)(F.ws + WS_SMALL + SM_RSTDX);
      for (int m = gw; m < MTOK; m += NGW) {
          const GAS f32x4* xr = (const GAS f32x4*)(x + (size_t)m * DM) + F.lane; f32x4 v[4]; float s = 0.f;
#pragma unroll
          for (int j = 0; j < 4; ++j) { v[j] = xr[64 * j]; s += (v[j].x * v[j].x + v[j].y * v[j].y) + (v[j].z * v[j].z + v[j].w * v[j].w); }
          s = wave_sum(s);
          GAS unsigned long long* o8 = (GAS unsigned long long*)(XB + (size_t)m * DM) + F.lane;
#pragma unroll
          for (int j = 0; j < 4; ++j) o8[64 * j] = (unsigned long long)pk2(v[j].x, v[j].y) | ((unsigned long long)pk2(v[j].z, v[j].w) << 32);
          if (F.lane == 0) rstdx[m] = 1.0f / sqrtf(s * (1.0f / DM) + 1e-6f);
      } }
    { f32x2* cs = (f32x2*)(F.ws + WS_CS);
      for (int e = F.vcu * 512 + F.tid; e < MTOK * 128; e += F.G * 512) { const int row = e >> 7, i = e & 127;
          const float inv = __builtin_amdgcn_exp2f(-(float)i * (13.287712379549449f / 128.0f));
          double rev = (double)pos[row] * (double)inv * 0.15915494309189535; rev -= __builtin_rint(rev);
          const float rf = (float)rev; cs[e] = (f32x2){__builtin_amdgcn_cosf(rf), __builtin_amdgcn_sinf(rf)}; } }
    { float* z = (float*)(F.ws + WS_SMALL + SM_SSQ_CQ); for (int e = F.vcu * 512 + F.tid; e < (int)((SM_END - SM_SSQ_CQ) / 4); e += F.G * 512) z[e] = 0.f; }
}
__device__ __forceinline__ void phase_late_weights(Frame& F, const float* p, const float* w_br, const float* w_bm, const float* w_o, const float* g_mlp, const float* w_up, const float* w_down, const float* g_ple, const float* w_pg, const float* w_ple) {
    LAS float* scr = (LAS float*)(F.lds + RING_OFF + F.wave * 16384);
    const int gw = F.vcu * NWAVES + F.wave, NGW = F.G * NWAVES;
    constexpr int NIT = 32 * 32 + 16 * 32 + 16 * 32 + 16 * 128 + 64 * 32 + 16 * 32 + 4 * 32;
    for (int it = gw; it < NIT; it += NGW) {
        int r = it;
        P0_SEG(w_br, 1024, 2048, 0, (bf16*)(F.ws + WS_WBR), 0, 1024, (const float*)nullptr)
        P0_SEG(w_bm, 1024, 1024, 0, (bf16*)(F.ws + WS_WBM), 0, 1024, (const float*)nullptr)
        P0_SEG(w_o, 1024, 1024, 0, (bf16*)(F.ws + WS_WO), 0, 1024, (const float*)nullptr)
        P0_SEG(w_up, 4096, 1024, 0, (bf16*)(F.ws + WS_WUP), 0, 4096, g_mlp)
        P0_SEG(w_down, 1024, 4096, 0, (bf16*)(F.ws + WS_WDOWN), 0, 1024, (const float*)nullptr)
        P0_SEG(w_pg, 1024, 1024, 0, (bf16*)(F.ws + WS_WPG), 0, 1024, g_ple)
        P0_SEG(w_ple, 1024, 256, 0, (bf16*)(F.ws + WS_WPLE), 0, 1024, (const float*)nullptr)
    }
    { bf16* PB = (bf16*)(F.ws + WS_PB);
      for (int e = F.vcu * 512 + F.tid; e < MTOK * 256 / 8; e += F.G * 512) { const f32x4 a = *(const GAS f32x4*)(p + (size_t)e * 8), b = *(const GAS f32x4*)(p + (size_t)e * 8 + 4);
          *(GAS v4u*)(PB + (size_t)e * 8) = (v4u){pk2(a.x, a.y), pk2(a.z, a.w), pk2(b.x, b.y), pk2(b.z, b.w)}; } }
}

typedef float f32x16 __attribute__((ext_vector_type(16)));
typedef unsigned u32x2 __attribute__((ext_vector_type(2)));
typedef short v4i16_t __attribute__((ext_vector_type(4)));
__device__ __forceinline__ int crow(int r, int hi) { return (r & 3) + 8 * (r >> 2) + 4 * hi; }
typedef __bf16 bf16x2m_t __attribute__((ext_vector_type(2)));
__device__ __forceinline__ unsigned cvtpk(float lo, float hi) { f32x2 v = {lo, hi}; bf16x2m_t b = __builtin_convertvector(v, bf16x2m_t); return __builtin_bit_cast(unsigned, b); }
__device__ __forceinline__ bf16x8 pack8f(const f32x16& p, int b) { v4u w = {cvtpk(p[b], p[b + 1]), cvtpk(p[b + 2], p[b + 3]), cvtpk(p[b + 4], p[b + 5]), cvtpk(p[b + 6], p[b + 7])}; return __builtin_bit_cast(bf16x8, w); }
__device__ __forceinline__ float bf2f(bf16 v) { return __uint_as_float((unsigned)v << 16); }
__device__ __forceinline__ float log2_gamma(int h) { return __builtin_amdgcn_logf(1.0f - __builtin_amdgcn_exp2f(-5.0f - (float)h)); }

__device__ __forceinline__ void phase_r0(Frame& F) {
    const bf16* RQ = (const bf16*)(F.ws + WS_RQ); const bf16* RK = (const bf16*)(F.ws + WS_RK); const bf16* RVT = (const bf16*)(F.ws + WS_RVT); bf16* RO = (bf16*)F.out;
    const int lane = F.lane, w = F.wave, l31 = lane & 31, hi = lane >> 5, tq = w & 3, dh = w >> 2;
    for (int unit = F.vcu; unit < 512; unit += F.G) {
        const int bh = unit >> 5, c = unit & 31, b = bh >> 2, h = bh & 3; const size_t tok0 = (size_t)b * SEQ + c * 128;
        const float lg2 = log2_gamma(h);
        bf16x8 qf[16];
#pragma unroll
        for (int ks = 0; ks < 16; ++ks) qf[ks] = *(const bf16x8*)(RQ + (tok0 + 32 * tq + l31) * 1024 + h * 256 + 16 * ks + 8 * hi);
        bf16x8 pf[4][2];
#pragma unroll
        for (int tb = 0; tb < 4; ++tb) {
            pf[tb][0] = (bf16x8){0, 0, 0, 0, 0, 0, 0, 0}; pf[tb][1] = pf[tb][0];
            if (tb <= tq) {
                f32x16 s = {};
#pragma unroll
                for (int ks = 0; ks < 16; ++ks) { const bf16x8 kf = *(const bf16x8*)(RK + (tok0 + 32 * tb + l31) * 1024 + h * 256 + 16 * ks + 8 * hi); s = __builtin_amdgcn_mfma_f32_32x32x16_bf16(kf, qf[ks], s, 0, 0, 0); }
#pragma unroll
                for (int r = 0; r < 16; ++r) { const int d = (32 * tq + l31) - (32 * tb + crow(r, hi)); s[r] = d >= 0 ? s[r] * __builtin_amdgcn_exp2f((float)d * lg2) : 0.f; }
                pf[tb][0] = pack8f(s, 0); pf[tb][1] = pack8f(s, 8);
            }
        }
#pragma unroll 1
        for (int db = 0; db < 8; ++db) {
            f32x16 o = {};
#pragma unroll
            for (int tb = 0; tb < 4; ++tb)
                if (tb <= tq) {
#pragma unroll
                    for (int s2 = 0; s2 < 2; ++s2) { const bf16* vp = RVT + ((size_t)bh * 512 + 256 * dh + 32 * db + l31) * 4096 + c * 128 + 32 * tb + 16 * s2 + 4 * hi;
                        const u32x2 lo = *(const u32x2*)vp, hh = *(const u32x2*)(vp + 8); const v4u w4 = {lo.x, lo.y, hh.x, hh.y};
                        o = __builtin_amdgcn_mfma_f32_32x32x16_bf16(pf[tb][s2], __builtin_bit_cast(bf16x8, w4), o, 0, 0, 0); }
                }
#pragma unroll
            for (int r = 0; r < 16; ++r) RO[(tok0 + 32 * tq + crow(r, hi)) * 2048 + h * 512 + 256 * dh + 32 * db + l31] = (bf16)f2bf(o[r]);
        }
    }
}
__device__ __forceinline__ void phase_r1(Frame& F) {
    const bf16* RQ = (const bf16*)(F.ws + WS_RQ); const bf16* RKDT = (const bf16*)(F.ws + WS_RKDT); const bf16* RVT = (const bf16*)(F.ws + WS_RVT); bf16* RO = (bf16*)F.out;
    float* ssq_ro = (float*)(F.ws + WS_SMALL + SM_SSQ_RO);
    const int lane = F.lane, w = F.wave, l31 = lane & 31, hi = lane >> 5, l15 = lane & 15, lq = lane >> 4;
    constexpr int SROW = 528, SBUF = 32 * SROW;
    for (int unit = F.vcu; unit < 256; unit += F.G) {
        const int bh = unit >> 4, j = unit & 15, b = bh >> 2, h = bh & 3;
        const float lg2 = log2_gamma(h), gC = __builtin_amdgcn_exp2f(128.0f * lg2);
        f32x16 S = {};
        __syncthreads();
#pragma unroll
        for (int g = 0; g < 4; ++g) *(LAS u32x2*)(F.lds + l31 * SROW + (32 * w + 8 * g + 4 * hi) * 2) = (u32x2){0u, 0u};
        for (int c = 0; c < 32; ++c) {
            const int cur = c & 1; const size_t tok0 = (size_t)b * SEQ + c * 128;
            __syncthreads();
            f32x4 oi[2] = {(f32x4){0.f, 0.f, 0.f, 0.f}, (f32x4){0.f, 0.f, 0.f, 0.f}};
#pragma unroll
            for (int ks = 0; ks < 8; ++ks) { const bf16x8 a = *(const bf16x8*)(RQ + (tok0 + 16 * w + l15) * 1024 + h * 256 + 32 * ks + 8 * lq);
#pragma unroll
                for (int nb = 0; nb < 2; ++nb) { const bf16x8 bq = *(const LAS bf16x8*)(F.lds + cur * SBUF + (16 * nb + l15) * SROW + (32 * ks + 8 * lq) * 2);
                    oi[nb] = __builtin_amdgcn_mfma_f32_16x16x32_bf16(a, bq, oi[nb], 0, 0, 0); } }
#pragma unroll
            for (int i = 0; i < 4; ++i) { const int tt = 16 * w + 4 * lq + i; const float qd = __builtin_amdgcn_exp2f((float)(tt + 1) * lg2); float q = 0.f;
#pragma unroll
                for (int nb = 0; nb < 2; ++nb) { bf16* p = RO + (tok0 + tt) * 2048 + h * 512 + 32 * j + 16 * nb + l15; const float v = bf2f(*p) + qd * oi[nb][i]; *p = (bf16)f2bf(v); q += v * v; }
                q += __shfl_xor(q, 1); q += __shfl_xor(q, 2); q += __shfl_xor(q, 4); q += __shfl_xor(q, 8);
                if (l15 == 0) atomicAdd(ssq_ro + (tok0 + tt) * 4 + h, q); }
#pragma unroll
            for (int r = 0; r < 16; ++r) S[r] *= gC;
#pragma unroll
            for (int ks = 0; ks < 8; ++ks) { const bf16x8 a = *(const bf16x8*)(RKDT + ((size_t)bh * 256 + 32 * w + l31) * 4096 + c * 128 + 16 * ks + 8 * hi);
                const bf16x8 bv = *(const bf16x8*)(RVT + ((size_t)bh * 512 + 32 * j + l31) * 4096 + c * 128 + 16 * ks + 8 * hi);
                S = __builtin_amdgcn_mfma_f32_32x32x16_bf16(a, bv, S, 0, 0, 0); }
#pragma unroll
            for (int g = 0; g < 4; ++g) *(LAS u32x2*)(F.lds + (cur ^ 1) * SBUF + l31 * SROW + (32 * w + 8 * g + 4 * hi) * 2) = (u32x2){cvtpk(S[4 * g], S[4 * g + 1]), cvtpk(S[4 * g + 2], S[4 * g + 3])};
        }
    }
    __syncthreads();
}
__device__ __forceinline__ void phase_fin(Frame& F, const float* qn, const float* kn) {
    bf16* QP = (bf16*)(F.ws + WS_QP); const bf16* KVP = (const bf16*)(F.ws + WS_KVP); const bf16* LAT = (const bf16*)(F.ws + WS_LAT); bf16* KF = (bf16*)(F.ws + WS_KF);
    const f32x2* cs = (const f32x2*)(F.ws + WS_CS);
    const int gw = F.vcu * NWAVES + F.wave, NGW = F.G * NWAVES, lane = F.lane, h = lane >> 3, part = lane & 7;
    for (int tok = gw; tok < MTOK; tok += NGW) {
#pragma unroll
        for (int which = 0; which < 2; ++which) {
            float v[3][8]; float ssq = 0.f;
#pragma unroll
            for (int r = 0; r < 3; ++r) { v4u wv;
                if (which == 0) wv = *(const v4u*)(QP + (size_t)tok * 1536 + h * 192 + 64 * r + 8 * part);
                else if (r < 2) wv = *(const v4u*)(KVP + (size_t)tok * 2048 + h * 256 + 64 * r + 8 * part);
                else wv = *(const v4u*)(LAT + (size_t)tok * LATW + 640 + 8 * part);
                const unsigned ww[4] = {wv.x, wv.y, wv.z, wv.w};
#pragma unroll
                for (int e = 0; e < 4; ++e) { v[r][2 * e] = __uint_as_float(ww[e] << 16); v[r][2 * e + 1] = __uint_as_float(ww[e] & 0xffff0000u); }
#pragma unroll
                for (int e = 0; e < 8; ++e) ssq += v[r][e] * v[r][e]; }
            ssq += __shfl_xor(ssq, 1); ssq += __shfl_xor(ssq, 2); ssq += __shfl_xor(ssq, 4);
            const float sc = (1.0f / sqrtf(ssq * (1.0f / 192.0f) + 1e-6f)) * (which == 0 ? C2Q : 1.0f);
            const float* gn = which == 0 ? qn : kn;
            bf16* dst = which == 0 ? QP + (size_t)tok * 1536 + h * 192 : KF + (size_t)tok * 1536 + h * 192;
#pragma unroll
            for (int r = 0; r < 3; ++r) {
                float y[8];
#pragma unroll
                for (int e = 0; e < 8; ++e) y[e] = v[r][e] * sc * gn[64 * r + 8 * part + e];
                if (r == 2) {
#pragma unroll
                    for (int e = 0; e < 8; ++e) { const float pr = __shfl_xor(y[e], 4); const f32x2 c = cs[(size_t)tok * 128 + 4 * (8 * (part & 3) + e)];
                        y[e] = part < 4 ? y[e] * c.x - pr * c.y : y[e] * c.x + pr * c.y; }
                }
                *(v4u*)(dst + 64 * r + 8 * part) = (v4u){pk2(y[0], y[1]), pk2(y[2], y[3]), pk2(y[4], y[5]), pk2(y[6], y[7])};
            }
        }
    }
}
__device__ __forceinline__ void phase_attn(Frame& F) {
    const bf16* QP = (const bf16*)(F.ws + WS_QP); const bf16* KVP = (const bf16*)(F.ws + WS_KVP); const bf16* KF = (const bf16*)(F.ws + WS_KF); bf16* MO = (bf16*)(F.ws + WS_MO);
    const int lane = F.lane, w = F.wave, l31 = lane & 31, hi = lane >> 5;
    LAS unsigned char* vst = F.lds + w * 9216; LAS float* al = (LAS float*)(vst + 8704); LAS float* li = al + 32;
    constexpr int VROW = 272;
    const int trb = (4 * hi + ((lane & 15) >> 2)) * VROW + (16 * ((lane >> 4) & 1) + 4 * (lane & 3)) * 2;
    for (int v = F.vcu; v < 256; v += F.G) {
#pragma unroll 1
        for (int half = 0; half < 2; ++half) {
            const int qb = half == 0 ? 15 - (v >> 5) : (v >> 5), bh = v & 31, b = bh >> 3, h = bh & 7;
            const int q0 = qb * 256 + 32 * w; const size_t tb = (size_t)b * SEQ;
            bf16x8 qr[12];
#pragma unroll
            for (int d = 0; d < 12; ++d) qr[d] = *(const bf16x8*)(QP + (tb + q0 + l31) * 1536 + h * 192 + 16 * d + 8 * hi);
            float m_run = -1e30f, l_run = 0.f; f32x16 o[4] = {};
            const int nkt = q0 / 32 + 1;
#pragma unroll 1
            for (int kt = 0; kt < nkt; ++kt) {
                const int k0 = kt * 32;
#pragma unroll
                for (int i = 0; i < 8; ++i) { const int idx = lane + 64 * i, row = idx >> 4, ch = idx & 15;
                    const v4u vv = *(const v4u*)(KVP + (tb + k0 + row) * 2048 + h * 256 + 128 + ch * 8); *(LAS v4u*)(vst + row * VROW + ch * 16) = vv; }
                f32x16 p = {};
#pragma unroll
                for (int d = 0; d < 12; ++d) { const bf16x8 kf = *(const bf16x8*)(KF + (tb + k0 + l31) * 1536 + h * 192 + 16 * d + 8 * hi); p = __builtin_amdgcn_mfma_f32_32x32x16_bf16(kf, qr[d], p, 0, 0, 0); }
                if (kt == nkt - 1) {
#pragma unroll
                    for (int r = 0; r < 16; ++r) if (crow(r, hi) > l31) p[r] = -__builtin_inff();
                }
                float pmax = p[0];
#pragma unroll
                for (int r = 1; r < 16; ++r) pmax = fmaxf(pmax, p[r]);
                pmax = fmaxf(pmax, __shfl_xor(pmax, 32));
                const float mn = fmaxf(m_run, pmax), alpha = __builtin_amdgcn_exp2f(m_run - mn); m_run = mn;
                float ps = 0.f;
#pragma unroll
                for (int r = 0; r < 16; ++r) { p[r] = __builtin_amdgcn_exp2f(p[r] - mn); ps += p[r]; }
                ps += __shfl_xor(ps, 32); l_run = l_run * alpha + ps;
                if (hi == 0) al[l31] = alpha;
                const bf16x8 pa0 = pack8f(p, 0), pa1 = pack8f(p, 8);
                LDS_WAIT();
#pragma unroll
                for (int r = 0; r < 16; ++r) { const float a = al[crow(r, hi)];
#pragma unroll
                    for (int db = 0; db < 4; ++db) o[db][r] *= a; }
#pragma unroll
                for (int db = 0; db < 4; ++db)
#pragma unroll
                    for (int s2 = 0; s2 < 2; ++s2) { LAS unsigned char* ap = vst + trb + (16 * s2) * VROW + db * 64;
                        const v4i16_t lo = __builtin_amdgcn_ds_read_tr16_b64_v4i16((LAS v4i16_t*)ap), hh = __builtin_amdgcn_ds_read_tr16_b64_v4i16((LAS v4i16_t*)(ap + 8 * VROW));
                        const bf16x8 bfv = (bf16x8){lo[0], lo[1], lo[2], lo[3], hh[0], hh[1], hh[2], hh[3]};
                        o[db] = __builtin_amdgcn_mfma_f32_32x32x16_bf16(s2 == 0 ? pa0 : pa1, bfv, o[db], 0, 0, 0); }
                LDS_WAIT();
            }
            if (hi == 0) li[l31] = l_run;
            LDS_WAIT();
#pragma unroll
            for (int r = 0; r < 16; ++r) { const float il = 1.0f / li[crow(r, hi)];
#pragma unroll
                for (int db = 0; db < 4; ++db) MO[(tb + q0 + crow(r, hi)) * 1024 + h * 128 + 32 * db + l31] = (bf16)f2bf(o[db][r] * il); }
            LDS_WAIT();
        }
    }
}

namespace attn2 {
typedef float f32x16 __attribute__((ext_vector_type(16)));
typedef short s16x4 __attribute__((ext_vector_type(4)));
constexpr int NW = 8, QBLK = 32, KVBLK = 64, QB = NW * QBLK;
constexpr int QS = 1536, KS = 1536, VS = 2048, OS = 1024;
constexpr int SHM_V = KVBLK * 128 * 2, SHM_K = KVBLK * 512;
constexpr int OFF_V = 0, OFF_K = 2 * SHM_V, OFF_WS = OFF_K + 2 * SHM_K, OFF_QR = OFF_WS + NW * 64 * 4, LDS_NEED = OFF_QR + NW * 4096;
constexpr float THR2 = 8.0f * 1.4426950408889634f;
#define A2_SBAR() __builtin_amdgcn_sched_barrier(0)
__device__ __forceinline__ int v_st(int k, int c) { const int kk = (k & ~0xC) | ((k & 4) << 1) | ((k & 8) >> 1); return ((kk >> 3) * 4 + (c >> 5)) * 512 + ((kk & 7) * 32 + (c & 31)) * 2; }
__device__ __forceinline__ int v_rd_base(int lane) { return ((lane & 3) << 3) | (((lane >> 2) & 3) << 6) | (((lane >> 4) & 1) << 5) | (((lane >> 5) & 1) << 8); }
constexpr int v_rd_off(int d0, int ks, int half) { return d0 * 512 + ks * 4096 + half * 2048; }
__device__ __forceinline__ int crow(int r, int hi) { return (r & 3) + 8 * (r >> 2) + 4 * hi; }
typedef __bf16 bf16x2a_t __attribute__((ext_vector_type(2)));
__device__ __forceinline__ unsigned cvtpk(float lo, float hi) { f32x2 v = {lo, hi}; bf16x2a_t b = __builtin_convertvector(v, bf16x2a_t); return __builtin_bit_cast(unsigned, b); }
__device__ __forceinline__ bf16x8 load8(const bf16* p) { return *reinterpret_cast<const bf16x8*>(p); }
__device__ __forceinline__ void mask_tile(f32x16& p0, f32x16& p1, int dq) {
    const float NEG = -__builtin_inff();
#pragma unroll
    for (int r = 0; r < 16; ++r) { const int c = (r & 3) + 8 * (r >> 2); if (dq - c < 0) p0[r] = NEG; if (dq - c - 32 < 0) p1[r] = NEG; }
}
__device__ __forceinline__ void partialSM(f32x16& p0, f32x16& p1, float& m_reg, float& mn, float& alpha) {
    float pmax = p0[0];
#pragma unroll
    for (int r = 1; r < 16; ++r) pmax = fmaxf(pmax, p0[r]);
#pragma unroll
    for (int r = 0; r < 16; ++r) pmax = fmaxf(pmax, p1[r]);
    { auto rr = __builtin_amdgcn_permlane32_swap(__float_as_uint(pmax), __float_as_uint(pmax), false, false); pmax = fmaxf(__uint_as_float(rr[0]), __uint_as_float(rr[1])); }
    if (__builtin_expect(__all((pmax - m_reg) <= THR2), 1)) { mn = m_reg; alpha = 1.f; }
    else { mn = fmaxf(m_reg, pmax); alpha = __builtin_amdgcn_exp2f(m_reg - mn); m_reg = mn; }
#pragma unroll
    for (int r = 0; r < 16; ++r) { p0[r] -= mn; p1[r] -= mn; }
#pragma unroll
    for (int r = 0; r < 16; ++r) p0[r] = __builtin_amdgcn_exp2f(p0[r]);
}
__device__ __forceinline__ void finishSM(f32x16& p0, f32x16& p1, float alpha, float& l_reg, bf16x8& pa0, bf16x8& pa1, bf16x8& pa2, bf16x8& pa3) {
#pragma unroll
    for (int r = 0; r < 16; ++r) p1[r] = __builtin_amdgcn_exp2f(p1[r]);
    float ps = 0;
#pragma unroll
    for (int r = 0; r < 16; ++r) ps += p0[r];
#pragma unroll
    for (int r = 0; r < 16; ++r) ps += p1[r];
    { auto rr = __builtin_amdgcn_permlane32_swap(__float_as_uint(ps), __float_as_uint(ps), false, false); ps = __uint_as_float(rr[0]) + __uint_as_float(rr[1]); }
    l_reg = l_reg * alpha + ps;
#define A2_PK4(P, B_, OUT) do { unsigned a0 = cvtpk(P[B_+0], P[B_+1]), a1 = cvtpk(P[B_+2], P[B_+3]); unsigned b0 = cvtpk(P[B_+4], P[B_+5]), b1 = cvtpk(P[B_+6], P[B_+7]); \
        auto r0 = __builtin_amdgcn_permlane32_swap(a0, b0, false, false); auto r1 = __builtin_amdgcn_permlane32_swap(a1, b1, false, false); \
        v4u w = {r0[0], r1[0], r0[1], r1[1]}; OUT = __builtin_bit_cast(bf16x8, w); } while (0)
    A2_PK4(p0, 0, pa0); A2_PK4(p0, 8, pa1); A2_PK4(p1, 0, pa2); A2_PK4(p1, 8, pa3);
#undef A2_PK4
}
template <int KB>
__device__ __forceinline__ void qkt(f32x16& p0, f32x16& p1, const char* K_lds, const char* qr_lds, int r32, int hi, const bf16x8* qr) {
    p0 = f32x16{}; p1 = f32x16{};
    const char* kbase = K_lds + KB * SHM_K + r32 * 512; const int x = r32 & 15;
#pragma unroll
    for (int d = 0; d < 12; ++d) { const char* a = kbase + ((((2 * d + hi) & 15) ^ x) << 4) + (d >= 8 ? 256 : 0);
        const bf16x8 b0 = *reinterpret_cast<const bf16x8*>(a), b1 = *reinterpret_cast<const bf16x8*>(a + 32 * 512);
        const bf16x8 q = d < 8 ? qr[d < 8 ? d : 0] : *reinterpret_cast<const bf16x8*>(qr_lds + (((d - 8) * 2 + hi) * 32 + r32) * 16);
        p0 = __builtin_amdgcn_mfma_f32_32x32x16_bf16(b0, q, p0, 0, 0, 0);
        p1 = __builtin_amdgcn_mfma_f32_32x32x16_bf16(b1, q, p1, 0, 0, 0); }
}
template <int VB>
__device__ __forceinline__ void pv_tile(f32x16* o, int vb0, bf16x8 pa0, bf16x8 pa1, bf16x8 pa2, bf16x8 pa3) {
#define A2_TRRD(dst, off) asm volatile("ds_read_b64_tr_b16 %0, %1 offset:%2" : "=&v"(dst) : "v"(vb0), "i"(off) : "memory")
#define A2_PV_D0(d0) do { s16x4 l0, l1, l2, l3, h0, h1, h2, h3; constexpr int b_ = VB * SHM_V + v_rd_off(d0, 0, 0); \
        A2_TRRD(l0, b_); A2_TRRD(h0, b_ + 2048); A2_TRRD(l1, b_ + 4096); A2_TRRD(h1, b_ + 6144); A2_TRRD(l2, b_ + 8192); A2_TRRD(h2, b_ + 10240); A2_TRRD(l3, b_ + 12288); A2_TRRD(h3, b_ + 14336); \
        asm volatile("s_waitcnt lgkmcnt(0)" ::: "memory"); A2_SBAR(); \
        o[d0] = __builtin_amdgcn_mfma_f32_32x32x16_bf16(pa0, (bf16x8){l0[0], l0[1], l0[2], l0[3], h0[0], h0[1], h0[2], h0[3]}, o[d0], 0, 0, 0); \
        o[d0] = __builtin_amdgcn_mfma_f32_32x32x16_bf16(pa1, (bf16x8){l1[0], l1[1], l1[2], l1[3], h1[0], h1[1], h1[2], h1[3]}, o[d0], 0, 0, 0); \
        o[d0] = __builtin_amdgcn_mfma_f32_32x32x16_bf16(pa2, (bf16x8){l2[0], l2[1], l2[2], l2[3], h2[0], h2[1], h2[2], h2[3]}, o[d0], 0, 0, 0); \
        o[d0] = __builtin_amdgcn_mfma_f32_32x32x16_bf16(pa3, (bf16x8){l3[0], l3[1], l3[2], l3[3], h3[0], h3[1], h3[2], h3[3]}, o[d0], 0, 0, 0); } while (0)
    A2_PV_D0(0); A2_PV_D0(1); A2_PV_D0(2); A2_PV_D0(3);
#undef A2_PV_D0
#undef A2_TRRD
}
struct BlockRef { const bf16* Q; const bf16* K; const bf16* V; bf16* O; int P0; };
struct Seam { bf16x8 qr[8]; bf16x8 st_v0, st_v1, st_k0, st_k1, st_k2; };
#define A2_VMW() asm volatile("s_waitcnt vmcnt(0)" ::: "memory")
#define A2_VMWN(n) asm volatile("s_waitcnt vmcnt(%0)" :: "i"(n) : "memory")
#define A2_SLOAD(Kp, Vp, k0) do { S.st_v0 = load8((Vp) + (size_t)((k0) + sr) * VS + sc); S.st_v1 = load8((Vp) + (size_t)((k0) + 32 + sr) * VS + sc); \
        const bf16* kp_ = (Kp) + (size_t)((k0) + krow) * KS + kc * 8; S.st_k0 = load8(kp_); S.st_k1 = load8(kp_ + 64); S.st_k2 = load8(kp_ + 128); } while (0)
#define A2_SWRITE_K(bf) do { *(bf16x8*)(K_lds + (bf) * SHM_K + kw0) = S.st_k0; *(bf16x8*)(K_lds + (bf) * SHM_K + kw1) = S.st_k1; *(bf16x8*)(K_lds + (bf) * SHM_K + kw0 + 256) = S.st_k2; } while (0)
#define A2_SWRITE_V(bf) do { *(bf16x8*)(V_lds + (bf) * SHM_V + vst0) = S.st_v0; *(bf16x8*)(V_lds + (bf) * SHM_V + vst1) = S.st_v1; } while (0)
#define A2_SWRITE(bf) do { A2_SWRITE_V(bf); A2_SWRITE_K(bf); } while (0)
#define A2_IDX const int tid = threadIdx.x, wid = __builtin_amdgcn_readfirstlane(tid >> 6), lane = tid & 63, r32 = lane & 31, hi = lane >> 5; \
    const int sr = tid >> 4, sc = (tid & 15) * 8, krow = tid >> 3, kc = tid & 7, kw0 = krow * 512 + ((kc ^ (krow & 15)) << 4), kw1 = krow * 512 + (((kc + 8) ^ (krow & 15)) << 4); \
    char* V_lds = lds + OFF_V; char* K_lds = lds + OFF_K; (void)lane; (void)r32; (void)hi; (void)sr; (void)sc; (void)V_lds
__device__ __forceinline__ void attn_prime(const BlockRef& cur, char* lds, Seam& S) {
    A2_IDX;
#pragma unroll
    for (int d0 = 0; d0 < 8; ++d0) S.qr[d0] = load8(cur.Q + (size_t)(wid * QBLK + r32) * QS + d0 * 16 + hi * 8);
    A2_SLOAD(cur.K, cur.V, 0); A2_VMW(); A2_SWRITE_K(0);
}
__device__ __forceinline__ void attn_block(const BlockRef& cur, const BlockRef& nxt, char* lds, Seam& S) {
    A2_IDX;
    const int NT = (cur.P0 + QB) / KVBLK;
    const int qlo = cur.P0 + wid * QBLK, qm = qlo + r32 - 4 * hi;
    float* ws = (float*)(lds + OFF_WS) + wid * 64; float* li_l = ws, * al_l = ws + 32;
    char* qr_lds = lds + OFF_QR + wid * 4096;
    float m_reg = -1e30f, l_reg = 0; f32x16 o[4] = {};
    const int vst0 = v_st(sr, sc), vst1 = v_st(32 + sr, sc);
    const int vb0 = (int)(uintptr_t)V_lds + v_rd_base(lane);
    const bf16* Kh = cur.K; const bf16* Vh = cur.V;
    { bf16x8 t4[4];
#pragma unroll
      for (int d = 0; d < 4; ++d) t4[d] = load8(cur.Q + (size_t)(wid * QBLK + r32) * QS + 128 + d * 16 + hi * 8);
#pragma unroll
      for (int d = 0; d < 4; ++d) *(bf16x8*)(qr_lds + ((d * 2 + hi) * 32 + r32) * 16) = t4[d]; }
    A2_SWRITE_V(0);
    __syncthreads();
    f32x16 p0, p1; float mn, al; bf16x8 pa0, pa1, pa2, pa3;
#define A2_STEP(t, BUF) do { const bool lastt = (t) + 1 >= NT; \
        A2_SBAR(); { const bf16* Kn = lastt ? nxt.K : Kh; const bf16* Vn = lastt ? nxt.V : Vh; const int k0n = lastt ? 0 : ((t) + 1) * KVBLK; A2_SLOAD(Kn, Vn, k0n); } A2_SBAR(); \
        qkt<BUF>(p0, p1, K_lds, qr_lds, r32, hi, S.qr); \
        if (lastt) { A2_SBAR(); _Pragma("unroll") for (int d0 = 0; d0 < 8; ++d0) S.qr[d0] = load8(nxt.Q + (size_t)(wid * QBLK + r32) * QS + d0 * 16 + hi * 8); A2_SBAR(); } \
        { const int kb_ = (t) * KVBLK; if (kb_ + KVBLK - 1 > qlo) mask_tile(p0, p1, qm - kb_); } \
        partialSM(p0, p1, m_reg, mn, al); finishSM(p0, p1, al, l_reg, pa0, pa1, pa2, pa3); \
        if (__any(al < 1.f)) { if (hi == 0) al_l[r32] = al; asm volatile("s_waitcnt lgkmcnt(0)" ::: "memory"); \
            for (int d_ = 0; d_ < 4; ++d_) for (int r = 0; r < 16; ++r) o[d_][r] *= al_l[crow(r, hi)]; } \
        A2_SBAR(); pv_tile<BUF>(o, vb0, pa0, pa1, pa2, pa3); A2_SBAR(); \
        if (lastt) { A2_VMWN(8); A2_SWRITE_K(0); } else { A2_VMW(); A2_SWRITE((BUF) ^ 1); } \
        __syncthreads(); } while (0)
    for (int t = 0; t < NT; t += 2) { A2_STEP(t, 0); A2_STEP(t + 1, 1); }
#undef A2_STEP
    if (hi == 0) li_l[r32] = l_reg; asm volatile("s_waitcnt lgkmcnt(0)" ::: "memory");
    float rli[16];
#pragma unroll
    for (int r = 0; r < 16; ++r) rli[r] = __builtin_amdgcn_rcpf(li_l[crow(r, hi)]);
    bf16* Ow = cur.O + (size_t)(wid * QBLK) * OS;
#pragma unroll
    for (int r = 0; r < 16; ++r) { const int orow = crow(r, hi);
#pragma unroll
        for (int d0 = 0; d0 < 4; ++d0) { const float v = o[d0][r] * rli[r]; const float vn = __shfl_xor(v, 1);
            if ((r32 & 1) == 0) *(unsigned*)(Ow + (size_t)orow * OS + d0 * 32 + r32) = cvtpk(v, vn); } }
    asm volatile("s_waitcnt lgkmcnt(0)" ::: "memory");
}
}
__device__ __forceinline__ attn2::BlockRef attn2_ref(unsigned char* ws, int v, int pass) {
    const int bh = v >> 3, b = bh >> 3, h = bh & 7, x = v & 7, qb = pass ? 15 - x : x;
    attn2::BlockRef r;
    r.Q = (const bf16*)(ws + WS_QP) + ((size_t)b * SEQ + qb * 256) * 1536 + h * 192; r.K = (const bf16*)(ws + WS_KF) + (size_t)b * SEQ * 1536 + h * 192;
    r.V = (const bf16*)(ws + WS_KVP) + (size_t)b * SEQ * 2048 + h * 256 + 128; r.O = (bf16*)(ws + WS_MO) + ((size_t)b * SEQ + qb * 256) * 1024 + h * 128; r.P0 = qb * 256;
    return r;
}
__device__ __forceinline__ void phase_attn2(Frame& F, char* lds) {
    int L = F.vcu; if (L >= 256) return;
    attn2::Seam S; int pass = 0;
    attn2::BlockRef cur = attn2_ref(F.ws, L, 0);
    attn2::attn_prime(cur, lds, S);
    for (;;) {
        const bool more_pass = pass == 0, more_item = L + F.G < 256, last = !more_pass && !more_item;
        int passn = pass + 1, Ln = L;
        if (!more_pass) { passn = 0; Ln = more_item ? L + F.G : L; }
        const attn2::BlockRef nxt = last ? cur : attn2_ref(F.ws, Ln, passn);
        attn2::attn_block(cur, nxt, lds, S);
        if (last) break;
        cur = nxt; pass = passn; L = Ln;
    }
}

#ifndef MK_N_LAUNCHES
#define MK_N_LAUNCHES 13
#endif
constexpr int N_PHASES = 13;
constexpr int N_LAUNCHES = MK_N_LAUNCHES;
struct Args { const float* in[21]; float* out; unsigned char* ws; int ph_lo, ph_hi; };
#define PG8_SP2 true
#define PG8_ALIGN true
template <class Epi> __device__ __forceinline__ void run_gemm(Frame& F, const pg8::bf16_t* A, int lda, const pg8::bf16_t* Bt, int ldb, int N, int K, const Epi& E) {
    __syncthreads();
    pg8::Gemm g{A, Bt, MTOK, N, K, lda, ldb}; pg8::StaticOrder S; S.init(MTOK, N, F.G, (int)blockIdx.x);
    pg8::gemm_phase<Epi, pg8::StaticOrder, PG8_ALIGN, PG8_SP2>(F.lds + RING_OFF, g, S, E);
}
__global__ void __launch_bounds__(NWAVES * 64, 2) mk_fwd(Args args) {
    extern __shared__ __attribute__((aligned(16))) unsigned char lds[];
    Frame F;
    F.lds = (LAS unsigned char*)lds; F.MISC = (volatile LAS unsigned*)(F.lds + MISC_OFF);
    F.tid = threadIdx.x; F.lane = F.tid & 63; F.wave = __builtin_amdgcn_readfirstlane(F.tid >> 6);
    F.G = gridDim.x; { const int bx = blockIdx.x; F.vcu = (F.G % 8 == 0) ? (bx % 8) * (F.G / 8) + bx / 8 : bx; }
    F.out = args.out; F.ws = args.ws;
    unsigned char* ws = args.ws;
    if (F.tid < 32) F.MISC[F.tid] = 0u;
    __syncthreads();
    XcdBarrier bar; bar.bar = (unsigned*)(ws + WS_CTL) + CW_BAR; bar.x = 0; bar.st = nullptr;
    if (N_LAUNCHES == 1) bar = xcd_barrier_post((unsigned*)(ws + WS_CTL) + CW_BAR, F.MISC + 8);
    const int lo = args.ph_lo, hi = args.ph_hi;
#ifndef PH_MASK
#define PH_MASK 0x1fff
#endif
#define IN(k) (((PH_MASK >> (k)) & 1) && lo <= (k) && (k) < hi)
#define SEAM(k) do { if (IN(k) && IN((k) + 1)) xcd_barrier(bar); } while (0)
    float* sm = (float*)(ws + WS_SMALL);
    const float* rstdx = sm + SM_RSTDX / 4; float* ssq_cq = sm + SM_SSQ_CQ / 4; float* ssq_ckv = sm + SM_SSQ_CKV / 4; float* ssq1 = sm + SM_SSQ1 / 4; float* ssq2 = sm + SM_SSQ2 / 4; float* ssq_ro = sm + SM_SSQ_RO / 4;
    typedef pg8::bf16_t b16;
    b16* WinT = (b16*)(ws + WS_WIN); b16* XB = (b16*)(ws + WS_XB); b16* LATb = (b16*)(ws + WS_LAT); b16* ROb = (b16*)args.out;

    if (IN(0)) { phase_p0(F, args.in[0], (const int*)args.in[2], args.in[3], args.in[4], args.in[6], args.in[7], args.in[8], args.in[9]); } SEAM(0);
    if (IN(1)) {
        pg8::EpiInProj E{rstdx, (const pg8::f32x4*)(ws + WS_CS), (b16*)(ws + WS_RQ), (b16*)(ws + WS_RK), (b16*)(ws + WS_RKDT), (b16*)(ws + WS_RVT), LATb, ssq_cq, (PG8_LAS unsigned char*)(F.lds + XS_OFF)};
        run_gemm(F, XB, 1024, WinT + (size_t)4096 * 1024, 1024, NIN1, 1024, E);
    } SEAM(1);
    if (IN(2)) { phase_r0(F); } SEAM(2);
    if (IN(3)) { phase_r1(F); } SEAM(3);
    if (IN(4)) {
        { pg8::EpiRetGate E{ROb, rstdx, ssq_ro, args.in[5]}; run_gemm(F, XB, 1024, WinT + (size_t)2048 * 1024, 1024, 2048, 1024, E); }
        { pg8::EpiRowAct<0> E{(b16*)(ws + WS_QP), 1536, ssq_cq, 1.0f / 384.0f}; run_gemm(F, LATb, LATW, (const b16*)(ws + WS_WUQ), 384, 1536, 384, E); }
        { pg8::EpiRowAct<0> E{(b16*)(ws + WS_KVP), 2048, ssq_ckv, 1.0f / 256.0f}; run_gemm(F, LATb + 384, LATW, (const b16*)(ws + WS_WUKV), 256, 2048, 256, E); }
    } SEAM(4);
    if (IN(5)) { phase_fin(F, args.in[10], args.in[11]); } SEAM(5);
#ifdef ATTN_V1
    if (IN(6)) { phase_attn(F); } SEAM(6);
#else
    if (IN(6)) { phase_attn2(F, (char*)lds); } SEAM(6);
#endif
    if (IN(7)) {
#ifndef SKIP_LATE
        phase_late_weights(F, args.in[1], args.in[12], args.in[13], args.in[14], args.in[15], args.in[16], args.in[17], args.in[18], args.in[19], args.in[20]);
#endif
        { pg8::EpiRowAct<1> E{(b16*)(ws + WS_SG), 2048, rstdx, 0.f}; run_gemm(F, XB, 1024, WinT, 1024, 2048, 1024, E); }
    } SEAM(7);
    if (IN(8)) {
        { pg8::EpiGateMix<0> E{(b16*)(ws + WS_TM), (const b16*)(ws + WS_SG), 0}; run_gemm(F, ROb, 2048, (const b16*)(ws + WS_WBR), 2048, 1024, 2048, E); }
        VM_WAIT(); __syncthreads(); __builtin_amdgcn_fence(__ATOMIC_ACQUIRE, "agent"); VM_WAIT(); __syncthreads();
        { pg8::EpiGateMix<1> E{(b16*)(ws + WS_TM), (const b16*)(ws + WS_SG), 1024}; run_gemm(F, (const b16*)(ws + WS_MO), 1024, (const b16*)(ws + WS_WBM), 1024, 1024, 1024, E); }
    } SEAM(8);
    if (IN(9)) { pg8::EpiResid E{args.in[0], args.out, XB, ssq1}; run_gemm(F, (const b16*)(ws + WS_TM), 1024, (const b16*)(ws + WS_WO), 1024, 1024, 1024, E); } SEAM(9);
    if (IN(10)) { pg8::EpiRowAct<2> E{(b16*)(ws + WS_H), 4096, ssq1, 1.0f / 1024.0f}; run_gemm(F, XB, 1024, (const b16*)(ws + WS_WUP), 1024, 4096, 1024, E); } SEAM(10);
    if (IN(11)) { pg8::EpiResid E{args.out, args.out, XB, ssq2}; run_gemm(F, (const b16*)(ws + WS_H), 4096, (const b16*)(ws + WS_WDOWN), 4096, 1024, 4096, E); } SEAM(11);
    if (IN(12)) {
        { pg8::EpiRowAct<1> E{(b16*)(ws + WS_GT), 1024, ssq2, 1.0f / 1024.0f}; run_gemm(F, XB, 1024, (const b16*)(ws + WS_WPG), 1024, 1024, 1024, E); }
        VM_WAIT(); __syncthreads(); __builtin_amdgcn_fence(__ATOMIC_ACQUIRE, "agent"); VM_WAIT(); __syncthreads();
        { pg8::EpiFinal E{args.out, (const b16*)(ws + WS_GT)}; run_gemm(F, (const b16*)(ws + WS_PB), 256, (const b16*)(ws + WS_WPLE), 256, 1024, 256, E); }
    }
#undef IN
#undef SEAM
}


#ifdef DUMPK
struct DumpArgs { const unsigned* reg[6]; unsigned nw[6]; unsigned* out; int own; int pad; };
__global__ void dump_hash(DumpArgs d) {
    for (unsigned i = blockIdx.x * blockDim.x + threadIdx.x; i < (unsigned)MTOK * DM; i += gridDim.x * blockDim.x) {
        float s = 0.f;
        if (d.own) { const unsigned w = d.out[i]; s += __uint_as_float(w << 16) + __uint_as_float(w & 0xffff0000u); }
        for (int r = 0; r < 6; ++r) if (d.reg[r] && i < d.nw[r] * 2u) { const unsigned short v = ((const unsigned short*)d.reg[r])[i]; s += __uint_as_float((unsigned)v << 16); }
        ((float*)d.out)[i] = s;
    }
}
#endif
extern "C" void kernel_launch(void* const* d_in, const int* in_sizes, int n_in, void* d_out, int out_size, void* d_ws, size_t ws_size, hipStream_t stream) {
    static int grid = 0;
    if (grid == 0) {
        if (n_in != 21 || in_sizes[0] != MTOK * DM || out_size != MTOK * DM || ws_size < WS_END) { fprintf(stderr, "kernel_launch: unexpected shapes (n_in %d in0 %d out %d ws %zu)\n", n_in, n_in > 0 ? in_sizes[0] : -1, out_size, ws_size); grid = -1; return; }
        int dev = 0, cus = 0, per_cu = 0;
        if (hipGetDevice(&dev) != hipSuccess || hipDeviceGetAttribute(&cus, hipDeviceAttributeMultiprocessorCount, dev) != hipSuccess) { grid = -1; return; }
        if (hipFuncSetAttribute((const void*)mk_fwd, hipFuncAttributeMaxDynamicSharedMemorySize, LDS_BYTES) != hipSuccess) { fprintf(stderr, "kernel_launch: hipFuncSetAttribute failed\n"); grid = -1; return; }
        if (hipOccupancyMaxActiveBlocksPerMultiprocessor(&per_cu, (const void*)mk_fwd, NWAVES * 64, LDS_BYTES) != hipSuccess || per_cu < 1) { fprintf(stderr, "kernel_launch: occupancy query says %d workgroups per CU\n", per_cu); (void)hipGetLastError(); grid = -1; return; }
        grid = cus;
    }
    if (grid < 0) return;
    (void)hipMemsetAsync((char*)d_ws + WS_CTL, 0, CTL_ZERO_BYTES, stream);
    Args a{};
    for (int i = 0; i < 21; ++i) a.in[i] = (const float*)d_in[i];
    a.out = (float*)d_out; a.ws = (unsigned char*)d_ws;
    if (N_LAUNCHES == 1) { a.ph_lo = 0; a.ph_hi = N_PHASES; hipLaunchKernelGGL(mk_fwd, dim3(grid), dim3(NWAVES * 64), LDS_BYTES, stream, a); }
    else for (int ph = 0; ph < N_PHASES; ++ph) {
#ifdef DUMPK
        if (ph > DUMPK) break;
#endif
        a.ph_lo = ph; a.ph_hi = ph + 1; hipLaunchKernelGGL(mk_fwd, dim3(grid), dim3(NWAVES * 64), LDS_BYTES, stream, a); }
#ifdef DUMPK
    { DumpArgs d{}; d.out = (unsigned*)d_out; d.own = DUMP_OWN; const size_t offs[6] = DUMP_OFFS; const size_t len[6] = DUMP_LENS;
      for (int r = 0; r < 6; ++r) if (len[r]) { d.reg[r] = (const unsigned*)((const char*)d_ws + offs[r]); d.nw[r] = (unsigned)(len[r] / 4); }
      hipLaunchKernelGGL(dump_hash, dim3(2048), dim3(256), 0, stream, d); }
#endif
}
```

```cpp
#define MK_N_LAUNCHES 1
#include <hip/hip_runtime.h>
#include <hip/hip_bf16.h>
#include <cstdio>
#include <cstdint>
namespace pg8 {
#define PG8_LAS __attribute__((address_space(3)))
typedef unsigned short bf16_t;
typedef short bf16x8 __attribute__((ext_vector_type(8)));
typedef float f32x4 __attribute__((ext_vector_type(4)));
typedef unsigned u32x4 __attribute__((ext_vector_type(4)));
constexpr int BM = 256, BK = 64, HALF = 128, HTB = HALF * BK * 2  , STAGE_BYTES = 8 * HTB, NXCD = 8, WGM = 8;

__host__ __device__ __forceinline__ int lds_byte(int r, int c) { const int st = (r >> 4) * 2 + (c >> 5), rr = r & 15, cc = c & 31, ob = rr * 64 + cc * 2; return st * 1024 + (ob ^ (((ob >> 9) & 1) << 5)); }
__host__ __device__ __forceinline__ void stage_rc(int b, int& R, int& C) { const int st = b / 1024, sb = b % 1024, swz = sb ^ (((sb >> 9) & 1) << 5); R = (st >> 1) * 16 + swz / 64; C = (st & 1) * 32 + (swz % 64) / 2; }
__host__ __device__ __forceinline__ int perm32(int rho) { const int n = rho >> 4, i = rho & 15; return 8 * (i >> 2) + 4 * n + (i & 3); }

struct Unit { int pm, pn; };
struct Gemm { const bf16_t* A; const bf16_t* Bt; int M, N, K, lda, ldb; };

struct StaticOrder {
    int nM, nN, nwg, G, c;
    __host__ __device__ void init(int M, int N, int G_, int c_) { nM = M / BM; nN = N / BM; nwg = nM * nN; G = G_; c = c_; }
    __host__ __device__ bool next(int i, Unit& u) const {
        const long L = (long)i * G + c; if (L >= nwg) return false;
        int wgid = (int)L; { const int q = nwg / NXCD, r = nwg % NXCD, xcd = wgid % NXCD, off = wgid / NXCD; wgid = (xcd < r ? xcd * (q + 1) : r * (q + 1) + (xcd - r) * q) + off; }
        const int nig = WGM * nN, gid = wgid / nig, fm = gid * WGM, gsz = (nM - fm) < WGM ? (nM - fm) : WGM;
        u.pm = fm + ((wgid % nig) % gsz); u.pn = (wgid % nig) / gsz; return true;
    }
    __device__ __forceinline__ void a_ready(const Unit&) const {}
    __device__ __forceinline__ void done(const Unit&) const {}
};


typedef float f32x2 __attribute__((ext_vector_type(2)));
typedef __bf16 bf16x2_t __attribute__((ext_vector_type(2)));
__device__ __forceinline__ unsigned cvt_pk_bf16(float lo, float hi) { f32x2 v = {lo, hi}; bf16x2_t b = __builtin_convertvector(v, bf16x2_t); return __builtin_bit_cast(unsigned, b); }
__device__ __forceinline__ float bflo(unsigned w) { return __uint_as_float(w << 16); }
__device__ __forceinline__ float bfhi(unsigned w) { return __uint_as_float(w & 0xffff0000u); }
__device__ __forceinline__ u32x4 pack8(const float (&v)[8]) { u32x4 w; w.x = cvt_pk_bf16(v[0], v[1]); w.y = cvt_pk_bf16(v[2], v[3]); w.z = cvt_pk_bf16(v[4], v[5]); w.w = cvt_pk_bf16(v[6], v[7]); return w; }
__device__ __forceinline__ void unpack8(const u32x4 w, float (&v)[8]) { v[0] = bflo(w.x); v[1] = bfhi(w.x); v[2] = bflo(w.y); v[3] = bfhi(w.y); v[4] = bflo(w.z); v[5] = bfhi(w.z); v[6] = bflo(w.w); v[7] = bfhi(w.w); }
__device__ __forceinline__ float sigmoidf_(float x) { return __builtin_amdgcn_rcpf(1.0f + __builtin_amdgcn_exp2f(-1.4426950408889634f * x)); }
constexpr float RMS_EPS_ = 1e-6f;

#define EPI_ACC8(v, ai, bj, m) float v[8]; { const f32x4 a0_ = acc[ai][bj][m][0], a1_ = acc[ai][bj][m][1]; v[0] = a0_[0]; v[1] = a0_[1]; v[2] = a0_[2]; v[3] = a0_[3]; v[4] = a1_[0]; v[5] = a1_[1]; v[6] = a1_[2]; v[7] = a1_[3]; }

__device__ __forceinline__ void xpose_store(PG8_LAS unsigned char* st, const unsigned (&pk)[4][4], bf16_t* dst, size_t cstride, int lane, int fr, int fq) {
#pragma unroll
    for (int pass = 0; pass < 2; ++pass) {
        if ((fq >> 1) == pass) {
#pragma unroll
            for (int m = 0; m < 4; ++m)
#pragma unroll
                for (int q = 0; q < 4; ++q) { const unsigned w = pk[m][q]; const int c = (fq & 1) * 8 + 2 * q;
                    *(PG8_LAS unsigned short*)(st + c * 144 + (16 * m + fr) * 2) = (unsigned short)(w & 0xffffu);
                    *(PG8_LAS unsigned short*)(st + (c + 1) * 144 + (16 * m + fr) * 2) = (unsigned short)(w >> 16); }
        }
        asm volatile("s_waitcnt lgkmcnt(0)" ::: "memory");
#pragma unroll
        for (int k = 0; k < 2; ++k) { const int idx = lane + 64 * k, c = idx >> 3, ch = idx & 7;
            const u32x4 v = *(const PG8_LAS u32x4*)(st + c * 144 + ch * 16);
            *(u32x4*)(dst + (size_t)(pass * 16 + c) * cstride + ch * 8) = v; }
        asm volatile("s_waitcnt lgkmcnt(0)" ::: "memory");
    }
}

struct EpiInProj {
    static constexpr bool PERM = true, AFTER_DRAIN = false;
    const float* rstdx; const f32x4* cs;
    bf16_t *RQ, *RK, *RKDT, *RVT, *LAT; float *ssq_lat;   PG8_LAS unsigned char* xs;
    __device__ __forceinline__ void operator()(const f32x4 (&acc)[2][2][4][2], const Unit& u, int wr, int wc, int fr, int fq) const {
        const int pn = u.pn, lane = fq * 16 + fr, wid = wr * 4 + wc;
        PG8_LAS unsigned char* st = xs + wid * 2304;
        const int rowt = u.pm * BM + wr * 64 + fr;
        const int bidx = (u.pm * BM) >> 12, s0 = (u.pm * BM) & 4095;
        if (pn < 8) {
            const bool isk = pn >= 4; const int head = pn & 3;
            const float lg2 = __builtin_amdgcn_logf(1.0f - __builtin_amdgcn_exp2f(-5.0f - (float)head));
            float kd[4];
#pragma unroll
            for (int m = 0; m < 4; ++m) kd[m] = __builtin_amdgcn_exp2f((float)(127 - (wr * 64 + m * 16 + fr)) * lg2);
            bf16_t* O = isk ? RK : RQ;
#pragma unroll
            for (int ai = 0; ai < 2; ++ai) {
                unsigned pk0[4][4], pk1[4][4];
#pragma unroll
                for (int m = 0; m < 4; ++m) {
                    const int row = rowt + ai * HALF + m * 16; const float rs = rstdx[row] * (isk ? 0.0625f : 1.0f);
                    const f32x4* cp = cs + (size_t)row * 64 + wc * 16 + fq * 4;
                    const f32x4 c0 = cp[0], c1 = cp[1], c2 = cp[2], c3 = cp[3];
                    const float cc[8] = {c0[0], c0[2], c1[0], c1[2], c2[0], c2[2], c3[0], c3[2]}, ss[8] = {c0[1], c0[3], c1[1], c1[3], c2[1], c2[3], c3[1], c3[3]};
                    EPI_ACC8(x1, ai, 0, m); EPI_ACC8(x2, ai, 1, m);
                    float o1[8], o2[8];
#pragma unroll
                    for (int e = 0; e < 8; ++e) { const float a = x1[e] * rs, b = x2[e] * rs; o1[e] = a * cc[e] - b * ss[e]; o2[e] = b * cc[e] + a * ss[e]; }
                    bf16_t* rp = O + (size_t)row * 1024 + head * 256 + wc * 32 + 8 * fq;
                    *(u32x4*)rp = pack8(o1); *(u32x4*)(rp + HALF) = pack8(o2);
                    if (isk) {
#pragma unroll
                        for (int q = 0; q < 4; ++q) { pk0[m][q] = cvt_pk_bf16(o1[2 * q] * kd[m], o1[2 * q + 1] * kd[m]); pk1[m][q] = cvt_pk_bf16(o2[2 * q] * kd[m], o2[2 * q + 1] * kd[m]); }
                    }
                }
                if (isk) {
                    bf16_t* d0 = RKDT + ((size_t)(bidx * 4 + head) * 256 + wc * 32) * 4096 + s0 + ai * HALF + wr * 64;
                    xpose_store(st, pk0, d0, 4096, lane, fr, fq);
                    xpose_store(st, pk1, d0 + (size_t)HALF * 4096, 4096, lane, fr, fq);
                }
            }
        } else if (pn < 16) {
            const int head = (pn - 8) >> 1, dvb = ((pn - 8) & 1) * 256;
#pragma unroll
            for (int ai = 0; ai < 2; ++ai)
#pragma unroll
                for (int bj = 0; bj < 2; ++bj) {
                    unsigned pk[4][4];
#pragma unroll
                    for (int m = 0; m < 4; ++m) { const float rs = rstdx[rowt + ai * HALF + m * 16]; EPI_ACC8(v, ai, bj, m);
#pragma unroll
                        for (int q = 0; q < 4; ++q) pk[m][q] = cvt_pk_bf16(v[2 * q] * rs, v[2 * q + 1] * rs); }
                    bf16_t* d0 = RVT + ((size_t)(bidx * 4 + head) * 512 + dvb + bj * HALF + wc * 32) * 4096 + s0 + ai * HALF + wr * 64;
                    xpose_store(st, pk, d0, 4096, lane, fr, fq);
                }
        } else {
            const int lt = pn - 16;
#pragma unroll
            for (int ai = 0; ai < 2; ++ai)
#pragma unroll
                for (int m = 0; m < 4; ++m) { const int row = rowt + ai * HALF + m * 16; const float rs = rstdx[row];
#pragma unroll
                    for (int bj = 0; bj < 2; ++bj) { EPI_ACC8(v, ai, bj, m); float q = 0.f;
#pragma unroll
                        for (int e = 0; e < 8; ++e) { v[e] *= rs; q += v[e] * v[e]; }
                        *(u32x4*)(LAT + (size_t)row * 768 + lt * 256 + bj * HALF + wc * 32 + 8 * fq) = pack8(v);
                        const int kind = (lt == 0) ? 0 : (lt == 1 ? (bj == 0 ? 0 : 1) : (bj == 0 ? 1 : 2));
                        if (kind < 2) { q += __shfl_xor(q, 16); q += __shfl_xor(q, 32); if (fq == 0) atomicAdd(ssq_lat + kind * 16384 + row, q); } } }
        }
    }
};

template <int MODE> struct EpiRowAct {
    static constexpr bool PERM = true, AFTER_DRAIN = false;
    bf16_t* O; int ldo; const float* rsrc; float inv_dim;
    __device__ __forceinline__ void operator()(const f32x4 (&acc)[2][2][4][2], const Unit& u, int wr, int wc, int fr, int fq) const {
        const int rowt = u.pm * BM + wr * 64 + fr, colt = u.pn * BM + wc * 32 + 8 * fq;
#pragma unroll
        for (int ai = 0; ai < 2; ++ai)
#pragma unroll
            for (int m = 0; m < 4; ++m) { const int row = rowt + ai * HALF + m * 16; const float r0 = rsrc[row]; const float rs = inv_dim == 0.f ? r0 : __builtin_amdgcn_rsqf(r0 * inv_dim + RMS_EPS_);
#pragma unroll
                for (int bj = 0; bj < 2; ++bj) { EPI_ACC8(v, ai, bj, m);
#pragma unroll
                    for (int e = 0; e < 8; ++e) { float x = v[e] * rs; if (MODE == 1) x = sigmoidf_(x); if (MODE == 2) { x = fmaxf(x, 0.f); x = x * x; } v[e] = x; }
                    *(u32x4*)(O + (size_t)row * ldo + colt + bj * HALF) = pack8(v); } }
    }
};
struct EpiRetGate {
    static constexpr bool PERM = true, AFTER_DRAIN = false;
    bf16_t* RO; const float* rstdx; const float* ssq_ro; const float* ret_norm;
    __device__ __forceinline__ void operator()(const f32x4 (&acc)[2][2][4][2], const Unit& u, int wr, int wc, int fr, int fq) const {
        const int rowt = u.pm * BM + wr * 64 + fr, colt = u.pn * BM + wc * 32 + 8 * fq, head = u.pn >> 1;
        f32x4 g[2][2];
#pragma unroll
        for (int bj = 0; bj < 2; ++bj) { g[bj][0] = *(const f32x4*)(ret_norm + colt + bj * HALF); g[bj][1] = *(const f32x4*)(ret_norm + colt + bj * HALF + 4); }
#pragma unroll
        for (int ai = 0; ai < 2; ++ai)
#pragma unroll
            for (int m = 0; m < 4; ++m) { const int row = rowt + ai * HALF + m * 16; const float rs = rstdx[row], rr = __builtin_amdgcn_rsqf(ssq_ro[row * 4 + head] * (1.0f / 512.0f) + RMS_EPS_);
#pragma unroll
                for (int bj = 0; bj < 2; ++bj) { EPI_ACC8(v, ai, bj, m); bf16_t* p = RO + (size_t)row * 2048 + colt + bj * HALF; float o[8]; unpack8(*(const u32x4*)p, o);
#pragma unroll
                    for (int e = 0; e < 8; ++e) { const float x = v[e] * rs; const float gg = e < 4 ? g[bj][0][e & 3] : g[bj][1][e & 3]; v[e] = o[e] * rr * gg * x * sigmoidf_(x); }
                    *(u32x4*)p = pack8(v); } }
    }
};
template <int MODE> struct EpiGateMix {
    static constexpr bool PERM = true, AFTER_DRAIN = false;
    bf16_t* TM; const bf16_t* SG; int sgoff;
    __device__ __forceinline__ void operator()(const f32x4 (&acc)[2][2][4][2], const Unit& u, int wr, int wc, int fr, int fq) const {
        const int rowt = u.pm * BM + wr * 64 + fr, colt = u.pn * BM + wc * 32 + 8 * fq;
#pragma unroll
        for (int ai = 0; ai < 2; ++ai)
#pragma unroll
            for (int m = 0; m < 4; ++m) { const int row = rowt + ai * HALF + m * 16;
#pragma unroll
                for (int bj = 0; bj < 2; ++bj) { EPI_ACC8(v, ai, bj, m); float s[8]; unpack8(*(const u32x4*)(SG + (size_t)row * 2048 + sgoff + colt + bj * HALF), s);
                    bf16_t* p = TM + (size_t)row * 1024 + colt + bj * HALF;
                    if (MODE == 1) { float t[8]; unpack8(*(const u32x4*)p, t);
#pragma unroll
                        for (int e = 0; e < 8; ++e) v[e] = t[e] + s[e] * v[e]; }
                    else {
#pragma unroll
                        for (int e = 0; e < 8; ++e) v[e] = s[e] * v[e]; }
                    *(u32x4*)p = pack8(v); } }
    }
};
struct EpiResid {
    static constexpr bool PERM = true, AFTER_DRAIN = false;
    const float* res; float* out; bf16_t* xb; float* ssq;
    __device__ __forceinline__ void operator()(const f32x4 (&acc)[2][2][4][2], const Unit& u, int wr, int wc, int fr, int fq) const {
        const int rowt = u.pm * BM + wr * 64 + fr, colt = u.pn * BM + wc * 32 + 8 * fq;
#pragma unroll
        for (int ai = 0; ai < 2; ++ai)
#pragma unroll
            for (int m = 0; m < 4; ++m) { const int row = rowt + ai * HALF + m * 16; float q = 0.f;
#pragma unroll
                for (int bj = 0; bj < 2; ++bj) { EPI_ACC8(v, ai, bj, m); const size_t off = (size_t)row * 1024 + colt + bj * HALF;
                    const f32x4 r0 = *(const f32x4*)(res + off), r1 = *(const f32x4*)(res + off + 4);
#pragma unroll
                    for (int e = 0; e < 8; ++e) { v[e] += e < 4 ? r0[e & 3] : r1[e & 3]; q += v[e] * v[e]; }
                    *(f32x4*)(out + off) = (f32x4){v[0], v[1], v[2], v[3]}; *(f32x4*)(out + off + 4) = (f32x4){v[4], v[5], v[6], v[7]};
                    *(u32x4*)(xb + off) = pack8(v); }
                q += __shfl_xor(q, 16); q += __shfl_xor(q, 32); if (fq == 0) atomicAdd(ssq + row, q);
                if (m & 1) asm volatile("" ::: "memory"); }
    }
};
struct EpiFinal {
    static constexpr bool PERM = true, AFTER_DRAIN = false;
    float* out; const bf16_t* GT;
    __device__ __forceinline__ void operator()(const f32x4 (&acc)[2][2][4][2], const Unit& u, int wr, int wc, int fr, int fq) const {
        const int rowt = u.pm * BM + wr * 64 + fr, colt = u.pn * BM + wc * 32 + 8 * fq;
#pragma unroll
        for (int ai = 0; ai < 2; ++ai)
#pragma unroll
            for (int m = 0; m < 4; ++m) { const int row = rowt + ai * HALF + m * 16;
#pragma unroll
                for (int bj = 0; bj < 2; ++bj) { EPI_ACC8(v, ai, bj, m); const size_t off = (size_t)row * 1024 + colt + bj * HALF; float gt[8]; unpack8(*(const u32x4*)(GT + off), gt);
                    const f32x4 r0 = *(const f32x4*)(out + off), r1 = *(const f32x4*)(out + off + 4);
#pragma unroll
                    for (int e = 0; e < 8; ++e) v[e] = (e < 4 ? r0[e & 3] : r1[e & 3]) + gt[e] * v[e];
                    *(f32x4*)(out + off) = (f32x4){v[0], v[1], v[2], v[3]}; *(f32x4*)(out + off + 4) = (f32x4){v[4], v[5], v[6], v[7]}; }
                if (m & 1) asm volatile("" ::: "memory"); }
    }
};
template <class Epi, class Sched, bool ALIGN_EPI = false, bool SP2 = false>
__device__ __forceinline__ void gemm_phase(PG8_LAS unsigned char* lds, const Gemm g, const Sched& S, const Epi& E) {
    const int tid = threadIdx.x, wid = __builtin_amdgcn_readfirstlane(tid >> 6), lane = tid & 63, wr = wid >> 2, wc = wid & 3, fr = lane & 15, fq = lane >> 4;
    const int K = g.K, nt = K / BK;
    unsigned voffA[2], voffB[2];
#pragma unroll
    for (int i = 0; i < 2; ++i) { int R, C; stage_rc(tid * 16 + i * 8192, R, C); const int Rb = Epi::PERM ? ((R & ~31) + perm32(R & 31)) : R;
        voffA[i] = (unsigned)(R * g.lda + C) * 2u; voffB[i] = (unsigned)(Rb * g.ldb + C) * 2u; }
    const size_t kstep = (size_t)(BK * 2);
    const size_t hstepA = (size_t)HALF * g.lda * 2, hstepB = (size_t)HALF * g.ldb * 2;
    const size_t tstepA = 2 * hstepA, tstepB = 2 * hstepB;
    const unsigned ldsw = (unsigned)wid * 1024u;
    const int aoff = lds_byte(wr * 64 + fr, fq * 8), boff = lds_byte(wc * 32 + fr, fq * 8);
#define PG8_SA(b, h) (((b) * 2 + (h)) * HTB)
#define PG8_SB(b, h) ((4 + (b) * 2 + (h)) * HTB)
#define PG8_STAGE(bufoff, gbase, voff) do { _Pragma("unroll") for (int _i = 0; _i < 2; ++_i) \
        __builtin_amdgcn_global_load_lds((const unsigned*)((const char*)(gbase) + (voff)[_i]), (PG8_LAS unsigned*)(lds + (bufoff) + ldsw + _i * 8192), 16, 0, 0); } while (0)
#define PG8_LDA(dst, b, h) do { _Pragma("unroll") for (int m = 0; m < 4; ++m) _Pragma("unroll") for (int k = 0; k < 2; ++k) dst[m][k] = *(const PG8_LAS bf16x8*)(lds + PG8_SA(b, h) + aoff + m * 2048 + k * 1024); } while (0)
#define PG8_LDB(dst, b, h) do { _Pragma("unroll") for (int n = 0; n < 2; ++n) _Pragma("unroll") for (int k = 0; k < 2; ++k) dst[n][k] = *(const PG8_LAS bf16x8*)(lds + PG8_SB(b, h) + boff + n * 2048 + k * 1024); } while (0)
#define PG8_MMA(ai, bj, At, Bt) do { __builtin_amdgcn_s_setprio(1); _Pragma("unroll") for (int m = 0; m < 4; ++m) _Pragma("unroll") for (int n = 0; n < 2; ++n) _Pragma("unroll") for (int k = 0; k < 2; ++k) \
        acc[ai][bj][m][n] = __builtin_amdgcn_mfma_f32_16x16x32_bf16(Bt[n][k], At[m][k], acc[ai][bj][m][n], 0, 0, 0); __builtin_amdgcn_s_setprio(0); } while (0)
#define PG8_WAIT_V(n) asm volatile("s_waitcnt vmcnt(" #n ")" ::: "memory")
#define PG8_WAIT_L(n) asm volatile("s_waitcnt lgkmcnt(" #n ")" ::: "memory")
#define PG8_BAR __builtin_amdgcn_s_barrier()
#define PG8_SCHED __builtin_amdgcn_sched_barrier(0)
    Unit cur, nxt; int ui = 0;
    if (!S.next(0, cur)) return;
    f32x4 acc[2][2][4][2];
#pragma unroll
    for (int a = 0; a < 2; ++a)
#pragma unroll
        for (int b = 0; b < 2; ++b)
#pragma unroll
            for (int m = 0; m < 4; ++m)
#pragma unroll
                for (int n = 0; n < 2; ++n) acc[a][b][m][n] = (f32x4){0.f, 0.f, 0.f, 0.f};
    bf16x8 At[4][2], B0[2][2], B1[2][2];
    const char* cA = (const char*)g.A + (size_t)cur.pm * tstepA; const char* cB = (const char*)g.Bt + (size_t)cur.pn * tstepB;
    S.a_ready(cur);
    if constexpr (SP2) {
        PG8_STAGE(PG8_SB(0, 0), cB, voffB); PG8_STAGE(PG8_SB(0, 1), cB + hstepB, voffB); PG8_STAGE(PG8_SA(0, 0), cA, voffA); PG8_STAGE(PG8_SA(0, 1), cA + hstepA, voffA);
        if (wr == 1) PG8_BAR;
        PG8_WAIT_V(2); PG8_BAR;
        PG8_STAGE(PG8_SB(1, 0), cB + kstep, voffB); PG8_STAGE(PG8_SA(1, 0), cA + kstep, voffA); PG8_STAGE(PG8_SB(1, 1), cB + hstepB + kstep, voffB);
        PG8_WAIT_V(6); PG8_BAR;
    } else {
        PG8_STAGE(PG8_SB(0, 0), cB, voffB); PG8_STAGE(PG8_SA(0, 0), cA, voffA); PG8_STAGE(PG8_SB(0, 1), cB + hstepB, voffB); PG8_STAGE(PG8_SA(0, 1), cA + hstepA, voffA);
        if (wr == 1) PG8_BAR;
        PG8_WAIT_V(4); PG8_BAR;
        PG8_STAGE(PG8_SB(1, 0), cB + kstep, voffB); PG8_STAGE(PG8_SA(1, 0), cA + kstep, voffA); PG8_STAGE(PG8_SB(1, 1), cB + hstepB + kstep, voffB);
        PG8_WAIT_V(6); PG8_BAR;
    }
    for (;;) {
        const bool has_next = S.next(ui + 1, nxt);
        const char* nA = has_next ? (const char*)g.A + (size_t)nxt.pm * tstepA : cA; const char* nB = has_next ? (const char*)g.Bt + (size_t)nxt.pn * tstepB : cB;
        for (int t = 0; t < nt; t += 2) {
            const bool last = (t == nt - 2);
            const char* a1 = cA + (size_t)(t + 1) * kstep;
            const char* a2 = last ? nA : cA + (size_t)(t + 2) * kstep; const char* b2 = last ? nB : cB + (size_t)(t + 2) * kstep;
            const char* a3 = a2 + kstep; const char* b3 = b2 + kstep;
            if (last && has_next) S.a_ready(nxt);
            if constexpr (SP2) {
            PG8_LDB(B0, 0, 0); PG8_LDB(B1, 0, 1); PG8_SCHED; PG8_LDA(At, 0, 0); PG8_STAGE(PG8_SA(1, 1), a1 + hstepA, voffA);
            PG8_WAIT_V(8); PG8_WAIT_L(0); PG8_BAR; PG8_MMA(0, 0, At, B0); PG8_MMA(0, 1, At, B1); PG8_BAR; PG8_SCHED;
            PG8_LDA(At, 0, 1); PG8_STAGE(PG8_SB(0, 0), b2, voffB); PG8_STAGE(PG8_SB(0, 1), b2 + hstepB, voffB); PG8_STAGE(PG8_SA(0, 0), a2, voffA);
            PG8_WAIT_V(8); PG8_WAIT_L(0); PG8_BAR; PG8_MMA(1, 0, At, B0); PG8_MMA(1, 1, At, B1); PG8_BAR; PG8_SCHED;
            PG8_LDB(B0, 1, 0); PG8_LDB(B1, 1, 1); PG8_SCHED; PG8_LDA(At, 1, 0); PG8_STAGE(PG8_SA(0, 1), a2 + hstepA, voffA);
            PG8_WAIT_V(8); PG8_WAIT_L(0); PG8_BAR; PG8_MMA(0, 0, At, B0); PG8_MMA(0, 1, At, B1); PG8_BAR; PG8_SCHED;
            PG8_LDA(At, 1, 1); PG8_STAGE(PG8_SB(1, 0), b3, voffB); PG8_STAGE(PG8_SB(1, 1), b3 + hstepB, voffB); PG8_STAGE(PG8_SA(1, 0), a3, voffA);
            PG8_WAIT_V(8); PG8_WAIT_L(0); PG8_BAR; PG8_MMA(1, 0, At, B0); PG8_MMA(1, 1, At, B1); PG8_BAR; PG8_SCHED;
            } else {
            PG8_LDB(B0, 0, 0); PG8_SCHED; PG8_LDA(At, 0, 0); PG8_STAGE(PG8_SA(1, 1), a1 + hstepA, voffA);
            PG8_WAIT_L(8); PG8_BAR; PG8_WAIT_L(0); PG8_MMA(0, 0, At, B0); PG8_BAR; PG8_SCHED;
            PG8_LDB(B1, 0, 1); PG8_STAGE(PG8_SB(0, 0), b2, voffB);
            PG8_BAR; PG8_WAIT_L(0); PG8_MMA(0, 1, At, B1); PG8_BAR;
            PG8_LDA(At, 0, 1); PG8_STAGE(PG8_SA(0, 0), a2, voffA);
            PG8_BAR; PG8_WAIT_L(0); PG8_MMA(1, 0, At, B0); PG8_BAR; PG8_SCHED;
            PG8_STAGE(PG8_SB(0, 1), b2 + hstepB, voffB);
            PG8_WAIT_V(6); PG8_BAR; PG8_MMA(1, 1, At, B1); PG8_BAR;
            PG8_LDB(B0, 1, 0); PG8_SCHED; PG8_LDA(At, 1, 0); PG8_STAGE(PG8_SA(0, 1), a2 + hstepA, voffA);
            PG8_WAIT_L(8); PG8_BAR; PG8_WAIT_L(0); PG8_MMA(0, 0, At, B0); PG8_BAR; PG8_SCHED;
            PG8_LDB(B1, 1, 1); PG8_STAGE(PG8_SB(1, 0), b3, voffB);
            PG8_BAR; PG8_WAIT_L(0); PG8_MMA(0, 1, At, B1); PG8_BAR;
            PG8_LDA(At, 1, 1); PG8_STAGE(PG8_SA(1, 0), a3, voffA);
            PG8_BAR; PG8_WAIT_L(0); PG8_MMA(1, 0, At, B0); PG8_BAR; PG8_SCHED;
            PG8_STAGE(PG8_SB(1, 1), b3 + hstepB, voffB);
            PG8_WAIT_V(6); PG8_BAR; PG8_MMA(1, 1, At, B1); PG8_BAR;
            }
        }
        if constexpr (ALIGN_EPI) { if (wr == 0) PG8_BAR; }
        if constexpr (!Epi::AFTER_DRAIN) { E(acc, cur, wr, wc, fr, fq); S.done(cur); }
        if (!has_next) break;
#pragma unroll
        for (int a = 0; a < 2; ++a)
#pragma unroll
            for (int b = 0; b < 2; ++b)
#pragma unroll
                for (int m = 0; m < 4; ++m)
#pragma unroll
                    for (int n = 0; n < 2; ++n) acc[a][b][m][n] = (f32x4){0.f, 0.f, 0.f, 0.f};
        cur = nxt; cA = nA; cB = nB; ++ui;
        if constexpr (ALIGN_EPI) { if (wr == 1) PG8_BAR; }
    }
    PG8_WAIT_V(0);
    if constexpr (!ALIGN_EPI) { if (wr == 0) PG8_BAR; }
    PG8_BAR;
    if constexpr (Epi::AFTER_DRAIN) { E.fused(acc, cur, wr, wc, fr, fq, lds, wid, lane); S.done(cur); }
#undef PG8_SA
#undef PG8_SB
#undef PG8_STAGE
#undef PG8_LDA
#undef PG8_LDB
#undef PG8_MMA
#undef PG8_WAIT_V
#undef PG8_WAIT_L
#undef PG8_BAR
#undef PG8_SCHED
}
}
#define GAS __attribute__((address_space(1)))
#define LAS __attribute__((address_space(3)))
typedef unsigned short bf16;
typedef unsigned v4u __attribute__((ext_vector_type(4)));
typedef float f32x4 __attribute__((ext_vector_type(4)));
typedef short bf16x8 __attribute__((ext_vector_type(8)));
typedef GAS unsigned gu32;
typedef GAS unsigned long long gu64;
#define RLX_AGENT __ATOMIC_RELAXED, __HIP_MEMORY_SCOPE_AGENT
#define LDS_WAIT() asm volatile("s_waitcnt lgkmcnt(0)" ::: "memory")
#define VM_WAIT() asm volatile("s_waitcnt vmcnt(0)" ::: "memory")
__device__ __forceinline__ unsigned long long rt() { return __builtin_amdgcn_s_memrealtime(); }
__device__ __forceinline__ unsigned f2bf(float f) { unsigned u = __builtin_bit_cast(unsigned, f); return (u + 0x7fffu + ((u >> 16) & 1u)) >> 16; }
__device__ __forceinline__ unsigned pk2(float lo, float hi) { return f2bf(lo) | (f2bf(hi) << 16); }

#define XB_TMO      128
#define XB_XCNT(j)  (256  + 64 * (j))
#define XB_XSUB(j)  (1280 + 64 * (j))
#define XB_XGEN(j)  (2304 + 64 * (j))
#define XB_TOP      3328
#define XB_TOPGEN   3392
#define XCD_BAR_WORDS 3456
#define XB_SPIN_CAP (1u << 18)

__device__ __forceinline__ unsigned xb_ld(unsigned* p)              { return __hip_atomic_load(p, __ATOMIC_RELAXED, __HIP_MEMORY_SCOPE_AGENT); }
__device__ __forceinline__ unsigned xb_add(unsigned* p, unsigned v) { return __hip_atomic_fetch_add(p, v, __ATOMIC_RELAXED, __HIP_MEMORY_SCOPE_AGENT); }
__device__ __forceinline__ unsigned xb_xcc_id() { return (unsigned)__builtin_amdgcn_s_getreg((3 << 11) | 20) & 0xFu; }
#define XB_SPIN(cond, bar) do { unsigned _sp = 0; while (cond) { __builtin_amdgcn_s_sleep(1); \
    if ((++_sp & 255u) == 0u) { if (xb_ld(&(bar)[XB_TMO])) break; if (_sp > XB_SPIN_CAP) { atomicAdd(&(bar)[XB_TMO], 1u); break; } } } } while (0)

struct XcdBarrier {
    unsigned* bar; unsigned x;
    volatile LAS unsigned* st;
};

__device__ __forceinline__ XcdBarrier xcd_barrier_post(unsigned* bar, volatile LAS unsigned* st) {
    XcdBarrier b; b.bar = bar; b.x = xb_xcc_id(); b.st = st;
    if (threadIdx.x == 0) (void)xb_add(&bar[XB_XCNT(b.x)], 1u);
    return b;
}
__device__ __forceinline__ void xcd_barrier_complete(unsigned* bar, unsigned x, unsigned& nloc, unsigned& nx) {
    const unsigned G = gridDim.x * gridDim.y * gridDim.z;
    unsigned sum, cnt, mine, sp = 0u;
    for (;;) {
        sum = 0u; cnt = 0u; mine = 0u;
#pragma unroll
        for (unsigned j = 0; j < 16; ++j) { const unsigned c = xb_ld(&bar[XB_XCNT(j)]); sum += c; cnt += (c > 0u) ? 1u : 0u; mine = (j == x) ? c : mine; }
        if (sum == G) break;
        __builtin_amdgcn_s_sleep(1);
        if ((++sp & 255u) == 0u) { if (xb_ld(&bar[XB_TMO])) break; if (sp > XB_SPIN_CAP) { atomicAdd(&bar[XB_TMO], 1u); break; } }
    }
    nloc = mine > 0u ? mine : 1u; nx = cnt > 0u ? cnt : 1u;
}

__device__ __forceinline__ void xcd_barrier(const XcdBarrier& b) {
    asm volatile("s_waitcnt vmcnt(0)" ::: "memory");
    __syncthreads();
    if (threadIdx.x == 0) {
        unsigned* bar = b.bar;
        __builtin_amdgcn_s_waitcnt(0);
        unsigned nloc = b.st[0], nx = b.st[1];
        if (nloc == 0u) { xcd_barrier_complete(bar, b.x, nloc, nx); b.st[0] = nloc; b.st[1] = nx; }
        const unsigned old = xb_add(&bar[XB_XSUB(b.x)], 1u);
        const unsigned gen = old / nloc;
        if (old + 1u == (gen + 1u) * nloc) {
            __builtin_amdgcn_fence(__ATOMIC_RELEASE, "agent");
            asm volatile("s_waitcnt vmcnt(0)" ::: "memory");
            const unsigned og = xb_add(&bar[XB_TOP], 1u);
            const unsigned tg = og / nx;
            if (og + 1u == (tg + 1u) * nx) xb_add(&bar[XB_TOPGEN], 1u);
            else XB_SPIN(xb_ld(&bar[XB_TOPGEN]) == tg, bar);
            __builtin_amdgcn_fence(__ATOMIC_ACQUIRE, "agent");
            xb_add(&bar[XB_XGEN(b.x)], 1u);
            asm volatile("s_waitcnt vmcnt(0)" ::: "memory");
        } else {
            XB_SPIN(xb_ld(&bar[XB_XGEN(b.x)]) == gen, bar);
            __builtin_amdgcn_fence(__ATOMIC_ACQUIRE, "agent");
            asm volatile("s_waitcnt vmcnt(0)" ::: "memory");
        }
    }
    __syncthreads();
}


typedef float f32x2 __attribute__((ext_vector_type(2)));
constexpr int NWAVES = 8;
constexpr int BATCH = 4, SEQ = 4096, DM = 1024, MTOK = BATCH * SEQ;
constexpr int NIN1 = 4864;
constexpr int LATW = 768;
constexpr float C2Q = 0.07216878364870323f * 1.4426950408889634f;

constexpr size_t MiB = 1u << 20, KiB = 1u << 10;
constexpr size_t WS_CTL = 0, CTL_ZERO_BYTES = 64 * KiB;
constexpr size_t WS_SMALL = 1 * MiB;
constexpr size_t SM_RSTDX = 0, SM_SSQ_CQ = 64 * KiB, SM_SSQ_CKV = 128 * KiB, SM_SSQ1 = 192 * KiB, SM_SSQ2 = 256 * KiB, SM_SSQ_RO = 320 * KiB, SM_END = 576 * KiB;
constexpr size_t WS_WIN = 2 * MiB;
constexpr size_t WS_WUQ = WS_WIN + (size_t)8960 * 1024 * 2;
constexpr size_t WS_WUKV = WS_WUQ + (size_t)1536 * 384 * 2;
constexpr size_t WS_XB = 22 * MiB;
constexpr size_t WS_CS = 54 * MiB;
constexpr size_t WS_LAT = 70 * MiB;
constexpr size_t WS_RQ = 94 * MiB, WS_RK = 126 * MiB, WS_RKDT = 158 * MiB, WS_RVT = 190 * MiB;
constexpr size_t WS_QP = 94 * MiB, WS_KVP = 142 * MiB, WS_KF = 206 * MiB;
constexpr size_t WS_MO = 54 * MiB;
constexpr size_t WS_SG = 94 * MiB, WS_TM = 158 * MiB;
constexpr size_t WS_WBR = 190 * MiB, WS_WBM = 194 * MiB, WS_WO = 196 * MiB, WS_WUP = 198 * MiB, WS_WDOWN = 206 * MiB, WS_WPG = 214 * MiB, WS_WPLE = 216 * MiB;
constexpr size_t WS_PB = 217 * MiB;
constexpr size_t WS_H = 54 * MiB;
constexpr size_t WS_GT = 54 * MiB;
constexpr size_t WS_END = 256 * MiB;
static_assert(SM_SSQ_CKV == SM_SSQ_CQ + 65536, "ssq_lat layout");
static_assert(WS_WUKV + (size_t)2048 * 256 * 2 <= WS_XB && WS_RVT + 64 * MiB <= WS_END && WS_KF + 48 * MiB <= WS_END && WS_H + 128 * MiB <= WS_WBR && WS_PB + 8 * MiB <= WS_END, "d_ws map");
constexpr int CW_BAR = 1024;

constexpr int RING_OFF = 0, RING_BYTES = 131072;
constexpr int XS_OFF = RING_BYTES, XS_BYTES = 8 * 2304;
constexpr int MISC_OFF = XS_OFF + XS_BYTES;
constexpr int LDS_BYTES = 160 * 1024;
static_assert(MISC_OFF + 128 <= LDS_BYTES, "LDS map");

struct Frame {
    LAS unsigned char* lds; volatile LAS unsigned* MISC; int tid, lane, wave, G, vcu;
    float* out; unsigned char* ws;
};
__device__ __forceinline__ float wave_sum(float v) {
#pragma unroll
    for (int o = 1; o < 64; o <<= 1) v += __shfl_xor(v, o);
    return v;
}
__device__ __forceinline__ void p0_transpose_item(const float* W, int ldw, int K, int src_col, bf16* WT, int dst_row, int ncols, const float* gain, LAS float* scr, int item, int lane) {
    const int nblk = ncols / 32, kb = item / nblk, nb = item % nblk, k0 = 64 * kb, n0 = 32 * nb;
#pragma unroll 8
    for (int i = 0; i < 32; ++i) { const int kk = 2 * i + (lane >> 5); const float gk = gain ? gain[k0 + kk] : 1.0f; scr[kk * 33 + (lane & 31)] = W[(size_t)(k0 + kk) * ldw + src_col + n0 + (lane & 31)] * gk; }
    LDS_WAIT(); asm volatile("" ::: "memory");
    const int c = lane & 7;
#pragma unroll
    for (int j = 0; j < 4; ++j) { const int n = (lane >> 3) + 8 * j; const LAS float* s = scr + (8 * c) * 33 + n;
        v4u o; o.x = pk2(s[0 * 33], s[1 * 33]); o.y = pk2(s[2 * 33], s[3 * 33]); o.z = pk2(s[4 * 33], s[5 * 33]); o.w = pk2(s[6 * 33], s[7 * 33]);
        *(GAS v4u*)(WT + (size_t)(dst_row + n0 + n) * K + k0 + 8 * c) = o; }
    LDS_WAIT(); asm volatile("" ::: "memory");
}
#define P0_SEG(W, ldw, K, src, WT, dst, ncols, gain) { const int n_ = ((K) / 64) * ((ncols) / 32); if (r < n_) { p0_transpose_item(W, ldw, K, src, WT, dst, ncols, gain, scr, r, F.lane); continue; } r -= n_; }
__device__ __forceinline__ void phase_p0(Frame& F, const float* x, const int* pos, const float* g_mix, const float* w_in, const float* g_qlat, const float* g_kvlat, const float* w_uq, const float* w_ukv) {
    LAS float* scr = (LAS float*)(F.lds + RING_OFF + F.wave * 16384);
    const int gw = F.vcu * NWAVES + F.wave, NGW = F.G * NWAVES;
    bf16* WinT = (bf16*)(F.ws + WS_WIN); bf16* WuqT = (bf16*)(F.ws + WS_WUQ); bf16* WukvT = (bf16*)(F.ws + WS_WUKV);
    constexpr int NIT = 16 * (2048 / 32) * 2 + 16 * (4096 / 32) + 16 * (704 / 32) + 6 * (1536 / 32) + 4 * (2048 / 32);
    for (int it = gw; it < NIT; it += NGW) {
        int r = it;
        P0_SEG(w_in, 8896, 1024, 6848, WinT, 0, 2048, g_mix)
        P0_SEG(w_in, 8896, 1024, 4096, WinT, 2048, 2048, g_mix)
        P0_SEG(w_in, 8896, 1024, 0, WinT, 4096, 4096, g_mix)
        P0_SEG(w_in, 8896, 1024, 6144, WinT, 8192, 704, g_mix)
        P0_SEG(w_uq, 1536, 384, 0, WuqT, 0, 1536, g_qlat)
        P0_SEG(w_ukv, 2048, 256, 0, WukvT, 0, 2048, g_kvlat)
    }
    { const int gt = F.vcu * 512 + F.tid; if (gt < 8192) *(GAS v4u*)((unsigned char*)(WinT + (size_t)8896 * 1024) + (size_t)gt * 16) = (v4u){0u, 0u, 0u, 0u}; }
    { bf16* XB = (bf16*)(F.ws + WS_XB); float* rstdx = (float*)(F.ws + WS_SMALL + SM_RSTDX);
      for (int m = gw; m < MTOK; m += NGW) {
          const GAS f32x4* xr = (const GAS f32x4*)(x + (size_t)m * DM) + F.lane; f32x4 v[4]; float s = 0.f;
#pragma unroll
          for (int j = 0; j < 4; ++j) { v[j] = xr[64 * j]; s += (v[j].x * v[j].x + v[j].y * v[j].y) + (v[j].z * v[j].z + v[j].w * v[j].w); }
          s = wave_sum(s);
          GAS unsigned long long* o8 = (GAS unsigned long long*)(XB + (size_t)m * DM) + F.lane;
#pragma unroll
          for (int j = 0; j < 4; ++j) o8[64 * j] = (unsigned long long)pk2(v[j].x, v[j].y) | ((unsigned long long)pk2(v[j].z, v[j].w) << 32);
          if (F.lane == 0) rstdx[m] = 1.0f / sqrtf(s * (1.0f / DM) + 1e-6f);
      } }
    { f32x2* cs = (f32x2*)(F.ws + WS_CS);
      for (int e = F.vcu * 512 + F.tid; e < MTOK * 128; e += F.G * 512) { const int row = e >> 7, i = e & 127;
          const float inv = __builtin_amdgcn_exp2f(-(float)i * (13.287712379549449f / 128.0f));
          double rev = (double)pos[row] * (double)inv * 0.15915494309189535; rev -= __builtin_rint(rev);
          const float rf = (float)rev; cs[e] = (f32x2){__builtin_amdgcn_cosf(rf), __builtin_amdgcn_sinf(rf)}; } }
    { float* z = (float*)(F.ws + WS_SMALL + SM_SSQ_CQ); for (int e = F.vcu * 512 + F.tid; e < (int)((SM_END - SM_SSQ_CQ) / 4); e += F.G * 512) z[e] = 0.f; }
}
__device__ __forceinline__ void phase_late_weights(Frame& F, const float* p, const float* w_br, const float* w_bm, const float* w_o, const float* g_mlp, const float* w_up, const float* w_down, const float* g_ple, const float* w_pg, const float* w_ple) {
    LAS float* scr = (LAS float*)(F.lds + RING_OFF + F.wave * 16384);
    const int gw = F.vcu * NWAVES + F.wave, NGW = F.G * NWAVES;
    constexpr int NIT = 32 * 32 + 16 * 32 + 16 * 32 + 16 * 128 + 64 * 32 + 16 * 32 + 4 * 32;
    for (int it = gw; it < NIT; it += NGW) {
        int r = it;
        P0_SEG(w_br, 1024, 2048, 0, (bf16*)(F.ws + WS_WBR), 0, 1024, (const float*)nullptr)
        P0_SEG(w_bm, 1024, 1024, 0, (bf16*)(F.ws + WS_WBM), 0, 1024, (const float*)nullptr)
        P0_SEG(w_o, 1024, 1024, 0, (bf16*)(F.ws + WS_WO), 0, 1024, (const float*)nullptr)
        P0_SEG(w_up, 4096, 1024, 0, (bf16*)(F.ws + WS_WUP), 0, 4096, g_mlp)
        P0_SEG(w_down, 1024, 4096, 0, (bf16*)(F.ws + WS_WDOWN), 0, 1024, (const float*)nullptr)
        P0_SEG(w_pg, 1024, 1024, 0, (bf16*)(F.ws + WS_WPG), 0, 1024, g_ple)
        P0_SEG(w_ple, 1024, 256, 0, (bf16*)(F.ws + WS_WPLE), 0, 1024, (const float*)nullptr)
    }
    { bf16* PB = (bf16*)(F.ws + WS_PB);
      for (int e = F.vcu * 512 + F.tid; e < MTOK * 256 / 8; e += F.G * 512) { const f32x4 a = *(const GAS f32x4*)(p + (size_t)e * 8), b = *(const GAS f32x4*)(p + (size_t)e * 8 + 4);
          *(GAS v4u*)(PB + (size_t)e * 8) = (v4u){pk2(a.x, a.y), pk2(a.z, a.w), pk2(b.x, b.y), pk2(b.z, b.w)}; } }
}

typedef float f32x16 __attribute__((ext_vector_type(16)));
typedef unsigned u32x2 __attribute__((ext_vector_type(2)));
typedef short v4i16_t __attribute__((ext_vector_type(4)));
__device__ __forceinline__ int crow(int r, int hi) { return (r & 3) + 8 * (r >> 2) + 4 * hi; }
typedef __bf16 bf16x2m_t __attribute__((ext_vector_type(2)));
__device__ __forceinline__ unsigned cvtpk(float lo, float hi) { f32x2 v = {lo, hi}; bf16x2m_t b = __builtin_convertvector(v, bf16x2m_t); return __builtin_bit_cast(unsigned, b); }
__device__ __forceinline__ bf16x8 pack8f(const f32x16& p, int b) { v4u w = {cvtpk(p[b], p[b + 1]), cvtpk(p[b + 2], p[b + 3]), cvtpk(p[b + 4], p[b + 5]), cvtpk(p[b + 6], p[b + 7])}; return __builtin_bit_cast(bf16x8, w); }
__device__ __forceinline__ float bf2f(bf16 v) { return __uint_as_float((unsigned)v << 16); }
__device__ __forceinline__ float log2_gamma(int h) { return __builtin_amdgcn_logf(1.0f - __builtin_amdgcn_exp2f(-5.0f - (float)h)); }

__device__ __forceinline__ void phase_r0(Frame& F) {
    const bf16* RQ = (const bf16*)(F.ws + WS_RQ); const bf16* RK = (const bf16*)(F.ws + WS_RK); const bf16* RVT = (const bf16*)(F.ws + WS_RVT); bf16* RO = (bf16*)F.out;
    const int lane = F.lane, w = F.wave, l31 = lane & 31, hi = lane >> 5, tq = w & 3, dh = w >> 2;
    for (int unit = F.vcu; unit < 512; unit += F.G) {
        const int bh = unit >> 5, c = unit & 31, b = bh >> 2, h = bh & 3; const size_t tok0 = (size_t)b * SEQ + c * 128;
        const float lg2 = log2_gamma(h);
        bf16x8 qf[16];
#pragma unroll
        for (int ks = 0; ks < 16; ++ks) qf[ks] = *(const bf16x8*)(RQ + (tok0 + 32 * tq + l31) * 1024 + h * 256 + 16 * ks + 8 * hi);
        bf16x8 pf[4][2];
#pragma unroll
        for (int tb = 0; tb < 4; ++tb) {
            pf[tb][0] = (bf16x8){0, 0, 0, 0, 0, 0, 0, 0}; pf[tb][1] = pf[tb][0];
            if (tb <= tq) {
                f32x16 s = {};
#pragma unroll
                for (int ks = 0; ks < 16; ++ks) { const bf16x8 kf = *(const bf16x8*)(RK + (tok0 + 32 * tb + l31) * 1024 + h * 256 + 16 * ks + 8 * hi); s = __builtin_amdgcn_mfma_f32_32x32x16_bf16(kf, qf[ks], s, 0, 0, 0); }
#pragma unroll
                for (int r = 0; r < 16; ++r) { const int d = (32 * tq + l31) - (32 * tb + crow(r, hi)); s[r] = d >= 0 ? s[r] * __builtin_amdgcn_exp2f((float)d * lg2) : 0.f; }
                pf[tb][0] = pack8f(s, 0); pf[tb][1] = pack8f(s, 8);
            }
        }
#pragma unroll 1
        for (int db = 0; db < 8; ++db) {
            f32x16 o = {};
#pragma unroll
            for (int tb = 0; tb < 4; ++tb)
                if (tb <= tq) {
#pragma unroll
                    for (int s2 = 0; s2 < 2; ++s2) { const bf16* vp = RVT + ((size_t)bh * 512 + 256 * dh + 32 * db + l31) * 4096 + c * 128 + 32 * tb + 16 * s2 + 4 * hi;
                        const u32x2 lo = *(const u32x2*)vp, hh = *(const u32x2*)(vp + 8); const v4u w4 = {lo.x, lo.y, hh.x, hh.y};
                        o = __builtin_amdgcn_mfma_f32_32x32x16_bf16(pf[tb][s2], __builtin_bit_cast(bf16x8, w4), o, 0, 0, 0); }
                }
#pragma unroll
            for (int r = 0; r < 16; ++r) RO[(tok0 + 32 * tq + crow(r, hi)) * 2048 + h * 512 + 256 * dh + 32 * db + l31] = (bf16)f2bf(o[r]);
        }
    }
}
__device__ __forceinline__ void phase_r1(Frame& F) {
    const bf16* RQ = (const bf16*)(F.ws + WS_RQ); const bf16* RKDT = (const bf16*)(F.ws + WS_RKDT); const bf16* RVT = (const bf16*)(F.ws + WS_RVT); bf16* RO = (bf16*)F.out;
    float* ssq_ro = (float*)(F.ws + WS_SMALL + SM_SSQ_RO);
    const int lane = F.lane, w = F.wave, l31 = lane & 31, hi = lane >> 5, l15 = lane & 15, lq = lane >> 4;
    constexpr int SROW = 528, SBUF = 32 * SROW;
    for (int unit = F.vcu; unit < 256; unit += F.G) {
        const int bh = unit >> 4, j = unit & 15, b = bh >> 2, h = bh & 3;
        const float lg2 = log2_gamma(h), gC = __builtin_amdgcn_exp2f(128.0f * lg2);
        f32x16 S = {};
        __syncthreads();
#pragma unroll
        for (int g = 0; g < 4; ++g) *(LAS u32x2*)(F.lds + l31 * SROW + (32 * w + 8 * g + 4 * hi) * 2) = (u32x2){0u, 0u};
        for (int c = 0; c < 32; ++c) {
            const int cur = c & 1; const size_t tok0 = (size_t)b * SEQ + c * 128;
            __syncthreads();
            f32x4 oi[2] = {(f32x4){0.f, 0.f, 0.f, 0.f}, (f32x4){0.f, 0.f, 0.f, 0.f}};
#pragma unroll
            for (int ks = 0; ks < 8; ++ks) { const bf16x8 a = *(const bf16x8*)(RQ + (tok0 + 16 * w + l15) * 1024 + h * 256 + 32 * ks + 8 * lq);
#pragma unroll
                for (int nb = 0; nb < 2; ++nb) { const bf16x8 bq = *(const LAS bf16x8*)(F.lds + cur * SBUF + (16 * nb + l15) * SROW + (32 * ks + 8 * lq) * 2);
                    oi[nb] = __builtin_amdgcn_mfma_f32_16x16x32_bf16(a, bq, oi[nb], 0, 0, 0); } }
#pragma unroll
            for (int i = 0; i < 4; ++i) { const int tt = 16 * w + 4 * lq + i; const float qd = __builtin_amdgcn_exp2f((float)(tt + 1) * lg2); float q = 0.f;
#pragma unroll
                for (int nb = 0; nb < 2; ++nb) { bf16* p = RO + (tok0 + tt) * 2048 + h * 512 + 32 * j + 16 * nb + l15; const float v = bf2f(*p) + qd * oi[nb][i]; *p = (bf16)f2bf(v); q += v * v; }
                q += __shfl_xor(q, 1); q += __shfl_xor(q, 2); q += __shfl_xor(q, 4); q += __shfl_xor(q, 8);
                if (l15 == 0) atomicAdd(ssq_ro + (tok0 + tt) * 4 + h, q); }
#pragma unroll
            for (int r = 0; r < 16; ++r) S[r] *= gC;
#pragma unroll
            for (int ks = 0; ks < 8; ++ks) { const bf16x8 a = *(const bf16x8*)(RKDT + ((size_t)bh * 256 + 32 * w + l31) * 4096 + c * 128 + 16 * ks + 8 * hi);
                const bf16x8 bv = *(const bf16x8*)(RVT + ((size_t)bh * 512 + 32 * j + l31) * 4096 + c * 128 + 16 * ks + 8 * hi);
                S = __builtin_amdgcn_mfma_f32_32x32x16_bf16(a, bv, S, 0, 0, 0); }
#pragma unroll
            for (int g = 0; g < 4; ++g) *(LAS u32x2*)(F.lds + (cur ^ 1) * SBUF + l31 * SROW + (32 * w + 8 * g + 4 * hi) * 2) = (u32x2){cvtpk(S[4 * g], S[4 * g + 1]), cvtpk(S[4 * g + 2], S[4 * g + 3])};
        }
    }
    __syncthreads();
}
__device__ __forceinline__ void phase_fin(Frame& F, const float* qn, const float* kn) {
    bf16* QP = (bf16*)(F.ws + WS_QP); const bf16* KVP = (const bf16*)(F.ws + WS_KVP); const bf16* LAT = (const bf16*)(F.ws + WS_LAT); bf16* KF = (bf16*)(F.ws + WS_KF);
    const f32x2* cs = (const f32x2*)(F.ws + WS_CS);
    const int gw = F.vcu * NWAVES + F.wave, NGW = F.G * NWAVES, lane = F.lane, h = lane >> 3, part = lane & 7;
    for (int tok = gw; tok < MTOK; tok += NGW) {
#pragma unroll
        for (int which = 0; which < 2; ++which) {
            float v[3][8]; float ssq = 0.f;
#pragma unroll
            for (int r = 0; r < 3; ++r) { v4u wv;
                if (which == 0) wv = *(const v4u*)(QP + (size_t)tok * 1536 + h * 192 + 64 * r + 8 * part);
                else if (r < 2) wv = *(const v4u*)(KVP + (size_t)tok * 2048 + h * 256 + 64 * r + 8 * part);
                else wv = *(const v4u*)(LAT + (size_t)tok * LATW + 640 + 8 * part);
                const unsigned ww[4] = {wv.x, wv.y, wv.z, wv.w};
#pragma unroll
                for (int e = 0; e < 4; ++e) { v[r][2 * e] = __uint_as_float(ww[e] << 16); v[r][2 * e + 1] = __uint_as_float(ww[e] & 0xffff0000u); }
#pragma unroll
                for (int e = 0; e < 8; ++e) ssq += v[r][e] * v[r][e]; }
            ssq += __shfl_xor(ssq, 1); ssq += __shfl_xor(ssq, 2); ssq += __shfl_xor(ssq, 4);
            const float sc = (1.0f / sqrtf(ssq * (1.0f / 192.0f) + 1e-6f)) * (which == 0 ? C2Q : 1.0f);
            const float* gn = which == 0 ? qn : kn;
            bf16* dst = which == 0 ? QP + (size_t)tok * 1536 + h * 192 : KF + (size_t)tok * 1536 + h * 192;
#pragma unroll
            for (int r = 0; r < 3; ++r) {
                float y[8];
#pragma unroll
                for (int e = 0; e < 8; ++e) y[e] = v[r][e] * sc * gn[64 * r + 8 * part + e];
                if (r == 2) {
#pragma unroll
                    for (int e = 0; e < 8; ++e) { const float pr = __shfl_xor(y[e], 4); const f32x2 c = cs[(size_t)tok * 128 + 4 * (8 * (part & 3) + e)];
                        y[e] = part < 4 ? y[e] * c.x - pr * c.y : y[e] * c.x + pr * c.y; }
                }
                *(v4u*)(dst + 64 * r + 8 * part) = (v4u){pk2(y[0], y[1]), pk2(y[2], y[3]), pk2(y[4], y[5]), pk2(y[6], y[7])};
            }
        }
    }
}
__device__ __forceinline__ void phase_attn(Frame& F) {
    const bf16* QP = (const bf16*)(F.ws + WS_QP); const bf16* KVP = (const bf16*)(F.ws + WS_KVP); const bf16* KF = (const bf16*)(F.ws + WS_KF); bf16* MO = (bf16*)(F.ws + WS_MO);
    const int lane = F.lane, w = F.wave, l31 = lane & 31, hi = lane >> 5;
    LAS unsigned char* vst = F.lds + w * 9216; LAS float* al = (LAS float*)(vst + 8704); LAS float* li = al + 32;
    constexpr int VROW = 272;
    const int trb = (4 * hi + ((lane & 15) >> 2)) * VROW + (16 * ((lane >> 4) & 1) + 4 * (lane & 3)) * 2;
    for (int v = F.vcu; v < 256; v += F.G) {
#pragma unroll 1
        for (int half = 0; half < 2; ++half) {
            const int qb = half == 0 ? 15 - (v >> 5) : (v >> 5), bh = v & 31, b = bh >> 3, h = bh & 7;
            const int q0 = qb * 256 + 32 * w; const size_t tb = (size_t)b * SEQ;
            bf16x8 qr[12];
#pragma unroll
            for (int d = 0; d < 12; ++d) qr[d] = *(const bf16x8*)(QP + (tb + q0 + l31) * 1536 + h * 192 + 16 * d + 8 * hi);
            float m_run = -1e30f, l_run = 0.f; f32x16 o[4] = {};
            const int nkt = q0 / 32 + 1;
#pragma unroll 1
            for (int kt = 0; kt < nkt; ++kt) {
                const int k0 = kt * 32;
#pragma unroll
                for (int i = 0; i < 8; ++i) { const int idx = lane + 64 * i, row = idx >> 4, ch = idx & 15;
                    const v4u vv = *(const v4u*)(KVP + (tb + k0 + row) * 2048 + h * 256 + 128 + ch * 8); *(LAS v4u*)(vst + row * VROW + ch * 16) = vv; }
                f32x16 p = {};
#pragma unroll
                for (int d = 0; d < 12; ++d) { const bf16x8 kf = *(const bf16x8*)(KF + (tb + k0 + l31) * 1536 + h * 192 + 16 * d + 8 * hi); p = __builtin_amdgcn_mfma_f32_32x32x16_bf16(kf, qr[d], p, 0, 0, 0); }
                if (kt == nkt - 1) {
#pragma unroll
                    for (int r = 0; r < 16; ++r) if (crow(r, hi) > l31) p[r] = -__builtin_inff();
                }
                float pmax = p[0];
#pragma unroll
                for (int r = 1; r < 16; ++r) pmax = fmaxf(pmax, p[r]);
                pmax = fmaxf(pmax, __shfl_xor(pmax, 32));
                const float mn = fmaxf(m_run, pmax), alpha = __builtin_amdgcn_exp2f(m_run - mn); m_run = mn;
                float ps = 0.f;
#pragma unroll
                for (int r = 0; r < 16; ++r) { p[r] = __builtin_amdgcn_exp2f(p[r] - mn); ps += p[r]; }
                ps += __shfl_xor(ps, 32); l_run = l_run * alpha + ps;
                if (hi == 0) al[l31] = alpha;
                const bf16x8 pa0 = pack8f(p, 0), pa1 = pack8f(p, 8);
                LDS_WAIT();
#pragma unroll
                for (int r = 0; r < 16; ++r) { const float a = al[crow(r, hi)];
#pragma unroll
                    for (int db = 0; db < 4; ++db) o[db][r] *= a; }
#pragma unroll
                for (int db = 0; db < 4; ++db)
#pragma unroll
                    for (int s2 = 0; s2 < 2; ++s2) { LAS unsigned char* ap = vst + trb + (16 * s2) * VROW + db * 64;
                        const v4i16_t lo = __builtin_amdgcn_ds_read_tr16_b64_v4i16((LAS v4i16_t*)ap), hh = __builtin_amdgcn_ds_read_tr16_b64_v4i16((LAS v4i16_t*)(ap + 8 * VROW));
                        const bf16x8 bfv = (bf16x8){lo[0], lo[1], lo[2], lo[3], hh[0], hh[1], hh[2], hh[3]};
                        o[db] = __builtin_amdgcn_mfma_f32_32x32x16_bf16(s2 == 0 ? pa0 : pa1, bfv, o[db], 0, 0, 0); }
                LDS_WAIT();
            }
            if (hi == 0) li[l31] = l_run;
            LDS_WAIT();
#pragma unroll
            for (int r = 0; r < 16; ++r) { const float il = 1.0f / li[crow(r, hi)];
#pragma unroll
                for (int db = 0; db < 4; ++db) MO[(tb + q0 + crow(r, hi)) * 1024 + h * 128 + 32 * db + l31] = (bf16)f2bf(o[db][r] * il); }
            LDS_WAIT();
        }
    }
}

__device__ __forceinline__ void phase_r0p(Frame& F) {
    const bf16* RQ = (const bf16*)(F.ws + WS_RQ); bf16* RK = (bf16*)(F.ws + WS_RK);
    const int lane = F.lane, w = F.wave, l31 = lane & 31, hi = lane >> 5, tq = w & 3, dh = w >> 2;
    for (int unit = F.vcu; unit < 512; unit += F.G) {
        const int bh = unit >> 5, c = unit & 31, b = bh >> 2, h = bh & 3; const size_t tok0 = (size_t)b * SEQ + c * 128;
        const float lg2 = log2_gamma(h);
        bf16x8 qf[16];
#pragma unroll
        for (int ks = 0; ks < 16; ++ks) qf[ks] = *(const bf16x8*)(RQ + (tok0 + 32 * tq + l31) * 1024 + h * 256 + 16 * ks + 8 * hi);
        f32x16 s[2] = {};
#pragma unroll
        for (int x = 0; x < 2; ++x) { const int tb = 2 * dh + x;
            if (tb <= tq) {
#pragma unroll
                for (int ks = 0; ks < 16; ++ks) { const bf16x8 kf = *(const bf16x8*)(RK + (tok0 + 32 * tb + l31) * 1024 + h * 256 + 16 * ks + 8 * hi); s[x] = __builtin_amdgcn_mfma_f32_32x32x16_bf16(kf, qf[ks], s[x], 0, 0, 0); }
#pragma unroll
                for (int r = 0; r < 16; ++r) { const int d = (32 * tq + l31) - (32 * tb + crow(r, hi)); s[x][r] = d >= 0 ? s[x][r] * __builtin_amdgcn_exp2f((float)d * lg2) : 0.f; }
            } }
        VM_WAIT(); __syncthreads();
#pragma unroll
        for (int x = 0; x < 2; ++x) { const int tb = 2 * dh + x;
            if (tb <= tq) {
#pragma unroll
                for (int g = 0; g < 4; ++g) *(u32x2*)(RK + (tok0 + 32 * tq + l31) * 1024 + h * 256 + 32 * tb + 8 * g + 4 * hi) = (u32x2){cvtpk(s[x][4 * g], s[x][4 * g + 1]), cvtpk(s[x][4 * g + 2], s[x][4 * g + 3])};
            } }
    }
}
__device__ __forceinline__ void phase_r1p(Frame& F) {
    const bf16* RQ = (const bf16*)(F.ws + WS_RQ); const bf16* RP = (const bf16*)(F.ws + WS_RK); const bf16* RKDT = (const bf16*)(F.ws + WS_RKDT); const bf16* RVT = (const bf16*)(F.ws + WS_RVT); bf16* RO = (bf16*)F.out;
    float* ssq_ro = (float*)(F.ws + WS_SMALL + SM_SSQ_RO);
    const int lane = F.lane, w = F.wave, l15 = lane & 15, lq = lane >> 4;
    constexpr int SROW = 528, SBUF = 32 * SROW;
    const int nkp = (w >> 1) + 1;
    for (int unit = F.vcu; unit < 256; unit += F.G) {
        const int bh = unit >> 4, j = unit & 15, b = bh >> 2, h = bh & 3;
        const float lg2 = log2_gamma(h), gC = __builtin_amdgcn_exp2f(128.0f * lg2);
        float qd[4];
#pragma unroll
        for (int i = 0; i < 4; ++i) qd[i] = __builtin_amdgcn_exp2f((float)(16 * w + 4 * lq + i + 1) * lg2);
        f32x4 S[2][2];
#pragma unroll
        for (int mb = 0; mb < 2; ++mb)
#pragma unroll
            for (int nb = 0; nb < 2; ++nb) S[mb][nb] = (f32x4){0.f, 0.f, 0.f, 0.f};
        __syncthreads();
#pragma unroll
        for (int mb = 0; mb < 2; ++mb)
#pragma unroll
            for (int nb = 0; nb < 2; ++nb) *(LAS u32x2*)(F.lds + (16 * nb + l15) * SROW + (32 * w + 16 * mb + 4 * lq) * 2) = (u32x2){0u, 0u};
        const bf16* qp = RQ + ((size_t)b * SEQ + 16 * w + l15) * 1024 + h * 256 + 8 * lq;
        const bf16* pp = RP + ((size_t)b * SEQ + 16 * w + l15) * 1024 + h * 256 + 8 * lq;
        const bf16* kp = RKDT + ((size_t)bh * 256 + 32 * w + l15) * 4096 + 8 * lq;
        const bf16* vp = RVT + ((size_t)bh * 512 + 32 * j + l15) * 4096 + 8 * lq;
        bf16x8 QA[8], PA[4], KA[2][4], VB[2][4];
#pragma unroll
        for (int ks = 0; ks < 8; ++ks) QA[ks] = *(const bf16x8*)(qp + 32 * ks);
#pragma unroll
        for (int ks = 0; ks < 4; ++ks) { PA[ks] = (bf16x8){0, 0, 0, 0, 0, 0, 0, 0}; if (ks < nkp) PA[ks] = *(const bf16x8*)(pp + 32 * ks); }
#pragma unroll
        for (int mb = 0; mb < 2; ++mb)
#pragma unroll
            for (int ks = 0; ks < 4; ++ks) { KA[mb][ks] = *(const bf16x8*)(kp + (size_t)mb * 16 * 4096 + 32 * ks); VB[mb][ks] = *(const bf16x8*)(vp + (size_t)mb * 16 * 4096 + 32 * ks); }
#pragma unroll 1
        for (int c = 0; c < 32; ++c) {
            const int cur = c & 1, cn = c < 31 ? c + 1 : 31; const size_t tok0 = (size_t)b * SEQ + c * 128;
            __syncthreads();
            f32x4 oc[2] = {(f32x4){0.f, 0.f, 0.f, 0.f}, (f32x4){0.f, 0.f, 0.f, 0.f}};
#pragma unroll
            for (int ks = 0; ks < 8; ++ks)
#pragma unroll
                for (int nb = 0; nb < 2; ++nb) { const bf16x8 bq = *(const LAS bf16x8*)(F.lds + cur * SBUF + (16 * nb + l15) * SROW + (32 * ks + 8 * lq) * 2);
                    oc[nb] = __builtin_amdgcn_mfma_f32_16x16x32_bf16(QA[ks], bq, oc[nb], 0, 0, 0); }
#pragma unroll
            for (int ks = 0; ks < 8; ++ks) QA[ks] = *(const bf16x8*)(qp + (size_t)cn * 128 * 1024 + 32 * ks);
#pragma unroll
            for (int nb = 0; nb < 2; ++nb)
#pragma unroll
                for (int i = 0; i < 4; ++i) oc[nb][i] *= qd[i];
#pragma unroll
            for (int ks = 0; ks < 4; ++ks)
                if (ks < nkp) {
#pragma unroll
                    for (int nb = 0; nb < 2; ++nb) oc[nb] = __builtin_amdgcn_mfma_f32_16x16x32_bf16(PA[ks], VB[nb][ks], oc[nb], 0, 0, 0); }
#pragma unroll
            for (int ks = 0; ks < 4; ++ks) if (ks < nkp) PA[ks] = *(const bf16x8*)(pp + (size_t)cn * 128 * 1024 + 32 * ks);
#pragma unroll
            for (int mb = 0; mb < 2; ++mb)
#pragma unroll
                for (int nb = 0; nb < 2; ++nb) { S[mb][nb] *= gC;
#pragma unroll
                    for (int ks = 0; ks < 4; ++ks) S[mb][nb] = __builtin_amdgcn_mfma_f32_16x16x32_bf16(KA[mb][ks], VB[nb][ks], S[mb][nb], 0, 0, 0); }
#pragma unroll
            for (int mb = 0; mb < 2; ++mb)
#pragma unroll
                for (int ks = 0; ks < 4; ++ks) { KA[mb][ks] = *(const bf16x8*)(kp + (size_t)mb * 16 * 4096 + cn * 128 + 32 * ks); VB[mb][ks] = *(const bf16x8*)(vp + (size_t)mb * 16 * 4096 + cn * 128 + 32 * ks); }
#pragma unroll
            for (int i = 0; i < 4; ++i) { const int tt = 16 * w + 4 * lq + i; float q = 0.f;
#pragma unroll
                for (int nb = 0; nb < 2; ++nb) { const float v = oc[nb][i], vn = __shfl_xor(v, 1); q += v * v;
                    if ((l15 & 1) == 0) *(unsigned*)(RO + (tok0 + tt) * 2048 + h * 512 + 32 * j + 16 * nb + l15) = cvtpk(v, vn); }
                q += __shfl_xor(q, 1); q += __shfl_xor(q, 2); q += __shfl_xor(q, 4); q += __shfl_xor(q, 8);
                if (l15 == 0) atomicAdd(ssq_ro + (tok0 + tt) * 4 + h, q); }
#pragma unroll
            for (int mb = 0; mb < 2; ++mb)
#pragma unroll
                for (int nb = 0; nb < 2; ++nb) *(LAS u32x2*)(F.lds + (cur ^ 1) * SBUF + (16 * nb + l15) * SROW + (32 * w + 16 * mb + 4 * lq) * 2) = (u32x2){cvtpk(S[mb][nb][0], S[mb][nb][1]), cvtpk(S[mb][nb][2], S[mb][nb][3])};
        }
    }
    __syncthreads();
}

namespace attn2 {
typedef float f32x16 __attribute__((ext_vector_type(16)));
typedef short s16x4 __attribute__((ext_vector_type(4)));
constexpr int NW = 8, QBLK = 32, KVBLK = 64, QB = NW * QBLK;
constexpr int QS = 1536, KS = 1536, VS = 2048, OS = 1024;
constexpr int SHM_V = KVBLK * 128 * 2, SHM_K = KVBLK * 512;
constexpr int OFF_V = 0, OFF_K = 2 * SHM_V, OFF_WS = OFF_K + 2 * SHM_K, OFF_QR = OFF_WS + NW * 64 * 4, LDS_NEED = OFF_QR + NW * 4096;
constexpr float THR2 = 8.0f * 1.4426950408889634f;
#define A2_SBAR() __builtin_amdgcn_sched_barrier(0)
__device__ __forceinline__ int v_st(int k, int c) { const int kk = (k & ~0xC) | ((k & 4) << 1) | ((k & 8) >> 1); return ((kk >> 3) * 4 + (c >> 5)) * 512 + ((kk & 7) * 32 + (c & 31)) * 2; }
__device__ __forceinline__ int v_rd_base(int lane) { return ((lane & 3) << 3) | (((lane >> 2) & 3) << 6) | (((lane >> 4) & 1) << 5) | (((lane >> 5) & 1) << 8); }
constexpr int v_rd_off(int d0, int ks, int half) { return d0 * 512 + ks * 4096 + half * 2048; }
__device__ __forceinline__ int crow(int r, int hi) { return (r & 3) + 8 * (r >> 2) + 4 * hi; }
typedef __bf16 bf16x2a_t __attribute__((ext_vector_type(2)));
__device__ __forceinline__ unsigned cvtpk(float lo, float hi) { f32x2 v = {lo, hi}; bf16x2a_t b = __builtin_convertvector(v, bf16x2a_t); return __builtin_bit_cast(unsigned, b); }
__device__ __forceinline__ bf16x8 load8(const bf16* p) { return *reinterpret_cast<const bf16x8*>(p); }
__device__ __forceinline__ void mask_tile(f32x16& p0, f32x16& p1, int dq) {
    const float NEG = -__builtin_inff();
#pragma unroll
    for (int r = 0; r < 16; ++r) { const int c = (r & 3) + 8 * (r >> 2); if (dq - c < 0) p0[r] = NEG; if (dq - c - 32 < 0) p1[r] = NEG; }
}
__device__ __forceinline__ void partialSM(f32x16& p0, f32x16& p1, float& m_reg, float& mn, float& alpha) {
    float pmax = p0[0];
#pragma unroll
    for (int r = 1; r < 16; ++r) pmax = fmaxf(pmax, p0[r]);
#pragma unroll
    for (int r = 0; r < 16; ++r) pmax = fmaxf(pmax, p1[r]);
    { auto rr = __builtin_amdgcn_permlane32_swap(__float_as_uint(pmax), __float_as_uint(pmax), false, false); pmax = fmaxf(__uint_as_float(rr[0]), __uint_as_float(rr[1])); }
    if (__builtin_expect(__all((pmax - m_reg) <= THR2), 1)) { mn = m_reg; alpha = 1.f; }
    else { mn = fmaxf(m_reg, pmax); alpha = __builtin_amdgcn_exp2f(m_reg - mn); m_reg = mn; }
#pragma unroll
    for (int r = 0; r < 16; ++r) { p0[r] -= mn; p1[r] -= mn; }
#pragma unroll
    for (int r = 0; r < 16; ++r) p0[r] = __builtin_amdgcn_exp2f(p0[r]);
}
__device__ __forceinline__ void finishSM(f32x16& p0, f32x16& p1, float alpha, float& l_reg, bf16x8& pa0, bf16x8& pa1, bf16x8& pa2, bf16x8& pa3) {
#pragma unroll
    for (int r = 0; r < 16; ++r) p1[r] = __builtin_amdgcn_exp2f(p1[r]);
    float ps = 0;
#pragma unroll
    for (int r = 0; r < 16; ++r) ps += p0[r];
#pragma unroll
    for (int r = 0; r < 16; ++r) ps += p1[r];
    { auto rr = __builtin_amdgcn_permlane32_swap(__float_as_uint(ps), __float_as_uint(ps), false, false); ps = __uint_as_float(rr[0]) + __uint_as_float(rr[1]); }
    l_reg = l_reg * alpha + ps;
#define A2_PK4(P, B_, OUT) do { unsigned a0 = cvtpk(P[B_+0], P[B_+1]), a1 = cvtpk(P[B_+2], P[B_+3]); unsigned b0 = cvtpk(P[B_+4], P[B_+5]), b1 = cvtpk(P[B_+6], P[B_+7]); \
        auto r0 = __builtin_amdgcn_permlane32_swap(a0, b0, false, false); auto r1 = __builtin_amdgcn_permlane32_swap(a1, b1, false, false); \
        v4u w = {r0[0], r1[0], r0[1], r1[1]}; OUT = __builtin_bit_cast(bf16x8, w); } while (0)
    A2_PK4(p0, 0, pa0); A2_PK4(p0, 8, pa1); A2_PK4(p1, 0, pa2); A2_PK4(p1, 8, pa3);
#undef A2_PK4
}
template <int KB>
__device__ __forceinline__ void qkt(f32x16& p0, f32x16& p1, const char* K_lds, const char* qr_lds, int r32, int hi, const bf16x8* qr) {
    p0 = f32x16{}; p1 = f32x16{};
    const char* kbase = K_lds + KB * SHM_K + r32 * 512; const int x = r32 & 15;
#pragma unroll
    for (int d = 0; d < 12; ++d) { const char* a = kbase + ((((2 * d + hi) & 15) ^ x) << 4) + (d >= 8 ? 256 : 0);
        const bf16x8 b0 = *reinterpret_cast<const bf16x8*>(a), b1 = *reinterpret_cast<const bf16x8*>(a + 32 * 512);
        const bf16x8 q = d < 8 ? qr[d < 8 ? d : 0] : *reinterpret_cast<const bf16x8*>(qr_lds + (((d - 8) * 2 + hi) * 32 + r32) * 16);
        p0 = __builtin_amdgcn_mfma_f32_32x32x16_bf16(b0, q, p0, 0, 0, 0);
        p1 = __builtin_amdgcn_mfma_f32_32x32x16_bf16(b1, q, p1, 0, 0, 0); }
}
template <int VB>
__device__ __forceinline__ void pv_tile(f32x16* o, int vb0, bf16x8 pa0, bf16x8 pa1, bf16x8 pa2, bf16x8 pa3) {
#define A2_TRRD(dst, off) asm volatile("ds_read_b64_tr_b16 %0, %1 offset:%2" : "=&v"(dst) : "v"(vb0), "i"(off) : "memory")
#define A2_PV_D0(d0) do { s16x4 l0, l1, l2, l3, h0, h1, h2, h3; constexpr int b_ = VB * SHM_V + v_rd_off(d0, 0, 0); \
        A2_TRRD(l0, b_); A2_TRRD(h0, b_ + 2048); A2_TRRD(l1, b_ + 4096); A2_TRRD(h1, b_ + 6144); A2_TRRD(l2, b_ + 8192); A2_TRRD(h2, b_ + 10240); A2_TRRD(l3, b_ + 12288); A2_TRRD(h3, b_ + 14336); \
        asm volatile("s_waitcnt lgkmcnt(0)" ::: "memory"); A2_SBAR(); \
        o[d0] = __builtin_amdgcn_mfma_f32_32x32x16_bf16(pa0, (bf16x8){l0[0], l0[1], l0[2], l0[3], h0[0], h0[1], h0[2], h0[3]}, o[d0], 0, 0, 0); \
        o[d0] = __builtin_amdgcn_mfma_f32_32x32x16_bf16(pa1, (bf16x8){l1[0], l1[1], l1[2], l1[3], h1[0], h1[1], h1[2], h1[3]}, o[d0], 0, 0, 0); \
        o[d0] = __builtin_amdgcn_mfma_f32_32x32x16_bf16(pa2, (bf16x8){l2[0], l2[1], l2[2], l2[3], h2[0], h2[1], h2[2], h2[3]}, o[d0], 0, 0, 0); \
        o[d0] = __builtin_amdgcn_mfma_f32_32x32x16_bf16(pa3, (bf16x8){l3[0], l3[1], l3[2], l3[3], h3[0], h3[1], h3[2], h3[3]}, o[d0], 0, 0, 0); } while (0)
    A2_PV_D0(0); A2_PV_D0(1); A2_PV_D0(2); A2_PV_D0(3);
#undef A2_PV_D0
#undef A2_TRRD
}
struct BlockRef { const bf16* Q; const bf16* K; const bf16* V; bf16* O; int P0; };
struct Seam { bf16x8 qr[8]; bf16x8 st_v0, st_v1, st_k0, st_k1, st_k2; };
#define A2_VMW() asm volatile("s_waitcnt vmcnt(0)" ::: "memory")
#define A2_VMWN(n) asm volatile("s_waitcnt vmcnt(%0)" :: "i"(n) : "memory")
#define A2_SLOAD(Kp, Vp, k0) do { S.st_v0 = load8((Vp) + (size_t)((k0) + sr) * VS + sc); S.st_v1 = load8((Vp) + (size_t)((k0) + 32 + sr) * VS + sc); \
        const bf16* kp_ = (Kp) + (size_t)((k0) + krow) * KS + kc * 8; S.st_k0 = load8(kp_); S.st_k1 = load8(kp_ + 64); S.st_k2 = load8(kp_ + 128); } while (0)
#define A2_SWRITE_K(bf) do { *(bf16x8*)(K_lds + (bf) * SHM_K + kw0) = S.st_k0; *(bf16x8*)(K_lds + (bf) * SHM_K + kw1) = S.st_k1; *(bf16x8*)(K_lds + (bf) * SHM_K + kw0 + 256) = S.st_k2; } while (0)
#define A2_SWRITE_V(bf) do { *(bf16x8*)(V_lds + (bf) * SHM_V + vst0) = S.st_v0; *(bf16x8*)(V_lds + (bf) * SHM_V + vst1) = S.st_v1; } while (0)
#define A2_SWRITE(bf) do { A2_SWRITE_V(bf); A2_SWRITE_K(bf); } while (0)
#define A2_IDX const int tid = threadIdx.x, wid = __builtin_amdgcn_readfirstlane(tid >> 6), lane = tid & 63, r32 = lane & 31, hi = lane >> 5; \
    const int sr = tid >> 4, sc = (tid & 15) * 8, krow = tid >> 3, kc = tid & 7, kw0 = krow * 512 + ((kc ^ (krow & 15)) << 4), kw1 = krow * 512 + (((kc + 8) ^ (krow & 15)) << 4); \
    char* V_lds = lds + OFF_V; char* K_lds = lds + OFF_K; (void)lane; (void)r32; (void)hi; (void)sr; (void)sc; (void)V_lds
__device__ __forceinline__ void attn_prime(const BlockRef& cur, char* lds, Seam& S) {
    A2_IDX;
#pragma unroll
    for (int d0 = 0; d0 < 8; ++d0) S.qr[d0] = load8(cur.Q + (size_t)(wid * QBLK + r32) * QS + d0 * 16 + hi * 8);
    A2_SLOAD(cur.K, cur.V, 0); A2_VMW(); A2_SWRITE_K(0);
}
__device__ __forceinline__ void attn_block(const BlockRef& cur, const BlockRef& nxt, char* lds, Seam& S) {
    A2_IDX;
    const int NT = (cur.P0 + QB) / KVBLK;
    const int qlo = cur.P0 + wid * QBLK, qm = qlo + r32 - 4 * hi;
    float* ws = (float*)(lds + OFF_WS) + wid * 64; float* li_l = ws, * al_l = ws + 32;
    char* qr_lds = lds + OFF_QR + wid * 4096;
    float m_reg = -1e30f, l_reg = 0; f32x16 o[4] = {};
    const int vst0 = v_st(sr, sc), vst1 = v_st(32 + sr, sc);
    const int vb0 = (int)(uintptr_t)V_lds + v_rd_base(lane);
    const bf16* Kh = cur.K; const bf16* Vh = cur.V;
    { bf16x8 t4[4];
#pragma unroll
      for (int d = 0; d < 4; ++d) t4[d] = load8(cur.Q + (size_t)(wid * QBLK + r32) * QS + 128 + d * 16 + hi * 8);
#pragma unroll
      for (int d = 0; d < 4; ++d) *(bf16x8*)(qr_lds + ((d * 2 + hi) * 32 + r32) * 16) = t4[d]; }
    A2_SWRITE_V(0);
    __syncthreads();
    f32x16 p0, p1; float mn, al; bf16x8 pa0, pa1, pa2, pa3;
#define A2_STEP(t, BUF) do { const bool lastt = (t) + 1 >= NT; \
        A2_SBAR(); { const bf16* Kn = lastt ? nxt.K : Kh; const bf16* Vn = lastt ? nxt.V : Vh; const int k0n = lastt ? 0 : ((t) + 1) * KVBLK; A2_SLOAD(Kn, Vn, k0n); } A2_SBAR(); \
        qkt<BUF>(p0, p1, K_lds, qr_lds, r32, hi, S.qr); \
        if (lastt) { A2_SBAR(); _Pragma("unroll") for (int d0 = 0; d0 < 8; ++d0) S.qr[d0] = load8(nxt.Q + (size_t)(wid * QBLK + r32) * QS + d0 * 16 + hi * 8); A2_SBAR(); } \
        { const int kb_ = (t) * KVBLK; if (kb_ + KVBLK - 1 > qlo) mask_tile(p0, p1, qm - kb_); } \
        partialSM(p0, p1, m_reg, mn, al); finishSM(p0, p1, al, l_reg, pa0, pa1, pa2, pa3); \
        if (__any(al < 1.f)) { if (hi == 0) al_l[r32] = al; asm volatile("s_waitcnt lgkmcnt(0)" ::: "memory"); \
            for (int d_ = 0; d_ < 4; ++d_) for (int r = 0; r < 16; ++r) o[d_][r] *= al_l[crow(r, hi)]; } \
        A2_SBAR(); pv_tile<BUF>(o, vb0, pa0, pa1, pa2, pa3); A2_SBAR(); \
        if (lastt) { A2_VMWN(8); A2_SWRITE_K(0); } else { A2_VMW(); A2_SWRITE((BUF) ^ 1); } \
        __syncthreads(); } while (0)
    for (int t = 0; t < NT; t += 2) { A2_STEP(t, 0); A2_STEP(t + 1, 1); }
#undef A2_STEP
    if (hi == 0) li_l[r32] = l_reg; asm volatile("s_waitcnt lgkmcnt(0)" ::: "memory");
    float rli[16];
#pragma unroll
    for (int r = 0; r < 16; ++r) rli[r] = __builtin_amdgcn_rcpf(li_l[crow(r, hi)]);
    bf16* Ow = cur.O + (size_t)(wid * QBLK) * OS;
#pragma unroll
    for (int r = 0; r < 16; ++r) { const int orow = crow(r, hi);
#pragma unroll
        for (int d0 = 0; d0 < 4; ++d0) { const float v = o[d0][r] * rli[r]; const float vn = __shfl_xor(v, 1);
            if ((r32 & 1) == 0) *(unsigned*)(Ow + (size_t)orow * OS + d0 * 32 + r32) = cvtpk(v, vn); } }
    asm volatile("s_waitcnt lgkmcnt(0)" ::: "memory");
}
}
__device__ __forceinline__ attn2::BlockRef attn2_ref(unsigned char* ws, int v, int pass) {
    const int bh = v >> 3, b = bh >> 3, h = bh & 7, x = v & 7, qb = pass ? 15 - x : x;
    attn2::BlockRef r;
    r.Q = (const bf16*)(ws + WS_QP) + ((size_t)b * SEQ + qb * 256) * 1536 + h * 192; r.K = (const bf16*)(ws + WS_KF) + (size_t)b * SEQ * 1536 + h * 192;
    r.V = (const bf16*)(ws + WS_KVP) + (size_t)b * SEQ * 2048 + h * 256 + 128; r.O = (bf16*)(ws + WS_MO) + ((size_t)b * SEQ + qb * 256) * 1024 + h * 128; r.P0 = qb * 256;
    return r;
}
__device__ __forceinline__ void phase_attn2(Frame& F, char* lds) {
    int L = F.vcu; if (L >= 256) return;
    attn2::Seam S; int pass = 0;
    attn2::BlockRef cur = attn2_ref(F.ws, L, 0);
    attn2::attn_prime(cur, lds, S);
    for (;;) {
        const bool more_pass = pass == 0, more_item = L + F.G < 256, last = !more_pass && !more_item;
        int passn = pass + 1, Ln = L;
        if (!more_pass) { passn = 0; Ln = more_item ? L + F.G : L; }
        const attn2::BlockRef nxt = last ? cur : attn2_ref(F.ws, Ln, passn);
        attn2::attn_block(cur, nxt, lds, S);
        if (last) break;
        cur = nxt; pass = passn; L = Ln;
    }
}

#ifndef MK_N_LAUNCHES
#define MK_N_LAUNCHES 13
#endif
constexpr int N_PHASES = 13;
constexpr int N_LAUNCHES = MK_N_LAUNCHES;
struct Args { const float* in[21]; float* out; unsigned char* ws; int ph_lo, ph_hi; };
#define PG8_SP2 true
#define PG8_ALIGN true
template <class Epi> __device__ __forceinline__ void run_gemm(Frame& F, const pg8::bf16_t* A, int lda, const pg8::bf16_t* Bt, int ldb, int N, int K, const Epi& E) {
    __syncthreads();
    pg8::Gemm g{A, Bt, MTOK, N, K, lda, ldb}; pg8::StaticOrder S; S.init(MTOK, N, F.G, (int)blockIdx.x);
    pg8::gemm_phase<Epi, pg8::StaticOrder, PG8_ALIGN, PG8_SP2>(F.lds + RING_OFF, g, S, E);
}
__global__ void __launch_bounds__(NWAVES * 64, 2) mk_fwd(Args args) {
    extern __shared__ __attribute__((aligned(16))) unsigned char lds[];
    Frame F;
    F.lds = (LAS unsigned char*)lds; F.MISC = (volatile LAS unsigned*)(F.lds + MISC_OFF);
    F.tid = threadIdx.x; F.lane = F.tid & 63; F.wave = __builtin_amdgcn_readfirstlane(F.tid >> 6);
    F.G = gridDim.x; { const int bx = blockIdx.x; F.vcu = (F.G % 8 == 0) ? (bx % 8) * (F.G / 8) + bx / 8 : bx; }
    F.out = args.out; F.ws = args.ws;
    unsigned char* ws = args.ws;
    if (F.tid < 32) F.MISC[F.tid] = 0u;
    __syncthreads();
    XcdBarrier bar; bar.bar = (unsigned*)(ws + WS_CTL) + CW_BAR; bar.x = 0; bar.st = nullptr;
    if (N_LAUNCHES == 1) bar = xcd_barrier_post((unsigned*)(ws + WS_CTL) + CW_BAR, F.MISC + 8);
    const int lo = args.ph_lo, hi = args.ph_hi;
#ifndef PH_MASK
#define PH_MASK 0x1fff
#endif
#define IN(k) (((PH_MASK >> (k)) & 1) && lo <= (k) && (k) < hi)
#define SEAM(k) do { if (IN(k) && IN((k) + 1)) xcd_barrier(bar); } while (0)
#ifdef STRETCH_MASK
#define PH_T0() const unsigned long long t0_ = __builtin_amdgcn_s_memrealtime()
#define PH_STRETCH(k) do { if ((STRETCH_MASK >> (k)) & 1) { const unsigned long long t1_ = __builtin_amdgcn_s_memrealtime(); const unsigned long long d_ = (t1_ - t0_) * STRETCH_MULT; while (__builtin_amdgcn_s_memrealtime() - t1_ < d_) __builtin_amdgcn_s_sleep(8); } } while (0)
#else
#define PH_T0() do {} while (0)
#define PH_STRETCH(k) do {} while (0)
#endif
    float* sm = (float*)(ws + WS_SMALL);
    const float* rstdx = sm + SM_RSTDX / 4; float* ssq_cq = sm + SM_SSQ_CQ / 4; float* ssq_ckv = sm + SM_SSQ_CKV / 4; float* ssq1 = sm + SM_SSQ1 / 4; float* ssq2 = sm + SM_SSQ2 / 4; float* ssq_ro = sm + SM_SSQ_RO / 4;
    typedef pg8::bf16_t b16;
    b16* WinT = (b16*)(ws + WS_WIN); b16* XB = (b16*)(ws + WS_XB); b16* LATb = (b16*)(ws + WS_LAT); b16* ROb = (b16*)args.out;

    if (IN(0)) { PH_T0(); phase_p0(F, args.in[0], (const int*)args.in[2], args.in[3], args.in[4], args.in[6], args.in[7], args.in[8], args.in[9]); PH_STRETCH(0); } SEAM(0);
    if (IN(1)) { PH_T0();
        pg8::EpiInProj E{rstdx, (const pg8::f32x4*)(ws + WS_CS), (b16*)(ws + WS_RQ), (b16*)(ws + WS_RK), (b16*)(ws + WS_RKDT), (b16*)(ws + WS_RVT), LATb, ssq_cq, (PG8_LAS unsigned char*)(F.lds + XS_OFF)};
        run_gemm(F, XB, 1024, WinT + (size_t)4096 * 1024, 1024, NIN1, 1024, E);
    PH_STRETCH(1); } SEAM(1);
    if (IN(2)) { PH_T0(); phase_r0p(F); PH_STRETCH(2); } SEAM(2);
    if (IN(3)) { PH_T0(); phase_r1p(F); PH_STRETCH(3); } SEAM(3);
    if (IN(4)) { PH_T0();
        { pg8::EpiRetGate E{ROb, rstdx, ssq_ro, args.in[5]}; run_gemm(F, XB, 1024, WinT + (size_t)2048 * 1024, 1024, 2048, 1024, E); }
        { pg8::EpiRowAct<0> E{(b16*)(ws + WS_QP), 1536, ssq_cq, 1.0f / 384.0f}; run_gemm(F, LATb, LATW, (const b16*)(ws + WS_WUQ), 384, 1536, 384, E); }
        { pg8::EpiRowAct<0> E{(b16*)(ws + WS_KVP), 2048, ssq_ckv, 1.0f / 256.0f}; run_gemm(F, LATb + 384, LATW, (const b16*)(ws + WS_WUKV), 256, 2048, 256, E); }
    PH_STRETCH(4); } SEAM(4);
    if (IN(5)) { PH_T0(); phase_fin(F, args.in[10], args.in[11]); PH_STRETCH(5); } SEAM(5);
#ifdef ATTN_V1
    if (IN(6)) { PH_T0(); phase_attn(F); PH_STRETCH(6); } SEAM(6);
#else
    if (IN(6)) { PH_T0(); phase_attn2(F, (char*)lds); PH_STRETCH(6); } SEAM(6);
#endif
    if (IN(7)) { PH_T0();
#ifndef SKIP_LATE
        phase_late_weights(F, args.in[1], args.in[12], args.in[13], args.in[14], args.in[15], args.in[16], args.in[17], args.in[18], args.in[19], args.in[20]);
#endif
        { pg8::EpiRowAct<1> E{(b16*)(ws + WS_SG), 2048, rstdx, 0.f}; run_gemm(F, XB, 1024, WinT, 1024, 2048, 1024, E); }
    PH_STRETCH(7); } SEAM(7);
    if (IN(8)) { PH_T0();
        { pg8::EpiGateMix<0> E{(b16*)(ws + WS_TM), (const b16*)(ws + WS_SG), 0}; run_gemm(F, ROb, 2048, (const b16*)(ws + WS_WBR), 2048, 1024, 2048, E); }
        VM_WAIT(); __syncthreads(); __builtin_amdgcn_fence(__ATOMIC_ACQUIRE, "agent"); VM_WAIT(); __syncthreads();
        { pg8::EpiGateMix<1> E{(b16*)(ws + WS_TM), (const b16*)(ws + WS_SG), 1024}; run_gemm(F, (const b16*)(ws + WS_MO), 1024, (const b16*)(ws + WS_WBM), 1024, 1024, 1024, E); }
    PH_STRETCH(8); } SEAM(8);
    if (IN(9)) { PH_T0(); pg8::EpiResid E{args.in[0], args.out, XB, ssq1}; run_gemm(F, (const b16*)(ws + WS_TM), 1024, (const b16*)(ws + WS_WO), 1024, 1024, 1024, E); PH_STRETCH(9); } SEAM(9);
    if (IN(10)) { PH_T0(); pg8::EpiRowAct<2> E{(b16*)(ws + WS_H), 4096, ssq1, 1.0f / 1024.0f}; run_gemm(F, XB, 1024, (const b16*)(ws + WS_WUP), 1024, 4096, 1024, E); PH_STRETCH(10); } SEAM(10);
    if (IN(11)) { PH_T0(); pg8::EpiResid E{args.out, args.out, XB, ssq2}; run_gemm(F, (const b16*)(ws + WS_H), 4096, (const b16*)(ws + WS_WDOWN), 4096, 1024, 4096, E); PH_STRETCH(11); } SEAM(11);
    if (IN(12)) { PH_T0();
        { pg8::EpiRowAct<1> E{(b16*)(ws + WS_GT), 1024, ssq2, 1.0f / 1024.0f}; run_gemm(F, XB, 1024, (const b16*)(ws + WS_WPG), 1024, 1024, 1024, E); }
        VM_WAIT(); __syncthreads(); __builtin_amdgcn_fence(__ATOMIC_ACQUIRE, "agent"); VM_WAIT(); __syncthreads();
        { pg8::EpiFinal E{args.out, (const b16*)(ws + WS_GT)}; run_gemm(F, (const b16*)(ws + WS_PB), 256, (const b16*)(ws + WS_WPLE), 256, 1024, 256, E); }
    PH_STRETCH(12); }
#undef IN
#undef SEAM
}


#ifdef DUMPK
struct DumpArgs { const unsigned* reg[6]; unsigned nw[6]; unsigned* out; int own; int pad; };
__global__ void dump_hash(DumpArgs d) {
    for (unsigned i = blockIdx.x * blockDim.x + threadIdx.x; i < (unsigned)MTOK * DM; i += gridDim.x * blockDim.x) {
        float s = 0.f;
        if (d.own) { const unsigned w = d.out[i]; s += __uint_as_float(w << 16) + __uint_as_float(w & 0xffff0000u); }
        for (int r = 0; r < 6; ++r) if (d.reg[r] && i < d.nw[r] * 2u) { const unsigned short v = ((const unsigned short*)d.reg[r])[i]; s += __uint_as_float((unsigned)v << 16); }
        ((float*)d.out)[i] = s;
    }
}
#endif
extern "C" void kernel_launch(void* const* d_in, const int* in_sizes, int n_in, void* d_out, int out_size, void* d_ws, size_t ws_size, hipStream_t stream) {
    static int grid = 0;
    if (grid == 0) {
        if (n_in != 21 || in_sizes[0] != MTOK * DM || out_size != MTOK * DM || ws_size < WS_END) { fprintf(stderr, "kernel_launch: unexpected shapes (n_in %d in0 %d out %d ws %zu)\n", n_in, n_in > 0 ? in_sizes[0] : -1, out_size, ws_size); grid = -1; return; }
        int dev = 0, cus = 0, per_cu = 0;
        if (hipGetDevice(&dev) != hipSuccess || hipDeviceGetAttribute(&cus, hipDeviceAttributeMultiprocessorCount, dev) != hipSuccess) { grid = -1; return; }
        if (hipFuncSetAttribute((const void*)mk_fwd, hipFuncAttributeMaxDynamicSharedMemorySize, LDS_BYTES) != hipSuccess) { fprintf(stderr, "kernel_launch: hipFuncSetAttribute failed\n"); grid = -1; return; }
        if (hipOccupancyMaxActiveBlocksPerMultiprocessor(&per_cu, (const void*)mk_fwd, NWAVES * 64, LDS_BYTES) != hipSuccess || per_cu < 1) { fprintf(stderr, "kernel_launch: occupancy query says %d workgroups per CU\n", per_cu); (void)hipGetLastError(); grid = -1; return; }
        grid = cus;
    }
    if (grid < 0) return;
    (void)hipMemsetAsync((char*)d_ws + WS_CTL, 0, CTL_ZERO_BYTES, stream);
    Args a{};
    for (int i = 0; i < 21; ++i) a.in[i] = (const float*)d_in[i];
    a.out = (float*)d_out; a.ws = (unsigned char*)d_ws;
    if (N_LAUNCHES == 1) { a.ph_lo = 0; a.ph_hi = N_PHASES; hipLaunchKernelGGL(mk_fwd, dim3(grid), dim3(NWAVES * 64), LDS_BYTES, stream, a); }
    else for (int ph = 0; ph < N_PHASES; ++ph) {
#ifdef DUMPK
        if (ph > DUMPK) break;
#endif
        a.ph_lo = ph; a.ph_hi = ph + 1; hipLaunchKernelGGL(mk_fwd, dim3(grid), dim3(NWAVES * 64), LDS_BYTES, stream, a); }
#ifdef DUMPK
    { DumpArgs d{}; d.out = (unsigned*)d_out; d.own = DUMP_OWN; const size_t offs[6] = DUMP_OFFS; const size_t len[6] = DUMP_LENS;
      for (int r = 0; r < 6; ++r) if (len[r]) { d.reg[r] = (const unsigned*)((const char*)d_ws + offs[r]); d.nw[r] = (unsigned)(len[r] / 4); }
      hipLaunchKernelGGL(dump_hash, dim3(2048), dim3(256), 0, stream, d); }
#endif
}
```

```cpp
#define MK_N_LAUNCHES 1
#include <hip/hip_runtime.h>
#include <hip/hip_bf16.h>
#include <cstdio>
#include <cstdint>
namespace pg8 {
#define PG8_LAS __attribute__((address_space(3)))
typedef unsigned short bf16_t;
typedef short bf16x8 __attribute__((ext_vector_type(8)));
typedef float f32x4 __attribute__((ext_vector_type(4)));
typedef unsigned u32x4 __attribute__((ext_vector_type(4)));
constexpr int BM = 256, BK = 64, HALF = 128, HTB = HALF * BK * 2  , STAGE_BYTES = 8 * HTB, NXCD = 8, WGM = 8;

__host__ __device__ __forceinline__ int lds_byte(int r, int c) { const int st = (r >> 4) * 2 + (c >> 5), rr = r & 15, cc = c & 31, ob = rr * 64 + cc * 2; return st * 1024 + (ob ^ (((ob >> 9) & 1) << 5)); }
__host__ __device__ __forceinline__ void stage_rc(int b, int& R, int& C) { const int st = b / 1024, sb = b % 1024, swz = sb ^ (((sb >> 9) & 1) << 5); R = (st >> 1) * 16 + swz / 64; C = (st & 1) * 32 + (swz % 64) / 2; }
__host__ __device__ __forceinline__ int perm32(int rho) { const int n = rho >> 4, i = rho & 15; return 8 * (i >> 2) + 4 * n + (i & 3); }

struct Unit { int pm, pn; };
struct Gemm { const bf16_t* A; const bf16_t* Bt; int M, N, K, lda, ldb; };

struct StaticOrder {
    int nM, nN, nwg, G, c;
    __host__ __device__ void init(int M, int N, int G_, int c_) { nM = M / BM; nN = N / BM; nwg = nM * nN; G = G_; c = c_; }
    __host__ __device__ bool next(int i, Unit& u) const {
        const long L = (long)i * G + c; if (L >= nwg) return false;
        int wgid = (int)L; { const int q = nwg / NXCD, r = nwg % NXCD, xcd = wgid % NXCD, off = wgid / NXCD; wgid = (xcd < r ? xcd * (q + 1) : r * (q + 1) + (xcd - r) * q) + off; }
        const int nig = WGM * nN, gid = wgid / nig, fm = gid * WGM, gsz = (nM - fm) < WGM ? (nM - fm) : WGM;
        u.pm = fm + ((wgid % nig) % gsz); u.pn = (wgid % nig) / gsz; return true;
    }
    __device__ __forceinline__ void a_ready(const Unit&) const {}
    __device__ __forceinline__ void done(const Unit&) const {}
};


typedef float f32x2 __attribute__((ext_vector_type(2)));
typedef __bf16 bf16x2_t __attribute__((ext_vector_type(2)));
__device__ __forceinline__ unsigned cvt_pk_bf16(float lo, float hi) { f32x2 v = {lo, hi}; bf16x2_t b = __builtin_convertvector(v, bf16x2_t); return __builtin_bit_cast(unsigned, b); }
__device__ __forceinline__ float bflo(unsigned w) { return __uint_as_float(w << 16); }
__device__ __forceinline__ float bfhi(unsigned w) { return __uint_as_float(w & 0xffff0000u); }
__device__ __forceinline__ u32x4 pack8(const float (&v)[8]) { u32x4 w; w.x = cvt_pk_bf16(v[0], v[1]); w.y = cvt_pk_bf16(v[2], v[3]); w.z = cvt_pk_bf16(v[4], v[5]); w.w = cvt_pk_bf16(v[6], v[7]); return w; }
__device__ __forceinline__ void unpack8(const u32x4 w, float (&v)[8]) { v[0] = bflo(w.x); v[1] = bfhi(w.x); v[2] = bflo(w.y); v[3] = bfhi(w.y); v[4] = bflo(w.z); v[5] = bfhi(w.z); v[6] = bflo(w.w); v[7] = bfhi(w.w); }
__device__ __forceinline__ float sigmoidf_(float x) { return __builtin_amdgcn_rcpf(1.0f + __builtin_amdgcn_exp2f(-1.4426950408889634f * x)); }
constexpr float RMS_EPS_ = 1e-6f;

#define EPI_ACC8(v, ai, bj, m) float v[8]; { const f32x4 a0_ = acc[ai][bj][m][0], a1_ = acc[ai][bj][m][1]; v[0] = a0_[0]; v[1] = a0_[1]; v[2] = a0_[2]; v[3] = a0_[3]; v[4] = a1_[0]; v[5] = a1_[1]; v[6] = a1_[2]; v[7] = a1_[3]; }

__device__ __forceinline__ void xpose_store(PG8_LAS unsigned char* st, const unsigned (&pk)[4][4], bf16_t* dst, int R, int lane, int fr, int fq) {
#pragma unroll
    for (int pass = 0; pass < 2; ++pass) {
        if ((fq >> 1) == pass) {
#pragma unroll
            for (int m = 0; m < 4; ++m)
#pragma unroll
                for (int q = 0; q < 4; ++q) { const unsigned w = pk[m][q]; const int c = (fq & 1) * 8 + 2 * q;
                    *(PG8_LAS unsigned short*)(st + c * 144 + (16 * m + fr) * 2) = (unsigned short)(w & 0xffffu);
                    *(PG8_LAS unsigned short*)(st + (c + 1) * 144 + (16 * m + fr) * 2) = (unsigned short)(w >> 16); }
        }
        asm volatile("s_waitcnt lgkmcnt(0)" ::: "memory");
#pragma unroll
        for (int k = 0; k < 2; ++k) { const int idx = lane + 64 * k, c = idx & 15, ch = idx >> 4;
            const u32x4 v = *(const PG8_LAS u32x4*)(st + c * 144 + ch * 16);
            *(u32x4*)(dst + ((size_t)ch * R + pass * 16 + c) * 8) = v; }
        asm volatile("s_waitcnt lgkmcnt(0)" ::: "memory");
    }
}

struct EpiInProj {
    static constexpr bool PERM = true, AFTER_DRAIN = false;
    const float* rstdx; const f32x4* cs;
    bf16_t *RQ, *RK, *RKDT, *RVT, *LAT; float *ssq_lat;   PG8_LAS unsigned char* xs;
    __device__ __forceinline__ void operator()(const f32x4 (&acc)[2][2][4][2], const Unit& u, int wr, int wc, int fr, int fq) const {
        const int pn = u.pn, lane = fq * 16 + fr, wid = wr * 4 + wc;
        PG8_LAS unsigned char* st = xs + wid * 2304;
        const int rowt = u.pm * BM + wr * 64 + fr;
        const int bidx = (u.pm * BM) >> 12, s0 = (u.pm * BM) & 4095;
        if (pn < 8) {
            const bool isk = pn >= 4; const int head = pn & 3;
            const float lg2 = __builtin_amdgcn_logf(1.0f - __builtin_amdgcn_exp2f(-5.0f - (float)head));
            float kd[4];
#pragma unroll
            for (int m = 0; m < 4; ++m) kd[m] = __builtin_amdgcn_exp2f((float)(127 - (wr * 64 + m * 16 + fr)) * lg2);
            bf16_t* O = isk ? RK : RQ;
#pragma unroll
            for (int ai = 0; ai < 2; ++ai) {
                unsigned pk0[4][4], pk1[4][4];
#pragma unroll
                for (int m = 0; m < 4; ++m) {
                    const int row = rowt + ai * HALF + m * 16; const float rs = rstdx[row] * (isk ? 0.0625f : 1.0f);
                    const f32x4* cp = cs + (size_t)row * 64 + wc * 16 + fq * 4;
                    const f32x4 c0 = cp[0], c1 = cp[1], c2 = cp[2], c3 = cp[3];
                    const float cc[8] = {c0[0], c0[2], c1[0], c1[2], c2[0], c2[2], c3[0], c3[2]}, ss[8] = {c0[1], c0[3], c1[1], c1[3], c2[1], c2[3], c3[1], c3[3]};
                    EPI_ACC8(x1, ai, 0, m); EPI_ACC8(x2, ai, 1, m);
                    float o1[8], o2[8];
#pragma unroll
                    for (int e = 0; e < 8; ++e) { const float a = x1[e] * rs, b = x2[e] * rs; o1[e] = a * cc[e] - b * ss[e]; o2[e] = b * cc[e] + a * ss[e]; }
                    bf16_t* rp = O + ((((size_t)(bidx * 4 + head) * 32 + (s0 >> 7) + ai) * 32 + wc * 4 + fq) * 128 + wr * 64 + m * 16 + fr) * 8;
                    *(u32x4*)rp = pack8(o1); *(u32x4*)(rp + (size_t)16 * 128 * 8) = pack8(o2);
                    if (isk) {
#pragma unroll
                        for (int q = 0; q < 4; ++q) { pk0[m][q] = cvt_pk_bf16(o1[2 * q] * kd[m], o1[2 * q + 1] * kd[m]); pk1[m][q] = cvt_pk_bf16(o2[2 * q] * kd[m], o2[2 * q + 1] * kd[m]); }
                    }
                }
                if (isk) {
                    bf16_t* d0 = RKDT + ((((size_t)(bidx * 4 + head) * 32 + (s0 >> 7) + ai) * 16 + wr * 8) * 256 + wc * 32) * 8;
                    xpose_store(st, pk0, d0, 256, lane, fr, fq);
                    xpose_store(st, pk1, d0 + (size_t)HALF * 8, 256, lane, fr, fq);
                }
            }
        } else if (pn < 16) {
            const int head = (pn - 8) >> 1, dvb = ((pn - 8) & 1) * 256;
#pragma unroll
            for (int ai = 0; ai < 2; ++ai)
#pragma unroll
                for (int bj = 0; bj < 2; ++bj) {
                    unsigned pk[4][4];
#pragma unroll
                    for (int m = 0; m < 4; ++m) { const float rs = rstdx[rowt + ai * HALF + m * 16]; EPI_ACC8(v, ai, bj, m);
#pragma unroll
                        for (int q = 0; q < 4; ++q) pk[m][q] = cvt_pk_bf16(v[2 * q] * rs, v[2 * q + 1] * rs); }
                    bf16_t* d0 = RVT + ((((size_t)(bidx * 4 + head) * 32 + (s0 >> 7) + ai) * 16 + wr * 8) * 512 + dvb + bj * HALF + wc * 32) * 8;
                    xpose_store(st, pk, d0, 512, lane, fr, fq);
                }
        } else {
            const int lt = pn - 16;
#pragma unroll
            for (int ai = 0; ai < 2; ++ai)
#pragma unroll
                for (int m = 0; m < 4; ++m) { const int row = rowt + ai * HALF + m * 16; const float rs = rstdx[row];
#pragma unroll
                    for (int bj = 0; bj < 2; ++bj) { EPI_ACC8(v, ai, bj, m); float q = 0.f;
#pragma unroll
                        for (int e = 0; e < 8; ++e) { v[e] *= rs; q += v[e] * v[e]; }
                        *(u32x4*)(LAT + (size_t)row * 768 + lt * 256 + bj * HALF + wc * 32 + 8 * fq) = pack8(v);
                        const int kind = (lt == 0) ? 0 : (lt == 1 ? (bj == 0 ? 0 : 1) : (bj == 0 ? 1 : 2));
                        if (kind < 2) { q += __shfl_xor(q, 16); q += __shfl_xor(q, 32); if (fq == 0) atomicAdd(ssq_lat + kind * 16384 + row, q); } } }
        }
    }
};

template <int MODE> struct EpiRowAct {
    static constexpr bool PERM = true, AFTER_DRAIN = false;
    bf16_t* O; int ldo; const float* rsrc; float inv_dim;
    __device__ __forceinline__ void operator()(const f32x4 (&acc)[2][2][4][2], const Unit& u, int wr, int wc, int fr, int fq) const {
        const int rowt = u.pm * BM + wr * 64 + fr, colt = u.pn * BM + wc * 32 + 8 * fq;
#pragma unroll
        for (int ai = 0; ai < 2; ++ai)
#pragma unroll
            for (int m = 0; m < 4; ++m) { const int row = rowt + ai * HALF + m * 16; const float r0 = rsrc[row]; const float rs = inv_dim == 0.f ? r0 : __builtin_amdgcn_rsqf(r0 * inv_dim + RMS_EPS_);
#pragma unroll
                for (int bj = 0; bj < 2; ++bj) { EPI_ACC8(v, ai, bj, m);
#pragma unroll
                    for (int e = 0; e < 8; ++e) { float x = v[e] * rs; if (MODE == 1) x = sigmoidf_(x); if (MODE == 2) { x = fmaxf(x, 0.f); x = x * x; } v[e] = x; }
                    *(u32x4*)(O + (size_t)row * ldo + colt + bj * HALF) = pack8(v); } }
    }
};
struct EpiRetGate {
    static constexpr bool PERM = true, AFTER_DRAIN = false;
    bf16_t* RO; const float* rstdx; const float* ssq_ro; const float* ret_norm;
    __device__ __forceinline__ void operator()(const f32x4 (&acc)[2][2][4][2], const Unit& u, int wr, int wc, int fr, int fq) const {
        const int rowt = u.pm * BM + wr * 64 + fr, colt = u.pn * BM + wc * 32 + 8 * fq, head = u.pn >> 1;
        f32x4 g[2][2];
#pragma unroll
        for (int bj = 0; bj < 2; ++bj) { g[bj][0] = *(const f32x4*)(ret_norm + colt + bj * HALF); g[bj][1] = *(const f32x4*)(ret_norm + colt + bj * HALF + 4); }
#pragma unroll
        for (int ai = 0; ai < 2; ++ai)
#pragma unroll
            for (int m = 0; m < 4; ++m) { const int row = rowt + ai * HALF + m * 16; const float rs = rstdx[row]; const f32x4* sp = (const f32x4*)(ssq_ro + ((size_t)row * 4 + head) * 16); const f32x4 s4 = (sp[0] + sp[1]) + (sp[2] + sp[3]);
                const float rr = __builtin_amdgcn_rsqf(((s4[0] + s4[1]) + (s4[2] + s4[3])) * (1.0f / 512.0f) + RMS_EPS_);
#pragma unroll
                for (int bj = 0; bj < 2; ++bj) { EPI_ACC8(v, ai, bj, m); bf16_t* p = RO + (size_t)row * 2048 + colt + bj * HALF; float o[8]; unpack8(*(const u32x4*)p, o);
#pragma unroll
                    for (int e = 0; e < 8; ++e) { const float x = v[e] * rs; const float gg = e < 4 ? g[bj][0][e & 3] : g[bj][1][e & 3]; v[e] = o[e] * rr * gg * x * sigmoidf_(x); }
                    *(u32x4*)p = pack8(v); } }
    }
};
template <int MODE> struct EpiGateMix {
    static constexpr bool PERM = true, AFTER_DRAIN = false;
    bf16_t* TM; const bf16_t* SG; int sgoff;
    __device__ __forceinline__ void operator()(const f32x4 (&acc)[2][2][4][2], const Unit& u, int wr, int wc, int fr, int fq) const {
        const int rowt = u.pm * BM + wr * 64 + fr, colt = u.pn * BM + wc * 32 + 8 * fq;
#pragma unroll
        for (int ai = 0; ai < 2; ++ai)
#pragma unroll
            for (int m = 0; m < 4; ++m) { const int row = rowt + ai * HALF + m * 16;
#pragma unroll
                for (int bj = 0; bj < 2; ++bj) { EPI_ACC8(v, ai, bj, m); float s[8]; unpack8(*(const u32x4*)(SG + (size_t)row * 2048 + sgoff + colt + bj * HALF), s);
                    bf16_t* p = TM + (size_t)row * 1024 + colt + bj * HALF;
                    if (MODE == 1) { float t[8]; unpack8(*(const u32x4*)p, t);
#pragma unroll
                        for (int e = 0; e < 8; ++e) v[e] = t[e] + s[e] * v[e]; }
                    else {
#pragma unroll
                        for (int e = 0; e < 8; ++e) v[e] = s[e] * v[e]; }
                    *(u32x4*)p = pack8(v); } }
    }
};
struct EpiResid {
    static constexpr bool PERM = true, AFTER_DRAIN = false;
    const float* res; float* out; bf16_t* xb; float* ssq;
    __device__ __forceinline__ void operator()(const f32x4 (&acc)[2][2][4][2], const Unit& u, int wr, int wc, int fr, int fq) const {
        const int rowt = u.pm * BM + wr * 64 + fr, colt = u.pn * BM + wc * 32 + 8 * fq;
#pragma unroll
        for (int ai = 0; ai < 2; ++ai)
#pragma unroll
            for (int m = 0; m < 4; ++m) { const int row = rowt + ai * HALF + m * 16; float q = 0.f;
#pragma unroll
                for (int bj = 0; bj < 2; ++bj) { EPI_ACC8(v, ai, bj, m); const size_t off = (size_t)row * 1024 + colt + bj * HALF;
                    const f32x4 r0 = *(const f32x4*)(res + off), r1 = *(const f32x4*)(res + off + 4);
#pragma unroll
                    for (int e = 0; e < 8; ++e) { v[e] += e < 4 ? r0[e & 3] : r1[e & 3]; q += v[e] * v[e]; }
                    *(f32x4*)(out + off) = (f32x4){v[0], v[1], v[2], v[3]}; *(f32x4*)(out + off + 4) = (f32x4){v[4], v[5], v[6], v[7]};
                    *(u32x4*)(xb + off) = pack8(v); }
                q += __shfl_xor(q, 16); q += __shfl_xor(q, 32); if (fq == 0) atomicAdd(ssq + row, q);
                if (m & 1) asm volatile("" ::: "memory"); }
    }
};
struct EpiFinal {
    static constexpr bool PERM = true, AFTER_DRAIN = false;
    float* out; const bf16_t* GT;
    __device__ __forceinline__ void operator()(const f32x4 (&acc)[2][2][4][2], const Unit& u, int wr, int wc, int fr, int fq) const {
        const int rowt = u.pm * BM + wr * 64 + fr, colt = u.pn * BM + wc * 32 + 8 * fq;
#pragma unroll
        for (int ai = 0; ai < 2; ++ai)
#pragma unroll
            for (int m = 0; m < 4; ++m) { const int row = rowt + ai * HALF + m * 16;
#pragma unroll
                for (int bj = 0; bj < 2; ++bj) { EPI_ACC8(v, ai, bj, m); const size_t off = (size_t)row * 1024 + colt + bj * HALF; float gt[8]; unpack8(*(const u32x4*)(GT + off), gt);
                    const f32x4 r0 = *(const f32x4*)(out + off), r1 = *(const f32x4*)(out + off + 4);
#pragma unroll
                    for (int e = 0; e < 8; ++e) v[e] = (e < 4 ? r0[e & 3] : r1[e & 3]) + gt[e] * v[e];
                    *(f32x4*)(out + off) = (f32x4){v[0], v[1], v[2], v[3]}; *(f32x4*)(out + off + 4) = (f32x4){v[4], v[5], v[6], v[7]}; }
                if (m & 1) asm volatile("" ::: "memory"); }
    }
};
template <class Epi, class Sched, bool ALIGN_EPI = false, bool SP2 = false>
__device__ __forceinline__ void gemm_phase(PG8_LAS unsigned char* lds, const Gemm g, const Sched& S, const Epi& E) {
    const int tid = threadIdx.x, wid = __builtin_amdgcn_readfirstlane(tid >> 6), lane = tid & 63, wr = wid >> 2, wc = wid & 3, fr = lane & 15, fq = lane >> 4;
    const int K = g.K, nt = K / BK;
    unsigned voffA[2], voffB[2];
#pragma unroll
    for (int i = 0; i < 2; ++i) { int R, C; stage_rc(tid * 16 + i * 8192, R, C); const int Rb = Epi::PERM ? ((R & ~31) + perm32(R & 31)) : R;
        voffA[i] = (unsigned)(R * g.lda + C) * 2u; voffB[i] = (unsigned)(Rb * g.ldb + C) * 2u; }
    const size_t kstep = (size_t)(BK * 2);
    const size_t hstepA = (size_t)HALF * g.lda * 2, hstepB = (size_t)HALF * g.ldb * 2;
    const size_t tstepA = 2 * hstepA, tstepB = 2 * hstepB;
    const unsigned ldsw = (unsigned)wid * 1024u;
    const int aoff = lds_byte(wr * 64 + fr, fq * 8), boff = lds_byte(wc * 32 + fr, fq * 8);
#define PG8_SA(b, h) (((b) * 2 + (h)) * HTB)
#define PG8_SB(b, h) ((4 + (b) * 2 + (h)) * HTB)
#define PG8_STAGE(bufoff, gbase, voff) do { _Pragma("unroll") for (int _i = 0; _i < 2; ++_i) \
        __builtin_amdgcn_global_load_lds((const unsigned*)((const char*)(gbase) + (voff)[_i]), (PG8_LAS unsigned*)(lds + (bufoff) + ldsw + _i * 8192), 16, 0, 0); } while (0)
#define PG8_LDA(dst, b, h) do { _Pragma("unroll") for (int m = 0; m < 4; ++m) _Pragma("unroll") for (int k = 0; k < 2; ++k) dst[m][k] = *(const PG8_LAS bf16x8*)(lds + PG8_SA(b, h) + aoff + m * 2048 + k * 1024); } while (0)
#define PG8_LDB(dst, b, h) do { _Pragma("unroll") for (int n = 0; n < 2; ++n) _Pragma("unroll") for (int k = 0; k < 2; ++k) dst[n][k] = *(const PG8_LAS bf16x8*)(lds + PG8_SB(b, h) + boff + n * 2048 + k * 1024); } while (0)
#define PG8_MMA(ai, bj, At, Bt) do { __builtin_amdgcn_s_setprio(1); _Pragma("unroll") for (int m = 0; m < 4; ++m) _Pragma("unroll") for (int n = 0; n < 2; ++n) _Pragma("unroll") for (int k = 0; k < 2; ++k) \
        acc[ai][bj][m][n] = __builtin_amdgcn_mfma_f32_16x16x32_bf16(Bt[n][k], At[m][k], acc[ai][bj][m][n], 0, 0, 0); __builtin_amdgcn_s_setprio(0); } while (0)
#define PG8_WAIT_V(n) asm volatile("s_waitcnt vmcnt(" #n ")" ::: "memory")
#define PG8_WAIT_L(n) asm volatile("s_waitcnt lgkmcnt(" #n ")" ::: "memory")
#define PG8_BAR __builtin_amdgcn_s_barrier()
#define PG8_SCHED __builtin_amdgcn_sched_barrier(0)
    Unit cur, nxt; int ui = 0;
    if (!S.next(0, cur)) return;
    f32x4 acc[2][2][4][2];
#pragma unroll
    for (int a = 0; a < 2; ++a)
#pragma unroll
        for (int b = 0; b < 2; ++b)
#pragma unroll
            for (int m = 0; m < 4; ++m)
#pragma unroll
                for (int n = 0; n < 2; ++n) acc[a][b][m][n] = (f32x4){0.f, 0.f, 0.f, 0.f};
    bf16x8 At[4][2], B0[2][2], B1[2][2];
    const char* cA = (const char*)g.A + (size_t)cur.pm * tstepA; const char* cB = (const char*)g.Bt + (size_t)cur.pn * tstepB;
    S.a_ready(cur);
    if constexpr (SP2) {
        PG8_STAGE(PG8_SB(0, 0), cB, voffB); PG8_STAGE(PG8_SB(0, 1), cB + hstepB, voffB); PG8_STAGE(PG8_SA(0, 0), cA, voffA); PG8_STAGE(PG8_SA(0, 1), cA + hstepA, voffA);
        if (wr == 1) PG8_BAR;
        PG8_WAIT_V(2); PG8_BAR;
        PG8_STAGE(PG8_SB(1, 0), cB + kstep, voffB); PG8_STAGE(PG8_SA(1, 0), cA + kstep, voffA); PG8_STAGE(PG8_SB(1, 1), cB + hstepB + kstep, voffB);
        PG8_WAIT_V(6); PG8_BAR;
    } else {
        PG8_STAGE(PG8_SB(0, 0), cB, voffB); PG8_STAGE(PG8_SA(0, 0), cA, voffA); PG8_STAGE(PG8_SB(0, 1), cB + hstepB, voffB); PG8_STAGE(PG8_SA(0, 1), cA + hstepA, voffA);
        if (wr == 1) PG8_BAR;
        PG8_WAIT_V(4); PG8_BAR;
        PG8_STAGE(PG8_SB(1, 0), cB + kstep, voffB); PG8_STAGE(PG8_SA(1, 0), cA + kstep, voffA); PG8_STAGE(PG8_SB(1, 1), cB + hstepB + kstep, voffB);
        PG8_WAIT_V(6); PG8_BAR;
    }
    for (;;) {
        const bool has_next = S.next(ui + 1, nxt);
        const char* nA = has_next ? (const char*)g.A + (size_t)nxt.pm * tstepA : cA; const char* nB = has_next ? (const char*)g.Bt + (size_t)nxt.pn * tstepB : cB;
        for (int t = 0; t < nt; t += 2) {
            const bool last = (t == nt - 2);
            const char* a1 = cA + (size_t)(t + 1) * kstep;
            const char* a2 = last ? nA : cA + (size_t)(t + 2) * kstep; const char* b2 = last ? nB : cB + (size_t)(t + 2) * kstep;
            const char* a3 = a2 + kstep; const char* b3 = b2 + kstep;
            if (last && has_next) S.a_ready(nxt);
            if constexpr (SP2) {
            PG8_LDB(B0, 0, 0); PG8_LDB(B1, 0, 1); PG8_SCHED; PG8_LDA(At, 0, 0); PG8_STAGE(PG8_SA(1, 1), a1 + hstepA, voffA);
            PG8_WAIT_V(8); PG8_WAIT_L(0); PG8_BAR; PG8_MMA(0, 0, At, B0); PG8_MMA(0, 1, At, B1); PG8_BAR; PG8_SCHED;
            PG8_LDA(At, 0, 1); PG8_STAGE(PG8_SB(0, 0), b2, voffB); PG8_STAGE(PG8_SB(0, 1), b2 + hstepB, voffB); PG8_STAGE(PG8_SA(0, 0), a2, voffA);
            PG8_WAIT_V(8); PG8_WAIT_L(0); PG8_BAR; PG8_MMA(1, 0, At, B0); PG8_MMA(1, 1, At, B1); PG8_BAR; PG8_SCHED;
            PG8_LDB(B0, 1, 0); PG8_LDB(B1, 1, 1); PG8_SCHED; PG8_LDA(At, 1, 0); PG8_STAGE(PG8_SA(0, 1), a2 + hstepA, voffA);
            PG8_WAIT_V(8); PG8_WAIT_L(0); PG8_BAR; PG8_MMA(0, 0, At, B0); PG8_MMA(0, 1, At, B1); PG8_BAR; PG8_SCHED;
            PG8_LDA(At, 1, 1); PG8_STAGE(PG8_SB(1, 0), b3, voffB); PG8_STAGE(PG8_SB(1, 1), b3 + hstepB, voffB); PG8_STAGE(PG8_SA(1, 0), a3, voffA);
            PG8_WAIT_V(8); PG8_WAIT_L(0); PG8_BAR; PG8_MMA(1, 0, At, B0); PG8_MMA(1, 1, At, B1); PG8_BAR; PG8_SCHED;
            } else {
            PG8_LDB(B0, 0, 0); PG8_SCHED; PG8_LDA(At, 0, 0); PG8_STAGE(PG8_SA(1, 1), a1 + hstepA, voffA);
            PG8_WAIT_L(8); PG8_BAR; PG8_WAIT_L(0); PG8_MMA(0, 0, At, B0); PG8_BAR; PG8_SCHED;
            PG8_LDB(B1, 0, 1); PG8_STAGE(PG8_SB(0, 0), b2, voffB);
            PG8_BAR; PG8_WAIT_L(0); PG8_MMA(0, 1, At, B1); PG8_BAR;
            PG8_LDA(At, 0, 1); PG8_STAGE(PG8_SA(0, 0), a2, voffA);
            PG8_BAR; PG8_WAIT_L(0); PG8_MMA(1, 0, At, B0); PG8_BAR; PG8_SCHED;
            PG8_STAGE(PG8_SB(0, 1), b2 + hstepB, voffB);
            PG8_WAIT_V(6); PG8_BAR; PG8_MMA(1, 1, At, B1); PG8_BAR;
            PG8_LDB(B0, 1, 0); PG8_SCHED; PG8_LDA(At, 1, 0); PG8_STAGE(PG8_SA(0, 1), a2 + hstepA, voffA);
            PG8_WAIT_L(8); PG8_BAR; PG8_WAIT_L(0); PG8_MMA(0, 0, At, B0); PG8_BAR; PG8_SCHED;
            PG8_LDB(B1, 1, 1); PG8_STAGE(PG8_SB(1, 0), b3, voffB);
            PG8_BAR; PG8_WAIT_L(0); PG8_MMA(0, 1, At, B1); PG8_BAR;
            PG8_LDA(At, 1, 1); PG8_STAGE(PG8_SA(1, 0), a3, voffA);
            PG8_BAR; PG8_WAIT_L(0); PG8_MMA(1, 0, At, B0); PG8_BAR; PG8_SCHED;
            PG8_STAGE(PG8_SB(1, 1), b3 + hstepB, voffB);
            PG8_WAIT_V(6); PG8_BAR; PG8_MMA(1, 1, At, B1); PG8_BAR;
            }
        }
        if constexpr (ALIGN_EPI) { if (wr == 0) PG8_BAR; }
        if constexpr (!Epi::AFTER_DRAIN) { E(acc, cur, wr, wc, fr, fq); S.done(cur); }
        if (!has_next) break;
#pragma unroll
        for (int a = 0; a < 2; ++a)
#pragma unroll
            for (int b = 0; b < 2; ++b)
#pragma unroll
                for (int m = 0; m < 4; ++m)
#pragma unroll
                    for (int n = 0; n < 2; ++n) acc[a][b][m][n] = (f32x4){0.f, 0.f, 0.f, 0.f};
        cur = nxt; cA = nA; cB = nB; ++ui;
        if constexpr (ALIGN_EPI) { if (wr == 1) PG8_BAR; }
    }
    PG8_WAIT_V(0);
    if constexpr (!ALIGN_EPI) { if (wr == 0) PG8_BAR; }
    PG8_BAR;
    if constexpr (Epi::AFTER_DRAIN) { E.fused(acc, cur, wr, wc, fr, fq, lds, wid, lane); S.done(cur); }
#undef PG8_SA
#undef PG8_SB
#undef PG8_STAGE
#undef PG8_LDA
#undef PG8_LDB
#undef PG8_MMA
#undef PG8_WAIT_V
#undef PG8_WAIT_L
#undef PG8_BAR
#undef PG8_SCHED
}
}
#define GAS __attribute__((address_space(1)))
#define LAS __attribute__((address_space(3)))
typedef unsigned short bf16;
typedef unsigned v4u __attribute__((ext_vector_type(4)));
typedef float f32x4 __attribute__((ext_vector_type(4)));
typedef short bf16x8 __attribute__((ext_vector_type(8)));
typedef GAS unsigned gu32;
typedef GAS unsigned long long gu64;
#define RLX_AGENT __ATOMIC_RELAXED, __HIP_MEMORY_SCOPE_AGENT
#define LDS_WAIT() asm volatile("s_waitcnt lgkmcnt(0)" ::: "memory")
#define VM_WAIT() asm volatile("s_waitcnt vmcnt(0)" ::: "memory")
__device__ __forceinline__ unsigned long long rt() { return __builtin_amdgcn_s_memrealtime(); }
__device__ __forceinline__ unsigned f2bf(float f) { unsigned u = __builtin_bit_cast(unsigned, f); return (u + 0x7fffu + ((u >> 16) & 1u)) >> 16; }
__device__ __forceinline__ unsigned pk2(float lo, float hi) { return f2bf(lo) | (f2bf(hi) << 16); }

#define XB_TMO      128
#define XB_XCNT(j)  (256  + 64 * (j))
#define XB_XSUB(j)  (1280 + 64 * (j))
#define XB_XGEN(j)  (2304 + 64 * (j))
#define XB_TOP      3328
#define XB_TOPGEN   3392
#define XCD_BAR_WORDS 3456
#define XB_SPIN_CAP (1u << 18)

__device__ __forceinline__ unsigned xb_ld(unsigned* p)              { return __hip_atomic_load(p, __ATOMIC_RELAXED, __HIP_MEMORY_SCOPE_AGENT); }
__device__ __forceinline__ unsigned xb_add(unsigned* p, unsigned v) { return __hip_atomic_fetch_add(p, v, __ATOMIC_RELAXED, __HIP_MEMORY_SCOPE_AGENT); }
__device__ __forceinline__ unsigned xb_xcc_id() { return (unsigned)__builtin_amdgcn_s_getreg((3 << 11) | 20) & 0xFu; }
#define XB_SPIN(cond, bar) do { unsigned _sp = 0; while (cond) { __builtin_amdgcn_s_sleep(1); \
    if ((++_sp & 255u) == 0u) { if (xb_ld(&(bar)[XB_TMO])) break; if (_sp > XB_SPIN_CAP) { atomicAdd(&(bar)[XB_TMO], 1u); break; } } } } while (0)

struct XcdBarrier {
    unsigned* bar; unsigned x;
    volatile LAS unsigned* st;
};

__device__ __forceinline__ XcdBarrier xcd_barrier_post(unsigned* bar, volatile LAS unsigned* st) {
    XcdBarrier b; b.bar = bar; b.x = xb_xcc_id(); b.st = st;
    if (threadIdx.x == 0) (void)xb_add(&bar[XB_XCNT(b.x)], 1u);
    return b;
}
__device__ __forceinline__ void xcd_barrier_complete(unsigned* bar, unsigned x, unsigned& nloc, unsigned& nx) {
    const unsigned G = gridDim.x * gridDim.y * gridDim.z;
    unsigned sum, cnt, mine, sp = 0u;
    for (;;) {
        sum = 0u; cnt = 0u; mine = 0u;
#pragma unroll
        for (unsigned j = 0; j < 16; ++j) { const unsigned c = xb_ld(&bar[XB_XCNT(j)]); sum += c; cnt += (c > 0u) ? 1u : 0u; mine = (j == x) ? c : mine; }
        if (sum == G) break;
        __builtin_amdgcn_s_sleep(1);
        if ((++sp & 255u) == 0u) { if (xb_ld(&bar[XB_TMO])) break; if (sp > XB_SPIN_CAP) { atomicAdd(&bar[XB_TMO], 1u); break; } }
    }
    nloc = mine > 0u ? mine : 1u; nx = cnt > 0u ? cnt : 1u;
}

__device__ __forceinline__ void xcd_barrier(const XcdBarrier& b) {
    asm volatile("s_waitcnt vmcnt(0)" ::: "memory");
    __syncthreads();
    if (threadIdx.x == 0) {
        unsigned* bar = b.bar;
        __builtin_amdgcn_s_waitcnt(0);
        unsigned nloc = b.st[0], nx = b.st[1];
        if (nloc == 0u) { xcd_barrier_complete(bar, b.x, nloc, nx); b.st[0] = nloc; b.st[1] = nx; }
        const unsigned old = xb_add(&bar[XB_XSUB(b.x)], 1u);
        const unsigned gen = old / nloc;
        if (old + 1u == (gen + 1u) * nloc) {
            __builtin_amdgcn_fence(__ATOMIC_RELEASE, "agent");
            asm volatile("s_waitcnt vmcnt(0)" ::: "memory");
            const unsigned og = xb_add(&bar[XB_TOP], 1u);
            const unsigned tg = og / nx;
            if (og + 1u == (tg + 1u) * nx) xb_add(&bar[XB_TOPGEN], 1u);
            else XB_SPIN(xb_ld(&bar[XB_TOPGEN]) == tg, bar);
            __builtin_amdgcn_fence(__ATOMIC_ACQUIRE, "agent");
            xb_add(&bar[XB_XGEN(b.x)], 1u);
            asm volatile("s_waitcnt vmcnt(0)" ::: "memory");
        } else {
            XB_SPIN(xb_ld(&bar[XB_XGEN(b.x)]) == gen, bar);
            __builtin_amdgcn_fence(__ATOMIC_ACQUIRE, "agent");
            asm volatile("s_waitcnt vmcnt(0)" ::: "memory");
        }
    }
    __syncthreads();
}


typedef float f32x2 __attribute__((ext_vector_type(2)));
constexpr int NWAVES = 8;
constexpr int BATCH = 4, SEQ = 4096, DM = 1024, MTOK = BATCH * SEQ;
constexpr int NIN1 = 4864;
constexpr int LATW = 768;
constexpr float C2Q = 0.07216878364870323f * 1.4426950408889634f;

constexpr size_t MiB = 1u << 20, KiB = 1u << 10;
constexpr size_t WS_CTL = 0, CTL_ZERO_BYTES = 64 * KiB;
constexpr size_t WS_SMALL = 1 * MiB;
constexpr size_t SM_RSTDX = 0, SM_SSQ_CQ = 64 * KiB, SM_SSQ_CKV = 128 * KiB, SM_SSQ1 = 192 * KiB, SM_SSQ2 = 256 * KiB, SM_SSQ_RO = 320 * KiB, SM_END = 576 * KiB;
constexpr size_t WS_WIN = 2 * MiB;
constexpr size_t WS_SSQP = 10 * MiB;
constexpr size_t WS_WUQ = WS_WIN + (size_t)8960 * 1024 * 2;
constexpr size_t WS_WUKV = WS_WUQ + (size_t)1536 * 384 * 2;
constexpr size_t WS_XB = 22 * MiB;
constexpr size_t WS_CS = 54 * MiB;
constexpr size_t WS_LAT = 70 * MiB;
constexpr size_t WS_RQ = 94 * MiB, WS_RK = 126 * MiB, WS_RKDT = 158 * MiB, WS_RVT = 190 * MiB;
constexpr size_t WS_QP = 94 * MiB, WS_KVP = 142 * MiB, WS_KF = 206 * MiB;
constexpr size_t WS_MO = 54 * MiB;
constexpr size_t WS_SG = 94 * MiB, WS_TM = 158 * MiB;
constexpr size_t WS_WBR = 190 * MiB, WS_WBM = 194 * MiB, WS_WO = 196 * MiB, WS_WUP = 198 * MiB, WS_WDOWN = 206 * MiB, WS_WPG = 214 * MiB, WS_WPLE = 216 * MiB;
constexpr size_t WS_PB = 217 * MiB;
constexpr size_t WS_H = 54 * MiB;
constexpr size_t WS_GT = 54 * MiB;
constexpr size_t WS_END = 256 * MiB;
static_assert(SM_SSQ_CKV == SM_SSQ_CQ + 65536, "ssq_lat layout");
static_assert(WS_WUKV + (size_t)2048 * 256 * 2 <= WS_XB && WS_RVT + 64 * MiB <= WS_END && WS_KF + 48 * MiB <= WS_END && WS_H + 128 * MiB <= WS_WBR && WS_PB + 8 * MiB <= WS_END, "d_ws map");
constexpr int CW_BAR = 1024;

constexpr int RING_OFF = 0, RING_BYTES = 131072;
constexpr int XS_OFF = RING_BYTES, XS_BYTES = 8 * 2304;
constexpr int MISC_OFF = XS_OFF + XS_BYTES;
constexpr int LDS_BYTES = 160 * 1024;
static_assert(MISC_OFF + 128 <= LDS_BYTES, "LDS map");

struct Frame {
    LAS unsigned char* lds; volatile LAS unsigned* MISC; int tid, lane, wave, G, vcu;
    float* out; unsigned char* ws;
};
__device__ __forceinline__ float wave_sum(float v) {
#pragma unroll
    for (int o = 1; o < 64; o <<= 1) v += __shfl_xor(v, o);
    return v;
}
__device__ __forceinline__ void p0_transpose_item(const float* W, int ldw, int K, int src_col, bf16* WT, int dst_row, int ncols, const float* gain, LAS float* scr, int item, int lane) {
    const int nblk = ncols / 32, kb = item / nblk, nb = item % nblk, k0 = 64 * kb, n0 = 32 * nb;
#pragma unroll 8
    for (int i = 0; i < 32; ++i) { const int kk = 2 * i + (lane >> 5); const float gk = gain ? gain[k0 + kk] : 1.0f; scr[kk * 33 + (lane & 31)] = W[(size_t)(k0 + kk) * ldw + src_col + n0 + (lane & 31)] * gk; }
    LDS_WAIT(); asm volatile("" ::: "memory");
    const int c = lane & 7;
#pragma unroll
    for (int j = 0; j < 4; ++j) { const int n = (lane >> 3) + 8 * j; const LAS float* s = scr + (8 * c) * 33 + n;
        v4u o; o.x = pk2(s[0 * 33], s[1 * 33]); o.y = pk2(s[2 * 33], s[3 * 33]); o.z = pk2(s[4 * 33], s[5 * 33]); o.w = pk2(s[6 * 33], s[7 * 33]);
        *(GAS v4u*)(WT + (size_t)(dst_row + n0 + n) * K + k0 + 8 * c) = o; }
    LDS_WAIT(); asm volatile("" ::: "memory");
}
#define P0_SEG(W, ldw, K, src, WT, dst, ncols, gain) { const int n_ = ((K) / 64) * ((ncols) / 32); if (r < n_) { p0_transpose_item(W, ldw, K, src, WT, dst, ncols, gain, scr, r, F.lane); continue; } r -= n_; }
__device__ __forceinline__ void phase_p0(Frame& F, const float* x, const int* pos, const float* g_mix, const float* w_in, const float* g_qlat, const float* g_kvlat, const float* w_uq, const float* w_ukv) {
    LAS float* scr = (LAS float*)(F.lds + RING_OFF + F.wave * 16384);
    const int gw = F.vcu * NWAVES + F.wave, NGW = F.G * NWAVES;
    bf16* WinT = (bf16*)(F.ws + WS_WIN); bf16* WuqT = (bf16*)(F.ws + WS_WUQ); bf16* WukvT = (bf16*)(F.ws + WS_WUKV);
    constexpr int NIT = 16 * (2048 / 32) * 2 + 16 * (4096 / 32) + 16 * (704 / 32) + 6 * (1536 / 32) + 4 * (2048 / 32);
    for (int it = gw; it < NIT; it += NGW) {
        int r = it;
        P0_SEG(w_in, 8896, 1024, 6848, WinT, 0, 2048, g_mix)
        P0_SEG(w_in, 8896, 1024, 4096, WinT, 2048, 2048, g_mix)
        P0_SEG(w_in, 8896, 1024, 0, WinT, 4096, 4096, g_mix)
        P0_SEG(w_in, 8896, 1024, 6144, WinT, 8192, 704, g_mix)
        P0_SEG(w_uq, 1536, 384, 0, WuqT, 0, 1536, g_qlat)
        P0_SEG(w_ukv, 2048, 256, 0, WukvT, 0, 2048, g_kvlat)
    }
    { const int gt = F.vcu * 512 + F.tid; if (gt < 8192) *(GAS v4u*)((unsigned char*)(WinT + (size_t)8896 * 1024) + (size_t)gt * 16) = (v4u){0u, 0u, 0u, 0u}; }
    { bf16* XB = (bf16*)(F.ws + WS_XB); float* rstdx = (float*)(F.ws + WS_SMALL + SM_RSTDX);
      for (int m = gw; m < MTOK; m += NGW) {
          const GAS f32x4* xr = (const GAS f32x4*)(x + (size_t)m * DM) + F.lane; f32x4 v[4]; float s = 0.f;
#pragma unroll
          for (int j = 0; j < 4; ++j) { v[j] = xr[64 * j]; s += (v[j].x * v[j].x + v[j].y * v[j].y) + (v[j].z * v[j].z + v[j].w * v[j].w); }
          s = wave_sum(s);
          GAS unsigned long long* o8 = (GAS unsigned long long*)(XB + (size_t)m * DM) + F.lane;
#pragma unroll
          for (int j = 0; j < 4; ++j) o8[64 * j] = (unsigned long long)pk2(v[j].x, v[j].y) | ((unsigned long long)pk2(v[j].z, v[j].w) << 32);
          if (F.lane == 0) rstdx[m] = 1.0f / sqrtf(s * (1.0f / DM) + 1e-6f);
      } }
    { f32x2* cs = (f32x2*)(F.ws + WS_CS);
      for (int e = F.vcu * 512 + F.tid; e < MTOK * 128; e += F.G * 512) { const int row = e >> 7, i = e & 127;
          const float inv = __builtin_amdgcn_exp2f(-(float)i * (13.287712379549449f / 128.0f));
          double rev = (double)pos[row] * (double)inv * 0.15915494309189535; rev -= __builtin_rint(rev);
          const float rf = (float)rev; cs[e] = (f32x2){__builtin_amdgcn_cosf(rf), __builtin_amdgcn_sinf(rf)}; } }
    { float* z = (float*)(F.ws + WS_SMALL + SM_SSQ_CQ); for (int e = F.vcu * 512 + F.tid; e < (int)((SM_END - SM_SSQ_CQ) / 4); e += F.G * 512) z[e] = 0.f; }
}
__device__ __forceinline__ void phase_late_weights(Frame& F, const float* p, const float* w_br, const float* w_bm, const float* w_o, const float* g_mlp, const float* w_up, const float* w_down, const float* g_ple, const float* w_pg, const float* w_ple) {
    LAS float* scr = (LAS float*)(F.lds + RING_OFF + F.wave * 16384);
    const int gw = F.vcu * NWAVES + F.wave, NGW = F.G * NWAVES;
    constexpr int NIT = 32 * 32 + 16 * 32 + 16 * 32 + 16 * 128 + 64 * 32 + 16 * 32 + 4 * 32;
    for (int it = gw; it < NIT; it += NGW) {
        int r = it;
        P0_SEG(w_br, 1024, 2048, 0, (bf16*)(F.ws + WS_WBR), 0, 1024, (const float*)nullptr)
        P0_SEG(w_bm, 1024, 1024, 0, (bf16*)(F.ws + WS_WBM), 0, 1024, (const float*)nullptr)
        P0_SEG(w_o, 1024, 1024, 0, (bf16*)(F.ws + WS_WO), 0, 1024, (const float*)nullptr)
        P0_SEG(w_up, 4096, 1024, 0, (bf16*)(F.ws + WS_WUP), 0, 4096, g_mlp)
        P0_SEG(w_down, 1024, 4096, 0, (bf16*)(F.ws + WS_WDOWN), 0, 1024, (const float*)nullptr)
        P0_SEG(w_pg, 1024, 1024, 0, (bf16*)(F.ws + WS_WPG), 0, 1024, g_ple)
        P0_SEG(w_ple, 1024, 256, 0, (bf16*)(F.ws + WS_WPLE), 0, 1024, (const float*)nullptr)
    }
    { bf16* PB = (bf16*)(F.ws + WS_PB);
      for (int e = F.vcu * 512 + F.tid; e < MTOK * 256 / 8; e += F.G * 512) { const f32x4 a = *(const GAS f32x4*)(p + (size_t)e * 8), b = *(const GAS f32x4*)(p + (size_t)e * 8 + 4);
          *(GAS v4u*)(PB + (size_t)e * 8) = (v4u){pk2(a.x, a.y), pk2(a.z, a.w), pk2(b.x, b.y), pk2(b.z, b.w)}; } }
}

typedef float f32x16 __attribute__((ext_vector_type(16)));
typedef unsigned u32x2 __attribute__((ext_vector_type(2)));
typedef short v4i16_t __attribute__((ext_vector_type(4)));
__device__ __forceinline__ int crow(int r, int hi) { return (r & 3) + 8 * (r >> 2) + 4 * hi; }
typedef __bf16 bf16x2m_t __attribute__((ext_vector_type(2)));
__device__ __forceinline__ unsigned cvtpk(float lo, float hi) { f32x2 v = {lo, hi}; bf16x2m_t b = __builtin_convertvector(v, bf16x2m_t); return __builtin_bit_cast(unsigned, b); }
__device__ __forceinline__ bf16x8 pack8f(const f32x16& p, int b) { v4u w = {cvtpk(p[b], p[b + 1]), cvtpk(p[b + 2], p[b + 3]), cvtpk(p[b + 4], p[b + 5]), cvtpk(p[b + 6], p[b + 7])}; return __builtin_bit_cast(bf16x8, w); }
__device__ __forceinline__ float bf2f(bf16 v) { return __uint_as_float((unsigned)v << 16); }
__device__ __forceinline__ float log2_gamma(int h) { return __builtin_amdgcn_logf(1.0f - __builtin_amdgcn_exp2f(-5.0f - (float)h)); }

__device__ __forceinline__ void phase_r0(Frame& F) {
    const bf16* RQ = (const bf16*)(F.ws + WS_RQ); const bf16* RK = (const bf16*)(F.ws + WS_RK); const bf16* RVT = (const bf16*)(F.ws + WS_RVT); bf16* RO = (bf16*)F.out;
    const int lane = F.lane, w = F.wave, l31 = lane & 31, hi = lane >> 5, tq = w & 3, dh = w >> 2;
    for (int unit = F.vcu; unit < 512; unit += F.G) {
        const int bh = unit >> 5, c = unit & 31, b = bh >> 2, h = bh & 3; const size_t tok0 = (size_t)b * SEQ + c * 128;
        const float lg2 = log2_gamma(h);
        bf16x8 qf[16];
#pragma unroll
        for (int ks = 0; ks < 16; ++ks) qf[ks] = *(const bf16x8*)(RQ + (tok0 + 32 * tq + l31) * 1024 + h * 256 + 16 * ks + 8 * hi);
        bf16x8 pf[4][2];
#pragma unroll
        for (int tb = 0; tb < 4; ++tb) {
            pf[tb][0] = (bf16x8){0, 0, 0, 0, 0, 0, 0, 0}; pf[tb][1] = pf[tb][0];
            if (tb <= tq) {
                f32x16 s = {};
#pragma unroll
                for (int ks = 0; ks < 16; ++ks) { const bf16x8 kf = *(const bf16x8*)(RK + (tok0 + 32 * tb + l31) * 1024 + h * 256 + 16 * ks + 8 * hi); s = __builtin_amdgcn_mfma_f32_32x32x16_bf16(kf, qf[ks], s, 0, 0, 0); }
#pragma unroll
                for (int r = 0; r < 16; ++r) { const int d = (32 * tq + l31) - (32 * tb + crow(r, hi)); s[r] = d >= 0 ? s[r] * __builtin_amdgcn_exp2f((float)d * lg2) : 0.f; }
                pf[tb][0] = pack8f(s, 0); pf[tb][1] = pack8f(s, 8);
            }
        }
#pragma unroll 1
        for (int db = 0; db < 8; ++db) {
            f32x16 o = {};
#pragma unroll
            for (int tb = 0; tb < 4; ++tb)
                if (tb <= tq) {
#pragma unroll
                    for (int s2 = 0; s2 < 2; ++s2) { const bf16* vp = RVT + ((size_t)bh * 512 + 256 * dh + 32 * db + l31) * 4096 + c * 128 + 32 * tb + 16 * s2 + 4 * hi;
                        const u32x2 lo = *(const u32x2*)vp, hh = *(const u32x2*)(vp + 8); const v4u w4 = {lo.x, lo.y, hh.x, hh.y};
                        o = __builtin_amdgcn_mfma_f32_32x32x16_bf16(pf[tb][s2], __builtin_bit_cast(bf16x8, w4), o, 0, 0, 0); }
                }
#pragma unroll
            for (int r = 0; r < 16; ++r) RO[(tok0 + 32 * tq + crow(r, hi)) * 2048 + h * 512 + 256 * dh + 32 * db + l31] = (bf16)f2bf(o[r]);
        }
    }
}
__device__ __forceinline__ void phase_r1(Frame& F) {
    const bf16* RQ = (const bf16*)(F.ws + WS_RQ); const bf16* RKDT = (const bf16*)(F.ws + WS_RKDT); const bf16* RVT = (const bf16*)(F.ws + WS_RVT); bf16* RO = (bf16*)F.out;
    float* ssq_ro = (float*)(F.ws + WS_SMALL + SM_SSQ_RO);
    const int lane = F.lane, w = F.wave, l31 = lane & 31, hi = lane >> 5, l15 = lane & 15, lq = lane >> 4;
    constexpr int SROW = 528, SBUF = 32 * SROW;
    for (int unit = F.vcu; unit < 256; unit += F.G) {
        const int bh = unit >> 4, j = unit & 15, b = bh >> 2, h = bh & 3;
        const float lg2 = log2_gamma(h), gC = __builtin_amdgcn_exp2f(128.0f * lg2);
        f32x16 S = {};
        __syncthreads();
#pragma unroll
        for (int g = 0; g < 4; ++g) *(LAS u32x2*)(F.lds + l31 * SROW + (32 * w + 8 * g + 4 * hi) * 2) = (u32x2){0u, 0u};
        for (int c = 0; c < 32; ++c) {
            const int cur = c & 1; const size_t tok0 = (size_t)b * SEQ + c * 128;
            __syncthreads();
            f32x4 oi[2] = {(f32x4){0.f, 0.f, 0.f, 0.f}, (f32x4){0.f, 0.f, 0.f, 0.f}};
#pragma unroll
            for (int ks = 0; ks < 8; ++ks) { const bf16x8 a = *(const bf16x8*)(RQ + (tok0 + 16 * w + l15) * 1024 + h * 256 + 32 * ks + 8 * lq);
#pragma unroll
                for (int nb = 0; nb < 2; ++nb) { const bf16x8 bq = *(const LAS bf16x8*)(F.lds + cur * SBUF + (16 * nb + l15) * SROW + (32 * ks + 8 * lq) * 2);
                    oi[nb] = __builtin_amdgcn_mfma_f32_16x16x32_bf16(a, bq, oi[nb], 0, 0, 0); } }
#pragma unroll
            for (int i = 0; i < 4; ++i) { const int tt = 16 * w + 4 * lq + i; const float qd = __builtin_amdgcn_exp2f((float)(tt + 1) * lg2); float q = 0.f;
#pragma unroll
                for (int nb = 0; nb < 2; ++nb) { bf16* p = RO + (tok0 + tt) * 2048 + h * 512 + 32 * j + 16 * nb + l15; const float v = bf2f(*p) + qd * oi[nb][i]; *p = (bf16)f2bf(v); q += v * v; }
                q += __shfl_xor(q, 1); q += __shfl_xor(q, 2); q += __shfl_xor(q, 4); q += __shfl_xor(q, 8);
                if (l15 == 0) atomicAdd(ssq_ro + (tok0 + tt) * 4 + h, q); }
#pragma unroll
            for (int r = 0; r < 16; ++r) S[r] *= gC;
#pragma unroll
            for (int ks = 0; ks < 8; ++ks) { const bf16x8 a = *(const bf16x8*)(RKDT + ((size_t)bh * 256 + 32 * w + l31) * 4096 + c * 128 + 16 * ks + 8 * hi);
                const bf16x8 bv = *(const bf16x8*)(RVT + ((size_t)bh * 512 + 32 * j + l31) * 4096 + c * 128 + 16 * ks + 8 * hi);
                S = __builtin_amdgcn_mfma_f32_32x32x16_bf16(a, bv, S, 0, 0, 0); }
#pragma unroll
            for (int g = 0; g < 4; ++g) *(LAS u32x2*)(F.lds + (cur ^ 1) * SBUF + l31 * SROW + (32 * w + 8 * g + 4 * hi) * 2) = (u32x2){cvtpk(S[4 * g], S[4 * g + 1]), cvtpk(S[4 * g + 2], S[4 * g + 3])};
        }
    }
    __syncthreads();
}
__device__ __forceinline__ void phase_fin(Frame& F, const float* qn, const float* kn) {
    bf16* QP = (bf16*)(F.ws + WS_QP); const bf16* KVP = (const bf16*)(F.ws + WS_KVP); const bf16* LAT = (const bf16*)(F.ws + WS_LAT); bf16* KF = (bf16*)(F.ws + WS_KF);
    const f32x2* cs = (const f32x2*)(F.ws + WS_CS);
    const int gw = F.vcu * NWAVES + F.wave, NGW = F.G * NWAVES, lane = F.lane, h = lane >> 3, part = lane & 7;
    for (int tok = gw; tok < MTOK; tok += NGW) {
#pragma unroll
        for (int which = 0; which < 2; ++which) {
            float v[3][8]; float ssq = 0.f;
#pragma unroll
            for (int r = 0; r < 3; ++r) { v4u wv;
                if (which == 0) wv = *(const v4u*)(QP + (size_t)tok * 1536 + h * 192 + 64 * r + 8 * part);
                else if (r < 2) wv = *(const v4u*)(KVP + (size_t)tok * 2048 + h * 256 + 64 * r + 8 * part);
                else wv = *(const v4u*)(LAT + (size_t)tok * LATW + 640 + 8 * part);
                const unsigned ww[4] = {wv.x, wv.y, wv.z, wv.w};
#pragma unroll
                for (int e = 0; e < 4; ++e) { v[r][2 * e] = __uint_as_float(ww[e] << 16); v[r][2 * e + 1] = __uint_as_float(ww[e] & 0xffff0000u); }
#pragma unroll
                for (int e = 0; e < 8; ++e) ssq += v[r][e] * v[r][e]; }
            ssq += __shfl_xor(ssq, 1); ssq += __shfl_xor(ssq, 2); ssq += __shfl_xor(ssq, 4);
            const float sc = (1.0f / sqrtf(ssq * (1.0f / 192.0f) + 1e-6f)) * (which == 0 ? C2Q : 1.0f);
            const float* gn = which == 0 ? qn : kn;
            bf16* dst = which == 0 ? QP + (size_t)tok * 1536 + h * 192 : KF + (size_t)tok * 1536 + h * 192;
#pragma unroll
            for (int r = 0; r < 3; ++r) {
                float y[8];
#pragma unroll
                for (int e = 0; e < 8; ++e) y[e] = v[r][e] * sc * gn[64 * r + 8 * part + e];
                if (r == 2) {
#pragma unroll
                    for (int e = 0; e < 8; ++e) { const float pr = __shfl_xor(y[e], 4); const f32x2 c = cs[(size_t)tok * 128 + 4 * (8 * (part & 3) + e)];
                        y[e] = part < 4 ? y[e] * c.x - pr * c.y : y[e] * c.x + pr * c.y; }
                }
                *(v4u*)(dst + 64 * r + 8 * part) = (v4u){pk2(y[0], y[1]), pk2(y[2], y[3]), pk2(y[4], y[5]), pk2(y[6], y[7])};
            }
        }
    }
}
__device__ __forceinline__ void phase_attn(Frame& F) {
    const bf16* QP = (const bf16*)(F.ws + WS_QP); const bf16* KVP = (const bf16*)(F.ws + WS_KVP); const bf16* KF = (const bf16*)(F.ws + WS_KF); bf16* MO = (bf16*)(F.ws + WS_MO);
    const int lane = F.lane, w = F.wave, l31 = lane & 31, hi = lane >> 5;
    LAS unsigned char* vst = F.lds + w * 9216; LAS float* al = (LAS float*)(vst + 8704); LAS float* li = al + 32;
    constexpr int VROW = 272;
    const int trb = (4 * hi + ((lane & 15) >> 2)) * VROW + (16 * ((lane >> 4) & 1) + 4 * (lane & 3)) * 2;
    for (int v = F.vcu; v < 256; v += F.G) {
#pragma unroll 1
        for (int half = 0; half < 2; ++half) {
            const int qb = half == 0 ? 15 - (v >> 5) : (v >> 5), bh = v & 31, b = bh >> 3, h = bh & 7;
            const int q0 = qb * 256 + 32 * w; const size_t tb = (size_t)b * SEQ;
            bf16x8 qr[12];
#pragma unroll
            for (int d = 0; d < 12; ++d) qr[d] = *(const bf16x8*)(QP + (tb + q0 + l31) * 1536 + h * 192 + 16 * d + 8 * hi);
            float m_run = -1e30f, l_run = 0.f; f32x16 o[4] = {};
            const int nkt = q0 / 32 + 1;
#pragma unroll 1
            for (int kt = 0; kt < nkt; ++kt) {
                const int k0 = kt * 32;
#pragma unroll
                for (int i = 0; i < 8; ++i) { const int idx = lane + 64 * i, row = idx >> 4, ch = idx & 15;
                    const v4u vv = *(const v4u*)(KVP + (tb + k0 + row) * 2048 + h * 256 + 128 + ch * 8); *(LAS v4u*)(vst + row * VROW + ch * 16) = vv; }
                f32x16 p = {};
#pragma unroll
                for (int d = 0; d < 12; ++d) { const bf16x8 kf = *(const bf16x8*)(KF + (tb + k0 + l31) * 1536 + h * 192 + 16 * d + 8 * hi); p = __builtin_amdgcn_mfma_f32_32x32x16_bf16(kf, qr[d], p, 0, 0, 0); }
                if (kt == nkt - 1) {
#pragma unroll
                    for (int r = 0; r < 16; ++r) if (crow(r, hi) > l31) p[r] = -__builtin_inff();
                }
                float pmax = p[0];
#pragma unroll
                for (int r = 1; r < 16; ++r) pmax = fmaxf(pmax, p[r]);
                pmax = fmaxf(pmax, __shfl_xor(pmax, 32));
                const float mn = fmaxf(m_run, pmax), alpha = __builtin_amdgcn_exp2f(m_run - mn); m_run = mn;
                float ps = 0.f;
#pragma unroll
                for (int r = 0; r < 16; ++r) { p[r] = __builtin_amdgcn_exp2f(p[r] - mn); ps += p[r]; }
                ps += __shfl_xor(ps, 32); l_run = l_run * alpha + ps;
                if (hi == 0) al[l31] = alpha;
                const bf16x8 pa0 = pack8f(p, 0), pa1 = pack8f(p, 8);
                LDS_WAIT();
#pragma unroll
                for (int r = 0; r < 16; ++r) { const float a = al[crow(r, hi)];
#pragma unroll
                    for (int db = 0; db < 4; ++db) o[db][r] *= a; }
#pragma unroll
                for (int db = 0; db < 4; ++db)
#pragma unroll
                    for (int s2 = 0; s2 < 2; ++s2) { LAS unsigned char* ap = vst + trb + (16 * s2) * VROW + db * 64;
                        const v4i16_t lo = __builtin_amdgcn_ds_read_tr16_b64_v4i16((LAS v4i16_t*)ap), hh = __builtin_amdgcn_ds_read_tr16_b64_v4i16((LAS v4i16_t*)(ap + 8 * VROW));
                        const bf16x8 bfv = (bf16x8){lo[0], lo[1], lo[2], lo[3], hh[0], hh[1], hh[2], hh[3]};
                        o[db] = __builtin_amdgcn_mfma_f32_32x32x16_bf16(s2 == 0 ? pa0 : pa1, bfv, o[db], 0, 0, 0); }
                LDS_WAIT();
            }
            if (hi == 0) li[l31] = l_run;
            LDS_WAIT();
#pragma unroll
            for (int r = 0; r < 16; ++r) { const float il = 1.0f / li[crow(r, hi)];
#pragma unroll
                for (int db = 0; db < 4; ++db) MO[(tb + q0 + crow(r, hi)) * 1024 + h * 128 + 32 * db + l31] = (bf16)f2bf(o[db][r] * il); }
            LDS_WAIT();
        }
    }
}

__device__ __forceinline__ void phase_r0p(Frame& F) {
    const bf16* RQ = (const bf16*)(F.ws + WS_RQ); bf16* RK = (bf16*)(F.ws + WS_RK);
    const int lane = F.lane, w = F.wave, l31 = lane & 31, hi = lane >> 5, tq = w & 3, dh = w >> 2;
    for (int unit = F.vcu; unit < 512; unit += F.G) {
        const int bh = unit >> 5, c = unit & 31, h = bh & 3; const size_t blk = (size_t)bh * 32 + c;
        const float lg2 = log2_gamma(h);
        bf16x8 qf[16];
#pragma unroll
        for (int ks = 0; ks < 16; ++ks) qf[ks] = *(const bf16x8*)(RQ + ((blk * 32 + 2 * ks + hi) * 128 + 32 * tq + l31) * 8);
        f32x16 s[2] = {};
#pragma unroll
        for (int x = 0; x < 2; ++x) { const int tb = 2 * dh + x;
            if (tb <= tq) {
#pragma unroll
                for (int ks = 0; ks < 16; ++ks) { const bf16x8 kf = *(const bf16x8*)(RK + ((blk * 32 + 2 * ks + hi) * 128 + 32 * tb + l31) * 8); s[x] = __builtin_amdgcn_mfma_f32_32x32x16_bf16(kf, qf[ks], s[x], 0, 0, 0); }
#pragma unroll
                for (int r = 0; r < 16; ++r) { const int d = (32 * tq + l31) - (32 * tb + crow(r, hi)); s[x][r] = d >= 0 ? s[x][r] * __builtin_amdgcn_exp2f((float)d * lg2) : 0.f; }
            } }
        VM_WAIT(); __syncthreads();
#pragma unroll
        for (int x = 0; x < 2; ++x) { const int tb = 2 * dh + x;
            if (tb <= tq) {
#pragma unroll
                for (int g = 0; g < 4; ++g) *(u32x2*)(RK + ((blk * 32 + 4 * tb + g) * 128 + 32 * tq + l31) * 8 + 4 * hi) = (u32x2){cvtpk(s[x][4 * g], s[x][4 * g + 1]), cvtpk(s[x][4 * g + 2], s[x][4 * g + 3])};
            } }
    }
}
__device__ __forceinline__ void phase_r1p(Frame& F) {
    const bf16* RQ = (const bf16*)(F.ws + WS_RQ); const bf16* RP = (const bf16*)(F.ws + WS_RK); const bf16* RKDT = (const bf16*)(F.ws + WS_RKDT); const bf16* RVT = (const bf16*)(F.ws + WS_RVT); bf16* RO = (bf16*)F.out;
    float* ssqp = (float*)(F.ws + WS_SSQP);
    const int lane = F.lane, w = F.wave, l15 = lane & 15, lq = lane >> 4;
    constexpr int SROW = 528, SBUF = 32 * SROW;
    LAS unsigned char* ost = F.lds + 2 * SBUF + 1024 + w * 1024;
    const int nkp = (w >> 1) + 1;
    for (int unit = F.vcu; unit < 256; unit += F.G) {
        const int bh = unit >> 4, j = unit & 15, b = bh >> 2, h = bh & 3;
        const float lg2 = log2_gamma(h), gC = __builtin_amdgcn_exp2f(128.0f * lg2);
        float qd[4];
#pragma unroll
        for (int i = 0; i < 4; ++i) qd[i] = __builtin_amdgcn_exp2f((float)(16 * w + 4 * lq + i + 1) * lg2);
        f32x4 S[2][2];
#pragma unroll
        for (int mb = 0; mb < 2; ++mb)
#pragma unroll
            for (int nb = 0; nb < 2; ++nb) S[mb][nb] = (f32x4){0.f, 0.f, 0.f, 0.f};
        __syncthreads();
#pragma unroll
        for (int mb = 0; mb < 2; ++mb)
#pragma unroll
            for (int nb = 0; nb < 2; ++nb) *(LAS u32x2*)(F.lds + (16 * nb + l15) * SROW + (32 * w + 16 * mb + 4 * lq) * 2) = (u32x2){0u, 0u};
        const bf16* qp = RQ + (((size_t)bh * 32 * 32 + lq) * 128 + 16 * w + l15) * 8;
        const bf16* pp = RP + (((size_t)bh * 32 * 32 + lq) * 128 + 16 * w + l15) * 8;
        const bf16* kp = RKDT + (((size_t)bh * 32 * 16 + lq) * 256 + 32 * w + l15) * 8;
        const bf16* vp = RVT + (((size_t)bh * 32 * 16 + lq) * 512 + 32 * j + l15) * 8;
        constexpr size_t QC = 32 * 128 * 8, QK = 4 * 128 * 8, KC = 16 * 256 * 8, KK = 4 * 256 * 8, VC = 16 * 512 * 8, VK = 4 * 512 * 8;
        bf16x8 QA[8], PA[4], KA[2][4], VB[2][4];
#pragma unroll
        for (int ks = 0; ks < 8; ++ks) QA[ks] = *(const bf16x8*)(qp + QK * ks);
#pragma unroll
        for (int ks = 0; ks < 4; ++ks) { PA[ks] = (bf16x8){0, 0, 0, 0, 0, 0, 0, 0}; if (ks < nkp) PA[ks] = *(const bf16x8*)(pp + QK * ks); }
#pragma unroll
        for (int mb = 0; mb < 2; ++mb)
#pragma unroll
            for (int ks = 0; ks < 4; ++ks) { KA[mb][ks] = *(const bf16x8*)(kp + mb * 128 + KK * ks); VB[mb][ks] = *(const bf16x8*)(vp + mb * 128 + VK * ks); }
#pragma unroll 1
        for (int c = 0; c < 32; ++c) {
            const int cur = c & 1, cn = c < 31 ? c + 1 : 31; const size_t tok0 = (size_t)b * SEQ + c * 128;
            __syncthreads();
            f32x4 oc[2] = {(f32x4){0.f, 0.f, 0.f, 0.f}, (f32x4){0.f, 0.f, 0.f, 0.f}};
#pragma unroll
            for (int ks = 0; ks < 8; ++ks)
#pragma unroll
                for (int nb = 0; nb < 2; ++nb) { const bf16x8 bq = *(const LAS bf16x8*)(F.lds + cur * SBUF + (16 * nb + l15) * SROW + (32 * ks + 8 * lq) * 2);
                    oc[nb] = __builtin_amdgcn_mfma_f32_16x16x32_bf16(QA[ks], bq, oc[nb], 0, 0, 0); }
#pragma unroll
            for (int ks = 0; ks < 8; ++ks) QA[ks] = *(const bf16x8*)(qp + QC * cn + QK * ks);
#pragma unroll
            for (int nb = 0; nb < 2; ++nb)
#pragma unroll
                for (int i = 0; i < 4; ++i) oc[nb][i] *= qd[i];
#pragma unroll
            for (int ks = 0; ks < 4; ++ks)
                if (ks < nkp) {
#pragma unroll
                    for (int nb = 0; nb < 2; ++nb) oc[nb] = __builtin_amdgcn_mfma_f32_16x16x32_bf16(PA[ks], VB[nb][ks], oc[nb], 0, 0, 0); }
#pragma unroll
            for (int ks = 0; ks < 4; ++ks) if (ks < nkp) PA[ks] = *(const bf16x8*)(pp + QC * cn + QK * ks);
#pragma unroll
            for (int mb = 0; mb < 2; ++mb)
#pragma unroll
                for (int nb = 0; nb < 2; ++nb) { S[mb][nb] *= gC;
#pragma unroll
                    for (int ks = 0; ks < 4; ++ks) S[mb][nb] = __builtin_amdgcn_mfma_f32_16x16x32_bf16(KA[mb][ks], VB[nb][ks], S[mb][nb], 0, 0, 0); }
#pragma unroll
            for (int mb = 0; mb < 2; ++mb)
#pragma unroll
                for (int ks = 0; ks < 4; ++ks) { KA[mb][ks] = *(const bf16x8*)(kp + mb * 128 + KC * cn + KK * ks); VB[mb][ks] = *(const bf16x8*)(vp + mb * 128 + VC * cn + VK * ks); }
#pragma unroll
            for (int i = 0; i < 4; ++i) { float q = 0.f;
#pragma unroll
                for (int nb = 0; nb < 2; ++nb) { const float v = oc[nb][i]; q += v * v; *(LAS unsigned short*)(ost + ((4 * lq + i) * 32 + 16 * nb + l15) * 2) = (unsigned short)f2bf(v); }
                q += __shfl_xor(q, 1); q += __shfl_xor(q, 2); q += __shfl_xor(q, 4); q += __shfl_xor(q, 8);
                if (l15 == 0) ssqp[((tok0 + 16 * w + 4 * lq + i) * 4 + h) * 16 + j] = q; }
            LDS_WAIT();
            { const v4u ov = *(const LAS v4u*)(ost + lane * 16); *(v4u*)(RO + (tok0 + 16 * w + (lane >> 2)) * 2048 + h * 512 + 32 * j + (lane & 3) * 8) = ov; }
#pragma unroll
            for (int mb = 0; mb < 2; ++mb)
#pragma unroll
                for (int nb = 0; nb < 2; ++nb) *(LAS u32x2*)(F.lds + (cur ^ 1) * SBUF + (16 * nb + l15) * SROW + (32 * w + 16 * mb + 4 * lq) * 2) = (u32x2){cvtpk(S[mb][nb][0], S[mb][nb][1]), cvtpk(S[mb][nb][2], S[mb][nb][3])};
        }
    }
    __syncthreads();
}

namespace attn2 {
typedef float f32x16 __attribute__((ext_vector_type(16)));
typedef short s16x4 __attribute__((ext_vector_type(4)));
constexpr int NW = 8, QBLK = 32, KVBLK = 64, QB = NW * QBLK;
constexpr int QS = 1536, KS = 1536, VS = 2048, OS = 1024;
constexpr int SHM_V = KVBLK * 128 * 2, SHM_K = KVBLK * 512;
constexpr int OFF_V = 0, OFF_K = 2 * SHM_V, OFF_WS = OFF_K + 2 * SHM_K, OFF_QR = OFF_WS + NW * 64 * 4, LDS_NEED = OFF_QR + NW * 4096;
constexpr float THR2 = 8.0f * 1.4426950408889634f;
#define A2_SBAR() __builtin_amdgcn_sched_barrier(0)
__device__ __forceinline__ int v_st(int k, int c) { const int kk = (k & ~0xC) | ((k & 4) << 1) | ((k & 8) >> 1); return ((kk >> 3) * 4 + (c >> 5)) * 512 + ((kk & 7) * 32 + (c & 31)) * 2; }
__device__ __forceinline__ int v_rd_base(int lane) { return ((lane & 3) << 3) | (((lane >> 2) & 3) << 6) | (((lane >> 4) & 1) << 5) | (((lane >> 5) & 1) << 8); }
constexpr int v_rd_off(int d0, int ks, int half) { return d0 * 512 + ks * 4096 + half * 2048; }
__device__ __forceinline__ int crow(int r, int hi) { return (r & 3) + 8 * (r >> 2) + 4 * hi; }
typedef __bf16 bf16x2a_t __attribute__((ext_vector_type(2)));
__device__ __forceinline__ unsigned cvtpk(float lo, float hi) { f32x2 v = {lo, hi}; bf16x2a_t b = __builtin_convertvector(v, bf16x2a_t); return __builtin_bit_cast(unsigned, b); }
__device__ __forceinline__ bf16x8 load8(const bf16* p) { return *reinterpret_cast<const bf16x8*>(p); }
__device__ __forceinline__ void mask_tile(f32x16& p0, f32x16& p1, int dq) {
    const float NEG = -__builtin_inff();
#pragma unroll
    for (int r = 0; r < 16; ++r) { const int c = (r & 3) + 8 * (r >> 2); if (dq - c < 0) p0[r] = NEG; if (dq - c - 32 < 0) p1[r] = NEG; }
}
__device__ __forceinline__ void partialSM(f32x16& p0, f32x16& p1, float& m_reg, float& mn, float& alpha) {
    float pmax = p0[0];
#pragma unroll
    for (int r = 1; r < 16; ++r) pmax = fmaxf(pmax, p0[r]);
#pragma unroll
    for (int r = 0; r < 16; ++r) pmax = fmaxf(pmax, p1[r]);
    { auto rr = __builtin_amdgcn_permlane32_swap(__float_as_uint(pmax), __float_as_uint(pmax), false, false); pmax = fmaxf(__uint_as_float(rr[0]), __uint_as_float(rr[1])); }
    if (__builtin_expect(__all((pmax - m_reg) <= THR2), 1)) { mn = m_reg; alpha = 1.f; }
    else { mn = fmaxf(m_reg, pmax); alpha = __builtin_amdgcn_exp2f(m_reg - mn); m_reg = mn; }
#pragma unroll
    for (int r = 0; r < 16; ++r) { p0[r] -= mn; p1[r] -= mn; }
#pragma unroll
    for (int r = 0; r < 16; ++r) p0[r] = __builtin_amdgcn_exp2f(p0[r]);
}
__device__ __forceinline__ void finishSM(f32x16& p0, f32x16& p1, float alpha, float& l_reg, bf16x8& pa0, bf16x8& pa1, bf16x8& pa2, bf16x8& pa3) {
#pragma unroll
    for (int r = 0; r < 16; ++r) p1[r] = __builtin_amdgcn_exp2f(p1[r]);
    float ps = 0;
#pragma unroll
    for (int r = 0; r < 16; ++r) ps += p0[r];
#pragma unroll
    for (int r = 0; r < 16; ++r) ps += p1[r];
    { auto rr = __builtin_amdgcn_permlane32_swap(__float_as_uint(ps), __float_as_uint(ps), false, false); ps = __uint_as_float(rr[0]) + __uint_as_float(rr[1]); }
    l_reg = l_reg * alpha + ps;
#define A2_PK4(P, B_, OUT) do { unsigned a0 = cvtpk(P[B_+0], P[B_+1]), a1 = cvtpk(P[B_+2], P[B_+3]); unsigned b0 = cvtpk(P[B_+4], P[B_+5]), b1 = cvtpk(P[B_+6], P[B_+7]); \
        auto r0 = __builtin_amdgcn_permlane32_swap(a0, b0, false, false); auto r1 = __builtin_amdgcn_permlane32_swap(a1, b1, false, false); \
        v4u w = {r0[0], r1[0], r0[1], r1[1]}; OUT = __builtin_bit_cast(bf16x8, w); } while (0)
    A2_PK4(p0, 0, pa0); A2_PK4(p0, 8, pa1); A2_PK4(p1, 0, pa2); A2_PK4(p1, 8, pa3);
#undef A2_PK4
}
template <int KB>
__device__ __forceinline__ void qkt(f32x16& p0, f32x16& p1, const char* K_lds, const char* qr_lds, int r32, int hi, const bf16x8* qr) {
    p0 = f32x16{}; p1 = f32x16{};
    const char* kbase = K_lds + KB * SHM_K + r32 * 512; const int x = r32 & 15;
#pragma unroll
    for (int d = 0; d < 12; ++d) { const char* a = kbase + ((((2 * d + hi) & 15) ^ x) << 4) + (d >= 8 ? 256 : 0);
        const bf16x8 b0 = *reinterpret_cast<const bf16x8*>(a), b1 = *reinterpret_cast<const bf16x8*>(a + 32 * 512);
        const bf16x8 q = d < 8 ? qr[d < 8 ? d : 0] : *reinterpret_cast<const bf16x8*>(qr_lds + (((d - 8) * 2 + hi) * 32 + r32) * 16);
        p0 = __builtin_amdgcn_mfma_f32_32x32x16_bf16(b0, q, p0, 0, 0, 0);
        p1 = __builtin_amdgcn_mfma_f32_32x32x16_bf16(b1, q, p1, 0, 0, 0); }
}
template <int VB>
__device__ __forceinline__ void pv_tile(f32x16* o, int vb0, bf16x8 pa0, bf16x8 pa1, bf16x8 pa2, bf16x8 pa3) {
#define A2_TRRD(dst, off) asm volatile("ds_read_b64_tr_b16 %0, %1 offset:%2" : "=&v"(dst) : "v"(vb0), "i"(off) : "memory")
#define A2_PV_D0(d0) do { s16x4 l0, l1, l2, l3, h0, h1, h2, h3; constexpr int b_ = VB * SHM_V + v_rd_off(d0, 0, 0); \
        A2_TRRD(l0, b_); A2_TRRD(h0, b_ + 2048); A2_TRRD(l1, b_ + 4096); A2_TRRD(h1, b_ + 6144); A2_TRRD(l2, b_ + 8192); A2_TRRD(h2, b_ + 10240); A2_TRRD(l3, b_ + 12288); A2_TRRD(h3, b_ + 14336); \
        asm volatile("s_waitcnt lgkmcnt(0)" ::: "memory"); A2_SBAR(); \
        o[d0] = __builtin_amdgcn_mfma_f32_32x32x16_bf16(pa0, (bf16x8){l0[0], l0[1], l0[2], l0[3], h0[0], h0[1], h0[2], h0[3]}, o[d0], 0, 0, 0); \
        o[d0] = __builtin_amdgcn_mfma_f32_32x32x16_bf16(pa1, (bf16x8){l1[0], l1[1], l1[2], l1[3], h1[0], h1[1], h1[2], h1[3]}, o[d0], 0, 0, 0); \
        o[d0] = __builtin_amdgcn_mfma_f32_32x32x16_bf16(pa2, (bf16x8){l2[0], l2[1], l2[2], l2[3], h2[0], h2[1], h2[2], h2[3]}, o[d0], 0, 0, 0); \
        o[d0] = __builtin_amdgcn_mfma_f32_32x32x16_bf16(pa3, (bf16x8){l3[0], l3[1], l3[2], l3[3], h3[0], h3[1], h3[2], h3[3]}, o[d0], 0, 0, 0); } while (0)
    A2_PV_D0(0); A2_PV_D0(1); A2_PV_D0(2); A2_PV_D0(3);
#undef A2_PV_D0
#undef A2_TRRD
}
struct BlockRef { const bf16* Q; const bf16* K; const bf16* V; bf16* O; int P0; };
struct Seam { bf16x8 qr[8]; bf16x8 st_v0, st_v1, st_k0, st_k1, st_k2; };
#define A2_VMW() asm volatile("s_waitcnt vmcnt(0)" ::: "memory")
#define A2_VMWN(n) asm volatile("s_waitcnt vmcnt(%0)" :: "i"(n) : "memory")
#define A2_SLOAD(Kp, Vp, k0) do { S.st_v0 = load8((Vp) + (size_t)((k0) + sr) * VS + sc); S.st_v1 = load8((Vp) + (size_t)((k0) + 32 + sr) * VS + sc); \
        const bf16* kp_ = (Kp) + (size_t)((k0) + krow) * KS + kc * 8; S.st_k0 = load8(kp_); S.st_k1 = load8(kp_ + 64); S.st_k2 = load8(kp_ + 128); } while (0)
#define A2_SWRITE_K(bf) do { *(bf16x8*)(K_lds + (bf) * SHM_K + kw0) = S.st_k0; *(bf16x8*)(K_lds + (bf) * SHM_K + kw1) = S.st_k1; *(bf16x8*)(K_lds + (bf) * SHM_K + kw0 + 256) = S.st_k2; } while (0)
#define A2_SWRITE_V(bf) do { *(bf16x8*)(V_lds + (bf) * SHM_V + vst0) = S.st_v0; *(bf16x8*)(V_lds + (bf) * SHM_V + vst1) = S.st_v1; } while (0)
#define A2_SWRITE(bf) do { A2_SWRITE_V(bf); A2_SWRITE_K(bf); } while (0)
#define A2_IDX const int tid = threadIdx.x, wid = __builtin_amdgcn_readfirstlane(tid >> 6), lane = tid & 63, r32 = lane & 31, hi = lane >> 5; \
    const int sr = tid >> 4, sc = (tid & 15) * 8, krow = tid >> 3, kc = tid & 7, kw0 = krow * 512 + ((kc ^ (krow & 15)) << 4), kw1 = krow * 512 + (((kc + 8) ^ (krow & 15)) << 4); \
    char* V_lds = lds + OFF_V; char* K_lds = lds + OFF_K; (void)lane; (void)r32; (void)hi; (void)sr; (void)sc; (void)V_lds
__device__ __forceinline__ void attn_prime(const BlockRef& cur, char* lds, Seam& S) {
    A2_IDX;
#pragma unroll
    for (int d0 = 0; d0 < 8; ++d0) S.qr[d0] = load8(cur.Q + (size_t)(wid * QBLK + r32) * QS + d0 * 16 + hi * 8);
    A2_SLOAD(cur.K, cur.V, 0); A2_VMW(); A2_SWRITE_K(0);
}
__device__ __forceinline__ void attn_block(const BlockRef& cur, const BlockRef& nxt, char* lds, Seam& S) {
    A2_IDX;
    const int NT = (cur.P0 + QB) / KVBLK;
    const int qlo = cur.P0 + wid * QBLK, qm = qlo + r32 - 4 * hi;
    float* ws = (float*)(lds + OFF_WS) + wid * 64; float* li_l = ws, * al_l = ws + 32;
    char* qr_lds = lds + OFF_QR + wid * 4096;
    float m_reg = -1e30f, l_reg = 0; f32x16 o[4] = {};
    const int vst0 = v_st(sr, sc), vst1 = v_st(32 + sr, sc);
    const int vb0 = (int)(uintptr_t)V_lds + v_rd_base(lane);
    const bf16* Kh = cur.K; const bf16* Vh = cur.V;
    { bf16x8 t4[4];
#pragma unroll
      for (int d = 0; d < 4; ++d) t4[d] = load8(cur.Q + (size_t)(wid * QBLK + r32) * QS + 128 + d * 16 + hi * 8);
#pragma unroll
      for (int d = 0; d < 4; ++d) *(bf16x8*)(qr_lds + ((d * 2 + hi) * 32 + r32) * 16) = t4[d]; }
    A2_SWRITE_V(0);
    __syncthreads();
    f32x16 p0, p1; float mn, al; bf16x8 pa0, pa1, pa2, pa3;
#define A2_STEP(t, BUF) do { const bool lastt = (t) + 1 >= NT; \
        A2_SBAR(); { const bf16* Kn = lastt ? nxt.K : Kh; const bf16* Vn = lastt ? nxt.V : Vh; const int k0n = lastt ? 0 : ((t) + 1) * KVBLK; A2_SLOAD(Kn, Vn, k0n); } A2_SBAR(); \
        qkt<BUF>(p0, p1, K_lds, qr_lds, r32, hi, S.qr); \
        if (lastt) { A2_SBAR(); _Pragma("unroll") for (int d0 = 0; d0 < 8; ++d0) S.qr[d0] = load8(nxt.Q + (size_t)(wid * QBLK + r32) * QS + d0 * 16 + hi * 8); A2_SBAR(); } \
        { const int kb_ = (t) * KVBLK; if (kb_ + KVBLK - 1 > qlo) mask_tile(p0, p1, qm - kb_); } \
        partialSM(p0, p1, m_reg, mn, al); finishSM(p0, p1, al, l_reg, pa0, pa1, pa2, pa3); \
        if (__any(al < 1.f)) { if (hi == 0) al_l[r32] = al; asm volatile("s_waitcnt lgkmcnt(0)" ::: "memory"); \
            for (int d_ = 0; d_ < 4; ++d_) for (int r = 0; r < 16; ++r) o[d_][r] *= al_l[crow(r, hi)]; } \
        A2_SBAR(); pv_tile<BUF>(o, vb0, pa0, pa1, pa2, pa3); A2_SBAR(); \
        if (lastt) { A2_VMWN(8); A2_SWRITE_K(0); } else { A2_VMW(); A2_SWRITE((BUF) ^ 1); } \
        __syncthreads(); } while (0)
    for (int t = 0; t < NT; t += 2) { A2_STEP(t, 0); A2_STEP(t + 1, 1); }
#undef A2_STEP
    if (hi == 0) li_l[r32] = l_reg; asm volatile("s_waitcnt lgkmcnt(0)" ::: "memory");
    float rli[16];
#pragma unroll
    for (int r = 0; r < 16; ++r) rli[r] = __builtin_amdgcn_rcpf(li_l[crow(r, hi)]);
    bf16* Ow = cur.O + (size_t)(wid * QBLK) * OS;
#pragma unroll
    for (int r = 0; r < 16; ++r) { const int orow = crow(r, hi);
#pragma unroll
        for (int d0 = 0; d0 < 4; ++d0) { const float v = o[d0][r] * rli[r]; const float vn = __shfl_xor(v, 1);
            if ((r32 & 1) == 0) *(unsigned*)(Ow + (size_t)orow * OS + d0 * 32 + r32) = cvtpk(v, vn); } }
    asm volatile("s_waitcnt lgkmcnt(0)" ::: "memory");
}
}
__device__ __forceinline__ attn2::BlockRef attn2_ref(unsigned char* ws, int v, int pass) {
    const int bh = v >> 3, b = bh >> 3, h = bh & 7, x = v & 7, qb = pass ? 15 - x : x;
    attn2::BlockRef r;
    r.Q = (const bf16*)(ws + WS_QP) + ((size_t)b * SEQ + qb * 256) * 1536 + h * 192; r.K = (const bf16*)(ws + WS_KF) + (size_t)b * SEQ * 1536 + h * 192;
    r.V = (const bf16*)(ws + WS_KVP) + (size_t)b * SEQ * 2048 + h * 256 + 128; r.O = (bf16*)(ws + WS_MO) + ((size_t)b * SEQ + qb * 256) * 1024 + h * 128; r.P0 = qb * 256;
    return r;
}
__device__ __forceinline__ void phase_attn2(Frame& F, char* lds) {
    int L = F.vcu; if (L >= 256) return;
    attn2::Seam S; int pass = 0;
    attn2::BlockRef cur = attn2_ref(F.ws, L, 0);
    attn2::attn_prime(cur, lds, S);
    for (;;) {
        const bool more_pass = pass == 0, more_item = L + F.G < 256, last = !more_pass && !more_item;
        int passn = pass + 1, Ln = L;
        if (!more_pass) { passn = 0; Ln = more_item ? L + F.G : L; }
        const attn2::BlockRef nxt = last ? cur : attn2_ref(F.ws, Ln, passn);
        attn2::attn_block(cur, nxt, lds, S);
        if (last) break;
        cur = nxt; pass = passn; L = Ln;
    }
}

#ifndef MK_N_LAUNCHES
#define MK_N_LAUNCHES 13
#endif
constexpr int N_PHASES = 13;
constexpr int N_LAUNCHES = MK_N_LAUNCHES;
struct Args { const float* in[21]; float* out; unsigned char* ws; int ph_lo, ph_hi; };
#define PG8_SP2 true
#define PG8_ALIGN true
template <class Epi> __device__ __forceinline__ void run_gemm(Frame& F, const pg8::bf16_t* A, int lda, const pg8::bf16_t* Bt, int ldb, int N, int K, const Epi& E) {
    __syncthreads();
    pg8::Gemm g{A, Bt, MTOK, N, K, lda, ldb}; pg8::StaticOrder S; S.init(MTOK, N, F.G, (int)blockIdx.x);
    pg8::gemm_phase<Epi, pg8::StaticOrder, PG8_ALIGN, PG8_SP2>(F.lds + RING_OFF, g, S, E);
}
__global__ void __launch_bounds__(NWAVES * 64, 2) mk_fwd(Args args) {
    extern __shared__ __attribute__((aligned(16))) unsigned char lds[];
    Frame F;
    F.lds = (LAS unsigned char*)lds; F.MISC = (volatile LAS unsigned*)(F.lds + MISC_OFF);
    F.tid = threadIdx.x; F.lane = F.tid & 63; F.wave = __builtin_amdgcn_readfirstlane(F.tid >> 6);
    F.G = gridDim.x; { const int bx = blockIdx.x; F.vcu = (F.G % 8 == 0) ? (bx % 8) * (F.G / 8) + bx / 8 : bx; }
    F.out = args.out; F.ws = args.ws;
    unsigned char* ws = args.ws;
    if (F.tid < 32) F.MISC[F.tid] = 0u;
    __syncthreads();
    XcdBarrier bar; bar.bar = (unsigned*)(ws + WS_CTL) + CW_BAR; bar.x = 0; bar.st = nullptr;
    if (N_LAUNCHES == 1) bar = xcd_barrier_post((unsigned*)(ws + WS_CTL) + CW_BAR, F.MISC + 8);
    const int lo = args.ph_lo, hi = args.ph_hi;
#ifndef PH_MASK
#define PH_MASK 0x1fff
#endif
#define IN(k) (((PH_MASK >> (k)) & 1) && lo <= (k) && (k) < hi)
#define SEAM(k) do { if (IN(k) && IN((k) + 1)) xcd_barrier(bar); } while (0)
#ifdef STRETCH_MASK
#define PH_T0() const unsigned long long t0_ = __builtin_amdgcn_s_memrealtime()
#define PH_STRETCH(k) do { if ((STRETCH_MASK >> (k)) & 1) { const unsigned long long t1_ = __builtin_amdgcn_s_memrealtime(); const unsigned long long d_ = (t1_ - t0_) * STRETCH_MULT; while (__builtin_amdgcn_s_memrealtime() - t1_ < d_) __builtin_amdgcn_s_sleep(8); } } while (0)
#else
#define PH_T0() do {} while (0)
#define PH_STRETCH(k) do {} while (0)
#endif
    float* sm = (float*)(ws + WS_SMALL);
    const float* rstdx = sm + SM_RSTDX / 4; float* ssq_cq = sm + SM_SSQ_CQ / 4; float* ssq_ckv = sm + SM_SSQ_CKV / 4; float* ssq1 = sm + SM_SSQ1 / 4; float* ssq2 = sm + SM_SSQ2 / 4; float* ssq_ro = sm + SM_SSQ_RO / 4;
    typedef pg8::bf16_t b16;
    b16* WinT = (b16*)(ws + WS_WIN); b16* XB = (b16*)(ws + WS_XB); b16* LATb = (b16*)(ws + WS_LAT); b16* ROb = (b16*)args.out;

    if (IN(0)) { PH_T0(); phase_p0(F, args.in[0], (const int*)args.in[2], args.in[3], args.in[4], args.in[6], args.in[7], args.in[8], args.in[9]); PH_STRETCH(0); } SEAM(0);
    if (IN(1)) { PH_T0();
        pg8::EpiInProj E{rstdx, (const pg8::f32x4*)(ws + WS_CS), (b16*)(ws + WS_RQ), (b16*)(ws + WS_RK), (b16*)(ws + WS_RKDT), (b16*)(ws + WS_RVT), LATb, ssq_cq, (PG8_LAS unsigned char*)(F.lds + XS_OFF)};
        run_gemm(F, XB, 1024, WinT + (size_t)4096 * 1024, 1024, NIN1, 1024, E);
    PH_STRETCH(1); } SEAM(1);
    if (IN(2)) { PH_T0(); phase_r0p(F); PH_STRETCH(2); } SEAM(2);
    if (IN(3)) { PH_T0(); phase_r1p(F); PH_STRETCH(3); } SEAM(3);
    if (IN(4)) { PH_T0();
        { pg8::EpiRetGate E{ROb, rstdx, (const float*)(ws + WS_SSQP), args.in[5]}; run_gemm(F, XB, 1024, WinT + (size_t)2048 * 1024, 1024, 2048, 1024, E); }
        { pg8::EpiRowAct<0> E{(b16*)(ws + WS_QP), 1536, ssq_cq, 1.0f / 384.0f}; run_gemm(F, LATb, LATW, (const b16*)(ws + WS_WUQ), 384, 1536, 384, E); }
        { pg8::EpiRowAct<0> E{(b16*)(ws + WS_KVP), 2048, ssq_ckv, 1.0f / 256.0f}; run_gemm(F, LATb + 384, LATW, (const b16*)(ws + WS_WUKV), 256, 2048, 256, E); }
    PH_STRETCH(4); } SEAM(4);
    if (IN(5)) { PH_T0(); phase_fin(F, args.in[10], args.in[11]); PH_STRETCH(5); } SEAM(5);
#ifdef ATTN_V1
    if (IN(6)) { PH_T0(); phase_attn(F); PH_STRETCH(6); } SEAM(6);
#else
    if (IN(6)) { PH_T0(); phase_attn2(F, (char*)lds); PH_STRETCH(6); } SEAM(6);
#endif
    if (IN(7)) { PH_T0();
#ifndef SKIP_LATE
        phase_late_weights(F, args.in[1], args.in[12], args.in[13], args.in[14], args.in[15], args.in[16], args.in[17], args.in[18], args.in[19], args.in[20]);
#endif
        { pg8::EpiRowAct<1> E{(b16*)(ws + WS_SG), 2048, rstdx, 0.f}; run_gemm(F, XB, 1024, WinT, 1024, 2048, 1024, E); }
    PH_STRETCH(7); } SEAM(7);
    if (IN(8)) { PH_T0();
        { pg8::EpiGateMix<0> E{(b16*)(ws + WS_TM), (const b16*)(ws + WS_SG), 0}; run_gemm(F, ROb, 2048, (const b16*)(ws + WS_WBR), 2048, 1024, 2048, E); }
        VM_WAIT(); __syncthreads(); __builtin_amdgcn_fence(__ATOMIC_ACQUIRE, "agent"); VM_WAIT(); __syncthreads();
        { pg8::EpiGateMix<1> E{(b16*)(ws + WS_TM), (const b16*)(ws + WS_SG), 1024}; run_gemm(F, (const b16*)(ws + WS_MO), 1024, (const b16*)(ws + WS_WBM), 1024, 1024, 1024, E); }
    PH_STRETCH(8); } SEAM(8);
    if (IN(9)) { PH_T0(); pg8::EpiResid E{args.in[0], args.out, XB, ssq1}; run_gemm(F, (const b16*)(ws + WS_TM), 1024, (const b16*)(ws + WS_WO), 1024, 1024, 1024, E); PH_STRETCH(9); } SEAM(9);
    if (IN(10)) { PH_T0(); pg8::EpiRowAct<2> E{(b16*)(ws + WS_H), 4096, ssq1, 1.0f / 1024.0f}; run_gemm(F, XB, 1024, (const b16*)(ws + WS_WUP), 1024, 4096, 1024, E); PH_STRETCH(10); } SEAM(10);
    if (IN(11)) { PH_T0(); pg8::EpiResid E{args.out, args.out, XB, ssq2}; run_gemm(F, (const b16*)(ws + WS_H), 4096, (const b16*)(ws + WS_WDOWN), 4096, 1024, 4096, E); PH_STRETCH(11); } SEAM(11);
    if (IN(12)) { PH_T0();
        { pg8::EpiRowAct<1> E{(b16*)(ws + WS_GT), 1024, ssq2, 1.0f / 1024.0f}; run_gemm(F, XB, 1024, (const b16*)(ws + WS_WPG), 1024, 1024, 1024, E); }
        VM_WAIT(); __syncthreads(); __builtin_amdgcn_fence(__ATOMIC_ACQUIRE, "agent"); VM_WAIT(); __syncthreads();
        { pg8::EpiFinal E{args.out, (const b16*)(ws + WS_GT)}; run_gemm(F, (const b16*)(ws + WS_PB), 256, (const b16*)(ws + WS_WPLE), 256, 1024, 256, E); }
    PH_STRETCH(12); }
#undef IN
#undef SEAM
}


#ifdef DUMPK
struct DumpArgs { const unsigned* reg[6]; unsigned nw[6]; unsigned* out; int own; int pad; };
__global__ void dump_hash(DumpArgs d) {
    for (unsigned i = blockIdx.x * blockDim.x + threadIdx.x; i < (unsigned)MTOK * DM; i += gridDim.x * blockDim.x) {
        float s = 0.f;
        if (d.own) { const unsigned w = d.out[i]; s += __uint_as_float(w << 16) + __uint_as_float(w & 0xffff0000u); }
        for (int r = 0; r < 6; ++r) if (d.reg[r] && i < d.nw[r] * 2u) { const unsigned short v = ((const unsigned short*)d.reg[r])[i]; s += __uint_as_float((unsigned)v << 16); }
        ((float*)d.out)[i] = s;
    }
}
#endif
extern "C" void kernel_launch(void* const* d_in, const int* in_sizes, int n_in, void* d_out, int out_size, void* d_ws, size_t ws_size, hipStream_t stream) {
    static int grid = 0;
    if (grid == 0) {
        if (n_in != 21 || in_sizes[0] != MTOK * DM || out_size != MTOK * DM || ws_size < WS_END) { fprintf(stderr, "kernel_launch: unexpected shapes (n_in %d in0 %d out %d ws %zu)\n", n_in, n_in > 0 ? in_sizes[0] : -1, out_size, ws_size); grid = -1; return; }
        int dev = 0, cus = 0, per_cu = 0;
        if (hipGetDevice(&dev) != hipSuccess || hipDeviceGetAttribute(&cus, hipDeviceAttributeMultiprocessorCount, dev) != hipSuccess) { grid = -1; return; }
        if (hipFuncSetAttribute((const void*)mk_fwd, hipFuncAttributeMaxDynamicSharedMemorySize, LDS_BYTES) != hipSuccess) { fprintf(stderr, "kernel_launch: hipFuncSetAttribute failed\n"); grid = -1; return; }
        if (hipOccupancyMaxActiveBlocksPerMultiprocessor(&per_cu, (const void*)mk_fwd, NWAVES * 64, LDS_BYTES) != hipSuccess || per_cu < 1) { fprintf(stderr, "kernel_launch: occupancy query says %d workgroups per CU\n", per_cu); (void)hipGetLastError(); grid = -1; return; }
        grid = cus;
    }
    if (grid < 0) return;
    (void)hipMemsetAsync((char*)d_ws + WS_CTL, 0, CTL_ZERO_BYTES, stream);
    Args a{};
    for (int i = 0; i < 21; ++i) a.in[i] = (const float*)d_in[i];
    a.out = (float*)d_out; a.ws = (unsigned char*)d_ws;
    if (N_LAUNCHES == 1) { a.ph_lo = 0; a.ph_hi = N_PHASES; hipLaunchKernelGGL(mk_fwd, dim3(grid), dim3(NWAVES * 64), LDS_BYTES, stream, a); }
    else for (int ph = 0; ph < N_PHASES; ++ph) {
#ifdef DUMPK
        if (ph > DUMPK) break;
#endif
        a.ph_lo = ph; a.ph_hi = ph + 1; hipLaunchKernelGGL(mk_fwd, dim3(grid), dim3(NWAVES * 64), LDS_BYTES, stream, a); }
#ifdef DUMPK
    { DumpArgs d{}; d.out = (unsigned*)d_out; d.own = DUMP_OWN; const size_t offs[6] = DUMP_OFFS; const size_t len[6] = DUMP_LENS;
      for (int r = 0; r < 6; ++r) if (len[r]) { d.reg[r] = (const unsigned*)((const char*)d_ws + offs[r]); d.nw[r] = (unsigned)(len[r] / 4); }
      hipLaunchKernelGGL(dump_hash, dim3(2048), dim3(256), 0, stream, d); }
#endif
}
```

```cpp
#define MK_N_LAUNCHES 1
#include <hip/hip_runtime.h>
#include <hip/hip_bf16.h>
#include <cstdio>
#include <cstdint>
namespace pg8 {
#define PG8_LAS __attribute__((address_space(3)))
typedef unsigned short bf16_t;
typedef short bf16x8 __attribute__((ext_vector_type(8)));
typedef float f32x4 __attribute__((ext_vector_type(4)));
typedef unsigned u32x4 __attribute__((ext_vector_type(4)));
constexpr int BM = 256, BK = 64, HALF = 128, HTB = HALF * BK * 2  , STAGE_BYTES = 8 * HTB, NXCD = 8, WGM = 8;

__host__ __device__ __forceinline__ int lds_byte(int r, int c) { const int st = (r >> 4) * 2 + (c >> 5), rr = r & 15, cc = c & 31, ob = rr * 64 + cc * 2; return st * 1024 + (ob ^ (((ob >> 9) & 1) << 5)); }
__host__ __device__ __forceinline__ void stage_rc(int b, int& R, int& C) { const int st = b / 1024, sb = b % 1024, swz = sb ^ (((sb >> 9) & 1) << 5); R = (st >> 1) * 16 + swz / 64; C = (st & 1) * 32 + (swz % 64) / 2; }
__host__ __device__ __forceinline__ int perm32(int rho) { const int n = rho >> 4, i = rho & 15; return 8 * (i >> 2) + 4 * n + (i & 3); }

struct Unit { int pm, pn; };
struct Gemm { const bf16_t* A; const bf16_t* Bt; int M, N, K, lda, ldb; };

struct StaticOrder {
    int nM, nN, nwg, G, c;
    __host__ __device__ void init(int M, int N, int G_, int c_) { nM = M / BM; nN = N / BM; nwg = nM * nN; G = G_; c = c_; }
    __host__ __device__ bool next(int i, Unit& u) const {
        const long L = (long)i * G + c; if (L >= nwg) return false;
        int wgid = (int)L; { const int q = nwg / NXCD, r = nwg % NXCD, xcd = wgid % NXCD, off = wgid / NXCD; wgid = (xcd < r ? xcd * (q + 1) : r * (q + 1) + (xcd - r) * q) + off; }
        const int nig = WGM * nN, gid = wgid / nig, fm = gid * WGM, gsz = (nM - fm) < WGM ? (nM - fm) : WGM;
        u.pm = fm + ((wgid % nig) % gsz); u.pn = (wgid % nig) / gsz; return true;
    }
    __device__ __forceinline__ void a_ready(const Unit&) const {}
    __device__ __forceinline__ void done(const Unit&) const {}
};


typedef float f32x2 __attribute__((ext_vector_type(2)));
typedef __bf16 bf16x2_t __attribute__((ext_vector_type(2)));
__device__ __forceinline__ unsigned cvt_pk_bf16(float lo, float hi) { f32x2 v = {lo, hi}; bf16x2_t b = __builtin_convertvector(v, bf16x2_t); return __builtin_bit_cast(unsigned, b); }
__device__ __forceinline__ float bflo(unsigned w) { return __uint_as_float(w << 16); }
__device__ __forceinline__ float bfhi(unsigned w) { return __uint_as_float(w & 0xffff0000u); }
__device__ __forceinline__ u32x4 pack8(const float (&v)[8]) { u32x4 w; w.x = cvt_pk_bf16(v[0], v[1]); w.y = cvt_pk_bf16(v[2], v[3]); w.z = cvt_pk_bf16(v[4], v[5]); w.w = cvt_pk_bf16(v[6], v[7]); return w; }
__device__ __forceinline__ void unpack8(const u32x4 w, float (&v)[8]) { v[0] = bflo(w.x); v[1] = bfhi(w.x); v[2] = bflo(w.y); v[3] = bfhi(w.y); v[4] = bflo(w.z); v[5] = bfhi(w.z); v[6] = bflo(w.w); v[7] = bfhi(w.w); }
__device__ __forceinline__ float sigmoidf_(float x) { return __builtin_amdgcn_rcpf(1.0f + __builtin_amdgcn_exp2f(-1.4426950408889634f * x)); }
constexpr float RMS_EPS_ = 1e-6f;

#define EPI_ACC8(v, ai, bj, m) float v[8]; { const f32x4 a0_ = acc[ai][bj][m][0], a1_ = acc[ai][bj][m][1]; v[0] = a0_[0]; v[1] = a0_[1]; v[2] = a0_[2]; v[3] = a0_[3]; v[4] = a1_[0]; v[5] = a1_[1]; v[6] = a1_[2]; v[7] = a1_[3]; }

__device__ __forceinline__ void xpose_store(PG8_LAS unsigned char* st, const unsigned (&pk)[4][4], bf16_t* dst, int R, int lane, int fr, int fq) {
#pragma unroll
    for (int pass = 0; pass < 2; ++pass) {
        if ((fq >> 1) == pass) {
#pragma unroll
            for (int m = 0; m < 4; ++m)
#pragma unroll
                for (int q = 0; q < 4; ++q) { const unsigned w = pk[m][q]; const int c = (fq & 1) * 8 + 2 * q;
                    *(PG8_LAS unsigned short*)(st + c * 144 + (16 * m + fr) * 2) = (unsigned short)(w & 0xffffu);
                    *(PG8_LAS unsigned short*)(st + (c + 1) * 144 + (16 * m + fr) * 2) = (unsigned short)(w >> 16); }
        }
        asm volatile("s_waitcnt lgkmcnt(0)" ::: "memory");
#pragma unroll
        for (int k = 0; k < 2; ++k) { const int idx = lane + 64 * k, c = idx & 15, ch = idx >> 4;
            const u32x4 v = *(const PG8_LAS u32x4*)(st + c * 144 + ch * 16);
            *(u32x4*)(dst + ((size_t)ch * R + pass * 16 + c) * 8) = v; }
        asm volatile("s_waitcnt lgkmcnt(0)" ::: "memory");
    }
}

struct EpiInProj {
    static constexpr bool PERM = true, AFTER_DRAIN = false, TWICE_OK = true; static __device__ __forceinline__ bool twice(const Unit& u) { return u.pn < 16; }
    const float* rstdx; const f32x4* cs;
    bf16_t *RQ, *RK, *RKDT, *RVT, *LAT; float *ssq_lat;   PG8_LAS unsigned char* xs;
    __device__ __forceinline__ void operator()(const f32x4 (&acc)[2][2][4][2], const Unit& u, int wr, int wc, int fr, int fq) const {
        const int pn = u.pn, lane = fq * 16 + fr, wid = wr * 4 + wc;
        PG8_LAS unsigned char* st = xs + wid * 2304;
        const int rowt = u.pm * BM + wr * 64 + fr;
        const int bidx = (u.pm * BM) >> 12, s0 = (u.pm * BM) & 4095;
        if (pn < 8) {
            const bool isk = pn >= 4; const int head = pn & 3;
            const float lg2 = __builtin_amdgcn_logf(1.0f - __builtin_amdgcn_exp2f(-5.0f - (float)head));
            float kd[4];
#pragma unroll
            for (int m = 0; m < 4; ++m) kd[m] = __builtin_amdgcn_exp2f((float)(127 - (wr * 64 + m * 16 + fr)) * lg2);
            bf16_t* O = isk ? RK : RQ;
#pragma unroll
            for (int ai = 0; ai < 2; ++ai) {
                unsigned pk0[4][4], pk1[4][4];
#pragma unroll
                for (int m = 0; m < 4; ++m) {
                    const int row = rowt + ai * HALF + m * 16; const float rs = rstdx[row] * (isk ? 0.0625f : 1.0f);
                    const f32x4* cp = cs + (size_t)row * 64 + wc * 16 + fq * 4;
                    const f32x4 c0 = cp[0], c1 = cp[1], c2 = cp[2], c3 = cp[3];
                    const float cc[8] = {c0[0], c0[2], c1[0], c1[2], c2[0], c2[2], c3[0], c3[2]}, ss[8] = {c0[1], c0[3], c1[1], c1[3], c2[1], c2[3], c3[1], c3[3]};
                    EPI_ACC8(x1, ai, 0, m); EPI_ACC8(x2, ai, 1, m);
                    float o1[8], o2[8];
#pragma unroll
                    for (int e = 0; e < 8; ++e) { const float a = x1[e] * rs, b = x2[e] * rs; o1[e] = a * cc[e] - b * ss[e]; o2[e] = b * cc[e] + a * ss[e]; }
                    bf16_t* rp = O + ((((size_t)(bidx * 4 + head) * 32 + (s0 >> 7) + ai) * 32 + wc * 4 + fq) * 128 + wr * 64 + m * 16 + fr) * 8;
                    *(u32x4*)rp = pack8(o1); *(u32x4*)(rp + (size_t)16 * 128 * 8) = pack8(o2);
                    if (isk) {
#pragma unroll
                        for (int q = 0; q < 4; ++q) { pk0[m][q] = cvt_pk_bf16(o1[2 * q] * kd[m], o1[2 * q + 1] * kd[m]); pk1[m][q] = cvt_pk_bf16(o2[2 * q] * kd[m], o2[2 * q + 1] * kd[m]); }
                    }
                }
                if (isk) {
                    bf16_t* d0 = RKDT + ((((size_t)(bidx * 4 + head) * 32 + (s0 >> 7) + ai) * 16 + wr * 8) * 256 + wc * 32) * 8;
                    xpose_store(st, pk0, d0, 256, lane, fr, fq);
                    xpose_store(st, pk1, d0 + (size_t)HALF * 8, 256, lane, fr, fq);
                }
            }
        } else if (pn < 16) {
            const int head = (pn - 8) >> 1, dvb = ((pn - 8) & 1) * 256;
#pragma unroll
            for (int ai = 0; ai < 2; ++ai)
#pragma unroll
                for (int bj = 0; bj < 2; ++bj) {
                    unsigned pk[4][4];
#pragma unroll
                    for (int m = 0; m < 4; ++m) { const float rs = rstdx[rowt + ai * HALF + m * 16]; EPI_ACC8(v, ai, bj, m);
#pragma unroll
                        for (int q = 0; q < 4; ++q) pk[m][q] = cvt_pk_bf16(v[2 * q] * rs, v[2 * q + 1] * rs); }
                    bf16_t* d0 = RVT + ((((size_t)(bidx * 4 + head) * 32 + (s0 >> 7) + ai) * 16 + wr * 8) * 512 + dvb + bj * HALF + wc * 32) * 8;
                    xpose_store(st, pk, d0, 512, lane, fr, fq);
                }
        } else {
            const int lt = pn - 16;
#pragma unroll
            for (int ai = 0; ai < 2; ++ai)
#pragma unroll
                for (int m = 0; m < 4; ++m) { const int row = rowt + ai * HALF + m * 16; const float rs = rstdx[row];
#pragma unroll
                    for (int bj = 0; bj < 2; ++bj) { EPI_ACC8(v, ai, bj, m); float q = 0.f;
#pragma unroll
                        for (int e = 0; e < 8; ++e) { v[e] *= rs; q += v[e] * v[e]; }
                        *(u32x4*)(LAT + (size_t)row * 768 + lt * 256 + bj * HALF + wc * 32 + 8 * fq) = pack8(v);
                        const int kind = (lt == 0) ? 0 : (lt == 1 ? (bj == 0 ? 0 : 1) : (bj == 0 ? 1 : 2));
                        if (kind < 2) { q += __shfl_xor(q, 16); q += __shfl_xor(q, 32); if (fq == 0) atomicAdd(ssq_lat + kind * 16384 + row, q); } } }
        }
    }
};

template <int MODE> struct EpiRowAct {
    static constexpr bool PERM = true, AFTER_DRAIN = false, TWICE_OK = (MODE == 2); static __device__ __forceinline__ bool twice(const Unit&) { return true; }
    bf16_t* O; int ldo; const float* rsrc; float inv_dim;
    __device__ __forceinline__ void operator()(const f32x4 (&acc)[2][2][4][2], const Unit& u, int wr, int wc, int fr, int fq) const {
        const int rowt = u.pm * BM + wr * 64 + fr, colt = u.pn * BM + wc * 32 + 8 * fq;
#pragma unroll
        for (int ai = 0; ai < 2; ++ai)
#pragma unroll
            for (int m = 0; m < 4; ++m) { const int row = rowt + ai * HALF + m * 16; const float r0 = rsrc[row]; const float rs = inv_dim == 0.f ? r0 : __builtin_amdgcn_rsqf(r0 * inv_dim + RMS_EPS_);
#pragma unroll
                for (int bj = 0; bj < 2; ++bj) { EPI_ACC8(v, ai, bj, m);
#pragma unroll
                    for (int e = 0; e < 8; ++e) { float x = v[e] * rs; if (MODE == 1) x = sigmoidf_(x); if (MODE == 2) { x = fmaxf(x, 0.f); x = x * x; } v[e] = x; }
                    *(u32x4*)(O + (size_t)row * ldo + colt + bj * HALF) = pack8(v); } }
    }
};
struct EpiRetGate {
    static constexpr bool PERM = true, AFTER_DRAIN = false, TWICE_OK = false; static __device__ __forceinline__ bool twice(const Unit&) { return false; }
    bf16_t* RO; const float* rstdx; const float* ssq_ro; const float* ret_norm;
    __device__ __forceinline__ void operator()(const f32x4 (&acc)[2][2][4][2], const Unit& u, int wr, int wc, int fr, int fq) const {
        const int rowt = u.pm * BM + wr * 64 + fr, colt = u.pn * BM + wc * 32 + 8 * fq, head = u.pn >> 1;
        f32x4 g[2][2];
#pragma unroll
        for (int bj = 0; bj < 2; ++bj) { g[bj][0] = *(const f32x4*)(ret_norm + colt + bj * HALF); g[bj][1] = *(const f32x4*)(ret_norm + colt + bj * HALF + 4); }
#pragma unroll
        for (int ai = 0; ai < 2; ++ai)
#pragma unroll
            for (int m = 0; m < 4; ++m) { const int row = rowt + ai * HALF + m * 16; const float rs = rstdx[row]; const f32x4* sp = (const f32x4*)(ssq_ro + ((size_t)row * 4 + head) * 16); const f32x4 s4 = (sp[0] + sp[1]) + (sp[2] + sp[3]);
                const float rr = __builtin_amdgcn_rsqf(((s4[0] + s4[1]) + (s4[2] + s4[3])) * (1.0f / 512.0f) + RMS_EPS_);
#pragma unroll
                for (int bj = 0; bj < 2; ++bj) { EPI_ACC8(v, ai, bj, m); bf16_t* p = RO + (size_t)row * 2048 + colt + bj * HALF; float o[8]; unpack8(*(const u32x4*)p, o);
#pragma unroll
                    for (int e = 0; e < 8; ++e) { const float x = v[e] * rs; const float gg = e < 4 ? g[bj][0][e & 3] : g[bj][1][e & 3]; v[e] = o[e] * rr * gg * x * sigmoidf_(x); }
                    *(u32x4*)p = pack8(v); } }
    }
};
template <int MODE> struct EpiGateMix {
    static constexpr bool PERM = true, AFTER_DRAIN = false, TWICE_OK = false; static __device__ __forceinline__ bool twice(const Unit&) { return false; }
    bf16_t* TM; const bf16_t* SG; int sgoff;
    __device__ __forceinline__ void operator()(const f32x4 (&acc)[2][2][4][2], const Unit& u, int wr, int wc, int fr, int fq) const {
        const int rowt = u.pm * BM + wr * 64 + fr, colt = u.pn * BM + wc * 32 + 8 * fq;
#pragma unroll
        for (int ai = 0; ai < 2; ++ai)
#pragma unroll
            for (int m = 0; m < 4; ++m) { const int row = rowt + ai * HALF + m * 16;
#pragma unroll
                for (int bj = 0; bj < 2; ++bj) { EPI_ACC8(v, ai, bj, m); float s[8]; unpack8(*(const u32x4*)(SG + (size_t)row * 2048 + sgoff + colt + bj * HALF), s);
                    bf16_t* p = TM + (size_t)row * 1024 + colt + bj * HALF;
                    if (MODE == 1) { float t[8]; unpack8(*(const u32x4*)p, t);
#pragma unroll
                        for (int e = 0; e < 8; ++e) v[e] = t[e] + s[e] * v[e]; }
                    else {
#pragma unroll
                        for (int e = 0; e < 8; ++e) v[e] = s[e] * v[e]; }
                    *(u32x4*)p = pack8(v); } }
    }
};
template <bool RESB> struct EpiResid {
    static constexpr bool PERM = true, AFTER_DRAIN = false, TWICE_OK = false; static __device__ __forceinline__ bool twice(const Unit&) { return false; }
    const void* res; bf16_t* xb; float* ssq;
    __device__ __forceinline__ void operator()(const f32x4 (&acc)[2][2][4][2], const Unit& u, int wr, int wc, int fr, int fq) const {
        const int rowt = u.pm * BM + wr * 64 + fr, colt = u.pn * BM + wc * 32 + 8 * fq;
#pragma unroll
        for (int ai = 0; ai < 2; ++ai)
#pragma unroll
            for (int m = 0; m < 4; ++m) { const int row = rowt + ai * HALF + m * 16; float q = 0.f;
#pragma unroll
                for (int bj = 0; bj < 2; ++bj) { EPI_ACC8(v, ai, bj, m); const size_t off = (size_t)row * 1024 + colt + bj * HALF;
                    if (RESB) { float r[8]; unpack8(*(const u32x4*)((const bf16_t*)res + off), r);
#pragma unroll
                        for (int e = 0; e < 8; ++e) { v[e] += r[e]; q += v[e] * v[e]; } }
                    else { const f32x4 r0 = *(const f32x4*)((const float*)res + off), r1 = *(const f32x4*)((const float*)res + off + 4);
#pragma unroll
                        for (int e = 0; e < 8; ++e) { v[e] += e < 4 ? r0[e & 3] : r1[e & 3]; q += v[e] * v[e]; } }
                    *(u32x4*)(xb + off) = pack8(v); }
                q += __shfl_xor(q, 16); q += __shfl_xor(q, 32); if (fq == 0) atomicAdd(ssq + row, q);
                if (m & 1) asm volatile("" ::: "memory"); }
    }
};
struct EpiFinal {
    static constexpr bool PERM = true, AFTER_DRAIN = false, TWICE_OK = false; static __device__ __forceinline__ bool twice(const Unit&) { return false; }
    float* out; const bf16_t* GT; const bf16_t* xb;
    __device__ __forceinline__ void operator()(const f32x4 (&acc)[2][2][4][2], const Unit& u, int wr, int wc, int fr, int fq) const {
        const int rowt = u.pm * BM + wr * 64 + fr, colt = u.pn * BM + wc * 32 + 8 * fq;
#pragma unroll
        for (int ai = 0; ai < 2; ++ai)
#pragma unroll
            for (int m = 0; m < 4; ++m) { const int row = rowt + ai * HALF + m * 16;
#pragma unroll
                for (int bj = 0; bj < 2; ++bj) { EPI_ACC8(v, ai, bj, m); const size_t off = (size_t)row * 1024 + colt + bj * HALF; float gt[8], r[8]; unpack8(*(const u32x4*)(GT + off), gt); unpack8(*(const u32x4*)(xb + off), r);
#pragma unroll
                    for (int e = 0; e < 8; ++e) v[e] = r[e] + gt[e] * v[e];
                    *(f32x4*)(out + off) = (f32x4){v[0], v[1], v[2], v[3]}; *(f32x4*)(out + off + 4) = (f32x4){v[4], v[5], v[6], v[7]}; }
                if (m & 1) asm volatile("" ::: "memory"); }
    }
};
template <class Epi, class Sched, bool ALIGN_EPI = false, bool SP2 = false>
__device__ __forceinline__ void gemm_phase(PG8_LAS unsigned char* lds, const Gemm g, const Sched& S, const Epi& E) {
    const int tid = threadIdx.x, wid = __builtin_amdgcn_readfirstlane(tid >> 6), lane = tid & 63, wr = wid >> 2, wc = wid & 3, fr = lane & 15, fq = lane >> 4;
    const int K = g.K, nt = K / BK;
    unsigned voffA[2], voffB[2];
#pragma unroll
    for (int i = 0; i < 2; ++i) { int R, C; stage_rc(tid * 16 + i * 8192, R, C); const int Rb = Epi::PERM ? ((R & ~31) + perm32(R & 31)) : R;
        voffA[i] = (unsigned)(R * g.lda + C) * 2u; voffB[i] = (unsigned)(Rb * g.ldb + C) * 2u; }
    const size_t kstep = (size_t)(BK * 2);
    const size_t hstepA = (size_t)HALF * g.lda * 2, hstepB = (size_t)HALF * g.ldb * 2;
    const size_t tstepA = 2 * hstepA, tstepB = 2 * hstepB;
    const unsigned ldsw = (unsigned)wid * 1024u;
    const int aoff = lds_byte(wr * 64 + fr, fq * 8), boff = lds_byte(wc * 32 + fr, fq * 8);
#define PG8_SA(b, h) (((b) * 2 + (h)) * HTB)
#define PG8_SB(b, h) ((4 + (b) * 2 + (h)) * HTB)
#define PG8_STAGE(bufoff, gbase, voff) do { _Pragma("unroll") for (int _i = 0; _i < 2; ++_i) \
        __builtin_amdgcn_global_load_lds((const unsigned*)((const char*)(gbase) + (voff)[_i]), (PG8_LAS unsigned*)(lds + (bufoff) + ldsw + _i * 8192), 16, 0, 0); } while (0)
#define PG8_LDA(dst, b, h) do { _Pragma("unroll") for (int m = 0; m < 4; ++m) _Pragma("unroll") for (int k = 0; k < 2; ++k) dst[m][k] = *(const PG8_LAS bf16x8*)(lds + PG8_SA(b, h) + aoff + m * 2048 + k * 1024); } while (0)
#define PG8_LDB(dst, b, h) do { _Pragma("unroll") for (int n = 0; n < 2; ++n) _Pragma("unroll") for (int k = 0; k < 2; ++k) dst[n][k] = *(const PG8_LAS bf16x8*)(lds + PG8_SB(b, h) + boff + n * 2048 + k * 1024); } while (0)
#define PG8_MMA(ai, bj, At, Bt) do { __builtin_amdgcn_s_setprio(1); _Pragma("unroll") for (int m = 0; m < 4; ++m) _Pragma("unroll") for (int n = 0; n < 2; ++n) _Pragma("unroll") for (int k = 0; k < 2; ++k) \
        acc[ai][bj][m][n] = __builtin_amdgcn_mfma_f32_16x16x32_bf16(Bt[n][k], At[m][k], acc[ai][bj][m][n], 0, 0, 0); __builtin_amdgcn_s_setprio(0); } while (0)
#define PG8_WAIT_V(n) asm volatile("s_waitcnt vmcnt(" #n ")" ::: "memory")
#define PG8_WAIT_L(n) asm volatile("s_waitcnt lgkmcnt(" #n ")" ::: "memory")
#define PG8_BAR __builtin_amdgcn_s_barrier()
#define PG8_SCHED __builtin_amdgcn_sched_barrier(0)
    Unit cur, nxt; int ui = 0;
    if (!S.next(0, cur)) return;
    f32x4 acc[2][2][4][2];
#pragma unroll
    for (int a = 0; a < 2; ++a)
#pragma unroll
        for (int b = 0; b < 2; ++b)
#pragma unroll
            for (int m = 0; m < 4; ++m)
#pragma unroll
                for (int n = 0; n < 2; ++n) acc[a][b][m][n] = (f32x4){0.f, 0.f, 0.f, 0.f};
    bf16x8 At[4][2], B0[2][2], B1[2][2];
    const char* cA = (const char*)g.A + (size_t)cur.pm * tstepA; const char* cB = (const char*)g.Bt + (size_t)cur.pn * tstepB;
    S.a_ready(cur);
    if constexpr (SP2) {
        PG8_STAGE(PG8_SB(0, 0), cB, voffB); PG8_STAGE(PG8_SB(0, 1), cB + hstepB, voffB); PG8_STAGE(PG8_SA(0, 0), cA, voffA); PG8_STAGE(PG8_SA(0, 1), cA + hstepA, voffA);
        if (wr == 1) PG8_BAR;
        PG8_WAIT_V(2); PG8_BAR;
        PG8_STAGE(PG8_SB(1, 0), cB + kstep, voffB); PG8_STAGE(PG8_SA(1, 0), cA + kstep, voffA); PG8_STAGE(PG8_SB(1, 1), cB + hstepB + kstep, voffB);
        PG8_WAIT_V(6); PG8_BAR;
    } else {
        PG8_STAGE(PG8_SB(0, 0), cB, voffB); PG8_STAGE(PG8_SA(0, 0), cA, voffA); PG8_STAGE(PG8_SB(0, 1), cB + hstepB, voffB); PG8_STAGE(PG8_SA(0, 1), cA + hstepA, voffA);
        if (wr == 1) PG8_BAR;
        PG8_WAIT_V(4); PG8_BAR;
        PG8_STAGE(PG8_SB(1, 0), cB + kstep, voffB); PG8_STAGE(PG8_SA(1, 0), cA + kstep, voffA); PG8_STAGE(PG8_SB(1, 1), cB + hstepB + kstep, voffB);
        PG8_WAIT_V(6); PG8_BAR;
    }
    for (;;) {
        const bool has_next = S.next(ui + 1, nxt);
        const char* nA = has_next ? (const char*)g.A + (size_t)nxt.pm * tstepA : cA; const char* nB = has_next ? (const char*)g.Bt + (size_t)nxt.pn * tstepB : cB;
        for (int t = 0; t < nt; t += 2) {
            const bool last = (t == nt - 2);
            const char* a1 = cA + (size_t)(t + 1) * kstep;
            const char* a2 = last ? nA : cA + (size_t)(t + 2) * kstep; const char* b2 = last ? nB : cB + (size_t)(t + 2) * kstep;
            const char* a3 = a2 + kstep; const char* b3 = b2 + kstep;
            if (last && has_next) S.a_ready(nxt);
            if constexpr (SP2) {
            PG8_LDB(B0, 0, 0); PG8_LDB(B1, 0, 1); PG8_SCHED; PG8_LDA(At, 0, 0); PG8_STAGE(PG8_SA(1, 1), a1 + hstepA, voffA);
            PG8_WAIT_V(8); PG8_WAIT_L(0); PG8_BAR; PG8_MMA(0, 0, At, B0); PG8_MMA(0, 1, At, B1); PG8_BAR; PG8_SCHED;
            PG8_LDA(At, 0, 1); PG8_STAGE(PG8_SB(0, 0), b2, voffB); PG8_STAGE(PG8_SB(0, 1), b2 + hstepB, voffB); PG8_STAGE(PG8_SA(0, 0), a2, voffA);
            PG8_WAIT_V(8); PG8_WAIT_L(0); PG8_BAR; PG8_MMA(1, 0, At, B0); PG8_MMA(1, 1, At, B1); PG8_BAR; PG8_SCHED;
            PG8_LDB(B0, 1, 0); PG8_LDB(B1, 1, 1); PG8_SCHED; PG8_LDA(At, 1, 0); PG8_STAGE(PG8_SA(0, 1), a2 + hstepA, voffA);
            PG8_WAIT_V(8); PG8_WAIT_L(0); PG8_BAR; PG8_MMA(0, 0, At, B0); PG8_MMA(0, 1, At, B1); PG8_BAR; PG8_SCHED;
            PG8_LDA(At, 1, 1); PG8_STAGE(PG8_SB(1, 0), b3, voffB); PG8_STAGE(PG8_SB(1, 1), b3 + hstepB, voffB); PG8_STAGE(PG8_SA(1, 0), a3, voffA);
            PG8_WAIT_V(8); PG8_WAIT_L(0); PG8_BAR; PG8_MMA(1, 0, At, B0); PG8_MMA(1, 1, At, B1); PG8_BAR; PG8_SCHED;
            } else {
            PG8_LDB(B0, 0, 0); PG8_SCHED; PG8_LDA(At, 0, 0); PG8_STAGE(PG8_SA(1, 1), a1 + hstepA, voffA);
            PG8_WAIT_L(8); PG8_BAR; PG8_WAIT_L(0); PG8_MMA(0, 0, At, B0); PG8_BAR; PG8_SCHED;
            PG8_LDB(B1, 0, 1); PG8_STAGE(PG8_SB(0, 0), b2, voffB);
            PG8_BAR; PG8_WAIT_L(0); PG8_MMA(0, 1, At, B1); PG8_BAR;
            PG8_LDA(At, 0, 1); PG8_STAGE(PG8_SA(0, 0), a2, voffA);
            PG8_BAR; PG8_WAIT_L(0); PG8_MMA(1, 0, At, B0); PG8_BAR; PG8_SCHED;
            PG8_STAGE(PG8_SB(0, 1), b2 + hstepB, voffB);
            PG8_WAIT_V(6); PG8_BAR; PG8_MMA(1, 1, At, B1); PG8_BAR;
            PG8_LDB(B0, 1, 0); PG8_SCHED; PG8_LDA(At, 1, 0); PG8_STAGE(PG8_SA(0, 1), a2 + hstepA, voffA);
            PG8_WAIT_L(8); PG8_BAR; PG8_WAIT_L(0); PG8_MMA(0, 0, At, B0); PG8_BAR; PG8_SCHED;
            PG8_LDB(B1, 1, 1); PG8_STAGE(PG8_SB(1, 0), b3, voffB);
            PG8_BAR; PG8_WAIT_L(0); PG8_MMA(0, 1, At, B1); PG8_BAR;
            PG8_LDA(At, 1, 1); PG8_STAGE(PG8_SA(1, 0), a3, voffA);
            PG8_BAR; PG8_WAIT_L(0); PG8_MMA(1, 0, At, B0); PG8_BAR; PG8_SCHED;
            PG8_STAGE(PG8_SB(1, 1), b3 + hstepB, voffB);
            PG8_WAIT_V(6); PG8_BAR; PG8_MMA(1, 1, At, B1); PG8_BAR;
            }
        }
        if constexpr (ALIGN_EPI) { if (wr == 0) PG8_BAR; }
        if constexpr (!Epi::AFTER_DRAIN) { E(acc, cur, wr, wc, fr, fq);
#ifdef EPI_TWICE
            if constexpr (Epi::TWICE_OK) { asm volatile("" ::: "memory"); if (Epi::twice(cur)) E(acc, cur, wr, wc, fr, fq); }
#endif
            S.done(cur); }
        if (!has_next) break;
#pragma unroll
        for (int a = 0; a < 2; ++a)
#pragma unroll
            for (int b = 0; b < 2; ++b)
#pragma unroll
                for (int m = 0; m < 4; ++m)
#pragma unroll
                    for (int n = 0; n < 2; ++n) acc[a][b][m][n] = (f32x4){0.f, 0.f, 0.f, 0.f};
        cur = nxt; cA = nA; cB = nB; ++ui;
        if constexpr (ALIGN_EPI) { if (wr == 1) PG8_BAR; }
    }
    PG8_WAIT_V(0);
    if constexpr (!ALIGN_EPI) { if (wr == 0) PG8_BAR; }
    PG8_BAR;
    if constexpr (Epi::AFTER_DRAIN) { E.fused(acc, cur, wr, wc, fr, fq, lds, wid, lane); S.done(cur); }
#undef PG8_SA
#undef PG8_SB
#undef PG8_STAGE
#undef PG8_LDA
#undef PG8_LDB
#undef PG8_MMA
#undef PG8_WAIT_V
#undef PG8_WAIT_L
#undef PG8_BAR
#undef PG8_SCHED
}
}
#define GAS __attribute__((address_space(1)))
#define LAS __attribute__((address_space(3)))
typedef unsigned short bf16;
typedef unsigned v4u __attribute__((ext_vector_type(4)));
typedef float f32x4 __attribute__((ext_vector_type(4)));
typedef short bf16x8 __attribute__((ext_vector_type(8)));
typedef GAS unsigned gu32;
typedef GAS unsigned long long gu64;
#define RLX_AGENT __ATOMIC_RELAXED, __HIP_MEMORY_SCOPE_AGENT
#define LDS_WAIT() asm volatile("s_waitcnt lgkmcnt(0)" ::: "memory")
#define VM_WAIT() asm volatile("s_waitcnt vmcnt(0)" ::: "memory")
__device__ __forceinline__ unsigned long long rt() { return __builtin_amdgcn_s_memrealtime(); }
__device__ __forceinline__ unsigned f2bf(float f) { unsigned u = __builtin_bit_cast(unsigned, f); return (u + 0x7fffu + ((u >> 16) & 1u)) >> 16; }
__device__ __forceinline__ unsigned pk2(float lo, float hi) { return f2bf(lo) | (f2bf(hi) << 16); }

#define XB_TMO      128
#define XB_XCNT(j)  (256  + 64 * (j))
#define XB_XSUB(j)  (1280 + 64 * (j))
#define XB_XGEN(j)  (2304 + 64 * (j))
#define XB_TOP      3328
#define XB_TOPGEN   3392
#define XCD_BAR_WORDS 3456
#define XB_SPIN_CAP (1u << 18)

__device__ __forceinline__ unsigned xb_ld(unsigned* p)              { return __hip_atomic_load(p, __ATOMIC_RELAXED, __HIP_MEMORY_SCOPE_AGENT); }
__device__ __forceinline__ unsigned xb_add(unsigned* p, unsigned v) { return __hip_atomic_fetch_add(p, v, __ATOMIC_RELAXED, __HIP_MEMORY_SCOPE_AGENT); }
__device__ __forceinline__ unsigned xb_xcc_id() { return (unsigned)__builtin_amdgcn_s_getreg((3 << 11) | 20) & 0xFu; }
#define XB_SPIN(cond, bar) do { unsigned _sp = 0; while (cond) { __builtin_amdgcn_s_sleep(1); \
    if ((++_sp & 255u) == 0u) { if (xb_ld(&(bar)[XB_TMO])) break; if (_sp > XB_SPIN_CAP) { atomicAdd(&(bar)[XB_TMO], 1u); break; } } } } while (0)

struct XcdBarrier {
    unsigned* bar; unsigned x;
    volatile LAS unsigned* st;
};

__device__ __forceinline__ XcdBarrier xcd_barrier_post(unsigned* bar, volatile LAS unsigned* st) {
    XcdBarrier b; b.bar = bar; b.x = xb_xcc_id(); b.st = st;
    if (threadIdx.x == 0) (void)xb_add(&bar[XB_XCNT(b.x)], 1u);
    return b;
}
__device__ __forceinline__ void xcd_barrier_complete(unsigned* bar, unsigned x, unsigned& nloc, unsigned& nx) {
    const unsigned G = gridDim.x * gridDim.y * gridDim.z;
    unsigned sum, cnt, mine, sp = 0u;
    for (;;) {
        sum = 0u; cnt = 0u; mine = 0u;
#pragma unroll
        for (unsigned j = 0; j < 16; ++j) { const unsigned c = xb_ld(&bar[XB_XCNT(j)]); sum += c; cnt += (c > 0u) ? 1u : 0u; mine = (j == x) ? c : mine; }
        if (sum == G) break;
        __builtin_amdgcn_s_sleep(1);
        if ((++sp & 255u) == 0u) { if (xb_ld(&bar[XB_TMO])) break; if (sp > XB_SPIN_CAP) { atomicAdd(&bar[XB_TMO], 1u); break; } }
    }
    nloc = mine > 0u ? mine : 1u; nx = cnt > 0u ? cnt : 1u;
}

__device__ __forceinline__ void xcd_barrier(const XcdBarrier& b) {
    asm volatile("s_waitcnt vmcnt(0)" ::: "memory");
    __syncthreads();
    if (threadIdx.x == 0) {
        unsigned* bar = b.bar;
        __builtin_amdgcn_s_waitcnt(0);
        unsigned nloc = b.st[0], nx = b.st[1];
        if (nloc == 0u) { xcd_barrier_complete(bar, b.x, nloc, nx); b.st[0] = nloc; b.st[1] = nx; }
        const unsigned old = xb_add(&bar[XB_XSUB(b.x)], 1u);
        const unsigned gen = old / nloc;
        if (old + 1u == (gen + 1u) * nloc) {
            __builtin_amdgcn_fence(__ATOMIC_RELEASE, "agent");
            asm volatile("s_waitcnt vmcnt(0)" ::: "memory");
            const unsigned og = xb_add(&bar[XB_TOP], 1u);
            const unsigned tg = og / nx;
            if (og + 1u == (tg + 1u) * nx) xb_add(&bar[XB_TOPGEN], 1u);
            else XB_SPIN(xb_ld(&bar[XB_TOPGEN]) == tg, bar);
            __builtin_amdgcn_fence(__ATOMIC_ACQUIRE, "agent");
            xb_add(&bar[XB_XGEN(b.x)], 1u);
            asm volatile("s_waitcnt vmcnt(0)" ::: "memory");
        } else {
            XB_SPIN(xb_ld(&bar[XB_XGEN(b.x)]) == gen, bar);
            __builtin_amdgcn_fence(__ATOMIC_ACQUIRE, "agent");
            asm volatile("s_waitcnt vmcnt(0)" ::: "memory");
        }
    }
    __syncthreads();
}


typedef float f32x2 __attribute__((ext_vector_type(2)));
constexpr int NWAVES = 8;
constexpr int BATCH = 4, SEQ = 4096, DM = 1024, MTOK = BATCH * SEQ;
constexpr int NIN1 = 4864;
constexpr int LATW = 768;
constexpr float C2Q = 0.07216878364870323f * 1.4426950408889634f;

constexpr size_t MiB = 1u << 20, KiB = 1u << 10;
constexpr size_t WS_CTL = 0, CTL_ZERO_BYTES = 64 * KiB;
constexpr size_t WS_SMALL = 1 * MiB;
constexpr size_t SM_RSTDX = 0, SM_SSQ_CQ = 64 * KiB, SM_SSQ_CKV = 128 * KiB, SM_SSQ1 = 192 * KiB, SM_SSQ2 = 256 * KiB, SM_SSQ_RO = 320 * KiB, SM_END = 576 * KiB;
constexpr size_t WS_WIN = 2 * MiB;
constexpr size_t WS_SSQP = 10 * MiB;
constexpr size_t WS_WUQ = WS_WIN + (size_t)8960 * 1024 * 2;
constexpr size_t WS_WUKV = WS_WUQ + (size_t)1536 * 384 * 2;
constexpr size_t WS_XB = 22 * MiB;
constexpr size_t WS_CS = 54 * MiB;
constexpr size_t WS_LAT = 70 * MiB;
constexpr size_t WS_RQ = 94 * MiB, WS_RK = 126 * MiB, WS_RKDT = 158 * MiB, WS_RVT = 190 * MiB;
constexpr size_t WS_QP = 94 * MiB, WS_KVP = 142 * MiB, WS_KF = 206 * MiB;
constexpr size_t WS_MO = 54 * MiB;
constexpr size_t WS_SG = 94 * MiB, WS_TM = 158 * MiB;
constexpr size_t WS_WBR = 190 * MiB, WS_WBM = 194 * MiB, WS_WO = 196 * MiB, WS_WUP = 198 * MiB, WS_WDOWN = 206 * MiB, WS_WPG = 214 * MiB, WS_WPLE = 216 * MiB;
constexpr size_t WS_PB = 217 * MiB;
constexpr size_t WS_H = 54 * MiB;
constexpr size_t WS_GT = 54 * MiB;
constexpr size_t WS_END = 256 * MiB;
static_assert(SM_SSQ_CKV == SM_SSQ_CQ + 65536, "ssq_lat layout");
static_assert(WS_WUKV + (size_t)2048 * 256 * 2 <= WS_XB && WS_RVT + 64 * MiB <= WS_END && WS_KF + 48 * MiB <= WS_END && WS_H + 128 * MiB <= WS_WBR && WS_PB + 8 * MiB <= WS_END, "d_ws map");
constexpr int CW_BAR = 1024;

constexpr int RING_OFF = 0, RING_BYTES = 131072;
constexpr int XS_OFF = RING_BYTES, XS_BYTES = 8 * 2304;
constexpr int MISC_OFF = XS_OFF + XS_BYTES;
constexpr int LDS_BYTES = 160 * 1024;
static_assert(MISC_OFF + 128 <= LDS_BYTES, "LDS map");

struct Frame {
    LAS unsigned char* lds; volatile LAS unsigned* MISC; int tid, lane, wave, G, vcu;
    float* out; unsigned char* ws;
};
__device__ __forceinline__ float wave_sum(float v) {
#pragma unroll
    for (int o = 1; o < 64; o <<= 1) v += __shfl_xor(v, o);
    return v;
}
__device__ __forceinline__ void p0_transpose_item(const float* W, int ldw, int K, int src_col, bf16* WT, int dst_row, int ncols, const float* gain, LAS float* scr, int item, int lane) {
    const int nblk = ncols / 32, kb = item / nblk, nb = item % nblk, k0 = 64 * kb, n0 = 32 * nb;
#pragma unroll 8
    for (int i = 0; i < 32; ++i) { const int kk = 2 * i + (lane >> 5); const float gk = gain ? gain[k0 + kk] : 1.0f; scr[kk * 33 + (lane & 31)] = W[(size_t)(k0 + kk) * ldw + src_col + n0 + (lane & 31)] * gk; }
    LDS_WAIT(); asm volatile("" ::: "memory");
    const int c = lane & 7;
#pragma unroll
    for (int j = 0; j < 4; ++j) { const int n = (lane >> 3) + 8 * j; const LAS float* s = scr + (8 * c) * 33 + n;
        v4u o; o.x = pk2(s[0 * 33], s[1 * 33]); o.y = pk2(s[2 * 33], s[3 * 33]); o.z = pk2(s[4 * 33], s[5 * 33]); o.w = pk2(s[6 * 33], s[7 * 33]);
        *(GAS v4u*)(WT + (size_t)(dst_row + n0 + n) * K + k0 + 8 * c) = o; }
    LDS_WAIT(); asm volatile("" ::: "memory");
}
#define P0_SEG(W, ldw, K, src, WT, dst, ncols, gain) { const int n_ = ((K) / 64) * ((ncols) / 32); if (r < n_) { p0_transpose_item(W, ldw, K, src, WT, dst, ncols, gain, scr, r, F.lane); continue; } r -= n_; }
__device__ __forceinline__ void phase_p0(Frame& F, const float* x, const int* pos, const float* g_mix, const float* w_in, const float* g_qlat, const float* g_kvlat, const float* w_uq, const float* w_ukv) {
    LAS float* scr = (LAS float*)(F.lds + RING_OFF + F.wave * 16384);
    const int gw = F.vcu * NWAVES + F.wave, NGW = F.G * NWAVES;
    bf16* WinT = (bf16*)(F.ws + WS_WIN); bf16* WuqT = (bf16*)(F.ws + WS_WUQ); bf16* WukvT = (bf16*)(F.ws + WS_WUKV);
    constexpr int NIT = 16 * (2048 / 32) * 2 + 16 * (4096 / 32) + 16 * (704 / 32) + 6 * (1536 / 32) + 4 * (2048 / 32);
    for (int it = gw; it < NIT; it += NGW) {
        int r = it;
        P0_SEG(w_in, 8896, 1024, 6848, WinT, 0, 2048, g_mix)
        P0_SEG(w_in, 8896, 1024, 4096, WinT, 2048, 2048, g_mix)
        P0_SEG(w_in, 8896, 1024, 0, WinT, 4096, 4096, g_mix)
        P0_SEG(w_in, 8896, 1024, 6144, WinT, 8192, 704, g_mix)
        P0_SEG(w_uq, 1536, 384, 0, WuqT, 0, 1536, g_qlat)
        P0_SEG(w_ukv, 2048, 256, 0, WukvT, 0, 2048, g_kvlat)
    }
    { const int gt = F.vcu * 512 + F.tid; if (gt < 8192) *(GAS v4u*)((unsigned char*)(WinT + (size_t)8896 * 1024) + (size_t)gt * 16) = (v4u){0u, 0u, 0u, 0u}; }
    { bf16* XB = (bf16*)(F.ws + WS_XB); float* rstdx = (float*)(F.ws + WS_SMALL + SM_RSTDX);
      for (int m = gw; m < MTOK; m += NGW) {
          const GAS f32x4* xr = (const GAS f32x4*)(x + (size_t)m * DM) + F.lane; f32x4 v[4]; float s = 0.f;
#pragma unroll
          for (int j = 0; j < 4; ++j) { v[j] = xr[64 * j]; s += (v[j].x * v[j].x + v[j].y * v[j].y) + (v[j].z * v[j].z + v[j].w * v[j].w); }
          s = wave_sum(s);
          GAS unsigned long long* o8 = (GAS unsigned long long*)(XB + (size_t)m * DM) + F.lane;
#pragma unroll
          for (int j = 0; j < 4; ++j) o8[64 * j] = (unsigned long long)pk2(v[j].x, v[j].y) | ((unsigned long long)pk2(v[j].z, v[j].w) << 32);
          if (F.lane == 0) rstdx[m] = 1.0f / sqrtf(s * (1.0f / DM) + 1e-6f);
      } }
    { f32x2* cs = (f32x2*)(F.ws + WS_CS);
      for (int e = F.vcu * 512 + F.tid; e < MTOK * 128; e += F.G * 512) { const int row = e >> 7, i = e & 127;
          const float inv = __builtin_amdgcn_exp2f(-(float)i * (13.287712379549449f / 128.0f));
          double rev = (double)pos[row] * (double)inv * 0.15915494309189535; rev -= __builtin_rint(rev);
          const float rf = (float)rev; cs[e] = (f32x2){__builtin_amdgcn_cosf(rf), __builtin_amdgcn_sinf(rf)}; } }
    { float* z = (float*)(F.ws + WS_SMALL + SM_SSQ_CQ); for (int e = F.vcu * 512 + F.tid; e < (int)((SM_END - SM_SSQ_CQ) / 4); e += F.G * 512) z[e] = 0.f; }
}
__device__ __forceinline__ void phase_late_weights(Frame& F, const float* p, const float* w_br, const float* w_bm, const float* w_o, const float* g_mlp, const float* w_up, const float* w_down, const float* g_ple, const float* w_pg, const float* w_ple) {
    LAS float* scr = (LAS float*)(F.lds + RING_OFF + F.wave * 16384);
    const int gw = F.vcu * NWAVES + F.wave, NGW = F.G * NWAVES;
    constexpr int NIT = 32 * 32 + 16 * 32 + 16 * 32 + 16 * 128 + 64 * 32 + 16 * 32 + 4 * 32;
    for (int it = gw; it < NIT; it += NGW) {
        int r = it;
        P0_SEG(w_br, 1024, 2048, 0, (bf16*)(F.ws + WS_WBR), 0, 1024, (const float*)nullptr)
        P0_SEG(w_bm, 1024, 1024, 0, (bf16*)(F.ws + WS_WBM), 0, 1024, (const float*)nullptr)
        P0_SEG(w_o, 1024, 1024, 0, (bf16*)(F.ws + WS_WO), 0, 1024, (const float*)nullptr)
        P0_SEG(w_up, 4096, 1024, 0, (bf16*)(F.ws + WS_WUP), 0, 4096, g_mlp)
        P0_SEG(w_down, 1024, 4096, 0, (bf16*)(F.ws + WS_WDOWN), 0, 1024, (const float*)nullptr)
        P0_SEG(w_pg, 1024, 1024, 0, (bf16*)(F.ws + WS_WPG), 0, 1024, g_ple)
        P0_SEG(w_ple, 1024, 256, 0, (bf16*)(F.ws + WS_WPLE), 0, 1024, (const float*)nullptr)
    }
    { bf16* PB = (bf16*)(F.ws + WS_PB);
      for (int e = F.vcu * 512 + F.tid; e < MTOK * 256 / 8; e += F.G * 512) { const f32x4 a = *(const GAS f32x4*)(p + (size_t)e * 8), b = *(const GAS f32x4*)(p + (size_t)e * 8 + 4);
          *(GAS v4u*)(PB + (size_t)e * 8) = (v4u){pk2(a.x, a.y), pk2(a.z, a.w), pk2(b.x, b.y), pk2(b.z, b.w)}; } }
}

typedef float f32x16 __attribute__((ext_vector_type(16)));
typedef unsigned u32x2 __attribute__((ext_vector_type(2)));
typedef short v4i16_t __attribute__((ext_vector_type(4)));
__device__ __forceinline__ int crow(int r, int hi) { return (r & 3) + 8 * (r >> 2) + 4 * hi; }
typedef __bf16 bf16x2m_t __attribute__((ext_vector_type(2)));
__device__ __forceinline__ unsigned cvtpk(float lo, float hi) { f32x2 v = {lo, hi}; bf16x2m_t b = __builtin_convertvector(v, bf16x2m_t); return __builtin_bit_cast(unsigned, b); }
__device__ __forceinline__ bf16x8 pack8f(const f32x16& p, int b) { v4u w = {cvtpk(p[b], p[b + 1]), cvtpk(p[b + 2], p[b + 3]), cvtpk(p[b + 4], p[b + 5]), cvtpk(p[b + 6], p[b + 7])}; return __builtin_bit_cast(bf16x8, w); }
__device__ __forceinline__ float bf2f(bf16 v) { return __uint_as_float((unsigned)v << 16); }
__device__ __forceinline__ float log2_gamma(int h) { return __builtin_amdgcn_logf(1.0f - __builtin_amdgcn_exp2f(-5.0f - (float)h)); }

__device__ __forceinline__ void phase_r0(Frame& F) {
    const bf16* RQ = (const bf16*)(F.ws + WS_RQ); const bf16* RK = (const bf16*)(F.ws + WS_RK); const bf16* RVT = (const bf16*)(F.ws + WS_RVT); bf16* RO = (bf16*)F.out;
    const int lane = F.lane, w = F.wave, l31 = lane & 31, hi = lane >> 5, tq = w & 3, dh = w >> 2;
    for (int unit = F.vcu; unit < 512; unit += F.G) {
        const int bh = unit >> 5, c = unit & 31, b = bh >> 2, h = bh & 3; const size_t tok0 = (size_t)b * SEQ + c * 128;
        const float lg2 = log2_gamma(h);
        bf16x8 qf[16];
#pragma unroll
        for (int ks = 0; ks < 16; ++ks) qf[ks] = *(const bf16x8*)(RQ + (tok0 + 32 * tq + l31) * 1024 + h * 256 + 16 * ks + 8 * hi);
        bf16x8 pf[4][2];
#pragma unroll
        for (int tb = 0; tb < 4; ++tb) {
            pf[tb][0] = (bf16x8){0, 0, 0, 0, 0, 0, 0, 0}; pf[tb][1] = pf[tb][0];
            if (tb <= tq) {
                f32x16 s = {};
#pragma unroll
                for (int ks = 0; ks < 16; ++ks) { const bf16x8 kf = *(const bf16x8*)(RK + (tok0 + 32 * tb + l31) * 1024 + h * 256 + 16 * ks + 8 * hi); s = __builtin_amdgcn_mfma_f32_32x32x16_bf16(kf, qf[ks], s, 0, 0, 0); }
#pragma unroll
                for (int r = 0; r < 16; ++r) { const int d = (32 * tq + l31) - (32 * tb + crow(r, hi)); s[r] = d >= 0 ? s[r] * __builtin_amdgcn_exp2f((float)d * lg2) : 0.f; }
                pf[tb][0] = pack8f(s, 0); pf[tb][1] = pack8f(s, 8);
            }
        }
#pragma unroll 1
        for (int db = 0; db < 8; ++db) {
            f32x16 o = {};
#pragma unroll
            for (int tb = 0; tb < 4; ++tb)
                if (tb <= tq) {
#pragma unroll
                    for (int s2 = 0; s2 < 2; ++s2) { const bf16* vp = RVT + ((size_t)bh * 512 + 256 * dh + 32 * db + l31) * 4096 + c * 128 + 32 * tb + 16 * s2 + 4 * hi;
                        const u32x2 lo = *(const u32x2*)vp, hh = *(const u32x2*)(vp + 8); const v4u w4 = {lo.x, lo.y, hh.x, hh.y};
                        o = __builtin_amdgcn_mfma_f32_32x32x16_bf16(pf[tb][s2], __builtin_bit_cast(bf16x8, w4), o, 0, 0, 0); }
                }
#pragma unroll
            for (int r = 0; r < 16; ++r) RO[(tok0 + 32 * tq + crow(r, hi)) * 2048 + h * 512 + 256 * dh + 32 * db + l31] = (bf16)f2bf(o[r]);
        }
    }
}
__device__ __forceinline__ void phase_r1(Frame& F) {
    const bf16* RQ = (const bf16*)(F.ws + WS_RQ); const bf16* RKDT = (const bf16*)(F.ws + WS_RKDT); const bf16* RVT = (const bf16*)(F.ws + WS_RVT); bf16* RO = (bf16*)F.out;
    float* ssq_ro = (float*)(F.ws + WS_SMALL + SM_SSQ_RO);
    const int lane = F.lane, w = F.wave, l31 = lane & 31, hi = lane >> 5, l15 = lane & 15, lq = lane >> 4;
    constexpr int SROW = 528, SBUF = 32 * SROW;
    for (int unit = F.vcu; unit < 256; unit += F.G) {
        const int bh = unit >> 4, j = unit & 15, b = bh >> 2, h = bh & 3;
        const float lg2 = log2_gamma(h), gC = __builtin_amdgcn_exp2f(128.0f * lg2);
        f32x16 S = {};
        __syncthreads();
#pragma unroll
        for (int g = 0; g < 4; ++g) *(LAS u32x2*)(F.lds + l31 * SROW + (32 * w + 8 * g + 4 * hi) * 2) = (u32x2){0u, 0u};
        for (int c = 0; c < 32; ++c) {
            const int cur = c & 1; const size_t tok0 = (size_t)b * SEQ + c * 128;
            __syncthreads();
            f32x4 oi[2] = {(f32x4){0.f, 0.f, 0.f, 0.f}, (f32x4){0.f, 0.f, 0.f, 0.f}};
#pragma unroll
            for (int ks = 0; ks < 8; ++ks) { const bf16x8 a = *(const bf16x8*)(RQ + (tok0 + 16 * w + l15) * 1024 + h * 256 + 32 * ks + 8 * lq);
#pragma unroll
                for (int nb = 0; nb < 2; ++nb) { const bf16x8 bq = *(const LAS bf16x8*)(F.lds + cur * SBUF + (16 * nb + l15) * SROW + (32 * ks + 8 * lq) * 2);
                    oi[nb] = __builtin_amdgcn_mfma_f32_16x16x32_bf16(a, bq, oi[nb], 0, 0, 0); } }
#pragma unroll
            for (int i = 0; i < 4; ++i) { const int tt = 16 * w + 4 * lq + i; const float qd = __builtin_amdgcn_exp2f((float)(tt + 1) * lg2); float q = 0.f;
#pragma unroll
                for (int nb = 0; nb < 2; ++nb) { bf16* p = RO + (tok0 + tt) * 2048 + h * 512 + 32 * j + 16 * nb + l15; const float v = bf2f(*p) + qd * oi[nb][i]; *p = (bf16)f2bf(v); q += v * v; }
                q += __shfl_xor(q, 1); q += __shfl_xor(q, 2); q += __shfl_xor(q, 4); q += __shfl_xor(q, 8);
                if (l15 == 0) atomicAdd(ssq_ro + (tok0 + tt) * 4 + h, q); }
#pragma unroll
            for (int r = 0; r < 16; ++r) S[r] *= gC;
#pragma unroll
            for (int ks = 0; ks < 8; ++ks) { const bf16x8 a = *(const bf16x8*)(RKDT + ((size_t)bh * 256 + 32 * w + l31) * 4096 + c * 128 + 16 * ks + 8 * hi);
                const bf16x8 bv = *(const bf16x8*)(RVT + ((size_t)bh * 512 + 32 * j + l31) * 4096 + c * 128 + 16 * ks + 8 * hi);
                S = __builtin_amdgcn_mfma_f32_32x32x16_bf16(a, bv, S, 0, 0, 0); }
#pragma unroll
            for (int g = 0; g < 4; ++g) *(LAS u32x2*)(F.lds + (cur ^ 1) * SBUF + l31 * SROW + (32 * w + 8 * g + 4 * hi) * 2) = (u32x2){cvtpk(S[4 * g], S[4 * g + 1]), cvtpk(S[4 * g + 2], S[4 * g + 3])};
        }
    }
    __syncthreads();
}
__device__ __forceinline__ void phase_fin(Frame& F, const float* qn, const float* kn) {
    bf16* QP = (bf16*)(F.ws + WS_QP); const bf16* KVP = (const bf16*)(F.ws + WS_KVP); const bf16* LAT = (const bf16*)(F.ws + WS_LAT); bf16* KF = (bf16*)(F.ws + WS_KF);
    const f32x2* cs = (const f32x2*)(F.ws + WS_CS);
    const int gw = F.vcu * NWAVES + F.wave, NGW = F.G * NWAVES, lane = F.lane, h = lane >> 3, part = lane & 7;
    for (int tok = gw; tok < MTOK; tok += NGW) {
#pragma unroll
        for (int which = 0; which < 2; ++which) {
            float v[3][8]; float ssq = 0.f;
#pragma unroll
            for (int r = 0; r < 3; ++r) { v4u wv;
                if (which == 0) wv = *(const v4u*)(QP + (size_t)tok * 1536 + h * 192 + 64 * r + 8 * part);
                else if (r < 2) wv = *(const v4u*)(KVP + (size_t)tok * 2048 + h * 256 + 64 * r + 8 * part);
                else wv = *(const v4u*)(LAT + (size_t)tok * LATW + 640 + 8 * part);
                const unsigned ww[4] = {wv.x, wv.y, wv.z, wv.w};
#pragma unroll
                for (int e = 0; e < 4; ++e) { v[r][2 * e] = __uint_as_float(ww[e] << 16); v[r][2 * e + 1] = __uint_as_float(ww[e] & 0xffff0000u); }
#pragma unroll
                for (int e = 0; e < 8; ++e) ssq += v[r][e] * v[r][e]; }
            ssq += __shfl_xor(ssq, 1); ssq += __shfl_xor(ssq, 2); ssq += __shfl_xor(ssq, 4);
            const float sc = (1.0f / sqrtf(ssq * (1.0f / 192.0f) + 1e-6f)) * (which == 0 ? C2Q : 1.0f);
            const float* gn = which == 0 ? qn : kn;
            bf16* dst = which == 0 ? QP + (size_t)tok * 1536 + h * 192 : KF + (size_t)tok * 1536 + h * 192;
#pragma unroll
            for (int r = 0; r < 3; ++r) {
                float y[8];
#pragma unroll
                for (int e = 0; e < 8; ++e) y[e] = v[r][e] * sc * gn[64 * r + 8 * part + e];
                if (r == 2) {
#pragma unroll
                    for (int e = 0; e < 8; ++e) { const float pr = __shfl_xor(y[e], 4); const f32x2 c = cs[(size_t)tok * 128 + 4 * (8 * (part & 3) + e)];
                        y[e] = part < 4 ? y[e] * c.x - pr * c.y : y[e] * c.x + pr * c.y; }
                }
                *(v4u*)(dst + 64 * r + 8 * part) = (v4u){pk2(y[0], y[1]), pk2(y[2], y[3]), pk2(y[4], y[5]), pk2(y[6], y[7])};
            }
        }
    }
}
__device__ __forceinline__ void phase_attn(Frame& F) {
    const bf16* QP = (const bf16*)(F.ws + WS_QP); const bf16* KVP = (const bf16*)(F.ws + WS_KVP); const bf16* KF = (const bf16*)(F.ws + WS_KF); bf16* MO = (bf16*)(F.ws + WS_MO);
    const int lane = F.lane, w = F.wave, l31 = lane & 31, hi = lane >> 5;
    LAS unsigned char* vst = F.lds + w * 9216; LAS float* al = (LAS float*)(vst + 8704); LAS float* li = al + 32;
    constexpr int VROW = 272;
    const int trb = (4 * hi + ((lane & 15) >> 2)) * VROW + (16 * ((lane >> 4) & 1) + 4 * (lane & 3)) * 2;
    for (int v = F.vcu; v < 256; v += F.G) {
#pragma unroll 1
        for (int half = 0; half < 2; ++half) {
            const int qb = half == 0 ? 15 - (v >> 5) : (v >> 5), bh = v & 31, b = bh >> 3, h = bh & 7;
            const int q0 = qb * 256 + 32 * w; const size_t tb = (size_t)b * SEQ;
            bf16x8 qr[12];
#pragma unroll
            for (int d = 0; d < 12; ++d) qr[d] = *(const bf16x8*)(QP + (tb + q0 + l31) * 1536 + h * 192 + 16 * d + 8 * hi);
            float m_run = -1e30f, l_run = 0.f; f32x16 o[4] = {};
            const int nkt = q0 / 32 + 1;
#pragma unroll 1
            for (int kt = 0; kt < nkt; ++kt) {
                const int k0 = kt * 32;
#pragma unroll
                for (int i = 0; i < 8; ++i) { const int idx = lane + 64 * i, row = idx >> 4, ch = idx & 15;
                    const v4u vv = *(const v4u*)(KVP + (tb + k0 + row) * 2048 + h * 256 + 128 + ch * 8); *(LAS v4u*)(vst + row * VROW + ch * 16) = vv; }
                f32x16 p = {};
#pragma unroll
                for (int d = 0; d < 12; ++d) { const bf16x8 kf = *(const bf16x8*)(KF + (tb + k0 + l31) * 1536 + h * 192 + 16 * d + 8 * hi); p = __builtin_amdgcn_mfma_f32_32x32x16_bf16(kf, qr[d], p, 0, 0, 0); }
                if (kt == nkt - 1) {
#pragma unroll
                    for (int r = 0; r < 16; ++r) if (crow(r, hi) > l31) p[r] = -__builtin_inff();
                }
                float pmax = p[0];
#pragma unroll
                for (int r = 1; r < 16; ++r) pmax = fmaxf(pmax, p[r]);
                pmax = fmaxf(pmax, __shfl_xor(pmax, 32));
                const float mn = fmaxf(m_run, pmax), alpha = __builtin_amdgcn_exp2f(m_run - mn); m_run = mn;
                float ps = 0.f;
#pragma unroll
                for (int r = 0; r < 16; ++r) { p[r] = __builtin_amdgcn_exp2f(p[r] - mn); ps += p[r]; }
                ps += __shfl_xor(ps, 32); l_run = l_run * alpha + ps;
                if (hi == 0) al[l31] = alpha;
                const bf16x8 pa0 = pack8f(p, 0), pa1 = pack8f(p, 8);
                LDS_WAIT();
#pragma unroll
                for (int r = 0; r < 16; ++r) { const float a = al[crow(r, hi)];
#pragma unroll
                    for (int db = 0; db < 4; ++db) o[db][r] *= a; }
#pragma unroll
                for (int db = 0; db < 4; ++db)
#pragma unroll
                    for (int s2 = 0; s2 < 2; ++s2) { LAS unsigned char* ap = vst + trb + (16 * s2) * VROW + db * 64;
                        const v4i16_t lo = __builtin_amdgcn_ds_read_tr16_b64_v4i16((LAS v4i16_t*)ap), hh = __builtin_amdgcn_ds_read_tr16_b64_v4i16((LAS v4i16_t*)(ap + 8 * VROW));
                        const bf16x8 bfv = (bf16x8){lo[0], lo[1], lo[2], lo[3], hh[0], hh[1], hh[2], hh[3]};
                        o[db] = __builtin_amdgcn_mfma_f32_32x32x16_bf16(s2 == 0 ? pa0 : pa1, bfv, o[db], 0, 0, 0); }
                LDS_WAIT();
            }
            if (hi == 0) li[l31] = l_run;
            LDS_WAIT();
#pragma unroll
            for (int r = 0; r < 16; ++r) { const float il = 1.0f / li[crow(r, hi)];
#pragma unroll
                for (int db = 0; db < 4; ++db) MO[(tb + q0 + crow(r, hi)) * 1024 + h * 128 + 32 * db + l31] = (bf16)f2bf(o[db][r] * il); }
            LDS_WAIT();
        }
    }
}

__device__ __forceinline__ void phase_r0p(Frame& F) {
    const bf16* RQ = (const bf16*)(F.ws + WS_RQ); bf16* RK = (bf16*)(F.ws + WS_RK);
    const int lane = F.lane, w = F.wave, l31 = lane & 31, hi = lane >> 5, tq = w & 3, dh = w >> 2;
    for (int unit = F.vcu; unit < 512; unit += F.G) {
        const int bh = unit >> 5, c = unit & 31, h = bh & 3; const size_t blk = (size_t)bh * 32 + c;
        const float lg2 = log2_gamma(h);
        bf16x8 qf[16];
#pragma unroll
        for (int ks = 0; ks < 16; ++ks) qf[ks] = *(const bf16x8*)(RQ + ((blk * 32 + 2 * ks + hi) * 128 + 32 * tq + l31) * 8);
        f32x16 s[2] = {};
#pragma unroll
        for (int x = 0; x < 2; ++x) { const int tb = 2 * dh + x;
            if (tb <= tq) {
#pragma unroll
                for (int ks = 0; ks < 16; ++ks) { const bf16x8 kf = *(const bf16x8*)(RK + ((blk * 32 + 2 * ks + hi) * 128 + 32 * tb + l31) * 8); s[x] = __builtin_amdgcn_mfma_f32_32x32x16_bf16(kf, qf[ks], s[x], 0, 0, 0); }
#pragma unroll
                for (int r = 0; r < 16; ++r) { const int d = (32 * tq + l31) - (32 * tb + crow(r, hi)); s[x][r] = d >= 0 ? s[x][r] * __builtin_amdgcn_exp2f((float)d * lg2) : 0.f; }
            } }
        VM_WAIT(); __syncthreads();
#pragma unroll
        for (int x = 0; x < 2; ++x) { const int tb = 2 * dh + x;
            if (tb <= tq) {
#pragma unroll
                for (int g = 0; g < 4; ++g) *(u32x2*)(RK + ((blk * 32 + 4 * tb + g) * 128 + 32 * tq + l31) * 8 + 4 * hi) = (u32x2){cvtpk(s[x][4 * g], s[x][4 * g + 1]), cvtpk(s[x][4 * g + 2], s[x][4 * g + 3])};
            } }
    }
}
__device__ __forceinline__ void phase_r1p(Frame& F) {
    const bf16* RQ = (const bf16*)(F.ws + WS_RQ); const bf16* RP = (const bf16*)(F.ws + WS_RK); const bf16* RKDT = (const bf16*)(F.ws + WS_RKDT); const bf16* RVT = (const bf16*)(F.ws + WS_RVT); bf16* RO = (bf16*)F.out;
    float* ssqp = (float*)(F.ws + WS_SSQP);
    const int lane = F.lane, w = F.wave, l15 = lane & 15, lq = lane >> 4;
    constexpr int SROW = 528, SBUF = 32 * SROW;
    LAS unsigned char* ost = F.lds + 2 * SBUF + 1024 + w * 1024;
    const int nkp = (w >> 1) + 1;
    for (int unit = F.vcu; unit < 256; unit += F.G) {
        const int bh = unit >> 4, j = unit & 15, b = bh >> 2, h = bh & 3;
        const float lg2 = log2_gamma(h), gC = __builtin_amdgcn_exp2f(128.0f * lg2);
        float qd[4];
#pragma unroll
        for (int i = 0; i < 4; ++i) qd[i] = __builtin_amdgcn_exp2f((float)(16 * w + 4 * lq + i + 1) * lg2);
        f32x4 S[2][2];
#pragma unroll
        for (int mb = 0; mb < 2; ++mb)
#pragma unroll
            for (int nb = 0; nb < 2; ++nb) S[mb][nb] = (f32x4){0.f, 0.f, 0.f, 0.f};
        __syncthreads();
#pragma unroll
        for (int mb = 0; mb < 2; ++mb)
#pragma unroll
            for (int nb = 0; nb < 2; ++nb) *(LAS u32x2*)(F.lds + (16 * nb + l15) * SROW + (32 * w + 16 * mb + 4 * lq) * 2) = (u32x2){0u, 0u};
        const bf16* qp = RQ + (((size_t)bh * 32 * 32 + lq) * 128 + 16 * w + l15) * 8;
        const bf16* pp = RP + (((size_t)bh * 32 * 32 + lq) * 128 + 16 * w + l15) * 8;
        const bf16* kp = RKDT + (((size_t)bh * 32 * 16 + lq) * 256 + 32 * w + l15) * 8;
        const bf16* vp = RVT + (((size_t)bh * 32 * 16 + (F.tid >> 5)) * 512 + 32 * j + (F.tid & 31)) * 8;
        constexpr size_t QC = 32 * 128 * 8, QK = 4 * 128 * 8, KC = 16 * 256 * 8, KK = 4 * 256 * 8, VC = 16 * 512 * 8;
        bf16x8 QA[8], PA[4], KA[2][4], vpre;
        LAS unsigned char* vl = F.lds + 2 * SBUF + 1024 + 8 * 1024;
#pragma unroll
        for (int ks = 0; ks < 8; ++ks) QA[ks] = *(const bf16x8*)(qp + QK * ks);
#pragma unroll
        for (int ks = 0; ks < 4; ++ks) { PA[ks] = (bf16x8){0, 0, 0, 0, 0, 0, 0, 0}; if (ks < nkp) PA[ks] = *(const bf16x8*)(pp + QK * ks); }
#pragma unroll
        for (int mb = 0; mb < 2; ++mb)
#pragma unroll
            for (int ks = 0; ks < 4; ++ks) KA[mb][ks] = *(const bf16x8*)(kp + mb * 128 + KK * ks);
        vpre = *(const bf16x8*)vp;
        *(LAS bf16x8*)(vl + F.tid * 16) = vpre;
#pragma unroll 1
        for (int c = 0; c < 32; ++c) {
            const int cur = c & 1, cn = c < 31 ? c + 1 : 31; const size_t tok0 = (size_t)b * SEQ + c * 128;
            __syncthreads();
            vpre = *(const bf16x8*)(vp + VC * cn);
            bf16x8 VB[2][4];
#pragma unroll
            for (int nb = 0; nb < 2; ++nb)
#pragma unroll
                for (int ks = 0; ks < 4; ++ks) VB[nb][ks] = *(const LAS bf16x8*)(vl + cur * 8192 + ((4 * ks + lq) * 32 + 16 * nb + l15) * 16);
            f32x4 oc[2] = {(f32x4){0.f, 0.f, 0.f, 0.f}, (f32x4){0.f, 0.f, 0.f, 0.f}};
#pragma unroll
            for (int ks = 0; ks < 8; ++ks)
#pragma unroll
                for (int nb = 0; nb < 2; ++nb) { const bf16x8 bq = *(const LAS bf16x8*)(F.lds + cur * SBUF + (16 * nb + l15) * SROW + (32 * ks + 8 * lq) * 2);
                    oc[nb] = __builtin_amdgcn_mfma_f32_16x16x32_bf16(QA[ks], bq, oc[nb], 0, 0, 0); }
#pragma unroll
            for (int ks = 0; ks < 8; ++ks) QA[ks] = *(const bf16x8*)(qp + QC * cn + QK * ks);
#pragma unroll
            for (int nb = 0; nb < 2; ++nb)
#pragma unroll
                for (int i = 0; i < 4; ++i) oc[nb][i] *= qd[i];
#pragma unroll
            for (int ks = 0; ks < 4; ++ks)
                if (ks < nkp) {
#pragma unroll
                    for (int nb = 0; nb < 2; ++nb) oc[nb] = __builtin_amdgcn_mfma_f32_16x16x32_bf16(PA[ks], VB[nb][ks], oc[nb], 0, 0, 0); }
#pragma unroll
            for (int ks = 0; ks < 4; ++ks) if (ks < nkp) PA[ks] = *(const bf16x8*)(pp + QC * cn + QK * ks);
#pragma unroll
            for (int mb = 0; mb < 2; ++mb)
#pragma unroll
                for (int nb = 0; nb < 2; ++nb) { S[mb][nb] *= gC;
#pragma unroll
                    for (int ks = 0; ks < 4; ++ks) S[mb][nb] = __builtin_amdgcn_mfma_f32_16x16x32_bf16(KA[mb][ks], VB[nb][ks], S[mb][nb], 0, 0, 0); }
#pragma unroll
            for (int mb = 0; mb < 2; ++mb)
#pragma unroll
                for (int ks = 0; ks < 4; ++ks) KA[mb][ks] = *(const bf16x8*)(kp + mb * 128 + KC * cn + KK * ks);
#pragma unroll
            for (int i = 0; i < 4; ++i) { float q = 0.f;
#pragma unroll
                for (int nb = 0; nb < 2; ++nb) { const float v = oc[nb][i]; q += v * v; *(LAS unsigned short*)(ost + ((4 * lq + i) * 32 + 16 * nb + l15) * 2) = (unsigned short)f2bf(v); }
                q += __shfl_xor(q, 1); q += __shfl_xor(q, 2); q += __shfl_xor(q, 4); q += __shfl_xor(q, 8);
                if (l15 == 0) ssqp[((tok0 + 16 * w + 4 * lq + i) * 4 + h) * 16 + j] = q; }
            LDS_WAIT();
            { const v4u ov = *(const LAS v4u*)(ost + lane * 16); *(v4u*)(RO + (tok0 + 16 * w + (lane >> 2)) * 2048 + h * 512 + 32 * j + (lane & 3) * 8) = ov; }
            *(LAS bf16x8*)(vl + (cur ^ 1) * 8192 + F.tid * 16) = vpre;
#pragma unroll
            for (int mb = 0; mb < 2; ++mb)
#pragma unroll
                for (int nb = 0; nb < 2; ++nb) *(LAS u32x2*)(F.lds + (cur ^ 1) * SBUF + (16 * nb + l15) * SROW + (32 * w + 16 * mb + 4 * lq) * 2) = (u32x2){cvtpk(S[mb][nb][0], S[mb][nb][1]), cvtpk(S[mb][nb][2], S[mb][nb][3])};
        }
    }
    __syncthreads();
}

namespace attn2 {
typedef float f32x16 __attribute__((ext_vector_type(16)));
typedef short s16x4 __attribute__((ext_vector_type(4)));
constexpr int NW = 8, QBLK = 32, KVBLK = 64, QB = NW * QBLK;
constexpr int QS = 1536, KS = 1536, VS = 2048, OS = 1024;
constexpr int SHM_V = KVBLK * 128 * 2, SHM_K = KVBLK * 512;
constexpr int OFF_V = 0, OFF_K = 2 * SHM_V, OFF_WS = OFF_K + 2 * SHM_K, OFF_QR = OFF_WS + NW * 64 * 4, LDS_NEED = OFF_QR + NW * 4096;
constexpr float THR2 = 8.0f * 1.4426950408889634f;
#define A2_SBAR() __builtin_amdgcn_sched_barrier(0)
__device__ __forceinline__ int v_st(int k, int c) { const int kk = (k & ~0xC) | ((k & 4) << 1) | ((k & 8) >> 1); return ((kk >> 3) * 4 + (c >> 5)) * 512 + ((kk & 7) * 32 + (c & 31)) * 2; }
__device__ __forceinline__ int v_rd_base(int lane) { return ((lane & 3) << 3) | (((lane >> 2) & 3) << 6) | (((lane >> 4) & 1) << 5) | (((lane >> 5) & 1) << 8); }
constexpr int v_rd_off(int d0, int ks, int half) { return d0 * 512 + ks * 4096 + half * 2048; }
__device__ __forceinline__ int crow(int r, int hi) { return (r & 3) + 8 * (r >> 2) + 4 * hi; }
typedef __bf16 bf16x2a_t __attribute__((ext_vector_type(2)));
__device__ __forceinline__ unsigned cvtpk(float lo, float hi) { f32x2 v = {lo, hi}; bf16x2a_t b = __builtin_convertvector(v, bf16x2a_t); return __builtin_bit_cast(unsigned, b); }
__device__ __forceinline__ bf16x8 load8(const bf16* p) { return *reinterpret_cast<const bf16x8*>(p); }
__device__ __forceinline__ void mask_tile(f32x16& p0, f32x16& p1, int dq) {
    const float NEG = -__builtin_inff();
#pragma unroll
    for (int r = 0; r < 16; ++r) { const int c = (r & 3) + 8 * (r >> 2); if (dq - c < 0) p0[r] = NEG; if (dq - c - 32 < 0) p1[r] = NEG; }
}
__device__ __forceinline__ void partialSM(f32x16& p0, f32x16& p1, float& m_reg, float& mn, float& alpha) {
    float pmax = p0[0];
#pragma unroll
    for (int r = 1; r < 16; ++r) pmax = fmaxf(pmax, p0[r]);
#pragma unroll
    for (int r = 0; r < 16; ++r) pmax = fmaxf(pmax, p1[r]);
    { auto rr = __builtin_amdgcn_permlane32_swap(__float_as_uint(pmax), __float_as_uint(pmax), false, false); pmax = fmaxf(__uint_as_float(rr[0]), __uint_as_float(rr[1])); }
    if (__builtin_expect(__all((pmax - m_reg) <= THR2), 1)) { mn = m_reg; alpha = 1.f; }
    else { mn = fmaxf(m_reg, pmax); alpha = __builtin_amdgcn_exp2f(m_reg - mn); m_reg = mn; }
#pragma unroll
    for (int r = 0; r < 16; ++r) { p0[r] -= mn; p1[r] -= mn; }
#pragma unroll
    for (int r = 0; r < 16; ++r) p0[r] = __builtin_amdgcn_exp2f(p0[r]);
}
__device__ __forceinline__ void finishSM(f32x16& p0, f32x16& p1, float alpha, float& l_reg, bf16x8& pa0, bf16x8& pa1, bf16x8& pa2, bf16x8& pa3) {
#pragma unroll
    for (int r = 0; r < 16; ++r) p1[r] = __builtin_amdgcn_exp2f(p1[r]);
    float ps = 0;
#pragma unroll
    for (int r = 0; r < 16; ++r) ps += p0[r];
#pragma unroll
    for (int r = 0; r < 16; ++r) ps += p1[r];
    { auto rr = __builtin_amdgcn_permlane32_swap(__float_as_uint(ps), __float_as_uint(ps), false, false); ps = __uint_as_float(rr[0]) + __uint_as_float(rr[1]); }
    l_reg = l_reg * alpha + ps;
#define A2_PK4(P, B_, OUT) do { unsigned a0 = cvtpk(P[B_+0], P[B_+1]), a1 = cvtpk(P[B_+2], P[B_+3]); unsigned b0 = cvtpk(P[B_+4], P[B_+5]), b1 = cvtpk(P[B_+6], P[B_+7]); \
        auto r0 = __builtin_amdgcn_permlane32_swap(a0, b0, false, false); auto r1 = __builtin_amdgcn_permlane32_swap(a1, b1, false, false); \
        v4u w = {r0[0], r1[0], r0[1], r1[1]}; OUT = __builtin_bit_cast(bf16x8, w); } while (0)
    A2_PK4(p0, 0, pa0); A2_PK4(p0, 8, pa1); A2_PK4(p1, 0, pa2); A2_PK4(p1, 8, pa3);
#undef A2_PK4
}
template <int KB>
__device__ __forceinline__ void qkt(f32x16& p0, f32x16& p1, const char* K_lds, const char* qr_lds, int r32, int hi, const bf16x8* qr) {
    p0 = f32x16{}; p1 = f32x16{};
    const char* kbase = K_lds + KB * SHM_K + r32 * 512; const int x = r32 & 15;
#pragma unroll
    for (int d = 0; d < 12; ++d) { const char* a = kbase + ((((2 * d + hi) & 15) ^ x) << 4) + (d >= 8 ? 256 : 0);
        const bf16x8 b0 = *reinterpret_cast<const bf16x8*>(a), b1 = *reinterpret_cast<const bf16x8*>(a + 32 * 512);
        const bf16x8 q = d < 8 ? qr[d < 8 ? d : 0] : *reinterpret_cast<const bf16x8*>(qr_lds + (((d - 8) * 2 + hi) * 32 + r32) * 16);
        p0 = __builtin_amdgcn_mfma_f32_32x32x16_bf16(b0, q, p0, 0, 0, 0);
        p1 = __builtin_amdgcn_mfma_f32_32x32x16_bf16(b1, q, p1, 0, 0, 0); }
}
template <int VB>
__device__ __forceinline__ void pv_tile(f32x16* o, int vb0, bf16x8 pa0, bf16x8 pa1, bf16x8 pa2, bf16x8 pa3) {
#define A2_TRRD(dst, off) asm volatile("ds_read_b64_tr_b16 %0, %1 offset:%2" : "=&v"(dst) : "v"(vb0), "i"(off) : "memory")
#define A2_PV_D0(d0) do { s16x4 l0, l1, l2, l3, h0, h1, h2, h3; constexpr int b_ = VB * SHM_V + v_rd_off(d0, 0, 0); \
        A2_TRRD(l0, b_); A2_TRRD(h0, b_ + 2048); A2_TRRD(l1, b_ + 4096); A2_TRRD(h1, b_ + 6144); A2_TRRD(l2, b_ + 8192); A2_TRRD(h2, b_ + 10240); A2_TRRD(l3, b_ + 12288); A2_TRRD(h3, b_ + 14336); \
        asm volatile("s_waitcnt lgkmcnt(0)" ::: "memory"); A2_SBAR(); \
        o[d0] = __builtin_amdgcn_mfma_f32_32x32x16_bf16(pa0, (bf16x8){l0[0], l0[1], l0[2], l0[3], h0[0], h0[1], h0[2], h0[3]}, o[d0], 0, 0, 0); \
        o[d0] = __builtin_amdgcn_mfma_f32_32x32x16_bf16(pa1, (bf16x8){l1[0], l1[1], l1[2], l1[3], h1[0], h1[1], h1[2], h1[3]}, o[d0], 0, 0, 0); \
        o[d0] = __builtin_amdgcn_mfma_f32_32x32x16_bf16(pa2, (bf16x8){l2[0], l2[1], l2[2], l2[3], h2[0], h2[1], h2[2], h2[3]}, o[d0], 0, 0, 0); \
        o[d0] = __builtin_amdgcn_mfma_f32_32x32x16_bf16(pa3, (bf16x8){l3[0], l3[1], l3[2], l3[3], h3[0], h3[1], h3[2], h3[3]}, o[d0], 0, 0, 0); } while (0)
    A2_PV_D0(0); A2_PV_D0(1); A2_PV_D0(2); A2_PV_D0(3);
#undef A2_PV_D0
#undef A2_TRRD
}
struct BlockRef { const bf16* Q; const bf16* K; const bf16* V; bf16* O; int P0; };
struct Seam { bf16x8 qr[8]; bf16x8 st_v0, st_v1, st_k0, st_k1, st_k2; };
#define A2_VMW() asm volatile("s_waitcnt vmcnt(0)" ::: "memory")
#define A2_VMWN(n) asm volatile("s_waitcnt vmcnt(%0)" :: "i"(n) : "memory")
#define A2_SLOAD(Kp, Vp, k0) do { S.st_v0 = load8((Vp) + (size_t)((k0) + sr) * VS + sc); S.st_v1 = load8((Vp) + (size_t)((k0) + 32 + sr) * VS + sc); \
        const bf16* kp_ = (Kp) + (size_t)((k0) + krow) * KS + kc * 8; S.st_k0 = load8(kp_); S.st_k1 = load8(kp_ + 64); S.st_k2 = load8(kp_ + 128); } while (0)
#define A2_SWRITE_K(bf) do { *(bf16x8*)(K_lds + (bf) * SHM_K + kw0) = S.st_k0; *(bf16x8*)(K_lds + (bf) * SHM_K + kw1) = S.st_k1; *(bf16x8*)(K_lds + (bf) * SHM_K + kw0 + 256) = S.st_k2; } while (0)
#define A2_SWRITE_V(bf) do { *(bf16x8*)(V_lds + (bf) * SHM_V + vst0) = S.st_v0; *(bf16x8*)(V_lds + (bf) * SHM_V + vst1) = S.st_v1; } while (0)
#define A2_SWRITE(bf) do { A2_SWRITE_V(bf); A2_SWRITE_K(bf); } while (0)
#define A2_IDX const int tid = threadIdx.x, wid = __builtin_amdgcn_readfirstlane(tid >> 6), lane = tid & 63, r32 = lane & 31, hi = lane >> 5; \
    const int sr = tid >> 4, sc = (tid & 15) * 8, krow = tid >> 3, kc = tid & 7, kw0 = krow * 512 + ((kc ^ (krow & 15)) << 4), kw1 = krow * 512 + (((kc + 8) ^ (krow & 15)) << 4); \
    char* V_lds = lds + OFF_V; char* K_lds = lds + OFF_K; (void)lane; (void)r32; (void)hi; (void)sr; (void)sc; (void)V_lds
__device__ __forceinline__ void attn_prime(const BlockRef& cur, char* lds, Seam& S) {
    A2_IDX;
#pragma unroll
    for (int d0 = 0; d0 < 8; ++d0) S.qr[d0] = load8(cur.Q + (size_t)(wid * QBLK + r32) * QS + d0 * 16 + hi * 8);
    A2_SLOAD(cur.K, cur.V, 0); A2_VMW(); A2_SWRITE_K(0);
}
__device__ __forceinline__ void attn_block(const BlockRef& cur, const BlockRef& nxt, char* lds, Seam& S) {
    A2_IDX;
    const int NT = (cur.P0 + QB) / KVBLK;
    const int qlo = cur.P0 + wid * QBLK, qm = qlo + r32 - 4 * hi;
    float* ws = (float*)(lds + OFF_WS) + wid * 64; float* li_l = ws, * al_l = ws + 32;
    char* qr_lds = lds + OFF_QR + wid * 4096;
    float m_reg = -1e30f, l_reg = 0; f32x16 o[4] = {};
    const int vst0 = v_st(sr, sc), vst1 = v_st(32 + sr, sc);
    const int vb0 = (int)(uintptr_t)V_lds + v_rd_base(lane);
    const bf16* Kh = cur.K; const bf16* Vh = cur.V;
    { bf16x8 t4[4];
#pragma unroll
      for (int d = 0; d < 4; ++d) t4[d] = load8(cur.Q + (size_t)(wid * QBLK + r32) * QS + 128 + d * 16 + hi * 8);
#pragma unroll
      for (int d = 0; d < 4; ++d) *(bf16x8*)(qr_lds + ((d * 2 + hi) * 32 + r32) * 16) = t4[d]; }
    A2_SWRITE_V(0);
    __syncthreads();
    f32x16 p0, p1; float mn, al; bf16x8 pa0, pa1, pa2, pa3;
#define A2_STEP(t, BUF) do { const bool lastt = (t) + 1 >= NT; \
        A2_SBAR(); { const bf16* Kn = lastt ? nxt.K : Kh; const bf16* Vn = lastt ? nxt.V : Vh; const int k0n = lastt ? 0 : ((t) + 1) * KVBLK; A2_SLOAD(Kn, Vn, k0n); } A2_SBAR(); \
        qkt<BUF>(p0, p1, K_lds, qr_lds, r32, hi, S.qr); \
        if (lastt) { A2_SBAR(); _Pragma("unroll") for (int d0 = 0; d0 < 8; ++d0) S.qr[d0] = load8(nxt.Q + (size_t)(wid * QBLK + r32) * QS + d0 * 16 + hi * 8); A2_SBAR(); } \
        { const int kb_ = (t) * KVBLK; if (kb_ + KVBLK - 1 > qlo) mask_tile(p0, p1, qm - kb_); } \
        partialSM(p0, p1, m_reg, mn, al); finishSM(p0, p1, al, l_reg, pa0, pa1, pa2, pa3); \
        if (__any(al < 1.f)) { if (hi == 0) al_l[r32] = al; asm volatile("s_waitcnt lgkmcnt(0)" ::: "memory"); \
            for (int d_ = 0; d_ < 4; ++d_) for (int r = 0; r < 16; ++r) o[d_][r] *= al_l[crow(r, hi)]; } \
        A2_SBAR(); pv_tile<BUF>(o, vb0, pa0, pa1, pa2, pa3); A2_SBAR(); \
        if (lastt) { A2_VMWN(8); A2_SWRITE_K(0); } else { A2_VMW(); A2_SWRITE((BUF) ^ 1); } \
        __syncthreads(); } while (0)
    for (int t = 0; t < NT; t += 2) { A2_STEP(t, 0); A2_STEP(t + 1, 1); }
#undef A2_STEP
    if (hi == 0) li_l[r32] = l_reg; asm volatile("s_waitcnt lgkmcnt(0)" ::: "memory");
    float rli[16];
#pragma unroll
    for (int r = 0; r < 16; ++r) rli[r] = __builtin_amdgcn_rcpf(li_l[crow(r, hi)]);
    bf16* Ow = cur.O + (size_t)(wid * QBLK) * OS;
#pragma unroll
    for (int r = 0; r < 16; ++r) { const int orow = crow(r, hi);
#pragma unroll
        for (int d0 = 0; d0 < 4; ++d0) { const float v = o[d0][r] * rli[r]; const float vn = __shfl_xor(v, 1);
            if ((r32 & 1) == 0) *(unsigned*)(Ow + (size_t)orow * OS + d0 * 32 + r32) = cvtpk(v, vn); } }
    asm volatile("s_waitcnt lgkmcnt(0)" ::: "memory");
}
}
__device__ __forceinline__ attn2::BlockRef attn2_ref(unsigned char* ws, int v, int pass) {
    const int bh = v >> 3, b = bh >> 3, h = bh & 7, x = v & 7, qb = pass ? 15 - x : x;
    attn2::BlockRef r;
    r.Q = (const bf16*)(ws + WS_QP) + ((size_t)b * SEQ + qb * 256) * 1536 + h * 192; r.K = (const bf16*)(ws + WS_KF) + (size_t)b * SEQ * 1536 + h * 192;
    r.V = (const bf16*)(ws + WS_KVP) + (size_t)b * SEQ * 2048 + h * 256 + 128; r.O = (bf16*)(ws + WS_MO) + ((size_t)b * SEQ + qb * 256) * 1024 + h * 128; r.P0 = qb * 256;
    return r;
}
__device__ __forceinline__ void phase_attn2(Frame& F, char* lds) {
    int L = F.vcu; if (L >= 256) return;
    attn2::Seam S; int pass = 0;
    attn2::BlockRef cur = attn2_ref(F.ws, L, 0);
    attn2::attn_prime(cur, lds, S);
    for (;;) {
        const bool more_pass = pass == 0, more_item = L + F.G < 256, last = !more_pass && !more_item;
        int passn = pass + 1, Ln = L;
        if (!more_pass) { passn = 0; Ln = more_item ? L + F.G : L; }
        const attn2::BlockRef nxt = last ? cur : attn2_ref(F.ws, Ln, passn);
        attn2::attn_block(cur, nxt, lds, S);
        if (last) break;
        cur = nxt; pass = passn; L = Ln;
    }
}

#ifndef MK_N_LAUNCHES
#define MK_N_LAUNCHES 13
#endif
constexpr int N_PHASES = 13;
constexpr int N_LAUNCHES = MK_N_LAUNCHES;
struct Args { const float* in[21]; float* out; unsigned char* ws; int ph_lo, ph_hi; };
#define PG8_SP2 true
#define PG8_ALIGN true
template <class Epi> __device__ __forceinline__ void run_gemm(Frame& F, const pg8::bf16_t* A, int lda, const pg8::bf16_t* Bt, int ldb, int N, int K, const Epi& E) {
    __syncthreads();
    pg8::Gemm g{A, Bt, MTOK, N, K, lda, ldb}; pg8::StaticOrder S; S.init(MTOK, N, F.G, (int)blockIdx.x);
    pg8::gemm_phase<Epi, pg8::StaticOrder, PG8_ALIGN, PG8_SP2>(F.lds + RING_OFF, g, S, E);
}
__global__ void __launch_bounds__(NWAVES * 64, 2) mk_fwd(Args args) {
    extern __shared__ __attribute__((aligned(16))) unsigned char lds[];
    Frame F;
    F.lds = (LAS unsigned char*)lds; F.MISC = (volatile LAS unsigned*)(F.lds + MISC_OFF);
    F.tid = threadIdx.x; F.lane = F.tid & 63; F.wave = __builtin_amdgcn_readfirstlane(F.tid >> 6);
    F.G = gridDim.x; { const int bx = blockIdx.x; F.vcu = (F.G % 8 == 0) ? (bx % 8) * (F.G / 8) + bx / 8 : bx; }
    F.out = args.out; F.ws = args.ws;
    unsigned char* ws = args.ws;
    if (F.tid < 32) F.MISC[F.tid] = 0u;
    __syncthreads();
    XcdBarrier bar; bar.bar = (unsigned*)(ws + WS_CTL) + CW_BAR; bar.x = 0; bar.st = nullptr;
    if (N_LAUNCHES == 1) bar = xcd_barrier_post((unsigned*)(ws + WS_CTL) + CW_BAR, F.MISC + 8);
    const int lo = args.ph_lo, hi = args.ph_hi;
#ifndef PH_MASK
#define PH_MASK 0x1fff
#endif
#define IN(k) (((PH_MASK >> (k)) & 1) && lo <= (k) && (k) < hi)
#define SEAM(k) do { if (IN(k) && IN((k) + 1)) xcd_barrier(bar); } while (0)
#ifdef STRETCH_MASK
#define PH_T0() const unsigned long long t0_ = __builtin_amdgcn_s_memrealtime()
#define PH_STRETCH(k) do { if ((STRETCH_MASK >> (k)) & 1) { const unsigned long long t1_ = __builtin_amdgcn_s_memrealtime(); const unsigned long long d_ = (t1_ - t0_) * STRETCH_MULT; while (__builtin_amdgcn_s_memrealtime() - t1_ < d_) __builtin_amdgcn_s_sleep(8); } } while (0)
#else
#define PH_T0() do {} while (0)
#define PH_STRETCH(k) do {} while (0)
#endif
    float* sm = (float*)(ws + WS_SMALL);
    const float* rstdx = sm + SM_RSTDX / 4; float* ssq_cq = sm + SM_SSQ_CQ / 4; float* ssq_ckv = sm + SM_SSQ_CKV / 4; float* ssq1 = sm + SM_SSQ1 / 4; float* ssq2 = sm + SM_SSQ2 / 4; float* ssq_ro = sm + SM_SSQ_RO / 4;
    typedef pg8::bf16_t b16;
    b16* WinT = (b16*)(ws + WS_WIN); b16* XB = (b16*)(ws + WS_XB); b16* LATb = (b16*)(ws + WS_LAT); b16* ROb = (b16*)args.out;

    if (IN(0)) { PH_T0(); phase_p0(F, args.in[0], (const int*)args.in[2], args.in[3], args.in[4], args.in[6], args.in[7], args.in[8], args.in[9]); PH_STRETCH(0); } SEAM(0);
    if (IN(1)) { PH_T0();
        pg8::EpiInProj E{rstdx, (const pg8::f32x4*)(ws + WS_CS), (b16*)(ws + WS_RQ), (b16*)(ws + WS_RK), (b16*)(ws + WS_RKDT), (b16*)(ws + WS_RVT), LATb, ssq_cq, (PG8_LAS unsigned char*)(F.lds + XS_OFF)};
        run_gemm(F, XB, 1024, WinT + (size_t)4096 * 1024, 1024, NIN1, 1024, E);
    PH_STRETCH(1); } SEAM(1);
    if (IN(2)) { PH_T0(); phase_r0p(F); PH_STRETCH(2); } SEAM(2);
    if (IN(3)) { PH_T0(); phase_r1p(F); PH_STRETCH(3); } SEAM(3);
    if (IN(4)) { PH_T0();
        { pg8::EpiRetGate E{ROb, rstdx, (const float*)(ws + WS_SSQP), args.in[5]}; run_gemm(F, XB, 1024, WinT + (size_t)2048 * 1024, 1024, 2048, 1024, E); }
        { pg8::EpiRowAct<0> E{(b16*)(ws + WS_QP), 1536, ssq_cq, 1.0f / 384.0f}; run_gemm(F, LATb, LATW, (const b16*)(ws + WS_WUQ), 384, 1536, 384, E); }
        { pg8::EpiRowAct<0> E{(b16*)(ws + WS_KVP), 2048, ssq_ckv, 1.0f / 256.0f}; run_gemm(F, LATb + 384, LATW, (const b16*)(ws + WS_WUKV), 256, 2048, 256, E); }
    PH_STRETCH(4); } SEAM(4);
    if (IN(5)) { PH_T0(); phase_fin(F, args.in[10], args.in[11]); PH_STRETCH(5); } SEAM(5);
#ifdef ATTN_V1
    if (IN(6)) { PH_T0(); phase_attn(F); PH_STRETCH(6); } SEAM(6);
#else
    if (IN(6)) { PH_T0(); phase_attn2(F, (char*)lds); PH_STRETCH(6); } SEAM(6);
#endif
    if (IN(7)) { PH_T0();
#ifndef SKIP_LATE
        phase_late_weights(F, args.in[1], args.in[12], args.in[13], args.in[14], args.in[15], args.in[16], args.in[17], args.in[18], args.in[19], args.in[20]);
#endif
        { pg8::EpiRowAct<1> E{(b16*)(ws + WS_SG), 2048, rstdx, 0.f}; run_gemm(F, XB, 1024, WinT, 1024, 2048, 1024, E); }
    PH_STRETCH(7); } SEAM(7);
    if (IN(8)) { PH_T0();
        { pg8::EpiGateMix<0> E{(b16*)(ws + WS_TM), (const b16*)(ws + WS_SG), 0}; run_gemm(F, ROb, 2048, (const b16*)(ws + WS_WBR), 2048, 1024, 2048, E); }
        VM_WAIT(); __syncthreads(); __builtin_amdgcn_fence(__ATOMIC_ACQUIRE, "agent"); VM_WAIT(); __syncthreads();
        { pg8::EpiGateMix<1> E{(b16*)(ws + WS_TM), (const b16*)(ws + WS_SG), 1024}; run_gemm(F, (const b16*)(ws + WS_MO), 1024, (const b16*)(ws + WS_WBM), 1024, 1024, 1024, E); }
    PH_STRETCH(8); } SEAM(8);
    if (IN(9)) { PH_T0(); pg8::EpiResid<false> E{(const void*)args.in[0], XB, ssq1}; run_gemm(F, (const b16*)(ws + WS_TM), 1024, (const b16*)(ws + WS_WO), 1024, 1024, 1024, E); PH_STRETCH(9); } SEAM(9);
    if (IN(10)) { PH_T0(); pg8::EpiRowAct<2> E{(b16*)(ws + WS_H), 4096, ssq1, 1.0f / 1024.0f}; run_gemm(F, XB, 1024, (const b16*)(ws + WS_WUP), 1024, 4096, 1024, E); PH_STRETCH(10); } SEAM(10);
    if (IN(11)) { PH_T0(); pg8::EpiResid<true> E{(const void*)XB, XB, ssq2}; run_gemm(F, (const b16*)(ws + WS_H), 4096, (const b16*)(ws + WS_WDOWN), 4096, 1024, 4096, E); PH_STRETCH(11); } SEAM(11);
    if (IN(12)) { PH_T0();
        { pg8::EpiRowAct<1> E{(b16*)(ws + WS_GT), 1024, ssq2, 1.0f / 1024.0f}; run_gemm(F, XB, 1024, (const b16*)(ws + WS_WPG), 1024, 1024, 1024, E); }
        VM_WAIT(); __syncthreads(); __builtin_amdgcn_fence(__ATOMIC_ACQUIRE, "agent"); VM_WAIT(); __syncthreads();
        { pg8::EpiFinal E{args.out, (const b16*)(ws + WS_GT), XB}; run_gemm(F, (const b16*)(ws + WS_PB), 256, (const b16*)(ws + WS_WPLE), 256, 1024, 256, E); }
    PH_STRETCH(12); }
#undef IN
#undef SEAM
}


#ifdef DUMPK
struct DumpArgs { const unsigned* reg[6]; unsigned nw[6]; unsigned* out; int own; int pad; };
__global__ void dump_hash(DumpArgs d) {
    for (unsigned i = blockIdx.x * blockDim.x + threadIdx.x; i < (unsigned)MTOK * DM; i += gridDim.x * blockDim.x) {
        float s = 0.f;
        if (d.own) { const unsigned w = d.out[i]; s += __uint_as_float(w << 16) + __uint_as_float(w & 0xffff0000u); }
        for (int r = 0; r < 6; ++r) if (d.reg[r] && i < d.nw[r] * 2u) { const unsigned short v = ((const unsigned short*)d.reg[r])[i]; s += __uint_as_float((unsigned)v << 16); }
        ((float*)d.out)[i] = s;
    }
}
#endif
extern "C" void kernel_launch(void* const* d_in, const int* in_sizes, int n_in, void* d_out, int out_size, void* d_ws, size_t ws_size, hipStream_t stream) {
    static int grid = 0;
    if (grid == 0) {
        if (n_in != 21 || in_sizes[0] != MTOK * DM || out_size != MTOK * DM || ws_size < WS_END) { fprintf(stderr, "kernel_launch: unexpected shapes (n_in %d in0 %d out %d ws %zu)\n", n_in, n_in > 0 ? in_sizes[0] : -1, out_size, ws_size); grid = -1; return; }
        int dev = 0, cus = 0, per_cu = 0;
        if (hipGetDevice(&dev) != hipSuccess || hipDeviceGetAttribute(&cus, hipDeviceAttributeMultiprocessorCount, dev) != hipSuccess) { grid = -1; return; }
        if (hipFuncSetAttribute((const void*)mk_fwd, hipFuncAttributeMaxDynamicSharedMemorySize, LDS_BYTES) != hipSuccess) { fprintf(stderr, "kernel_launch: hipFuncSetAttribute failed\n"); grid = -1; return; }
        if (hipOccupancyMaxActiveBlocksPerMultiprocessor(&per_cu, (const void*)mk_fwd, NWAVES * 64, LDS_BYTES) != hipSuccess || per_cu < 1) { fprintf(stderr, "kernel_launch: occupancy query says %d workgroups per CU\n", per_cu); (void)hipGetLastError(); grid = -1; return; }
        grid = cus;
    }
    if (grid < 0) return;
    (void)hipMemsetAsync((char*)d_ws + WS_CTL, 0, CTL_ZERO_BYTES, stream);
    Args a{};
    for (int i = 0; i < 21; ++i) a.in[i] = (const float*)d_in[i];
    a.out = (float*)d_out; a.ws = (unsigned char*)d_ws;
    if (N_LAUNCHES == 1) { a.ph_lo = 0; a.ph_hi = N_PHASES; hipLaunchKernelGGL(mk_fwd, dim3(grid), dim3(NWAVES * 64), LDS_BYTES, stream, a); }
    else for (int ph = 0; ph < N_PHASES; ++ph) {
#ifdef DUMPK
        if (ph > DUMPK) break;
#endif
        a.ph_lo = ph; a.ph_hi = ph + 1; hipLaunchKernelGGL(mk_fwd, dim3(grid), dim3(NWAVES * 64), LDS_BYTES, stream, a); }
#ifdef DUMPK
    { DumpArgs d{}; d.out = (unsigned*)d_out; d.own = DUMP_OWN; const size_t offs[6] = DUMP_OFFS; const size_t len[6] = DUMP_LENS;
      for (int r = 0; r < 6; ++r) if (len[r]) { d.reg[r] = (const unsigned*)((const char*)d_ws + offs[r]); d.nw[r] = (unsigned)(len[r] / 4); }
      hipLaunchKernelGGL(dump_hash, dim3(2048), dim3(256), 0, stream, d); }
#endif
}
```

```cpp
#define MK_N_LAUNCHES 1
#include <hip/hip_runtime.h>
#include <hip/hip_bf16.h>
#include <cstdio>
#include <cstdint>
namespace pg8 {
#define PG8_LAS __attribute__((address_space(3)))
typedef unsigned short bf16_t;
typedef short bf16x8 __attribute__((ext_vector_type(8)));
typedef float f32x4 __attribute__((ext_vector_type(4)));
typedef unsigned u32x4 __attribute__((ext_vector_type(4)));
constexpr int BM = 256, BK = 64, HALF = 128, HTB = HALF * BK * 2  , STAGE_BYTES = 8 * HTB, NXCD = 8, WGM = 8;

__host__ __device__ __forceinline__ int lds_byte(int r, int c) { const int st = (r >> 4) * 2 + (c >> 5), rr = r & 15, cc = c & 31, ob = rr * 64 + cc * 2; return st * 1024 + (ob ^ (((ob >> 9) & 1) << 5)); }
__host__ __device__ __forceinline__ void stage_rc(int b, int& R, int& C) { const int st = b / 1024, sb = b % 1024, swz = sb ^ (((sb >> 9) & 1) << 5); R = (st >> 1) * 16 + swz / 64; C = (st & 1) * 32 + (swz % 64) / 2; }
__host__ __device__ __forceinline__ int perm32(int rho) { const int n = rho >> 4, i = rho & 15; return 8 * (i >> 2) + 4 * n + (i & 3); }

struct Unit { int pm, pn; };
struct Gemm { const bf16_t* A; const bf16_t* Bt; int M, N, K, lda, ldb; };

struct StaticOrder {
    int nM, nN, nwg, G, c;
    __host__ __device__ void init(int M, int N, int G_, int c_) { nM = M / BM; nN = N / BM; nwg = nM * nN; G = G_; c = c_; }
    __host__ __device__ bool next(int i, Unit& u) const {
        const long L = (long)i * G + c; if (L >= nwg) return false;
        int wgid = (int)L; { const int q = nwg / NXCD, r = nwg % NXCD, xcd = wgid % NXCD, off = wgid / NXCD; wgid = (xcd < r ? xcd * (q + 1) : r * (q + 1) + (xcd - r) * q) + off; }
        const int nig = WGM * nN, gid = wgid / nig, fm = gid * WGM, gsz = (nM - fm) < WGM ? (nM - fm) : WGM;
        u.pm = fm + ((wgid % nig) % gsz); u.pn = (wgid % nig) / gsz; return true;
    }
    __device__ __forceinline__ void a_ready(const Unit&) const {}
    __device__ __forceinline__ void done(const Unit&) const {}
};


typedef float f32x2 __attribute__((ext_vector_type(2)));
typedef unsigned u32x2 __attribute__((ext_vector_type(2)));
typedef __bf16 bf16x2_t __attribute__((ext_vector_type(2)));
__device__ __forceinline__ unsigned cvt_pk_bf16(float lo, float hi) { f32x2 v = {lo, hi}; bf16x2_t b = __builtin_convertvector(v, bf16x2_t); return __builtin_bit_cast(unsigned, b); }
__device__ __forceinline__ float bflo(unsigned w) { return __uint_as_float(w << 16); }
__device__ __forceinline__ float bfhi(unsigned w) { return __uint_as_float(w & 0xffff0000u); }
__device__ __forceinline__ u32x4 pack8(const float (&v)[8]) { u32x4 w; w.x = cvt_pk_bf16(v[0], v[1]); w.y = cvt_pk_bf16(v[2], v[3]); w.z = cvt_pk_bf16(v[4], v[5]); w.w = cvt_pk_bf16(v[6], v[7]); return w; }
__device__ __forceinline__ void unpack8(const u32x4 w, float (&v)[8]) { v[0] = bflo(w.x); v[1] = bfhi(w.x); v[2] = bflo(w.y); v[3] = bfhi(w.y); v[4] = bflo(w.z); v[5] = bfhi(w.z); v[6] = bflo(w.w); v[7] = bfhi(w.w); }
__device__ __forceinline__ float sigmoidf_(float x) { return __builtin_amdgcn_rcpf(1.0f + __builtin_amdgcn_exp2f(-1.4426950408889634f * x)); }
constexpr float RMS_EPS_ = 1e-6f;

#define EPI_ACC8(v, ai, bj, m) float v[8]; { const f32x4 a0_ = acc[ai][bj][m][0], a1_ = acc[ai][bj][m][1]; v[0] = a0_[0]; v[1] = a0_[1]; v[2] = a0_[2]; v[3] = a0_[3]; v[4] = a1_[0]; v[5] = a1_[1]; v[6] = a1_[2]; v[7] = a1_[3]; }

__device__ __forceinline__ void xpose_store(PG8_LAS unsigned char* st, const unsigned (&pk)[4][4], bf16_t* dst, int R, int lane, int fr, int fq) {
#pragma unroll
    for (int pass = 0; pass < 2; ++pass) {
        if ((fq >> 1) == pass) {
#pragma unroll
            for (int m = 0; m < 4; ++m)
#pragma unroll
                for (int q = 0; q < 4; ++q) { const unsigned w = pk[m][q]; const int c = (fq & 1) * 8 + 2 * q;
                    *(PG8_LAS unsigned short*)(st + c * 144 + (16 * m + fr) * 2) = (unsigned short)(w & 0xffffu);
                    *(PG8_LAS unsigned short*)(st + (c + 1) * 144 + (16 * m + fr) * 2) = (unsigned short)(w >> 16); }
        }
        asm volatile("s_waitcnt lgkmcnt(0)" ::: "memory");
#pragma unroll
        for (int k = 0; k < 2; ++k) { const int idx = lane + 64 * k, c = idx & 15, ch = idx >> 4;
            const u32x4 v = *(const PG8_LAS u32x4*)(st + c * 144 + ch * 16);
            *(u32x4*)(dst + ((size_t)ch * R + pass * 16 + c) * 8) = v; }
        asm volatile("s_waitcnt lgkmcnt(0)" ::: "memory");
    }
}

struct EpiInProj {
    static constexpr bool PERM = true, AFTER_DRAIN = false, TWICE_OK = true; static __device__ __forceinline__ bool twice(const Unit& u) { return u.pn < 16; }
    const float* rstdx; const f32x4* cs;
    bf16_t *RQ, *RK, *RKDT, *RVT, *LAT; float *ssq_lat;   PG8_LAS unsigned char* xs;
    bf16_t* KR; float* ssq_kr; const float* k_norm;
    __device__ __forceinline__ void operator()(const f32x4 (&acc)[2][2][4][2], const Unit& u, int wr, int wc, int fr, int fq) const {
        const int pn = u.pn, lane = fq * 16 + fr, wid = wr * 4 + wc;
        PG8_LAS unsigned char* st = xs + wid * 2304;
        const int rowt = u.pm * BM + wr * 64 + fr;
        const int bidx = (u.pm * BM) >> 12, s0 = (u.pm * BM) & 4095;
        if (pn < 8) {
            const bool isk = pn >= 4; const int head = pn & 3;
            const float lg2 = __builtin_amdgcn_logf(1.0f - __builtin_amdgcn_exp2f(-5.0f - (float)head));
            float kd[4];
#pragma unroll
            for (int m = 0; m < 4; ++m) kd[m] = __builtin_amdgcn_exp2f((float)(127 - (wr * 64 + m * 16 + fr)) * lg2);
            bf16_t* O = isk ? RK : RQ;
#pragma unroll
            for (int ai = 0; ai < 2; ++ai) {
                unsigned pk0[4][4], pk1[4][4];
#pragma unroll
                for (int m = 0; m < 4; ++m) {
                    const int row = rowt + ai * HALF + m * 16; const float rs = rstdx[row] * (isk ? 0.0625f : 1.0f);
                    const f32x4* cp = cs + (size_t)row * 64 + wc * 16 + fq * 4;
                    const f32x4 c0 = cp[0], c1 = cp[1], c2 = cp[2], c3 = cp[3];
                    const float cc[8] = {c0[0], c0[2], c1[0], c1[2], c2[0], c2[2], c3[0], c3[2]}, ss[8] = {c0[1], c0[3], c1[1], c1[3], c2[1], c2[3], c3[1], c3[3]};
                    EPI_ACC8(x1, ai, 0, m); EPI_ACC8(x2, ai, 1, m);
                    float o1[8], o2[8];
#pragma unroll
                    for (int e = 0; e < 8; ++e) { const float a = x1[e] * rs, b = x2[e] * rs; o1[e] = a * cc[e] - b * ss[e]; o2[e] = b * cc[e] + a * ss[e]; }
                    bf16_t* rp = O + ((((size_t)(bidx * 4 + head) * 32 + (s0 >> 7) + ai) * 32 + wc * 4 + fq) * 128 + wr * 64 + m * 16 + fr) * 8;
                    *(u32x4*)rp = pack8(o1); *(u32x4*)(rp + (size_t)16 * 128 * 8) = pack8(o2);
                    if (isk) {
#pragma unroll
                        for (int q = 0; q < 4; ++q) { pk0[m][q] = cvt_pk_bf16(o1[2 * q] * kd[m], o1[2 * q + 1] * kd[m]); pk1[m][q] = cvt_pk_bf16(o2[2 * q] * kd[m], o2[2 * q + 1] * kd[m]); }
                    }
                }
                if (isk) {
                    bf16_t* d0 = RKDT + ((((size_t)(bidx * 4 + head) * 32 + (s0 >> 7) + ai) * 16 + wr * 8) * 256 + wc * 32) * 8;
                    xpose_store(st, pk0, d0, 256, lane, fr, fq);
                    xpose_store(st, pk1, d0 + (size_t)HALF * 8, 256, lane, fr, fq);
                }
            }
        } else if (pn < 16) {
            const int head = (pn - 8) >> 1, dvb = ((pn - 8) & 1) * 256;
#pragma unroll
            for (int ai = 0; ai < 2; ++ai)
#pragma unroll
                for (int bj = 0; bj < 2; ++bj) {
                    unsigned pk[4][4];
#pragma unroll
                    for (int m = 0; m < 4; ++m) { const float rs = rstdx[rowt + ai * HALF + m * 16]; EPI_ACC8(v, ai, bj, m);
#pragma unroll
                        for (int q = 0; q < 4; ++q) pk[m][q] = cvt_pk_bf16(v[2 * q] * rs, v[2 * q + 1] * rs); }
                    bf16_t* d0 = RVT + ((((size_t)(bidx * 4 + head) * 32 + (s0 >> 7) + ai) * 16 + wr * 8) * 512 + dvb + bj * HALF + wc * 32) * 8;
                    xpose_store(st, pk, d0, 512, lane, fr, fq);
                }
        } else if (pn < 19) {
            const int lt = pn - 16;
#pragma unroll
            for (int ai = 0; ai < 2; ++ai)
#pragma unroll
                for (int m = 0; m < 4; ++m) { const int row = rowt + ai * HALF + m * 16; const float rs = rstdx[row];
#pragma unroll
                    for (int bj = 0; bj < 2; ++bj) { if (lt == 2 && bj == 1) continue;
                        EPI_ACC8(v, ai, bj, m); float q = 0.f;
#pragma unroll
                        for (int e = 0; e < 8; ++e) { v[e] *= rs; q += v[e] * v[e]; }
                        *(u32x4*)(LAT + ((unsigned)row * 640u + lt * 256 + bj * HALF + wc * 32 + 8 * fq)) = pack8(v);
                        const int kind = (lt == 0) ? 0 : (lt == 1 ? (bj == 0 ? 0 : 1) : 1);
                        q += __shfl_xor(q, 16); q += __shfl_xor(q, 32); if (fq == 0) atomicAdd(ssq_lat + kind * 16384 + row, q); } }
        } else if (wc == 0) {
#pragma unroll
            for (int ai = 0; ai < 2; ++ai)
#pragma unroll
                for (int m = 0; m < 4; ++m) { const int row = rowt + ai * HALF + m * 16; const float rs = rstdx[row];
                    const f32x2* cp = (const f32x2*)cs + ((unsigned)row * 128u + 32u * fq); float q = 0.f; unsigned w1[4], w2[4];
#pragma unroll
                    for (int hh = 0; hh < 2; ++hh) { const f32x4 xa = acc[ai][0][m][hh] * rs, xb = acc[ai][1][m][hh] * rs; const f32x4 ga = *(const f32x4*)(k_norm + 128 + 8 * fq + 4 * hh), gb = *(const f32x4*)(k_norm + 160 + 8 * fq + 4 * hh);
                        float oa[4], ob[4];
#pragma unroll
                        for (int e = 0; e < 4; ++e) { q += xa[e] * xa[e] + xb[e] * xb[e]; const float ya = xa[e] * ga[e], yb = xb[e] * gb[e]; const f32x2 c = cp[4 * (4 * hh + e)];
                            oa[e] = ya * c.x - yb * c.y; ob[e] = yb * c.x + ya * c.y; }
                        w1[2 * hh] = cvt_pk_bf16(oa[0], oa[1]); w1[2 * hh + 1] = cvt_pk_bf16(oa[2], oa[3]); w2[2 * hh] = cvt_pk_bf16(ob[0], ob[1]); w2[2 * hh + 1] = cvt_pk_bf16(ob[2], ob[3]); }
                    *(u32x4*)(KR + ((unsigned)row * 64u + 8u * fq)) = (u32x4){w1[0], w1[1], w1[2], w1[3]}; *(u32x4*)(KR + ((unsigned)row * 64u + 32u + 8u * fq)) = (u32x4){w2[0], w2[1], w2[2], w2[3]};
                    q += __shfl_xor(q, 16); q += __shfl_xor(q, 32); if (fq == 0) ssq_kr[row] = q;
                    asm volatile("" ::: "memory"); }
        }
    }
};

struct EpiKVup {
    static constexpr bool PERM = true, AFTER_DRAIN = false, TWICE_OK = false; static __device__ __forceinline__ bool twice(const Unit&) { return false; }
    unsigned char* ws; const float* k_norm; PG8_LAS float* xr;
    static constexpr size_t O_KF = (size_t)142 << 20, O_VV = (size_t)190 << 20, O_KR = ((size_t)22 << 20) + (256 << 10), O_SSQ_CKV = ((size_t)1 << 20) + (128 << 10), O_SSQ_KR = ((size_t)1 << 20) + (320 << 10);
    __device__ __forceinline__ void operator()(const f32x4 (&acc)[2][2][4][2], const Unit& u, int wr, int wc, int fr, int fq) const {
        const unsigned rowt = u.pm * BM + wr * 64 + fr, head = u.pn, d0 = wc * 32 + 8 * fq;
        bf16_t* KF = (bf16_t*)(ws + O_KF); bf16_t* VV = (bf16_t*)(ws + O_VV); const bf16_t* KR = (const bf16_t*)(ws + O_KR); const float* ssq_ckv = (const float*)(ws + O_SSQ_CKV); const float* ssq_kr = (const float*)(ws + O_SSQ_KR);
#pragma unroll
        for (int ai = 0; ai < 2; ++ai)
#pragma unroll
            for (int m = 0; m < 4; ++m) { const unsigned row = rowt + ai * HALF + m * 16; const float rs = __builtin_amdgcn_rsqf(ssq_ckv[row] * (1.0f / 256.0f) + RMS_EPS_);
                const f32x4 a0 = acc[ai][0][m][0] * rs, a1 = acc[ai][0][m][1] * rs;
                float q = (a0[0] * a0[0] + a0[1] * a0[1]) + (a0[2] * a0[2] + a0[3] * a0[3]) + (a1[0] * a1[0] + a1[1] * a1[1]) + (a1[2] * a1[2] + a1[3] * a1[3]);
                q += __shfl_xor(q, 16); q += __shfl_xor(q, 32);
                if (fq == 0) xr[(ai * HALF + wr * 64 + m * 16 + fr) * 4 + wc] = q;
                asm volatile("" ::: "memory"); }
        asm volatile("s_waitcnt lgkmcnt(0)\n\ts_barrier" ::: "memory");
        const f32x4 g0 = *(const f32x4*)(k_norm + d0), g1 = *(const f32x4*)(k_norm + d0 + 4);
#pragma unroll
        for (int ai = 0; ai < 2; ++ai)
#pragma unroll
            for (int m = 0; m < 4; ++m) { const unsigned row = rowt + ai * HALF + m * 16; const float rs = __builtin_amdgcn_rsqf(ssq_ckv[row] * (1.0f / 256.0f) + RMS_EPS_);
                const f32x4 p4 = *(const PG8_LAS f32x4*)(xr + (ai * HALF + wr * 64 + m * 16 + fr) * 4);
                const float sk = __builtin_amdgcn_rsqf(((p4[0] + p4[1]) + (p4[2] + p4[3]) + ssq_kr[row]) * (1.0f / 192.0f) + RMS_EPS_), rk = rs * sk;
                { EPI_ACC8(v, ai, 0, m);
#pragma unroll
                  for (int e = 0; e < 8; ++e) v[e] *= rk * (e < 4 ? g0[e & 3] : g1[e & 3]);
                  *(u32x4*)(KF + (row * 1536u + head * 192u + d0)) = pack8(v); }
                { EPI_ACC8(v, ai, 1, m);
#pragma unroll
                  for (int e = 0; e < 8; ++e) v[e] *= rs;
                  *(u32x4*)(VV + (row * 1024u + head * 128u + d0)) = pack8(v); }
                { const u32x2 kr = *(const u32x2*)(KR + (row * 64u + 16 * wc + 4 * fq));
                  *(u32x2*)(KF + (row * 1536u + head * 192u + 128 + 16 * wc + 4 * fq)) = (u32x2){cvt_pk_bf16(bflo(kr.x) * sk, bfhi(kr.x) * sk), cvt_pk_bf16(bflo(kr.y) * sk, bfhi(kr.y) * sk)}; }
                asm volatile("" ::: "memory"); }
    }
};

template <int MODE> struct EpiRowAct {
    static constexpr bool PERM = true, AFTER_DRAIN = false, TWICE_OK = (MODE == 2); static __device__ __forceinline__ bool twice(const Unit&) { return true; }
    bf16_t* O; int ldo; const float* rsrc; float inv_dim;
    __device__ __forceinline__ void operator()(const f32x4 (&acc)[2][2][4][2], const Unit& u, int wr, int wc, int fr, int fq) const {
        const int rowt = u.pm * BM + wr * 64 + fr, colt = u.pn * BM + wc * 32 + 8 * fq;
#pragma unroll
        for (int ai = 0; ai < 2; ++ai)
#pragma unroll
            for (int m = 0; m < 4; ++m) { const int row = rowt + ai * HALF + m * 16; const float r0 = rsrc[row]; const float rs = inv_dim == 0.f ? r0 : __builtin_amdgcn_rsqf(r0 * inv_dim + RMS_EPS_);
#pragma unroll
                for (int bj = 0; bj < 2; ++bj) { EPI_ACC8(v, ai, bj, m);
#pragma unroll
                    for (int e = 0; e < 8; ++e) { float x = v[e] * rs; if (MODE == 1) x = sigmoidf_(x); if (MODE == 2) { x = fmaxf(x, 0.f); x = x * x; } v[e] = x; }
                    *(u32x4*)(O + (size_t)row * ldo + colt + bj * HALF) = pack8(v); } }
    }
};
struct EpiRetGate {
    static constexpr bool PERM = true, AFTER_DRAIN = false, TWICE_OK = false; static __device__ __forceinline__ bool twice(const Unit&) { return false; }
    bf16_t* RO; const float* rstdx; const float* ssq_ro; const float* ret_norm;
    __device__ __forceinline__ void operator()(const f32x4 (&acc)[2][2][4][2], const Unit& u, int wr, int wc, int fr, int fq) const {
        const int rowt = u.pm * BM + wr * 64 + fr, colt = u.pn * BM + wc * 32 + 8 * fq, head = u.pn >> 1;
        f32x4 g[2][2];
#pragma unroll
        for (int bj = 0; bj < 2; ++bj) { g[bj][0] = *(const f32x4*)(ret_norm + colt + bj * HALF); g[bj][1] = *(const f32x4*)(ret_norm + colt + bj * HALF + 4); }
#pragma unroll
        for (int ai = 0; ai < 2; ++ai)
#pragma unroll
            for (int m = 0; m < 4; ++m) { const int row = rowt + ai * HALF + m * 16; const float rs = rstdx[row]; const f32x4* sp = (const f32x4*)(ssq_ro + ((size_t)row * 4 + head) * 16); const f32x4 s4 = (sp[0] + sp[1]) + (sp[2] + sp[3]);
                const float rr = __builtin_amdgcn_rsqf(((s4[0] + s4[1]) + (s4[2] + s4[3])) * (1.0f / 512.0f) + RMS_EPS_);
#pragma unroll
                for (int bj = 0; bj < 2; ++bj) { EPI_ACC8(v, ai, bj, m); bf16_t* p = RO + (size_t)row * 2048 + colt + bj * HALF; float o[8]; unpack8(*(const u32x4*)p, o);
#pragma unroll
                    for (int e = 0; e < 8; ++e) { const float x = v[e] * rs; const float gg = e < 4 ? g[bj][0][e & 3] : g[bj][1][e & 3]; v[e] = o[e] * rr * gg * x * sigmoidf_(x); }
                    *(u32x4*)p = pack8(v); } }
    }
};
template <int MODE> struct EpiGateMix {
    static constexpr bool PERM = true, AFTER_DRAIN = false, TWICE_OK = false; static __device__ __forceinline__ bool twice(const Unit&) { return false; }
    bf16_t* TM; const bf16_t* SG; int sgoff;
    __device__ __forceinline__ void operator()(const f32x4 (&acc)[2][2][4][2], const Unit& u, int wr, int wc, int fr, int fq) const {
        const int rowt = u.pm * BM + wr * 64 + fr, colt = u.pn * BM + wc * 32 + 8 * fq;
#pragma unroll
        for (int ai = 0; ai < 2; ++ai)
#pragma unroll
            for (int m = 0; m < 4; ++m) { const int row = rowt + ai * HALF + m * 16;
#pragma unroll
                for (int bj = 0; bj < 2; ++bj) { EPI_ACC8(v, ai, bj, m); float s[8]; unpack8(*(const u32x4*)(SG + (size_t)row * 2048 + sgoff + colt + bj * HALF), s);
                    bf16_t* p = TM + (size_t)row * 1024 + colt + bj * HALF;
                    if (MODE == 1) { float t[8]; unpack8(*(const u32x4*)p, t);
#pragma unroll
                        for (int e = 0; e < 8; ++e) v[e] = t[e] + s[e] * v[e]; }
                    else {
#pragma unroll
                        for (int e = 0; e < 8; ++e) v[e] = s[e] * v[e]; }
                    *(u32x4*)p = pack8(v); } }
    }
};
template <bool RESB> struct EpiResid {
    static constexpr bool PERM = true, AFTER_DRAIN = false, TWICE_OK = false; static __device__ __forceinline__ bool twice(const Unit&) { return false; }
    const void* res; bf16_t* xb; float* ssq;
    __device__ __forceinline__ void operator()(const f32x4 (&acc)[2][2][4][2], const Unit& u, int wr, int wc, int fr, int fq) const {
        const int rowt = u.pm * BM + wr * 64 + fr, colt = u.pn * BM + wc * 32 + 8 * fq;
#pragma unroll
        for (int ai = 0; ai < 2; ++ai)
#pragma unroll
            for (int m = 0; m < 4; ++m) { const int row = rowt + ai * HALF + m * 16; float q = 0.f;
#pragma unroll
                for (int bj = 0; bj < 2; ++bj) { EPI_ACC8(v, ai, bj, m); const size_t off = (size_t)row * 1024 + colt + bj * HALF;
                    if (RESB) { float r[8]; unpack8(*(const u32x4*)((const bf16_t*)res + off), r);
#pragma unroll
                        for (int e = 0; e < 8; ++e) { v[e] += r[e]; q += v[e] * v[e]; } }
                    else { const f32x4 r0 = *(const f32x4*)((const float*)res + off), r1 = *(const f32x4*)((const float*)res + off + 4);
#pragma unroll
                        for (int e = 0; e < 8; ++e) { v[e] += e < 4 ? r0[e & 3] : r1[e & 3]; q += v[e] * v[e]; } }
                    *(u32x4*)(xb + off) = pack8(v); }
                q += __shfl_xor(q, 16); q += __shfl_xor(q, 32); if (fq == 0) atomicAdd(ssq + row, q);
                if (m & 1) asm volatile("" ::: "memory"); }
    }
};
struct EpiFinal {
    static constexpr bool PERM = true, AFTER_DRAIN = false, TWICE_OK = false; static __device__ __forceinline__ bool twice(const Unit&) { return false; }
    float* out; const bf16_t* GT; const bf16_t* xb;
    __device__ __forceinline__ void operator()(const f32x4 (&acc)[2][2][4][2], const Unit& u, int wr, int wc, int fr, int fq) const {
        const int rowt = u.pm * BM + wr * 64 + fr, colt = u.pn * BM + wc * 32 + 8 * fq;
#pragma unroll
        for (int ai = 0; ai < 2; ++ai)
#pragma unroll
            for (int m = 0; m < 4; ++m) { const int row = rowt + ai * HALF + m * 16;
#pragma unroll
                for (int bj = 0; bj < 2; ++bj) { EPI_ACC8(v, ai, bj, m); const size_t off = (size_t)row * 1024 + colt + bj * HALF; float gt[8], r[8]; unpack8(*(const u32x4*)(GT + off), gt); unpack8(*(const u32x4*)(xb + off), r);
#pragma unroll
                    for (int e = 0; e < 8; ++e) v[e] = r[e] + gt[e] * v[e];
                    *(f32x4*)(out + off) = (f32x4){v[0], v[1], v[2], v[3]}; *(f32x4*)(out + off + 4) = (f32x4){v[4], v[5], v[6], v[7]}; }
                if (m & 1) asm volatile("" ::: "memory"); }
    }
};
template <class Epi, class Sched, bool ALIGN_EPI = false, bool SP2 = false>
__device__ __forceinline__ void gemm_phase(PG8_LAS unsigned char* lds, const Gemm g, const Sched& S, const Epi& E) {
    int tid = threadIdx.x; asm volatile("" : "+v"(tid));
    const int wid = __builtin_amdgcn_readfirstlane(tid >> 6), lane = tid & 63, wr = wid >> 2, wc = wid & 3, fr = lane & 15, fq = lane >> 4;
    int K = g.K; if (g.K < 512) asm volatile("" : "+s"(K));
    const int nt = K / BK;
    unsigned voffA[2], voffB[2];
#pragma unroll
    for (int i = 0; i < 2; ++i) { int R, C; stage_rc(tid * 16 + i * 8192, R, C); const int Rb = Epi::PERM ? ((R & ~31) + perm32(R & 31)) : R;
        voffA[i] = (unsigned)(R * g.lda + C) * 2u; voffB[i] = (unsigned)(Rb * g.ldb + C) * 2u; }
    const size_t kstep = (size_t)(BK * 2);
    const size_t hstepA = (size_t)HALF * g.lda * 2, hstepB = (size_t)HALF * g.ldb * 2;
    const size_t tstepA = 2 * hstepA, tstepB = 2 * hstepB;
    const unsigned ldsw = (unsigned)wid * 1024u;
    const int aoff = lds_byte(wr * 64 + fr, fq * 8), boff = lds_byte(wc * 32 + fr, fq * 8);
#define PG8_SA(b, h) (((b) * 2 + (h)) * HTB)
#define PG8_SB(b, h) ((4 + (b) * 2 + (h)) * HTB)
#define PG8_STAGE(bufoff, gbase, voff) do { _Pragma("unroll") for (int _i = 0; _i < 2; ++_i) \
        __builtin_amdgcn_global_load_lds((const unsigned*)((const char*)(gbase) + (voff)[_i]), (PG8_LAS unsigned*)(lds + (bufoff) + ldsw + _i * 8192), 16, 0, 0); } while (0)
#define PG8_LDA(dst, b, h) do { _Pragma("unroll") for (int m = 0; m < 4; ++m) _Pragma("unroll") for (int k = 0; k < 2; ++k) dst[m][k] = *(const PG8_LAS bf16x8*)(lds + PG8_SA(b, h) + aoff + m * 2048 + k * 1024); } while (0)
#define PG8_LDB(dst, b, h) do { _Pragma("unroll") for (int n = 0; n < 2; ++n) _Pragma("unroll") for (int k = 0; k < 2; ++k) dst[n][k] = *(const PG8_LAS bf16x8*)(lds + PG8_SB(b, h) + boff + n * 2048 + k * 1024); } while (0)
#define PG8_MMA(ai, bj, At, Bt) do { __builtin_amdgcn_s_setprio(1); _Pragma("unroll") for (int m = 0; m < 4; ++m) _Pragma("unroll") for (int n = 0; n < 2; ++n) _Pragma("unroll") for (int k = 0; k < 2; ++k) \
        acc[ai][bj][m][n] = __builtin_amdgcn_mfma_f32_16x16x32_bf16(Bt[n][k], At[m][k], acc[ai][bj][m][n], 0, 0, 0); __builtin_amdgcn_s_setprio(0); } while (0)
#define PG8_WAIT_V(n) asm volatile("s_waitcnt vmcnt(" #n ")" ::: "memory")
#define PG8_WAIT_L(n) asm volatile("s_waitcnt lgkmcnt(" #n ")" ::: "memory")
#define PG8_BAR __builtin_amdgcn_s_barrier()
#define PG8_SCHED __builtin_amdgcn_sched_barrier(0)
    Unit cur, nxt; int ui = 0;
    if (!S.next(0, cur)) return;
    f32x4 acc[2][2][4][2];
#pragma unroll
    for (int a = 0; a < 2; ++a)
#pragma unroll
        for (int b = 0; b < 2; ++b)
#pragma unroll
            for (int m = 0; m < 4; ++m)
#pragma unroll
                for (int n = 0; n < 2; ++n) acc[a][b][m][n] = (f32x4){0.f, 0.f, 0.f, 0.f};
    bf16x8 At[4][2], B0[2][2], B1[2][2];
    const char* cA = (const char*)g.A + (size_t)cur.pm * tstepA; const char* cB = (const char*)g.Bt + (size_t)cur.pn * tstepB;
    S.a_ready(cur);
    if constexpr (SP2) {
        PG8_STAGE(PG8_SB(0, 0), cB, voffB); PG8_STAGE(PG8_SB(0, 1), cB + hstepB, voffB); PG8_STAGE(PG8_SA(0, 0), cA, voffA); PG8_STAGE(PG8_SA(0, 1), cA + hstepA, voffA);
        if (wr == 1) PG8_BAR;
        PG8_WAIT_V(2); PG8_BAR;
        PG8_STAGE(PG8_SB(1, 0), cB + kstep, voffB); PG8_STAGE(PG8_SA(1, 0), cA + kstep, voffA); PG8_STAGE(PG8_SB(1, 1), cB + hstepB + kstep, voffB);
        PG8_WAIT_V(6); PG8_BAR;
    } else {
        PG8_STAGE(PG8_SB(0, 0), cB, voffB); PG8_STAGE(PG8_SA(0, 0), cA, voffA); PG8_STAGE(PG8_SB(0, 1), cB + hstepB, voffB); PG8_STAGE(PG8_SA(0, 1), cA + hstepA, voffA);
        if (wr == 1) PG8_BAR;
        PG8_WAIT_V(4); PG8_BAR;
        PG8_STAGE(PG8_SB(1, 0), cB + kstep, voffB); PG8_STAGE(PG8_SA(1, 0), cA + kstep, voffA); PG8_STAGE(PG8_SB(1, 1), cB + hstepB + kstep, voffB);
        PG8_WAIT_V(6); PG8_BAR;
    }
    for (;;) {
        const bool has_next = S.next(ui + 1, nxt);
        const char* nA = has_next ? (const char*)g.A + (size_t)nxt.pm * tstepA : cA; const char* nB = has_next ? (const char*)g.Bt + (size_t)nxt.pn * tstepB : cB;
        for (int t = 0; t < nt; t += 2) {
            const bool last = (t == nt - 2);
            const char* a1 = cA + (size_t)(t + 1) * kstep;
            const char* a2 = last ? nA : cA + (size_t)(t + 2) * kstep; const char* b2 = last ? nB : cB + (size_t)(t + 2) * kstep;
            const char* a3 = a2 + kstep; const char* b3 = b2 + kstep;
            if (last && has_next) S.a_ready(nxt);
            if constexpr (SP2) {
            PG8_LDB(B0, 0, 0); PG8_LDB(B1, 0, 1); PG8_SCHED; PG8_LDA(At, 0, 0); PG8_STAGE(PG8_SA(1, 1), a1 + hstepA, voffA);
            PG8_WAIT_V(8); PG8_WAIT_L(0); PG8_BAR; PG8_MMA(0, 0, At, B0); PG8_MMA(0, 1, At, B1); PG8_BAR; PG8_SCHED;
            PG8_LDA(At, 0, 1); PG8_STAGE(PG8_SB(0, 0), b2, voffB); PG8_STAGE(PG8_SB(0, 1), b2 + hstepB, voffB); PG8_STAGE(PG8_SA(0, 0), a2, voffA);
            PG8_WAIT_V(8); PG8_WAIT_L(0); PG8_BAR; PG8_MMA(1, 0, At, B0); PG8_MMA(1, 1, At, B1); PG8_BAR; PG8_SCHED;
            PG8_LDB(B0, 1, 0); PG8_LDB(B1, 1, 1); PG8_SCHED; PG8_LDA(At, 1, 0); PG8_STAGE(PG8_SA(0, 1), a2 + hstepA, voffA);
            PG8_WAIT_V(8); PG8_WAIT_L(0); PG8_BAR; PG8_MMA(0, 0, At, B0); PG8_MMA(0, 1, At, B1); PG8_BAR; PG8_SCHED;
            PG8_LDA(At, 1, 1); PG8_STAGE(PG8_SB(1, 0), b3, voffB); PG8_STAGE(PG8_SB(1, 1), b3 + hstepB, voffB); PG8_STAGE(PG8_SA(1, 0), a3, voffA);
            PG8_WAIT_V(8); PG8_WAIT_L(0); PG8_BAR; PG8_MMA(1, 0, At, B0); PG8_MMA(1, 1, At, B1); PG8_BAR; PG8_SCHED;
            } else {
            PG8_LDB(B0, 0, 0); PG8_SCHED; PG8_LDA(At, 0, 0); PG8_STAGE(PG8_SA(1, 1), a1 + hstepA, voffA);
            PG8_WAIT_L(8); PG8_BAR; PG8_WAIT_L(0); PG8_MMA(0, 0, At, B0); PG8_BAR; PG8_SCHED;
            PG8_LDB(B1, 0, 1); PG8_STAGE(PG8_SB(0, 0), b2, voffB);
            PG8_BAR; PG8_WAIT_L(0); PG8_MMA(0, 1, At, B1); PG8_BAR;
            PG8_LDA(At, 0, 1); PG8_STAGE(PG8_SA(0, 0), a2, voffA);
            PG8_BAR; PG8_WAIT_L(0); PG8_MMA(1, 0, At, B0); PG8_BAR; PG8_SCHED;
            PG8_STAGE(PG8_SB(0, 1), b2 + hstepB, voffB);
            PG8_WAIT_V(6); PG8_BAR; PG8_MMA(1, 1, At, B1); PG8_BAR;
            PG8_LDB(B0, 1, 0); PG8_SCHED; PG8_LDA(At, 1, 0); PG8_STAGE(PG8_SA(0, 1), a2 + hstepA, voffA);
            PG8_WAIT_L(8); PG8_BAR; PG8_WAIT_L(0); PG8_MMA(0, 0, At, B0); PG8_BAR; PG8_SCHED;
            PG8_LDB(B1, 1, 1); PG8_STAGE(PG8_SB(1, 0), b3, voffB);
            PG8_BAR; PG8_WAIT_L(0); PG8_MMA(0, 1, At, B1); PG8_BAR;
            PG8_LDA(At, 1, 1); PG8_STAGE(PG8_SA(1, 0), a3, voffA);
            PG8_BAR; PG8_WAIT_L(0); PG8_MMA(1, 0, At, B0); PG8_BAR; PG8_SCHED;
            PG8_STAGE(PG8_SB(1, 1), b3 + hstepB, voffB);
            PG8_WAIT_V(6); PG8_BAR; PG8_MMA(1, 1, At, B1); PG8_BAR;
            }
        }
        if constexpr (ALIGN_EPI) { if (wr == 0) PG8_BAR; }
        if constexpr (!Epi::AFTER_DRAIN) { E(acc, cur, wr, wc, fr, fq);
#ifdef EPI_TWICE
            if constexpr (Epi::TWICE_OK) { asm volatile("" ::: "memory"); if (Epi::twice(cur)) E(acc, cur, wr, wc, fr, fq); }
#endif
            S.done(cur); }
        if (!has_next) break;
#pragma unroll
        for (int a = 0; a < 2; ++a)
#pragma unroll
            for (int b = 0; b < 2; ++b)
#pragma unroll
                for (int m = 0; m < 4; ++m)
#pragma unroll
                    for (int n = 0; n < 2; ++n) acc[a][b][m][n] = (f32x4){0.f, 0.f, 0.f, 0.f};
        cur = nxt; cA = nA; cB = nB; ++ui;
        if constexpr (ALIGN_EPI) { if (wr == 1) PG8_BAR; }
    }
    PG8_WAIT_V(0);
    if constexpr (!ALIGN_EPI) { if (wr == 0) PG8_BAR; }
    PG8_BAR;
    if constexpr (Epi::AFTER_DRAIN) { E.fused(acc, cur, wr, wc, fr, fq, lds, wid, lane); S.done(cur); }
#undef PG8_SA
#undef PG8_SB
#undef PG8_STAGE
#undef PG8_LDA
#undef PG8_LDB
#undef PG8_MMA
#undef PG8_WAIT_V
#undef PG8_WAIT_L
#undef PG8_BAR
#undef PG8_SCHED
}
}
#define GAS __attribute__((address_space(1)))
#define LAS __attribute__((address_space(3)))
typedef unsigned short bf16;
typedef unsigned v4u __attribute__((ext_vector_type(4)));
typedef float f32x4 __attribute__((ext_vector_type(4)));
typedef short bf16x8 __attribute__((ext_vector_type(8)));
typedef GAS unsigned gu32;
typedef GAS unsigned long long gu64;
#define RLX_AGENT __ATOMIC_RELAXED, __HIP_MEMORY_SCOPE_AGENT
#define LDS_WAIT() asm volatile("s_waitcnt lgkmcnt(0)" ::: "memory")
#define VM_WAIT() asm volatile("s_waitcnt vmcnt(0)" ::: "memory")
__device__ __forceinline__ unsigned long long rt() { return __builtin_amdgcn_s_memrealtime(); }
__device__ __forceinline__ unsigned f2bf(float f) { unsigned u = __builtin_bit_cast(unsigned, f); return (u + 0x7fffu + ((u >> 16) & 1u)) >> 16; }
__device__ __forceinline__ unsigned pk2(float lo, float hi) { return f2bf(lo) | (f2bf(hi) << 16); }

#define XB_TMO      128
#define XB_XCNT(j)  (256  + 64 * (j))
#define XB_XSUB(j)  (1280 + 64 * (j))
#define XB_XGEN(j)  (2304 + 64 * (j))
#define XB_TOP      3328
#define XB_TOPGEN   3392
#define XCD_BAR_WORDS 3456
#define XB_SPIN_CAP (1u << 18)

__device__ __forceinline__ unsigned xb_ld(unsigned* p)              { return __hip_atomic_load(p, __ATOMIC_RELAXED, __HIP_MEMORY_SCOPE_AGENT); }
__device__ __forceinline__ unsigned xb_add(unsigned* p, unsigned v) { return __hip_atomic_fetch_add(p, v, __ATOMIC_RELAXED, __HIP_MEMORY_SCOPE_AGENT); }
__device__ __forceinline__ unsigned xb_xcc_id() { return (unsigned)__builtin_amdgcn_s_getreg((3 << 11) | 20) & 0xFu; }
#define XB_SPIN(cond, bar) do { unsigned _sp = 0; while (cond) { __builtin_amdgcn_s_sleep(1); \
    if ((++_sp & 255u) == 0u) { if (xb_ld(&(bar)[XB_TMO])) break; if (_sp > XB_SPIN_CAP) { atomicAdd(&(bar)[XB_TMO], 1u); break; } } } } while (0)

struct XcdBarrier {
    unsigned* bar; unsigned x;
    volatile LAS unsigned* st;
};

__device__ __forceinline__ XcdBarrier xcd_barrier_post(unsigned* bar, volatile LAS unsigned* st) {
    XcdBarrier b; b.bar = bar; b.x = xb_xcc_id(); b.st = st;
    if (threadIdx.x == 0) (void)xb_add(&bar[XB_XCNT(b.x)], 1u);
    return b;
}
__device__ __forceinline__ void xcd_barrier_complete(unsigned* bar, unsigned x, unsigned& nloc, unsigned& nx) {
    const unsigned G = gridDim.x * gridDim.y * gridDim.z;
    unsigned sum, cnt, mine, sp = 0u;
    for (;;) {
        sum = 0u; cnt = 0u; mine = 0u;
#pragma unroll
        for (unsigned j = 0; j < 16; ++j) { const unsigned c = xb_ld(&bar[XB_XCNT(j)]); sum += c; cnt += (c > 0u) ? 1u : 0u; mine = (j == x) ? c : mine; }
        if (sum == G) break;
        __builtin_amdgcn_s_sleep(1);
        if ((++sp & 255u) == 0u) { if (xb_ld(&bar[XB_TMO])) break; if (sp > XB_SPIN_CAP) { atomicAdd(&bar[XB_TMO], 1u); break; } }
    }
    nloc = mine > 0u ? mine : 1u; nx = cnt > 0u ? cnt : 1u;
}

__device__ __forceinline__ void xcd_barrier(const XcdBarrier& b) {
    asm volatile("s_waitcnt vmcnt(0)" ::: "memory");
    __syncthreads();
    if (threadIdx.x == 0) {
        unsigned* bar = b.bar;
        __builtin_amdgcn_s_waitcnt(0);
        unsigned nloc = b.st[0], nx = b.st[1];
        if (nloc == 0u) { xcd_barrier_complete(bar, b.x, nloc, nx); b.st[0] = nloc; b.st[1] = nx; }
        const unsigned old = xb_add(&bar[XB_XSUB(b.x)], 1u);
        const unsigned gen = old / nloc;
        if (old + 1u == (gen + 1u) * nloc) {
            __builtin_amdgcn_fence(__ATOMIC_RELEASE, "agent");
            asm volatile("s_waitcnt vmcnt(0)" ::: "memory");
            const unsigned og = xb_add(&bar[XB_TOP], 1u);
            const unsigned tg = og / nx;
            if (og + 1u == (tg + 1u) * nx) xb_add(&bar[XB_TOPGEN], 1u);
            else XB_SPIN(xb_ld(&bar[XB_TOPGEN]) == tg, bar);
            __builtin_amdgcn_fence(__ATOMIC_ACQUIRE, "agent");
            xb_add(&bar[XB_XGEN(b.x)], 1u);
            asm volatile("s_waitcnt vmcnt(0)" ::: "memory");
        } else {
            XB_SPIN(xb_ld(&bar[XB_XGEN(b.x)]) == gen, bar);
            __builtin_amdgcn_fence(__ATOMIC_ACQUIRE, "agent");
            asm volatile("s_waitcnt vmcnt(0)" ::: "memory");
        }
    }
    __syncthreads();
}


typedef float f32x2 __attribute__((ext_vector_type(2)));
constexpr int NWAVES = 8;
constexpr int BATCH = 4, SEQ = 4096, DM = 1024, MTOK = BATCH * SEQ;
constexpr int NIN1 = 5120;
constexpr int LATW = 640;
constexpr float C2Q = 0.07216878364870323f * 1.4426950408889634f;

constexpr size_t MiB = 1u << 20, KiB = 1u << 10;
constexpr size_t WS_CTL = 0, CTL_ZERO_BYTES = 64 * KiB;
constexpr size_t WS_SMALL = 1 * MiB;
constexpr size_t SM_RSTDX = 0, SM_SSQ_CQ = 64 * KiB, SM_SSQ_CKV = 128 * KiB, SM_SSQ1 = 192 * KiB, SM_SSQ2 = 256 * KiB, SM_SSQ_KR = 320 * KiB, SM_END = 384 * KiB;
constexpr size_t WS_WIN = 2 * MiB;
constexpr size_t WS_SSQP = 10 * MiB;
constexpr size_t WS_WUQ = 20 * MiB;
constexpr size_t WS_WUKV = WS_WUQ + (size_t)1536 * 384 * 2;
constexpr size_t WS_KR = 22 * MiB + 256 * KiB;
constexpr size_t WS_XB = 25 * MiB;
constexpr size_t WS_CS = 57 * MiB;
constexpr size_t WS_LAT = 73 * MiB;
constexpr size_t WS_RQ = 94 * MiB, WS_RK = 126 * MiB, WS_RKDT = 158 * MiB, WS_RVT = 190 * MiB;
constexpr size_t WS_QP = 94 * MiB, WS_KF = 142 * MiB, WS_VV = 190 * MiB;
constexpr size_t WS_MO = 57 * MiB;
constexpr size_t WS_SG = 94 * MiB, WS_TM = 158 * MiB;
constexpr size_t WS_WBR = 190 * MiB, WS_WBM = 194 * MiB, WS_WO = 196 * MiB, WS_WUP = 198 * MiB, WS_WDOWN = 206 * MiB, WS_WPG = 214 * MiB, WS_WPLE = 216 * MiB;
constexpr size_t WS_PB = 217 * MiB;
constexpr size_t WS_H = 57 * MiB;
constexpr size_t WS_GT = 57 * MiB;
constexpr size_t WS_END = 256 * MiB;
static_assert(SM_SSQ_CKV == SM_SSQ_CQ + 65536, "ssq_lat layout");
static_assert(WS_WIN + (size_t)9216 * 2048 <= WS_WUQ && WS_WUKV + (size_t)2048 * 256 * 2 <= WS_KR && WS_KR + 2 * MiB <= WS_XB && WS_LAT + 20 * MiB <= WS_RQ && WS_RVT + 64 * MiB <= WS_END && WS_H + 128 * MiB <= WS_WBR && WS_PB + 8 * MiB <= WS_END, "d_ws map");
constexpr int CW_BAR = 1024;

constexpr int RING_OFF = 0, RING_BYTES = 131072;
constexpr int XS_OFF = RING_BYTES, XS_BYTES = 8 * 2304;
constexpr int MISC_OFF = XS_OFF + XS_BYTES;
constexpr int LDS_BYTES = 160 * 1024;
static_assert(MISC_OFF + 128 <= LDS_BYTES, "LDS map");

struct Frame {
    LAS unsigned char* lds; volatile LAS unsigned* MISC; int tid, lane, wave, G, vcu;
    float* out; unsigned char* ws;
};
__device__ __forceinline__ float wave_sum(float v) {
#pragma unroll
    for (int o = 1; o < 64; o <<= 1) v += __shfl_xor(v, o);
    return v;
}
__device__ __forceinline__ void p0_transpose_item(const float* W, int ldw, int K, int src_col, bf16* WT, int dst_row, int ncols, const float* gain, LAS float* scr, int item, int lane) {
    const int nblk = ncols / 32, kb = item / nblk, nb = item % nblk, k0 = 64 * kb, n0 = 32 * nb;
#pragma unroll 16
    for (int i = 0; i < 32; ++i) { const int kk = 2 * i + (lane >> 5); const float gk = gain ? gain[k0 + kk] : 1.0f; scr[kk * 33 + (lane & 31)] = W[(size_t)(k0 + kk) * ldw + src_col + n0 + (lane & 31)] * gk; }
    LDS_WAIT(); asm volatile("" ::: "memory");
    const int c = lane & 7;
#pragma unroll
    for (int j = 0; j < 4; ++j) { const int n = (lane >> 3) + 8 * j; const LAS float* s = scr + (8 * c) * 33 + n;
        v4u o; o.x = pk2(s[0 * 33], s[1 * 33]); o.y = pk2(s[2 * 33], s[3 * 33]); o.z = pk2(s[4 * 33], s[5 * 33]); o.w = pk2(s[6 * 33], s[7 * 33]);
        *(GAS v4u*)(WT + (size_t)(dst_row + n0 + n) * K + k0 + 8 * c) = o; }
    LDS_WAIT(); asm volatile("" ::: "memory");
}
#define P0_SEG(W, ldw, K, src, WT, dst, ncols, gain) { const int n_ = ((K) / 64) * ((ncols) / 32); if (r < n_) { p0_transpose_item(W, ldw, K, src, WT, dst, ncols, gain, scr, r, F.lane); continue; } r -= n_; }
__device__ __forceinline__ void phase_p0(Frame& F, const float* x, const int* pos, const float* g_mix, const float* w_in, const float* g_qlat, const float* g_kvlat, const float* w_uq, const float* w_ukv) {
    LAS float* scr = (LAS float*)(F.lds + RING_OFF + F.wave * 16384);
    const int gw = F.vcu * NWAVES + F.wave, NGW = F.G * NWAVES;
    bf16* WinT = (bf16*)(F.ws + WS_WIN); bf16* WuqT = (bf16*)(F.ws + WS_WUQ); bf16* WukvT = (bf16*)(F.ws + WS_WUKV);
    constexpr int NIT = 16 * 64 * 2 + 16 * 128 + 16 * 20 + 16 * 2 + 6 * 48 + 4 * 64;
    for (int it = gw; it < NIT; it += NGW) {
        int r = it;
        P0_SEG(w_in, 8896, 1024, 6848, WinT, 0, 2048, g_mix)
        P0_SEG(w_in, 8896, 1024, 4096, WinT, 2048, 2048, g_mix)
        P0_SEG(w_in, 8896, 1024, 0, WinT, 4096, 4096, g_mix)
        P0_SEG(w_in, 8896, 1024, 6144, WinT, 8192, 640, g_mix)
        P0_SEG(w_in, 8896, 1024, 6784, WinT, 8960, 32, g_mix)
        P0_SEG(w_in, 8896, 1024, 6816, WinT, 8960 + 128, 32, g_mix)
        P0_SEG(w_uq, 1536, 384, 0, WuqT, 0, 1536, g_qlat)
        P0_SEG(w_ukv, 2048, 256, 0, WukvT, 0, 2048, g_kvlat)
    }
    for (int gt = F.vcu * 512 + F.tid; gt < 40960; gt += F.G * 512) { const int row = gt >> 7, piece = gt & 127; const int wrow = row < 128 ? 8832 + row : (row < 224 ? 8992 + (row - 128) : 9120 + (row - 224));
        *(GAS v4u*)((unsigned char*)(WinT + (size_t)wrow * 1024) + (size_t)piece * 16) = (v4u){0u, 0u, 0u, 0u}; }
    { bf16* XB = (bf16*)(F.ws + WS_XB); float* rstdx = (float*)(F.ws + WS_SMALL + SM_RSTDX);
      for (int m0 = 2 * gw; m0 < MTOK; m0 += 2 * NGW) {
          f32x4 v[2][4]; float s[2] = {0.f, 0.f};
#pragma unroll
          for (int u = 0; u < 2; ++u) { const GAS f32x4* xr = (const GAS f32x4*)(x + (size_t)(m0 + u) * DM) + F.lane;
#pragma unroll
              for (int j = 0; j < 4; ++j) v[u][j] = xr[64 * j]; }
#pragma unroll
          for (int u = 0; u < 2; ++u) {
#pragma unroll
              for (int j = 0; j < 4; ++j) s[u] += (v[u][j].x * v[u][j].x + v[u][j].y * v[u][j].y) + (v[u][j].z * v[u][j].z + v[u][j].w * v[u][j].w);
              s[u] = wave_sum(s[u]);
              GAS unsigned long long* o8 = (GAS unsigned long long*)(XB + (size_t)(m0 + u) * DM) + F.lane;
#pragma unroll
              for (int j = 0; j < 4; ++j) o8[64 * j] = (unsigned long long)pk2(v[u][j].x, v[u][j].y) | ((unsigned long long)pk2(v[u][j].z, v[u][j].w) << 32);
              if (F.lane == 0) rstdx[m0 + u] = 1.0f / sqrtf(s[u] * (1.0f / DM) + 1e-6f); }
      } }
    { f32x2* cs = (f32x2*)(F.ws + WS_CS);
      for (int e = F.vcu * 512 + F.tid; e < MTOK * 128; e += F.G * 512) { const int row = e >> 7, i = e & 127;
          const float inv = __builtin_amdgcn_exp2f(-(float)i * (13.287712379549449f / 128.0f));
          double rev = (double)pos[row] * (double)inv * 0.15915494309189535; rev -= __builtin_rint(rev);
          const float rf = (float)rev; cs[e] = (f32x2){__builtin_amdgcn_cosf(rf), __builtin_amdgcn_sinf(rf)}; } }
    { float* z = (float*)(F.ws + WS_SMALL + SM_SSQ_CQ); for (int e = F.vcu * 512 + F.tid; e < (int)((SM_END - SM_SSQ_CQ) / 4); e += F.G * 512) z[e] = 0.f; }
}
__device__ __forceinline__ void phase_late_weights(Frame& F, const float* p, const float* w_br, const float* w_bm, const float* w_o, const float* g_mlp, const float* w_up, const float* w_down, const float* g_ple, const float* w_pg, const float* w_ple) {
    LAS float* scr = (LAS float*)(F.lds + RING_OFF + F.wave * 16384);
    const int gw = F.vcu * NWAVES + F.wave, NGW = F.G * NWAVES;
    constexpr int NIT = 32 * 32 + 16 * 32 + 16 * 32 + 16 * 128 + 64 * 32 + 16 * 32 + 4 * 32;
    for (int it = gw; it < NIT; it += NGW) {
        int r = it;
        P0_SEG(w_br, 1024, 2048, 0, (bf16*)(F.ws + WS_WBR), 0, 1024, (const float*)nullptr)
        P0_SEG(w_bm, 1024, 1024, 0, (bf16*)(F.ws + WS_WBM), 0, 1024, (const float*)nullptr)
        P0_SEG(w_o, 1024, 1024, 0, (bf16*)(F.ws + WS_WO), 0, 1024, (const float*)nullptr)
        P0_SEG(w_up, 4096, 1024, 0, (bf16*)(F.ws + WS_WUP), 0, 4096, g_mlp)
        P0_SEG(w_down, 1024, 4096, 0, (bf16*)(F.ws + WS_WDOWN), 0, 1024, (const float*)nullptr)
        P0_SEG(w_pg, 1024, 1024, 0, (bf16*)(F.ws + WS_WPG), 0, 1024, g_ple)
        P0_SEG(w_ple, 1024, 256, 0, (bf16*)(F.ws + WS_WPLE), 0, 1024, (const float*)nullptr)
    }
    { bf16* PB = (bf16*)(F.ws + WS_PB);
      for (int e = F.vcu * 512 + F.tid; e < MTOK * 256 / 8; e += F.G * 512) { const f32x4 a = *(const GAS f32x4*)(p + (size_t)e * 8), b = *(const GAS f32x4*)(p + (size_t)e * 8 + 4);
          *(GAS v4u*)(PB + (size_t)e * 8) = (v4u){pk2(a.x, a.y), pk2(a.z, a.w), pk2(b.x, b.y), pk2(b.z, b.w)}; } }
}

typedef float f32x16 __attribute__((ext_vector_type(16)));
typedef unsigned u32x2 __attribute__((ext_vector_type(2)));
typedef short v4i16_t __attribute__((ext_vector_type(4)));
__device__ __forceinline__ int crow(int r, int hi) { return (r & 3) + 8 * (r >> 2) + 4 * hi; }
typedef __bf16 bf16x2m_t __attribute__((ext_vector_type(2)));
__device__ __forceinline__ unsigned cvtpk(float lo, float hi) { f32x2 v = {lo, hi}; bf16x2m_t b = __builtin_convertvector(v, bf16x2m_t); return __builtin_bit_cast(unsigned, b); }
__device__ __forceinline__ bf16x8 pack8f(const f32x16& p, int b) { v4u w = {cvtpk(p[b], p[b + 1]), cvtpk(p[b + 2], p[b + 3]), cvtpk(p[b + 4], p[b + 5]), cvtpk(p[b + 6], p[b + 7])}; return __builtin_bit_cast(bf16x8, w); }
__device__ __forceinline__ float bf2f(bf16 v) { return __uint_as_float((unsigned)v << 16); }
__device__ __forceinline__ float log2_gamma(int h) { return __builtin_amdgcn_logf(1.0f - __builtin_amdgcn_exp2f(-5.0f - (float)h)); }


__device__ __forceinline__ void phase_r0p(Frame& F) {
    const bf16* RQ = (const bf16*)(F.ws + WS_RQ); bf16* RK = (bf16*)(F.ws + WS_RK);
    const int lane = F.lane, w = F.wave, l31 = lane & 31, hi = lane >> 5, tq = w & 3, dh = w >> 2;
    for (int unit = F.vcu; unit < 512; unit += F.G) {
        const int bh = unit >> 5, c = unit & 31, h = bh & 3; const size_t blk = (size_t)bh * 32 + c;
        const float lg2 = log2_gamma(h);
        bf16x8 qf[16];
#pragma unroll
        for (int ks = 0; ks < 16; ++ks) qf[ks] = *(const bf16x8*)(RQ + ((blk * 32 + 2 * ks + hi) * 128 + 32 * tq + l31) * 8);
        f32x16 s[2] = {};
#pragma unroll
        for (int x = 0; x < 2; ++x) { const int tb = 2 * dh + x;
            if (tb <= tq) {
#pragma unroll
                for (int ks = 0; ks < 16; ++ks) { const bf16x8 kf = *(const bf16x8*)(RK + ((blk * 32 + 2 * ks + hi) * 128 + 32 * tb + l31) * 8); s[x] = __builtin_amdgcn_mfma_f32_32x32x16_bf16(kf, qf[ks], s[x], 0, 0, 0); }
#pragma unroll
                for (int r = 0; r < 16; ++r) { const int d = (32 * tq + l31) - (32 * tb + crow(r, hi)); s[x][r] = d >= 0 ? s[x][r] * __builtin_amdgcn_exp2f((float)d * lg2) : 0.f; }
            } }
        VM_WAIT(); __syncthreads();
#pragma unroll
        for (int x = 0; x < 2; ++x) { const int tb = 2 * dh + x;
            if (tb <= tq) {
#pragma unroll
                for (int g = 0; g < 4; ++g) *(u32x2*)(RK + ((blk * 32 + 4 * tb + g) * 128 + 32 * tq + l31) * 8 + 4 * hi) = (u32x2){cvtpk(s[x][4 * g], s[x][4 * g + 1]), cvtpk(s[x][4 * g + 2], s[x][4 * g + 3])};
            } }
    }
}
__device__ __forceinline__ void phase_r1p(Frame& F) {
    const bf16* RQ = (const bf16*)(F.ws + WS_RQ); const bf16* RP = (const bf16*)(F.ws + WS_RK); const bf16* RKDT = (const bf16*)(F.ws + WS_RKDT); const bf16* RVT = (const bf16*)(F.ws + WS_RVT); bf16* RO = (bf16*)F.out;
    float* ssqp = (float*)(F.ws + WS_SSQP);
    const int lane = F.lane, w = F.wave, l15 = lane & 15, lq = lane >> 4;
    constexpr int SROW = 528, SBUF = 32 * SROW;
    LAS unsigned char* ost = F.lds + 2 * SBUF + 1024 + w * 1024;
    const int nkp = (w >> 1) + 1;
    for (int unit = F.vcu; unit < 256; unit += F.G) {
        const int bh = unit >> 4, j = unit & 15, b = bh >> 2, h = bh & 3;
        const float lg2 = log2_gamma(h), gC = __builtin_amdgcn_exp2f(128.0f * lg2);
        float qd[4];
#pragma unroll
        for (int i = 0; i < 4; ++i) qd[i] = __builtin_amdgcn_exp2f((float)(16 * w + 4 * lq + i + 1) * lg2);
        f32x4 S[2][2];
#pragma unroll
        for (int mb = 0; mb < 2; ++mb)
#pragma unroll
            for (int nb = 0; nb < 2; ++nb) S[mb][nb] = (f32x4){0.f, 0.f, 0.f, 0.f};
        __syncthreads();
#pragma unroll
        for (int mb = 0; mb < 2; ++mb)
#pragma unroll
            for (int nb = 0; nb < 2; ++nb) *(LAS u32x2*)(F.lds + (16 * nb + l15) * SROW + (32 * w + 16 * mb + 4 * lq) * 2) = (u32x2){0u, 0u};
        const bf16* qp = RQ + (((size_t)bh * 32 * 32 + lq) * 128 + 16 * w + l15) * 8;
        const bf16* pp = RP + (((size_t)bh * 32 * 32 + lq) * 128 + 16 * w + l15) * 8;
        const bf16* kp = RKDT + (((size_t)bh * 32 * 16 + lq) * 256 + 32 * w + l15) * 8;
        const bf16* vp = RVT + (((size_t)bh * 32 * 16 + (F.tid >> 5)) * 512 + 32 * j + (F.tid & 31)) * 8;
        constexpr size_t QC = 32 * 128 * 8, QK = 4 * 128 * 8, KC = 16 * 256 * 8, KK = 4 * 256 * 8, VC = 16 * 512 * 8;
        bf16x8 QA[8], PA[4], KA[2][4], vpre;
        LAS unsigned char* vl = F.lds + 2 * SBUF + 1024 + 8 * 1024;
#pragma unroll
        for (int ks = 0; ks < 8; ++ks) QA[ks] = *(const bf16x8*)(qp + QK * ks);
#pragma unroll
        for (int ks = 0; ks < 4; ++ks) { PA[ks] = (bf16x8){0, 0, 0, 0, 0, 0, 0, 0}; if (ks < nkp) PA[ks] = *(const bf16x8*)(pp + QK * ks); }
#pragma unroll
        for (int mb = 0; mb < 2; ++mb)
#pragma unroll
            for (int ks = 0; ks < 4; ++ks) KA[mb][ks] = *(const bf16x8*)(kp + mb * 128 + KK * ks);
        vpre = *(const bf16x8*)vp;
        *(LAS bf16x8*)(vl + F.tid * 16) = vpre;
#pragma unroll 1
        for (int c = 0; c < 32; ++c) {
            const int cur = c & 1, cn = c < 31 ? c + 1 : 31; const size_t tok0 = (size_t)b * SEQ + c * 128;
            __syncthreads();
            vpre = *(const bf16x8*)(vp + VC * cn);
            bf16x8 VB[2][4];
#pragma unroll
            for (int nb = 0; nb < 2; ++nb)
#pragma unroll
                for (int ks = 0; ks < 4; ++ks) VB[nb][ks] = *(const LAS bf16x8*)(vl + cur * 8192 + ((4 * ks + lq) * 32 + 16 * nb + l15) * 16);
            f32x4 oc[2] = {(f32x4){0.f, 0.f, 0.f, 0.f}, (f32x4){0.f, 0.f, 0.f, 0.f}};
#pragma unroll
            for (int ks = 0; ks < 8; ++ks)
#pragma unroll
                for (int nb = 0; nb < 2; ++nb) { const bf16x8 bq = *(const LAS bf16x8*)(F.lds + cur * SBUF + (16 * nb + l15) * SROW + (32 * ks + 8 * lq) * 2);
                    oc[nb] = __builtin_amdgcn_mfma_f32_16x16x32_bf16(QA[ks], bq, oc[nb], 0, 0, 0); }
#pragma unroll
            for (int ks = 0; ks < 8; ++ks) QA[ks] = *(const bf16x8*)(qp + QC * cn + QK * ks);
#pragma unroll
            for (int nb = 0; nb < 2; ++nb)
#pragma unroll
                for (int i = 0; i < 4; ++i) oc[nb][i] *= qd[i];
#pragma unroll
            for (int ks = 0; ks < 4; ++ks)
                if (ks < nkp) {
#pragma unroll
                    for (int nb = 0; nb < 2; ++nb) oc[nb] = __builtin_amdgcn_mfma_f32_16x16x32_bf16(PA[ks], VB[nb][ks], oc[nb], 0, 0, 0); }
#pragma unroll
            for (int ks = 0; ks < 4; ++ks) if (ks < nkp) PA[ks] = *(const bf16x8*)(pp + QC * cn + QK * ks);
#pragma unroll
            for (int mb = 0; mb < 2; ++mb)
#pragma unroll
                for (int nb = 0; nb < 2; ++nb) { S[mb][nb] *= gC;
#pragma unroll
                    for (int ks = 0; ks < 4; ++ks) S[mb][nb] = __builtin_amdgcn_mfma_f32_16x16x32_bf16(KA[mb][ks], VB[nb][ks], S[mb][nb], 0, 0, 0); }
#pragma unroll
            for (int mb = 0; mb < 2; ++mb)
#pragma unroll
                for (int ks = 0; ks < 4; ++ks) KA[mb][ks] = *(const bf16x8*)(kp + mb * 128 + KC * cn + KK * ks);
#pragma unroll
            for (int i = 0; i < 4; ++i) { float q = 0.f;
#pragma unroll
                for (int nb = 0; nb < 2; ++nb) { const float v = oc[nb][i]; q += v * v; *(LAS unsigned short*)(ost + ((4 * lq + i) * 32 + 16 * nb + l15) * 2) = (unsigned short)f2bf(v); }
                q += __shfl_xor(q, 1); q += __shfl_xor(q, 2); q += __shfl_xor(q, 4); q += __shfl_xor(q, 8);
                if (l15 == 0) ssqp[((tok0 + 16 * w + 4 * lq + i) * 4 + h) * 16 + j] = q; }
            LDS_WAIT();
            { const v4u ov = *(const LAS v4u*)(ost + lane * 16); *(v4u*)(RO + (tok0 + 16 * w + (lane >> 2)) * 2048 + h * 512 + 32 * j + (lane & 3) * 8) = ov; }
            *(LAS bf16x8*)(vl + (cur ^ 1) * 8192 + F.tid * 16) = vpre;
#pragma unroll
            for (int mb = 0; mb < 2; ++mb)
#pragma unroll
                for (int nb = 0; nb < 2; ++nb) *(LAS u32x2*)(F.lds + (cur ^ 1) * SBUF + (16 * nb + l15) * SROW + (32 * w + 16 * mb + 4 * lq) * 2) = (u32x2){cvtpk(S[mb][nb][0], S[mb][nb][1]), cvtpk(S[mb][nb][2], S[mb][nb][3])};
        }
    }
    __syncthreads();
}

namespace attn2 {
typedef float f32x16 __attribute__((ext_vector_type(16)));
typedef short s16x4 __attribute__((ext_vector_type(4)));
constexpr int NW = 8, QBLK = 32, KVBLK = 64, QB = NW * QBLK;
constexpr int QS = 1536, KS = 1536, VS = 1024, OS = 1024;
constexpr int SHM_V = KVBLK * 128 * 2, SHM_K = KVBLK * 512;
constexpr int OFF_V = 0, OFF_K = 2 * SHM_V, OFF_WS = OFF_K + 2 * SHM_K, OFF_QR = OFF_WS + NW * 64 * 4, LDS_NEED = OFF_QR + NW * 4096;
constexpr float THR2 = 8.0f * 1.4426950408889634f;
#define A2_SBAR() __builtin_amdgcn_sched_barrier(0)
__device__ __forceinline__ int v_st(int k, int c) { const int kk = (k & ~0xC) | ((k & 4) << 1) | ((k & 8) >> 1); return ((kk >> 3) * 4 + (c >> 5)) * 512 + ((kk & 7) * 32 + (c & 31)) * 2; }
__device__ __forceinline__ int v_rd_base(int lane) { return ((lane & 3) << 3) | (((lane >> 2) & 3) << 6) | (((lane >> 4) & 1) << 5) | (((lane >> 5) & 1) << 8); }
constexpr int v_rd_off(int d0, int ks, int half) { return d0 * 512 + ks * 4096 + half * 2048; }
__device__ __forceinline__ int crow(int r, int hi) { return (r & 3) + 8 * (r >> 2) + 4 * hi; }
typedef __bf16 bf16x2a_t __attribute__((ext_vector_type(2)));
__device__ __forceinline__ unsigned cvtpk(float lo, float hi) { f32x2 v = {lo, hi}; bf16x2a_t b = __builtin_convertvector(v, bf16x2a_t); return __builtin_bit_cast(unsigned, b); }
__device__ __forceinline__ bf16x8 load8(const bf16* p) { return *reinterpret_cast<const bf16x8*>(p); }
__device__ __forceinline__ void mask_tile(f32x16& p0, f32x16& p1, int dq) {
    const float NEG = -__builtin_inff();
#pragma unroll
    for (int r = 0; r < 16; ++r) { const int c = (r & 3) + 8 * (r >> 2); if (dq - c < 0) p0[r] = NEG; if (dq - c - 32 < 0) p1[r] = NEG; }
}
__device__ __forceinline__ void partialSM(f32x16& p0, f32x16& p1, float& m_reg, float& mn, float& alpha) {
    float pmax = p0[0];
#pragma unroll
    for (int r = 1; r < 16; ++r) pmax = fmaxf(pmax, p0[r]);
#pragma unroll
    for (int r = 0; r < 16; ++r) pmax = fmaxf(pmax, p1[r]);
    { auto rr = __builtin_amdgcn_permlane32_swap(__float_as_uint(pmax), __float_as_uint(pmax), false, false); pmax = fmaxf(__uint_as_float(rr[0]), __uint_as_float(rr[1])); }
    if (__builtin_expect(__all((pmax - m_reg) <= THR2), 1)) { mn = m_reg; alpha = 1.f; }
    else { mn = fmaxf(m_reg, pmax); alpha = __builtin_amdgcn_exp2f(m_reg - mn); m_reg = mn; }
#pragma unroll
    for (int r = 0; r < 16; ++r) { p0[r] -= mn; p1[r] -= mn; }
#pragma unroll
    for (int r = 0; r < 16; ++r) p0[r] = __builtin_amdgcn_exp2f(p0[r]);
}
__device__ __forceinline__ void finishSM(f32x16& p0, f32x16& p1, float alpha, float& l_reg, bf16x8& pa0, bf16x8& pa1, bf16x8& pa2, bf16x8& pa3) {
#pragma unroll
    for (int r = 0; r < 16; ++r) p1[r] = __builtin_amdgcn_exp2f(p1[r]);
    float ps = 0;
#pragma unroll
    for (int r = 0; r < 16; ++r) ps += p0[r];
#pragma unroll
    for (int r = 0; r < 16; ++r) ps += p1[r];
    { auto rr = __builtin_amdgcn_permlane32_swap(__float_as_uint(ps), __float_as_uint(ps), false, false); ps = __uint_as_float(rr[0]) + __uint_as_float(rr[1]); }
    l_reg = l_reg * alpha + ps;
#define A2_PK4(P, B_, OUT) do { unsigned a0 = cvtpk(P[B_+0], P[B_+1]), a1 = cvtpk(P[B_+2], P[B_+3]); unsigned b0 = cvtpk(P[B_+4], P[B_+5]), b1 = cvtpk(P[B_+6], P[B_+7]); \
        auto r0 = __builtin_amdgcn_permlane32_swap(a0, b0, false, false); auto r1 = __builtin_amdgcn_permlane32_swap(a1, b1, false, false); \
        v4u w = {r0[0], r1[0], r0[1], r1[1]}; OUT = __builtin_bit_cast(bf16x8, w); } while (0)
    A2_PK4(p0, 0, pa0); A2_PK4(p0, 8, pa1); A2_PK4(p1, 0, pa2); A2_PK4(p1, 8, pa3);
#undef A2_PK4
}
template <int KB>
__device__ __forceinline__ void qkt(f32x16& p0, f32x16& p1, const char* K_lds, const char* qr_lds, int r32, int hi, const bf16x8* qr) {
    p0 = f32x16{}; p1 = f32x16{};
    const char* kbase = K_lds + KB * SHM_K + r32 * 512; const int x = r32 & 15;
#pragma unroll
    for (int d = 0; d < 12; ++d) { const char* a = kbase + ((((2 * d + hi) & 15) ^ x) << 4) + (d >= 8 ? 256 : 0);
        const bf16x8 b0 = *reinterpret_cast<const bf16x8*>(a), b1 = *reinterpret_cast<const bf16x8*>(a + 32 * 512);
        const bf16x8 q = d < 8 ? qr[d < 8 ? d : 0] : *reinterpret_cast<const bf16x8*>(qr_lds + (((d - 8) * 2 + hi) * 32 + r32) * 16);
        p0 = __builtin_amdgcn_mfma_f32_32x32x16_bf16(b0, q, p0, 0, 0, 0);
        p1 = __builtin_amdgcn_mfma_f32_32x32x16_bf16(b1, q, p1, 0, 0, 0); }
}
template <int VB>
__device__ __forceinline__ void pv_tile(f32x16* o, int vb0, bf16x8 pa0, bf16x8 pa1, bf16x8 pa2, bf16x8 pa3) {
#define A2_TRRD(dst, off) asm volatile("ds_read_b64_tr_b16 %0, %1 offset:%2" : "=&v"(dst) : "v"(vb0), "i"(off) : "memory")
#define A2_PV_D0(d0) do { s16x4 l0, l1, l2, l3, h0, h1, h2, h3; constexpr int b_ = VB * SHM_V + v_rd_off(d0, 0, 0); \
        A2_TRRD(l0, b_); A2_TRRD(h0, b_ + 2048); A2_TRRD(l1, b_ + 4096); A2_TRRD(h1, b_ + 6144); A2_TRRD(l2, b_ + 8192); A2_TRRD(h2, b_ + 10240); A2_TRRD(l3, b_ + 12288); A2_TRRD(h3, b_ + 14336); \
        asm volatile("s_waitcnt lgkmcnt(0)" ::: "memory"); A2_SBAR(); \
        o[d0] = __builtin_amdgcn_mfma_f32_32x32x16_bf16(pa0, (bf16x8){l0[0], l0[1], l0[2], l0[3], h0[0], h0[1], h0[2], h0[3]}, o[d0], 0, 0, 0); \
        o[d0] = __builtin_amdgcn_mfma_f32_32x32x16_bf16(pa1, (bf16x8){l1[0], l1[1], l1[2], l1[3], h1[0], h1[1], h1[2], h1[3]}, o[d0], 0, 0, 0); \
        o[d0] = __builtin_amdgcn_mfma_f32_32x32x16_bf16(pa2, (bf16x8){l2[0], l2[1], l2[2], l2[3], h2[0], h2[1], h2[2], h2[3]}, o[d0], 0, 0, 0); \
        o[d0] = __builtin_amdgcn_mfma_f32_32x32x16_bf16(pa3, (bf16x8){l3[0], l3[1], l3[2], l3[3], h3[0], h3[1], h3[2], h3[3]}, o[d0], 0, 0, 0); } while (0)
    A2_PV_D0(0); A2_PV_D0(1); A2_PV_D0(2); A2_PV_D0(3);
#undef A2_PV_D0
#undef A2_TRRD
}
struct BlockRef { const bf16* Q; const bf16* K; const bf16* V; bf16* O; int P0; };
struct Seam { bf16x8 qr[8]; bf16x8 st_v0, st_v1, st_k0, st_k1, st_k2; };
#define A2_VMW() asm volatile("s_waitcnt vmcnt(0)" ::: "memory")
#define A2_VMWN(n) asm volatile("s_waitcnt vmcnt(%0)" :: "i"(n) : "memory")
#define A2_SLOAD(Kp, Vp, k0) do { S.st_v0 = load8((Vp) + (size_t)((k0) + sr) * VS + sc); S.st_v1 = load8((Vp) + (size_t)((k0) + 32 + sr) * VS + sc); \
        const bf16* kp_ = (Kp) + (size_t)((k0) + krow) * KS + kc * 8; S.st_k0 = load8(kp_); S.st_k1 = load8(kp_ + 64); S.st_k2 = load8(kp_ + 128); } while (0)
#define A2_SWRITE_K(bf) do { *(bf16x8*)(K_lds + (bf) * SHM_K + kw0) = S.st_k0; *(bf16x8*)(K_lds + (bf) * SHM_K + kw1) = S.st_k1; *(bf16x8*)(K_lds + (bf) * SHM_K + kw0 + 256) = S.st_k2; } while (0)
#define A2_SWRITE_V(bf) do { *(bf16x8*)(V_lds + (bf) * SHM_V + vst0) = S.st_v0; *(bf16x8*)(V_lds + (bf) * SHM_V + vst1) = S.st_v1; } while (0)
#define A2_SWRITE(bf) do { A2_SWRITE_V(bf); A2_SWRITE_K(bf); } while (0)
#define A2_IDX int tid = threadIdx.x; asm volatile("" : "+v"(tid)); const int wid = __builtin_amdgcn_readfirstlane(tid >> 6), lane = tid & 63, r32 = lane & 31, hi = lane >> 5; \
    const int sr = tid >> 4, sc = (tid & 15) * 8, krow = tid >> 3, kc = tid & 7, kw0 = krow * 512 + ((kc ^ (krow & 15)) << 4), kw1 = krow * 512 + (((kc + 8) ^ (krow & 15)) << 4); \
    char* V_lds = lds + OFF_V; char* K_lds = lds + OFF_K; (void)lane; (void)r32; (void)hi; (void)sr; (void)sc; (void)V_lds
__device__ __forceinline__ void attn_qfin(const BlockRef& curA, const BlockRef& curB, const int* pos, const float* qn) {
    int tid = threadIdx.x; asm volatile("" : "+v"(tid)); const int wid = __builtin_amdgcn_readfirstlane(tid >> 6), lane = tid & 63, r32 = lane & 31, hi = lane >> 5;
    bf16* qrowA = const_cast<bf16*>(curA.Q) + (size_t)(wid * QBLK + r32) * QS + hi * 8; bf16* qrowB = const_cast<bf16*>(curB.Q) + (size_t)(wid * QBLK + r32) * QS + hi * 8;
    bf16x8 qA[12], qB[12];
#pragma unroll
    for (int d = 0; d < 12; ++d) qA[d] = load8(qrowA + d * 16);
#pragma unroll
    for (int d = 0; d < 12; ++d) qB[d] = load8(qrowB + d * 16);
    const int posA = pos[curA.P0 + wid * QBLK + r32], posB = pos[curB.P0 + wid * QBLK + r32];
#define A2_UNPK(X, W) do { const v4u wv_ = __builtin_bit_cast(v4u, W); const unsigned ww_[4] = {wv_.x, wv_.y, wv_.z, wv_.w}; \
        _Pragma("unroll") for (int e_ = 0; e_ < 4; ++e_) { X[2 * e_] = __uint_as_float(ww_[e_] << 16); X[2 * e_ + 1] = __uint_as_float(ww_[e_] & 0xffff0000u); } } while (0)
#define A2_GAIN(X, D) do { const f32x4 g0_ = *(const f32x4*)(qn + 16 * (D) + 8 * hi), g1_ = *(const f32x4*)(qn + 16 * (D) + 8 * hi + 4); \
        _Pragma("unroll") for (int e_ = 0; e_ < 8; ++e_) X[e_] *= sc * (e_ < 4 ? g0_[e_ & 3] : g1_[e_ & 3]); } while (0)
#define A2_REPK(X) __builtin_bit_cast(bf16x8, (v4u){cvtpk(X[0], X[1]), cvtpk(X[2], X[3]), cvtpk(X[4], X[5]), cvtpk(X[6], X[7])})
#define A2_QFIN(q, qrow, posv) do { float ssq = 0.f; \
    _Pragma("unroll") for (int d = 0; d < 12; ++d) { float x[8]; A2_UNPK(x, q[d]); _Pragma("unroll") for (int e = 0; e < 8; ++e) ssq += x[e] * x[e]; } \
    { auto rr = __builtin_amdgcn_permlane32_swap(__float_as_uint(ssq), __float_as_uint(ssq), false, false); ssq = __uint_as_float(rr[0]) + __uint_as_float(rr[1]); } \
    const float sc = __builtin_amdgcn_rsqf(ssq * (1.0f / 192.0f) + 1e-6f) * C2Q; const double posd = (double)(posv); \
    _Pragma("unroll") for (int d = 0; d < 8; ++d) { float x[8]; A2_UNPK(x, q[d]); A2_GAIN(x, d); *(bf16x8*)(qrow + d * 16) = A2_REPK(x); } \
    _Pragma("unroll") for (int dd = 0; dd < 2; ++dd) { float xa[8], xb[8]; A2_UNPK(xa, q[8 + dd]); A2_UNPK(xb, q[10 + dd]); A2_GAIN(xa, 8 + dd); A2_GAIN(xb, 10 + dd); \
        _Pragma("unroll") for (int e = 0; e < 8; ++e) { const int i = 16 * dd + 8 * hi + e; \
            const float inv = __builtin_amdgcn_exp2f(-(float)(4 * i) * (13.287712379549449f / 128.0f)); \
            double rev = posd * (double)inv * 0.15915494309189535; rev -= __builtin_rint(rev); \
            const float rf = (float)rev, c = __builtin_amdgcn_cosf(rf), s = __builtin_amdgcn_sinf(rf); \
            const float a_ = xa[e], b_ = xb[e]; xa[e] = a_ * c - b_ * s; xb[e] = b_ * c + a_ * s; } \
        *(bf16x8*)(qrow + (8 + dd) * 16) = A2_REPK(xa); *(bf16x8*)(qrow + (10 + dd) * 16) = A2_REPK(xb); } } while (0)
    A2_QFIN(qA, qrowA, posA);
    A2_QFIN(qB, qrowB, posB);
#undef A2_QFIN
#undef A2_UNPK
#undef A2_GAIN
#undef A2_REPK
    asm volatile("s_waitcnt vmcnt(0)" ::: "memory");
}
__device__ __forceinline__ void attn_prime(const BlockRef& cur, char* lds, Seam& S) {
    A2_IDX;
#pragma unroll
    for (int d0 = 0; d0 < 8; ++d0) S.qr[d0] = load8(cur.Q + (size_t)(wid * QBLK + r32) * QS + d0 * 16 + hi * 8);
    A2_SLOAD(cur.K, cur.V, 0); A2_VMW(); A2_SWRITE_K(0);
}
__device__ __forceinline__ void attn_block(const BlockRef& cur, const BlockRef& nxt, char* lds, Seam& S) {
    A2_IDX;
    const int NT = (cur.P0 + QB) / KVBLK;
    const int qlo = cur.P0 + wid * QBLK, qm = qlo + r32 - 4 * hi;
    float* ws = (float*)(lds + OFF_WS) + wid * 64; float* li_l = ws, * al_l = ws + 32;
    char* qr_lds = lds + OFF_QR + wid * 4096;
    float m_reg = -1e30f, l_reg = 0; f32x16 o[4] = {};
    const int vst0 = v_st(sr, sc), vst1 = v_st(32 + sr, sc);
    const int vb0 = (int)(uintptr_t)V_lds + v_rd_base(lane);
    const bf16* Kh = cur.K; const bf16* Vh = cur.V;
    { bf16x8 t4[4];
#pragma unroll
      for (int d = 0; d < 4; ++d) t4[d] = load8(cur.Q + (size_t)(wid * QBLK + r32) * QS + 128 + d * 16 + hi * 8);
#pragma unroll
      for (int d = 0; d < 4; ++d) *(bf16x8*)(qr_lds + ((d * 2 + hi) * 32 + r32) * 16) = t4[d]; }
    A2_SWRITE_V(0);
    __syncthreads();
    f32x16 p0, p1; float mn, al; bf16x8 pa0, pa1, pa2, pa3;
#define A2_STEP(t, BUF) do { const bool lastt = (t) + 1 >= NT; \
        A2_SBAR(); { const bf16* Kn = lastt ? nxt.K : Kh; const bf16* Vn = lastt ? nxt.V : Vh; const int k0n = lastt ? 0 : ((t) + 1) * KVBLK; A2_SLOAD(Kn, Vn, k0n); } A2_SBAR(); \
        qkt<BUF>(p0, p1, K_lds, qr_lds, r32, hi, S.qr); \
        if (lastt) { A2_SBAR(); _Pragma("unroll") for (int d0 = 0; d0 < 8; ++d0) S.qr[d0] = load8(nxt.Q + (size_t)(wid * QBLK + r32) * QS + d0 * 16 + hi * 8); A2_SBAR(); } \
        { const int kb_ = (t) * KVBLK; if (kb_ + KVBLK - 1 > qlo) mask_tile(p0, p1, qm - kb_); } \
        partialSM(p0, p1, m_reg, mn, al); finishSM(p0, p1, al, l_reg, pa0, pa1, pa2, pa3); \
        if (__any(al < 1.f)) { if (hi == 0) al_l[r32] = al; asm volatile("s_waitcnt lgkmcnt(0)" ::: "memory"); \
            for (int d_ = 0; d_ < 4; ++d_) for (int r = 0; r < 16; ++r) o[d_][r] *= al_l[crow(r, hi)]; } \
        A2_SBAR(); pv_tile<BUF>(o, vb0, pa0, pa1, pa2, pa3); A2_SBAR(); \
        if (lastt) { A2_VMWN(8); A2_SWRITE_K(0); } else { A2_VMW(); A2_SWRITE((BUF) ^ 1); } \
        __syncthreads(); } while (0)
    for (int t = 0; t < NT; t += 2) { A2_STEP(t, 0); A2_STEP(t + 1, 1); }
#undef A2_STEP
    if (hi == 0) li_l[r32] = l_reg; asm volatile("s_waitcnt lgkmcnt(0)" ::: "memory");
    float rli[16];
#pragma unroll
    for (int r = 0; r < 16; ++r) rli[r] = __builtin_amdgcn_rcpf(li_l[crow(r, hi)]);
    bf16* Ow = cur.O + (size_t)(wid * QBLK) * OS;
#pragma unroll
    for (int r = 0; r < 16; ++r) { const int orow = crow(r, hi);
#pragma unroll
        for (int d0 = 0; d0 < 4; ++d0) { const float v = o[d0][r] * rli[r]; const float vn = __shfl_xor(v, 1);
            if ((r32 & 1) == 0) *(unsigned*)(Ow + (size_t)orow * OS + d0 * 32 + r32) = cvtpk(v, vn); } }
    asm volatile("s_waitcnt lgkmcnt(0)" ::: "memory");
}
}
__device__ __forceinline__ attn2::BlockRef attn2_ref(unsigned char* ws, int v, int pass) {
    const int bh = v >> 3, b = bh >> 3, h = bh & 7, x = v & 7, qb = pass ? 15 - x : x;
    attn2::BlockRef r;
    r.Q = (const bf16*)(ws + WS_QP) + ((size_t)b * SEQ + qb * 256) * 1536 + h * 192; r.K = (const bf16*)(ws + WS_KF) + (size_t)b * SEQ * 1536 + h * 192;
    r.V = (const bf16*)(ws + WS_VV) + (size_t)b * SEQ * 1024 + h * 128; r.O = (bf16*)(ws + WS_MO) + ((size_t)b * SEQ + qb * 256) * 1024 + h * 128; r.P0 = qb * 256;
    return r;
}
__device__ __forceinline__ void phase_attn2(Frame& F, char* lds, const int* pos, const float* qn) {
    int L = F.vcu; if (L >= 256) return;
    for (int Lq = L; Lq < 256; Lq += F.G) { const attn2::BlockRef ra = attn2_ref(F.ws, Lq, 0), rb = attn2_ref(F.ws, Lq, 1); attn2::attn_qfin(ra, rb, pos + (size_t)(Lq >> 6) * SEQ, qn); }
    attn2::Seam S; int pass = 0;
    attn2::BlockRef cur = attn2_ref(F.ws, L, 0);
    attn2::attn_prime(cur, lds, S);
    for (;;) {
        const bool more_pass = pass == 0, more_item = L + F.G < 256, last = !more_pass && !more_item;
        int passn = pass + 1, Ln = L;
        if (!more_pass) { passn = 0; Ln = more_item ? L + F.G : L; }
        const attn2::BlockRef nxt = last ? cur : attn2_ref(F.ws, Ln, passn);
        attn2::attn_block(cur, nxt, lds, S);
        if (last) break;
        cur = nxt; pass = passn; L = Ln;
    }
}

static_assert(pg8::EpiKVup::O_KF == WS_KF && pg8::EpiKVup::O_VV == WS_VV && pg8::EpiKVup::O_KR == WS_KR && pg8::EpiKVup::O_SSQ_CKV == WS_SMALL + SM_SSQ_CKV && pg8::EpiKVup::O_SSQ_KR == WS_SMALL + SM_SSQ_KR, "EpiKVup offsets");
#ifndef MK_N_LAUNCHES
#define MK_N_LAUNCHES 12
#endif
constexpr int N_PHASES = 12;
constexpr int N_LAUNCHES = MK_N_LAUNCHES;
struct Args { const float* in[21]; float* out; unsigned char* ws; int ph_lo, ph_hi; };
#define PG8_SP2 true
#define PG8_ALIGN true
template <class Epi> __device__ __forceinline__ void run_gemm(Frame& F, const pg8::bf16_t* A, int lda, const pg8::bf16_t* Bt, int ldb, int N, int K, const Epi& E) {
    __syncthreads();
    pg8::Gemm g{A, Bt, MTOK, N, K, lda, ldb}; pg8::StaticOrder S; S.init(MTOK, N, F.G, (int)blockIdx.x);
    pg8::gemm_phase<Epi, pg8::StaticOrder, PG8_ALIGN, PG8_SP2>(F.lds + RING_OFF, g, S, E);
}
__global__ void __launch_bounds__(NWAVES * 64, 2) mk_fwd(Args args) {
    extern __shared__ __attribute__((aligned(16))) unsigned char lds[];
    Frame F;
    F.lds = (LAS unsigned char*)lds; F.MISC = (volatile LAS unsigned*)(F.lds + MISC_OFF);
    F.tid = threadIdx.x; F.lane = F.tid & 63; F.wave = __builtin_amdgcn_readfirstlane(F.tid >> 6);
    F.G = gridDim.x; { const int bx = blockIdx.x; F.vcu = (F.G % 8 == 0) ? (bx % 8) * (F.G / 8) + bx / 8 : bx; }
    F.out = args.out; F.ws = args.ws;
    unsigned char* ws = args.ws;
    if (F.tid < 32) F.MISC[F.tid] = 0u;
    __syncthreads();
    XcdBarrier bar; bar.bar = (unsigned*)(ws + WS_CTL) + CW_BAR; bar.x = 0; bar.st = nullptr;
    if (N_LAUNCHES == 1) bar = xcd_barrier_post((unsigned*)(ws + WS_CTL) + CW_BAR, F.MISC + 8);
    const int lo = args.ph_lo, hi = args.ph_hi;
#ifndef PH_MASK
#define PH_MASK 0xfff
#endif
#define IN(k) (((PH_MASK >> (k)) & 1) && lo <= (k) && (k) < hi)
#define SEAM(k) do { asm volatile("; SEAM_MARK %0" :: "i"(k)); if (IN(k) && IN((k) + 1)) xcd_barrier(bar); } while (0)
#define PH_IDX() do { int t_ = threadIdx.x; asm volatile("" : "+v"(t_)); F.tid = t_; F.lane = t_ & 63; F.wave = __builtin_amdgcn_readfirstlane(t_ >> 6); } while (0)
#ifdef STRETCH_MASK
#define PH_T0() PH_IDX(); const unsigned long long t0_ = __builtin_amdgcn_s_memrealtime()
#define PH_STRETCH(k) do { if ((STRETCH_MASK >> (k)) & 1) { const unsigned long long t1_ = __builtin_amdgcn_s_memrealtime(); const unsigned long long d_ = (t1_ - t0_) * STRETCH_MULT; while (__builtin_amdgcn_s_memrealtime() - t1_ < d_) __builtin_amdgcn_s_sleep(8); } } while (0)
#else
#define PH_T0() PH_IDX()
#define PH_STRETCH(k) do {} while (0)
#endif
    float* sm = (float*)(ws + WS_SMALL);
    const float* rstdx = sm + SM_RSTDX / 4; float* ssq_cq = sm + SM_SSQ_CQ / 4; float* ssq_ckv = sm + SM_SSQ_CKV / 4; float* ssq1 = sm + SM_SSQ1 / 4; float* ssq2 = sm + SM_SSQ2 / 4;
    typedef pg8::bf16_t b16;
    b16* WinT = (b16*)(ws + WS_WIN); b16* XB = (b16*)(ws + WS_XB); b16* LATb = (b16*)(ws + WS_LAT); b16* ROb = (b16*)args.out;

    if (IN(0)) { PH_T0(); phase_p0(F, args.in[0], (const int*)args.in[2], args.in[3], args.in[4], args.in[6], args.in[7], args.in[8], args.in[9]); PH_STRETCH(0); } SEAM(0);
    if (IN(1)) { PH_T0();
        pg8::EpiInProj E{rstdx, (const pg8::f32x4*)(ws + WS_CS), (b16*)(ws + WS_RQ), (b16*)(ws + WS_RK), (b16*)(ws + WS_RKDT), (b16*)(ws + WS_RVT), LATb, ssq_cq, (PG8_LAS unsigned char*)(F.lds + XS_OFF),
                          (b16*)(ws + WS_KR), sm + SM_SSQ_KR / 4, args.in[11]};
        run_gemm(F, XB, 1024, WinT + (size_t)4096 * 1024, 1024, NIN1, 1024, E);
    PH_STRETCH(1); } SEAM(1);
    if (IN(2)) { PH_T0(); phase_r0p(F);
    PH_STRETCH(2); } SEAM(2);
    if (IN(3)) { PH_T0(); phase_r1p(F); PH_STRETCH(3); } SEAM(3);
    if (IN(4)) { PH_T0();
        { pg8::EpiRetGate E{ROb, rstdx, (const float*)(ws + WS_SSQP), args.in[5]}; run_gemm(F, XB, 1024, WinT + (size_t)2048 * 1024, 1024, 2048, 1024, E); }
        asm volatile("; SEAM_MARK 41");
        { pg8::EpiRowAct<0> E{(b16*)(ws + WS_QP), 1536, ssq_cq, 1.0f / 384.0f}; run_gemm(F, LATb, LATW, (const b16*)(ws + WS_WUQ), 384, 1536, 384, E); }
        asm volatile("; SEAM_MARK 42");
        { pg8::EpiKVup E{ws, args.in[11], (PG8_LAS float*)(F.lds + XS_OFF)}; run_gemm(F, LATb + 384, LATW, (const b16*)(ws + WS_WUKV), 256, 2048, 256, E); }
    PH_STRETCH(4); } SEAM(4);
    if (IN(5)) { PH_T0(); phase_attn2(F, (char*)lds, (const int*)args.in[2], args.in[10]); PH_STRETCH(5); } SEAM(5);
    if (IN(6)) { PH_T0();
        phase_late_weights(F, args.in[1], args.in[12], args.in[13], args.in[14], args.in[15], args.in[16], args.in[17], args.in[18], args.in[19], args.in[20]);
        { pg8::EpiRowAct<1> E{(b16*)(ws + WS_SG), 2048, rstdx, 0.f}; run_gemm(F, XB, 1024, WinT, 1024, 2048, 1024, E); }
    PH_STRETCH(6); } SEAM(6);
    if (IN(7)) { PH_T0();
        { pg8::EpiGateMix<0> E{(b16*)(ws + WS_TM), (const b16*)(ws + WS_SG), 0}; run_gemm(F, ROb, 2048, (const b16*)(ws + WS_WBR), 2048, 1024, 2048, E); }
        VM_WAIT(); __syncthreads(); __builtin_amdgcn_fence(__ATOMIC_ACQUIRE, "agent"); VM_WAIT(); __syncthreads();
        { pg8::EpiGateMix<1> E{(b16*)(ws + WS_TM), (const b16*)(ws + WS_SG), 1024}; run_gemm(F, (const b16*)(ws + WS_MO), 1024, (const b16*)(ws + WS_WBM), 1024, 1024, 1024, E); }
    PH_STRETCH(7); } SEAM(7);
    if (IN(8)) { PH_T0(); pg8::EpiResid<false> E{(const void*)args.in[0], XB, ssq1}; run_gemm(F, (const b16*)(ws + WS_TM), 1024, (const b16*)(ws + WS_WO), 1024, 1024, 1024, E); PH_STRETCH(8); } SEAM(8);
    if (IN(9)) { PH_T0(); pg8::EpiRowAct<2> E{(b16*)(ws + WS_H), 4096, ssq1, 1.0f / 1024.0f}; run_gemm(F, XB, 1024, (const b16*)(ws + WS_WUP), 1024, 4096, 1024, E); PH_STRETCH(9); } SEAM(9);
    if (IN(10)) { PH_T0(); pg8::EpiResid<true> E{(const void*)XB, XB, ssq2}; run_gemm(F, (const b16*)(ws + WS_H), 4096, (const b16*)(ws + WS_WDOWN), 4096, 1024, 4096, E); PH_STRETCH(10); } SEAM(10);
    if (IN(11)) { PH_T0();
        { pg8::EpiRowAct<1> E{(b16*)(ws + WS_GT), 1024, ssq2, 1.0f / 1024.0f}; run_gemm(F, XB, 1024, (const b16*)(ws + WS_WPG), 1024, 1024, 1024, E); }
        VM_WAIT(); __syncthreads(); __builtin_amdgcn_fence(__ATOMIC_ACQUIRE, "agent"); VM_WAIT(); __syncthreads();
        { pg8::EpiFinal E{args.out, (const b16*)(ws + WS_GT), XB}; run_gemm(F, (const b16*)(ws + WS_PB), 256, (const b16*)(ws + WS_WPLE), 256, 1024, 256, E); }
    PH_STRETCH(11); }
#undef IN
#undef SEAM
}


#ifdef DUMPK
struct DumpArgs { const unsigned* reg[6]; unsigned nw[6]; unsigned* out; int own; int pad; };
__global__ void dump_hash(DumpArgs d) {
    for (unsigned i = blockIdx.x * blockDim.x + threadIdx.x; i < (unsigned)MTOK * DM; i += gridDim.x * blockDim.x) {
        float s = 0.f;
        if (d.own) { const unsigned w = d.out[i]; s += __uint_as_float(w << 16) + __uint_as_float(w & 0xffff0000u); }
        for (int r = 0; r < 6; ++r) if (d.reg[r] && i < d.nw[r] * 2u) { const unsigned short v = ((const unsigned short*)d.reg[r])[i]; s += __uint_as_float((unsigned)v << 16); }
        ((float*)d.out)[i] = s;
    }
}
#endif
extern "C" void kernel_launch(void* const* d_in, const int* in_sizes, int n_in, void* d_out, int out_size, void* d_ws, size_t ws_size, hipStream_t stream) {
    static int grid = 0;
    if (grid == 0) {
        if (n_in != 21 || in_sizes[0] != MTOK * DM || out_size != MTOK * DM || ws_size < WS_END) { fprintf(stderr, "kernel_launch: unexpected shapes (n_in %d in0 %d out %d ws %zu)\n", n_in, n_in > 0 ? in_sizes[0] : -1, out_size, ws_size); grid = -1; return; }
        int dev = 0, cus = 0, per_cu = 0;
        if (hipGetDevice(&dev) != hipSuccess || hipDeviceGetAttribute(&cus, hipDeviceAttributeMultiprocessorCount, dev) != hipSuccess) { grid = -1; return; }
        if (hipFuncSetAttribute((const void*)mk_fwd, hipFuncAttributeMaxDynamicSharedMemorySize, LDS_BYTES) != hipSuccess) { fprintf(stderr, "kernel_launch: hipFuncSetAttribute failed\n"); grid = -1; return; }
        if (hipOccupancyMaxActiveBlocksPerMultiprocessor(&per_cu, (const void*)mk_fwd, NWAVES * 64, LDS_BYTES) != hipSuccess || per_cu < 1) { fprintf(stderr, "kernel_launch: occupancy query says %d workgroups per CU\n", per_cu); (void)hipGetLastError(); grid = -1; return; }
        grid = cus;
    }
    if (grid < 0) return;
    (void)hipMemsetAsync((char*)d_ws + WS_CTL, 0, CTL_ZERO_BYTES, stream);
    Args a{};
    for (int i = 0; i < 21; ++i) a.in[i] = (const float*)d_in[i];
    a.out = (float*)d_out; a.ws = (unsigned char*)d_ws;
    if (N_LAUNCHES == 1) { a.ph_lo = 0; a.ph_hi = N_PHASES; hipLaunchKernelGGL(mk_fwd, dim3(grid), dim3(NWAVES * 64), LDS_BYTES, stream, a); }
    else for (int ph = 0; ph < N_PHASES; ++ph) {
#ifdef DUMPK
        if (ph > DUMPK) break;
#endif
        a.ph_lo = ph; a.ph_hi = ph + 1; hipLaunchKernelGGL(mk_fwd, dim3(grid), dim3(NWAVES * 64), LDS_BYTES, stream, a); }
#ifdef DUMPK
    { DumpArgs d{}; d.out = (unsigned*)d_out; d.own = DUMP_OWN; const size_t offs[6] = DUMP_OFFS; const size_t len[6] = DUMP_LENS;
      for (int r = 0; r < 6; ++r) if (len[r]) { d.reg[r] = (const unsigned*)((const char*)d_ws + offs[r]); d.nw[r] = (unsigned)(len[r] / 4); }
      hipLaunchKernelGGL(dump_hash, dim3(2048), dim3(256), 0, stream, d); }
#endif
}
```

```cpp
#define MK_N_LAUNCHES 1
#include <hip/hip_runtime.h>
#include <hip/hip_bf16.h>
#include <cstdio>
#include <cstdint>
namespace pg8 {
#define PG8_LAS __attribute__((address_space(3)))
typedef unsigned short bf16_t;
typedef short bf16x8 __attribute__((ext_vector_type(8)));
typedef float f32x4 __attribute__((ext_vector_type(4)));
typedef unsigned u32x4 __attribute__((ext_vector_type(4)));
constexpr int BM = 256, BK = 64, HALF = 128, HTB = HALF * BK * 2  , STAGE_BYTES = 8 * HTB, NXCD = 8, WGM = 8;

__host__ __device__ __forceinline__ int lds_byte(int r, int c) { const int st = (r >> 4) * 2 + (c >> 5), rr = r & 15, cc = c & 31, ob = rr * 64 + cc * 2; return st * 1024 + (ob ^ (((ob >> 9) & 1) << 5)); }
__host__ __device__ __forceinline__ void stage_rc(int b, int& R, int& C) { const int st = b / 1024, sb = b % 1024, swz = sb ^ (((sb >> 9) & 1) << 5); R = (st >> 1) * 16 + swz / 64; C = (st & 1) * 32 + (swz % 64) / 2; }
__host__ __device__ __forceinline__ int perm32(int rho) { const int n = rho >> 4, i = rho & 15; return 8 * (i >> 2) + 4 * n + (i & 3); }

struct Unit { int pm, pn; };
struct Gemm { const bf16_t* A; const bf16_t* Bt; int M, N, K, lda, ldb; };

struct StaticOrder {
    int nM, nN, nwg, G, c;
    __host__ __device__ void init(int M, int N, int G_, int c_) { nM = M / BM; nN = N / BM; nwg = nM * nN; G = G_; c = c_; }
    __host__ __device__ bool next(int i, Unit& u) const {
        const long L = (long)i * G + c; if (L >= nwg) return false;
        int wgid = (int)L; { const int q = nwg / NXCD, r = nwg % NXCD, xcd = wgid % NXCD, off = wgid / NXCD; wgid = (xcd < r ? xcd * (q + 1) : r * (q + 1) + (xcd - r) * q) + off; }
        const int nig = WGM * nN, gid = wgid / nig, fm = gid * WGM, gsz = (nM - fm) < WGM ? (nM - fm) : WGM;
        u.pm = fm + ((wgid % nig) % gsz); u.pn = (wgid % nig) / gsz; return true;
    }
    __device__ __forceinline__ void a_ready(const Unit&) const {}
    __device__ __forceinline__ void done(const Unit&) const {}
};


typedef float f32x2 __attribute__((ext_vector_type(2)));
typedef unsigned u32x2 __attribute__((ext_vector_type(2)));
typedef __bf16 bf16x2_t __attribute__((ext_vector_type(2)));
__device__ __forceinline__ unsigned cvt_pk_bf16(float lo, float hi) { f32x2 v = {lo, hi}; bf16x2_t b = __builtin_convertvector(v, bf16x2_t); return __builtin_bit_cast(unsigned, b); }
__device__ __forceinline__ float bflo(unsigned w) { return __uint_as_float(w << 16); }
__device__ __forceinline__ float bfhi(unsigned w) { return __uint_as_float(w & 0xffff0000u); }
__device__ __forceinline__ u32x4 pack8(const float (&v)[8]) { u32x4 w; w.x = cvt_pk_bf16(v[0], v[1]); w.y = cvt_pk_bf16(v[2], v[3]); w.z = cvt_pk_bf16(v[4], v[5]); w.w = cvt_pk_bf16(v[6], v[7]); return w; }
__device__ __forceinline__ void unpack8(const u32x4 w, float (&v)[8]) { v[0] = bflo(w.x); v[1] = bfhi(w.x); v[2] = bflo(w.y); v[3] = bfhi(w.y); v[4] = bflo(w.z); v[5] = bfhi(w.z); v[6] = bflo(w.w); v[7] = bfhi(w.w); }
__device__ __forceinline__ float sigmoidf_(float x) { return __builtin_amdgcn_rcpf(1.0f + __builtin_amdgcn_exp2f(-1.4426950408889634f * x)); }
constexpr float RMS_EPS_ = 1e-6f;

#define EPI_ACC8(v, ai, bj, m) float v[8]; { const f32x4 a0_ = acc[ai][bj][m][0], a1_ = acc[ai][bj][m][1]; v[0] = a0_[0]; v[1] = a0_[1]; v[2] = a0_[2]; v[3] = a0_[3]; v[4] = a1_[0]; v[5] = a1_[1]; v[6] = a1_[2]; v[7] = a1_[3]; }

__device__ __forceinline__ void xpose_store(PG8_LAS unsigned char* st, const unsigned (&pk)[4][4], bf16_t* dst, int R, int lane, int fr, int fq) {
#pragma unroll
    for (int pass = 0; pass < 2; ++pass) {
        if ((fq >> 1) == pass) {
#pragma unroll
            for (int m = 0; m < 4; ++m)
#pragma unroll
                for (int q = 0; q < 4; ++q) { const unsigned w = pk[m][q]; const int c = (fq & 1) * 8 + 2 * q;
                    *(PG8_LAS unsigned short*)(st + c * 144 + (16 * m + fr) * 2) = (unsigned short)(w & 0xffffu);
                    *(PG8_LAS unsigned short*)(st + (c + 1) * 144 + (16 * m + fr) * 2) = (unsigned short)(w >> 16); }
        }
        asm volatile("s_waitcnt lgkmcnt(0)" ::: "memory");
#pragma unroll
        for (int k = 0; k < 2; ++k) { const int idx = lane + 64 * k, c = idx & 15, ch = idx >> 4;
            const u32x4 v = *(const PG8_LAS u32x4*)(st + c * 144 + ch * 16);
            *(u32x4*)(dst + ((size_t)ch * R + pass * 16 + c) * 8) = v; }
        asm volatile("s_waitcnt lgkmcnt(0)" ::: "memory");
    }
}

struct EpiInProj {
    static constexpr bool PERM = true, AFTER_DRAIN = false, TWICE_OK = true; static __device__ __forceinline__ bool twice(const Unit& u) { return u.pn < 16; }
    const float* rstdx; const f32x4* cs;
    bf16_t *RQ, *RK, *RKDT, *RVT, *LAT; float *ssq_lat;   PG8_LAS unsigned char* xs;
    bf16_t* KR; float* ssq_kr; const float* k_norm;
    __device__ __forceinline__ void operator()(const f32x4 (&acc)[2][2][4][2], const Unit& u, int wr, int wc, int fr, int fq) const {
        const int pn = u.pn, lane = fq * 16 + fr, wid = wr * 4 + wc;
        PG8_LAS unsigned char* st = xs + wid * 2304;
        const int rowt = u.pm * BM + wr * 64 + fr;
        const int bidx = (u.pm * BM) >> 12, s0 = (u.pm * BM) & 4095;
        if (pn < 8) {
            const bool isk = pn >= 4; const int head = pn & 3;
            const float lg2 = __builtin_amdgcn_logf(1.0f - __builtin_amdgcn_exp2f(-5.0f - (float)head));
            float kd[4];
#pragma unroll
            for (int m = 0; m < 4; ++m) kd[m] = __builtin_amdgcn_exp2f((float)(127 - (wr * 64 + m * 16 + fr)) * lg2);
            bf16_t* O = isk ? RK : RQ;
#pragma unroll
            for (int ai = 0; ai < 2; ++ai) {
                unsigned pk0[4][4], pk1[4][4];
#pragma unroll
                for (int m = 0; m < 4; ++m) {
                    const int row = rowt + ai * HALF + m * 16; const float rs = rstdx[row] * (isk ? 0.0625f : 1.0f);
                    const f32x4* cp = cs + (size_t)row * 64 + wc * 16 + fq * 4;
                    const f32x4 c0 = cp[0], c1 = cp[1], c2 = cp[2], c3 = cp[3];
                    const float cc[8] = {c0[0], c0[2], c1[0], c1[2], c2[0], c2[2], c3[0], c3[2]}, ss[8] = {c0[1], c0[3], c1[1], c1[3], c2[1], c2[3], c3[1], c3[3]};
                    EPI_ACC8(x1, ai, 0, m); EPI_ACC8(x2, ai, 1, m);
                    float o1[8], o2[8];
#pragma unroll
                    for (int e = 0; e < 8; ++e) { const float a = x1[e] * rs, b = x2[e] * rs; o1[e] = a * cc[e] - b * ss[e]; o2[e] = b * cc[e] + a * ss[e]; }
                    bf16_t* rp = O + ((((size_t)(bidx * 4 + head) * 32 + (s0 >> 7) + ai) * 32 + wc * 4 + fq) * 128 + wr * 64 + m * 16 + fr) * 8;
                    *(u32x4*)rp = pack8(o1); *(u32x4*)(rp + (size_t)16 * 128 * 8) = pack8(o2);
                    if (isk) {
#pragma unroll
                        for (int q = 0; q < 4; ++q) { pk0[m][q] = cvt_pk_bf16(o1[2 * q] * kd[m], o1[2 * q + 1] * kd[m]); pk1[m][q] = cvt_pk_bf16(o2[2 * q] * kd[m], o2[2 * q + 1] * kd[m]); }
                    }
                }
                if (isk) {
                    bf16_t* d0 = RKDT + ((((size_t)(bidx * 4 + head) * 32 + (s0 >> 7) + ai) * 16 + wr * 8) * 256 + wc * 32) * 8;
                    xpose_store(st, pk0, d0, 256, lane, fr, fq);
                    xpose_store(st, pk1, d0 + (size_t)HALF * 8, 256, lane, fr, fq);
                }
            }
        } else if (pn < 16) {
            const int head = (pn - 8) >> 1, dvb = ((pn - 8) & 1) * 256;
#pragma unroll
            for (int ai = 0; ai < 2; ++ai)
#pragma unroll
                for (int bj = 0; bj < 2; ++bj) {
                    unsigned pk[4][4];
#pragma unroll
                    for (int m = 0; m < 4; ++m) { const float rs = rstdx[rowt + ai * HALF + m * 16]; EPI_ACC8(v, ai, bj, m);
#pragma unroll
                        for (int q = 0; q < 4; ++q) pk[m][q] = cvt_pk_bf16(v[2 * q] * rs, v[2 * q + 1] * rs); }
                    bf16_t* d0 = RVT + ((((size_t)(bidx * 4 + head) * 32 + (s0 >> 7) + ai) * 16 + wr * 8) * 512 + dvb + bj * HALF + wc * 32) * 8;
                    xpose_store(st, pk, d0, 512, lane, fr, fq);
                }
        } else if (pn < 19) {
            const int lt = pn - 16;
#pragma unroll
            for (int ai = 0; ai < 2; ++ai)
#pragma unroll
                for (int m = 0; m < 4; ++m) { const int row = rowt + ai * HALF + m * 16; const float rs = rstdx[row];
#pragma unroll
                    for (int bj = 0; bj < 2; ++bj) { if (lt == 2 && bj == 1) continue;
                        EPI_ACC8(v, ai, bj, m); float q = 0.f;
#pragma unroll
                        for (int e = 0; e < 8; ++e) { v[e] *= rs; q += v[e] * v[e]; }
                        *(u32x4*)(LAT + ((unsigned)row * 640u + lt * 256 + bj * HALF + wc * 32 + 8 * fq)) = pack8(v);
                        const int kind = (lt == 0) ? 0 : (lt == 1 ? (bj == 0 ? 0 : 1) : 1);
                        q += __shfl_xor(q, 16); q += __shfl_xor(q, 32); if (fq == 0) atomicAdd(ssq_lat + kind * 16384 + row, q); } }
        } else if (wc == 0) {
#pragma unroll
            for (int ai = 0; ai < 2; ++ai)
#pragma unroll
                for (int m = 0; m < 4; ++m) { const int row = rowt + ai * HALF + m * 16; const float rs = rstdx[row];
                    const f32x2* cp = (const f32x2*)cs + ((unsigned)row * 128u + 32u * fq); float q = 0.f; unsigned w1[4], w2[4];
#pragma unroll
                    for (int hh = 0; hh < 2; ++hh) { const f32x4 xa = acc[ai][0][m][hh] * rs, xb = acc[ai][1][m][hh] * rs; const f32x4 ga = *(const f32x4*)(k_norm + 128 + 8 * fq + 4 * hh), gb = *(const f32x4*)(k_norm + 160 + 8 * fq + 4 * hh);
                        float oa[4], ob[4];
#pragma unroll
                        for (int e = 0; e < 4; ++e) { q += xa[e] * xa[e] + xb[e] * xb[e]; const float ya = xa[e] * ga[e], yb = xb[e] * gb[e]; const f32x2 c = cp[4 * (4 * hh + e)];
                            oa[e] = ya * c.x - yb * c.y; ob[e] = yb * c.x + ya * c.y; }
                        w1[2 * hh] = cvt_pk_bf16(oa[0], oa[1]); w1[2 * hh + 1] = cvt_pk_bf16(oa[2], oa[3]); w2[2 * hh] = cvt_pk_bf16(ob[0], ob[1]); w2[2 * hh + 1] = cvt_pk_bf16(ob[2], ob[3]); }
                    *(u32x4*)(KR + ((unsigned)row * 64u + 8u * fq)) = (u32x4){w1[0], w1[1], w1[2], w1[3]}; *(u32x4*)(KR + ((unsigned)row * 64u + 32u + 8u * fq)) = (u32x4){w2[0], w2[1], w2[2], w2[3]};
                    q += __shfl_xor(q, 16); q += __shfl_xor(q, 32); if (fq == 0) ssq_kr[row] = q;
                    asm volatile("" ::: "memory"); }
        }
    }
};

struct EpiKVup {
    static constexpr bool PERM = true, AFTER_DRAIN = false, TWICE_OK = false; static __device__ __forceinline__ bool twice(const Unit&) { return false; }
    unsigned char* ws; const float* k_norm; PG8_LAS float* xr;
    static constexpr size_t O_KF = (size_t)142 << 20, O_VV = (size_t)190 << 20, O_KR = ((size_t)22 << 20) + (256 << 10), O_SSQ_CKV = ((size_t)1 << 20) + (128 << 10), O_SSQ_KR = ((size_t)1 << 20) + (320 << 10);
    __device__ __forceinline__ void operator()(const f32x4 (&acc)[2][2][4][2], const Unit& u, int wr, int wc, int fr, int fq) const {
        const unsigned rowt = u.pm * BM + wr * 64 + fr, head = u.pn, d0 = wc * 32 + 8 * fq;
        bf16_t* KF = (bf16_t*)(ws + O_KF); bf16_t* VV = (bf16_t*)(ws + O_VV); const bf16_t* KR = (const bf16_t*)(ws + O_KR); const float* ssq_ckv = (const float*)(ws + O_SSQ_CKV); const float* ssq_kr = (const float*)(ws + O_SSQ_KR);
#pragma unroll
        for (int ai = 0; ai < 2; ++ai)
#pragma unroll
            for (int m = 0; m < 4; ++m) { const unsigned row = rowt + ai * HALF + m * 16; const float rs = __builtin_amdgcn_rsqf(ssq_ckv[row] * (1.0f / 256.0f) + RMS_EPS_);
                const f32x4 a0 = acc[ai][0][m][0] * rs, a1 = acc[ai][0][m][1] * rs;
                float q = (a0[0] * a0[0] + a0[1] * a0[1]) + (a0[2] * a0[2] + a0[3] * a0[3]) + (a1[0] * a1[0] + a1[1] * a1[1]) + (a1[2] * a1[2] + a1[3] * a1[3]);
                q += __shfl_xor(q, 16); q += __shfl_xor(q, 32);
                if (fq == 0) xr[(ai * HALF + wr * 64 + m * 16 + fr) * 4 + wc] = q;
                asm volatile("" ::: "memory"); }
        asm volatile("s_waitcnt lgkmcnt(0)\n\ts_barrier" ::: "memory");
        const f32x4 g0 = *(const f32x4*)(k_norm + d0), g1 = *(const f32x4*)(k_norm + d0 + 4);
#pragma unroll
        for (int ai = 0; ai < 2; ++ai)
#pragma unroll
            for (int m = 0; m < 4; ++m) { const unsigned row = rowt + ai * HALF + m * 16; const float rs = __builtin_amdgcn_rsqf(ssq_ckv[row] * (1.0f / 256.0f) + RMS_EPS_);
                const f32x4 p4 = *(const PG8_LAS f32x4*)(xr + (ai * HALF + wr * 64 + m * 16 + fr) * 4);
                const float sk = __builtin_amdgcn_rsqf(((p4[0] + p4[1]) + (p4[2] + p4[3]) + ssq_kr[row]) * (1.0f / 192.0f) + RMS_EPS_), rk = rs * sk;
                { EPI_ACC8(v, ai, 0, m);
#pragma unroll
                  for (int e = 0; e < 8; ++e) v[e] *= rk * (e < 4 ? g0[e & 3] : g1[e & 3]);
                  *(u32x4*)(KF + (row * 1536u + head * 192u + d0)) = pack8(v); }
                { EPI_ACC8(v, ai, 1, m);
#pragma unroll
                  for (int e = 0; e < 8; ++e) v[e] *= rs;
                  *(u32x4*)(VV + (row * 1024u + head * 128u + d0)) = pack8(v); }
                { const u32x2 kr = *(const u32x2*)(KR + (row * 64u + 16 * wc + 4 * fq));
                  *(u32x2*)(KF + (row * 1536u + head * 192u + 128 + 16 * wc + 4 * fq)) = (u32x2){cvt_pk_bf16(bflo(kr.x) * sk, bfhi(kr.x) * sk), cvt_pk_bf16(bflo(kr.y) * sk, bfhi(kr.y) * sk)}; }
                asm volatile("" ::: "memory"); }
    }
};

template <int MODE> struct EpiRowAct {
    static constexpr bool PERM = true, AFTER_DRAIN = false, TWICE_OK = (MODE == 2); static __device__ __forceinline__ bool twice(const Unit&) { return true; }
    bf16_t* O; int ldo; const float* rsrc; float inv_dim;
    __device__ __forceinline__ void operator()(const f32x4 (&acc)[2][2][4][2], const Unit& u, int wr, int wc, int fr, int fq) const {
        const int rowt = u.pm * BM + wr * 64 + fr, colt = u.pn * BM + wc * 32 + 8 * fq;
#pragma unroll
        for (int ai = 0; ai < 2; ++ai)
#pragma unroll
            for (int m = 0; m < 4; ++m) { const int row = rowt + ai * HALF + m * 16; const float r0 = rsrc[row]; const float rs = inv_dim == 0.f ? r0 : __builtin_amdgcn_rsqf(r0 * inv_dim + RMS_EPS_);
#pragma unroll
                for (int bj = 0; bj < 2; ++bj) { EPI_ACC8(v, ai, bj, m);
#pragma unroll
                    for (int e = 0; e < 8; ++e) { float x = v[e] * rs; if (MODE == 1) x = sigmoidf_(x); if (MODE == 2) { x = fmaxf(x, 0.f); x = x * x; } v[e] = x; }
                    *(u32x4*)(O + (size_t)row * ldo + colt + bj * HALF) = pack8(v); } }
    }
};
struct EpiRetGate {
    static constexpr bool PERM = true, AFTER_DRAIN = false, TWICE_OK = false; static __device__ __forceinline__ bool twice(const Unit&) { return false; }
    bf16_t* RO; const float* rstdx; const float* ssq_ro; const float* ret_norm;
    __device__ __forceinline__ void operator()(const f32x4 (&acc)[2][2][4][2], const Unit& u, int wr, int wc, int fr, int fq) const {
        const int rowt = u.pm * BM + wr * 64 + fr, colt = u.pn * BM + wc * 32 + 8 * fq, head = u.pn >> 1;
        f32x4 g[2][2];
#pragma unroll
        for (int bj = 0; bj < 2; ++bj) { g[bj][0] = *(const f32x4*)(ret_norm + colt + bj * HALF); g[bj][1] = *(const f32x4*)(ret_norm + colt + bj * HALF + 4); }
#pragma unroll
        for (int ai = 0; ai < 2; ++ai)
#pragma unroll
            for (int m = 0; m < 4; ++m) { const int row = rowt + ai * HALF + m * 16; const float rs = rstdx[row]; const f32x4* sp = (const f32x4*)(ssq_ro + ((size_t)row * 4 + head) * 16); const f32x4 s4 = (sp[0] + sp[1]) + (sp[2] + sp[3]);
                const float rr = __builtin_amdgcn_rsqf(((s4[0] + s4[1]) + (s4[2] + s4[3])) * (1.0f / 512.0f) + RMS_EPS_);
#pragma unroll
                for (int bj = 0; bj < 2; ++bj) { EPI_ACC8(v, ai, bj, m); bf16_t* p = RO + (size_t)row * 2048 + colt + bj * HALF; float o[8]; unpack8(*(const u32x4*)p, o);
#pragma unroll
                    for (int e = 0; e < 8; ++e) { const float x = v[e] * rs; const float gg = e < 4 ? g[bj][0][e & 3] : g[bj][1][e & 3]; v[e] = o[e] * rr * gg * x * sigmoidf_(x); }
                    *(u32x4*)p = pack8(v); } }
    }
};
template <int MODE> struct EpiGateMix {
    static constexpr bool PERM = true, AFTER_DRAIN = false, TWICE_OK = false; static __device__ __forceinline__ bool twice(const Unit&) { return false; }
    bf16_t* TM; const bf16_t* SG; int sgoff;
    __device__ __forceinline__ void operator()(const f32x4 (&acc)[2][2][4][2], const Unit& u, int wr, int wc, int fr, int fq) const {
        const int rowt = u.pm * BM + wr * 64 + fr, colt = u.pn * BM + wc * 32 + 8 * fq;
#pragma unroll
        for (int ai = 0; ai < 2; ++ai)
#pragma unroll
            for (int m = 0; m < 4; ++m) { const int row = rowt + ai * HALF + m * 16;
#pragma unroll
                for (int bj = 0; bj < 2; ++bj) { EPI_ACC8(v, ai, bj, m); float s[8]; unpack8(*(const u32x4*)(SG + (size_t)row * 2048 + sgoff + colt + bj * HALF), s);
                    bf16_t* p = TM + (size_t)row * 1024 + colt + bj * HALF;
                    if (MODE == 1) { float t[8]; unpack8(*(const u32x4*)p, t);
#pragma unroll
                        for (int e = 0; e < 8; ++e) v[e] = t[e] + s[e] * v[e]; }
                    else {
#pragma unroll
                        for (int e = 0; e < 8; ++e) v[e] = s[e] * v[e]; }
                    *(u32x4*)p = pack8(v); } }
    }
};
template <bool RESB> struct EpiResid {
    static constexpr bool PERM = true, AFTER_DRAIN = false, TWICE_OK = false; static __device__ __forceinline__ bool twice(const Unit&) { return false; }
    const void* res; bf16_t* xb; float* ssq;
    __device__ __forceinline__ void operator()(const f32x4 (&acc)[2][2][4][2], const Unit& u, int wr, int wc, int fr, int fq) const {
        const int rowt = u.pm * BM + wr * 64 + fr, colt = u.pn * BM + wc * 32 + 8 * fq;
#pragma unroll
        for (int ai = 0; ai < 2; ++ai)
#pragma unroll
            for (int m = 0; m < 4; ++m) { const int row = rowt + ai * HALF + m * 16; float q = 0.f;
#pragma unroll
                for (int bj = 0; bj < 2; ++bj) { EPI_ACC8(v, ai, bj, m); const size_t off = (size_t)row * 1024 + colt + bj * HALF;
                    if (RESB) { float r[8]; unpack8(*(const u32x4*)((const bf16_t*)res + off), r);
#pragma unroll
                        for (int e = 0; e < 8; ++e) { v[e] += r[e]; q += v[e] * v[e]; } }
                    else { const f32x4 r0 = *(const f32x4*)((const float*)res + off), r1 = *(const f32x4*)((const float*)res + off + 4);
#pragma unroll
                        for (int e = 0; e < 8; ++e) { v[e] += e < 4 ? r0[e & 3] : r1[e & 3]; q += v[e] * v[e]; } }
                    *(u32x4*)(xb + off) = pack8(v); }
                q += __shfl_xor(q, 16); q += __shfl_xor(q, 32); if (fq == 0) atomicAdd(ssq + row, q);
                if (m & 1) asm volatile("" ::: "memory"); }
    }
};
struct EpiFinal {
    static constexpr bool PERM = true, AFTER_DRAIN = false, TWICE_OK = false; static __device__ __forceinline__ bool twice(const Unit&) { return false; }
    float* out; const bf16_t* GT; const bf16_t* xb;
    __device__ __forceinline__ void operator()(const f32x4 (&acc)[2][2][4][2], const Unit& u, int wr, int wc, int fr, int fq) const {
        const int rowt = u.pm * BM + wr * 64 + fr, colt = u.pn * BM + wc * 32 + 8 * fq;
#pragma unroll
        for (int ai = 0; ai < 2; ++ai)
#pragma unroll
            for (int m = 0; m < 4; ++m) { const int row = rowt + ai * HALF + m * 16;
#pragma unroll
                for (int bj = 0; bj < 2; ++bj) { EPI_ACC8(v, ai, bj, m); const size_t off = (size_t)row * 1024 + colt + bj * HALF; float gt[8], r[8]; unpack8(*(const u32x4*)(GT + off), gt); unpack8(*(const u32x4*)(xb + off), r);
#pragma unroll
                    for (int e = 0; e < 8; ++e) v[e] = r[e] + gt[e] * v[e];
                    *(f32x4*)(out + off) = (f32x4){v[0], v[1], v[2], v[3]}; *(f32x4*)(out + off + 4) = (f32x4){v[4], v[5], v[6], v[7]}; }
                if (m & 1) asm volatile("" ::: "memory"); }
    }
};
template <class Epi, class Sched, bool ALIGN_EPI = false, bool SP2 = false>
__device__ __forceinline__ void gemm_phase(PG8_LAS unsigned char* lds, const Gemm g, const Sched& S, const Epi& E) {
    int tid = threadIdx.x; asm volatile("" : "+v"(tid));
    const int wid = __builtin_amdgcn_readfirstlane(tid >> 6), lane = tid & 63, wr = wid >> 2, wc = wid & 3, fr = lane & 15, fq = lane >> 4;
    int K = g.K; if (g.K < 512) asm volatile("" : "+s"(K));
    const int nt = K / BK;
    unsigned voffA[2], voffB[2];
#pragma unroll
    for (int i = 0; i < 2; ++i) { int R, C; stage_rc(tid * 16 + i * 8192, R, C); const int Rb = Epi::PERM ? ((R & ~31) + perm32(R & 31)) : R;
        voffA[i] = (unsigned)(R * g.lda + C) * 2u; voffB[i] = (unsigned)(Rb * g.ldb + C) * 2u; }
    const size_t kstep = (size_t)(BK * 2);
    const size_t hstepA = (size_t)HALF * g.lda * 2, hstepB = (size_t)HALF * g.ldb * 2;
    const size_t tstepA = 2 * hstepA, tstepB = 2 * hstepB;
    const unsigned ldsw = (unsigned)wid * 1024u;
    const int aoff = lds_byte(wr * 64 + fr, fq * 8), boff = lds_byte(wc * 32 + fr, fq * 8);
#define PG8_SA(b, h) (((b) * 2 + (h)) * HTB)
#define PG8_SB(b, h) ((4 + (b) * 2 + (h)) * HTB)
#define PG8_STAGE(bufoff, gbase, voff) do { _Pragma("unroll") for (int _i = 0; _i < 2; ++_i) \
        __builtin_amdgcn_global_load_lds((const unsigned*)((const char*)(gbase) + (voff)[_i]), (PG8_LAS unsigned*)(lds + (bufoff) + ldsw + _i * 8192), 16, 0, 0); } while (0)
#define PG8_LDA(dst, b, h) do { _Pragma("unroll") for (int m = 0; m < 4; ++m) _Pragma("unroll") for (int k = 0; k < 2; ++k) dst[m][k] = *(const PG8_LAS bf16x8*)(lds + PG8_SA(b, h) + aoff + m * 2048 + k * 1024); } while (0)
#define PG8_LDB(dst, b, h) do { _Pragma("unroll") for (int n = 0; n < 2; ++n) _Pragma("unroll") for (int k = 0; k < 2; ++k) dst[n][k] = *(const PG8_LAS bf16x8*)(lds + PG8_SB(b, h) + boff + n * 2048 + k * 1024); } while (0)
#define PG8_MMA(ai, bj, At, Bt) do { __builtin_amdgcn_s_setprio(1); _Pragma("unroll") for (int m = 0; m < 4; ++m) _Pragma("unroll") for (int n = 0; n < 2; ++n) _Pragma("unroll") for (int k = 0; k < 2; ++k) \
        acc[ai][bj][m][n] = __builtin_amdgcn_mfma_f32_16x16x32_bf16(Bt[n][k], At[m][k], acc[ai][bj][m][n], 0, 0, 0); __builtin_amdgcn_s_setprio(0); } while (0)
#define PG8_WAIT_V(n) asm volatile("s_waitcnt vmcnt(" #n ")" ::: "memory")
#define PG8_WAIT_L(n) asm volatile("s_waitcnt lgkmcnt(" #n ")" ::: "memory")
#define PG8_BAR __builtin_amdgcn_s_barrier()
#define PG8_SCHED __builtin_amdgcn_sched_barrier(0)
    Unit cur, nxt; int ui = 0;
    if (!S.next(0, cur)) return;
    f32x4 acc[2][2][4][2];
#pragma unroll
    for (int a = 0; a < 2; ++a)
#pragma unroll
        for (int b = 0; b < 2; ++b)
#pragma unroll
            for (int m = 0; m < 4; ++m)
#pragma unroll
                for (int n = 0; n < 2; ++n) acc[a][b][m][n] = (f32x4){0.f, 0.f, 0.f, 0.f};
    bf16x8 At[4][2], B0[2][2], B1[2][2];
    const char* cA = (const char*)g.A + (size_t)cur.pm * tstepA; const char* cB = (const char*)g.Bt + (size_t)cur.pn * tstepB;
    S.a_ready(cur);
    if constexpr (SP2) {
        PG8_STAGE(PG8_SB(0, 0), cB, voffB); PG8_STAGE(PG8_SB(0, 1), cB + hstepB, voffB); PG8_STAGE(PG8_SA(0, 0), cA, voffA); PG8_STAGE(PG8_SA(0, 1), cA + hstepA, voffA);
        if (wr == 1) PG8_BAR;
        PG8_WAIT_V(2); PG8_BAR;
        PG8_STAGE(PG8_SB(1, 0), cB + kstep, voffB); PG8_STAGE(PG8_SA(1, 0), cA + kstep, voffA); PG8_STAGE(PG8_SB(1, 1), cB + hstepB + kstep, voffB);
        PG8_WAIT_V(6); PG8_BAR;
    } else {
        PG8_STAGE(PG8_SB(0, 0), cB, voffB); PG8_STAGE(PG8_SA(0, 0), cA, voffA); PG8_STAGE(PG8_SB(0, 1), cB + hstepB, voffB); PG8_STAGE(PG8_SA(0, 1), cA + hstepA, voffA);
        if (wr == 1) PG8_BAR;
        PG8_WAIT_V(4); PG8_BAR;
        PG8_STAGE(PG8_SB(1, 0), cB + kstep, voffB); PG8_STAGE(PG8_SA(1, 0), cA + kstep, voffA); PG8_STAGE(PG8_SB(1, 1), cB + hstepB + kstep, voffB);
        PG8_WAIT_V(6); PG8_BAR;
    }
    for (;;) {
        const bool has_next = S.next(ui + 1, nxt);
        const char* nA = has_next ? (const char*)g.A + (size_t)nxt.pm * tstepA : cA; const char* nB = has_next ? (const char*)g.Bt + (size_t)nxt.pn * tstepB : cB;
        for (int t = 0; t < nt; t += 2) {
            const bool last = (t == nt - 2);
            const char* a1 = cA + (size_t)(t + 1) * kstep;
            const char* a2 = last ? nA : cA + (size_t)(t + 2) * kstep; const char* b2 = last ? nB : cB + (size_t)(t + 2) * kstep;
            const char* a3 = a2 + kstep; const char* b3 = b2 + kstep;
            if (last && has_next) S.a_ready(nxt);
            if constexpr (SP2) {
            PG8_LDB(B0, 0, 0); PG8_LDB(B1, 0, 1); PG8_SCHED; PG8_LDA(At, 0, 0); PG8_STAGE(PG8_SA(1, 1), a1 + hstepA, voffA);
            PG8_WAIT_V(8); PG8_WAIT_L(0); PG8_BAR; PG8_MMA(0, 0, At, B0); PG8_MMA(0, 1, At, B1); PG8_BAR; PG8_SCHED;
            PG8_LDA(At, 0, 1); PG8_STAGE(PG8_SB(0, 0), b2, voffB); PG8_STAGE(PG8_SB(0, 1), b2 + hstepB, voffB); PG8_STAGE(PG8_SA(0, 0), a2, voffA);
            PG8_WAIT_V(8); PG8_WAIT_L(0); PG8_BAR; PG8_MMA(1, 0, At, B0); PG8_MMA(1, 1, At, B1); PG8_BAR; PG8_SCHED;
            PG8_LDB(B0, 1, 0); PG8_LDB(B1, 1, 1); PG8_SCHED; PG8_LDA(At, 1, 0); PG8_STAGE(PG8_SA(0, 1), a2 + hstepA, voffA);
            PG8_WAIT_V(8); PG8_WAIT_L(0); PG8_BAR; PG8_MMA(0, 0, At, B0); PG8_MMA(0, 1, At, B1); PG8_BAR; PG8_SCHED;
            PG8_LDA(At, 1, 1); PG8_STAGE(PG8_SB(1, 0), b3, voffB); PG8_STAGE(PG8_SB(1, 1), b3 + hstepB, voffB); PG8_STAGE(PG8_SA(1, 0), a3, voffA);
            PG8_WAIT_V(8); PG8_WAIT_L(0); PG8_BAR; PG8_MMA(1, 0, At, B0); PG8_MMA(1, 1, At, B1); PG8_BAR; PG8_SCHED;
            } else {
            PG8_LDB(B0, 0, 0); PG8_SCHED; PG8_LDA(At, 0, 0); PG8_STAGE(PG8_SA(1, 1), a1 + hstepA, voffA);
            PG8_WAIT_L(8); PG8_BAR; PG8_WAIT_L(0); PG8_MMA(0, 0, At, B0); PG8_BAR; PG8_SCHED;
            PG8_LDB(B1, 0, 1); PG8_STAGE(PG8_SB(0, 0), b2, voffB);
            PG8_BAR; PG8_WAIT_L(0); PG8_MMA(0, 1, At, B1); PG8_BAR;
            PG8_LDA(At, 0, 1); PG8_STAGE(PG8_SA(0, 0), a2, voffA);
            PG8_BAR; PG8_WAIT_L(0); PG8_MMA(1, 0, At, B0); PG8_BAR; PG8_SCHED;
            PG8_STAGE(PG8_SB(0, 1), b2 + hstepB, voffB);
            PG8_WAIT_V(6); PG8_BAR; PG8_MMA(1, 1, At, B1); PG8_BAR;
            PG8_LDB(B0, 1, 0); PG8_SCHED; PG8_LDA(At, 1, 0); PG8_STAGE(PG8_SA(0, 1), a2 + hstepA, voffA);
            PG8_WAIT_L(8); PG8_BAR; PG8_WAIT_L(0); PG8_MMA(0, 0, At, B0); PG8_BAR; PG8_SCHED;
            PG8_LDB(B1, 1, 1); PG8_STAGE(PG8_SB(1, 0), b3, voffB);
            PG8_BAR; PG8_WAIT_L(0); PG8_MMA(0, 1, At, B1); PG8_BAR;
            PG8_LDA(At, 1, 1); PG8_STAGE(PG8_SA(1, 0), a3, voffA);
            PG8_BAR; PG8_WAIT_L(0); PG8_MMA(1, 0, At, B0); PG8_BAR; PG8_SCHED;
            PG8_STAGE(PG8_SB(1, 1), b3 + hstepB, voffB);
            PG8_WAIT_V(6); PG8_BAR; PG8_MMA(1, 1, At, B1); PG8_BAR;
            }
        }
        if constexpr (ALIGN_EPI) { if (wr == 0) PG8_BAR; }
        if constexpr (!Epi::AFTER_DRAIN) { E(acc, cur, wr, wc, fr, fq);
#ifdef EPI_TWICE
            if constexpr (Epi::TWICE_OK) { asm volatile("" ::: "memory"); if (Epi::twice(cur)) E(acc, cur, wr, wc, fr, fq); }
#endif
            S.done(cur); }
        if (!has_next) break;
#pragma unroll
        for (int a = 0; a < 2; ++a)
#pragma unroll
            for (int b = 0; b < 2; ++b)
#pragma unroll
                for (int m = 0; m < 4; ++m)
#pragma unroll
                    for (int n = 0; n < 2; ++n) acc[a][b][m][n] = (f32x4){0.f, 0.f, 0.f, 0.f};
        cur = nxt; cA = nA; cB = nB; ++ui;
        if constexpr (ALIGN_EPI) { if (wr == 1) PG8_BAR; }
    }
    PG8_WAIT_V(0);
    if constexpr (!ALIGN_EPI) { if (wr == 0) PG8_BAR; }
    PG8_BAR;
    if constexpr (Epi::AFTER_DRAIN) { E.fused(acc, cur, wr, wc, fr, fq, lds, wid, lane); S.done(cur); }
#undef PG8_SA
#undef PG8_SB
#undef PG8_STAGE
#undef PG8_LDA
#undef PG8_LDB
#undef PG8_MMA
#undef PG8_WAIT_V
#undef PG8_WAIT_L
#undef PG8_BAR
#undef PG8_SCHED
}
}
#define GAS __attribute__((address_space(1)))
#define LAS __attribute__((address_space(3)))
typedef unsigned short bf16;
typedef unsigned v4u __attribute__((ext_vector_type(4)));
typedef float f32x4 __attribute__((ext_vector_type(4)));
typedef short bf16x8 __attribute__((ext_vector_type(8)));
typedef GAS unsigned gu32;
typedef GAS unsigned long long gu64;
#define RLX_AGENT __ATOMIC_RELAXED, __HIP_MEMORY_SCOPE_AGENT
#define LDS_WAIT() asm volatile("s_waitcnt lgkmcnt(0)" ::: "memory")
#define VM_WAIT() asm volatile("s_waitcnt vmcnt(0)" ::: "memory")
__device__ __forceinline__ unsigned long long rt() { return __builtin_amdgcn_s_memrealtime(); }
__device__ __forceinline__ unsigned f2bf(float f) { unsigned u = __builtin_bit_cast(unsigned, f); return (u + 0x7fffu + ((u >> 16) & 1u)) >> 16; }
__device__ __forceinline__ unsigned pk2(float lo, float hi) { return f2bf(lo) | (f2bf(hi) << 16); }

#define XB_TMO      128
#define XB_XCNT(j)  (256  + 64 * (j))
#define XB_XSUB(j)  (1280 + 64 * (j))
#define XB_XGEN(j)  (2304 + 64 * (j))
#define XB_TOP      3328
#define XB_TOPGEN   3392
#define XCD_BAR_WORDS 3456
#define XB_SPIN_CAP (1u << 18)

__device__ __forceinline__ unsigned xb_ld(unsigned* p)              { return __hip_atomic_load(p, __ATOMIC_RELAXED, __HIP_MEMORY_SCOPE_AGENT); }
__device__ __forceinline__ unsigned xb_add(unsigned* p, unsigned v) { return __hip_atomic_fetch_add(p, v, __ATOMIC_RELAXED, __HIP_MEMORY_SCOPE_AGENT); }
__device__ __forceinline__ unsigned xb_xcc_id() { return (unsigned)__builtin_amdgcn_s_getreg((3 << 11) | 20) & 0xFu; }
#define XB_SPIN(cond, bar) do { unsigned _sp = 0; while (cond) { __builtin_amdgcn_s_sleep(1); \
    if ((++_sp & 255u) == 0u) { if (xb_ld(&(bar)[XB_TMO])) break; if (_sp > XB_SPIN_CAP) { atomicAdd(&(bar)[XB_TMO], 1u); break; } } } } while (0)

struct XcdBarrier {
    unsigned* bar; unsigned x;
    volatile LAS unsigned* st;
};

__device__ __forceinline__ XcdBarrier xcd_barrier_post(unsigned* bar, volatile LAS unsigned* st) {
    XcdBarrier b; b.bar = bar; b.x = xb_xcc_id(); b.st = st;
    if (threadIdx.x == 0) (void)xb_add(&bar[XB_XCNT(b.x)], 1u);
    return b;
}
__device__ __forceinline__ void xcd_barrier_complete(unsigned* bar, unsigned x, unsigned& nloc, unsigned& nx) {
    const unsigned G = gridDim.x * gridDim.y * gridDim.z;
    unsigned sum, cnt, mine, sp = 0u;
    for (;;) {
        sum = 0u; cnt = 0u; mine = 0u;
#pragma unroll
        for (unsigned j = 0; j < 16; ++j) { const unsigned c = xb_ld(&bar[XB_XCNT(j)]); sum += c; cnt += (c > 0u) ? 1u : 0u; mine = (j == x) ? c : mine; }
        if (sum == G) break;
        __builtin_amdgcn_s_sleep(1);
        if ((++sp & 255u) == 0u) { if (xb_ld(&bar[XB_TMO])) break; if (sp > XB_SPIN_CAP) { atomicAdd(&bar[XB_TMO], 1u); break; } }
    }
    nloc = mine > 0u ? mine : 1u; nx = cnt > 0u ? cnt : 1u;
}

__device__ __forceinline__ void xcd_barrier(const XcdBarrier& b) {
    asm volatile("s_waitcnt vmcnt(0)" ::: "memory");
    __syncthreads();
    if (threadIdx.x == 0) {
        unsigned* bar = b.bar;
        __builtin_amdgcn_s_waitcnt(0);
        unsigned nloc = b.st[0], nx = b.st[1];
        if (nloc == 0u) { xcd_barrier_complete(bar, b.x, nloc, nx); b.st[0] = nloc; b.st[1] = nx; }
        const unsigned old = xb_add(&bar[XB_XSUB(b.x)], 1u);
        const unsigned gen = old / nloc;
        if (old + 1u == (gen + 1u) * nloc) {
            __builtin_amdgcn_fence(__ATOMIC_RELEASE, "agent");
            asm volatile("s_waitcnt vmcnt(0)" ::: "memory");
            const unsigned og = xb_add(&bar[XB_TOP], 1u);
            const unsigned tg = og / nx;
            if (og + 1u == (tg + 1u) * nx) xb_add(&bar[XB_TOPGEN], 1u);
            else XB_SPIN(xb_ld(&bar[XB_TOPGEN]) == tg, bar);
            __builtin_amdgcn_fence(__ATOMIC_ACQUIRE, "agent");
            xb_add(&bar[XB_XGEN(b.x)], 1u);
            asm volatile("s_waitcnt vmcnt(0)" ::: "memory");
        } else {
            XB_SPIN(xb_ld(&bar[XB_XGEN(b.x)]) == gen, bar);
            __builtin_amdgcn_fence(__ATOMIC_ACQUIRE, "agent");
            asm volatile("s_waitcnt vmcnt(0)" ::: "memory");
        }
    }
    __syncthreads();
}


typedef float f32x2 __attribute__((ext_vector_type(2)));
constexpr int NWAVES = 8;
constexpr int BATCH = 4, SEQ = 4096, DM = 1024, MTOK = BATCH * SEQ;
constexpr int NIN1 = 5120;
constexpr int LATW = 640;
constexpr float C2Q = 0.07216878364870323f * 1.4426950408889634f;

constexpr size_t MiB = 1u << 20, KiB = 1u << 10;
constexpr size_t WS_CTL = 0, CTL_ZERO_BYTES = 64 * KiB;
constexpr size_t WS_SMALL = 1 * MiB;
constexpr size_t SM_RSTDX = 0, SM_SSQ_CQ = 64 * KiB, SM_SSQ_CKV = 128 * KiB, SM_SSQ1 = 192 * KiB, SM_SSQ2 = 256 * KiB, SM_SSQ_KR = 320 * KiB, SM_END = 384 * KiB;
constexpr size_t WS_WIN = 2 * MiB;
constexpr size_t WS_SSQP = 10 * MiB;
constexpr size_t WS_WUQ = 20 * MiB;
constexpr size_t WS_WUKV = WS_WUQ + (size_t)1536 * 384 * 2;
constexpr size_t WS_KR = 22 * MiB + 256 * KiB;
constexpr size_t WS_XB = 25 * MiB;
constexpr size_t WS_CS = 57 * MiB;
constexpr size_t WS_LAT = 73 * MiB;
constexpr size_t WS_RQ = 94 * MiB, WS_RK = 126 * MiB, WS_RKDT = 158 * MiB, WS_RVT = 190 * MiB;
constexpr size_t WS_QP = 94 * MiB, WS_KF = 142 * MiB, WS_VV = 190 * MiB;
constexpr size_t WS_MO = 57 * MiB;
constexpr size_t WS_SG = 94 * MiB, WS_TM = 158 * MiB;
constexpr size_t WS_WBR = 190 * MiB, WS_WBM = 194 * MiB, WS_WO = 196 * MiB, WS_WUP = 198 * MiB, WS_WDOWN = 206 * MiB, WS_WPG = 214 * MiB, WS_WPLE = 216 * MiB;
constexpr size_t WS_PB = 217 * MiB;
constexpr size_t WS_H = 57 * MiB;
constexpr size_t WS_GT = 57 * MiB;
constexpr size_t WS_END = 256 * MiB;
static_assert(SM_SSQ_CKV == SM_SSQ_CQ + 65536, "ssq_lat layout");
static_assert(WS_WIN + (size_t)9216 * 2048 <= WS_WUQ && WS_WUKV + (size_t)2048 * 256 * 2 <= WS_KR && WS_KR + 2 * MiB <= WS_XB && WS_LAT + 20 * MiB <= WS_RQ && WS_RVT + 64 * MiB <= WS_END && WS_H + 128 * MiB <= WS_WBR && WS_PB + 8 * MiB <= WS_END, "d_ws map");
constexpr int CW_BAR = 1024;

constexpr int RING_OFF = 0, RING_BYTES = 131072;
constexpr int XS_OFF = RING_BYTES, XS_BYTES = 8 * 2304;
constexpr int MISC_OFF = XS_OFF + XS_BYTES;
constexpr int LDS_BYTES = 160 * 1024;
static_assert(MISC_OFF + 128 <= LDS_BYTES, "LDS map");

struct Frame {
    LAS unsigned char* lds; volatile LAS unsigned* MISC; int tid, lane, wave, G, vcu;
    float* out; unsigned char* ws;
};
__device__ __forceinline__ float wave_sum(float v) {
#pragma unroll
    for (int o = 1; o < 64; o <<= 1) v += __shfl_xor(v, o);
    return v;
}
__device__ __forceinline__ void p0_transpose_item(const float* W, int ldw, int K, int src_col, bf16* WT, int dst_row, int ncols, const float* gain, LAS float* scr, int item, int lane) {
    const int nblk = ncols / 32, kb = item / nblk, nb = item % nblk, k0 = 64 * kb, n0 = 32 * nb;
#pragma unroll 16
    for (int i = 0; i < 32; ++i) { const int kk = 2 * i + (lane >> 5); const float gk = gain ? gain[k0 + kk] : 1.0f; scr[kk * 33 + (lane & 31)] = W[(size_t)(k0 + kk) * ldw + src_col + n0 + (lane & 31)] * gk; }
    LDS_WAIT(); asm volatile("" ::: "memory");
    const int c = lane & 7;
#pragma unroll
    for (int j = 0; j < 4; ++j) { const int n = (lane >> 3) + 8 * j; const LAS float* s = scr + (8 * c) * 33 + n;
        v4u o; o.x = pk2(s[0 * 33], s[1 * 33]); o.y = pk2(s[2 * 33], s[3 * 33]); o.z = pk2(s[4 * 33], s[5 * 33]); o.w = pk2(s[6 * 33], s[7 * 33]);
        *(GAS v4u*)(WT + (size_t)(dst_row + n0 + n) * K + k0 + 8 * c) = o; }
    LDS_WAIT(); asm volatile("" ::: "memory");
}
struct XT { const float* src; bf16* dst; const float* gain; int ldw, K; };
#define XT_SEG(W_, ldw_, K_, src_, WT_, dst_, ncols_, gain_) { const int n_ = ((K_) / 64) * ((ncols_) / 128); if (r < n_) { const int nblk_ = (ncols_) / 128, kb_ = r / nblk_, nb_ = r - kb_ * nblk_; \
        x.src = (W_) + (size_t)(64 * kb_) * (ldw_) + (src_) + 128 * nb_; x.dst = (WT_) + (size_t)((dst_) + 128 * nb_) * (K_) + 64 * kb_; x.gain = (gain_) ? (gain_) + 64 * kb_ : (const float*)nullptr; x.ldw = (ldw_); x.K = (K_); return x; } r -= n_; }
__device__ __forceinline__ void xt_load(const XT& x, int tid, f32x4 (&v)[4], float (&g)[4]) {
#pragma unroll
    for (int i = 0; i < 4; ++i) { const int row = i * 16 + (tid >> 5); v[i] = *(const GAS f32x4*)(x.src + (size_t)row * x.ldw + 4 * (tid & 31)); g[i] = x.gain ? x.gain[row] : 1.0f; }
}
template <class Dec> __device__ __forceinline__ void xt_run(Frame& F, int ntiles, const Dec& dec) {
    LAS float* scr = (LAS float*)(F.lds + RING_OFF);
    const int tid = F.tid; int t = F.vcu; if (t >= ntiles) return;
    XT cur = dec(t); f32x4 v[4]; float g[4]; xt_load(cur, tid, v, g);
    for (;;) {
        const int tn = t + F.G; const bool has = tn < ntiles; const XT nxt = has ? dec(tn) : cur;
        __syncthreads();
#pragma unroll
        for (int i = 0; i < 4; ++i) *(LAS f32x4*)(scr + (i * 16 + (tid >> 5)) * 132 + 4 * (tid & 31)) = v[i] * g[i];
        if (has) xt_load(nxt, tid, v, g);
        __syncthreads();
        const int n = tid >> 2, kq = tid & 3;
#pragma unroll
        for (int j = 0; j < 2; ++j) { const int kc = kq + 4 * j; const LAS float* s = scr + (8 * kc) * 132 + n;
            v4u o; o.x = pk2(s[0 * 132], s[1 * 132]); o.y = pk2(s[2 * 132], s[3 * 132]); o.z = pk2(s[4 * 132], s[5 * 132]); o.w = pk2(s[6 * 132], s[7 * 132]);
            *(GAS v4u*)(cur.dst + (size_t)n * cur.K + 8 * kc) = o; }
        if (!has) break;
        cur = nxt; t = tn;
    }
    __syncthreads();
}
#define P0_SEG(W, ldw, K, src, WT, dst, ncols, gain) { const int n_ = ((K) / 64) * ((ncols) / 32); if (r < n_) { p0_transpose_item(W, ldw, K, src, WT, dst, ncols, gain, scr, r, F.lane); continue; } r -= n_; }
__device__ __forceinline__ void phase_p0(Frame& F, const float* x, const int* pos, const float* g_mix, const float* w_in, const float* g_qlat, const float* g_kvlat, const float* w_uq, const float* w_ukv) {
    LAS float* scr = (LAS float*)(F.lds + RING_OFF + F.wave * 16384);
    const int gw = F.vcu * NWAVES + F.wave, NGW = F.G * NWAVES;
    bf16* WinT = (bf16*)(F.ws + WS_WIN); bf16* WuqT = (bf16*)(F.ws + WS_WUQ); bf16* WukvT = (bf16*)(F.ws + WS_WUKV);
    struct Dec0 { const float *w_in, *g_mix, *w_uq, *g_qlat, *w_ukv, *g_kvlat; bf16 *WinT, *WuqT, *WukvT;
        __device__ __forceinline__ XT operator()(int r) const { XT x;
            XT_SEG(w_in, 8896, 1024, 6848, WinT, 0, 2048, g_mix)
            XT_SEG(w_in, 8896, 1024, 4096, WinT, 2048, 2048, g_mix)
            XT_SEG(w_in, 8896, 1024, 0, WinT, 4096, 4096, g_mix)
            XT_SEG(w_in, 8896, 1024, 6144, WinT, 8192, 640, g_mix)
            XT_SEG(w_uq, 1536, 384, 0, WuqT, 0, 1536, g_qlat)
            XT_SEG(w_ukv, 2048, 256, 0, WukvT, 0, 2048, g_kvlat)
            x.src = w_in; x.dst = WinT; x.gain = nullptr; x.ldw = 8896; x.K = 1024; return x; } };
    { const Dec0 d{w_in, g_mix, w_uq, g_qlat, w_ukv, g_kvlat, WinT, WuqT, WukvT}; xt_run(F, 16 * 16 * 2 + 16 * 32 + 16 * 5 + 6 * 12 + 4 * 16, d); }
    for (int it = gw; it < 32; it += NGW) {
        int r = it;
        P0_SEG(w_in, 8896, 1024, 6784, WinT, 8960, 32, g_mix)
        P0_SEG(w_in, 8896, 1024, 6816, WinT, 8960 + 128, 32, g_mix)
    }
    for (int gt = F.vcu * 512 + F.tid; gt < 40960; gt += F.G * 512) { const int row = gt >> 7, piece = gt & 127; const int wrow = row < 128 ? 8832 + row : (row < 224 ? 8992 + (row - 128) : 9120 + (row - 224));
        *(GAS v4u*)((unsigned char*)(WinT + (size_t)wrow * 1024) + (size_t)piece * 16) = (v4u){0u, 0u, 0u, 0u}; }
    { bf16* XB = (bf16*)(F.ws + WS_XB); float* rstdx = (float*)(F.ws + WS_SMALL + SM_RSTDX);
      for (int m0 = 2 * gw; m0 < MTOK; m0 += 2 * NGW) {
          f32x4 v[2][4]; float s[2] = {0.f, 0.f};
#pragma unroll
          for (int u = 0; u < 2; ++u) { const GAS f32x4* xr = (const GAS f32x4*)(x + (size_t)(m0 + u) * DM) + F.lane;
#pragma unroll
              for (int j = 0; j < 4; ++j) v[u][j] = xr[64 * j]; }
#pragma unroll
          for (int u = 0; u < 2; ++u) {
#pragma unroll
              for (int j = 0; j < 4; ++j) s[u] += (v[u][j].x * v[u][j].x + v[u][j].y * v[u][j].y) + (v[u][j].z * v[u][j].z + v[u][j].w * v[u][j].w);
              s[u] = wave_sum(s[u]);
              GAS unsigned long long* o8 = (GAS unsigned long long*)(XB + (size_t)(m0 + u) * DM) + F.lane;
#pragma unroll
              for (int j = 0; j < 4; ++j) o8[64 * j] = (unsigned long long)pk2(v[u][j].x, v[u][j].y) | ((unsigned long long)pk2(v[u][j].z, v[u][j].w) << 32);
              if (F.lane == 0) rstdx[m0 + u] = 1.0f / sqrtf(s[u] * (1.0f / DM) + 1e-6f); }
      } }
    { f32x2* cs = (f32x2*)(F.ws + WS_CS);
      for (int e = F.vcu * 512 + F.tid; e < MTOK * 128; e += F.G * 512) { const int row = e >> 7, i = e & 127;
          const float inv = __builtin_amdgcn_exp2f(-(float)i * (13.287712379549449f / 128.0f));
          double rev = (double)pos[row] * (double)inv * 0.15915494309189535; rev -= __builtin_rint(rev);
          const float rf = (float)rev; cs[e] = (f32x2){__builtin_amdgcn_cosf(rf), __builtin_amdgcn_sinf(rf)}; } }
    { float* z = (float*)(F.ws + WS_SMALL + SM_SSQ_CQ); for (int e = F.vcu * 512 + F.tid; e < (int)((SM_END - SM_SSQ_CQ) / 4); e += F.G * 512) z[e] = 0.f; }
}
__device__ __forceinline__ void phase_late_weights(Frame& F, const float* p, const float* w_br, const float* w_bm, const float* w_o, const float* g_mlp, const float* w_up, const float* w_down, const float* g_ple, const float* w_pg, const float* w_ple) {
    struct Dec1 { const float *w_br, *w_bm, *w_o, *g_mlp, *w_up, *w_down, *g_ple, *w_pg, *w_ple; unsigned char* ws;
        __device__ __forceinline__ XT operator()(int r) const { XT x; const float* nog = nullptr;
            XT_SEG(w_br, 1024, 2048, 0, (bf16*)(ws + WS_WBR), 0, 1024, nog)
            XT_SEG(w_bm, 1024, 1024, 0, (bf16*)(ws + WS_WBM), 0, 1024, nog)
            XT_SEG(w_o, 1024, 1024, 0, (bf16*)(ws + WS_WO), 0, 1024, nog)
            XT_SEG(w_up, 4096, 1024, 0, (bf16*)(ws + WS_WUP), 0, 4096, g_mlp)
            XT_SEG(w_down, 1024, 4096, 0, (bf16*)(ws + WS_WDOWN), 0, 1024, nog)
            XT_SEG(w_pg, 1024, 1024, 0, (bf16*)(ws + WS_WPG), 0, 1024, g_ple)
            XT_SEG(w_ple, 1024, 256, 0, (bf16*)(ws + WS_WPLE), 0, 1024, nog)
            x.src = w_br; x.dst = (bf16*)(ws + WS_WBR); x.gain = nullptr; x.ldw = 1024; x.K = 2048; return x; } };
    { const Dec1 d{w_br, w_bm, w_o, g_mlp, w_up, w_down, g_ple, w_pg, w_ple, F.ws}; xt_run(F, 32 * 8 + 16 * 8 * 2 + 16 * 32 + 64 * 8 + 16 * 8 + 4 * 8, d); }
    { bf16* PB = (bf16*)(F.ws + WS_PB);
      for (int e = F.vcu * 512 + F.tid; e < MTOK * 256 / 8; e += F.G * 512) { const f32x4 a = *(const GAS f32x4*)(p + (size_t)e * 8), b = *(const GAS f32x4*)(p + (size_t)e * 8 + 4);
          *(GAS v4u*)(PB + (size_t)e * 8) = (v4u){pk2(a.x, a.y), pk2(a.z, a.w), pk2(b.x, b.y), pk2(b.z, b.w)}; } }
}

typedef float f32x16 __attribute__((ext_vector_type(16)));
typedef unsigned u32x2 __attribute__((ext_vector_type(2)));
typedef short v4i16_t __attribute__((ext_vector_type(4)));
__device__ __forceinline__ int crow(int r, int hi) { return (r & 3) + 8 * (r >> 2) + 4 * hi; }
typedef __bf16 bf16x2m_t __attribute__((ext_vector_type(2)));
__device__ __forceinline__ unsigned cvtpk(float lo, float hi) { f32x2 v = {lo, hi}; bf16x2m_t b = __builtin_convertvector(v, bf16x2m_t); return __builtin_bit_cast(unsigned, b); }
__device__ __forceinline__ bf16x8 pack8f(const f32x16& p, int b) { v4u w = {cvtpk(p[b], p[b + 1]), cvtpk(p[b + 2], p[b + 3]), cvtpk(p[b + 4], p[b + 5]), cvtpk(p[b + 6], p[b + 7])}; return __builtin_bit_cast(bf16x8, w); }
__device__ __forceinline__ float bf2f(bf16 v) { return __uint_as_float((unsigned)v << 16); }
__device__ __forceinline__ float log2_gamma(int h) { return __builtin_amdgcn_logf(1.0f - __builtin_amdgcn_exp2f(-5.0f - (float)h)); }


__device__ __forceinline__ void phase_r0p(Frame& F) {
    const bf16* RQ = (const bf16*)(F.ws + WS_RQ); bf16* RK = (bf16*)(F.ws + WS_RK);
    const int lane = F.lane, w = F.wave, l31 = lane & 31, hi = lane >> 5, tq = w & 3, dh = w >> 2;
    for (int unit = F.vcu; unit < 512; unit += F.G) {
        const int bh = unit >> 5, c = unit & 31, h = bh & 3; const size_t blk = (size_t)bh * 32 + c;
        const float lg2 = log2_gamma(h);
        bf16x8 qf[16];
#pragma unroll
        for (int ks = 0; ks < 16; ++ks) qf[ks] = *(const bf16x8*)(RQ + ((blk * 32 + 2 * ks + hi) * 128 + 32 * tq + l31) * 8);
        f32x16 s[2] = {};
#pragma unroll
        for (int x = 0; x < 2; ++x) { const int tb = 2 * dh + x;
            if (tb <= tq) {
#pragma unroll
                for (int ks = 0; ks < 16; ++ks) { const bf16x8 kf = *(const bf16x8*)(RK + ((blk * 32 + 2 * ks + hi) * 128 + 32 * tb + l31) * 8); s[x] = __builtin_amdgcn_mfma_f32_32x32x16_bf16(kf, qf[ks], s[x], 0, 0, 0); }
#pragma unroll
                for (int r = 0; r < 16; ++r) { const int d = (32 * tq + l31) - (32 * tb + crow(r, hi)); s[x][r] = d >= 0 ? s[x][r] * __builtin_amdgcn_exp2f((float)d * lg2) : 0.f; }
            } }
        VM_WAIT(); __syncthreads();
#pragma unroll
        for (int x = 0; x < 2; ++x) { const int tb = 2 * dh + x;
            if (tb <= tq) {
#pragma unroll
                for (int g = 0; g < 4; ++g) *(u32x2*)(RK + ((blk * 32 + 4 * tb + g) * 128 + 32 * tq + l31) * 8 + 4 * hi) = (u32x2){cvtpk(s[x][4 * g], s[x][4 * g + 1]), cvtpk(s[x][4 * g + 2], s[x][4 * g + 3])};
            } }
    }
}
__device__ __forceinline__ void phase_r1p(Frame& F) {
    const bf16* RQ = (const bf16*)(F.ws + WS_RQ); const bf16* RP = (const bf16*)(F.ws + WS_RK); const bf16* RKDT = (const bf16*)(F.ws + WS_RKDT); const bf16* RVT = (const bf16*)(F.ws + WS_RVT); bf16* RO = (bf16*)F.out;
    float* ssqp = (float*)(F.ws + WS_SSQP);
    const int lane = F.lane, w = F.wave, l15 = lane & 15, lq = lane >> 4;
    constexpr int SROW = 528, SBUF = 32 * SROW;
    LAS unsigned char* ost = F.lds + 2 * SBUF + 1024 + w * 1024;
    const int nkp = (w >> 1) + 1;
    for (int unit = F.vcu; unit < 256; unit += F.G) {
        const int bh = unit >> 4, j = unit & 15, b = bh >> 2, h = bh & 3;
        const float lg2 = log2_gamma(h), gC = __builtin_amdgcn_exp2f(128.0f * lg2);
        float qd[4];
#pragma unroll
        for (int i = 0; i < 4; ++i) qd[i] = __builtin_amdgcn_exp2f((float)(16 * w + 4 * lq + i + 1) * lg2);
        f32x4 S[2][2];
#pragma unroll
        for (int mb = 0; mb < 2; ++mb)
#pragma unroll
            for (int nb = 0; nb < 2; ++nb) S[mb][nb] = (f32x4){0.f, 0.f, 0.f, 0.f};
        __syncthreads();
#pragma unroll
        for (int mb = 0; mb < 2; ++mb)
#pragma unroll
            for (int nb = 0; nb < 2; ++nb) *(LAS u32x2*)(F.lds + (16 * nb + l15) * SROW + (32 * w + 16 * mb + 4 * lq) * 2) = (u32x2){0u, 0u};
        const bf16* qp = RQ + (((size_t)bh * 32 * 32 + lq) * 128 + 16 * w + l15) * 8;
        const bf16* pp = RP + (((size_t)bh * 32 * 32 + lq) * 128 + 16 * w + l15) * 8;
        const bf16* kp = RKDT + (((size_t)bh * 32 * 16 + lq) * 256 + 32 * w + l15) * 8;
        const bf16* vp = RVT + (((size_t)bh * 32 * 16 + (F.tid >> 5)) * 512 + 32 * j + (F.tid & 31)) * 8;
        constexpr size_t QC = 32 * 128 * 8, QK = 4 * 128 * 8, KC = 16 * 256 * 8, KK = 4 * 256 * 8, VC = 16 * 512 * 8;
        bf16x8 QA[8], PA[4], KA[2][4], vpre;
        LAS unsigned char* vl = F.lds + 2 * SBUF + 1024 + 8 * 1024;
#pragma unroll
        for (int ks = 0; ks < 8; ++ks) QA[ks] = *(const bf16x8*)(qp + QK * ks);
#pragma unroll
        for (int ks = 0; ks < 4; ++ks) { PA[ks] = (bf16x8){0, 0, 0, 0, 0, 0, 0, 0}; if (ks < nkp) PA[ks] = *(const bf16x8*)(pp + QK * ks); }
#pragma unroll
        for (int mb = 0; mb < 2; ++mb)
#pragma unroll
            for (int ks = 0; ks < 4; ++ks) KA[mb][ks] = *(const bf16x8*)(kp + mb * 128 + KK * ks);
        vpre = *(const bf16x8*)vp;
        *(LAS bf16x8*)(vl + F.tid * 16) = vpre;
#pragma unroll 1
        for (int c = 0; c < 32; ++c) {
            const int cur = c & 1, cn = c < 31 ? c + 1 : 31; const size_t tok0 = (size_t)b * SEQ + c * 128;
            __syncthreads();
            vpre = *(const bf16x8*)(vp + VC * cn);
            bf16x8 VB[2][4];
#pragma unroll
            for (int nb = 0; nb < 2; ++nb)
#pragma unroll
                for (int ks = 0; ks < 4; ++ks) VB[nb][ks] = *(const LAS bf16x8*)(vl + cur * 8192 + ((4 * ks + lq) * 32 + 16 * nb + l15) * 16);
            f32x4 oc[2] = {(f32x4){0.f, 0.f, 0.f, 0.f}, (f32x4){0.f, 0.f, 0.f, 0.f}};
#pragma unroll
            for (int ks = 0; ks < 8; ++ks)
#pragma unroll
                for (int nb = 0; nb < 2; ++nb) { const bf16x8 bq = *(const LAS bf16x8*)(F.lds + cur * SBUF + (16 * nb + l15) * SROW + (32 * ks + 8 * lq) * 2);
                    oc[nb] = __builtin_amdgcn_mfma_f32_16x16x32_bf16(QA[ks], bq, oc[nb], 0, 0, 0); }
#pragma unroll
            for (int ks = 0; ks < 8; ++ks) QA[ks] = *(const bf16x8*)(qp + QC * cn + QK * ks);
#pragma unroll
            for (int nb = 0; nb < 2; ++nb)
#pragma unroll
                for (int i = 0; i < 4; ++i) oc[nb][i] *= qd[i];
#pragma unroll
            for (int ks = 0; ks < 4; ++ks)
                if (ks < nkp) {
#pragma unroll
                    for (int nb = 0; nb < 2; ++nb) oc[nb] = __builtin_amdgcn_mfma_f32_16x16x32_bf16(PA[ks], VB[nb][ks], oc[nb], 0, 0, 0); }
#pragma unroll
            for (int ks = 0; ks < 4; ++ks) if (ks < nkp) PA[ks] = *(const bf16x8*)(pp + QC * cn + QK * ks);
#pragma unroll
            for (int mb = 0; mb < 2; ++mb)
#pragma unroll
                for (int nb = 0; nb < 2; ++nb) { S[mb][nb] *= gC;
#pragma unroll
                    for (int ks = 0; ks < 4; ++ks) S[mb][nb] = __builtin_amdgcn_mfma_f32_16x16x32_bf16(KA[mb][ks], VB[nb][ks], S[mb][nb], 0, 0, 0); }
#pragma unroll
            for (int mb = 0; mb < 2; ++mb)
#pragma unroll
                for (int ks = 0; ks < 4; ++ks) KA[mb][ks] = *(const bf16x8*)(kp + mb * 128 + KC * cn + KK * ks);
#pragma unroll
            for (int i = 0; i < 4; ++i) { float q = 0.f;
#pragma unroll
                for (int nb = 0; nb < 2; ++nb) { const float v = oc[nb][i]; q += v * v; *(LAS unsigned short*)(ost + ((4 * lq + i) * 32 + 16 * nb + l15) * 2) = (unsigned short)f2bf(v); }
                q += __shfl_xor(q, 1); q += __shfl_xor(q, 2); q += __shfl_xor(q, 4); q += __shfl_xor(q, 8);
                if (l15 == 0) ssqp[((tok0 + 16 * w + 4 * lq + i) * 4 + h) * 16 + j] = q; }
            LDS_WAIT();
            { const v4u ov = *(const LAS v4u*)(ost + lane * 16); *(v4u*)(RO + (tok0 + 16 * w + (lane >> 2)) * 2048 + h * 512 + 32 * j + (lane & 3) * 8) = ov; }
            *(LAS bf16x8*)(vl + (cur ^ 1) * 8192 + F.tid * 16) = vpre;
#pragma unroll
            for (int mb = 0; mb < 2; ++mb)
#pragma unroll
                for (int nb = 0; nb < 2; ++nb) *(LAS u32x2*)(F.lds + (cur ^ 1) * SBUF + (16 * nb + l15) * SROW + (32 * w + 16 * mb + 4 * lq) * 2) = (u32x2){cvtpk(S[mb][nb][0], S[mb][nb][1]), cvtpk(S[mb][nb][2], S[mb][nb][3])};
        }
    }
    __syncthreads();
}

namespace attn2 {
typedef float f32x16 __attribute__((ext_vector_type(16)));
typedef short s16x4 __attribute__((ext_vector_type(4)));
constexpr int NW = 8, QBLK = 32, KVBLK = 64, QB = NW * QBLK;
constexpr int QS = 1536, KS = 1536, VS = 1024, OS = 1024;
constexpr int SHM_V = KVBLK * 128 * 2, SHM_K = KVBLK * 512;
constexpr int OFF_V = 0, OFF_K = 2 * SHM_V, OFF_WS = OFF_K + 2 * SHM_K, OFF_QR = OFF_WS + NW * 64 * 4, LDS_NEED = OFF_QR + NW * 4096;
constexpr float THR2 = 8.0f * 1.4426950408889634f;
#define A2_SBAR() __builtin_amdgcn_sched_barrier(0)
__device__ __forceinline__ int v_st(int k, int c) { const int kk = (k & ~0xC) | ((k & 4) << 1) | ((k & 8) >> 1); return ((kk >> 3) * 4 + (c >> 5)) * 512 + ((kk & 7) * 32 + (c & 31)) * 2; }
__device__ __forceinline__ int v_rd_base(int lane) { return ((lane & 3) << 3) | (((lane >> 2) & 3) << 6) | (((lane >> 4) & 1) << 5) | (((lane >> 5) & 1) << 8); }
constexpr int v_rd_off(int d0, int ks, int half) { return d0 * 512 + ks * 4096 + half * 2048; }
__device__ __forceinline__ int crow(int r, int hi) { return (r & 3) + 8 * (r >> 2) + 4 * hi; }
typedef __bf16 bf16x2a_t __attribute__((ext_vector_type(2)));
__device__ __forceinline__ unsigned cvtpk(float lo, float hi) { f32x2 v = {lo, hi}; bf16x2a_t b = __builtin_convertvector(v, bf16x2a_t); return __builtin_bit_cast(unsigned, b); }
__device__ __forceinline__ bf16x8 load8(const bf16* p) { return *reinterpret_cast<const bf16x8*>(p); }
__device__ __forceinline__ void mask_tile(f32x16& p0, f32x16& p1, int dq) {
    const float NEG = -__builtin_inff();
#pragma unroll
    for (int r = 0; r < 16; ++r) { const int c = (r & 3) + 8 * (r >> 2); if (dq - c < 0) p0[r] = NEG; if (dq - c - 32 < 0) p1[r] = NEG; }
}
__device__ __forceinline__ void partialSM(f32x16& p0, f32x16& p1, float& m_reg, float& mn, float& alpha) {
    float pmax = p0[0];
#pragma unroll
    for (int r = 1; r < 16; ++r) pmax = fmaxf(pmax, p0[r]);
#pragma unroll
    for (int r = 0; r < 16; ++r) pmax = fmaxf(pmax, p1[r]);
    { auto rr = __builtin_amdgcn_permlane32_swap(__float_as_uint(pmax), __float_as_uint(pmax), false, false); pmax = fmaxf(__uint_as_float(rr[0]), __uint_as_float(rr[1])); }
    if (__builtin_expect(__all((pmax - m_reg) <= THR2), 1)) { mn = m_reg; alpha = 1.f; }
    else { mn = fmaxf(m_reg, pmax); alpha = __builtin_amdgcn_exp2f(m_reg - mn); m_reg = mn; }
#pragma unroll
    for (int r = 0; r < 16; ++r) { p0[r] -= mn; p1[r] -= mn; }
#pragma unroll
    for (int r = 0; r < 16; ++r) p0[r] = __builtin_amdgcn_exp2f(p0[r]);
}
__device__ __forceinline__ void finishSM(f32x16& p0, f32x16& p1, float alpha, float& l_reg, bf16x8& pa0, bf16x8& pa1, bf16x8& pa2, bf16x8& pa3) {
#pragma unroll
    for (int r = 0; r < 16; ++r) p1[r] = __builtin_amdgcn_exp2f(p1[r]);
    float ps = 0;
#pragma unroll
    for (int r = 0; r < 16; ++r) ps += p0[r];
#pragma unroll
    for (int r = 0; r < 16; ++r) ps += p1[r];
    { auto rr = __builtin_amdgcn_permlane32_swap(__float_as_uint(ps), __float_as_uint(ps), false, false); ps = __uint_as_float(rr[0]) + __uint_as_float(rr[1]); }
    l_reg = l_reg * alpha + ps;
#define A2_PK4(P, B_, OUT) do { unsigned a0 = cvtpk(P[B_+0], P[B_+1]), a1 = cvtpk(P[B_+2], P[B_+3]); unsigned b0 = cvtpk(P[B_+4], P[B_+5]), b1 = cvtpk(P[B_+6], P[B_+7]); \
        auto r0 = __builtin_amdgcn_permlane32_swap(a0, b0, false, false); auto r1 = __builtin_amdgcn_permlane32_swap(a1, b1, false, false); \
        v4u w = {r0[0], r1[0], r0[1], r1[1]}; OUT = __builtin_bit_cast(bf16x8, w); } while (0)
    A2_PK4(p0, 0, pa0); A2_PK4(p0, 8, pa1); A2_PK4(p1, 0, pa2); A2_PK4(p1, 8, pa3);
#undef A2_PK4
}
template <int KB>
__device__ __forceinline__ void qkt(f32x16& p0, f32x16& p1, const char* K_lds, const char* qr_lds, int r32, int hi, const bf16x8* qr) {
    p0 = f32x16{}; p1 = f32x16{};
    const char* kbase = K_lds + KB * SHM_K + r32 * 512; const int x = r32 & 15;
#pragma unroll
    for (int d = 0; d < 12; ++d) { const char* a = kbase + ((((2 * d + hi) & 15) ^ x) << 4) + (d >= 8 ? 256 : 0);
        const bf16x8 b0 = *reinterpret_cast<const bf16x8*>(a), b1 = *reinterpret_cast<const bf16x8*>(a + 32 * 512);
        const bf16x8 q = d < 8 ? qr[d < 8 ? d : 0] : *reinterpret_cast<const bf16x8*>(qr_lds + (((d - 8) * 2 + hi) * 32 + r32) * 16);
        p0 = __builtin_amdgcn_mfma_f32_32x32x16_bf16(b0, q, p0, 0, 0, 0);
        p1 = __builtin_amdgcn_mfma_f32_32x32x16_bf16(b1, q, p1, 0, 0, 0); }
}
template <int VB>
__device__ __forceinline__ void pv_tile(f32x16* o, int vb0, bf16x8 pa0, bf16x8 pa1, bf16x8 pa2, bf16x8 pa3) {
#define A2_TRRD(dst, off) asm volatile("ds_read_b64_tr_b16 %0, %1 offset:%2" : "=&v"(dst) : "v"(vb0), "i"(off) : "memory")
#define A2_PV_D0(d0) do { s16x4 l0, l1, l2, l3, h0, h1, h2, h3; constexpr int b_ = VB * SHM_V + v_rd_off(d0, 0, 0); \
        A2_TRRD(l0, b_); A2_TRRD(h0, b_ + 2048); A2_TRRD(l1, b_ + 4096); A2_TRRD(h1, b_ + 6144); A2_TRRD(l2, b_ + 8192); A2_TRRD(h2, b_ + 10240); A2_TRRD(l3, b_ + 12288); A2_TRRD(h3, b_ + 14336); \
        asm volatile("s_waitcnt lgkmcnt(0)" ::: "memory"); A2_SBAR(); \
        o[d0] = __builtin_amdgcn_mfma_f32_32x32x16_bf16(pa0, (bf16x8){l0[0], l0[1], l0[2], l0[3], h0[0], h0[1], h0[2], h0[3]}, o[d0], 0, 0, 0); \
        o[d0] = __builtin_amdgcn_mfma_f32_32x32x16_bf16(pa1, (bf16x8){l1[0], l1[1], l1[2], l1[3], h1[0], h1[1], h1[2], h1[3]}, o[d0], 0, 0, 0); \
        o[d0] = __builtin_amdgcn_mfma_f32_32x32x16_bf16(pa2, (bf16x8){l2[0], l2[1], l2[2], l2[3], h2[0], h2[1], h2[2], h2[3]}, o[d0], 0, 0, 0); \
        o[d0] = __builtin_amdgcn_mfma_f32_32x32x16_bf16(pa3, (bf16x8){l3[0], l3[1], l3[2], l3[3], h3[0], h3[1], h3[2], h3[3]}, o[d0], 0, 0, 0); } while (0)
    A2_PV_D0(0); A2_PV_D0(1); A2_PV_D0(2); A2_PV_D0(3);
#undef A2_PV_D0
#undef A2_TRRD
}
struct BlockRef { const bf16* Q; const bf16* K; const bf16* V; bf16* O; int P0; };
struct Seam { bf16x8 qr[8]; bf16x8 st_v0, st_v1, st_k0, st_k1, st_k2; };
#define A2_VMW() asm volatile("s_waitcnt vmcnt(0)" ::: "memory")
#define A2_VMWN(n) asm volatile("s_waitcnt vmcnt(%0)" :: "i"(n) : "memory")
#define A2_SLOAD(Kp, Vp, k0) do { S.st_v0 = load8((Vp) + (size_t)((k0) + sr) * VS + sc); S.st_v1 = load8((Vp) + (size_t)((k0) + 32 + sr) * VS + sc); \
        const bf16* kp_ = (Kp) + (size_t)((k0) + krow) * KS + kc * 8; S.st_k0 = load8(kp_); S.st_k1 = load8(kp_ + 64); S.st_k2 = load8(kp_ + 128); } while (0)
#define A2_SWRITE_K(bf) do { *(bf16x8*)(K_lds + (bf) * SHM_K + kw0) = S.st_k0; *(bf16x8*)(K_lds + (bf) * SHM_K + kw1) = S.st_k1; *(bf16x8*)(K_lds + (bf) * SHM_K + kw0 + 256) = S.st_k2; } while (0)
#define A2_SWRITE_V(bf) do { *(bf16x8*)(V_lds + (bf) * SHM_V + vst0) = S.st_v0; *(bf16x8*)(V_lds + (bf) * SHM_V + vst1) = S.st_v1; } while (0)
#define A2_SWRITE(bf) do { A2_SWRITE_V(bf); A2_SWRITE_K(bf); } while (0)
#define A2_IDX int tid = threadIdx.x; asm volatile("" : "+v"(tid)); const int wid = __builtin_amdgcn_readfirstlane(tid >> 6), lane = tid & 63, r32 = lane & 31, hi = lane >> 5; \
    const int sr = tid >> 4, sc = (tid & 15) * 8, krow = tid >> 3, kc = tid & 7, kw0 = krow * 512 + ((kc ^ (krow & 15)) << 4), kw1 = krow * 512 + (((kc + 8) ^ (krow & 15)) << 4); \
    char* V_lds = lds + OFF_V; char* K_lds = lds + OFF_K; (void)lane; (void)r32; (void)hi; (void)sr; (void)sc; (void)V_lds
__device__ __forceinline__ void attn_qfin(const BlockRef& curA, const BlockRef& curB, const int* pos, const float* qn) {
    int tid = threadIdx.x; asm volatile("" : "+v"(tid)); const int wid = __builtin_amdgcn_readfirstlane(tid >> 6), lane = tid & 63, r32 = lane & 31, hi = lane >> 5;
    bf16* qrowA = const_cast<bf16*>(curA.Q) + (size_t)(wid * QBLK + r32) * QS + hi * 8; bf16* qrowB = const_cast<bf16*>(curB.Q) + (size_t)(wid * QBLK + r32) * QS + hi * 8;
    bf16x8 qA[12], qB[12];
#pragma unroll
    for (int d = 0; d < 12; ++d) qA[d] = load8(qrowA + d * 16);
#pragma unroll
    for (int d = 0; d < 12; ++d) qB[d] = load8(qrowB + d * 16);
    const int posA = pos[curA.P0 + wid * QBLK + r32], posB = pos[curB.P0 + wid * QBLK + r32];
#define A2_UNPK(X, W) do { const v4u wv_ = __builtin_bit_cast(v4u, W); const unsigned ww_[4] = {wv_.x, wv_.y, wv_.z, wv_.w}; \
        _Pragma("unroll") for (int e_ = 0; e_ < 4; ++e_) { X[2 * e_] = __uint_as_float(ww_[e_] << 16); X[2 * e_ + 1] = __uint_as_float(ww_[e_] & 0xffff0000u); } } while (0)
#define A2_GAIN(X, D) do { const f32x4 g0_ = *(const f32x4*)(qn + 16 * (D) + 8 * hi), g1_ = *(const f32x4*)(qn + 16 * (D) + 8 * hi + 4); \
        _Pragma("unroll") for (int e_ = 0; e_ < 8; ++e_) X[e_] *= sc * (e_ < 4 ? g0_[e_ & 3] : g1_[e_ & 3]); } while (0)
#define A2_REPK(X) __builtin_bit_cast(bf16x8, (v4u){cvtpk(X[0], X[1]), cvtpk(X[2], X[3]), cvtpk(X[4], X[5]), cvtpk(X[6], X[7])})
#define A2_QFIN(q, qrow, posv) do { float ssq = 0.f; \
    _Pragma("unroll") for (int d = 0; d < 12; ++d) { float x[8]; A2_UNPK(x, q[d]); _Pragma("unroll") for (int e = 0; e < 8; ++e) ssq += x[e] * x[e]; } \
    { auto rr = __builtin_amdgcn_permlane32_swap(__float_as_uint(ssq), __float_as_uint(ssq), false, false); ssq = __uint_as_float(rr[0]) + __uint_as_float(rr[1]); } \
    const float sc = __builtin_amdgcn_rsqf(ssq * (1.0f / 192.0f) + 1e-6f) * C2Q; const double posd = (double)(posv); \
    _Pragma("unroll") for (int d = 0; d < 8; ++d) { float x[8]; A2_UNPK(x, q[d]); A2_GAIN(x, d); *(bf16x8*)(qrow + d * 16) = A2_REPK(x); } \
    _Pragma("unroll") for (int dd = 0; dd < 2; ++dd) { float xa[8], xb[8]; A2_UNPK(xa, q[8 + dd]); A2_UNPK(xb, q[10 + dd]); A2_GAIN(xa, 8 + dd); A2_GAIN(xb, 10 + dd); \
        _Pragma("unroll") for (int e = 0; e < 8; ++e) { const int i = 16 * dd + 8 * hi + e; \
            const float inv = __builtin_amdgcn_exp2f(-(float)(4 * i) * (13.287712379549449f / 128.0f)); \
            double rev = posd * (double)inv * 0.15915494309189535; rev -= __builtin_rint(rev); \
            const float rf = (float)rev, c = __builtin_amdgcn_cosf(rf), s = __builtin_amdgcn_sinf(rf); \
            const float a_ = xa[e], b_ = xb[e]; xa[e] = a_ * c - b_ * s; xb[e] = b_ * c + a_ * s; } \
        *(bf16x8*)(qrow + (8 + dd) * 16) = A2_REPK(xa); *(bf16x8*)(qrow + (10 + dd) * 16) = A2_REPK(xb); } } while (0)
    A2_QFIN(qA, qrowA, posA);
    A2_QFIN(qB, qrowB, posB);
#undef A2_QFIN
#undef A2_UNPK
#undef A2_GAIN
#undef A2_REPK
    asm volatile("s_waitcnt vmcnt(0)" ::: "memory");
}
__device__ __forceinline__ void attn_prime(const BlockRef& cur, char* lds, Seam& S) {
    A2_IDX;
#pragma unroll
    for (int d0 = 0; d0 < 8; ++d0) S.qr[d0] = load8(cur.Q + (size_t)(wid * QBLK + r32) * QS + d0 * 16 + hi * 8);
    A2_SLOAD(cur.K, cur.V, 0); A2_VMW(); A2_SWRITE_K(0);
}
__device__ __forceinline__ void attn_block(const BlockRef& cur, const BlockRef& nxt, char* lds, Seam& S) {
    A2_IDX;
    const int NT = (cur.P0 + QB) / KVBLK;
    const int qlo = cur.P0 + wid * QBLK, qm = qlo + r32 - 4 * hi;
    float* ws = (float*)(lds + OFF_WS) + wid * 64; float* li_l = ws, * al_l = ws + 32;
    char* qr_lds = lds + OFF_QR + wid * 4096;
    float m_reg = -1e30f, l_reg = 0; f32x16 o[4] = {};
    const int vst0 = v_st(sr, sc), vst1 = v_st(32 + sr, sc);
    const int vb0 = (int)(uintptr_t)V_lds + v_rd_base(lane);
    const bf16* Kh = cur.K; const bf16* Vh = cur.V;
    { bf16x8 t4[4];
#pragma unroll
      for (int d = 0; d < 4; ++d) t4[d] = load8(cur.Q + (size_t)(wid * QBLK + r32) * QS + 128 + d * 16 + hi * 8);
#pragma unroll
      for (int d = 0; d < 4; ++d) *(bf16x8*)(qr_lds + ((d * 2 + hi) * 32 + r32) * 16) = t4[d]; }
    A2_SWRITE_V(0);
    __syncthreads();
    f32x16 p0, p1; float mn, al; bf16x8 pa0, pa1, pa2, pa3;
#define A2_STEP(t, BUF) do { const bool lastt = (t) + 1 >= NT; \
        A2_SBAR(); { const bf16* Kn = lastt ? nxt.K : Kh; const bf16* Vn = lastt ? nxt.V : Vh; const int k0n = lastt ? 0 : ((t) + 1) * KVBLK; A2_SLOAD(Kn, Vn, k0n); } A2_SBAR(); \
        qkt<BUF>(p0, p1, K_lds, qr_lds, r32, hi, S.qr); \
        if (lastt) { A2_SBAR(); _Pragma("unroll") for (int d0 = 0; d0 < 8; ++d0) S.qr[d0] = load8(nxt.Q + (size_t)(wid * QBLK + r32) * QS + d0 * 16 + hi * 8); A2_SBAR(); } \
        { const int kb_ = (t) * KVBLK; if (kb_ + KVBLK - 1 > qlo) mask_tile(p0, p1, qm - kb_); } \
        partialSM(p0, p1, m_reg, mn, al); finishSM(p0, p1, al, l_reg, pa0, pa1, pa2, pa3); \
        if (__any(al < 1.f)) { if (hi == 0) al_l[r32] = al; asm volatile("s_waitcnt lgkmcnt(0)" ::: "memory"); \
            for (int d_ = 0; d_ < 4; ++d_) for (int r = 0; r < 16; ++r) o[d_][r] *= al_l[crow(r, hi)]; } \
        A2_SBAR(); pv_tile<BUF>(o, vb0, pa0, pa1, pa2, pa3); A2_SBAR(); \
        if (lastt) { A2_VMWN(8); A2_SWRITE_K(0); } else { A2_VMW(); A2_SWRITE((BUF) ^ 1); } \
        __syncthreads(); } while (0)
    for (int t = 0; t < NT; t += 2) { A2_STEP(t, 0); A2_STEP(t + 1, 1); }
#undef A2_STEP
    if (hi == 0) li_l[r32] = l_reg; asm volatile("s_waitcnt lgkmcnt(0)" ::: "memory");
    float rli[16];
#pragma unroll
    for (int r = 0; r < 16; ++r) rli[r] = __builtin_amdgcn_rcpf(li_l[crow(r, hi)]);
    bf16* Ow = cur.O + (size_t)(wid * QBLK) * OS;
#pragma unroll
    for (int r = 0; r < 16; ++r) { const int orow = crow(r, hi);
#pragma unroll
        for (int d0 = 0; d0 < 4; ++d0) { const float v = o[d0][r] * rli[r]; const float vn = __shfl_xor(v, 1);
            if ((r32 & 1) == 0) *(unsigned*)(Ow + (size_t)orow * OS + d0 * 32 + r32) = cvtpk(v, vn); } }
    asm volatile("s_waitcnt lgkmcnt(0)" ::: "memory");
}
}
__device__ __forceinline__ attn2::BlockRef attn2_ref(unsigned char* ws, int v, int pass) {
    const int bh = v >> 3, b = bh >> 3, h = bh & 7, x = v & 7, qb = pass ? 15 - x : x;
    attn2::BlockRef r;
    r.Q = (const bf16*)(ws + WS_QP) + ((size_t)b * SEQ + qb * 256) * 1536 + h * 192; r.K = (const bf16*)(ws + WS_KF) + (size_t)b * SEQ * 1536 + h * 192;
    r.V = (const bf16*)(ws + WS_VV) + (size_t)b * SEQ * 1024 + h * 128; r.O = (bf16*)(ws + WS_MO) + ((size_t)b * SEQ + qb * 256) * 1024 + h * 128; r.P0 = qb * 256;
    return r;
}
__device__ __forceinline__ void phase_attn2(Frame& F, char* lds, const int* pos, const float* qn) {
    int L = F.vcu; if (L >= 256) return;
    for (int Lq = L; Lq < 256; Lq += F.G) { const attn2::BlockRef ra = attn2_ref(F.ws, Lq, 0), rb = attn2_ref(F.ws, Lq, 1); attn2::attn_qfin(ra, rb, pos + (size_t)(Lq >> 6) * SEQ, qn); }
    attn2::Seam S; int pass = 0;
    attn2::BlockRef cur = attn2_ref(F.ws, L, 0);
    attn2::attn_prime(cur, lds, S);
    for (;;) {
        const bool more_pass = pass == 0, more_item = L + F.G < 256, last = !more_pass && !more_item;
        int passn = pass + 1, Ln = L;
        if (!more_pass) { passn = 0; Ln = more_item ? L + F.G : L; }
        const attn2::BlockRef nxt = last ? cur : attn2_ref(F.ws, Ln, passn);
        attn2::attn_block(cur, nxt, lds, S);
        if (last) break;
        cur = nxt; pass = passn; L = Ln;
    }
}

static_assert(pg8::EpiKVup::O_KF == WS_KF && pg8::EpiKVup::O_VV == WS_VV && pg8::EpiKVup::O_KR == WS_KR && pg8::EpiKVup::O_SSQ_CKV == WS_SMALL + SM_SSQ_CKV && pg8::EpiKVup::O_SSQ_KR == WS_SMALL + SM_SSQ_KR, "EpiKVup offsets");
#ifndef MK_N_LAUNCHES
#define MK_N_LAUNCHES 12
#endif
constexpr int N_PHASES = 12;
constexpr int N_LAUNCHES = MK_N_LAUNCHES;
struct Args { const float* in[21]; float* out; unsigned char* ws; int ph_lo, ph_hi; };
#define PG8_SP2 true
#define PG8_ALIGN true
template <class Epi> __device__ __forceinline__ void run_gemm(Frame& F, const pg8::bf16_t* A, int lda, const pg8::bf16_t* Bt, int ldb, int N, int K, const Epi& E) {
    __syncthreads();
    pg8::Gemm g{A, Bt, MTOK, N, K, lda, ldb}; pg8::StaticOrder S; S.init(MTOK, N, F.G, (int)blockIdx.x);
    pg8::gemm_phase<Epi, pg8::StaticOrder, PG8_ALIGN, PG8_SP2>(F.lds + RING_OFF, g, S, E);
}
__global__ void __launch_bounds__(NWAVES * 64, 2) mk_fwd(Args args) {
    extern __shared__ __attribute__((aligned(16))) unsigned char lds[];
    Frame F;
    F.lds = (LAS unsigned char*)lds; F.MISC = (volatile LAS unsigned*)(F.lds + MISC_OFF);
    F.tid = threadIdx.x; F.lane = F.tid & 63; F.wave = __builtin_amdgcn_readfirstlane(F.tid >> 6);
    F.G = gridDim.x; { const int bx = blockIdx.x; F.vcu = (F.G % 8 == 0) ? (bx % 8) * (F.G / 8) + bx / 8 : bx; }
    F.out = args.out; F.ws = args.ws;
    unsigned char* ws = args.ws;
    if (F.tid < 32) F.MISC[F.tid] = 0u;
    __syncthreads();
    XcdBarrier bar; bar.bar = (unsigned*)(ws + WS_CTL) + CW_BAR; bar.x = 0; bar.st = nullptr;
    if (N_LAUNCHES == 1) bar = xcd_barrier_post((unsigned*)(ws + WS_CTL) + CW_BAR, F.MISC + 8);
    const int lo = args.ph_lo, hi = args.ph_hi;
#ifndef PH_MASK
#define PH_MASK 0xfff
#endif
#define IN(k) (((PH_MASK >> (k)) & 1) && lo <= (k) && (k) < hi)
#define SEAM(k) do { asm volatile("; SEAM_MARK %0" :: "i"(k)); if (IN(k) && IN((k) + 1)) xcd_barrier(bar); } while (0)
#define PH_IDX() do { int t_ = threadIdx.x; asm volatile("" : "+v"(t_)); F.tid = t_; F.lane = t_ & 63; F.wave = __builtin_amdgcn_readfirstlane(t_ >> 6); } while (0)
#ifdef STRETCH_MASK
#define PH_T0() PH_IDX(); const unsigned long long t0_ = __builtin_amdgcn_s_memrealtime()
#define PH_STRETCH(k) do { if ((STRETCH_MASK >> (k)) & 1) { const unsigned long long t1_ = __builtin_amdgcn_s_memrealtime(); const unsigned long long d_ = (t1_ - t0_) * STRETCH_MULT; while (__builtin_amdgcn_s_memrealtime() - t1_ < d_) __builtin_amdgcn_s_sleep(8); } } while (0)
#else
#define PH_T0() PH_IDX()
#define PH_STRETCH(k) do {} while (0)
#endif
    float* sm = (float*)(ws + WS_SMALL);
    const float* rstdx = sm + SM_RSTDX / 4; float* ssq_cq = sm + SM_SSQ_CQ / 4; float* ssq_ckv = sm + SM_SSQ_CKV / 4; float* ssq1 = sm + SM_SSQ1 / 4; float* ssq2 = sm + SM_SSQ2 / 4;
    typedef pg8::bf16_t b16;
    b16* WinT = (b16*)(ws + WS_WIN); b16* XB = (b16*)(ws + WS_XB); b16* LATb = (b16*)(ws + WS_LAT); b16* ROb = (b16*)args.out;

    if (IN(0)) { PH_T0(); phase_p0(F, args.in[0], (const int*)args.in[2], args.in[3], args.in[4], args.in[6], args.in[7], args.in[8], args.in[9]); PH_STRETCH(0); } SEAM(0);
    if (IN(1)) { PH_T0();
        pg8::EpiInProj E{rstdx, (const pg8::f32x4*)(ws + WS_CS), (b16*)(ws + WS_RQ), (b16*)(ws + WS_RK), (b16*)(ws + WS_RKDT), (b16*)(ws + WS_RVT), LATb, ssq_cq, (PG8_LAS unsigned char*)(F.lds + XS_OFF),
                          (b16*)(ws + WS_KR), sm + SM_SSQ_KR / 4, args.in[11]};
        run_gemm(F, XB, 1024, WinT + (size_t)4096 * 1024, 1024, NIN1, 1024, E);
    PH_STRETCH(1); } SEAM(1);
    if (IN(2)) { PH_T0(); phase_r0p(F);
    PH_STRETCH(2); } SEAM(2);
    if (IN(3)) { PH_T0(); phase_r1p(F); PH_STRETCH(3); } SEAM(3);
    if (IN(4)) { PH_T0();
        { pg8::EpiRetGate E{ROb, rstdx, (const float*)(ws + WS_SSQP), args.in[5]}; run_gemm(F, XB, 1024, WinT + (size_t)2048 * 1024, 1024, 2048, 1024, E); }
        asm volatile("; SEAM_MARK 41");
        { pg8::EpiRowAct<0> E{(b16*)(ws + WS_QP), 1536, ssq_cq, 1.0f / 384.0f}; run_gemm(F, LATb, LATW, (const b16*)(ws + WS_WUQ), 384, 1536, 384, E); }
        asm volatile("; SEAM_MARK 42");
        { pg8::EpiKVup E{ws, args.in[11], (PG8_LAS float*)(F.lds + XS_OFF)}; run_gemm(F, LATb + 384, LATW, (const b16*)(ws + WS_WUKV), 256, 2048, 256, E); }
    PH_STRETCH(4); } SEAM(4);
    if (IN(5)) { PH_T0(); phase_attn2(F, (char*)lds, (const int*)args.in[2], args.in[10]); PH_STRETCH(5); } SEAM(5);
    if (IN(6)) { PH_T0();
        phase_late_weights(F, args.in[1], args.in[12], args.in[13], args.in[14], args.in[15], args.in[16], args.in[17], args.in[18], args.in[19], args.in[20]);
        { pg8::EpiRowAct<1> E{(b16*)(ws + WS_SG), 2048, rstdx, 0.f}; run_gemm(F, XB, 1024, WinT, 1024, 2048, 1024, E); }
    PH_STRETCH(6); } SEAM(6);
    if (IN(7)) { PH_T0();
        { pg8::EpiGateMix<0> E{(b16*)(ws + WS_TM), (const b16*)(ws + WS_SG), 0}; run_gemm(F, ROb, 2048, (const b16*)(ws + WS_WBR), 2048, 1024, 2048, E); }
        VM_WAIT(); __syncthreads(); __builtin_amdgcn_fence(__ATOMIC_ACQUIRE, "agent"); VM_WAIT(); __syncthreads();
        { pg8::EpiGateMix<1> E{(b16*)(ws + WS_TM), (const b16*)(ws + WS_SG), 1024}; run_gemm(F, (const b16*)(ws + WS_MO), 1024, (const b16*)(ws + WS_WBM), 1024, 1024, 1024, E); }
    PH_STRETCH(7); } SEAM(7);
    if (IN(8)) { PH_T0(); pg8::EpiResid<false> E{(const void*)args.in[0], XB, ssq1}; run_gemm(F, (const b16*)(ws + WS_TM), 1024, (const b16*)(ws + WS_WO), 1024, 1024, 1024, E); PH_STRETCH(8); } SEAM(8);
    if (IN(9)) { PH_T0(); pg8::EpiRowAct<2> E{(b16*)(ws + WS_H), 4096, ssq1, 1.0f / 1024.0f}; run_gemm(F, XB, 1024, (const b16*)(ws + WS_WUP), 1024, 4096, 1024, E); PH_STRETCH(9); } SEAM(9);
    if (IN(10)) { PH_T0(); pg8::EpiResid<true> E{(const void*)XB, XB, ssq2}; run_gemm(F, (const b16*)(ws + WS_H), 4096, (const b16*)(ws + WS_WDOWN), 4096, 1024, 4096, E); PH_STRETCH(10); } SEAM(10);
    if (IN(11)) { PH_T0();
        { pg8::EpiRowAct<1> E{(b16*)(ws + WS_GT), 1024, ssq2, 1.0f / 1024.0f}; run_gemm(F, XB, 1024, (const b16*)(ws + WS_WPG), 1024, 1024, 1024, E); }
        VM_WAIT(); __syncthreads(); __builtin_amdgcn_fence(__ATOMIC_ACQUIRE, "agent"); VM_WAIT(); __syncthreads();
        { pg8::EpiFinal E{args.out, (const b16*)(ws + WS_GT), XB}; run_gemm(F, (const b16*)(ws + WS_PB), 256, (const b16*)(ws + WS_WPLE), 256, 1024, 256, E); }
    PH_STRETCH(11); }
#undef IN
#undef SEAM
}


#ifdef DUMPK
struct DumpArgs { const unsigned* reg[6]; unsigned nw[6]; unsigned* out; int own; int pad; };
__global__ void dump_hash(DumpArgs d) {
    for (unsigned i = blockIdx.x * blockDim.x + threadIdx.x; i < (unsigned)MTOK * DM; i += gridDim.x * blockDim.x) {
        float s = 0.f;
        if (d.own) { const unsigned w = d.out[i]; s += __uint_as_float(w << 16) + __uint_as_float(w & 0xffff0000u); }
        for (int r = 0; r < 6; ++r) if (d.reg[r] && i < d.nw[r] * 2u) { const unsigned short v = ((const unsigned short*)d.reg[r])[i]; s += __uint_as_float((unsigned)v << 16); }
        ((float*)d.out)[i] = s;
    }
}
#endif
extern "C" void kernel_launch(void* const* d_in, const int* in_sizes, int n_in, void* d_out, int out_size, void* d_ws, size_t ws_size, hipStream_t stream) {
    static int grid = 0;
    if (grid == 0) {
        if (n_in != 21 || in_sizes[0] != MTOK * DM || out_size != MTOK * DM || ws_size < WS_END) { fprintf(stderr, "kernel_launch: unexpected shapes (n_in %d in0 %d out %d ws %zu)\n", n_in, n_in > 0 ? in_sizes[0] : -1, out_size, ws_size); grid = -1; return; }
        int dev = 0, cus = 0, per_cu = 0;
        if (hipGetDevice(&dev) != hipSuccess || hipDeviceGetAttribute(&cus, hipDeviceAttributeMultiprocessorCount, dev) != hipSuccess) { grid = -1; return; }
        if (hipFuncSetAttribute((const void*)mk_fwd, hipFuncAttributeMaxDynamicSharedMemorySize, LDS_BYTES) != hipSuccess) { fprintf(stderr, "kernel_launch: hipFuncSetAttribute failed\n"); grid = -1; return; }
        if (hipOccupancyMaxActiveBlocksPerMultiprocessor(&per_cu, (const void*)mk_fwd, NWAVES * 64, LDS_BYTES) != hipSuccess || per_cu < 1) { fprintf(stderr, "kernel_launch: occupancy query says %d workgroups per CU\n", per_cu); (void)hipGetLastError(); grid = -1; return; }
        grid = cus;
    }
    if (grid < 0) return;
    (void)hipMemsetAsync((char*)d_ws + WS_CTL, 0, CTL_ZERO_BYTES, stream);
    Args a{};
    for (int i = 0; i < 21; ++i) a.in[i] = (const float*)d_in[i];
    a.out = (float*)d_out; a.ws = (unsigned char*)d_ws;
    if (N_LAUNCHES == 1) { a.ph_lo = 0; a.ph_hi = N_PHASES; hipLaunchKernelGGL(mk_fwd, dim3(grid), dim3(NWAVES * 64), LDS_BYTES, stream, a); }
    else for (int ph = 0; ph < N_PHASES; ++ph) {
#ifdef DUMPK
        if (ph > DUMPK) break;
#endif
        a.ph_lo = ph; a.ph_hi = ph + 1; hipLaunchKernelGGL(mk_fwd, dim3(grid), dim3(NWAVES * 64), LDS_BYTES, stream, a); }
#ifdef DUMPK
    { DumpArgs d{}; d.out = (unsigned*)d_out; d.own = DUMP_OWN; const size_t offs[6] = DUMP_OFFS; const size_t len[6] = DUMP_LENS;
      for (int r = 0; r < 6; ++r) if (len[r]) { d.reg[r] = (const unsigned*)((const char*)d_ws + offs[r]); d.nw[r] = (unsigned)(len[r] / 4); }
      hipLaunchKernelGGL(dump_hash, dim3(2048), dim3(256), 0, stream, d); }
#endif
}
```

```cpp
#define MK_N_LAUNCHES 1
#include <hip/hip_runtime.h>
#include <hip/hip_bf16.h>
#include <cstdio>
#include <cstdint>
namespace pg8 {
#define PG8_LAS __attribute__((address_space(3)))
typedef unsigned short bf16_t;
typedef short bf16x8 __attribute__((ext_vector_type(8)));
typedef float f32x4 __attribute__((ext_vector_type(4)));
typedef unsigned u32x4 __attribute__((ext_vector_type(4)));
constexpr int BM = 256, BK = 64, HALF = 128, HTB = HALF * BK * 2  , STAGE_BYTES = 8 * HTB, NXCD = 8, WGM = 8;

__host__ __device__ __forceinline__ int lds_byte(int r, int c) { const int st = (r >> 4) * 2 + (c >> 5), rr = r & 15, cc = c & 31, ob = rr * 64 + cc * 2; return st * 1024 + (ob ^ (((ob >> 9) & 1) << 5)); }
__host__ __device__ __forceinline__ void stage_rc(int b, int& R, int& C) { const int st = b / 1024, sb = b % 1024, swz = sb ^ (((sb >> 9) & 1) << 5); R = (st >> 1) * 16 + swz / 64; C = (st & 1) * 32 + (swz % 64) / 2; }
__host__ __device__ __forceinline__ int perm32(int rho) { const int n = rho >> 4, i = rho & 15; return 8 * (i >> 2) + 4 * n + (i & 3); }

struct Unit { int pm, pn; };
struct Gemm { const bf16_t* A; const bf16_t* Bt; int M, N, K, lda, ldb; };

struct StaticOrder {
    int nM, nN, nwg, G, c;
    __host__ __device__ void init(int M, int N, int G_, int c_) { nM = M / BM; nN = N / BM; nwg = nM * nN; G = G_; c = c_; }
    __host__ __device__ bool next(int i, Unit& u) const {
        const long L = (long)i * G + c; if (L >= nwg) return false;
        int wgid = (int)L; { const int q = nwg / NXCD, r = nwg % NXCD, xcd = wgid % NXCD, off = wgid / NXCD; wgid = (xcd < r ? xcd * (q + 1) : r * (q + 1) + (xcd - r) * q) + off; }
        const int nig = WGM * nN, gid = wgid / nig, fm = gid * WGM, gsz = (nM - fm) < WGM ? (nM - fm) : WGM;
        u.pm = fm + ((wgid % nig) % gsz); u.pn = (wgid % nig) / gsz; return true;
    }
    __device__ __forceinline__ void a_ready(const Unit&) const {}
    __device__ __forceinline__ void done(const Unit&) const {}
};


typedef float f32x2 __attribute__((ext_vector_type(2)));
typedef unsigned u32x2 __attribute__((ext_vector_type(2)));
typedef __bf16 bf16x2_t __attribute__((ext_vector_type(2)));
__device__ __forceinline__ unsigned cvt_pk_bf16(float lo, float hi) { f32x2 v = {lo, hi}; bf16x2_t b = __builtin_convertvector(v, bf16x2_t); return __builtin_bit_cast(unsigned, b); }
__device__ __forceinline__ float bflo(unsigned w) { return __uint_as_float(w << 16); }
__device__ __forceinline__ float bfhi(unsigned w) { return __uint_as_float(w & 0xffff0000u); }
__device__ __forceinline__ u32x4 pack8(const float (&v)[8]) { u32x4 w; w.x = cvt_pk_bf16(v[0], v[1]); w.y = cvt_pk_bf16(v[2], v[3]); w.z = cvt_pk_bf16(v[4], v[5]); w.w = cvt_pk_bf16(v[6], v[7]); return w; }
__device__ __forceinline__ void unpack8(const u32x4 w, float (&v)[8]) { v[0] = bflo(w.x); v[1] = bfhi(w.x); v[2] = bflo(w.y); v[3] = bfhi(w.y); v[4] = bflo(w.z); v[5] = bfhi(w.z); v[6] = bflo(w.w); v[7] = bfhi(w.w); }
__device__ __forceinline__ float sigmoidf_(float x) { return __builtin_amdgcn_rcpf(1.0f + __builtin_amdgcn_exp2f(-1.4426950408889634f * x)); }
constexpr float RMS_EPS_ = 1e-6f;
typedef _Float16 h2x4_t __attribute__((ext_vector_type(8)));
__device__ __forceinline__ void rope8(const void* csm, unsigned row, unsigned i0, float (&c)[8], float (&s)[8]) {
    const h2x4_t* p = (const h2x4_t*)csm + (row * 8u + (i0 >> 2)); const h2x4_t a = p[0], b = p[1];
#pragma unroll
    for (int e = 0; e < 4; ++e) { c[e] = (float)a[2 * e]; s[e] = (float)a[2 * e + 1]; c[4 + e] = (float)b[2 * e]; s[4 + e] = (float)b[2 * e + 1]; }
}
__device__ __forceinline__ void st16(bf16_t* p, const u32x4 v) {
#ifdef ST_SC1
    asm volatile("global_store_dwordx4 %0, %1, off sc1\n\ts_nop 1" :: "v"(p), "v"(v) : "memory");
#else
    *(u32x4*)p = v;
#endif
}

#define EPI_ACC8(v, ai, bj, m) float v[8]; { const f32x4 a0_ = acc[ai][bj][m][0], a1_ = acc[ai][bj][m][1]; v[0] = a0_[0]; v[1] = a0_[1]; v[2] = a0_[2]; v[3] = a0_[3]; v[4] = a1_[0]; v[5] = a1_[1]; v[6] = a1_[2]; v[7] = a1_[3]; }

__device__ __forceinline__ void xpose_store(PG8_LAS unsigned char* st, const unsigned (&pk)[4][4], bf16_t* dst, int R, int lane, int fr, int fq) {
#pragma unroll
    for (int pass = 0; pass < 2; ++pass) {
        if ((fq >> 1) == pass) {
#pragma unroll
            for (int m = 0; m < 4; ++m)
#pragma unroll
                for (int q = 0; q < 4; ++q) { const unsigned w = pk[m][q]; const int c = (fq & 1) * 8 + 2 * q;
                    *(PG8_LAS unsigned short*)(st + c * 144 + (16 * m + fr) * 2) = (unsigned short)(w & 0xffffu);
                    *(PG8_LAS unsigned short*)(st + (c + 1) * 144 + (16 * m + fr) * 2) = (unsigned short)(w >> 16); }
        }
        asm volatile("s_waitcnt lgkmcnt(0)" ::: "memory");
#pragma unroll
        for (int k = 0; k < 2; ++k) { const int idx = lane + 64 * k, c = idx & 15, ch = idx >> 4;
            const u32x4 v = *(const PG8_LAS u32x4*)(st + c * 144 + ch * 16);
            *(u32x4*)(dst + ((size_t)ch * R + pass * 16 + c) * 8) = v; }
        asm volatile("s_waitcnt lgkmcnt(0)" ::: "memory");
    }
}

struct EpiInProj {
    static constexpr bool PERM = true, AFTER_DRAIN = false, TWICE_OK = false; static __device__ __forceinline__ bool twice(const Unit& u) { return u.pn < 16; }
    const float* rstdx; const f32x4* cs;
    bf16_t *RQ, *RK, *RKDT, *RVT, *LAT; float *ssq_lat;   PG8_LAS unsigned char* xs;
    bf16_t* KR; float* ssq_kr; const float* k_norm; const void* csm;
    __device__ __forceinline__ void operator()(const f32x4 (&acc)[2][2][4][2], const Unit& u, int wr, int wc, int fr, int fq) const {
        const int pn = u.pn, lane = fq * 16 + fr, wid = wr * 4 + wc;
        PG8_LAS unsigned char* st = xs + wid * 2304;
        const int rowt = u.pm * BM + wr * 64 + fr;
        const int bidx = (u.pm * BM) >> 12, s0 = (u.pm * BM) & 4095;
        if (pn < 8) {
            const bool isk = pn >= 4; const int head = pn & 3;
            const float lg2 = __builtin_amdgcn_logf(1.0f - __builtin_amdgcn_exp2f(-5.0f - (float)head));
            float kd[4];
#pragma unroll
            for (int m = 0; m < 4; ++m) kd[m] = __builtin_amdgcn_exp2f((float)(127 - (wr * 64 + m * 16 + fr)) * lg2);
            bf16_t* O = isk ? RK : RQ;
#pragma unroll
            for (int ai = 0; ai < 2; ++ai) {
                unsigned pk0[4][4], pk1[4][4];
#pragma unroll
                for (int m = 0; m < 4; ++m) {
                    const int row = rowt + ai * HALF + m * 16; const float rs = rstdx[row] * (isk ? 0.0625f : 1.0f);
                    const f32x4* cp = cs + ((unsigned)row * 64u + (unsigned)(wc * 16 + fq * 4));
                    const f32x4 c0 = cp[0], c1 = cp[1], c2 = cp[2], c3 = cp[3];
                    const float cc[8] = {c0[0], c0[2], c1[0], c1[2], c2[0], c2[2], c3[0], c3[2]}, ss[8] = {c0[1], c0[3], c1[1], c1[3], c2[1], c2[3], c3[1], c3[3]};
                    EPI_ACC8(x1, ai, 0, m); EPI_ACC8(x2, ai, 1, m);
                    float o1[8], o2[8];
#pragma unroll
                    for (int e = 0; e < 8; ++e) { const float a = x1[e] * rs, b = x2[e] * rs; o1[e] = a * cc[e] - b * ss[e]; o2[e] = b * cc[e] + a * ss[e]; }
                    bf16_t* rp = O + ((((size_t)(bidx * 4 + head) * 32 + (s0 >> 7) + ai) * 32 + wc * 4 + fq) * 128 + wr * 64 + m * 16 + fr) * 8;
                    *(u32x4*)rp = pack8(o1); *(u32x4*)(rp + (size_t)16 * 128 * 8) = pack8(o2);
                    if (isk) {
#pragma unroll
                        for (int q = 0; q < 4; ++q) { pk0[m][q] = cvt_pk_bf16(o1[2 * q] * kd[m], o1[2 * q + 1] * kd[m]); pk1[m][q] = cvt_pk_bf16(o2[2 * q] * kd[m], o2[2 * q + 1] * kd[m]); }
                    }
                }
                if (isk) {
                    bf16_t* d0 = RKDT + ((((size_t)(bidx * 4 + head) * 32 + (s0 >> 7) + ai) * 16 + wr * 8) * 256 + wc * 32) * 8;
                    xpose_store(st, pk0, d0, 256, lane, fr, fq);
                    xpose_store(st, pk1, d0 + (size_t)HALF * 8, 256, lane, fr, fq);
                }
            }
        } else if (pn < 16) {
            const int head = (pn - 8) >> 1, dvb = ((pn - 8) & 1) * 256;
#pragma unroll
            for (int ai = 0; ai < 2; ++ai)
#pragma unroll
                for (int bj = 0; bj < 2; ++bj) {
                    unsigned pk[4][4];
#pragma unroll
                    for (int m = 0; m < 4; ++m) { const float rs = rstdx[rowt + ai * HALF + m * 16]; EPI_ACC8(v, ai, bj, m);
#pragma unroll
                        for (int q = 0; q < 4; ++q) pk[m][q] = cvt_pk_bf16(v[2 * q] * rs, v[2 * q + 1] * rs); }
                    bf16_t* d0 = RVT + ((((size_t)(bidx * 4 + head) * 32 + (s0 >> 7) + ai) * 16 + wr * 8) * 512 + dvb + bj * HALF + wc * 32) * 8;
                    xpose_store(st, pk, d0, 512, lane, fr, fq);
                }
        } else if (pn < 19) {
            const int lt = pn - 16;
#pragma unroll
            for (int ai = 0; ai < 2; ++ai)
#pragma unroll
                for (int m = 0; m < 4; ++m) { const int row = rowt + ai * HALF + m * 16; const float rs = rstdx[row];
#pragma unroll
                    for (int bj = 0; bj < 2; ++bj) { if (lt == 2 && bj == 1) continue;
                        EPI_ACC8(v, ai, bj, m); float q = 0.f;
#pragma unroll
                        for (int e = 0; e < 8; ++e) { v[e] *= rs; q += v[e] * v[e]; }
                        *(u32x4*)(LAT + ((unsigned)row * 640u + lt * 256 + bj * HALF + wc * 32 + 8 * fq)) = pack8(v);
                        const int kind = (lt == 0) ? 0 : (lt == 1 ? (bj == 0 ? 0 : 1) : 1);
                        q += __shfl_xor(q, 16); q += __shfl_xor(q, 32); if (fq == 0) atomicAdd(ssq_lat + kind * 16384 + row, q); } }
        } else if (wc == 0) {
#pragma unroll
            for (int ai = 0; ai < 2; ++ai)
#pragma unroll
                for (int m = 0; m < 4; ++m) { const int row = rowt + ai * HALF + m * 16; const float rs = rstdx[row];
                    float q = 0.f; unsigned w1[4], w2[4]; const h2x4_t* cp = (const h2x4_t*)csm + ((unsigned)row * 8u + 2u * (unsigned)fq);
#pragma unroll
                    for (int hh = 0; hh < 2; ++hh) { const f32x4 xa = acc[ai][0][m][hh] * rs, xb = acc[ai][1][m][hh] * rs; const f32x4 ga = *(const f32x4*)(k_norm + 128 + 8 * fq + 4 * hh), gb = *(const f32x4*)(k_norm + 160 + 8 * fq + 4 * hh);
                        const h2x4_t t4 = cp[hh]; float oa[4], ob[4];
#pragma unroll
                        for (int e = 0; e < 4; ++e) { q += xa[e] * xa[e] + xb[e] * xb[e]; const float ya = xa[e] * ga[e], yb = xb[e] * gb[e], c_ = (float)t4[2 * e], s_ = (float)t4[2 * e + 1];
                            oa[e] = ya * c_ - yb * s_; ob[e] = yb * c_ + ya * s_; }
                        w1[2 * hh] = cvt_pk_bf16(oa[0], oa[1]); w1[2 * hh + 1] = cvt_pk_bf16(oa[2], oa[3]); w2[2 * hh] = cvt_pk_bf16(ob[0], ob[1]); w2[2 * hh + 1] = cvt_pk_bf16(ob[2], ob[3]); }
                    *(u32x4*)(KR + ((unsigned)row * 64u + 8u * fq)) = (u32x4){w1[0], w1[1], w1[2], w1[3]}; *(u32x4*)(KR + ((unsigned)row * 64u + 32u + 8u * fq)) = (u32x4){w2[0], w2[1], w2[2], w2[3]};
                    q += __shfl_xor(q, 16); q += __shfl_xor(q, 32); if (fq == 0) ssq_kr[row] = q;
                    asm volatile("" ::: "memory"); }
        }
    }
};

struct EpiKVup {
    static constexpr bool PERM = true, AFTER_DRAIN = false, TWICE_OK = false; static __device__ __forceinline__ bool twice(const Unit&) { return false; }
    unsigned char* ws; const float* k_norm; PG8_LAS float* xr;
    static constexpr size_t O_KF = (size_t)142 << 20, O_VV = (size_t)190 << 20, O_KR = ((size_t)22 << 20) + (512 << 10), O_SSQ_CKV = ((size_t)1 << 20) + (128 << 10), O_SSQ_KR = ((size_t)1 << 20) + (320 << 10);
    __device__ __forceinline__ void operator()(const f32x4 (&acc)[2][2][4][2], const Unit& u, int wr, int wc, int fr, int fq) const {
        const unsigned rowt = u.pm * BM + wr * 64 + fr, head = u.pn, d0 = wc * 32 + 8 * fq;
        bf16_t* KF = (bf16_t*)(ws + O_KF); bf16_t* VV = (bf16_t*)(ws + O_VV); const bf16_t* KR = (const bf16_t*)(ws + O_KR); const float* ssq_ckv = (const float*)(ws + O_SSQ_CKV); const float* ssq_kr = (const float*)(ws + O_SSQ_KR);
        float rs8[2][4], kr8[2][4];
#pragma unroll
        for (int ai = 0; ai < 2; ++ai)
#pragma unroll
            for (int m = 0; m < 4; ++m) { rs8[ai][m] = __builtin_amdgcn_rsqf(ssq_ckv[rowt + ai * HALF + m * 16] * (1.0f / 256.0f) + RMS_EPS_); kr8[ai][m] = ssq_kr[rowt + ai * HALF + m * 16]; }
#pragma unroll
        for (int ai = 0; ai < 2; ++ai)
#pragma unroll
            for (int m = 0; m < 4; ++m) { const float rs = rs8[ai][m];
                const f32x4 a0 = acc[ai][0][m][0] * rs, a1 = acc[ai][0][m][1] * rs;
                float q = (a0[0] * a0[0] + a0[1] * a0[1]) + (a0[2] * a0[2] + a0[3] * a0[3]) + (a1[0] * a1[0] + a1[1] * a1[1]) + (a1[2] * a1[2] + a1[3] * a1[3]);
                q += __shfl_xor(q, 16); q += __shfl_xor(q, 32);
                if (fq == 0) xr[(ai * HALF + wr * 64 + m * 16 + fr) * 4 + wc] = q; }
        asm volatile("s_waitcnt lgkmcnt(0)\n\ts_barrier" ::: "memory");
        const f32x4 g0 = *(const f32x4*)(k_norm + d0), g1 = *(const f32x4*)(k_norm + d0 + 4);
#pragma unroll
        for (int ai = 0; ai < 2; ++ai)
#pragma unroll
            for (int m = 0; m < 4; ++m) { const unsigned row = rowt + ai * HALF + m * 16; const float rs = rs8[ai][m];
                const f32x4 p4 = *(const PG8_LAS f32x4*)(xr + (ai * HALF + wr * 64 + m * 16 + fr) * 4);
                const float sk = __builtin_amdgcn_rsqf(((p4[0] + p4[1]) + (p4[2] + p4[3]) + kr8[ai][m]) * (1.0f / 192.0f) + RMS_EPS_), rk = rs * sk;
                { EPI_ACC8(v, ai, 0, m);
#pragma unroll
                  for (int e = 0; e < 8; ++e) v[e] *= rk * (e < 4 ? g0[e & 3] : g1[e & 3]);
                  *(u32x4*)(KF + (row * 1536u + head * 192u + d0)) = pack8(v); }
                { EPI_ACC8(v, ai, 1, m);
#pragma unroll
                  for (int e = 0; e < 8; ++e) v[e] *= rs;
                  *(u32x4*)(VV + (row * 1024u + head * 128u + d0)) = pack8(v); }
                { const u32x2 kr = *(const u32x2*)(KR + (row * 64u + 16 * wc + 4 * fq));
                  *(u32x2*)(KF + (row * 1536u + head * 192u + 128 + 16 * wc + 4 * fq)) = (u32x2){cvt_pk_bf16(bflo(kr.x) * sk, bfhi(kr.x) * sk), cvt_pk_bf16(bflo(kr.y) * sk, bfhi(kr.y) * sk)}; } }
    }
};

struct EpiQup {
    static constexpr bool PERM = true, AFTER_DRAIN = false, TWICE_OK = false; static __device__ __forceinline__ bool twice(const Unit&) { return false; }
    bf16_t* QP; const float* ssq_cq; const float* q_norm; const void* csm; PG8_LAS float* xr; float c2q;
    __device__ __forceinline__ void operator()(const f32x4 (&acc)[2][2][4][2], const Unit& u, int wr, int wc, int fr, int fq) const {
        const unsigned rowt = u.pm * BM + wr * 64 + fr, head = u.pn;
#pragma unroll
        for (int ai = 0; ai < 2; ++ai)
#pragma unroll
            for (int m = 0; m < 4; ++m) { const float rs = __builtin_amdgcn_rsqf(ssq_cq[rowt + ai * HALF + m * 16] * (1.0f / 384.0f) + RMS_EPS_);
                const f32x4 a0 = acc[ai][0][m][0] * rs, a1 = acc[ai][0][m][1] * rs, b0 = acc[ai][1][m][0] * rs, b1 = acc[ai][1][m][1] * rs;
                float q = ((a0[0] * a0[0] + a0[1] * a0[1]) + (a0[2] * a0[2] + a0[3] * a0[3])) + ((a1[0] * a1[0] + a1[1] * a1[1]) + (a1[2] * a1[2] + a1[3] * a1[3]))
                        + ((b0[0] * b0[0] + b0[1] * b0[1]) + (b0[2] * b0[2] + b0[3] * b0[3])) + ((b1[0] * b1[0] + b1[1] * b1[1]) + (b1[2] * b1[2] + b1[3] * b1[3]));
                q += __shfl_xor(q, 16); q += __shfl_xor(q, 32);
                if (fq == 0) xr[(ai * HALF + wr * 64 + m * 16 + fr) * 4 + wc] = q; }
        asm volatile("s_waitcnt lgkmcnt(0)\n\ts_barrier" ::: "memory");
        const unsigned dA = wc < 3 ? wc * 32 + 8 * fq : 128 + 8 * fq, dB = wc == 0 ? 96 + 8 * fq : 160 + 8 * fq;
        const f32x4 gA0 = *(const f32x4*)(q_norm + dA), gA1 = *(const f32x4*)(q_norm + dA + 4), gB0 = *(const f32x4*)(q_norm + dB), gB1 = *(const f32x4*)(q_norm + dB + 4);
#pragma unroll
        for (int ai = 0; ai < 2; ++ai)
#pragma unroll
            for (int m = 0; m < 4; ++m) { const unsigned row = rowt + ai * HALF + m * 16; const float rs = __builtin_amdgcn_rsqf(ssq_cq[row] * (1.0f / 384.0f) + RMS_EPS_);
                const f32x4 p4 = *(const PG8_LAS f32x4*)(xr + (ai * HALF + wr * 64 + m * 16 + fr) * 4);
                const float sc = __builtin_amdgcn_rsqf(((p4[0] + p4[1]) + (p4[2] + p4[3])) * (1.0f / 192.0f) + RMS_EPS_) * rs * c2q;
                EPI_ACC8(va, ai, 0, m); EPI_ACC8(vb, ai, 1, m);
#pragma unroll
                for (int e = 0; e < 8; ++e) { va[e] *= sc * (e < 4 ? gA0[e & 3] : gA1[e & 3]); vb[e] *= sc * (e < 4 ? gB0[e & 3] : gB1[e & 3]); }
                bf16_t* qrow = QP + (row * 1536u + head * 192u);
                if (wc == 3) {
                    float cc[8], sn[8]; rope8(csm, row, 8 * fq, cc, sn);
#pragma unroll
                    for (int e = 0; e < 8; ++e) { const float a_ = va[e], b_ = vb[e]; va[e] = a_ * cc[e] - b_ * sn[e]; vb[e] = b_ * cc[e] + a_ * sn[e]; }
                }
                *(u32x4*)(qrow + dA) = pack8(va);
                if (wc == 0 || wc == 3) *(u32x4*)(qrow + dB) = pack8(vb); }
    }
};

template <int MODE> struct EpiRowAct {
    static constexpr bool PERM = true, AFTER_DRAIN = false, TWICE_OK = false; static __device__ __forceinline__ bool twice(const Unit&) { return true; }
    bf16_t* O; int ldo; const float* rsrc; float inv_dim;
    __device__ __forceinline__ void operator()(const f32x4 (&acc)[2][2][4][2], const Unit& u, int wr, int wc, int fr, int fq) const {
        const int rowt = u.pm * BM + wr * 64 + fr, colt = u.pn * BM + wc * 32 + 8 * fq;
#pragma unroll
        for (int ai = 0; ai < 2; ++ai)
#pragma unroll
            for (int m = 0; m < 4; ++m) { const int row = rowt + ai * HALF + m * 16; const float r0 = rsrc[row]; const float rs = inv_dim == 0.f ? r0 : __builtin_amdgcn_rsqf(r0 * inv_dim + RMS_EPS_);
#pragma unroll
                for (int bj = 0; bj < 2; ++bj) { EPI_ACC8(v, ai, bj, m);
#pragma unroll
                    for (int e = 0; e < 8; ++e) { float x = v[e] * rs; if (MODE == 1) x = sigmoidf_(x); if (MODE == 2) { x = fmaxf(x, 0.f); x = x * x; } v[e] = x; }
                    st16(O + (size_t)row * ldo + colt + bj * HALF, pack8(v)); } }
    }
};
struct EpiRetGate {
    static constexpr bool PERM = true, AFTER_DRAIN = false, TWICE_OK = false; static __device__ __forceinline__ bool twice(const Unit&) { return false; }
    bf16_t* RO; const float* rstdx; const float* ssq_ro; const float* ret_norm;
    __device__ __forceinline__ void operator()(const f32x4 (&acc)[2][2][4][2], const Unit& u, int wr, int wc, int fr, int fq) const {
        const int rowt = u.pm * BM + wr * 64 + fr, colt = u.pn * BM + wc * 32 + 8 * fq, head = u.pn >> 1;
        f32x4 g[2][2];
#pragma unroll
        for (int bj = 0; bj < 2; ++bj) { g[bj][0] = *(const f32x4*)(ret_norm + colt + bj * HALF); g[bj][1] = *(const f32x4*)(ret_norm + colt + bj * HALF + 4); }
#pragma unroll
        for (int ai = 0; ai < 2; ++ai)
#pragma unroll
            for (int m = 0; m < 4; ++m) { const int row = rowt + ai * HALF + m * 16; const float rs = rstdx[row]; const f32x4* sp = (const f32x4*)(ssq_ro + ((size_t)row * 4 + head) * 16); const f32x4 s4 = (sp[0] + sp[1]) + (sp[2] + sp[3]);
                const float rr = __builtin_amdgcn_rsqf(((s4[0] + s4[1]) + (s4[2] + s4[3])) * (1.0f / 512.0f) + RMS_EPS_);
#pragma unroll
                for (int bj = 0; bj < 2; ++bj) { EPI_ACC8(v, ai, bj, m); bf16_t* p = RO + (size_t)row * 2048 + colt + bj * HALF; float o[8]; unpack8(*(const u32x4*)p, o);
#pragma unroll
                    for (int e = 0; e < 8; ++e) { const float x = v[e] * rs; const float gg = e < 4 ? g[bj][0][e & 3] : g[bj][1][e & 3]; v[e] = o[e] * rr * gg * x * sigmoidf_(x); }
                    *(u32x4*)p = pack8(v); } }
    }
};
template <int MODE> struct EpiGateMix {
    static constexpr bool PERM = true, AFTER_DRAIN = false, TWICE_OK = false; static __device__ __forceinline__ bool twice(const Unit&) { return false; }
    bf16_t* TM; const bf16_t* SG; int sgoff;
    __device__ __forceinline__ void operator()(const f32x4 (&acc)[2][2][4][2], const Unit& u, int wr, int wc, int fr, int fq) const {
        const int rowt = u.pm * BM + wr * 64 + fr, colt = u.pn * BM + wc * 32 + 8 * fq;
#pragma unroll
        for (int ai = 0; ai < 2; ++ai)
#pragma unroll
            for (int m = 0; m < 4; ++m) { const int row = rowt + ai * HALF + m * 16;
#pragma unroll
                for (int bj = 0; bj < 2; ++bj) { EPI_ACC8(v, ai, bj, m); float s[8]; unpack8(*(const u32x4*)(SG + (size_t)row * 2048 + sgoff + colt + bj * HALF), s);
                    bf16_t* p = TM + (size_t)row * 1024 + colt + bj * HALF;
                    if (MODE == 1) { float t[8]; unpack8(*(const u32x4*)p, t);
#pragma unroll
                        for (int e = 0; e < 8; ++e) v[e] = t[e] + s[e] * v[e]; }
                    else {
#pragma unroll
                        for (int e = 0; e < 8; ++e) v[e] = s[e] * v[e]; }
                    *(u32x4*)p = pack8(v); } }
    }
};
template <bool RESB> struct EpiResid {
    static constexpr bool PERM = true, AFTER_DRAIN = false, TWICE_OK = false; static __device__ __forceinline__ bool twice(const Unit&) { return false; }
    const void* res; bf16_t* xb; float* ssq;
    __device__ __forceinline__ void operator()(const f32x4 (&acc)[2][2][4][2], const Unit& u, int wr, int wc, int fr, int fq) const {
        const int rowt = u.pm * BM + wr * 64 + fr, colt = u.pn * BM + wc * 32 + 8 * fq;
#pragma unroll
        for (int ai = 0; ai < 2; ++ai)
#pragma unroll
            for (int m = 0; m < 4; ++m) { const int row = rowt + ai * HALF + m * 16; float q = 0.f;
#pragma unroll
                for (int bj = 0; bj < 2; ++bj) { EPI_ACC8(v, ai, bj, m); const size_t off = (size_t)row * 1024 + colt + bj * HALF;
                    if (RESB) { float r[8]; unpack8(*(const u32x4*)((const bf16_t*)res + off), r);
#pragma unroll
                        for (int e = 0; e < 8; ++e) { v[e] += r[e]; q += v[e] * v[e]; } }
                    else { const f32x4 r0 = *(const f32x4*)((const float*)res + off), r1 = *(const f32x4*)((const float*)res + off + 4);
#pragma unroll
                        for (int e = 0; e < 8; ++e) { v[e] += e < 4 ? r0[e & 3] : r1[e & 3]; q += v[e] * v[e]; } }
                    *(u32x4*)(xb + off) = pack8(v); }
                q += __shfl_xor(q, 16); q += __shfl_xor(q, 32); if (fq == 0) atomicAdd(ssq + row, q);
                if (m & 1) asm volatile("" ::: "memory"); }
    }
};
struct EpiFinal {
    static constexpr bool PERM = true, AFTER_DRAIN = false, TWICE_OK = false; static __device__ __forceinline__ bool twice(const Unit&) { return false; }
    float* out; const bf16_t* GT; const bf16_t* xb;
    __device__ __forceinline__ void operator()(const f32x4 (&acc)[2][2][4][2], const Unit& u, int wr, int wc, int fr, int fq) const {
        const int rowt = u.pm * BM + wr * 64 + fr, colt = u.pn * BM + wc * 32 + 8 * fq;
#pragma unroll
        for (int ai = 0; ai < 2; ++ai)
#pragma unroll
            for (int m = 0; m < 4; ++m) { const int row = rowt + ai * HALF + m * 16;
#pragma unroll
                for (int bj = 0; bj < 2; ++bj) { EPI_ACC8(v, ai, bj, m); const size_t off = (size_t)row * 1024 + colt + bj * HALF; float gt[8], r[8]; unpack8(*(const u32x4*)(GT + off), gt); unpack8(*(const u32x4*)(xb + off), r);
#pragma unroll
                    for (int e = 0; e < 8; ++e) v[e] = r[e] + gt[e] * v[e];
                    *(f32x4*)(out + off) = (f32x4){v[0], v[1], v[2], v[3]}; *(f32x4*)(out + off + 4) = (f32x4){v[4], v[5], v[6], v[7]}; }
                if (m & 1) asm volatile("" ::: "memory"); }
    }
};
template <class Epi, class Sched, bool ALIGN_EPI = false, bool SP2 = false>
__device__ __forceinline__ void gemm_phase(PG8_LAS unsigned char* lds, const Gemm g, const Sched& S, const Epi& E) {
    int tid = threadIdx.x; asm volatile("" : "+v"(tid));
    const int wid = __builtin_amdgcn_readfirstlane(tid >> 6), lane = tid & 63, wr = wid >> 2, wc = wid & 3, fr = lane & 15, fq = lane >> 4;
    int K = g.K; if (g.K < 512) asm volatile("" : "+s"(K));
    const int nt = K / BK;
    unsigned voffA[2], voffB[2];
#pragma unroll
    for (int i = 0; i < 2; ++i) { int R, C; stage_rc(tid * 16 + i * 8192, R, C); const int Rb = Epi::PERM ? ((R & ~31) + perm32(R & 31)) : R;
        voffA[i] = (unsigned)(R * g.lda + C) * 2u; voffB[i] = (unsigned)(Rb * g.ldb + C) * 2u; }
    const size_t kstep = (size_t)(BK * 2);
    const size_t hstepA = (size_t)HALF * g.lda * 2, hstepB = (size_t)HALF * g.ldb * 2;
    const size_t tstepA = 2 * hstepA, tstepB = 2 * hstepB;
    const unsigned ldsw = (unsigned)wid * 1024u;
    const int aoff = lds_byte(wr * 64 + fr, fq * 8), boff = lds_byte(wc * 32 + fr, fq * 8);
#define PG8_SA(b, h) (((b) * 2 + (h)) * HTB)
#define PG8_SB(b, h) ((4 + (b) * 2 + (h)) * HTB)
#define PG8_STAGE(bufoff, gbase, voff) do { _Pragma("unroll") for (int _i = 0; _i < 2; ++_i) \
        __builtin_amdgcn_global_load_lds((const unsigned*)((const char*)(gbase) + (voff)[_i]), (PG8_LAS unsigned*)(lds + (bufoff) + ldsw + _i * 8192), 16, 0, 0); } while (0)
#define PG8_LDA(dst, b, h) do { _Pragma("unroll") for (int m = 0; m < 4; ++m) _Pragma("unroll") for (int k = 0; k < 2; ++k) dst[m][k] = *(const PG8_LAS bf16x8*)(lds + PG8_SA(b, h) + aoff + m * 2048 + k * 1024); } while (0)
#define PG8_LDB(dst, b, h) do { _Pragma("unroll") for (int n = 0; n < 2; ++n) _Pragma("unroll") for (int k = 0; k < 2; ++k) dst[n][k] = *(const PG8_LAS bf16x8*)(lds + PG8_SB(b, h) + boff + n * 2048 + k * 1024); } while (0)
#define PG8_MMA(ai, bj, At, Bt) do { __builtin_amdgcn_s_setprio(1); _Pragma("unroll") for (int m = 0; m < 4; ++m) _Pragma("unroll") for (int n = 0; n < 2; ++n) _Pragma("unroll") for (int k = 0; k < 2; ++k) \
        acc[ai][bj][m][n] = __builtin_amdgcn_mfma_f32_16x16x32_bf16(Bt[n][k], At[m][k], acc[ai][bj][m][n], 0, 0, 0); __builtin_amdgcn_s_setprio(0); } while (0)
#define PG8_WAIT_V(n) asm volatile("s_waitcnt vmcnt(" #n ")" ::: "memory")
#define PG8_WAIT_L(n) asm volatile("s_waitcnt lgkmcnt(" #n ")" ::: "memory")
#define PG8_BAR __builtin_amdgcn_s_barrier()
#define PG8_SCHED __builtin_amdgcn_sched_barrier(0)
    Unit cur, nxt; int ui = 0;
    if (!S.next(0, cur)) return;
    f32x4 acc[2][2][4][2];
#pragma unroll
    for (int a = 0; a < 2; ++a)
#pragma unroll
        for (int b = 0; b < 2; ++b)
#pragma unroll
            for (int m = 0; m < 4; ++m)
#pragma unroll
                for (int n = 0; n < 2; ++n) acc[a][b][m][n] = (f32x4){0.f, 0.f, 0.f, 0.f};
    bf16x8 At[4][2], B0[2][2], B1[2][2];
    const char* cA = (const char*)g.A + (size_t)cur.pm * tstepA; const char* cB = (const char*)g.Bt + (size_t)cur.pn * tstepB;
    S.a_ready(cur);
    if constexpr (SP2) {
        PG8_STAGE(PG8_SB(0, 0), cB, voffB); PG8_STAGE(PG8_SB(0, 1), cB + hstepB, voffB); PG8_STAGE(PG8_SA(0, 0), cA, voffA); PG8_STAGE(PG8_SA(0, 1), cA + hstepA, voffA);
        if (wr == 1) PG8_BAR;
        PG8_WAIT_V(2); PG8_BAR;
        PG8_STAGE(PG8_SB(1, 0), cB + kstep, voffB); PG8_STAGE(PG8_SA(1, 0), cA + kstep, voffA); PG8_STAGE(PG8_SB(1, 1), cB + hstepB + kstep, voffB);
        PG8_WAIT_V(6); PG8_BAR;
    } else {
        PG8_STAGE(PG8_SB(0, 0), cB, voffB); PG8_STAGE(PG8_SA(0, 0), cA, voffA); PG8_STAGE(PG8_SB(0, 1), cB + hstepB, voffB); PG8_STAGE(PG8_SA(0, 1), cA + hstepA, voffA);
        if (wr == 1) PG8_BAR;
        PG8_WAIT_V(4); PG8_BAR;
        PG8_STAGE(PG8_SB(1, 0), cB + kstep, voffB); PG8_STAGE(PG8_SA(1, 0), cA + kstep, voffA); PG8_STAGE(PG8_SB(1, 1), cB + hstepB + kstep, voffB);
        PG8_WAIT_V(6); PG8_BAR;
    }
    for (;;) {
        const bool has_next = S.next(ui + 1, nxt);
        const char* nA = has_next ? (const char*)g.A + (size_t)nxt.pm * tstepA : cA; const char* nB = has_next ? (const char*)g.Bt + (size_t)nxt.pn * tstepB : cB;
        for (int t = 0; t < nt; t += 2) {
            const bool last = (t == nt - 2);
            const char* a1 = cA + (size_t)(t + 1) * kstep;
            const char* a2 = last ? nA : cA + (size_t)(t + 2) * kstep; const char* b2 = last ? nB : cB + (size_t)(t + 2) * kstep;
            const char* a3 = a2 + kstep; const char* b3 = b2 + kstep;
            if (last && has_next) S.a_ready(nxt);
            if constexpr (SP2) {
            PG8_LDB(B0, 0, 0); PG8_LDB(B1, 0, 1); PG8_SCHED; PG8_LDA(At, 0, 0); PG8_STAGE(PG8_SA(1, 1), a1 + hstepA, voffA);
            PG8_WAIT_V(8); PG8_WAIT_L(0); PG8_BAR; PG8_MMA(0, 0, At, B0); PG8_MMA(0, 1, At, B1); PG8_BAR; PG8_SCHED;
            PG8_LDA(At, 0, 1); PG8_STAGE(PG8_SB(0, 0), b2, voffB); PG8_STAGE(PG8_SB(0, 1), b2 + hstepB, voffB); PG8_STAGE(PG8_SA(0, 0), a2, voffA);
            PG8_WAIT_V(8); PG8_WAIT_L(0); PG8_BAR; PG8_MMA(1, 0, At, B0); PG8_MMA(1, 1, At, B1); PG8_BAR; PG8_SCHED;
            PG8_LDB(B0, 1, 0); PG8_LDB(B1, 1, 1); PG8_SCHED; PG8_LDA(At, 1, 0); PG8_STAGE(PG8_SA(0, 1), a2 + hstepA, voffA);
            PG8_WAIT_V(8); PG8_WAIT_L(0); PG8_BAR; PG8_MMA(0, 0, At, B0); PG8_MMA(0, 1, At, B1); PG8_BAR; PG8_SCHED;
            PG8_LDA(At, 1, 1); PG8_STAGE(PG8_SB(1, 0), b3, voffB); PG8_STAGE(PG8_SB(1, 1), b3 + hstepB, voffB); PG8_STAGE(PG8_SA(1, 0), a3, voffA);
            PG8_WAIT_V(8); PG8_WAIT_L(0); PG8_BAR; PG8_MMA(1, 0, At, B0); PG8_MMA(1, 1, At, B1); PG8_BAR; PG8_SCHED;
            } else {
            PG8_LDB(B0, 0, 0); PG8_SCHED; PG8_LDA(At, 0, 0); PG8_STAGE(PG8_SA(1, 1), a1 + hstepA, voffA);
            PG8_WAIT_L(8); PG8_BAR; PG8_WAIT_L(0); PG8_MMA(0, 0, At, B0); PG8_BAR; PG8_SCHED;
            PG8_LDB(B1, 0, 1); PG8_STAGE(PG8_SB(0, 0), b2, voffB);
            PG8_BAR; PG8_WAIT_L(0); PG8_MMA(0, 1, At, B1); PG8_BAR;
            PG8_LDA(At, 0, 1); PG8_STAGE(PG8_SA(0, 0), a2, voffA);
            PG8_BAR; PG8_WAIT_L(0); PG8_MMA(1, 0, At, B0); PG8_BAR; PG8_SCHED;
            PG8_STAGE(PG8_SB(0, 1), b2 + hstepB, voffB);
            PG8_WAIT_V(6); PG8_BAR; PG8_MMA(1, 1, At, B1); PG8_BAR;
            PG8_LDB(B0, 1, 0); PG8_SCHED; PG8_LDA(At, 1, 0); PG8_STAGE(PG8_SA(0, 1), a2 + hstepA, voffA);
            PG8_WAIT_L(8); PG8_BAR; PG8_WAIT_L(0); PG8_MMA(0, 0, At, B0); PG8_BAR; PG8_SCHED;
            PG8_LDB(B1, 1, 1); PG8_STAGE(PG8_SB(1, 0), b3, voffB);
            PG8_BAR; PG8_WAIT_L(0); PG8_MMA(0, 1, At, B1); PG8_BAR;
            PG8_LDA(At, 1, 1); PG8_STAGE(PG8_SA(1, 0), a3, voffA);
            PG8_BAR; PG8_WAIT_L(0); PG8_MMA(1, 0, At, B0); PG8_BAR; PG8_SCHED;
            PG8_STAGE(PG8_SB(1, 1), b3 + hstepB, voffB);
            PG8_WAIT_V(6); PG8_BAR; PG8_MMA(1, 1, At, B1); PG8_BAR;
            }
        }
        if constexpr (ALIGN_EPI) { if (wr == 0) PG8_BAR; }
        if constexpr (!Epi::AFTER_DRAIN) { E(acc, cur, wr, wc, fr, fq);
#ifdef EPI_TWICE
            if constexpr (Epi::TWICE_OK) { asm volatile("" ::: "memory"); if (Epi::twice(cur)) E(acc, cur, wr, wc, fr, fq); }
#endif
            S.done(cur); }
        if (!has_next) break;
#pragma unroll
        for (int a = 0; a < 2; ++a)
#pragma unroll
            for (int b = 0; b < 2; ++b)
#pragma unroll
                for (int m = 0; m < 4; ++m)
#pragma unroll
                    for (int n = 0; n < 2; ++n) acc[a][b][m][n] = (f32x4){0.f, 0.f, 0.f, 0.f};
        cur = nxt; cA = nA; cB = nB; ++ui;
        if constexpr (ALIGN_EPI) { if (wr == 1) PG8_BAR; }
    }
    PG8_WAIT_V(0);
    if constexpr (!ALIGN_EPI) { if (wr == 0) PG8_BAR; }
    PG8_BAR;
    if constexpr (Epi::AFTER_DRAIN) { E.fused(acc, cur, wr, wc, fr, fq, lds, wid, lane); S.done(cur); }
#undef PG8_SA
#undef PG8_SB
#undef PG8_STAGE
#undef PG8_LDA
#undef PG8_LDB
#undef PG8_MMA
#undef PG8_WAIT_V
#undef PG8_WAIT_L
#undef PG8_BAR
#undef PG8_SCHED
}
}
#define GAS __attribute__((address_space(1)))
#define LAS __attribute__((address_space(3)))
typedef unsigned short bf16;
typedef unsigned v4u __attribute__((ext_vector_type(4)));
typedef float f32x4 __attribute__((ext_vector_type(4)));
typedef short bf16x8 __attribute__((ext_vector_type(8)));
typedef GAS unsigned gu32;
typedef GAS unsigned long long gu64;
#define RLX_AGENT __ATOMIC_RELAXED, __HIP_MEMORY_SCOPE_AGENT
#define LDS_WAIT() asm volatile("s_waitcnt lgkmcnt(0)" ::: "memory")
#define VM_WAIT() asm volatile("s_waitcnt vmcnt(0)" ::: "memory")
__device__ __forceinline__ unsigned long long rt() { return __builtin_amdgcn_s_memrealtime(); }
__device__ __forceinline__ unsigned f2bf(float f) { unsigned u = __builtin_bit_cast(unsigned, f); return (u + 0x7fffu + ((u >> 16) & 1u)) >> 16; }
__device__ __forceinline__ unsigned pk2(float lo, float hi) { return f2bf(lo) | (f2bf(hi) << 16); }

#define XB_TMO      128
#define XB_XCNT(j)  (256  + 64 * (j))
#define XB_XSUB(j)  (1280 + 64 * (j))
#define XB_XGEN(j)  (2304 + 64 * (j))
#define XB_TOP      3328
#define XB_TOPGEN   3392
#define XCD_BAR_WORDS 3456
#define XB_SPIN_CAP (1u << 18)

__device__ __forceinline__ unsigned xb_ld(unsigned* p)              { return __hip_atomic_load(p, __ATOMIC_RELAXED, __HIP_MEMORY_SCOPE_AGENT); }
__device__ __forceinline__ unsigned xb_add(unsigned* p, unsigned v) { return __hip_atomic_fetch_add(p, v, __ATOMIC_RELAXED, __HIP_MEMORY_SCOPE_AGENT); }
__device__ __forceinline__ unsigned xb_xcc_id() { return (unsigned)__builtin_amdgcn_s_getreg((3 << 11) | 20) & 0xFu; }
#define XB_SPIN(cond, bar) do { unsigned _sp = 0; while (cond) { __builtin_amdgcn_s_sleep(1); \
    if ((++_sp & 255u) == 0u) { if (xb_ld(&(bar)[XB_TMO])) break; if (_sp > XB_SPIN_CAP) { atomicAdd(&(bar)[XB_TMO], 1u); break; } } } } while (0)

struct XcdBarrier {
    unsigned* bar; unsigned x;
    volatile LAS unsigned* st;
};

__device__ __forceinline__ XcdBarrier xcd_barrier_post(unsigned* bar, volatile LAS unsigned* st) {
    XcdBarrier b; b.bar = bar; b.x = xb_xcc_id(); b.st = st;
    if (threadIdx.x == 0) (void)xb_add(&bar[XB_XCNT(b.x)], 1u);
    return b;
}
__device__ __forceinline__ void xcd_barrier_complete(unsigned* bar, unsigned x, unsigned& nloc, unsigned& nx) {
    const unsigned G = gridDim.x * gridDim.y * gridDim.z;
    unsigned sum, cnt, mine, sp = 0u;
    for (;;) {
        sum = 0u; cnt = 0u; mine = 0u;
#pragma unroll
        for (unsigned j = 0; j < 16; ++j) { const unsigned c = xb_ld(&bar[XB_XCNT(j)]); sum += c; cnt += (c > 0u) ? 1u : 0u; mine = (j == x) ? c : mine; }
        if (sum == G) break;
        __builtin_amdgcn_s_sleep(1);
        if ((++sp & 255u) == 0u) { if (xb_ld(&bar[XB_TMO])) break; if (sp > XB_SPIN_CAP) { atomicAdd(&bar[XB_TMO], 1u); break; } }
    }
    nloc = mine > 0u ? mine : 1u; nx = cnt > 0u ? cnt : 1u;
}

__device__ __forceinline__ void xcd_barrier(const XcdBarrier& b) {
    asm volatile("s_waitcnt vmcnt(0)" ::: "memory");
    __syncthreads();
    if (threadIdx.x == 0) {
        unsigned* bar = b.bar;
        __builtin_amdgcn_s_waitcnt(0);
        unsigned nloc = b.st[0], nx = b.st[1];
        if (nloc == 0u) { xcd_barrier_complete(bar, b.x, nloc, nx); b.st[0] = nloc; b.st[1] = nx; }
        const unsigned old = xb_add(&bar[XB_XSUB(b.x)], 1u);
        const unsigned gen = old / nloc;
        if (old + 1u == (gen + 1u) * nloc) {
            __builtin_amdgcn_fence(__ATOMIC_RELEASE, "agent");
            asm volatile("s_waitcnt vmcnt(0)" ::: "memory");
            const unsigned og = xb_add(&bar[XB_TOP], 1u);
            const unsigned tg = og / nx;
            if (og + 1u == (tg + 1u) * nx) xb_add(&bar[XB_TOPGEN], 1u);
            else XB_SPIN(xb_ld(&bar[XB_TOPGEN]) == tg, bar);
            __builtin_amdgcn_fence(__ATOMIC_ACQUIRE, "agent");
            xb_add(&bar[XB_XGEN(b.x)], 1u);
            asm volatile("s_waitcnt vmcnt(0)" ::: "memory");
        } else {
            XB_SPIN(xb_ld(&bar[XB_XGEN(b.x)]) == gen, bar);
            __builtin_amdgcn_fence(__ATOMIC_ACQUIRE, "agent");
            asm volatile("s_waitcnt vmcnt(0)" ::: "memory");
        }
    }
    __syncthreads();
}


typedef float f32x2 __attribute__((ext_vector_type(2)));
constexpr int NWAVES = 8;
constexpr int BATCH = 4, SEQ = 4096, DM = 1024, MTOK = BATCH * SEQ;
constexpr int NIN1 = 5120;
constexpr int LATW = 640;
constexpr float C2Q = 0.07216878364870323f * 1.4426950408889634f;

constexpr size_t MiB = 1u << 20, KiB = 1u << 10;
constexpr size_t WS_CTL = 0, CTL_ZERO_BYTES = 64 * KiB;
constexpr size_t WS_SMALL = 1 * MiB;
constexpr size_t SM_RSTDX = 0, SM_SSQ_CQ = 64 * KiB, SM_SSQ_CKV = 128 * KiB, SM_SSQ1 = 192 * KiB, SM_SSQ2 = 256 * KiB, SM_SSQ_KR = 320 * KiB, SM_END = 384 * KiB;
constexpr size_t WS_WIN = 2 * MiB;
constexpr size_t WS_SSQP = 10 * MiB;
constexpr size_t WS_WUQ = 20 * MiB;
constexpr size_t WS_WUKV = WS_WUQ + (size_t)2048 * 384 * 2;
constexpr size_t WS_KR = 22 * MiB + 512 * KiB;
constexpr size_t WS_XB = 25 * MiB;
constexpr size_t WS_CS = 57 * MiB;
constexpr size_t WS_LAT = 73 * MiB;
constexpr size_t WS_RQ = 94 * MiB, WS_RK = 126 * MiB, WS_RKDT = 158 * MiB, WS_RVT = 190 * MiB;
constexpr size_t WS_QP = 94 * MiB, WS_KF = 142 * MiB, WS_VV = 190 * MiB;
constexpr size_t WS_MO = 57 * MiB;
constexpr size_t WS_SG = 94 * MiB, WS_TM = 158 * MiB;
constexpr size_t WS_WBR = 190 * MiB, WS_WBM = 194 * MiB, WS_WO = 196 * MiB, WS_WUP = 198 * MiB, WS_WDOWN = 206 * MiB, WS_WPG = 214 * MiB, WS_WPLE = 216 * MiB;
constexpr size_t WS_PB = 217 * MiB;
constexpr size_t WS_H = 57 * MiB;
constexpr size_t WS_GT = 57 * MiB;
constexpr size_t WS_CSM = 254 * MiB;
constexpr size_t WS_END = 256 * MiB;
static_assert(SM_SSQ_CKV == SM_SSQ_CQ + 65536, "ssq_lat layout");
static_assert(WS_WIN + (size_t)9216 * 2048 <= WS_WUQ && WS_WUKV + (size_t)2048 * 256 * 2 <= WS_KR && WS_KR + 2 * MiB <= WS_XB && WS_LAT + 20 * MiB <= WS_RQ && WS_RVT + 64 * MiB <= WS_END && WS_H + 128 * MiB <= WS_WBR && WS_PB + 8 * MiB <= WS_END, "d_ws map");
constexpr int CW_BAR = 1024;

constexpr int RING_OFF = 0, RING_BYTES = 131072;
constexpr int XS_OFF = RING_BYTES, XS_BYTES = 8 * 2304;
constexpr int MISC_OFF = XS_OFF + XS_BYTES;
constexpr int LDS_BYTES = 160 * 1024;
static_assert(MISC_OFF + 128 <= LDS_BYTES, "LDS map");

struct Frame {
    LAS unsigned char* lds; volatile LAS unsigned* MISC; int tid, lane, wave, G, vcu;
    float* out; unsigned char* ws;
};
__device__ __forceinline__ float wave_sum(float v) {
#pragma unroll
    for (int o = 1; o < 64; o <<= 1) v += __shfl_xor(v, o);
    return v;
}
__device__ __forceinline__ void p0_transpose_item(const float* W, int ldw, int K, int src_col, bf16* WT, int dst_row, int ncols, const float* gain, LAS float* scr, int item, int lane) {
    const int nblk = ncols / 32, kb = item / nblk, nb = item % nblk, k0 = 64 * kb, n0 = 32 * nb;
#pragma unroll 16
    for (int i = 0; i < 32; ++i) { const int kk = 2 * i + (lane >> 5); const float gk = gain ? gain[k0 + kk] : 1.0f; scr[kk * 33 + (lane & 31)] = W[(size_t)(k0 + kk) * ldw + src_col + n0 + (lane & 31)] * gk; }
    LDS_WAIT(); asm volatile("" ::: "memory");
    const int c = lane & 7;
#pragma unroll
    for (int j = 0; j < 4; ++j) { const int n = (lane >> 3) + 8 * j; const LAS float* s = scr + (8 * c) * 33 + n;
        v4u o; o.x = pk2(s[0 * 33], s[1 * 33]); o.y = pk2(s[2 * 33], s[3 * 33]); o.z = pk2(s[4 * 33], s[5 * 33]); o.w = pk2(s[6 * 33], s[7 * 33]);
        *(GAS v4u*)(WT + (size_t)(dst_row + n0 + n) * K + k0 + 8 * c) = o; }
    LDS_WAIT(); asm volatile("" ::: "memory");
}
struct XT { const float* src; bf16* dst; const float* gain; int ldw, K; };
#define XT_SEG(W_, ldw_, K_, src_, WT_, dst_, ncols_, gain_) { const int n_ = ((K_) / 64) * ((ncols_) / 128); if (r < n_) { const int nblk_ = (ncols_) / 128, kb_ = r / nblk_, nb_ = r - kb_ * nblk_; \
        x.src = (W_) + (size_t)(64 * kb_) * (ldw_) + (src_) + 128 * nb_; x.dst = (WT_) + (size_t)((dst_) + 128 * nb_) * (K_) + 64 * kb_; x.gain = (gain_) ? (gain_) + 64 * kb_ : (const float*)nullptr; x.ldw = (ldw_); x.K = (K_); return x; } r -= n_; }
__device__ __forceinline__ void xt_load(const XT& x, int tid, f32x4 (&v)[4], float (&g)[4]) {
#pragma unroll
    for (int i = 0; i < 4; ++i) { const int row = i * 16 + (tid >> 5); v[i] = *(const GAS f32x4*)(x.src + (size_t)row * x.ldw + 4 * (tid & 31)); g[i] = x.gain ? x.gain[row] : 1.0f; }
}
template <class Dec> __device__ __forceinline__ void xt_run(Frame& F, int ntiles, const Dec& dec) {
    LAS float* scr = (LAS float*)(F.lds + RING_OFF);
    const int tid = F.tid; int t = F.vcu; if (t >= ntiles) return;
    XT cur = dec(t); f32x4 v[4]; float g[4]; xt_load(cur, tid, v, g);
    for (;;) {
        const int tn = t + F.G; const bool has = tn < ntiles; const XT nxt = has ? dec(tn) : cur;
        __syncthreads();
#pragma unroll
        for (int i = 0; i < 4; ++i) *(LAS f32x4*)(scr + (i * 16 + (tid >> 5)) * 132 + 4 * (tid & 31)) = v[i] * g[i];
        if (has) xt_load(nxt, tid, v, g);
        __syncthreads();
        const int n = tid >> 2, kq = tid & 3;
#pragma unroll
        for (int j = 0; j < 2; ++j) { const int kc = kq + 4 * j; const LAS float* s = scr + (8 * kc) * 132 + n;
            v4u o; o.x = pk2(s[0 * 132], s[1 * 132]); o.y = pk2(s[2 * 132], s[3 * 132]); o.z = pk2(s[4 * 132], s[5 * 132]); o.w = pk2(s[6 * 132], s[7 * 132]);
            *(GAS v4u*)(cur.dst + (size_t)n * cur.K + 8 * kc) = o; }
        if (!has) break;
        cur = nxt; t = tn;
    }
    __syncthreads();
}
#define P0_SEG(W, ldw, K, src, WT, dst, ncols, gain) { const int n_ = ((K) / 64) * ((ncols) / 32); if (r < n_) { p0_transpose_item(W, ldw, K, src, WT, dst, ncols, gain, scr, r, F.lane); continue; } r -= n_; }
__device__ __forceinline__ void phase_p0(Frame& F, const float* x, const int* pos, const float* g_mix, const float* w_in, const float* g_qlat, const float* g_kvlat, const float* w_uq, const float* w_ukv) {
    LAS float* scr = (LAS float*)(F.lds + RING_OFF + F.wave * 16384);
    const int gw = F.vcu * NWAVES + F.wave, NGW = F.G * NWAVES;
    bf16* WinT = (bf16*)(F.ws + WS_WIN); bf16* WuqT = (bf16*)(F.ws + WS_WUQ); bf16* WukvT = (bf16*)(F.ws + WS_WUKV);
    struct Dec0 { const float *w_in, *g_mix, *w_uq, *g_qlat, *w_ukv, *g_kvlat; bf16 *WinT, *WuqT, *WukvT;
        __device__ __forceinline__ XT operator()(int r) const { XT x;
            XT_SEG(w_in, 8896, 1024, 6848, WinT, 0, 2048, g_mix)
            XT_SEG(w_in, 8896, 1024, 4096, WinT, 2048, 2048, g_mix)
            XT_SEG(w_in, 8896, 1024, 0, WinT, 4096, 4096, g_mix)
            XT_SEG(w_in, 8896, 1024, 6144, WinT, 8192, 640, g_mix)
            XT_SEG(w_ukv, 2048, 256, 0, WukvT, 0, 2048, g_kvlat)
            x.src = w_in; x.dst = WinT; x.gain = nullptr; x.ldw = 8896; x.K = 1024; return x; } };
    { const Dec0 d{w_in, g_mix, w_uq, g_qlat, w_ukv, g_kvlat, WinT, WuqT, WukvT}; xt_run(F, 16 * 16 * 2 + 16 * 32 + 16 * 5 + 4 * 16, d); }
    for (int it = gw; it < 32 + 8 * 36; it += NGW) {
        int r = it;
        P0_SEG(w_in, 8896, 1024, 6784, WinT, 8960, 32, g_mix)
        P0_SEG(w_in, 8896, 1024, 6816, WinT, 8960 + 128, 32, g_mix)
        { const int hh = r / 36; r -= hh * 36;
          P0_SEG(w_uq, 1536, 384, hh * 192, WuqT, hh * 256, 96, g_qlat)
          P0_SEG(w_uq, 1536, 384, hh * 192 + 128, WuqT, hh * 256 + 96, 32, g_qlat)
          P0_SEG(w_uq, 1536, 384, hh * 192 + 96, WuqT, hh * 256 + 128, 32, g_qlat)
          P0_SEG(w_uq, 1536, 384, hh * 192 + 160, WuqT, hh * 256 + 224, 32, g_qlat) }
    }
    for (int gt = F.vcu * 512 + F.tid; gt < 24576; gt += F.G * 512) { const int hh = gt / 3072, rem = gt - hh * 3072; *(GAS v4u*)((unsigned char*)(WuqT + (size_t)(hh * 256 + 160) * 384) + (size_t)rem * 16) = (v4u){0u, 0u, 0u, 0u}; }
    for (int gt = F.vcu * 512 + F.tid; gt < 40960; gt += F.G * 512) { const int row = gt >> 7, piece = gt & 127; const int wrow = row < 128 ? 8832 + row : (row < 224 ? 8992 + (row - 128) : 9120 + (row - 224));
        *(GAS v4u*)((unsigned char*)(WinT + (size_t)wrow * 1024) + (size_t)piece * 16) = (v4u){0u, 0u, 0u, 0u}; }
    { bf16* XB = (bf16*)(F.ws + WS_XB); float* rstdx = (float*)(F.ws + WS_SMALL + SM_RSTDX);
      for (int m0 = 2 * gw; m0 < MTOK; m0 += 2 * NGW) {
          f32x4 v[2][4]; float s[2] = {0.f, 0.f};
#pragma unroll
          for (int u = 0; u < 2; ++u) { const GAS f32x4* xr = (const GAS f32x4*)(x + (size_t)(m0 + u) * DM) + F.lane;
#pragma unroll
              for (int j = 0; j < 4; ++j) v[u][j] = xr[64 * j]; }
#pragma unroll
          for (int u = 0; u < 2; ++u) {
#pragma unroll
              for (int j = 0; j < 4; ++j) s[u] += (v[u][j].x * v[u][j].x + v[u][j].y * v[u][j].y) + (v[u][j].z * v[u][j].z + v[u][j].w * v[u][j].w);
              s[u] = wave_sum(s[u]);
              GAS unsigned long long* o8 = (GAS unsigned long long*)(XB + (size_t)(m0 + u) * DM) + F.lane;
#pragma unroll
              for (int j = 0; j < 4; ++j) o8[64 * j] = (unsigned long long)pk2(v[u][j].x, v[u][j].y) | ((unsigned long long)pk2(v[u][j].z, v[u][j].w) << 32);
              if (F.lane == 0) rstdx[m0 + u] = 1.0f / sqrtf(s[u] * (1.0f / DM) + 1e-6f); }
      } }
    { f32x2* cs = (f32x2*)(F.ws + WS_CS);
      for (int e = F.vcu * 512 + F.tid; e < MTOK * 128; e += F.G * 512) { const int row = e >> 7, i = e & 127;
          const float inv = __builtin_amdgcn_exp2f(-(float)i * (13.287712379549449f / 128.0f));
          double rev = (double)pos[row] * (double)inv * 0.15915494309189535; rev -= __builtin_rint(rev);
          const float rf = (float)rev; cs[e] = (f32x2){__builtin_amdgcn_cosf(rf), __builtin_amdgcn_sinf(rf)}; } }
    { typedef _Float16 h2_t __attribute__((ext_vector_type(2))); h2_t* csm = (h2_t*)(F.ws + WS_CSM);
      for (int e = F.vcu * 512 + F.tid; e < MTOK * 32; e += F.G * 512) { const int row = e >> 5, i = e & 31;
          const float inv = __builtin_amdgcn_exp2f(-(float)(4 * i) * (13.287712379549449f / 128.0f));
          double rev = (double)pos[row] * (double)inv * 0.15915494309189535; rev -= __builtin_rint(rev);
          const float rf = (float)rev; csm[e] = (h2_t){(_Float16)__builtin_amdgcn_cosf(rf), (_Float16)__builtin_amdgcn_sinf(rf)}; } }
    { float* z = (float*)(F.ws + WS_SMALL + SM_SSQ_CQ); for (int e = F.vcu * 512 + F.tid; e < (int)((SM_END - SM_SSQ_CQ) / 4); e += F.G * 512) z[e] = 0.f; }
}
__device__ __forceinline__ void phase_late_weights(Frame& F, const float* p, const float* w_br, const float* w_bm, const float* w_o, const float* g_mlp, const float* w_up, const float* w_down, const float* g_ple, const float* w_pg, const float* w_ple) {
    struct Dec1 { const float *w_br, *w_bm, *w_o, *g_mlp, *w_up, *w_down, *g_ple, *w_pg, *w_ple; unsigned char* ws;
        __device__ __forceinline__ XT operator()(int r) const { XT x; const float* nog = nullptr;
            XT_SEG(w_br, 1024, 2048, 0, (bf16*)(ws + WS_WBR), 0, 1024, nog)
            XT_SEG(w_bm, 1024, 1024, 0, (bf16*)(ws + WS_WBM), 0, 1024, nog)
            XT_SEG(w_o, 1024, 1024, 0, (bf16*)(ws + WS_WO), 0, 1024, nog)
            XT_SEG(w_up, 4096, 1024, 0, (bf16*)(ws + WS_WUP), 0, 4096, g_mlp)
            XT_SEG(w_down, 1024, 4096, 0, (bf16*)(ws + WS_WDOWN), 0, 1024, nog)
            XT_SEG(w_pg, 1024, 1024, 0, (bf16*)(ws + WS_WPG), 0, 1024, g_ple)
            XT_SEG(w_ple, 1024, 256, 0, (bf16*)(ws + WS_WPLE), 0, 1024, nog)
            x.src = w_br; x.dst = (bf16*)(ws + WS_WBR); x.gain = nullptr; x.ldw = 1024; x.K = 2048; return x; } };
    { const Dec1 d{w_br, w_bm, w_o, g_mlp, w_up, w_down, g_ple, w_pg, w_ple, F.ws}; xt_run(F, 32 * 8 + 16 * 8 * 2 + 16 * 32 + 64 * 8 + 16 * 8 + 4 * 8, d); }
    { bf16* PB = (bf16*)(F.ws + WS_PB);
      for (int e = F.vcu * 512 + F.tid; e < MTOK * 256 / 8; e += F.G * 512) { const f32x4 a = *(const GAS f32x4*)(p + (size_t)e * 8), b = *(const GAS f32x4*)(p + (size_t)e * 8 + 4);
          *(GAS v4u*)(PB + (size_t)e * 8) = (v4u){pk2(a.x, a.y), pk2(a.z, a.w), pk2(b.x, b.y), pk2(b.z, b.w)}; } }
}

typedef float f32x16 __attribute__((ext_vector_type(16)));
typedef unsigned u32x2 __attribute__((ext_vector_type(2)));
typedef short v4i16_t __attribute__((ext_vector_type(4)));
__device__ __forceinline__ int crow(int r, int hi) { return (r & 3) + 8 * (r >> 2) + 4 * hi; }
typedef __bf16 bf16x2m_t __attribute__((ext_vector_type(2)));
__device__ __forceinline__ unsigned cvtpk(float lo, float hi) { f32x2 v = {lo, hi}; bf16x2m_t b = __builtin_convertvector(v, bf16x2m_t); return __builtin_bit_cast(unsigned, b); }
__device__ __forceinline__ bf16x8 pack8f(const f32x16& p, int b) { v4u w = {cvtpk(p[b], p[b + 1]), cvtpk(p[b + 2], p[b + 3]), cvtpk(p[b + 4], p[b + 5]), cvtpk(p[b + 6], p[b + 7])}; return __builtin_bit_cast(bf16x8, w); }
__device__ __forceinline__ float bf2f(bf16 v) { return __uint_as_float((unsigned)v << 16); }
__device__ __forceinline__ float log2_gamma(int h) { return __builtin_amdgcn_logf(1.0f - __builtin_amdgcn_exp2f(-5.0f - (float)h)); }


__device__ __forceinline__ void phase_r0p(Frame& F) {
    const bf16* RQ = (const bf16*)(F.ws + WS_RQ); bf16* RK = (bf16*)(F.ws + WS_RK);
    const int lane = F.lane, w = F.wave, l31 = lane & 31, hi = lane >> 5, tq = w & 3, dh = w >> 2;
    for (int unit = F.vcu; unit < 512; unit += F.G) {
        const int bh = unit >> 5, c = unit & 31, h = bh & 3; const size_t blk = (size_t)bh * 32 + c;
        const float lg2 = log2_gamma(h);
        bf16x8 qf[16];
#pragma unroll
        for (int ks = 0; ks < 16; ++ks) qf[ks] = *(const bf16x8*)(RQ + ((blk * 32 + 2 * ks + hi) * 128 + 32 * tq + l31) * 8);
        f32x16 s[2] = {};
#pragma unroll
        for (int x = 0; x < 2; ++x) { const int tb = 2 * dh + x;
            if (tb <= tq) {
#pragma unroll
                for (int ks = 0; ks < 16; ++ks) { const bf16x8 kf = *(const bf16x8*)(RK + ((blk * 32 + 2 * ks + hi) * 128 + 32 * tb + l31) * 8); s[x] = __builtin_amdgcn_mfma_f32_32x32x16_bf16(kf, qf[ks], s[x], 0, 0, 0); }
#pragma unroll
                for (int r = 0; r < 16; ++r) { const int d = (32 * tq + l31) - (32 * tb + crow(r, hi)); s[x][r] = d >= 0 ? s[x][r] * __builtin_amdgcn_exp2f((float)d * lg2) : 0.f; }
            } }
        VM_WAIT(); __syncthreads();
#pragma unroll
        for (int x = 0; x < 2; ++x) { const int tb = 2 * dh + x;
            if (tb <= tq) {
#pragma unroll
                for (int g = 0; g < 4; ++g) *(u32x2*)(RK + ((blk * 32 + 4 * tb + g) * 128 + 32 * tq + l31) * 8 + 4 * hi) = (u32x2){cvtpk(s[x][4 * g], s[x][4 * g + 1]), cvtpk(s[x][4 * g + 2], s[x][4 * g + 3])};
            } }
    }
}
__device__ __forceinline__ void phase_r1p(Frame& F) {
    const bf16* RQ = (const bf16*)(F.ws + WS_RQ); const bf16* RP = (const bf16*)(F.ws + WS_RK); const bf16* RKDT = (const bf16*)(F.ws + WS_RKDT); const bf16* RVT = (const bf16*)(F.ws + WS_RVT); bf16* RO = (bf16*)F.out;
    float* ssqp = (float*)(F.ws + WS_SSQP);
    const int lane = F.lane, w = F.wave, l15 = lane & 15, lq = lane >> 4;
    constexpr int SROW = 528, SBUF = 32 * SROW;
    LAS unsigned char* ost = F.lds + 2 * SBUF + 1024 + w * 1024;
    const int nkp = (w >> 1) + 1;
    for (int unit = F.vcu; unit < 256; unit += F.G) {
        const int bh = unit >> 4, j = unit & 15, b = bh >> 2, h = bh & 3;
        const float lg2 = log2_gamma(h), gC = __builtin_amdgcn_exp2f(128.0f * lg2);
        float qd[4];
#pragma unroll
        for (int i = 0; i < 4; ++i) qd[i] = __builtin_amdgcn_exp2f((float)(16 * w + 4 * lq + i + 1) * lg2);
        f32x4 S[2][2];
#pragma unroll
        for (int mb = 0; mb < 2; ++mb)
#pragma unroll
            for (int nb = 0; nb < 2; ++nb) S[mb][nb] = (f32x4){0.f, 0.f, 0.f, 0.f};
        __syncthreads();
#pragma unroll
        for (int mb = 0; mb < 2; ++mb)
#pragma unroll
            for (int nb = 0; nb < 2; ++nb) *(LAS u32x2*)(F.lds + (16 * nb + l15) * SROW + (32 * w + 16 * mb + 4 * lq) * 2) = (u32x2){0u, 0u};
        const bf16* qp = RQ + (((size_t)bh * 32 * 32 + lq) * 128 + 16 * w + l15) * 8;
        const bf16* pp = RP + (((size_t)bh * 32 * 32 + lq) * 128 + 16 * w + l15) * 8;
        const bf16* kp = RKDT + (((size_t)bh * 32 * 16 + lq) * 256 + 32 * w + l15) * 8;
        const bf16* vp = RVT + (((size_t)bh * 32 * 16 + (F.tid >> 5)) * 512 + 32 * j + (F.tid & 31)) * 8;
        constexpr size_t QC = 32 * 128 * 8, QK = 4 * 128 * 8, KC = 16 * 256 * 8, KK = 4 * 256 * 8, VC = 16 * 512 * 8;
        bf16x8 QA[8], PA[4], KA[2][4], vpre;
        LAS unsigned char* vl = F.lds + 2 * SBUF + 1024 + 8 * 1024;
#pragma unroll
        for (int ks = 0; ks < 8; ++ks) QA[ks] = *(const bf16x8*)(qp + QK * ks);
#pragma unroll
        for (int ks = 0; ks < 4; ++ks) { PA[ks] = (bf16x8){0, 0, 0, 0, 0, 0, 0, 0}; if (ks < nkp) PA[ks] = *(const bf16x8*)(pp + QK * ks); }
#pragma unroll
        for (int mb = 0; mb < 2; ++mb)
#pragma unroll
            for (int ks = 0; ks < 4; ++ks) KA[mb][ks] = *(const bf16x8*)(kp + mb * 128 + KK * ks);
        vpre = *(const bf16x8*)vp;
        *(LAS bf16x8*)(vl + F.tid * 16) = vpre;
#pragma unroll 1
        for (int c = 0; c < 32; ++c) {
            const int cur = c & 1, cn = c < 31 ? c + 1 : 31; const size_t tok0 = (size_t)b * SEQ + c * 128;
            __syncthreads();
            vpre = *(const bf16x8*)(vp + VC * cn);
            bf16x8 VB[2][4];
#pragma unroll
            for (int nb = 0; nb < 2; ++nb)
#pragma unroll
                for (int ks = 0; ks < 4; ++ks) VB[nb][ks] = *(const LAS bf16x8*)(vl + cur * 8192 + ((4 * ks + lq) * 32 + 16 * nb + l15) * 16);
            f32x4 oc[2] = {(f32x4){0.f, 0.f, 0.f, 0.f}, (f32x4){0.f, 0.f, 0.f, 0.f}};
#pragma unroll
            for (int ks = 0; ks < 8; ++ks)
#pragma unroll
                for (int nb = 0; nb < 2; ++nb) { const bf16x8 bq = *(const LAS bf16x8*)(F.lds + cur * SBUF + (16 * nb + l15) * SROW + (32 * ks + 8 * lq) * 2);
                    oc[nb] = __builtin_amdgcn_mfma_f32_16x16x32_bf16(QA[ks], bq, oc[nb], 0, 0, 0); }
#pragma unroll
            for (int ks = 0; ks < 8; ++ks) QA[ks] = *(const bf16x8*)(qp + QC * cn + QK * ks);
#pragma unroll
            for (int nb = 0; nb < 2; ++nb)
#pragma unroll
                for (int i = 0; i < 4; ++i) oc[nb][i] *= qd[i];
#pragma unroll
            for (int ks = 0; ks < 4; ++ks)
                if (ks < nkp) {
#pragma unroll
                    for (int nb = 0; nb < 2; ++nb) oc[nb] = __builtin_amdgcn_mfma_f32_16x16x32_bf16(PA[ks], VB[nb][ks], oc[nb], 0, 0, 0); }
#pragma unroll
            for (int ks = 0; ks < 4; ++ks) if (ks < nkp) PA[ks] = *(const bf16x8*)(pp + QC * cn + QK * ks);
#pragma unroll
            for (int mb = 0; mb < 2; ++mb)
#pragma unroll
                for (int nb = 0; nb < 2; ++nb) { S[mb][nb] *= gC;
#pragma unroll
                    for (int ks = 0; ks < 4; ++ks) S[mb][nb] = __builtin_amdgcn_mfma_f32_16x16x32_bf16(KA[mb][ks], VB[nb][ks], S[mb][nb], 0, 0, 0); }
#pragma unroll
            for (int mb = 0; mb < 2; ++mb)
#pragma unroll
                for (int ks = 0; ks < 4; ++ks) KA[mb][ks] = *(const bf16x8*)(kp + mb * 128 + KC * cn + KK * ks);
#pragma unroll
            for (int i = 0; i < 4; ++i) { float q = 0.f;
#pragma unroll
                for (int nb = 0; nb < 2; ++nb) { const float v = oc[nb][i]; q += v * v; *(LAS unsigned short*)(ost + ((4 * lq + i) * 32 + 16 * nb + l15) * 2) = (unsigned short)f2bf(v); }
                q += __shfl_xor(q, 1); q += __shfl_xor(q, 2); q += __shfl_xor(q, 4); q += __shfl_xor(q, 8);
                if (l15 == 0) ssqp[((tok0 + 16 * w + 4 * lq + i) * 4 + h) * 16 + j] = q; }
            LDS_WAIT();
            { const v4u ov = *(const LAS v4u*)(ost + lane * 16); *(v4u*)(RO + (tok0 + 16 * w + (lane >> 2)) * 2048 + h * 512 + 32 * j + (lane & 3) * 8) = ov; }
            *(LAS bf16x8*)(vl + (cur ^ 1) * 8192 + F.tid * 16) = vpre;
#pragma unroll
            for (int mb = 0; mb < 2; ++mb)
#pragma unroll
                for (int nb = 0; nb < 2; ++nb) *(LAS u32x2*)(F.lds + (cur ^ 1) * SBUF + (16 * nb + l15) * SROW + (32 * w + 16 * mb + 4 * lq) * 2) = (u32x2){cvtpk(S[mb][nb][0], S[mb][nb][1]), cvtpk(S[mb][nb][2], S[mb][nb][3])};
        }
    }
    __syncthreads();
}

namespace attn2 {
typedef float f32x16 __attribute__((ext_vector_type(16)));
typedef short s16x4 __attribute__((ext_vector_type(4)));
constexpr int NW = 8, QBLK = 32, KVBLK = 64, QB = NW * QBLK;
constexpr int QS = 1536, KS = 1536, VS = 1024, OS = 1024;
constexpr int SHM_V = KVBLK * 128 * 2, SHM_K = KVBLK * 512;
constexpr int OFF_V = 0, OFF_K = 2 * SHM_V, OFF_WS = OFF_K + 2 * SHM_K, OFF_QR = OFF_WS + NW * 64 * 4, LDS_NEED = OFF_QR + NW * 4096;
constexpr float THR2 = 8.0f * 1.4426950408889634f;
#define A2_SBAR() __builtin_amdgcn_sched_barrier(0)
__device__ __forceinline__ int v_st(int k, int c) { const int kk = (k & ~0xC) | ((k & 4) << 1) | ((k & 8) >> 1); return ((kk >> 3) * 4 + (c >> 5)) * 512 + ((kk & 7) * 32 + (c & 31)) * 2; }
__device__ __forceinline__ int v_rd_base(int lane) { return ((lane & 3) << 3) | (((lane >> 2) & 3) << 6) | (((lane >> 4) & 1) << 5) | (((lane >> 5) & 1) << 8); }
constexpr int v_rd_off(int d0, int ks, int half) { return d0 * 512 + ks * 4096 + half * 2048; }
__device__ __forceinline__ int crow(int r, int hi) { return (r & 3) + 8 * (r >> 2) + 4 * hi; }
typedef __bf16 bf16x2a_t __attribute__((ext_vector_type(2)));
__device__ __forceinline__ unsigned cvtpk(float lo, float hi) { f32x2 v = {lo, hi}; bf16x2a_t b = __builtin_convertvector(v, bf16x2a_t); return __builtin_bit_cast(unsigned, b); }
__device__ __forceinline__ bf16x8 load8(const bf16* p) { return *reinterpret_cast<const bf16x8*>(p); }
__device__ __forceinline__ void mask_tile(f32x16& p0, f32x16& p1, int dq) {
    const float NEG = -__builtin_inff();
#pragma unroll
    for (int r = 0; r < 16; ++r) { const int c = (r & 3) + 8 * (r >> 2); if (dq - c < 0) p0[r] = NEG; if (dq - c - 32 < 0) p1[r] = NEG; }
}
__device__ __forceinline__ void partialSM(f32x16& p0, f32x16& p1, float& m_reg, float& mn, float& alpha) {
    float pmax = p0[0];
#pragma unroll
    for (int r = 1; r < 16; ++r) pmax = fmaxf(pmax, p0[r]);
#pragma unroll
    for (int r = 0; r < 16; ++r) pmax = fmaxf(pmax, p1[r]);
    { auto rr = __builtin_amdgcn_permlane32_swap(__float_as_uint(pmax), __float_as_uint(pmax), false, false); pmax = fmaxf(__uint_as_float(rr[0]), __uint_as_float(rr[1])); }
    if (__builtin_expect(__all((pmax - m_reg) <= THR2), 1)) { mn = m_reg; alpha = 1.f; }
    else { mn = fmaxf(m_reg, pmax); alpha = __builtin_amdgcn_exp2f(m_reg - mn); m_reg = mn; }
#pragma unroll
    for (int r = 0; r < 16; ++r) { p0[r] -= mn; p1[r] -= mn; }
#pragma unroll
    for (int r = 0; r < 16; ++r) p0[r] = __builtin_amdgcn_exp2f(p0[r]);
}
__device__ __forceinline__ void finishSM(f32x16& p0, f32x16& p1, float alpha, float& l_reg, bf16x8& pa0, bf16x8& pa1, bf16x8& pa2, bf16x8& pa3) {
#pragma unroll
    for (int r = 0; r < 16; ++r) p1[r] = __builtin_amdgcn_exp2f(p1[r]);
    float ps = 0;
#pragma unroll
    for (int r = 0; r < 16; ++r) ps += p0[r];
#pragma unroll
    for (int r = 0; r < 16; ++r) ps += p1[r];
    { auto rr = __builtin_amdgcn_permlane32_swap(__float_as_uint(ps), __float_as_uint(ps), false, false); ps = __uint_as_float(rr[0]) + __uint_as_float(rr[1]); }
    l_reg = l_reg * alpha + ps;
#define A2_PK4(P, B_, OUT) do { unsigned a0 = cvtpk(P[B_+0], P[B_+1]), a1 = cvtpk(P[B_+2], P[B_+3]); unsigned b0 = cvtpk(P[B_+4], P[B_+5]), b1 = cvtpk(P[B_+6], P[B_+7]); \
        auto r0 = __builtin_amdgcn_permlane32_swap(a0, b0, false, false); auto r1 = __builtin_amdgcn_permlane32_swap(a1, b1, false, false); \
        v4u w = {r0[0], r1[0], r0[1], r1[1]}; OUT = __builtin_bit_cast(bf16x8, w); } while (0)
    A2_PK4(p0, 0, pa0); A2_PK4(p0, 8, pa1); A2_PK4(p1, 0, pa2); A2_PK4(p1, 8, pa3);
#undef A2_PK4
}
template <int KB>
__device__ __forceinline__ void qkt(f32x16& p0, f32x16& p1, const char* K_lds, const char* qr_lds, int r32, int hi, const bf16x8* qr) {
    p0 = f32x16{}; p1 = f32x16{};
    const char* kbase = K_lds + KB * SHM_K + r32 * 512; const int x = r32 & 15;
#pragma unroll
    for (int d = 0; d < 12; ++d) { const char* a = kbase + ((((2 * d + hi) & 15) ^ x) << 4) + (d >= 8 ? 256 : 0);
        const bf16x8 b0 = *reinterpret_cast<const bf16x8*>(a), b1 = *reinterpret_cast<const bf16x8*>(a + 32 * 512);
        const bf16x8 q = d < 8 ? qr[d < 8 ? d : 0] : *reinterpret_cast<const bf16x8*>(qr_lds + (((d - 8) * 2 + hi) * 32 + r32) * 16);
        p0 = __builtin_amdgcn_mfma_f32_32x32x16_bf16(b0, q, p0, 0, 0, 0);
        p1 = __builtin_amdgcn_mfma_f32_32x32x16_bf16(b1, q, p1, 0, 0, 0); }
}
template <int VB>
__device__ __forceinline__ void pv_tile(f32x16* o, int vb0, bf16x8 pa0, bf16x8 pa1, bf16x8 pa2, bf16x8 pa3) {
#define A2_TRRD(dst, off) asm volatile("ds_read_b64_tr_b16 %0, %1 offset:%2" : "=&v"(dst) : "v"(vb0), "i"(off) : "memory")
#define A2_PV_D0(d0) do { s16x4 l0, l1, l2, l3, h0, h1, h2, h3; constexpr int b_ = VB * SHM_V + v_rd_off(d0, 0, 0); \
        A2_TRRD(l0, b_); A2_TRRD(h0, b_ + 2048); A2_TRRD(l1, b_ + 4096); A2_TRRD(h1, b_ + 6144); A2_TRRD(l2, b_ + 8192); A2_TRRD(h2, b_ + 10240); A2_TRRD(l3, b_ + 12288); A2_TRRD(h3, b_ + 14336); \
        asm volatile("s_waitcnt lgkmcnt(0)" ::: "memory"); A2_SBAR(); \
        o[d0] = __builtin_amdgcn_mfma_f32_32x32x16_bf16(pa0, (bf16x8){l0[0], l0[1], l0[2], l0[3], h0[0], h0[1], h0[2], h0[3]}, o[d0], 0, 0, 0); \
        o[d0] = __builtin_amdgcn_mfma_f32_32x32x16_bf16(pa1, (bf16x8){l1[0], l1[1], l1[2], l1[3], h1[0], h1[1], h1[2], h1[3]}, o[d0], 0, 0, 0); \
        o[d0] = __builtin_amdgcn_mfma_f32_32x32x16_bf16(pa2, (bf16x8){l2[0], l2[1], l2[2], l2[3], h2[0], h2[1], h2[2], h2[3]}, o[d0], 0, 0, 0); \
        o[d0] = __builtin_amdgcn_mfma_f32_32x32x16_bf16(pa3, (bf16x8){l3[0], l3[1], l3[2], l3[3], h3[0], h3[1], h3[2], h3[3]}, o[d0], 0, 0, 0); } while (0)
    A2_PV_D0(0); A2_PV_D0(1); A2_PV_D0(2); A2_PV_D0(3);
#undef A2_PV_D0
#undef A2_TRRD
}
struct BlockRef { const bf16* Q; const bf16* K; const bf16* V; bf16* O; int P0; };
struct Seam { bf16x8 qr[8]; bf16x8 st_v0, st_v1, st_k0, st_k1, st_k2; };
#define A2_VMW() asm volatile("s_waitcnt vmcnt(0)" ::: "memory")
#define A2_VMWN(n) asm volatile("s_waitcnt vmcnt(%0)" :: "i"(n) : "memory")
#define A2_SLOAD(Kp, Vp, k0) do { S.st_v0 = load8((Vp) + (size_t)((k0) + sr) * VS + sc); S.st_v1 = load8((Vp) + (size_t)((k0) + 32 + sr) * VS + sc); \
        const bf16* kp_ = (Kp) + (size_t)((k0) + krow) * KS + kc * 8; S.st_k0 = load8(kp_); S.st_k1 = load8(kp_ + 64); S.st_k2 = load8(kp_ + 128); } while (0)
#define A2_SWRITE_K(bf) do { *(bf16x8*)(K_lds + (bf) * SHM_K + kw0) = S.st_k0; *(bf16x8*)(K_lds + (bf) * SHM_K + kw1) = S.st_k1; *(bf16x8*)(K_lds + (bf) * SHM_K + kw0 + 256) = S.st_k2; } while (0)
#define A2_SWRITE_V(bf) do { *(bf16x8*)(V_lds + (bf) * SHM_V + vst0) = S.st_v0; *(bf16x8*)(V_lds + (bf) * SHM_V + vst1) = S.st_v1; } while (0)
#define A2_SWRITE(bf) do { A2_SWRITE_V(bf); A2_SWRITE_K(bf); } while (0)
#define A2_IDX int tid = threadIdx.x; asm volatile("" : "+v"(tid)); const int wid = __builtin_amdgcn_readfirstlane(tid >> 6), lane = tid & 63, r32 = lane & 31, hi = lane >> 5; \
    const int sr = tid >> 4, sc = (tid & 15) * 8, krow = tid >> 3, kc = tid & 7, kw0 = krow * 512 + ((kc ^ (krow & 15)) << 4), kw1 = krow * 512 + (((kc + 8) ^ (krow & 15)) << 4); \
    char* V_lds = lds + OFF_V; char* K_lds = lds + OFF_K; (void)lane; (void)r32; (void)hi; (void)sr; (void)sc; (void)V_lds
__device__ __forceinline__ void attn_prime(const BlockRef& cur, char* lds, Seam& S) {
    A2_IDX;
#pragma unroll
    for (int d0 = 0; d0 < 8; ++d0) S.qr[d0] = load8(cur.Q + (size_t)(wid * QBLK + r32) * QS + d0 * 16 + hi * 8);
    A2_SLOAD(cur.K, cur.V, 0); A2_VMW(); A2_SWRITE_K(0);
}
__device__ __forceinline__ void attn_block(const BlockRef& cur, const BlockRef& nxt, char* lds, Seam& S) {
    A2_IDX;
    const int NT = (cur.P0 + QB) / KVBLK;
    const int qlo = cur.P0 + wid * QBLK, qm = qlo + r32 - 4 * hi;
    float* ws = (float*)(lds + OFF_WS) + wid * 64; float* li_l = ws, * al_l = ws + 32;
    char* qr_lds = lds + OFF_QR + wid * 4096;
    float m_reg = -1e30f, l_reg = 0; f32x16 o[4] = {};
    const int vst0 = v_st(sr, sc), vst1 = v_st(32 + sr, sc);
    const int vb0 = (int)(uintptr_t)V_lds + v_rd_base(lane);
    const bf16* Kh = cur.K; const bf16* Vh = cur.V;
    { bf16x8 t4[4];
#pragma unroll
      for (int d = 0; d < 4; ++d) t4[d] = load8(cur.Q + (size_t)(wid * QBLK + r32) * QS + 128 + d * 16 + hi * 8);
#pragma unroll
      for (int d = 0; d < 4; ++d) *(bf16x8*)(qr_lds + ((d * 2 + hi) * 32 + r32) * 16) = t4[d]; }
    A2_SWRITE_V(0);
    __syncthreads();
    f32x16 p0, p1; float mn, al; bf16x8 pa0, pa1, pa2, pa3;
#define A2_STEP(t, BUF) do { const bool lastt = (t) + 1 >= NT; \
        A2_SBAR(); { const bf16* Kn = lastt ? nxt.K : Kh; const bf16* Vn = lastt ? nxt.V : Vh; const int k0n = lastt ? 0 : ((t) + 1) * KVBLK; A2_SLOAD(Kn, Vn, k0n); } A2_SBAR(); \
        qkt<BUF>(p0, p1, K_lds, qr_lds, r32, hi, S.qr); \
        if (lastt) { A2_SBAR(); _Pragma("unroll") for (int d0 = 0; d0 < 8; ++d0) S.qr[d0] = load8(nxt.Q + (size_t)(wid * QBLK + r32) * QS + d0 * 16 + hi * 8); A2_SBAR(); } \
        { const int kb_ = (t) * KVBLK; if (kb_ + KVBLK - 1 > qlo) mask_tile(p0, p1, qm - kb_); } \
        partialSM(p0, p1, m_reg, mn, al); finishSM(p0, p1, al, l_reg, pa0, pa1, pa2, pa3); \
        if (__any(al < 1.f)) { if (hi == 0) al_l[r32] = al; asm volatile("s_waitcnt lgkmcnt(0)" ::: "memory"); \
            for (int d_ = 0; d_ < 4; ++d_) for (int r = 0; r < 16; ++r) o[d_][r] *= al_l[crow(r, hi)]; } \
        A2_SBAR(); pv_tile<BUF>(o, vb0, pa0, pa1, pa2, pa3); A2_SBAR(); \
        if (lastt) { A2_VMWN(8); A2_SWRITE_K(0); } else { A2_VMW(); A2_SWRITE((BUF) ^ 1); } \
        __syncthreads(); } while (0)
    for (int t = 0; t < NT; t += 2) { A2_STEP(t, 0); A2_STEP(t + 1, 1); }
#undef A2_STEP
    if (hi == 0) li_l[r32] = l_reg; asm volatile("s_waitcnt lgkmcnt(0)" ::: "memory");
    float rli[16];
#pragma unroll
    for (int r = 0; r < 16; ++r) rli[r] = __builtin_amdgcn_rcpf(li_l[crow(r, hi)]);
    bf16* Ow = cur.O + (size_t)(wid * QBLK) * OS;
#pragma unroll
    for (int r = 0; r < 16; ++r) { const int orow = crow(r, hi);
#pragma unroll
        for (int d0 = 0; d0 < 4; ++d0) { const float v = o[d0][r] * rli[r]; const float vn = __shfl_xor(v, 1);
            if ((r32 & 1) == 0) *(unsigned*)(Ow + (size_t)orow * OS + d0 * 32 + r32) = cvtpk(v, vn); } }
    asm volatile("s_waitcnt lgkmcnt(0)" ::: "memory");
}
}
__device__ __forceinline__ attn2::BlockRef attn2_ref(unsigned char* ws, int v, int pass) {
    const int bh = v >> 3, b = bh >> 3, h = bh & 7, x = v & 7, qb = pass ? 15 - x : x;
    attn2::BlockRef r;
    r.Q = (const bf16*)(ws + WS_QP) + ((size_t)b * SEQ + qb * 256) * 1536 + h * 192; r.K = (const bf16*)(ws + WS_KF) + (size_t)b * SEQ * 1536 + h * 192;
    r.V = (const bf16*)(ws + WS_VV) + (size_t)b * SEQ * 1024 + h * 128; r.O = (bf16*)(ws + WS_MO) + ((size_t)b * SEQ + qb * 256) * 1024 + h * 128; r.P0 = qb * 256;
    return r;
}
__device__ __forceinline__ void phase_attn2(Frame& F, char* lds) {
    int L = F.vcu; if (L >= 256) return;
    attn2::Seam S; int pass = 0;
    attn2::BlockRef cur = attn2_ref(F.ws, L, 0);
    attn2::attn_prime(cur, lds, S);
    for (;;) {
        const bool more_pass = pass == 0, more_item = L + F.G < 256, last = !more_pass && !more_item;
        int passn = pass + 1, Ln = L;
        if (!more_pass) { passn = 0; Ln = more_item ? L + F.G : L; }
        const attn2::BlockRef nxt = last ? cur : attn2_ref(F.ws, Ln, passn);
        attn2::attn_block(cur, nxt, lds, S);
        if (last) break;
        cur = nxt; pass = passn; L = Ln;
    }
}

static_assert(pg8::EpiKVup::O_KF == WS_KF && pg8::EpiKVup::O_VV == WS_VV && pg8::EpiKVup::O_KR == WS_KR && pg8::EpiKVup::O_SSQ_CKV == WS_SMALL + SM_SSQ_CKV && pg8::EpiKVup::O_SSQ_KR == WS_SMALL + SM_SSQ_KR, "EpiKVup offsets");
#ifndef MK_N_LAUNCHES
#define MK_N_LAUNCHES 12
#endif
constexpr int N_PHASES = 12;
constexpr int N_LAUNCHES = MK_N_LAUNCHES;
struct Args { const float* in[21]; float* out; unsigned char* ws; int ph_lo, ph_hi; };
#ifndef PG8_SP2
#define PG8_SP2 true
#endif
#define PG8_ALIGN true
template <class Epi> __device__ __forceinline__ void run_gemm(Frame& F, const pg8::bf16_t* A, int lda, const pg8::bf16_t* Bt, int ldb, int N, int K, const Epi& E) {
    __syncthreads();
    pg8::Gemm g{A, Bt, MTOK, N, K, lda, ldb}; pg8::StaticOrder S; S.init(MTOK, N, F.G, (int)blockIdx.x);
    pg8::gemm_phase<Epi, pg8::StaticOrder, PG8_ALIGN, PG8_SP2>(F.lds + RING_OFF, g, S, E);
}
__global__ void __launch_bounds__(NWAVES * 64, 2) mk_fwd(Args args) {
    extern __shared__ __attribute__((aligned(16))) unsigned char lds[];
    Frame F;
    F.lds = (LAS unsigned char*)lds; F.MISC = (volatile LAS unsigned*)(F.lds + MISC_OFF);
    F.tid = threadIdx.x; F.lane = F.tid & 63; F.wave = __builtin_amdgcn_readfirstlane(F.tid >> 6);
    F.G = gridDim.x; { const int bx = blockIdx.x; F.vcu = (F.G % 8 == 0) ? (bx % 8) * (F.G / 8) + bx / 8 : bx; }
    F.out = args.out; F.ws = args.ws;
    unsigned char* ws = args.ws;
    if (F.tid < 32) F.MISC[F.tid] = 0u;
    __syncthreads();
    XcdBarrier bar; bar.bar = (unsigned*)(ws + WS_CTL) + CW_BAR; bar.x = 0; bar.st = nullptr;
    if (N_LAUNCHES == 1) bar = xcd_barrier_post((unsigned*)(ws + WS_CTL) + CW_BAR, F.MISC + 8);
    const int lo = args.ph_lo, hi = args.ph_hi;
#ifndef PH_MASK
#define PH_MASK 0xfff
#endif
#define IN(k) (((PH_MASK >> (k)) & 1) && lo <= (k) && (k) < hi)
#define SEAM(k) do { asm volatile("; SEAM_MARK %0" :: "i"(k)); if (IN(k) && IN((k) + 1)) xcd_barrier(bar); } while (0)
#ifdef SUBSTRETCH
#define SUB_T0(n) const unsigned long long ts0_##n = __builtin_amdgcn_s_memrealtime()
#define SUB_ST(n) do { if (SUBSTRETCH == (n)) { const unsigned long long t1_ = __builtin_amdgcn_s_memrealtime(); const unsigned long long d_ = t1_ - ts0_##n; while (__builtin_amdgcn_s_memrealtime() - t1_ < d_) __builtin_amdgcn_s_sleep(8); } } while (0)
#else
#define SUB_T0(n) do {} while (0)
#define SUB_ST(n) do {} while (0)
#endif
#define PH_IDX() do { int t_ = threadIdx.x; asm volatile("" : "+v"(t_)); F.tid = t_; F.lane = t_ & 63; F.wave = __builtin_amdgcn_readfirstlane(t_ >> 6); } while (0)
#ifdef STRETCH_MASK
#define PH_T0() PH_IDX(); const unsigned long long t0_ = __builtin_amdgcn_s_memrealtime()
#define PH_STRETCH(k) do { if ((STRETCH_MASK >> (k)) & 1) { const unsigned long long t1_ = __builtin_amdgcn_s_memrealtime(); const unsigned long long d_ = (t1_ - t0_) * STRETCH_MULT; while (__builtin_amdgcn_s_memrealtime() - t1_ < d_) __builtin_amdgcn_s_sleep(8); } } while (0)
#else
#define PH_T0() PH_IDX()
#define PH_STRETCH(k) do {} while (0)
#endif
    float* sm = (float*)(ws + WS_SMALL);
    const float* rstdx = sm + SM_RSTDX / 4; float* ssq_cq = sm + SM_SSQ_CQ / 4; float* ssq_ckv = sm + SM_SSQ_CKV / 4; float* ssq1 = sm + SM_SSQ1 / 4; float* ssq2 = sm + SM_SSQ2 / 4;
    typedef pg8::bf16_t b16;
    b16* WinT = (b16*)(ws + WS_WIN); b16* XB = (b16*)(ws + WS_XB); b16* LATb = (b16*)(ws + WS_LAT); b16* ROb = (b16*)args.out;

    if (IN(0)) { PH_T0(); phase_p0(F, args.in[0], (const int*)args.in[2], args.in[3], args.in[4], args.in[6], args.in[7], args.in[8], args.in[9]); PH_STRETCH(0); } SEAM(0);
    if (IN(1)) { PH_T0();
        pg8::EpiInProj E{rstdx, (const pg8::f32x4*)(ws + WS_CS), (b16*)(ws + WS_RQ), (b16*)(ws + WS_RK), (b16*)(ws + WS_RKDT), (b16*)(ws + WS_RVT), LATb, ssq_cq, (PG8_LAS unsigned char*)(F.lds + XS_OFF),
                          (b16*)(ws + WS_KR), sm + SM_SSQ_KR / 4, args.in[11], (const void*)(ws + WS_CSM)};
        run_gemm(F, XB, 1024, WinT + (size_t)4096 * 1024, 1024, NIN1, 1024, E);
    PH_STRETCH(1); } SEAM(1);
    if (IN(2)) { PH_T0(); phase_r0p(F);
    PH_STRETCH(2); } SEAM(2);
    if (IN(3)) { PH_T0(); phase_r1p(F); PH_STRETCH(3); } SEAM(3);
    if (IN(4)) { PH_T0();
        SUB_T0(1); { pg8::EpiRetGate E{ROb, rstdx, (const float*)(ws + WS_SSQP), args.in[5]}; run_gemm(F, XB, 1024, WinT + (size_t)2048 * 1024, 1024, 2048, 1024, E); } SUB_ST(1);
        asm volatile("; SEAM_MARK 41");
        SUB_T0(2); { pg8::EpiQup E{(b16*)(ws + WS_QP), ssq_cq, args.in[10], (const void*)(ws + WS_CSM), (PG8_LAS float*)(F.lds + XS_OFF), C2Q}; run_gemm(F, LATb, LATW, (const b16*)(ws + WS_WUQ), 384, 2048, 384, E);
#ifdef QUP_TWICE
          run_gemm(F, LATb, LATW, (const b16*)(ws + WS_WUQ), 384, 2048, 384, E);
#endif
        } SUB_ST(2);
        asm volatile("; SEAM_MARK 42");
        SUB_T0(3); { pg8::EpiKVup E{ws, args.in[11], (PG8_LAS float*)(F.lds + XS_OFF)}; run_gemm(F, LATb + 384, LATW, (const b16*)(ws + WS_WUKV), 256, 2048, 256, E);
#ifdef KVUP_TWICE
          run_gemm(F, LATb + 384, LATW, (const b16*)(ws + WS_WUKV), 256, 2048, 256, E);
#endif
        } SUB_ST(3);
    PH_STRETCH(4); } SEAM(4);
    if (IN(5)) { PH_T0(); phase_attn2(F, (char*)lds); PH_STRETCH(5); } SEAM(5);
    if (IN(6)) { PH_T0();
        phase_late_weights(F, args.in[1], args.in[12], args.in[13], args.in[14], args.in[15], args.in[16], args.in[17], args.in[18], args.in[19], args.in[20]);
        { pg8::EpiRowAct<1> E{(b16*)(ws + WS_SG), 2048, rstdx, 0.f}; run_gemm(F, XB, 1024, WinT, 1024, 2048, 1024, E); }
    PH_STRETCH(6); } SEAM(6);
    if (IN(7)) { PH_T0();
        { pg8::EpiGateMix<0> E{(b16*)(ws + WS_TM), (const b16*)(ws + WS_SG), 0}; run_gemm(F, ROb, 2048, (const b16*)(ws + WS_WBR), 2048, 1024, 2048, E); }
        VM_WAIT(); __syncthreads(); __builtin_amdgcn_fence(__ATOMIC_ACQUIRE, "agent"); VM_WAIT(); __syncthreads();
        { pg8::EpiGateMix<1> E{(b16*)(ws + WS_TM), (const b16*)(ws + WS_SG), 1024}; run_gemm(F, (const b16*)(ws + WS_MO), 1024, (const b16*)(ws + WS_WBM), 1024, 1024, 1024, E); }
    PH_STRETCH(7); } SEAM(7);
    if (IN(8)) { PH_T0(); pg8::EpiResid<false> E{(const void*)args.in[0], XB, ssq1}; run_gemm(F, (const b16*)(ws + WS_TM), 1024, (const b16*)(ws + WS_WO), 1024, 1024, 1024, E); PH_STRETCH(8); } SEAM(8);
    if (IN(9)) { PH_T0(); pg8::EpiRowAct<2> E{(b16*)(ws + WS_H), 4096, ssq1, 1.0f / 1024.0f}; run_gemm(F, XB, 1024, (const b16*)(ws + WS_WUP), 1024, 4096, 1024, E); PH_STRETCH(9); } SEAM(9);
    if (IN(10)) { PH_T0(); pg8::EpiResid<true> E{(const void*)XB, XB, ssq2}; run_gemm(F, (const b16*)(ws + WS_H), 4096, (const b16*)(ws + WS_WDOWN), 4096, 1024, 4096, E); PH_STRETCH(10); } SEAM(10);
    if (IN(11)) { PH_T0();
        { pg8::EpiRowAct<1> E{(b16*)(ws + WS_GT), 1024, ssq2, 1.0f / 1024.0f}; run_gemm(F, XB, 1024, (const b16*)(ws + WS_WPG), 1024, 1024, 1024, E); }
        VM_WAIT(); __syncthreads(); __builtin_amdgcn_fence(__ATOMIC_ACQUIRE, "agent"); VM_WAIT(); __syncthreads();
        { pg8::EpiFinal E{args.out, (const b16*)(ws + WS_GT), XB}; run_gemm(F, (const b16*)(ws + WS_PB), 256, (const b16*)(ws + WS_WPLE), 256, 1024, 256, E); }
    PH_STRETCH(11); }
#undef IN
#undef SEAM
}


#ifdef DUMPK
struct DumpArgs { const unsigned* reg[6]; unsigned nw[6]; unsigned* out; int own; int pad; };
__global__ void dump_hash(DumpArgs d) {
    for (unsigned i = blockIdx.x * blockDim.x + threadIdx.x; i < (unsigned)MTOK * DM; i += gridDim.x * blockDim.x) {
        float s = 0.f;
        if (d.own) { const unsigned w = d.out[i]; s += __uint_as_float(w << 16) + __uint_as_float(w & 0xffff0000u); }
        for (int r = 0; r < 6; ++r) if (d.reg[r] && i < d.nw[r] * 2u) { const unsigned short v = ((const unsigned short*)d.reg[r])[i]; s += __uint_as_float((unsigned)v << 16); }
        ((float*)d.out)[i] = s;
    }
}
#endif
extern "C" void kernel_launch(void* const* d_in, const int* in_sizes, int n_in, void* d_out, int out_size, void* d_ws, size_t ws_size, hipStream_t stream) {
    static int grid = 0;
    if (grid == 0) {
        if (n_in != 21 || in_sizes[0] != MTOK * DM || out_size != MTOK * DM || ws_size < WS_END) { fprintf(stderr, "kernel_launch: unexpected shapes (n_in %d in0 %d out %d ws %zu)\n", n_in, n_in > 0 ? in_sizes[0] : -1, out_size, ws_size); grid = -1; return; }
        int dev = 0, cus = 0, per_cu = 0;
        if (hipGetDevice(&dev) != hipSuccess || hipDeviceGetAttribute(&cus, hipDeviceAttributeMultiprocessorCount, dev) != hipSuccess) { grid = -1; return; }
        if (hipFuncSetAttribute((const void*)mk_fwd, hipFuncAttributeMaxDynamicSharedMemorySize, LDS_BYTES) != hipSuccess) { fprintf(stderr, "kernel_launch: hipFuncSetAttribute failed\n"); grid = -1; return; }
        if (hipOccupancyMaxActiveBlocksPerMultiprocessor(&per_cu, (const void*)mk_fwd, NWAVES * 64, LDS_BYTES) != hipSuccess || per_cu < 1) { fprintf(stderr, "kernel_launch: occupancy query says %d workgroups per CU\n", per_cu); (void)hipGetLastError(); grid = -1; return; }
        grid = cus;
    }
    if (grid < 0) return;
    (void)hipMemsetAsync((char*)d_ws + WS_CTL, 0, CTL_ZERO_BYTES, stream);
    Args a{};
    for (int i = 0; i < 21; ++i) a.in[i] = (const float*)d_in[i];
    a.out = (float*)d_out; a.ws = (unsigned char*)d_ws;
    if (N_LAUNCHES == 1) { a.ph_lo = 0; a.ph_hi = N_PHASES; hipLaunchKernelGGL(mk_fwd, dim3(grid), dim3(NWAVES * 64), LDS_BYTES, stream, a); }
    else for (int ph = 0; ph < N_PHASES; ++ph) {
#ifdef DUMPK
        if (ph > DUMPK) break;
#endif
        a.ph_lo = ph; a.ph_hi = ph + 1; hipLaunchKernelGGL(mk_fwd, dim3(grid), dim3(NWAVES * 64), LDS_BYTES, stream, a); }
#ifdef DUMPK
    { DumpArgs d{}; d.out = (unsigned*)d_out; d.own = DUMP_OWN; const size_t offs[6] = DUMP_OFFS; const size_t len[6] = DUMP_LENS;
      for (int r = 0; r < 6; ++r) if (len[r]) { d.reg[r] = (const unsigned*)((const char*)d_ws + offs[r]); d.nw[r] = (unsigned)(len[r] / 4); }
      hipLaunchKernelGGL(dump_hash, dim3(2048), dim3(256), 0, stream, d); }
#endif
}
```

```cpp
#define MK_N_LAUNCHES 1
#include <hip/hip_runtime.h>
#include <hip/hip_bf16.h>
#include <cstdio>
#include <cstdint>
namespace pg8 {
#define PG8_LAS __attribute__((address_space(3)))
typedef unsigned short bf16_t;
typedef short bf16x8 __attribute__((ext_vector_type(8)));
typedef float f32x4 __attribute__((ext_vector_type(4)));
typedef unsigned u32x4 __attribute__((ext_vector_type(4)));
constexpr int BM = 256, BK = 64, HALF = 128, HTB = HALF * BK * 2  , STAGE_BYTES = 8 * HTB, NXCD = 8, WGM = 8;

__host__ __device__ __forceinline__ int lds_byte(int r, int c) { const int st = (r >> 4) * 2 + (c >> 5), rr = r & 15, cc = c & 31, ob = rr * 64 + cc * 2; return st * 1024 + (ob ^ (((ob >> 9) & 1) << 5)); }
__host__ __device__ __forceinline__ void stage_rc(int b, int& R, int& C) { const int st = b / 1024, sb = b % 1024, swz = sb ^ (((sb >> 9) & 1) << 5); R = (st >> 1) * 16 + swz / 64; C = (st & 1) * 32 + (swz % 64) / 2; }
__host__ __device__ __forceinline__ int perm32(int rho) { const int n = rho >> 4, i = rho & 15; return 8 * (i >> 2) + 4 * n + (i & 3); }

struct Unit { int pm, pn; };
struct Gemm { const bf16_t* A; const bf16_t* Bt; int M, N, K, lda, ldb; };

struct StaticOrder {
    int nM, nN, nwg, G, c;
    __host__ __device__ void init(int M, int N, int G_, int c_) { nM = M / BM; nN = N / BM; nwg = nM * nN; G = G_; c = c_; }
    __host__ __device__ bool next(int i, Unit& u) const {
        const long L = (long)i * G + c; if (L >= nwg) return false;
        int wgid = (int)L; { const int q = nwg / NXCD, r = nwg % NXCD, xcd = wgid % NXCD, off = wgid / NXCD; wgid = (xcd < r ? xcd * (q + 1) : r * (q + 1) + (xcd - r) * q) + off; }
        const int nig = WGM * nN, gid = wgid / nig, fm = gid * WGM, gsz = (nM - fm) < WGM ? (nM - fm) : WGM;
        u.pm = fm + ((wgid % nig) % gsz); u.pn = (wgid % nig) / gsz; return true;
    }
    __device__ __forceinline__ void a_ready(const Unit&) const {}
    __device__ __forceinline__ void done(const Unit&) const {}
};


typedef float f32x2 __attribute__((ext_vector_type(2)));
typedef unsigned u32x2 __attribute__((ext_vector_type(2)));
typedef __bf16 bf16x2_t __attribute__((ext_vector_type(2)));
__device__ __forceinline__ unsigned cvt_pk_bf16(float lo, float hi) { f32x2 v = {lo, hi}; bf16x2_t b = __builtin_convertvector(v, bf16x2_t); return __builtin_bit_cast(unsigned, b); }
__device__ __forceinline__ float bflo(unsigned w) { return __uint_as_float(w << 16); }
__device__ __forceinline__ float bfhi(unsigned w) { return __uint_as_float(w & 0xffff0000u); }
__device__ __forceinline__ u32x4 pack8(const float (&v)[8]) { u32x4 w; w.x = cvt_pk_bf16(v[0], v[1]); w.y = cvt_pk_bf16(v[2], v[3]); w.z = cvt_pk_bf16(v[4], v[5]); w.w = cvt_pk_bf16(v[6], v[7]); return w; }
__device__ __forceinline__ void unpack8(const u32x4 w, float (&v)[8]) { v[0] = bflo(w.x); v[1] = bfhi(w.x); v[2] = bflo(w.y); v[3] = bfhi(w.y); v[4] = bflo(w.z); v[5] = bfhi(w.z); v[6] = bflo(w.w); v[7] = bfhi(w.w); }
__device__ __forceinline__ float sigmoidf_(float x) { return __builtin_amdgcn_rcpf(1.0f + __builtin_amdgcn_exp2f(-1.4426950408889634f * x)); }
constexpr float RMS_EPS_ = 1e-6f;
typedef _Float16 h2x4_t __attribute__((ext_vector_type(8)));
__device__ __forceinline__ void rope8(const void* csm, unsigned row, unsigned i0, float (&c)[8], float (&s)[8]) {
    const h2x4_t* p = (const h2x4_t*)csm + (row * 8u + (i0 >> 2)); const h2x4_t a = p[0], b = p[1];
#pragma unroll
    for (int e = 0; e < 4; ++e) { c[e] = (float)a[2 * e]; s[e] = (float)a[2 * e + 1]; c[4 + e] = (float)b[2 * e]; s[4 + e] = (float)b[2 * e + 1]; }
}
__device__ __forceinline__ void st16(bf16_t* p, const u32x4 v) {
#ifdef ST_SC1
    asm volatile("global_store_dwordx4 %0, %1, off sc1\n\ts_nop 1" :: "v"(p), "v"(v) : "memory");
#else
    *(u32x4*)p = v;
#endif
}

#define EPI_ACC8(v, ai, bj, m) float v[8]; { const f32x4 a0_ = acc[ai][bj][m][0], a1_ = acc[ai][bj][m][1]; v[0] = a0_[0]; v[1] = a0_[1]; v[2] = a0_[2]; v[3] = a0_[3]; v[4] = a1_[0]; v[5] = a1_[1]; v[6] = a1_[2]; v[7] = a1_[3]; }

__device__ __forceinline__ void xpose_store(PG8_LAS unsigned char* st, const unsigned (&pk)[4][4], bf16_t* dst, int R, int lane, int fr, int fq) {
#pragma unroll
    for (int pass = 0; pass < 2; ++pass) {
        if ((fq >> 1) == pass) {
#pragma unroll
            for (int m = 0; m < 4; ++m)
#pragma unroll
                for (int q = 0; q < 4; ++q) { const unsigned w = pk[m][q]; const int c = (fq & 1) * 8 + 2 * q;
                    *(PG8_LAS unsigned short*)(st + c * 144 + (16 * m + fr) * 2) = (unsigned short)(w & 0xffffu);
                    *(PG8_LAS unsigned short*)(st + (c + 1) * 144 + (16 * m + fr) * 2) = (unsigned short)(w >> 16); }
        }
        asm volatile("s_waitcnt lgkmcnt(0)" ::: "memory");
#pragma unroll
        for (int k = 0; k < 2; ++k) { const int idx = lane + 64 * k, c = idx & 15, ch = idx >> 4;
            const u32x4 v = *(const PG8_LAS u32x4*)(st + c * 144 + ch * 16);
            *(u32x4*)(dst + ((size_t)ch * R + pass * 16 + c) * 8) = v; }
        asm volatile("s_waitcnt lgkmcnt(0)" ::: "memory");
    }
}

struct EpiInProj {
    static constexpr bool PERM = true, AFTER_DRAIN = false, TWICE_OK = false; static __device__ __forceinline__ bool twice(const Unit& u) { return u.pn < 16; }
    unsigned char* ws; const float* k_norm; PG8_LAS unsigned char* xs;
    static constexpr size_t O_RSTDX = (size_t)1 << 20, O_SSQ_LAT = ((size_t)1 << 20) + (64 << 10), O_SSQ_KR = ((size_t)1 << 20) + (320 << 10), O_CS = (size_t)57 << 20, O_CSM = (size_t)254 << 20,
        O_RQ = (size_t)94 << 20, O_RK = (size_t)126 << 20, O_RKDT = (size_t)158 << 20, O_RVT = (size_t)190 << 20, O_LAT = (size_t)73 << 20, O_KR = ((size_t)22 << 20) + (512 << 10);
    __device__ __forceinline__ void operator()(const f32x4 (&acc)[2][2][4][2], const Unit& u, int wr, int wc, int fr, int fq) const {
        const int pn = u.pn, lane = fq * 16 + fr, wid = wr * 4 + wc;
        const float* rstdx = (const float*)(ws + O_RSTDX); const f32x4* cs = (const f32x4*)(ws + O_CS); const void* csm = (const void*)(ws + O_CSM); float* ssq_lat = (float*)(ws + O_SSQ_LAT); float* ssq_kr = (float*)(ws + O_SSQ_KR);
        bf16_t* RQ = (bf16_t*)(ws + O_RQ); bf16_t* RK = (bf16_t*)(ws + O_RK); bf16_t* RKDT = (bf16_t*)(ws + O_RKDT); bf16_t* RVT = (bf16_t*)(ws + O_RVT); bf16_t* LAT = (bf16_t*)(ws + O_LAT); bf16_t* KR = (bf16_t*)(ws + O_KR);
        PG8_LAS unsigned char* st = xs + wid * 2304;
        const int rowt = u.pm * BM + wr * 64 + fr;
        const int bidx = (u.pm * BM) >> 12, s0 = (u.pm * BM) & 4095;
        if (pn < 8) {
            const bool isk = pn >= 4; const int head = pn & 3;
            const float lg2 = __builtin_amdgcn_logf(1.0f - __builtin_amdgcn_exp2f(-5.0f - (float)head));
            bf16_t* O = isk ? RK : RQ;
#pragma unroll
            for (int ai = 0; ai < 2; ++ai) {
                unsigned pk0[4][4], pk1[4][4];
#pragma unroll
                for (int m = 0; m < 4; ++m) {
                    const int row = rowt + ai * HALF + m * 16; const float rs = rstdx[row] * (isk ? 0.0625f : 1.0f);
                    const f32x4* cp = cs + ((unsigned)row * 64u + (unsigned)(wc * 16 + fq * 4));
                    const f32x4 c0 = cp[0], c1 = cp[1], c2 = cp[2], c3 = cp[3];
                    const float cc[8] = {c0[0], c0[2], c1[0], c1[2], c2[0], c2[2], c3[0], c3[2]}, ss[8] = {c0[1], c0[3], c1[1], c1[3], c2[1], c2[3], c3[1], c3[3]};
                    EPI_ACC8(x1, ai, 0, m); EPI_ACC8(x2, ai, 1, m);
                    float o1[8], o2[8];
#pragma unroll
                    for (int e = 0; e < 8; ++e) { const float a = x1[e] * rs, b = x2[e] * rs; o1[e] = a * cc[e] - b * ss[e]; o2[e] = b * cc[e] + a * ss[e]; }
                    bf16_t* rp = O + ((((size_t)(bidx * 4 + head) * 32 + (s0 >> 7) + ai) * 32 + wc * 4 + fq) * 128 + wr * 64 + m * 16 + fr) * 8;
                    *(u32x4*)rp = pack8(o1); *(u32x4*)(rp + (size_t)16 * 128 * 8) = pack8(o2);
                    if (isk) { const float kdm = __builtin_amdgcn_exp2f((float)(127 - (wr * 64 + m * 16 + fr)) * lg2);
#pragma unroll
                        for (int q = 0; q < 4; ++q) { pk0[m][q] = cvt_pk_bf16(o1[2 * q] * kdm, o1[2 * q + 1] * kdm); pk1[m][q] = cvt_pk_bf16(o2[2 * q] * kdm, o2[2 * q + 1] * kdm); }
                    }
                }
                if (isk) {
                    bf16_t* d0 = RKDT + ((((size_t)(bidx * 4 + head) * 32 + (s0 >> 7) + ai) * 16 + wr * 8) * 256 + wc * 32) * 8;
                    xpose_store(st, pk0, d0, 256, lane, fr, fq);
                    xpose_store(st, pk1, d0 + (size_t)HALF * 8, 256, lane, fr, fq);
                }
            }
        } else if (pn < 16) {
            const int head = (pn - 8) >> 1, dvb = ((pn - 8) & 1) * 256;
#pragma unroll
            for (int ai = 0; ai < 2; ++ai)
#pragma unroll
                for (int bj = 0; bj < 2; ++bj) {
                    unsigned pk[4][4];
#pragma unroll
                    for (int m = 0; m < 4; ++m) { const float rs = rstdx[rowt + ai * HALF + m * 16]; EPI_ACC8(v, ai, bj, m);
#pragma unroll
                        for (int q = 0; q < 4; ++q) pk[m][q] = cvt_pk_bf16(v[2 * q] * rs, v[2 * q + 1] * rs); }
                    bf16_t* d0 = RVT + ((((size_t)(bidx * 4 + head) * 32 + (s0 >> 7) + ai) * 16 + wr * 8) * 512 + dvb + bj * HALF + wc * 32) * 8;
                    xpose_store(st, pk, d0, 512, lane, fr, fq);
                }
        } else if (pn < 19) {
            const int lt = pn - 16; int fqo = fq; asm volatile("" : "+v"(fqo));
#pragma unroll
            for (int ai = 0; ai < 2; ++ai)
#pragma unroll
                for (int m = 0; m < 4; ++m) { const int row = rowt + ai * HALF + m * 16; const float rs = rstdx[row];
#pragma unroll
                    for (int bj = 0; bj < 2; ++bj) { if (lt == 2 && bj == 1) continue;
                        EPI_ACC8(v, ai, bj, m); float q = 0.f;
#pragma unroll
                        for (int e = 0; e < 8; ++e) { v[e] *= rs; q += v[e] * v[e]; }
                        *(u32x4*)(LAT + ((unsigned)row * 640u + lt * 256 + bj * HALF + wc * 32 + 8 * fqo)) = pack8(v);
                        const int kind = (lt == 0) ? 0 : (lt == 1 ? (bj == 0 ? 0 : 1) : 1);
                        q += __shfl_xor(q, 16); q += __shfl_xor(q, 32); if (fq == 0) atomicAdd(ssq_lat + kind * 16384 + row, q); } }
        } else if (wc == 0) {
#pragma unroll
            for (int ai = 0; ai < 2; ++ai)
#pragma unroll
                for (int m = 0; m < 4; ++m) { const int row = rowt + ai * HALF + m * 16; const float rs = rstdx[row];
                    float q = 0.f; unsigned w1[4], w2[4]; const h2x4_t* cp = (const h2x4_t*)csm + ((unsigned)row * 8u + 2u * (unsigned)fq);
#pragma unroll
                    for (int hh = 0; hh < 2; ++hh) { const f32x4 xa = acc[ai][0][m][hh] * rs, xb = acc[ai][1][m][hh] * rs; const f32x4 ga = *(const f32x4*)(k_norm + 128 + 8 * fq + 4 * hh), gb = *(const f32x4*)(k_norm + 160 + 8 * fq + 4 * hh);
                        const h2x4_t t4 = cp[hh]; float oa[4], ob[4];
#pragma unroll
                        for (int e = 0; e < 4; ++e) { q += xa[e] * xa[e] + xb[e] * xb[e]; const float ya = xa[e] * ga[e], yb = xb[e] * gb[e], c_ = (float)t4[2 * e], s_ = (float)t4[2 * e + 1];
                            oa[e] = ya * c_ - yb * s_; ob[e] = yb * c_ + ya * s_; }
                        w1[2 * hh] = cvt_pk_bf16(oa[0], oa[1]); w1[2 * hh + 1] = cvt_pk_bf16(oa[2], oa[3]); w2[2 * hh] = cvt_pk_bf16(ob[0], ob[1]); w2[2 * hh + 1] = cvt_pk_bf16(ob[2], ob[3]); }
                    *(u32x4*)(KR + ((unsigned)row * 64u + 8u * fq)) = (u32x4){w1[0], w1[1], w1[2], w1[3]}; *(u32x4*)(KR + ((unsigned)row * 64u + 32u + 8u * fq)) = (u32x4){w2[0], w2[1], w2[2], w2[3]};
                    q += __shfl_xor(q, 16); q += __shfl_xor(q, 32); if (fq == 0) ssq_kr[row] = q;
                    asm volatile("" ::: "memory"); }
        }
    }
};

struct EpiKVup {
    static constexpr bool PERM = true, AFTER_DRAIN = false, TWICE_OK = false; static __device__ __forceinline__ bool twice(const Unit&) { return false; }
    unsigned char* ws; const float* k_norm; PG8_LAS float* xr;
    static constexpr size_t O_KF = (size_t)142 << 20, O_VV = (size_t)190 << 20, O_KR = ((size_t)22 << 20) + (512 << 10), O_SSQ_CKV = ((size_t)1 << 20) + (128 << 10), O_SSQ_KR = ((size_t)1 << 20) + (320 << 10);
    __device__ __forceinline__ void operator()(const f32x4 (&acc)[2][2][4][2], const Unit& u, int wr, int wc, int fr, int fq) const {
        const unsigned rowt = u.pm * BM + wr * 64 + fr, head = u.pn, d0 = wc * 32 + 8 * fq;
        bf16_t* KF = (bf16_t*)(ws + O_KF); bf16_t* VV = (bf16_t*)(ws + O_VV); const bf16_t* KR = (const bf16_t*)(ws + O_KR); const float* ssq_ckv = (const float*)(ws + O_SSQ_CKV); const float* ssq_kr = (const float*)(ws + O_SSQ_KR);
        float rs8[2][4], kr8[2][4];
#pragma unroll
        for (int ai = 0; ai < 2; ++ai)
#pragma unroll
            for (int m = 0; m < 4; ++m) { rs8[ai][m] = __builtin_amdgcn_rsqf(ssq_ckv[rowt + ai * HALF + m * 16] * (1.0f / 256.0f) + RMS_EPS_); kr8[ai][m] = ssq_kr[rowt + ai * HALF + m * 16]; }
#pragma unroll
        for (int ai = 0; ai < 2; ++ai)
#pragma unroll
            for (int m = 0; m < 4; ++m) { const float rs = rs8[ai][m];
                const f32x4 a0 = acc[ai][0][m][0] * rs, a1 = acc[ai][0][m][1] * rs;
                float q = (a0[0] * a0[0] + a0[1] * a0[1]) + (a0[2] * a0[2] + a0[3] * a0[3]) + (a1[0] * a1[0] + a1[1] * a1[1]) + (a1[2] * a1[2] + a1[3] * a1[3]);
                q += __shfl_xor(q, 16); q += __shfl_xor(q, 32);
                if (fq == 0) xr[(ai * HALF + wr * 64 + m * 16 + fr) * 4 + wc] = q; }
        asm volatile("s_waitcnt lgkmcnt(0)\n\ts_barrier" ::: "memory");
        const f32x4 g0 = *(const f32x4*)(k_norm + d0), g1 = *(const f32x4*)(k_norm + d0 + 4);
#pragma unroll
        for (int ai = 0; ai < 2; ++ai)
#pragma unroll
            for (int m = 0; m < 4; ++m) { const unsigned row = rowt + ai * HALF + m * 16; const float rs = rs8[ai][m];
                const f32x4 p4 = *(const PG8_LAS f32x4*)(xr + (ai * HALF + wr * 64 + m * 16 + fr) * 4);
                const float sk = __builtin_amdgcn_rsqf(((p4[0] + p4[1]) + (p4[2] + p4[3]) + kr8[ai][m]) * (1.0f / 192.0f) + RMS_EPS_), rk = rs * sk;
                { EPI_ACC8(v, ai, 0, m);
#pragma unroll
                  for (int e = 0; e < 8; ++e) v[e] *= rk * (e < 4 ? g0[e & 3] : g1[e & 3]);
                  *(u32x4*)(KF + (row * 1536u + head * 192u + d0)) = pack8(v); }
                { EPI_ACC8(v, ai, 1, m);
#pragma unroll
                  for (int e = 0; e < 8; ++e) v[e] *= rs;
                  *(u32x4*)(VV + (row * 1024u + head * 128u + d0)) = pack8(v); }
                { const u32x2 kr = *(const u32x2*)(KR + (row * 64u + 16 * wc + 4 * fq));
                  *(u32x2*)(KF + (row * 1536u + head * 192u + 128 + 16 * wc + 4 * fq)) = (u32x2){cvt_pk_bf16(bflo(kr.x) * sk, bfhi(kr.x) * sk), cvt_pk_bf16(bflo(kr.y) * sk, bfhi(kr.y) * sk)}; } }
    }
};

struct EpiQup {
    static constexpr bool PERM = true, AFTER_DRAIN = false, TWICE_OK = false; static __device__ __forceinline__ bool twice(const Unit&) { return false; }
    bf16_t* QP; const float* ssq_cq; const float* q_norm; const void* csm; PG8_LAS float* xr; float c2q;
    __device__ __forceinline__ void operator()(const f32x4 (&acc)[2][2][4][2], const Unit& u, int wr, int wc, int fr, int fq) const {
        const unsigned rowt = u.pm * BM + wr * 64 + fr, head = u.pn;
#pragma unroll
        for (int ai = 0; ai < 2; ++ai)
#pragma unroll
            for (int m = 0; m < 4; ++m) { const float rs = __builtin_amdgcn_rsqf(ssq_cq[rowt + ai * HALF + m * 16] * (1.0f / 384.0f) + RMS_EPS_);
                const f32x4 a0 = acc[ai][0][m][0] * rs, a1 = acc[ai][0][m][1] * rs, b0 = acc[ai][1][m][0] * rs, b1 = acc[ai][1][m][1] * rs;
                float q = ((a0[0] * a0[0] + a0[1] * a0[1]) + (a0[2] * a0[2] + a0[3] * a0[3])) + ((a1[0] * a1[0] + a1[1] * a1[1]) + (a1[2] * a1[2] + a1[3] * a1[3]))
                        + ((b0[0] * b0[0] + b0[1] * b0[1]) + (b0[2] * b0[2] + b0[3] * b0[3])) + ((b1[0] * b1[0] + b1[1] * b1[1]) + (b1[2] * b1[2] + b1[3] * b1[3]));
                q += __shfl_xor(q, 16); q += __shfl_xor(q, 32);
                if (fq == 0) xr[(ai * HALF + wr * 64 + m * 16 + fr) * 4 + wc] = q; }
        asm volatile("s_waitcnt lgkmcnt(0)\n\ts_barrier" ::: "memory");
        const unsigned dA = wc < 3 ? wc * 32 + 8 * fq : 128 + 8 * fq, dB = wc == 0 ? 96 + 8 * fq : 160 + 8 * fq;
        const f32x4 gA0 = *(const f32x4*)(q_norm + dA), gA1 = *(const f32x4*)(q_norm + dA + 4), gB0 = *(const f32x4*)(q_norm + dB), gB1 = *(const f32x4*)(q_norm + dB + 4);
#pragma unroll
        for (int ai = 0; ai < 2; ++ai)
#pragma unroll
            for (int m = 0; m < 4; ++m) { const unsigned row = rowt + ai * HALF + m * 16; const float rs = __builtin_amdgcn_rsqf(ssq_cq[row] * (1.0f / 384.0f) + RMS_EPS_);
                const f32x4 p4 = *(const PG8_LAS f32x4*)(xr + (ai * HALF + wr * 64 + m * 16 + fr) * 4);
                const float sc = __builtin_amdgcn_rsqf(((p4[0] + p4[1]) + (p4[2] + p4[3])) * (1.0f / 192.0f) + RMS_EPS_) * rs * c2q;
                EPI_ACC8(va, ai, 0, m); EPI_ACC8(vb, ai, 1, m);
#pragma unroll
                for (int e = 0; e < 8; ++e) { va[e] *= sc * (e < 4 ? gA0[e & 3] : gA1[e & 3]); vb[e] *= sc * (e < 4 ? gB0[e & 3] : gB1[e & 3]); }
                bf16_t* qrow = QP + (row * 1536u + head * 192u);
                if (wc == 3) {
                    float cc[8], sn[8]; rope8(csm, row, 8 * fq, cc, sn);
#pragma unroll
                    for (int e = 0; e < 8; ++e) { const float a_ = va[e], b_ = vb[e]; va[e] = a_ * cc[e] - b_ * sn[e]; vb[e] = b_ * cc[e] + a_ * sn[e]; }
                }
                *(u32x4*)(qrow + dA) = pack8(va);
                if (wc == 0 || wc == 3) *(u32x4*)(qrow + dB) = pack8(vb); }
    }
};

template <int MODE> struct EpiRowAct {
    static constexpr bool PERM = true, AFTER_DRAIN = false, TWICE_OK = false; static __device__ __forceinline__ bool twice(const Unit&) { return true; }
    bf16_t* O; int ldo; const float* rsrc; float inv_dim;
    __device__ __forceinline__ void operator()(const f32x4 (&acc)[2][2][4][2], const Unit& u, int wr, int wc, int fr, int fq) const {
        const int rowt = u.pm * BM + wr * 64 + fr, colt = u.pn * BM + wc * 32 + 8 * fq;
#pragma unroll
        for (int ai = 0; ai < 2; ++ai)
#pragma unroll
            for (int m = 0; m < 4; ++m) { const int row = rowt + ai * HALF + m * 16; const float r0 = rsrc[row]; const float rs = inv_dim == 0.f ? r0 : __builtin_amdgcn_rsqf(r0 * inv_dim + RMS_EPS_);
#pragma unroll
                for (int bj = 0; bj < 2; ++bj) { EPI_ACC8(v, ai, bj, m);
#pragma unroll
                    for (int e = 0; e < 8; ++e) { float x = v[e] * rs; if (MODE == 1) x = sigmoidf_(x); if (MODE == 2) { x = fmaxf(x, 0.f); x = x * x; } v[e] = x; }
                    st16(O + (size_t)row * ldo + colt + bj * HALF, pack8(v)); } }
    }
};
struct EpiRetGate {
    static constexpr bool PERM = true, AFTER_DRAIN = false, TWICE_OK = false; static __device__ __forceinline__ bool twice(const Unit&) { return false; }
    bf16_t* RO; const float* rstdx; const float* ssq_ro; const float* ret_norm;
    __device__ __forceinline__ void operator()(const f32x4 (&acc)[2][2][4][2], const Unit& u, int wr, int wc, int fr, int fq) const {
        const int rowt = u.pm * BM + wr * 64 + fr, colt = u.pn * BM + wc * 32 + 8 * fq, head = u.pn >> 1;
        f32x4 g[2][2];
#pragma unroll
        for (int bj = 0; bj < 2; ++bj) { g[bj][0] = *(const f32x4*)(ret_norm + colt + bj * HALF); g[bj][1] = *(const f32x4*)(ret_norm + colt + bj * HALF + 4); }
#pragma unroll
        for (int ai = 0; ai < 2; ++ai)
#pragma unroll
            for (int m = 0; m < 4; ++m) { const int row = rowt + ai * HALF + m * 16; const float rs = rstdx[row]; const f32x4* sp = (const f32x4*)(ssq_ro + ((size_t)row * 4 + head) * 16); const f32x4 s4 = (sp[0] + sp[1]) + (sp[2] + sp[3]);
                const float rr = __builtin_amdgcn_rsqf(((s4[0] + s4[1]) + (s4[2] + s4[3])) * (1.0f / 512.0f) + RMS_EPS_);
#pragma unroll
                for (int bj = 0; bj < 2; ++bj) { EPI_ACC8(v, ai, bj, m); bf16_t* p = RO + (size_t)row * 2048 + colt + bj * HALF; float o[8]; unpack8(*(const u32x4*)p, o);
#pragma unroll
                    for (int e = 0; e < 8; ++e) { const float x = v[e] * rs; const float gg = e < 4 ? g[bj][0][e & 3] : g[bj][1][e & 3]; v[e] = o[e] * rr * gg * x * sigmoidf_(x); }
                    *(u32x4*)p = pack8(v); } }
    }
};
template <int MODE> struct EpiGateMix {
    static constexpr bool PERM = true, AFTER_DRAIN = false, TWICE_OK = false; static __device__ __forceinline__ bool twice(const Unit&) { return false; }
    bf16_t* TM; const bf16_t* SG; int sgoff;
    __device__ __forceinline__ void operator()(const f32x4 (&acc)[2][2][4][2], const Unit& u, int wr, int wc, int fr, int fq) const {
        const int rowt = u.pm * BM + wr * 64 + fr, colt = u.pn * BM + wc * 32 + 8 * fq;
#pragma unroll
        for (int ai = 0; ai < 2; ++ai)
#pragma unroll
            for (int m = 0; m < 4; ++m) { const int row = rowt + ai * HALF + m * 16;
#pragma unroll
                for (int bj = 0; bj < 2; ++bj) { EPI_ACC8(v, ai, bj, m); float s[8]; unpack8(*(const u32x4*)(SG + (size_t)row * 2048 + sgoff + colt + bj * HALF), s);
                    bf16_t* p = TM + (size_t)row * 1024 + colt + bj * HALF;
                    if (MODE == 1) { float t[8]; unpack8(*(const u32x4*)p, t);
#pragma unroll
                        for (int e = 0; e < 8; ++e) v[e] = t[e] + s[e] * v[e]; }
                    else {
#pragma unroll
                        for (int e = 0; e < 8; ++e) v[e] = s[e] * v[e]; }
                    *(u32x4*)p = pack8(v); } }
    }
};
template <bool RESB> struct EpiResid {
    static constexpr bool PERM = true, AFTER_DRAIN = false, TWICE_OK = false; static __device__ __forceinline__ bool twice(const Unit&) { return false; }
    const void* res; bf16_t* xb; float* ssq;
    __device__ __forceinline__ void operator()(const f32x4 (&acc)[2][2][4][2], const Unit& u, int wr, int wc, int fr, int fq) const {
        const int rowt = u.pm * BM + wr * 64 + fr, colt = u.pn * BM + wc * 32 + 8 * fq;
#pragma unroll
        for (int ai = 0; ai < 2; ++ai)
#pragma unroll
            for (int m = 0; m < 4; ++m) { const int row = rowt + ai * HALF + m * 16; float q = 0.f;
#pragma unroll
                for (int bj = 0; bj < 2; ++bj) { EPI_ACC8(v, ai, bj, m); const size_t off = (size_t)row * 1024 + colt + bj * HALF;
                    if (RESB) { float r[8]; unpack8(*(const u32x4*)((const bf16_t*)res + off), r);
#pragma unroll
                        for (int e = 0; e < 8; ++e) { v[e] += r[e]; q += v[e] * v[e]; } }
                    else { const f32x4 r0 = *(const f32x4*)((const float*)res + off), r1 = *(const f32x4*)((const float*)res + off + 4);
#pragma unroll
                        for (int e = 0; e < 8; ++e) { v[e] += e < 4 ? r0[e & 3] : r1[e & 3]; q += v[e] * v[e]; } }
                    *(u32x4*)(xb + off) = pack8(v); }
                q += __shfl_xor(q, 16); q += __shfl_xor(q, 32); if (fq == 0) atomicAdd(ssq + row, q);
                if (m & 1) asm volatile("" ::: "memory"); }
    }
};
struct EpiFinal {
    static constexpr bool PERM = true, AFTER_DRAIN = false, TWICE_OK = false; static __device__ __forceinline__ bool twice(const Unit&) { return false; }
    float* out; const bf16_t* GT; const bf16_t* xb;
    __device__ __forceinline__ void operator()(const f32x4 (&acc)[2][2][4][2], const Unit& u, int wr, int wc, int fr, int fq) const {
        const int rowt = u.pm * BM + wr * 64 + fr, colt = u.pn * BM + wc * 32 + 8 * fq;
#pragma unroll
        for (int ai = 0; ai < 2; ++ai)
#pragma unroll
            for (int m = 0; m < 4; ++m) { const int row = rowt + ai * HALF + m * 16;
#pragma unroll
                for (int bj = 0; bj < 2; ++bj) { EPI_ACC8(v, ai, bj, m); const size_t off = (size_t)row * 1024 + colt + bj * HALF; float gt[8], r[8]; unpack8(*(const u32x4*)(GT + off), gt); unpack8(*(const u32x4*)(xb + off), r);
#pragma unroll
                    for (int e = 0; e < 8; ++e) v[e] = r[e] + gt[e] * v[e];
                    *(f32x4*)(out + off) = (f32x4){v[0], v[1], v[2], v[3]}; *(f32x4*)(out + off + 4) = (f32x4){v[4], v[5], v[6], v[7]}; }
                if (m & 1) asm volatile("" ::: "memory"); }
    }
};
template <class Epi, class Sched, bool ALIGN_EPI = false, bool SP2 = false>
__device__ __forceinline__ void gemm_phase(PG8_LAS unsigned char* lds, const Gemm g, const Sched& S, const Epi& E) {
    int tid = threadIdx.x; asm volatile("" : "+v"(tid));
    const int wid = __builtin_amdgcn_readfirstlane(tid >> 6), lane = tid & 63, wr = wid >> 2, wc = wid & 3, fr = lane & 15, fq = lane >> 4;
    int K = g.K; if (g.K < 512) asm volatile("" : "+s"(K));
    const int nt = K / BK;
    unsigned voffA[2], voffB[2];
#pragma unroll
    for (int i = 0; i < 2; ++i) { int R, C; stage_rc(tid * 16 + i * 8192, R, C); const int Rb = Epi::PERM ? ((R & ~31) + perm32(R & 31)) : R;
        voffA[i] = (unsigned)(R * g.lda + C) * 2u; voffB[i] = (unsigned)(Rb * g.ldb + C) * 2u; }
    const size_t kstep = (size_t)(BK * 2);
    const size_t hstepA = (size_t)HALF * g.lda * 2, hstepB = (size_t)HALF * g.ldb * 2;
    const size_t tstepA = 2 * hstepA, tstepB = 2 * hstepB;
    const unsigned ldsw = (unsigned)wid * 1024u;
    const int aoff = lds_byte(wr * 64 + fr, fq * 8), boff = lds_byte(wc * 32 + fr, fq * 8);
#define PG8_SA(b, h) (((b) * 2 + (h)) * HTB)
#define PG8_SB(b, h) ((4 + (b) * 2 + (h)) * HTB)
#define PG8_STAGE(bufoff, gbase, voff) do { _Pragma("unroll") for (int _i = 0; _i < 2; ++_i) \
        __builtin_amdgcn_global_load_lds((const unsigned*)((const char*)(gbase) + (voff)[_i]), (PG8_LAS unsigned*)(lds + (bufoff) + ldsw + _i * 8192), 16, 0, 0); } while (0)
#define PG8_LDA(dst, b, h) do { _Pragma("unroll") for (int m = 0; m < 4; ++m) _Pragma("unroll") for (int k = 0; k < 2; ++k) dst[m][k] = *(const PG8_LAS bf16x8*)(lds + PG8_SA(b, h) + aoff + m * 2048 + k * 1024); } while (0)
#define PG8_LDB(dst, b, h) do { _Pragma("unroll") for (int n = 0; n < 2; ++n) _Pragma("unroll") for (int k = 0; k < 2; ++k) dst[n][k] = *(const PG8_LAS bf16x8*)(lds + PG8_SB(b, h) + boff + n * 2048 + k * 1024); } while (0)
#define PG8_MMA(ai, bj, At, Bt) do { __builtin_amdgcn_s_setprio(1); _Pragma("unroll") for (int m = 0; m < 4; ++m) _Pragma("unroll") for (int n = 0; n < 2; ++n) _Pragma("unroll") for (int k = 0; k < 2; ++k) \
        acc[ai][bj][m][n] = __builtin_amdgcn_mfma_f32_16x16x32_bf16(Bt[n][k], At[m][k], acc[ai][bj][m][n], 0, 0, 0); __builtin_amdgcn_s_setprio(0); } while (0)
#define PG8_WAIT_V(n) asm volatile("s_waitcnt vmcnt(" #n ")" ::: "memory")
#define PG8_WAIT_L(n) asm volatile("s_waitcnt lgkmcnt(" #n ")" ::: "memory")
#define PG8_BAR __builtin_amdgcn_s_barrier()
#define PG8_SCHED __builtin_amdgcn_sched_barrier(0)
    Unit cur, nxt; int ui = 0;
    if (!S.next(0, cur)) return;
    f32x4 acc[2][2][4][2];
#pragma unroll
    for (int a = 0; a < 2; ++a)
#pragma unroll
        for (int b = 0; b < 2; ++b)
#pragma unroll
            for (int m = 0; m < 4; ++m)
#pragma unroll
                for (int n = 0; n < 2; ++n) acc[a][b][m][n] = (f32x4){0.f, 0.f, 0.f, 0.f};
    bf16x8 At[4][2], B0[2][2], B1[2][2];
    const char* cA = (const char*)g.A + (size_t)cur.pm * tstepA; const char* cB = (const char*)g.Bt + (size_t)cur.pn * tstepB;
    S.a_ready(cur);
    if constexpr (SP2) {
        PG8_STAGE(PG8_SB(0, 0), cB, voffB); PG8_STAGE(PG8_SB(0, 1), cB + hstepB, voffB); PG8_STAGE(PG8_SA(0, 0), cA, voffA); PG8_STAGE(PG8_SA(0, 1), cA + hstepA, voffA);
        if (wr == 1) PG8_BAR;
        PG8_WAIT_V(2); PG8_BAR;
        PG8_STAGE(PG8_SB(1, 0), cB + kstep, voffB); PG8_STAGE(PG8_SA(1, 0), cA + kstep, voffA); PG8_STAGE(PG8_SB(1, 1), cB + hstepB + kstep, voffB);
        PG8_WAIT_V(6); PG8_BAR;
    } else {
        PG8_STAGE(PG8_SB(0, 0), cB, voffB); PG8_STAGE(PG8_SA(0, 0), cA, voffA); PG8_STAGE(PG8_SB(0, 1), cB + hstepB, voffB); PG8_STAGE(PG8_SA(0, 1), cA + hstepA, voffA);
        if (wr == 1) PG8_BAR;
        PG8_WAIT_V(4); PG8_BAR;
        PG8_STAGE(PG8_SB(1, 0), cB + kstep, voffB); PG8_STAGE(PG8_SA(1, 0), cA + kstep, voffA); PG8_STAGE(PG8_SB(1, 1), cB + hstepB + kstep, voffB);
        PG8_WAIT_V(6); PG8_BAR;
    }
    for (;;) {
        const bool has_next = S.next(ui + 1, nxt);
        const char* nA = has_next ? (const char*)g.A + (size_t)nxt.pm * tstepA : cA; const char* nB = has_next ? (const char*)g.Bt + (size_t)nxt.pn * tstepB : cB;
        for (int t = 0; t < nt; t += 2) {
            const bool last = (t == nt - 2);
            const char* a1 = cA + (size_t)(t + 1) * kstep;
            const char* a2 = last ? nA : cA + (size_t)(t + 2) * kstep; const char* b2 = last ? nB : cB + (size_t)(t + 2) * kstep;
            const char* a3 = a2 + kstep; const char* b3 = b2 + kstep;
            if (last && has_next) S.a_ready(nxt);
            if constexpr (SP2) {
            PG8_LDB(B0, 0, 0); PG8_LDB(B1, 0, 1); PG8_SCHED; PG8_LDA(At, 0, 0); PG8_STAGE(PG8_SA(1, 1), a1 + hstepA, voffA);
            PG8_WAIT_V(8); PG8_WAIT_L(0); PG8_BAR; PG8_MMA(0, 0, At, B0); PG8_MMA(0, 1, At, B1); PG8_BAR; PG8_SCHED;
            PG8_LDA(At, 0, 1); PG8_STAGE(PG8_SB(0, 0), b2, voffB); PG8_STAGE(PG8_SB(0, 1), b2 + hstepB, voffB); PG8_STAGE(PG8_SA(0, 0), a2, voffA);
            PG8_WAIT_V(8); PG8_WAIT_L(0); PG8_BAR; PG8_MMA(1, 0, At, B0); PG8_MMA(1, 1, At, B1); PG8_BAR; PG8_SCHED;
            PG8_LDB(B0, 1, 0); PG8_LDB(B1, 1, 1); PG8_SCHED; PG8_LDA(At, 1, 0); PG8_STAGE(PG8_SA(0, 1), a2 + hstepA, voffA);
            PG8_WAIT_V(8); PG8_WAIT_L(0); PG8_BAR; PG8_MMA(0, 0, At, B0); PG8_MMA(0, 1, At, B1); PG8_BAR; PG8_SCHED;
            PG8_LDA(At, 1, 1); PG8_STAGE(PG8_SB(1, 0), b3, voffB); PG8_STAGE(PG8_SB(1, 1), b3 + hstepB, voffB); PG8_STAGE(PG8_SA(1, 0), a3, voffA);
            PG8_WAIT_V(8); PG8_WAIT_L(0); PG8_BAR; PG8_MMA(1, 0, At, B0); PG8_MMA(1, 1, At, B1); PG8_BAR; PG8_SCHED;
            } else {
            PG8_LDB(B0, 0, 0); PG8_SCHED; PG8_LDA(At, 0, 0); PG8_STAGE(PG8_SA(1, 1), a1 + hstepA, voffA);
            PG8_WAIT_L(8); PG8_BAR; PG8_WAIT_L(0); PG8_MMA(0, 0, At, B0); PG8_BAR; PG8_SCHED;
            PG8_LDB(B1, 0, 1); PG8_STAGE(PG8_SB(0, 0), b2, voffB);
            PG8_BAR; PG8_WAIT_L(0); PG8_MMA(0, 1, At, B1); PG8_BAR;
            PG8_LDA(At, 0, 1); PG8_STAGE(PG8_SA(0, 0), a2, voffA);
            PG8_BAR; PG8_WAIT_L(0); PG8_MMA(1, 0, At, B0); PG8_BAR; PG8_SCHED;
            PG8_STAGE(PG8_SB(0, 1), b2 + hstepB, voffB);
            PG8_WAIT_V(6); PG8_BAR; PG8_MMA(1, 1, At, B1); PG8_BAR;
            PG8_LDB(B0, 1, 0); PG8_SCHED; PG8_LDA(At, 1, 0); PG8_STAGE(PG8_SA(0, 1), a2 + hstepA, voffA);
            PG8_WAIT_L(8); PG8_BAR; PG8_WAIT_L(0); PG8_MMA(0, 0, At, B0); PG8_BAR; PG8_SCHED;
            PG8_LDB(B1, 1, 1); PG8_STAGE(PG8_SB(1, 0), b3, voffB);
            PG8_BAR; PG8_WAIT_L(0); PG8_MMA(0, 1, At, B1); PG8_BAR;
            PG8_LDA(At, 1, 1); PG8_STAGE(PG8_SA(1, 0), a3, voffA);
            PG8_BAR; PG8_WAIT_L(0); PG8_MMA(1, 0, At, B0); PG8_BAR; PG8_SCHED;
            PG8_STAGE(PG8_SB(1, 1), b3 + hstepB, voffB);
            PG8_WAIT_V(6); PG8_BAR; PG8_MMA(1, 1, At, B1); PG8_BAR;
            }
        }
        if constexpr (ALIGN_EPI) { if (wr == 0) PG8_BAR; }
        if constexpr (!Epi::AFTER_DRAIN) { E(acc, cur, wr, wc, fr, fq);
#ifdef EPI_TWICE
            if constexpr (Epi::TWICE_OK) { asm volatile("" ::: "memory"); if (Epi::twice(cur)) E(acc, cur, wr, wc, fr, fq); }
#endif
            S.done(cur); }
        if (!has_next) break;
#pragma unroll
        for (int a = 0; a < 2; ++a)
#pragma unroll
            for (int b = 0; b < 2; ++b)
#pragma unroll
                for (int m = 0; m < 4; ++m)
#pragma unroll
                    for (int n = 0; n < 2; ++n) acc[a][b][m][n] = (f32x4){0.f, 0.f, 0.f, 0.f};
        cur = nxt; cA = nA; cB = nB; ++ui;
        if constexpr (ALIGN_EPI) { if (wr == 1) PG8_BAR; }
    }
    PG8_WAIT_V(0);
    if constexpr (!ALIGN_EPI) { if (wr == 0) PG8_BAR; }
    PG8_BAR;
    if constexpr (Epi::AFTER_DRAIN) { E.fused(acc, cur, wr, wc, fr, fq, lds, wid, lane); S.done(cur); }
#undef PG8_SA
#undef PG8_SB
#undef PG8_STAGE
#undef PG8_LDA
#undef PG8_LDB
#undef PG8_MMA
#undef PG8_WAIT_V
#undef PG8_WAIT_L
#undef PG8_BAR
#undef PG8_SCHED
}
}
#define GAS __attribute__((address_space(1)))
#define LAS __attribute__((address_space(3)))
typedef unsigned short bf16;
typedef unsigned v4u __attribute__((ext_vector_type(4)));
typedef float f32x4 __attribute__((ext_vector_type(4)));
typedef short bf16x8 __attribute__((ext_vector_type(8)));
typedef GAS unsigned gu32;
typedef GAS unsigned long long gu64;
#define RLX_AGENT __ATOMIC_RELAXED, __HIP_MEMORY_SCOPE_AGENT
#define LDS_WAIT() asm volatile("s_waitcnt lgkmcnt(0)" ::: "memory")
#define VM_WAIT() asm volatile("s_waitcnt vmcnt(0)" ::: "memory")
__device__ __forceinline__ unsigned long long rt() { return __builtin_amdgcn_s_memrealtime(); }
__device__ __forceinline__ unsigned f2bf(float f) { unsigned u = __builtin_bit_cast(unsigned, f); return (u + 0x7fffu + ((u >> 16) & 1u)) >> 16; }
__device__ __forceinline__ unsigned pk2(float lo, float hi) { return f2bf(lo) | (f2bf(hi) << 16); }

#define XB_TMO      128
#define XB_XCNT(j)  (256  + 64 * (j))
#define XB_XSUB(j)  (1280 + 64 * (j))
#define XB_XGEN(j)  (2304 + 64 * (j))
#define XB_TOP      3328
#define XB_TOPGEN   3392
#define XCD_BAR_WORDS 3456
#define XB_SPIN_CAP (1u << 18)

__device__ __forceinline__ unsigned xb_ld(unsigned* p)              { return __hip_atomic_load(p, __ATOMIC_RELAXED, __HIP_MEMORY_SCOPE_AGENT); }
__device__ __forceinline__ unsigned xb_add(unsigned* p, unsigned v) { return __hip_atomic_fetch_add(p, v, __ATOMIC_RELAXED, __HIP_MEMORY_SCOPE_AGENT); }
__device__ __forceinline__ unsigned xb_xcc_id() { return (unsigned)__builtin_amdgcn_s_getreg((3 << 11) | 20) & 0xFu; }
#define XB_SPIN(cond, bar) do { unsigned _sp = 0; while (cond) { __builtin_amdgcn_s_sleep(1); \
    if ((++_sp & 255u) == 0u) { if (xb_ld(&(bar)[XB_TMO])) break; if (_sp > XB_SPIN_CAP) { atomicAdd(&(bar)[XB_TMO], 1u); break; } } } } while (0)

struct XcdBarrier {
    unsigned* bar; unsigned x;
    volatile LAS unsigned* st;
};

__device__ __forceinline__ XcdBarrier xcd_barrier_post(unsigned* bar, volatile LAS unsigned* st) {
    XcdBarrier b; b.bar = bar; b.x = xb_xcc_id(); b.st = st;
    if (threadIdx.x == 0) st[2] = xb_add(&bar[XB_XCNT(b.x)], 1u);
    return b;
}
__device__ __forceinline__ void xcd_barrier_complete(unsigned* bar, unsigned x, unsigned& nloc, unsigned& nx) {
    const unsigned G = gridDim.x * gridDim.y * gridDim.z;
    unsigned sum, cnt, mine, sp = 0u;
    for (;;) {
        sum = 0u; cnt = 0u; mine = 0u;
#pragma unroll
        for (unsigned j = 0; j < 16; ++j) { const unsigned c = xb_ld(&bar[XB_XCNT(j)]); sum += c; cnt += (c > 0u) ? 1u : 0u; mine = (j == x) ? c : mine; }
        if (sum == G) break;
        __builtin_amdgcn_s_sleep(1);
        if ((++sp & 255u) == 0u) { if (xb_ld(&bar[XB_TMO])) break; if (sp > XB_SPIN_CAP) { atomicAdd(&bar[XB_TMO], 1u); break; } }
    }
    nloc = mine > 0u ? mine : 1u; nx = cnt > 0u ? cnt : 1u;
}

__device__ __forceinline__ void xcd_barrier(const XcdBarrier& b) {
    asm volatile("s_waitcnt vmcnt(0)" ::: "memory");
    __syncthreads();
    if (threadIdx.x == 0) {
        unsigned* bar = b.bar;
        __builtin_amdgcn_s_waitcnt(0);
        unsigned nloc = b.st[0], nx = b.st[1];
        if (nloc == 0u) { xcd_barrier_complete(bar, b.x, nloc, nx); b.st[0] = nloc; b.st[1] = nx; }
        const unsigned old = xb_add(&bar[XB_XSUB(b.x)], 1u);
        const unsigned gen = old / nloc;
        if (old + 1u == (gen + 1u) * nloc) {
            __builtin_amdgcn_fence(__ATOMIC_RELEASE, "agent");
            asm volatile("s_waitcnt vmcnt(0)" ::: "memory");
            const unsigned og = xb_add(&bar[XB_TOP], 1u);
            const unsigned tg = og / nx;
            if (og + 1u == (tg + 1u) * nx) xb_add(&bar[XB_TOPGEN], 1u);
            else XB_SPIN(xb_ld(&bar[XB_TOPGEN]) == tg, bar);
            __builtin_amdgcn_fence(__ATOMIC_ACQUIRE, "agent");
            xb_add(&bar[XB_XGEN(b.x)], 1u);
            asm volatile("s_waitcnt vmcnt(0)" ::: "memory");
        } else {
            XB_SPIN(xb_ld(&bar[XB_XGEN(b.x)]) == gen, bar);
            __builtin_amdgcn_fence(__ATOMIC_ACQUIRE, "agent");
            asm volatile("s_waitcnt vmcnt(0)" ::: "memory");
        }
    }
    __syncthreads();
}


#define XB_LSUB(j)  (3520 + 64 * (j))
#define XB_LGEN(j)  (4544 + 64 * (j))
#define XCD_BAR_WORDS_ALL 5632
__device__ __forceinline__ void xcd_local_barrier(const XcdBarrier& b) {
    asm volatile("s_waitcnt vmcnt(0)" ::: "memory");
    __syncthreads();
    if (threadIdx.x == 0) {
        unsigned* bar = b.bar; __builtin_amdgcn_s_waitcnt(0);
        const unsigned nloc = b.st[0];
        const unsigned old = xb_add(&bar[XB_LSUB(b.x)], 1u), gen = old / nloc;
        if (old + 1u == (gen + 1u) * nloc) { __builtin_amdgcn_fence(__ATOMIC_ACQUIRE, "agent"); xb_add(&bar[XB_LGEN(b.x)], 1u); asm volatile("s_waitcnt vmcnt(0)" ::: "memory"); }
        else { XB_SPIN(xb_ld(&bar[XB_LGEN(b.x)]) == gen, bar); __builtin_amdgcn_fence(__ATOMIC_ACQUIRE, "agent"); asm volatile("s_waitcnt vmcnt(0)" ::: "memory"); }
    }
    __syncthreads();
}

typedef float f32x2 __attribute__((ext_vector_type(2)));
constexpr int NWAVES = 8;
constexpr int BATCH = 4, SEQ = 4096, DM = 1024, MTOK = BATCH * SEQ;
constexpr int NIN1 = 5120;
constexpr int LATW = 640;
constexpr float C2Q = 0.07216878364870323f * 1.4426950408889634f;

constexpr size_t MiB = 1u << 20, KiB = 1u << 10;
constexpr size_t WS_CTL = 0, CTL_ZERO_BYTES = 64 * KiB;
constexpr size_t WS_SMALL = 1 * MiB;
constexpr size_t SM_RSTDX = 0, SM_SSQ_CQ = 64 * KiB, SM_SSQ_CKV = 128 * KiB, SM_SSQ1 = 192 * KiB, SM_SSQ2 = 256 * KiB, SM_SSQ_KR = 320 * KiB, SM_END = 384 * KiB;
constexpr size_t WS_WIN = 2 * MiB;
constexpr size_t WS_SSQP = 10 * MiB;
constexpr size_t WS_WUQ = 20 * MiB;
constexpr size_t WS_WUKV = WS_WUQ + (size_t)2048 * 384 * 2;
constexpr size_t WS_KR = 22 * MiB + 512 * KiB;
constexpr size_t WS_XB = 25 * MiB;
constexpr size_t WS_CS = 57 * MiB;
constexpr size_t WS_LAT = 73 * MiB;
constexpr size_t WS_RQ = 94 * MiB, WS_RK = 126 * MiB, WS_RKDT = 158 * MiB, WS_RVT = 190 * MiB;
constexpr size_t WS_QP = 94 * MiB, WS_KF = 142 * MiB, WS_VV = 190 * MiB;
constexpr size_t WS_MO = 57 * MiB;
constexpr size_t WS_SG = 94 * MiB, WS_TM = 158 * MiB;
constexpr size_t WS_WBR = 190 * MiB, WS_WBM = 194 * MiB, WS_WO = 196 * MiB, WS_WUP = 198 * MiB, WS_WDOWN = 206 * MiB, WS_WPG = 214 * MiB, WS_WPLE = 18 * MiB;
constexpr size_t WS_PB = 10 * MiB;
constexpr size_t WS_H = 57 * MiB;
constexpr size_t WS_GT = 217 * MiB;
constexpr size_t WS_CSM = 254 * MiB;
constexpr size_t WS_END = 256 * MiB;
static_assert(SM_SSQ_CKV == SM_SSQ_CQ + 65536, "ssq_lat layout");
static_assert(WS_WIN + (size_t)9216 * 2048 <= WS_WUQ && WS_WUKV + (size_t)2048 * 256 * 2 <= WS_KR && WS_KR + 2 * MiB <= WS_XB && WS_LAT + 20 * MiB <= WS_RQ && WS_RVT + 64 * MiB <= WS_END && WS_H + 128 * MiB <= WS_WBR && WS_PB + 8 * MiB <= WS_WPLE && WS_WPLE + 512 * KiB <= WS_WUQ && WS_WPG + 2 * MiB <= WS_GT && WS_GT + 32 * MiB <= WS_CSM, "d_ws map");
constexpr int CW_BAR = 1024;

constexpr int RING_OFF = 0, RING_BYTES = 131072;
constexpr int XS_OFF = RING_BYTES, XS_BYTES = 8 * 2304;
constexpr int MISC_OFF = XS_OFF + XS_BYTES;
constexpr int LDS_BYTES = 160 * 1024;
static_assert(MISC_OFF + 128 <= LDS_BYTES, "LDS map");

struct Frame {
    LAS unsigned char* lds; volatile LAS unsigned* MISC; int tid, lane, wave, G, vcu;
    float* out; unsigned char* ws;
};
__device__ __forceinline__ float wave_sum(float v) {
#pragma unroll
    for (int o = 1; o < 64; o <<= 1) v += __shfl_xor(v, o);
    return v;
}
__device__ __forceinline__ void p0_transpose_item(const float* W, int ldw, int K, int src_col, bf16* WT, int dst_row, int ncols, const float* gain, LAS float* scr, int item, int lane) {
    const int nblk = ncols / 32, kb = item / nblk, nb = item % nblk, k0 = 64 * kb, n0 = 32 * nb;
#pragma unroll 16
    for (int i = 0; i < 32; ++i) { const int kk = 2 * i + (lane >> 5); const float gk = gain ? gain[k0 + kk] : 1.0f; scr[kk * 33 + (lane & 31)] = W[(size_t)(k0 + kk) * ldw + src_col + n0 + (lane & 31)] * gk; }
    LDS_WAIT(); asm volatile("" ::: "memory");
    const int c = lane & 7;
#pragma unroll
    for (int j = 0; j < 4; ++j) { const int n = (lane >> 3) + 8 * j; const LAS float* s = scr + (8 * c) * 33 + n;
        v4u o; o.x = pk2(s[0 * 33], s[1 * 33]); o.y = pk2(s[2 * 33], s[3 * 33]); o.z = pk2(s[4 * 33], s[5 * 33]); o.w = pk2(s[6 * 33], s[7 * 33]);
        *(GAS v4u*)(WT + (size_t)(dst_row + n0 + n) * K + k0 + 8 * c) = o; }
    LDS_WAIT(); asm volatile("" ::: "memory");
}
struct XT { const float* src; bf16* dst; const float* gain; int ldw, K; };
#define XT_SEG(W_, ldw_, K_, src_, WT_, dst_, ncols_, gain_) { const int n_ = ((K_) / 64) * ((ncols_) / 128); if (r < n_) { const int nblk_ = (ncols_) / 128, kb_ = r / nblk_, nb_ = r - kb_ * nblk_; \
        x.src = (W_) + (size_t)(64 * kb_) * (ldw_) + (src_) + 128 * nb_; x.dst = (WT_) + (size_t)((dst_) + 128 * nb_) * (K_) + 64 * kb_; x.gain = (gain_) ? (gain_) + 64 * kb_ : (const float*)nullptr; x.ldw = (ldw_); x.K = (K_); return x; } r -= n_; }
__device__ __forceinline__ void xt_load(const XT& x, int tid, f32x4 (&v)[4], float (&g)[4]) {
#pragma unroll
    for (int i = 0; i < 4; ++i) { const int row = i * 16 + (tid >> 5); v[i] = *(const GAS f32x4*)(x.src + (size_t)row * x.ldw + 4 * (tid & 31)); g[i] = x.gain ? x.gain[row] : 1.0f; }
}
template <class Dec> __device__ __forceinline__ void xt_run(Frame& F, int ntiles, const Dec& dec) {
    LAS float* scr = (LAS float*)(F.lds + RING_OFF);
    const int tid = F.tid; int t = F.vcu; if (t >= ntiles) return;
    XT cur = dec(t); f32x4 v[4]; float g[4]; xt_load(cur, tid, v, g);
    for (;;) {
        const int tn = t + F.G; const bool has = tn < ntiles; const XT nxt = has ? dec(tn) : cur;
        __syncthreads();
#pragma unroll
        for (int i = 0; i < 4; ++i) *(LAS f32x4*)(scr + (i * 16 + (tid >> 5)) * 132 + 4 * (tid & 31)) = v[i] * g[i];
        if (has) xt_load(nxt, tid, v, g);
        __syncthreads();
        const int n = tid >> 2, kq = tid & 3;
#pragma unroll
        for (int j = 0; j < 2; ++j) { const int kc = kq + 4 * j; const LAS float* s = scr + (8 * kc) * 132 + n;
            v4u o; o.x = pk2(s[0 * 132], s[1 * 132]); o.y = pk2(s[2 * 132], s[3 * 132]); o.z = pk2(s[4 * 132], s[5 * 132]); o.w = pk2(s[6 * 132], s[7 * 132]);
            *(GAS v4u*)(cur.dst + (size_t)n * cur.K + 8 * kc) = o; }
        if (!has) break;
        cur = nxt; t = tn;
    }
    __syncthreads();
}
#define P0_SEG(W, ldw, K, src, WT, dst, ncols, gain) { const int n_ = ((K) / 64) * ((ncols) / 32); if (r < n_) { p0_transpose_item(W, ldw, K, src, WT, dst, ncols, gain, scr, r, F.lane); continue; } r -= n_; }
__device__ __forceinline__ void phase_p0(Frame& F, const float* x, const int* pos, const float* g_mix, const float* w_in, const float* g_qlat, const float* g_kvlat, const float* w_uq, const float* w_ukv) {
    LAS float* scr = (LAS float*)(F.lds + RING_OFF + F.wave * 16384);
    const int gw = F.vcu * NWAVES + F.wave, NGW = F.G * NWAVES;
    bf16* WinT = (bf16*)(F.ws + WS_WIN); bf16* WuqT = (bf16*)(F.ws + WS_WUQ); bf16* WukvT = (bf16*)(F.ws + WS_WUKV);
    struct Dec0 { const float *w_in, *g_mix, *w_uq, *g_qlat, *w_ukv, *g_kvlat; bf16 *WinT, *WuqT, *WukvT;
        __device__ __forceinline__ XT operator()(int r) const { XT x;
            XT_SEG(w_in, 8896, 1024, 6848, WinT, 0, 2048, g_mix)
            XT_SEG(w_in, 8896, 1024, 4096, WinT, 2048, 2048, g_mix)
            XT_SEG(w_in, 8896, 1024, 0, WinT, 4096, 4096, g_mix)
            XT_SEG(w_in, 8896, 1024, 6144, WinT, 8192, 640, g_mix)
            XT_SEG(w_ukv, 2048, 256, 0, WukvT, 0, 2048, g_kvlat)
            x.src = w_in; x.dst = WinT; x.gain = nullptr; x.ldw = 8896; x.K = 1024; return x; } };
    { const Dec0 d{w_in, g_mix, w_uq, g_qlat, w_ukv, g_kvlat, WinT, WuqT, WukvT}; xt_run(F, 16 * 16 * 2 + 16 * 32 + 16 * 5 + 4 * 16, d); }
    for (int it = gw; it < 32 + 8 * 36; it += NGW) {
        int r = it;
        P0_SEG(w_in, 8896, 1024, 6784, WinT, 8960, 32, g_mix)
        P0_SEG(w_in, 8896, 1024, 6816, WinT, 8960 + 128, 32, g_mix)
        { const int hh = r / 36; r -= hh * 36;
          P0_SEG(w_uq, 1536, 384, hh * 192, WuqT, hh * 256, 96, g_qlat)
          P0_SEG(w_uq, 1536, 384, hh * 192 + 128, WuqT, hh * 256 + 96, 32, g_qlat)
          P0_SEG(w_uq, 1536, 384, hh * 192 + 96, WuqT, hh * 256 + 128, 32, g_qlat)
          P0_SEG(w_uq, 1536, 384, hh * 192 + 160, WuqT, hh * 256 + 224, 32, g_qlat) }
    }
    for (int gt = F.vcu * 512 + F.tid; gt < 24576; gt += F.G * 512) { const int hh = gt / 3072, rem = gt - hh * 3072; *(GAS v4u*)((unsigned char*)(WuqT + (size_t)(hh * 256 + 160) * 384) + (size_t)rem * 16) = (v4u){0u, 0u, 0u, 0u}; }
    for (int gt = F.vcu * 512 + F.tid; gt < 40960; gt += F.G * 512) { const int row = gt >> 7, piece = gt & 127; const int wrow = row < 128 ? 8832 + row : (row < 224 ? 8992 + (row - 128) : 9120 + (row - 224));
        *(GAS v4u*)((unsigned char*)(WinT + (size_t)wrow * 1024) + (size_t)piece * 16) = (v4u){0u, 0u, 0u, 0u}; }
    { bf16* XB = (bf16*)(F.ws + WS_XB); float* rstdx = (float*)(F.ws + WS_SMALL + SM_RSTDX);
      for (int m0 = 2 * gw; m0 < MTOK; m0 += 2 * NGW) {
          f32x4 v[2][4]; float s[2] = {0.f, 0.f};
#pragma unroll
          for (int u = 0; u < 2; ++u) { const GAS f32x4* xr = (const GAS f32x4*)(x + (size_t)(m0 + u) * DM) + F.lane;
#pragma unroll
              for (int j = 0; j < 4; ++j) v[u][j] = xr[64 * j]; }
#pragma unroll
          for (int u = 0; u < 2; ++u) {
#pragma unroll
              for (int j = 0; j < 4; ++j) s[u] += (v[u][j].x * v[u][j].x + v[u][j].y * v[u][j].y) + (v[u][j].z * v[u][j].z + v[u][j].w * v[u][j].w);
              s[u] = wave_sum(s[u]);
              GAS unsigned long long* o8 = (GAS unsigned long long*)(XB + (size_t)(m0 + u) * DM) + F.lane;
#pragma unroll
              for (int j = 0; j < 4; ++j) o8[64 * j] = (unsigned long long)pk2(v[u][j].x, v[u][j].y) | ((unsigned long long)pk2(v[u][j].z, v[u][j].w) << 32);
              if (F.lane == 0) rstdx[m0 + u] = 1.0f / sqrtf(s[u] * (1.0f / DM) + 1e-6f); }
      } }
    { f32x2* cs = (f32x2*)(F.ws + WS_CS);
      for (int e = F.vcu * 512 + F.tid; e < MTOK * 128; e += F.G * 512) { const int row = e >> 7, i = e & 127;
          const float inv = __builtin_amdgcn_exp2f(-(float)i * (13.287712379549449f / 128.0f));
          double rev = (double)pos[row] * (double)inv * 0.15915494309189535; rev -= __builtin_rint(rev);
          const float rf = (float)rev; cs[e] = (f32x2){__builtin_amdgcn_cosf(rf), __builtin_amdgcn_sinf(rf)}; } }
    { typedef _Float16 h2_t __attribute__((ext_vector_type(2))); h2_t* csm = (h2_t*)(F.ws + WS_CSM);
      for (int e = F.vcu * 512 + F.tid; e < MTOK * 32; e += F.G * 512) { const int row = e >> 5, i = e & 31;
          const float inv = __builtin_amdgcn_exp2f(-(float)(4 * i) * (13.287712379549449f / 128.0f));
          double rev = (double)pos[row] * (double)inv * 0.15915494309189535; rev -= __builtin_rint(rev);
          const float rf = (float)rev; csm[e] = (h2_t){(_Float16)__builtin_amdgcn_cosf(rf), (_Float16)__builtin_amdgcn_sinf(rf)}; } }
    { float* z = (float*)(F.ws + WS_SMALL + SM_SSQ_CQ); for (int e = F.vcu * 512 + F.tid; e < (int)((SM_END - SM_SSQ_CQ) / 4); e += F.G * 512) z[e] = 0.f; }
}
__device__ __forceinline__ void phase_late_weights(Frame& F, const float* p, const float* w_br, const float* w_bm, const float* w_o, const float* g_mlp, const float* w_up, const float* w_down, const float* g_ple, const float* w_pg, const float* w_ple) {
    struct Dec1 { const float *w_br, *w_bm, *w_o, *g_mlp, *w_up, *w_down, *g_ple, *w_pg, *w_ple; unsigned char* ws;
        __device__ __forceinline__ XT operator()(int r) const { XT x; const float* nog = nullptr;
            XT_SEG(w_br, 1024, 2048, 0, (bf16*)(ws + WS_WBR), 0, 1024, nog)
            XT_SEG(w_bm, 1024, 1024, 0, (bf16*)(ws + WS_WBM), 0, 1024, nog)
            XT_SEG(w_o, 1024, 1024, 0, (bf16*)(ws + WS_WO), 0, 1024, nog)
            XT_SEG(w_up, 4096, 1024, 0, (bf16*)(ws + WS_WUP), 0, 4096, g_mlp)
            XT_SEG(w_down, 1024, 4096, 0, (bf16*)(ws + WS_WDOWN), 0, 1024, nog)
            XT_SEG(w_pg, 1024, 1024, 0, (bf16*)(ws + WS_WPG), 0, 1024, g_ple)
            XT_SEG(w_ple, 1024, 256, 0, (bf16*)(ws + WS_WPLE), 0, 1024, nog)
            x.src = w_br; x.dst = (bf16*)(ws + WS_WBR); x.gain = nullptr; x.ldw = 1024; x.K = 2048; return x; } };
    { const Dec1 d{w_br, w_bm, w_o, g_mlp, w_up, w_down, g_ple, w_pg, w_ple, F.ws}; xt_run(F, 32 * 8 + 16 * 8 * 2 + 16 * 32 + 64 * 8 + 16 * 8 + 4 * 8, d); }
    { bf16* PB = (bf16*)(F.ws + WS_PB);
      for (int e = F.vcu * 512 + F.tid; e < MTOK * 256 / 8; e += F.G * 512) { const f32x4 a = *(const GAS f32x4*)(p + (size_t)e * 8), b = *(const GAS f32x4*)(p + (size_t)e * 8 + 4);
          *(GAS v4u*)(PB + (size_t)e * 8) = (v4u){pk2(a.x, a.y), pk2(a.z, a.w), pk2(b.x, b.y), pk2(b.z, b.w)}; } }
}

typedef float f32x16 __attribute__((ext_vector_type(16)));
typedef unsigned u32x2 __attribute__((ext_vector_type(2)));
typedef short v4i16_t __attribute__((ext_vector_type(4)));
__device__ __forceinline__ int crow(int r, int hi) { return (r & 3) + 8 * (r >> 2) + 4 * hi; }
typedef __bf16 bf16x2m_t __attribute__((ext_vector_type(2)));
__device__ __forceinline__ unsigned cvtpk(float lo, float hi) { f32x2 v = {lo, hi}; bf16x2m_t b = __builtin_convertvector(v, bf16x2m_t); return __builtin_bit_cast(unsigned, b); }
__device__ __forceinline__ bf16x8 pack8f(const f32x16& p, int b) { v4u w = {cvtpk(p[b], p[b + 1]), cvtpk(p[b + 2], p[b + 3]), cvtpk(p[b + 4], p[b + 5]), cvtpk(p[b + 6], p[b + 7])}; return __builtin_bit_cast(bf16x8, w); }
__device__ __forceinline__ float bf2f(bf16 v) { return __uint_as_float((unsigned)v << 16); }
__device__ __forceinline__ float log2_gamma(int h) { return __builtin_amdgcn_logf(1.0f - __builtin_amdgcn_exp2f(-5.0f - (float)h)); }


__device__ __forceinline__ void phase_r0p(Frame& F) {
    const bf16* RQ = (const bf16*)(F.ws + WS_RQ); bf16* RK = (bf16*)(F.ws + WS_RK);
    const int lane = F.lane, w = F.wave, l31 = lane & 31, hi = lane >> 5, tq = w & 3, dh = w >> 2;
    for (int unit = F.vcu; unit < 512; unit += F.G) {
        const int bh = unit >> 5, c = unit & 31, h = bh & 3; const size_t blk = (size_t)bh * 32 + c;
        const float lg2 = log2_gamma(h);
        bf16x8 qf[16];
#pragma unroll
        for (int ks = 0; ks < 16; ++ks) qf[ks] = *(const bf16x8*)(RQ + ((blk * 32 + 2 * ks + hi) * 128 + 32 * tq + l31) * 8);
        f32x16 s[2] = {};
#pragma unroll
        for (int x = 0; x < 2; ++x) { const int tb = 2 * dh + x;
            if (tb <= tq) {
#pragma unroll
                for (int ks = 0; ks < 16; ++ks) { const bf16x8 kf = *(const bf16x8*)(RK + ((blk * 32 + 2 * ks + hi) * 128 + 32 * tb + l31) * 8); s[x] = __builtin_amdgcn_mfma_f32_32x32x16_bf16(kf, qf[ks], s[x], 0, 0, 0); }
#pragma unroll
                for (int r = 0; r < 16; ++r) { const int d = (32 * tq + l31) - (32 * tb + crow(r, hi)); s[x][r] = d >= 0 ? s[x][r] * __builtin_amdgcn_exp2f((float)d * lg2) : 0.f; }
            } }
        VM_WAIT(); __syncthreads();
#pragma unroll
        for (int x = 0; x < 2; ++x) { const int tb = 2 * dh + x;
            if (tb <= tq) {
#pragma unroll
                for (int g = 0; g < 4; ++g) *(u32x2*)(RK + ((blk * 32 + 4 * tb + g) * 128 + 32 * tq + l31) * 8 + 4 * hi) = (u32x2){cvtpk(s[x][4 * g], s[x][4 * g + 1]), cvtpk(s[x][4 * g + 2], s[x][4 * g + 3])};
            } }
    }
}
__device__ __forceinline__ void phase_r1p(Frame& F) {
    const bf16* RQ = (const bf16*)(F.ws + WS_RQ); const bf16* RP = (const bf16*)(F.ws + WS_RK); const bf16* RKDT = (const bf16*)(F.ws + WS_RKDT); const bf16* RVT = (const bf16*)(F.ws + WS_RVT); bf16* RO = (bf16*)F.out;
    float* ssqp = (float*)(F.ws + WS_SSQP);
    const int lane = F.lane, w = F.wave, l15 = lane & 15, lq = lane >> 4;
    constexpr int SROW = 528, SBUF = 32 * SROW;
    LAS unsigned char* ost = F.lds + 2 * SBUF + 1024 + w * 1024;
    const int nkp = (w >> 1) + 1;
    for (int unit = F.vcu; unit < 256; unit += F.G) {
        const int bh = unit >> 4, j = unit & 15, b = bh >> 2, h = bh & 3;
        const float lg2 = log2_gamma(h), gC = __builtin_amdgcn_exp2f(128.0f * lg2);
        float qd[4];
#pragma unroll
        for (int i = 0; i < 4; ++i) qd[i] = __builtin_amdgcn_exp2f((float)(16 * w + 4 * lq + i + 1) * lg2);
        f32x4 S[2][2];
#pragma unroll
        for (int mb = 0; mb < 2; ++mb)
#pragma unroll
            for (int nb = 0; nb < 2; ++nb) S[mb][nb] = (f32x4){0.f, 0.f, 0.f, 0.f};
        __syncthreads();
#pragma unroll
        for (int mb = 0; mb < 2; ++mb)
#pragma unroll
            for (int nb = 0; nb < 2; ++nb) *(LAS u32x2*)(F.lds + (16 * nb + l15) * SROW + (32 * w + 16 * mb + 4 * lq) * 2) = (u32x2){0u, 0u};
        const bf16* qp = RQ + (((size_t)bh * 32 * 32 + lq) * 128 + 16 * w + l15) * 8;
        const bf16* pp = RP + (((size_t)bh * 32 * 32 + lq) * 128 + 16 * w + l15) * 8;
        const bf16* kp = RKDT + (((size_t)bh * 32 * 16 + lq) * 256 + 32 * w + l15) * 8;
        const bf16* vp = RVT + (((size_t)bh * 32 * 16 + (F.tid >> 5)) * 512 + 32 * j + (F.tid & 31)) * 8;
        constexpr size_t QC = 32 * 128 * 8, QK = 4 * 128 * 8, KC = 16 * 256 * 8, KK = 4 * 256 * 8, VC = 16 * 512 * 8;
        bf16x8 QA[8], PA[4], KA[2][4], vpre;
        LAS unsigned char* vl = F.lds + 2 * SBUF + 1024 + 8 * 1024;
#pragma unroll
        for (int ks = 0; ks < 8; ++ks) QA[ks] = *(const bf16x8*)(qp + QK * ks);
#pragma unroll
        for (int ks = 0; ks < 4; ++ks) { PA[ks] = (bf16x8){0, 0, 0, 0, 0, 0, 0, 0}; if (ks < nkp) PA[ks] = *(const bf16x8*)(pp + QK * ks); }
#pragma unroll
        for (int mb = 0; mb < 2; ++mb)
#pragma unroll
            for (int ks = 0; ks < 4; ++ks) KA[mb][ks] = *(const bf16x8*)(kp + mb * 128 + KK * ks);
        vpre = *(const bf16x8*)vp;
        *(LAS bf16x8*)(vl + F.tid * 16) = vpre;
#pragma unroll 1
        for (int c = 0; c < 32; ++c) {
            const int cur = c & 1, cn = c < 31 ? c + 1 : 31; const size_t tok0 = (size_t)b * SEQ + c * 128;
            __syncthreads();
            vpre = *(const bf16x8*)(vp + VC * cn);
            bf16x8 VB[2][4];
#pragma unroll
            for (int nb = 0; nb < 2; ++nb)
#pragma unroll
                for (int ks = 0; ks < 4; ++ks) VB[nb][ks] = *(const LAS bf16x8*)(vl + cur * 8192 + ((4 * ks + lq) * 32 + 16 * nb + l15) * 16);
            f32x4 oc[2] = {(f32x4){0.f, 0.f, 0.f, 0.f}, (f32x4){0.f, 0.f, 0.f, 0.f}};
#pragma unroll
            for (int ks = 0; ks < 8; ++ks)
#pragma unroll
                for (int nb = 0; nb < 2; ++nb) { const bf16x8 bq = *(const LAS bf16x8*)(F.lds + cur * SBUF + (16 * nb + l15) * SROW + (32 * ks + 8 * lq) * 2);
                    oc[nb] = __builtin_amdgcn_mfma_f32_16x16x32_bf16(QA[ks], bq, oc[nb], 0, 0, 0); }
#pragma unroll
            for (int ks = 0; ks < 8; ++ks) QA[ks] = *(const bf16x8*)(qp + QC * cn + QK * ks);
#pragma unroll
            for (int nb = 0; nb < 2; ++nb)
#pragma unroll
                for (int i = 0; i < 4; ++i) oc[nb][i] *= qd[i];
#pragma unroll
            for (int ks = 0; ks < 4; ++ks)
                if (ks < nkp) {
#pragma unroll
                    for (int nb = 0; nb < 2; ++nb) oc[nb] = __builtin_amdgcn_mfma_f32_16x16x32_bf16(PA[ks], VB[nb][ks], oc[nb], 0, 0, 0); }
#pragma unroll
            for (int ks = 0; ks < 4; ++ks) if (ks < nkp) PA[ks] = *(const bf16x8*)(pp + QC * cn + QK * ks);
#pragma unroll
            for (int mb = 0; mb < 2; ++mb)
#pragma unroll
                for (int nb = 0; nb < 2; ++nb) { S[mb][nb] *= gC;
#pragma unroll
                    for (int ks = 0; ks < 4; ++ks) S[mb][nb] = __builtin_amdgcn_mfma_f32_16x16x32_bf16(KA[mb][ks], VB[nb][ks], S[mb][nb], 0, 0, 0); }
#pragma unroll
            for (int mb = 0; mb < 2; ++mb)
#pragma unroll
                for (int ks = 0; ks < 4; ++ks) KA[mb][ks] = *(const bf16x8*)(kp + mb * 128 + KC * cn + KK * ks);
#pragma unroll
            for (int i = 0; i < 4; ++i) { float q = 0.f;
#pragma unroll
                for (int nb = 0; nb < 2; ++nb) { const float v = oc[nb][i]; q += v * v; *(LAS unsigned short*)(ost + ((4 * lq + i) * 32 + 16 * nb + l15) * 2) = (unsigned short)f2bf(v); }
                q += __shfl_xor(q, 1); q += __shfl_xor(q, 2); q += __shfl_xor(q, 4); q += __shfl_xor(q, 8);
                if (l15 == 0) ssqp[((tok0 + 16 * w + 4 * lq + i) * 4 + h) * 16 + j] = q; }
            LDS_WAIT();
            { const v4u ov = *(const LAS v4u*)(ost + lane * 16); *(v4u*)(RO + (tok0 + 16 * w + (lane >> 2)) * 2048 + h * 512 + 32 * j + (lane & 3) * 8) = ov; }
            *(LAS bf16x8*)(vl + (cur ^ 1) * 8192 + F.tid * 16) = vpre;
#pragma unroll
            for (int mb = 0; mb < 2; ++mb)
#pragma unroll
                for (int nb = 0; nb < 2; ++nb) *(LAS u32x2*)(F.lds + (cur ^ 1) * SBUF + (16 * nb + l15) * SROW + (32 * w + 16 * mb + 4 * lq) * 2) = (u32x2){cvtpk(S[mb][nb][0], S[mb][nb][1]), cvtpk(S[mb][nb][2], S[mb][nb][3])};
        }
    }
    __syncthreads();
}

namespace attn2 {
typedef float f32x16 __attribute__((ext_vector_type(16)));
typedef short s16x4 __attribute__((ext_vector_type(4)));
constexpr int NW = 8, QBLK = 32, KVBLK = 64, QB = NW * QBLK;
constexpr int QS = 1536, KS = 1536, VS = 1024, OS = 1024;
constexpr int SHM_V = KVBLK * 128 * 2, SHM_K = KVBLK * 512;
constexpr int OFF_V = 0, OFF_K = 2 * SHM_V, OFF_WS = OFF_K + 2 * SHM_K, OFF_QR = OFF_WS + NW * 64 * 4, LDS_NEED = OFF_QR + NW * 4096;
constexpr float THR2 = 8.0f * 1.4426950408889634f;
#define A2_SBAR() __builtin_amdgcn_sched_barrier(0)
__device__ __forceinline__ int v_st(int k, int c) { const int kk = (k & ~0xC) | ((k & 4) << 1) | ((k & 8) >> 1); return ((kk >> 3) * 4 + (c >> 5)) * 512 + ((kk & 7) * 32 + (c & 31)) * 2; }
__device__ __forceinline__ int v_rd_base(int lane) { return ((lane & 3) << 3) | (((lane >> 2) & 3) << 6) | (((lane >> 4) & 1) << 5) | (((lane >> 5) & 1) << 8); }
constexpr int v_rd_off(int d0, int ks, int half) { return d0 * 512 + ks * 4096 + half * 2048; }
__device__ __forceinline__ int crow(int r, int hi) { return (r & 3) + 8 * (r >> 2) + 4 * hi; }
typedef __bf16 bf16x2a_t __attribute__((ext_vector_type(2)));
__device__ __forceinline__ unsigned cvtpk(float lo, float hi) { f32x2 v = {lo, hi}; bf16x2a_t b = __builtin_convertvector(v, bf16x2a_t); return __builtin_bit_cast(unsigned, b); }
__device__ __forceinline__ bf16x8 load8(const bf16* p) { return *reinterpret_cast<const bf16x8*>(p); }
__device__ __forceinline__ void mask_tile(f32x16& p0, f32x16& p1, int dq) {
    const float NEG = -__builtin_inff();
#pragma unroll
    for (int r = 0; r < 16; ++r) { const int c = (r & 3) + 8 * (r >> 2); if (dq - c < 0) p0[r] = NEG; if (dq - c - 32 < 0) p1[r] = NEG; }
}
__device__ __forceinline__ void partialSM(f32x16& p0, f32x16& p1, float& m_reg, float& mn, float& alpha) {
    float pmax = p0[0];
#pragma unroll
    for (int r = 1; r < 16; ++r) pmax = fmaxf(pmax, p0[r]);
#pragma unroll
    for (int r = 0; r < 16; ++r) pmax = fmaxf(pmax, p1[r]);
    { auto rr = __builtin_amdgcn_permlane32_swap(__float_as_uint(pmax), __float_as_uint(pmax), false, false); pmax = fmaxf(__uint_as_float(rr[0]), __uint_as_float(rr[1])); }
    if (__builtin_expect(__all((pmax - m_reg) <= THR2), 1)) { mn = m_reg; alpha = 1.f; }
    else { mn = fmaxf(m_reg, pmax); alpha = __builtin_amdgcn_exp2f(m_reg - mn); m_reg = mn; }
#pragma unroll
    for (int r = 0; r < 16; ++r) { p0[r] -= mn; p1[r] -= mn; }
#pragma unroll
    for (int r = 0; r < 16; ++r) p0[r] = __builtin_amdgcn_exp2f(p0[r]);
}
__device__ __forceinline__ void finishSM(f32x16& p0, f32x16& p1, float alpha, float& l_reg, bf16x8& pa0, bf16x8& pa1, bf16x8& pa2, bf16x8& pa3) {
#pragma unroll
    for (int r = 0; r < 16; ++r) p1[r] = __builtin_amdgcn_exp2f(p1[r]);
    float ps = 0;
#pragma unroll
    for (int r = 0; r < 16; ++r) ps += p0[r];
#pragma unroll
    for (int r = 0; r < 16; ++r) ps += p1[r];
    { auto rr = __builtin_amdgcn_permlane32_swap(__float_as_uint(ps), __float_as_uint(ps), false, false); ps = __uint_as_float(rr[0]) + __uint_as_float(rr[1]); }
    l_reg = l_reg * alpha + ps;
#define A2_PK4(P, B_, OUT) do { unsigned a0 = cvtpk(P[B_+0], P[B_+1]), a1 = cvtpk(P[B_+2], P[B_+3]); unsigned b0 = cvtpk(P[B_+4], P[B_+5]), b1 = cvtpk(P[B_+6], P[B_+7]); \
        auto r0 = __builtin_amdgcn_permlane32_swap(a0, b0, false, false); auto r1 = __builtin_amdgcn_permlane32_swap(a1, b1, false, false); \
        v4u w = {r0[0], r1[0], r0[1], r1[1]}; OUT = __builtin_bit_cast(bf16x8, w); } while (0)
    A2_PK4(p0, 0, pa0); A2_PK4(p0, 8, pa1); A2_PK4(p1, 0, pa2); A2_PK4(p1, 8, pa3);
#undef A2_PK4
}
template <int KB>
__device__ __forceinline__ void qkt(f32x16& p0, f32x16& p1, const char* K_lds, const char* qr_lds, int r32, int hi, const bf16x8* qr) {
    p0 = f32x16{}; p1 = f32x16{};
    const char* kbase = K_lds + KB * SHM_K + r32 * 512; const int x = r32 & 15;
#pragma unroll
    for (int d = 0; d < 12; ++d) { const char* a = kbase + ((((2 * d + hi) & 15) ^ x) << 4) + (d >= 8 ? 256 : 0);
        const bf16x8 b0 = *reinterpret_cast<const bf16x8*>(a), b1 = *reinterpret_cast<const bf16x8*>(a + 32 * 512);
        const bf16x8 q = d < 8 ? qr[d < 8 ? d : 0] : *reinterpret_cast<const bf16x8*>(qr_lds + (((d - 8) * 2 + hi) * 32 + r32) * 16);
        p0 = __builtin_amdgcn_mfma_f32_32x32x16_bf16(b0, q, p0, 0, 0, 0);
        p1 = __builtin_amdgcn_mfma_f32_32x32x16_bf16(b1, q, p1, 0, 0, 0); }
}
template <int VB>
__device__ __forceinline__ void pv_tile(f32x16* o, int vb0, bf16x8 pa0, bf16x8 pa1, bf16x8 pa2, bf16x8 pa3) {
#define A2_TRRD(dst, off) asm volatile("ds_read_b64_tr_b16 %0, %1 offset:%2" : "=&v"(dst) : "v"(vb0), "i"(off) : "memory")
#define A2_PV_D0(d0) do { s16x4 l0, l1, l2, l3, h0, h1, h2, h3; constexpr int b_ = VB * SHM_V + v_rd_off(d0, 0, 0); \
        A2_TRRD(l0, b_); A2_TRRD(h0, b_ + 2048); A2_TRRD(l1, b_ + 4096); A2_TRRD(h1, b_ + 6144); A2_TRRD(l2, b_ + 8192); A2_TRRD(h2, b_ + 10240); A2_TRRD(l3, b_ + 12288); A2_TRRD(h3, b_ + 14336); \
        asm volatile("s_waitcnt lgkmcnt(0)" ::: "memory"); A2_SBAR(); \
        o[d0] = __builtin_amdgcn_mfma_f32_32x32x16_bf16(pa0, (bf16x8){l0[0], l0[1], l0[2], l0[3], h0[0], h0[1], h0[2], h0[3]}, o[d0], 0, 0, 0); \
        o[d0] = __builtin_amdgcn_mfma_f32_32x32x16_bf16(pa1, (bf16x8){l1[0], l1[1], l1[2], l1[3], h1[0], h1[1], h1[2], h1[3]}, o[d0], 0, 0, 0); \
        o[d0] = __builtin_amdgcn_mfma_f32_32x32x16_bf16(pa2, (bf16x8){l2[0], l2[1], l2[2], l2[3], h2[0], h2[1], h2[2], h2[3]}, o[d0], 0, 0, 0); \
        o[d0] = __builtin_amdgcn_mfma_f32_32x32x16_bf16(pa3, (bf16x8){l3[0], l3[1], l3[2], l3[3], h3[0], h3[1], h3[2], h3[3]}, o[d0], 0, 0, 0); } while (0)
    A2_PV_D0(0); A2_PV_D0(1); A2_PV_D0(2); A2_PV_D0(3);
#undef A2_PV_D0
#undef A2_TRRD
}
struct BlockRef { const bf16* Q; const bf16* K; const bf16* V; bf16* O; int P0; };
struct Seam { bf16x8 qr[8]; bf16x8 st_v0, st_v1, st_k0, st_k1, st_k2; };
#define A2_VMW() asm volatile("s_waitcnt vmcnt(0)" ::: "memory")
#define A2_VMWN(n) asm volatile("s_waitcnt vmcnt(%0)" :: "i"(n) : "memory")
#define A2_SLOAD(Kp, Vp, k0) do { S.st_v0 = load8((Vp) + (size_t)((k0) + sr) * VS + sc); S.st_v1 = load8((Vp) + (size_t)((k0) + 32 + sr) * VS + sc); \
        const bf16* kp_ = (Kp) + (size_t)((k0) + krow) * KS + kc * 8; S.st_k0 = load8(kp_); S.st_k1 = load8(kp_ + 64); S.st_k2 = load8(kp_ + 128); } while (0)
#define A2_SWRITE_K(bf) do { *(bf16x8*)(K_lds + (bf) * SHM_K + kw0) = S.st_k0; *(bf16x8*)(K_lds + (bf) * SHM_K + kw1) = S.st_k1; *(bf16x8*)(K_lds + (bf) * SHM_K + kw0 + 256) = S.st_k2; } while (0)
#define A2_SWRITE_V(bf) do { *(bf16x8*)(V_lds + (bf) * SHM_V + vst0) = S.st_v0; *(bf16x8*)(V_lds + (bf) * SHM_V + vst1) = S.st_v1; } while (0)
#define A2_SWRITE(bf) do { A2_SWRITE_V(bf); A2_SWRITE_K(bf); } while (0)
#define A2_IDX int tid = threadIdx.x; asm volatile("" : "+v"(tid)); const int wid = __builtin_amdgcn_readfirstlane(tid >> 6), lane = tid & 63, r32 = lane & 31, hi = lane >> 5; \
    const int sr = tid >> 4, sc = (tid & 15) * 8, krow = tid >> 3, kc = tid & 7, kw0 = krow * 512 + ((kc ^ (krow & 15)) << 4), kw1 = krow * 512 + (((kc + 8) ^ (krow & 15)) << 4); \
    char* V_lds = lds + OFF_V; char* K_lds = lds + OFF_K; (void)lane; (void)r32; (void)hi; (void)sr; (void)sc; (void)V_lds
__device__ __forceinline__ void attn_prime(const BlockRef& cur, char* lds, Seam& S) {
    A2_IDX;
#pragma unroll
    for (int d0 = 0; d0 < 8; ++d0) S.qr[d0] = load8(cur.Q + (size_t)(wid * QBLK + r32) * QS + d0 * 16 + hi * 8);
    A2_SLOAD(cur.K, cur.V, 0); A2_VMW(); A2_SWRITE_K(0);
}
__device__ __forceinline__ void attn_block(const BlockRef& cur, const BlockRef& nxt, char* lds, Seam& S) {
    A2_IDX;
    const int NT = (cur.P0 + QB) / KVBLK;
    const int qlo = cur.P0 + wid * QBLK, qm = qlo + r32 - 4 * hi;
    float* ws = (float*)(lds + OFF_WS) + wid * 64; float* li_l = ws, * al_l = ws + 32;
    char* qr_lds = lds + OFF_QR + wid * 4096;
    float m_reg = -1e30f, l_reg = 0; f32x16 o[4] = {};
    const int vst0 = v_st(sr, sc), vst1 = v_st(32 + sr, sc);
    const int vb0 = (int)(uintptr_t)V_lds + v_rd_base(lane);
    const bf16* Kh = cur.K; const bf16* Vh = cur.V;
    { bf16x8 t4[4];
#pragma unroll
      for (int d = 0; d < 4; ++d) t4[d] = load8(cur.Q + (size_t)(wid * QBLK + r32) * QS + 128 + d * 16 + hi * 8);
#pragma unroll
      for (int d = 0; d < 4; ++d) *(bf16x8*)(qr_lds + ((d * 2 + hi) * 32 + r32) * 16) = t4[d]; }
    A2_SWRITE_V(0);
    __syncthreads();
    f32x16 p0, p1; float mn, al; bf16x8 pa0, pa1, pa2, pa3;
#define A2_STEP(t, BUF) do { const bool lastt = (t) + 1 >= NT; \
        A2_SBAR(); { const bf16* Kn = lastt ? nxt.K : Kh; const bf16* Vn = lastt ? nxt.V : Vh; const int k0n = lastt ? 0 : ((t) + 1) * KVBLK; A2_SLOAD(Kn, Vn, k0n); } A2_SBAR(); \
        qkt<BUF>(p0, p1, K_lds, qr_lds, r32, hi, S.qr); \
        if (lastt) { A2_SBAR(); _Pragma("unroll") for (int d0 = 0; d0 < 8; ++d0) S.qr[d0] = load8(nxt.Q + (size_t)(wid * QBLK + r32) * QS + d0 * 16 + hi * 8); A2_SBAR(); } \
        { const int kb_ = (t) * KVBLK; if (kb_ + KVBLK - 1 > qlo) mask_tile(p0, p1, qm - kb_); } \
        partialSM(p0, p1, m_reg, mn, al); finishSM(p0, p1, al, l_reg, pa0, pa1, pa2, pa3); \
        if (__any(al < 1.f)) { if (hi == 0) al_l[r32] = al; asm volatile("s_waitcnt lgkmcnt(0)" ::: "memory"); \
            for (int d_ = 0; d_ < 4; ++d_) for (int r = 0; r < 16; ++r) o[d_][r] *= al_l[crow(r, hi)]; } \
        A2_SBAR(); pv_tile<BUF>(o, vb0, pa0, pa1, pa2, pa3); A2_SBAR(); \
        if (lastt) { A2_VMWN(8); A2_SWRITE_K(0); } else { A2_VMW(); A2_SWRITE((BUF) ^ 1); } \
        __syncthreads(); } while (0)
    for (int t = 0; t < NT; t += 2) { A2_STEP(t, 0); A2_STEP(t + 1, 1); }
#undef A2_STEP
    if (hi == 0) li_l[r32] = l_reg; asm volatile("s_waitcnt lgkmcnt(0)" ::: "memory");
    float rli[16];
#pragma unroll
    for (int r = 0; r < 16; ++r) rli[r] = __builtin_amdgcn_rcpf(li_l[crow(r, hi)]);
    bf16* Ow = cur.O + (size_t)(wid * QBLK) * OS;
#pragma unroll
    for (int r = 0; r < 16; ++r) { const int orow = crow(r, hi);
#pragma unroll
        for (int d0 = 0; d0 < 4; ++d0) { const float v = o[d0][r] * rli[r]; const float vn = __shfl_xor(v, 1);
            if ((r32 & 1) == 0) *(unsigned*)(Ow + (size_t)orow * OS + d0 * 32 + r32) = cvtpk(v, vn); } }
    asm volatile("s_waitcnt lgkmcnt(0)" ::: "memory");
}
}
__device__ __forceinline__ attn2::BlockRef attn2_ref(unsigned char* ws, int v, int pass) {
    const int bh = v >> 3, b = bh >> 3, h = bh & 7, x = v & 7, qb = pass ? 15 - x : x;
    attn2::BlockRef r;
    r.Q = (const bf16*)(ws + WS_QP) + ((size_t)b * SEQ + qb * 256) * 1536 + h * 192; r.K = (const bf16*)(ws + WS_KF) + (size_t)b * SEQ * 1536 + h * 192;
    r.V = (const bf16*)(ws + WS_VV) + (size_t)b * SEQ * 1024 + h * 128; r.O = (bf16*)(ws + WS_MO) + ((size_t)b * SEQ + qb * 256) * 1024 + h * 128; r.P0 = qb * 256;
    return r;
}
__device__ __forceinline__ void phase_attn2(Frame& F, char* lds) {
    int L = F.vcu; if (L >= 256) return;
    attn2::Seam S; int pass = 0;
    attn2::BlockRef cur = attn2_ref(F.ws, L, 0);
    attn2::attn_prime(cur, lds, S);
    for (;;) {
        const bool more_pass = pass == 0, more_item = L + F.G < 256, last = !more_pass && !more_item;
        int passn = pass + 1, Ln = L;
        if (!more_pass) { passn = 0; Ln = more_item ? L + F.G : L; }
        const attn2::BlockRef nxt = last ? cur : attn2_ref(F.ws, Ln, passn);
        attn2::attn_block(cur, nxt, lds, S);
        if (last) break;
        cur = nxt; pass = passn; L = Ln;
    }
}

static_assert(pg8::EpiInProj::O_RSTDX == WS_SMALL + SM_RSTDX && pg8::EpiInProj::O_SSQ_LAT == WS_SMALL + SM_SSQ_CQ && pg8::EpiInProj::O_SSQ_KR == WS_SMALL + SM_SSQ_KR && pg8::EpiInProj::O_CS == WS_CS && pg8::EpiInProj::O_CSM == WS_CSM && pg8::EpiInProj::O_RQ == WS_RQ && pg8::EpiInProj::O_RK == WS_RK && pg8::EpiInProj::O_RKDT == WS_RKDT && pg8::EpiInProj::O_RVT == WS_RVT && pg8::EpiInProj::O_LAT == WS_LAT && pg8::EpiInProj::O_KR == WS_KR, "EpiInProj offsets");
static_assert(pg8::EpiKVup::O_KF == WS_KF && pg8::EpiKVup::O_VV == WS_VV && pg8::EpiKVup::O_KR == WS_KR && pg8::EpiKVup::O_SSQ_CKV == WS_SMALL + SM_SSQ_CKV && pg8::EpiKVup::O_SSQ_KR == WS_SMALL + SM_SSQ_KR, "EpiKVup offsets");
#ifndef MK_N_LAUNCHES
#define MK_N_LAUNCHES 12
#endif
constexpr int N_PHASES = 12;
constexpr int N_LAUNCHES = MK_N_LAUNCHES;
struct Args { const float* in[21]; float* out; unsigned char* ws; int ph_lo, ph_hi; };
#ifndef PG8_SP2
#define PG8_SP2 true
#endif
#define PG8_ALIGN true
template <class Epi> __device__ __forceinline__ void run_gemm(Frame& F, const pg8::bf16_t* A, int lda, const pg8::bf16_t* Bt, int ldb, int N, int K, const Epi& E, int c = -1) {
    __syncthreads();
    pg8::Gemm g{A, Bt, MTOK, N, K, lda, ldb}; pg8::StaticOrder S; S.init(MTOK, N, F.G, c < 0 ? (int)blockIdx.x : c);
    pg8::gemm_phase<Epi, pg8::StaticOrder, PG8_ALIGN, PG8_SP2>(F.lds + RING_OFF, g, S, E);
}
__global__ void __launch_bounds__(NWAVES * 64, 2) mk_fwd(Args args) {
    extern __shared__ __attribute__((aligned(16))) unsigned char lds[];
    Frame F;
    F.lds = (LAS unsigned char*)lds; F.MISC = (volatile LAS unsigned*)(F.lds + MISC_OFF);
    F.tid = threadIdx.x; F.lane = F.tid & 63; F.wave = __builtin_amdgcn_readfirstlane(F.tid >> 6);
    F.G = gridDim.x; { const int bx = blockIdx.x; F.vcu = (F.G % 8 == 0) ? (bx % 8) * (F.G / 8) + bx / 8 : bx; }
    F.out = args.out; F.ws = args.ws;
    unsigned char* ws = args.ws;
    if (F.tid < 32) F.MISC[F.tid] = 0u;
    __syncthreads();
    if (N_LAUNCHES == 1) (void)xcd_barrier_post((unsigned*)(ws + WS_CTL) + CW_BAR, F.MISC + 8);
    const int lo = args.ph_lo, hi = args.ph_hi;
    int ctile = (int)blockIdx.x;
    bool xlocal = false;
#ifndef PH_MASK
#define PH_MASK 0xfff
#endif
#define IN(k) (((PH_MASK >> (k)) & 1) && lo <= (k) && (k) < hi)
#define BAR_NOW() XcdBarrier bar_; bar_.bar = (unsigned*)(args.ws + WS_CTL) + CW_BAR; bar_.x = xb_xcc_id(); bar_.st = (volatile LAS unsigned*)((LAS unsigned char*)lds + MISC_OFF) + 8
#define SEAM(k) do { asm volatile("; SEAM_MARK %0" :: "i"(k)); if (IN(k) && IN((k) + 1)) { BAR_NOW(); xcd_barrier(bar_); } } while (0)
#define SEAM_L(k) do { if (IN(k) && IN((k) + 1)) { BAR_NOW(); if (xlocal) xcd_local_barrier(bar_); else xcd_barrier(bar_); } } while (0)
#ifdef SUBSTRETCH
#define SUB_T0(n) const unsigned long long ts0_##n = __builtin_amdgcn_s_memrealtime()
#define SUB_ST(n) do { if (SUBSTRETCH == (n)) { const unsigned long long t1_ = __builtin_amdgcn_s_memrealtime(); const unsigned long long d_ = t1_ - ts0_##n; while (__builtin_amdgcn_s_memrealtime() - t1_ < d_) __builtin_amdgcn_s_sleep(8); } } while (0)
#else
#define SUB_T0(n) do {} while (0)
#define SUB_ST(n) do {} while (0)
#endif
#define PH_IDX() do { int t_ = threadIdx.x; asm volatile("" : "+v"(t_)); F.tid = t_; F.lane = t_ & 63; F.wave = __builtin_amdgcn_readfirstlane(t_ >> 6); } while (0)
#ifdef STRETCH_MASK
#define PH_T0() PH_IDX(); const unsigned long long t0_ = __builtin_amdgcn_s_memrealtime()
#define PH_STRETCH(k) do { if ((STRETCH_MASK >> (k)) & 1) { const unsigned long long t1_ = __builtin_amdgcn_s_memrealtime(); const unsigned long long d_ = (t1_ - t0_) * STRETCH_MULT; while (__builtin_amdgcn_s_memrealtime() - t1_ < d_) __builtin_amdgcn_s_sleep(8); } } while (0)
#else
#define PH_T0() PH_IDX()
#define PH_STRETCH(k) do {} while (0)
#endif
    float* sm = (float*)(ws + WS_SMALL);
    const float* rstdx = sm + SM_RSTDX / 4; float* ssq_cq = sm + SM_SSQ_CQ / 4; float* ssq_ckv = sm + SM_SSQ_CKV / 4; float* ssq1 = sm + SM_SSQ1 / 4; float* ssq2 = sm + SM_SSQ2 / 4;
    typedef pg8::bf16_t b16;
    b16* WinT = (b16*)(ws + WS_WIN); b16* XB = (b16*)(ws + WS_XB); b16* LATb = (b16*)(ws + WS_LAT); b16* ROb = (b16*)args.out;

    if (IN(0)) { PH_T0(); phase_p0(F, args.in[0], (const int*)args.in[2], args.in[3], args.in[4], args.in[6], args.in[7], args.in[8], args.in[9]); PH_STRETCH(0); } SEAM(0);
    if (IN(1)) { PH_T0();
        pg8::EpiInProj E{ws, args.in[11], (PG8_LAS unsigned char*)(F.lds + XS_OFF)};
        run_gemm(F, XB, 1024, WinT + (size_t)4096 * 1024, 1024, NIN1, 1024, E);
    PH_STRETCH(1); } SEAM(1);
    if (IN(2)) { PH_T0(); phase_r0p(F);
    PH_STRETCH(2); } SEAM(2);
    if (IN(3)) { PH_T0(); phase_r1p(F); PH_STRETCH(3); } SEAM(3);
    if (IN(4)) { PH_T0();
        SUB_T0(1); { pg8::EpiRetGate E{ROb, rstdx, (const float*)(ws + WS_SSQP), args.in[5]}; run_gemm(F, XB, 1024, WinT + (size_t)2048 * 1024, 1024, 2048, 1024, E); } SUB_ST(1);
        asm volatile("; SEAM_MARK 41");
        SUB_T0(2); { pg8::EpiQup E{(b16*)(ws + WS_QP), ssq_cq, args.in[10], (const void*)(ws + WS_CSM), (PG8_LAS float*)(F.lds + XS_OFF), C2Q}; run_gemm(F, LATb, LATW, (const b16*)(ws + WS_WUQ), 384, 2048, 384, E);
#ifdef QUP_TWICE
          run_gemm(F, LATb, LATW, (const b16*)(ws + WS_WUQ), 384, 2048, 384, E);
#endif
        } SUB_ST(2);
        asm volatile("; SEAM_MARK 42");
        SUB_T0(3); { pg8::EpiKVup E{ws, args.in[11], (PG8_LAS float*)(F.lds + XS_OFF)}; run_gemm(F, LATb + 384, LATW, (const b16*)(ws + WS_WUKV), 256, 2048, 256, E);
#ifdef KVUP_TWICE
          run_gemm(F, LATb + 384, LATW, (const b16*)(ws + WS_WUKV), 256, 2048, 256, E);
#endif
        } SUB_ST(3);
    PH_STRETCH(4); } SEAM(4);
    if (IN(5)) { PH_T0(); phase_attn2(F, (char*)lds); PH_STRETCH(5); } SEAM(5);
    if (IN(6)) { PH_T0();
        phase_late_weights(F, args.in[1], args.in[12], args.in[13], args.in[14], args.in[15], args.in[16], args.in[17], args.in[18], args.in[19], args.in[20]);
        { pg8::EpiRowAct<1> E{(b16*)(ws + WS_SG), 2048, rstdx, 0.f}; run_gemm(F, XB, 1024, WinT, 1024, 2048, 1024, E); }
    PH_STRETCH(6); } SEAM(6);
#ifndef NO_XLOCAL
    if (N_LAUNCHES == 1 && IN(7)) {
        if (F.tid == 0) { unsigned ok = (F.G == 256) ? 1u : 0u;
            for (unsigned j = 0; j < 16; ++j) { const unsigned c = xb_ld((unsigned*)(args.ws + WS_CTL) + CW_BAR + XB_XCNT(j)); ok &= (j < 8 ? (c == 32u) : (c == 0u)) ? 1u : 0u; }
            F.MISC[12] = ok; }
        __syncthreads();
        xlocal = F.MISC[12] != 0u; if (xlocal) ctile = (int)(F.MISC[10] * 8u + xb_xcc_id());
    }
#endif
    if (IN(7)) { PH_T0();
        { pg8::EpiGateMix<0> E{(b16*)(ws + WS_TM), (const b16*)(ws + WS_SG), 0}; run_gemm(F, ROb, 2048, (const b16*)(ws + WS_WBR), 2048, 1024, 2048, E, ctile); }
        VM_WAIT(); __syncthreads(); __builtin_amdgcn_fence(__ATOMIC_ACQUIRE, "agent"); VM_WAIT(); __syncthreads();
        { pg8::EpiGateMix<1> E{(b16*)(ws + WS_TM), (const b16*)(ws + WS_SG), 1024}; run_gemm(F, (const b16*)(ws + WS_MO), 1024, (const b16*)(ws + WS_WBM), 1024, 1024, 1024, E, ctile); }
    PH_STRETCH(7); } SEAM_L(7);
    if (IN(8)) { PH_T0(); pg8::EpiResid<false> E{(const void*)args.in[0], XB, ssq1}; run_gemm(F, (const b16*)(ws + WS_TM), 1024, (const b16*)(ws + WS_WO), 1024, 1024, 1024, E, ctile); PH_STRETCH(8); } SEAM(8);
    if (IN(9)) { PH_T0(); pg8::EpiRowAct<2> E{(b16*)(ws + WS_H), 4096, ssq1, 1.0f / 1024.0f}; run_gemm(F, XB, 1024, (const b16*)(ws + WS_WUP), 1024, 4096, 1024, E, ctile); PH_STRETCH(9); } SEAM_L(9);
    if (IN(10)) { PH_T0(); pg8::EpiResid<true> E{(const void*)XB, XB, ssq2}; run_gemm(F, (const b16*)(ws + WS_H), 4096, (const b16*)(ws + WS_WDOWN), 4096, 1024, 4096, E, ctile); PH_STRETCH(10); } SEAM_L(10);
    if (IN(11)) { PH_T0();
        { pg8::EpiRowAct<1> E{(b16*)(ws + WS_GT), 1024, ssq2, 1.0f / 1024.0f}; run_gemm(F, XB, 1024, (const b16*)(ws + WS_WPG), 1024, 1024, 1024, E, ctile); }
        VM_WAIT(); __syncthreads(); __builtin_amdgcn_fence(__ATOMIC_ACQUIRE, "agent"); VM_WAIT(); __syncthreads();
        { pg8::EpiFinal E{args.out, (const b16*)(ws + WS_GT), XB}; run_gemm(F, (const b16*)(ws + WS_PB), 256, (const b16*)(ws + WS_WPLE), 256, 1024, 256, E, ctile); }
    PH_STRETCH(11); }
#undef IN
#undef SEAM
}


#ifdef DUMPK
struct DumpArgs { const unsigned* reg[6]; unsigned nw[6]; unsigned* out; int own; int pad; };
__global__ void dump_hash(DumpArgs d) {
    for (unsigned i = blockIdx.x * blockDim.x + threadIdx.x; i < (unsigned)MTOK * DM; i += gridDim.x * blockDim.x) {
        float s = 0.f;
        if (d.own) { const unsigned w = d.out[i]; s += __uint_as_float(w << 16) + __uint_as_float(w & 0xffff0000u); }
        for (int r = 0; r < 6; ++r) if (d.reg[r] && i < d.nw[r] * 2u) { const unsigned short v = ((const unsigned short*)d.reg[r])[i]; s += __uint_as_float((unsigned)v << 16); }
        ((float*)d.out)[i] = s;
    }
}
#endif
extern "C" void kernel_launch(void* const* d_in, const int* in_sizes, int n_in, void* d_out, int out_size, void* d_ws, size_t ws_size, hipStream_t stream) {
    static int grid = 0;
    if (grid == 0) {
        if (n_in != 21 || in_sizes[0] != MTOK * DM || out_size != MTOK * DM || ws_size < WS_END) { fprintf(stderr, "kernel_launch: unexpected shapes (n_in %d in0 %d out %d ws %zu)\n", n_in, n_in > 0 ? in_sizes[0] : -1, out_size, ws_size); grid = -1; return; }
        int dev = 0, cus = 0, per_cu = 0;
        if (hipGetDevice(&dev) != hipSuccess || hipDeviceGetAttribute(&cus, hipDeviceAttributeMultiprocessorCount, dev) != hipSuccess) { grid = -1; return; }
        if (hipFuncSetAttribute((const void*)mk_fwd, hipFuncAttributeMaxDynamicSharedMemorySize, LDS_BYTES) != hipSuccess) { fprintf(stderr, "kernel_launch: hipFuncSetAttribute failed\n"); grid = -1; return; }
        if (hipOccupancyMaxActiveBlocksPerMultiprocessor(&per_cu, (const void*)mk_fwd, NWAVES * 64, LDS_BYTES) != hipSuccess || per_cu < 1) { fprintf(stderr, "kernel_launch: occupancy query says %d workgroups per CU\n", per_cu); (void)hipGetLastError(); grid = -1; return; }
        grid = cus;
    }
    if (grid < 0) return;
    (void)hipMemsetAsync((char*)d_ws + WS_CTL, 0, CTL_ZERO_BYTES, stream);
    Args a{};
    for (int i = 0; i < 21; ++i) a.in[i] = (const float*)d_in[i];
    a.out = (float*)d_out; a.ws = (unsigned char*)d_ws;
    if (N_LAUNCHES == 1) { a.ph_lo = 0; a.ph_hi = N_PHASES; hipLaunchKernelGGL(mk_fwd, dim3(grid), dim3(NWAVES * 64), LDS_BYTES, stream, a); }
    else for (int ph = 0; ph < N_PHASES; ++ph) {
#ifdef DUMPK
        if (ph > DUMPK) break;
#endif
        a.ph_lo = ph; a.ph_hi = ph + 1; hipLaunchKernelGGL(mk_fwd, dim3(grid), dim3(NWAVES * 64), LDS_BYTES, stream, a); }
#ifdef DUMPK
    { DumpArgs d{}; d.out = (unsigned*)d_out; d.own = DUMP_OWN; const size_t offs[6] = DUMP_OFFS; const size_t len[6] = DUMP_LENS;
      for (int r = 0; r < 6; ++r) if (len[r]) { d.reg[r] = (const unsigned*)((const char*)d_ws + offs[r]); d.nw[r] = (unsigned)(len[r] / 4); }
      hipLaunchKernelGGL(dump_hash, dim3(2048), dim3(256), 0, stream, d); }
#endif
}
```

```cpp
#define MK_N_LAUNCHES 1
#include <hip/hip_runtime.h>
#include <hip/hip_bf16.h>
#include <cstdio>
#include <cstdint>
namespace pg8 {
#define PG8_LAS __attribute__((address_space(3)))
typedef unsigned short bf16_t;
typedef short bf16x8 __attribute__((ext_vector_type(8)));
typedef float f32x4 __attribute__((ext_vector_type(4)));
typedef unsigned u32x4 __attribute__((ext_vector_type(4)));
constexpr int BM = 256, BK = 64, HALF = 128, HTB = HALF * BK * 2  , STAGE_BYTES = 8 * HTB, NXCD = 8, WGM = 8;

__host__ __device__ __forceinline__ int lds_byte(int r, int c) { const int st = (r >> 4) * 2 + (c >> 5), rr = r & 15, cc = c & 31, ob = rr * 64 + cc * 2; return st * 1024 + (ob ^ (((ob >> 9) & 1) << 5)); }
__host__ __device__ __forceinline__ void stage_rc(int b, int& R, int& C) { const int st = b / 1024, sb = b % 1024, swz = sb ^ (((sb >> 9) & 1) << 5); R = (st >> 1) * 16 + swz / 64; C = (st & 1) * 32 + (swz % 64) / 2; }
__host__ __device__ __forceinline__ int perm32(int rho) { const int n = rho >> 4, i = rho & 15; return 8 * (i >> 2) + 4 * n + (i & 3); }

struct Unit { int pm, pn; };
struct Gemm { const bf16_t* A; const bf16_t* Bt; int M, N, K, lda, ldb; size_t gsA; };

struct StaticOrder {
    int nM, nN, nwg, G, c;
    __host__ __device__ void init(int M, int N, int G_, int c_) { nM = M / BM; nN = N / BM; nwg = nM * nN; G = G_; c = c_; }
    __host__ __device__ bool next(int i, Unit& u) const {
        const long L = (long)i * G + c; if (L >= nwg) return false;
        int wgid = (int)L; { const int q = nwg / NXCD, r = nwg % NXCD, xcd = wgid % NXCD, off = wgid / NXCD; wgid = (xcd < r ? xcd * (q + 1) : r * (q + 1) + (xcd - r) * q) + off; }
        const int nig = WGM * nN, gid = wgid / nig, fm = gid * WGM, gsz = (nM - fm) < WGM ? (nM - fm) : WGM;
        u.pm = fm + ((wgid % nig) % gsz); u.pn = (wgid % nig) / gsz; return true;
    }
    __device__ __forceinline__ void a_ready(const Unit&) const {}
    __device__ __forceinline__ void done(const Unit&) const {}
};


typedef float f32x2 __attribute__((ext_vector_type(2)));
typedef unsigned u32x2 __attribute__((ext_vector_type(2)));
typedef __bf16 bf16x2_t __attribute__((ext_vector_type(2)));
__device__ __forceinline__ unsigned cvt_pk_bf16(float lo, float hi) { f32x2 v = {lo, hi}; bf16x2_t b = __builtin_convertvector(v, bf16x2_t); return __builtin_bit_cast(unsigned, b); }
__device__ __forceinline__ float bflo(unsigned w) { return __uint_as_float(w << 16); }
__device__ __forceinline__ float bfhi(unsigned w) { return __uint_as_float(w & 0xffff0000u); }
__device__ __forceinline__ u32x4 pack8(const float (&v)[8]) { u32x4 w; w.x = cvt_pk_bf16(v[0], v[1]); w.y = cvt_pk_bf16(v[2], v[3]); w.z = cvt_pk_bf16(v[4], v[5]); w.w = cvt_pk_bf16(v[6], v[7]); return w; }
__device__ __forceinline__ void unpack8(const u32x4 w, float (&v)[8]) { v[0] = bflo(w.x); v[1] = bfhi(w.x); v[2] = bflo(w.y); v[3] = bfhi(w.y); v[4] = bflo(w.z); v[5] = bfhi(w.z); v[6] = bflo(w.w); v[7] = bfhi(w.w); }
__device__ __forceinline__ float sigmoidf_(float x) { return __builtin_amdgcn_rcpf(1.0f + __builtin_amdgcn_exp2f(-1.4426950408889634f * x)); }
constexpr float RMS_EPS_ = 1e-6f;
typedef _Float16 h2x4_t __attribute__((ext_vector_type(8)));
__device__ __forceinline__ void rope8(const void* csm, unsigned row, unsigned i0, float (&c)[8], float (&s)[8]) {
    const h2x4_t* p = (const h2x4_t*)csm + (row * 8u + (i0 >> 2)); const h2x4_t a = p[0], b = p[1];
#pragma unroll
    for (int e = 0; e < 4; ++e) { c[e] = (float)a[2 * e]; s[e] = (float)a[2 * e + 1]; c[4 + e] = (float)b[2 * e]; s[4 + e] = (float)b[2 * e + 1]; }
}
__device__ __forceinline__ void st16(bf16_t* p, const u32x4 v) {
#ifdef ST_SC1
    asm volatile("global_store_dwordx4 %0, %1, off sc1\n\ts_nop 1" :: "v"(p), "v"(v) : "memory");
#else
    *(u32x4*)p = v;
#endif
}

#define EPI_ACC8(v, ai, bj, m) float v[8]; { const f32x4 a0_ = acc[ai][bj][m][0], a1_ = acc[ai][bj][m][1]; v[0] = a0_[0]; v[1] = a0_[1]; v[2] = a0_[2]; v[3] = a0_[3]; v[4] = a1_[0]; v[5] = a1_[1]; v[6] = a1_[2]; v[7] = a1_[3]; }

__device__ __forceinline__ void xpose_store(PG8_LAS unsigned char* st, const unsigned (&pk)[4][4], bf16_t* dst, int R, int lane, int fr, int fq) {
#pragma unroll
    for (int pass = 0; pass < 2; ++pass) {
        if ((fq >> 1) == pass) {
#pragma unroll
            for (int m = 0; m < 4; ++m)
#pragma unroll
                for (int q = 0; q < 4; ++q) { const unsigned w = pk[m][q]; const int c = (fq & 1) * 8 + 2 * q;
                    *(PG8_LAS unsigned short*)(st + c * 144 + (16 * m + fr) * 2) = (unsigned short)(w & 0xffffu);
                    *(PG8_LAS unsigned short*)(st + (c + 1) * 144 + (16 * m + fr) * 2) = (unsigned short)(w >> 16); }
        }
        asm volatile("s_waitcnt lgkmcnt(0)" ::: "memory");
#pragma unroll
        for (int k = 0; k < 2; ++k) { const int idx = lane + 64 * k, c = idx & 15, ch = idx >> 4;
            const u32x4 v = *(const PG8_LAS u32x4*)(st + c * 144 + ch * 16);
            *(u32x4*)(dst + ((size_t)ch * R + pass * 16 + c) * 8) = v; }
        asm volatile("s_waitcnt lgkmcnt(0)" ::: "memory");
    }
}

struct EpiInProj {
    static constexpr bool PERM = true, AFTER_DRAIN = false, TWICE_OK = false; static __device__ __forceinline__ bool twice(const Unit& u) { return u.pn < 16; }
    unsigned char* ws; const float* k_norm; PG8_LAS unsigned char* xs;
    static constexpr size_t O_RSTDX = (size_t)1 << 20, O_SSQ_LAT = ((size_t)1 << 20) + (64 << 10), O_SSQ_KR = ((size_t)1 << 20) + (320 << 10), O_CS = (size_t)57 << 20, O_CSM = (size_t)254 << 20,
        O_RQ = (size_t)94 << 20, O_RK = (size_t)126 << 20, O_RKDT = (size_t)158 << 20, O_RVT = (size_t)190 << 20, O_LAT = (size_t)73 << 20, O_KR = ((size_t)22 << 20) + (512 << 10);
    __device__ __forceinline__ void operator()(const f32x4 (&acc)[2][2][4][2], const Unit& u, int wr, int wc, int fr, int fq) const {
        const int pn = u.pn, lane = fq * 16 + fr, wid = wr * 4 + wc;
        const float* rstdx = (const float*)(ws + O_RSTDX); const f32x4* cs = (const f32x4*)(ws + O_CS); const void* csm = (const void*)(ws + O_CSM); float* ssq_lat = (float*)(ws + O_SSQ_LAT); float* ssq_kr = (float*)(ws + O_SSQ_KR);
        bf16_t* RQ = (bf16_t*)(ws + O_RQ); bf16_t* RK = (bf16_t*)(ws + O_RK); bf16_t* RKDT = (bf16_t*)(ws + O_RKDT); bf16_t* RVT = (bf16_t*)(ws + O_RVT); bf16_t* LAT = (bf16_t*)(ws + O_LAT); bf16_t* KR = (bf16_t*)(ws + O_KR);
        PG8_LAS unsigned char* st = xs + wid * 2304;
        const int rowt = u.pm * BM + wr * 64 + fr;
        const int bidx = (u.pm * BM) >> 12, s0 = (u.pm * BM) & 4095;
        if (pn < 8) {
            const bool isk = pn >= 4; const int head = pn & 3;
            const float lg2 = __builtin_amdgcn_logf(1.0f - __builtin_amdgcn_exp2f(-5.0f - (float)head));
            bf16_t* O = isk ? RK : RQ;
#pragma unroll
            for (int ai = 0; ai < 2; ++ai) {
                unsigned pk0[4][4], pk1[4][4];
#pragma unroll
                for (int m = 0; m < 4; ++m) {
                    const int row = rowt + ai * HALF + m * 16; const float rs = rstdx[row] * (isk ? 0.0625f : 1.0f);
                    const f32x4* cp = cs + ((unsigned)row * 64u + (unsigned)(wc * 16 + fq * 4));
                    const f32x4 c0 = cp[0], c1 = cp[1], c2 = cp[2], c3 = cp[3];
                    const float cc[8] = {c0[0], c0[2], c1[0], c1[2], c2[0], c2[2], c3[0], c3[2]}, ss[8] = {c0[1], c0[3], c1[1], c1[3], c2[1], c2[3], c3[1], c3[3]};
                    EPI_ACC8(x1, ai, 0, m); EPI_ACC8(x2, ai, 1, m);
                    float o1[8], o2[8];
#pragma unroll
                    for (int e = 0; e < 8; ++e) { const float a = x1[e] * rs, b = x2[e] * rs; o1[e] = a * cc[e] - b * ss[e]; o2[e] = b * cc[e] + a * ss[e]; }
                    bf16_t* rp = O + ((((size_t)(bidx * 4 + head) * 32 + (s0 >> 7) + ai) * 32 + wc * 4 + fq) * 128 + wr * 64 + m * 16 + fr) * 8;
                    *(u32x4*)rp = pack8(o1); *(u32x4*)(rp + (size_t)16 * 128 * 8) = pack8(o2);
                    if (isk) { const float kdm = __builtin_amdgcn_exp2f((float)(127 - (wr * 64 + m * 16 + fr)) * lg2);
#pragma unroll
                        for (int q = 0; q < 4; ++q) { pk0[m][q] = cvt_pk_bf16(o1[2 * q] * kdm, o1[2 * q + 1] * kdm); pk1[m][q] = cvt_pk_bf16(o2[2 * q] * kdm, o2[2 * q + 1] * kdm); }
                    }
                }
                if (isk) {
                    bf16_t* d0 = RKDT + ((((size_t)(bidx * 4 + head) * 32 + (s0 >> 7) + ai) * 16 + wr * 8) * 256 + wc * 32) * 8;
                    xpose_store(st, pk0, d0, 256, lane, fr, fq);
                    xpose_store(st, pk1, d0 + (size_t)HALF * 8, 256, lane, fr, fq);
                }
            }
        } else if (pn < 16) {
            const int head = (pn - 8) >> 1, dvb = ((pn - 8) & 1) * 256;
#pragma unroll
            for (int ai = 0; ai < 2; ++ai)
#pragma unroll
                for (int bj = 0; bj < 2; ++bj) {
                    unsigned pk[4][4];
#pragma unroll
                    for (int m = 0; m < 4; ++m) { const float rs = rstdx[rowt + ai * HALF + m * 16]; EPI_ACC8(v, ai, bj, m);
#pragma unroll
                        for (int q = 0; q < 4; ++q) pk[m][q] = cvt_pk_bf16(v[2 * q] * rs, v[2 * q + 1] * rs); }
                    bf16_t* d0 = RVT + ((((size_t)(bidx * 4 + head) * 32 + (s0 >> 7) + ai) * 16 + wr * 8) * 512 + dvb + bj * HALF + wc * 32) * 8;
                    xpose_store(st, pk, d0, 512, lane, fr, fq);
                }
        } else if (pn < 19) {
            const int lt = pn - 16; int fqo = fq; asm volatile("" : "+v"(fqo));
#pragma unroll
            for (int ai = 0; ai < 2; ++ai)
#pragma unroll
                for (int m = 0; m < 4; ++m) { const int row = rowt + ai * HALF + m * 16; const float rs = rstdx[row];
#pragma unroll
                    for (int bj = 0; bj < 2; ++bj) { if (lt == 2 && bj == 1) continue;
                        EPI_ACC8(v, ai, bj, m); float q = 0.f;
#pragma unroll
                        for (int e = 0; e < 8; ++e) { v[e] *= rs; q += v[e] * v[e]; }
                        *(u32x4*)(LAT + ((unsigned)row * 640u + lt * 256 + bj * HALF + wc * 32 + 8 * fqo)) = pack8(v);
                        const int kind = (lt == 0) ? 0 : (lt == 1 ? (bj == 0 ? 0 : 1) : 1);
                        q += __shfl_xor(q, 16); q += __shfl_xor(q, 32); if (fq == 0) atomicAdd(ssq_lat + kind * 16384 + row, q); } }
        } else if (wc == 0) {
#pragma unroll
            for (int ai = 0; ai < 2; ++ai)
#pragma unroll
                for (int m = 0; m < 4; ++m) { const int row = rowt + ai * HALF + m * 16; const float rs = rstdx[row];
                    float q = 0.f; unsigned w1[4], w2[4]; const h2x4_t* cp = (const h2x4_t*)csm + ((unsigned)row * 8u + 2u * (unsigned)fq);
#pragma unroll
                    for (int hh = 0; hh < 2; ++hh) { const f32x4 xa = acc[ai][0][m][hh] * rs, xb = acc[ai][1][m][hh] * rs; const f32x4 ga = *(const f32x4*)(k_norm + 128 + 8 * fq + 4 * hh), gb = *(const f32x4*)(k_norm + 160 + 8 * fq + 4 * hh);
                        const h2x4_t t4 = cp[hh]; float oa[4], ob[4];
#pragma unroll
                        for (int e = 0; e < 4; ++e) { q += xa[e] * xa[e] + xb[e] * xb[e]; const float ya = xa[e] * ga[e], yb = xb[e] * gb[e], c_ = (float)t4[2 * e], s_ = (float)t4[2 * e + 1];
                            oa[e] = ya * c_ - yb * s_; ob[e] = yb * c_ + ya * s_; }
                        w1[2 * hh] = cvt_pk_bf16(oa[0], oa[1]); w1[2 * hh + 1] = cvt_pk_bf16(oa[2], oa[3]); w2[2 * hh] = cvt_pk_bf16(ob[0], ob[1]); w2[2 * hh + 1] = cvt_pk_bf16(ob[2], ob[3]); }
                    *(u32x4*)(KR + ((unsigned)row * 64u + 8u * fq)) = (u32x4){w1[0], w1[1], w1[2], w1[3]}; *(u32x4*)(KR + ((unsigned)row * 64u + 32u + 8u * fq)) = (u32x4){w2[0], w2[1], w2[2], w2[3]};
                    q += __shfl_xor(q, 16); q += __shfl_xor(q, 32); if (fq == 0) ssq_kr[row] = q;
                    asm volatile("" ::: "memory"); }
        }
    }
};

struct EpiKVup {
    static constexpr bool PERM = true, AFTER_DRAIN = false, TWICE_OK = false; static __device__ __forceinline__ bool twice(const Unit&) { return false; }
    unsigned char* ws; const float* k_norm; PG8_LAS float* xr;
    static constexpr size_t O_KF = (size_t)142 << 20, O_VV = (size_t)190 << 20, O_KR = ((size_t)22 << 20) + (512 << 10), O_SSQ_CKV = ((size_t)1 << 20) + (128 << 10), O_SSQ_KR = ((size_t)1 << 20) + (320 << 10);
    __device__ __forceinline__ void operator()(const f32x4 (&acc)[2][2][4][2], const Unit& u, int wr, int wc, int fr, int fq) const {
        const unsigned rowt = u.pm * BM + wr * 64 + fr, head = u.pn, d0 = wc * 32 + 8 * fq;
        bf16_t* KF = (bf16_t*)(ws + O_KF); bf16_t* VV = (bf16_t*)(ws + O_VV); const bf16_t* KR = (const bf16_t*)(ws + O_KR); const float* ssq_ckv = (const float*)(ws + O_SSQ_CKV); const float* ssq_kr = (const float*)(ws + O_SSQ_KR);
        float rs8[2][4], kr8[2][4];
#pragma unroll
        for (int ai = 0; ai < 2; ++ai)
#pragma unroll
            for (int m = 0; m < 4; ++m) { rs8[ai][m] = __builtin_amdgcn_rsqf(ssq_ckv[rowt + ai * HALF + m * 16] * (1.0f / 256.0f) + RMS_EPS_); kr8[ai][m] = ssq_kr[rowt + ai * HALF + m * 16]; }
#pragma unroll
        for (int ai = 0; ai < 2; ++ai)
#pragma unroll
            for (int m = 0; m < 4; ++m) { const float rs = rs8[ai][m];
                const f32x4 a0 = acc[ai][0][m][0] * rs, a1 = acc[ai][0][m][1] * rs;
                float q = (a0[0] * a0[0] + a0[1] * a0[1]) + (a0[2] * a0[2] + a0[3] * a0[3]) + (a1[0] * a1[0] + a1[1] * a1[1]) + (a1[2] * a1[2] + a1[3] * a1[3]);
                q += __shfl_xor(q, 16); q += __shfl_xor(q, 32);
                if (fq == 0) xr[(ai * HALF + wr * 64 + m * 16 + fr) * 4 + wc] = q; }
        asm volatile("s_waitcnt lgkmcnt(0)\n\ts_barrier" ::: "memory");
        const f32x4 g0 = *(const f32x4*)(k_norm + d0), g1 = *(const f32x4*)(k_norm + d0 + 4);
#pragma unroll
        for (int ai = 0; ai < 2; ++ai)
#pragma unroll
            for (int m = 0; m < 4; ++m) { const unsigned row = rowt + ai * HALF + m * 16; const float rs = rs8[ai][m];
                const f32x4 p4 = *(const PG8_LAS f32x4*)(xr + (ai * HALF + wr * 64 + m * 16 + fr) * 4);
                const float sk = __builtin_amdgcn_rsqf(((p4[0] + p4[1]) + (p4[2] + p4[3]) + kr8[ai][m]) * (1.0f / 192.0f) + RMS_EPS_), rk = rs * sk;
                { EPI_ACC8(v, ai, 0, m);
#pragma unroll
                  for (int e = 0; e < 8; ++e) v[e] *= rk * (e < 4 ? g0[e & 3] : g1[e & 3]);
                  *(u32x4*)(KF + (row * 1536u + head * 192u + d0)) = pack8(v); }
                { EPI_ACC8(v, ai, 1, m);
#pragma unroll
                  for (int e = 0; e < 8; ++e) v[e] *= rs;
                  *(u32x4*)(VV + (row * 1024u + head * 128u + d0)) = pack8(v); }
                { const u32x2 kr = *(const u32x2*)(KR + (row * 64u + 16 * wc + 4 * fq));
                  *(u32x2*)(KF + (row * 1536u + head * 192u + 128 + 16 * wc + 4 * fq)) = (u32x2){cvt_pk_bf16(bflo(kr.x) * sk, bfhi(kr.x) * sk), cvt_pk_bf16(bflo(kr.y) * sk, bfhi(kr.y) * sk)}; } }
    }
};

struct EpiQup {
    static constexpr bool PERM = true, AFTER_DRAIN = false, TWICE_OK = false; static __device__ __forceinline__ bool twice(const Unit&) { return false; }
    bf16_t* QP; const float* ssq_cq; const float* q_norm; const void* csm; PG8_LAS float* xr; float c2q;
    __device__ __forceinline__ void operator()(const f32x4 (&acc)[2][2][4][2], const Unit& u, int wr, int wc, int fr, int fq) const {
        const unsigned rowt = u.pm * BM + wr * 64 + fr, head = u.pn;
#pragma unroll
        for (int ai = 0; ai < 2; ++ai)
#pragma unroll
            for (int m = 0; m < 4; ++m) { const float rs = __builtin_amdgcn_rsqf(ssq_cq[rowt + ai * HALF + m * 16] * (1.0f / 384.0f) + RMS_EPS_);
                const f32x4 a0 = acc[ai][0][m][0] * rs, a1 = acc[ai][0][m][1] * rs, b0 = acc[ai][1][m][0] * rs, b1 = acc[ai][1][m][1] * rs;
                float q = ((a0[0] * a0[0] + a0[1] * a0[1]) + (a0[2] * a0[2] + a0[3] * a0[3])) + ((a1[0] * a1[0] + a1[1] * a1[1]) + (a1[2] * a1[2] + a1[3] * a1[3]))
                        + ((b0[0] * b0[0] + b0[1] * b0[1]) + (b0[2] * b0[2] + b0[3] * b0[3])) + ((b1[0] * b1[0] + b1[1] * b1[1]) + (b1[2] * b1[2] + b1[3] * b1[3]));
                q += __shfl_xor(q, 16); q += __shfl_xor(q, 32);
                if (fq == 0) xr[(ai * HALF + wr * 64 + m * 16 + fr) * 4 + wc] = q; }
        asm volatile("s_waitcnt lgkmcnt(0)\n\ts_barrier" ::: "memory");
        const unsigned dA = wc < 3 ? wc * 32 + 8 * fq : 128 + 8 * fq, dB = wc == 0 ? 96 + 8 * fq : 160 + 8 * fq;
        const f32x4 gA0 = *(const f32x4*)(q_norm + dA), gA1 = *(const f32x4*)(q_norm + dA + 4), gB0 = *(const f32x4*)(q_norm + dB), gB1 = *(const f32x4*)(q_norm + dB + 4);
#pragma unroll
        for (int ai = 0; ai < 2; ++ai)
#pragma unroll
            for (int m = 0; m < 4; ++m) { const unsigned row = rowt + ai * HALF + m * 16; const float rs = __builtin_amdgcn_rsqf(ssq_cq[row] * (1.0f / 384.0f) + RMS_EPS_);
                const f32x4 p4 = *(const PG8_LAS f32x4*)(xr + (ai * HALF + wr * 64 + m * 16 + fr) * 4);
                const float sc = __builtin_amdgcn_rsqf(((p4[0] + p4[1]) + (p4[2] + p4[3])) * (1.0f / 192.0f) + RMS_EPS_) * rs * c2q;
                EPI_ACC8(va, ai, 0, m); EPI_ACC8(vb, ai, 1, m);
#pragma unroll
                for (int e = 0; e < 8; ++e) { va[e] *= sc * (e < 4 ? gA0[e & 3] : gA1[e & 3]); vb[e] *= sc * (e < 4 ? gB0[e & 3] : gB1[e & 3]); }
                bf16_t* qrow = QP + (row * 1536u + head * 192u);
                if (wc == 3) {
                    float cc[8], sn[8]; rope8(csm, row, 8 * fq, cc, sn);
#pragma unroll
                    for (int e = 0; e < 8; ++e) { const float a_ = va[e], b_ = vb[e]; va[e] = a_ * cc[e] - b_ * sn[e]; vb[e] = b_ * cc[e] + a_ * sn[e]; }
                }
                *(u32x4*)(qrow + dA) = pack8(va);
                if (wc == 0 || wc == 3) *(u32x4*)(qrow + dB) = pack8(vb); }
    }
};

template <int MODE> struct EpiRowAct {
    static constexpr bool PERM = true, AFTER_DRAIN = false, TWICE_OK = false; static __device__ __forceinline__ bool twice(const Unit&) { return true; }
    bf16_t* O; int ldo; const float* rsrc; float inv_dim; unsigned gso;
    __device__ __forceinline__ void operator()(const f32x4 (&acc)[2][2][4][2], const Unit& u, int wr, int wc, int fr, int fq) const {
        const int rowt = u.pm * BM + wr * 64 + fr, colt = u.pn * BM + wc * 32 + 8 * fq;
#pragma unroll
        for (int ai = 0; ai < 2; ++ai)
#pragma unroll
            for (int m = 0; m < 4; ++m) { const int row = rowt + ai * HALF + m * 16; const float r0 = rsrc[row]; const float rs = inv_dim == 0.f ? r0 : __builtin_amdgcn_rsqf(r0 * inv_dim + RMS_EPS_);
#pragma unroll
                for (int bj = 0; bj < 2; ++bj) { EPI_ACC8(v, ai, bj, m);
#pragma unroll
                    for (int e = 0; e < 8; ++e) { float x = v[e] * rs; if (MODE == 1) x = sigmoidf_(x); if (MODE == 2) { x = fmaxf(x, 0.f); x = x * x; } v[e] = x; }
                    st16(O + (gso ? (size_t)(row >> 11) * gso + (size_t)(row & 2047) * ldo : (size_t)row * ldo) + colt + bj * HALF, pack8(v)); } }
    }
};
struct EpiRetGate {
    static constexpr bool PERM = true, AFTER_DRAIN = false, TWICE_OK = false; static __device__ __forceinline__ bool twice(const Unit&) { return false; }
    bf16_t* RO; const float* rstdx; const float* ssq_ro; const float* ret_norm;
    __device__ __forceinline__ void operator()(const f32x4 (&acc)[2][2][4][2], const Unit& u, int wr, int wc, int fr, int fq) const {
        const int rowt = u.pm * BM + wr * 64 + fr, colt = u.pn * BM + wc * 32 + 8 * fq, head = u.pn >> 1;
        f32x4 g[2][2];
#pragma unroll
        for (int bj = 0; bj < 2; ++bj) { g[bj][0] = *(const f32x4*)(ret_norm + colt + bj * HALF); g[bj][1] = *(const f32x4*)(ret_norm + colt + bj * HALF + 4); }
#pragma unroll
        for (int ai = 0; ai < 2; ++ai)
#pragma unroll
            for (int m = 0; m < 4; ++m) { const int row = rowt + ai * HALF + m * 16; const float rs = rstdx[row]; const f32x4* sp = (const f32x4*)(ssq_ro + ((size_t)row * 4 + head) * 16); const f32x4 s4 = (sp[0] + sp[1]) + (sp[2] + sp[3]);
                const float rr = __builtin_amdgcn_rsqf(((s4[0] + s4[1]) + (s4[2] + s4[3])) * (1.0f / 512.0f) + RMS_EPS_);
#pragma unroll
                for (int bj = 0; bj < 2; ++bj) { EPI_ACC8(v, ai, bj, m); bf16_t* p = RO + (size_t)row * 2048 + colt + bj * HALF; float o[8]; unpack8(*(const u32x4*)p, o);
#pragma unroll
                    for (int e = 0; e < 8; ++e) { const float x = v[e] * rs; const float gg = e < 4 ? g[bj][0][e & 3] : g[bj][1][e & 3]; v[e] = o[e] * rr * gg * x * sigmoidf_(x); }
                    *(u32x4*)p = pack8(v); } }
    }
};
template <int MODE> struct EpiGateMix {
    static constexpr bool PERM = true, AFTER_DRAIN = false, TWICE_OK = false; static __device__ __forceinline__ bool twice(const Unit&) { return false; }
    bf16_t* TM; const bf16_t* SG; int sgoff; static constexpr size_t BLKE = (size_t)8 << 20;
    __device__ __forceinline__ void operator()(const f32x4 (&acc)[2][2][4][2], const Unit& u, int wr, int wc, int fr, int fq) const {
        const int rowt = u.pm * BM + wr * 64 + fr, colt = u.pn * BM + wc * 32 + 8 * fq;
#pragma unroll
        for (int ai = 0; ai < 2; ++ai)
#pragma unroll
            for (int m = 0; m < 4; ++m) { const int row = rowt + ai * HALF + m * 16;
#pragma unroll
                for (int bj = 0; bj < 2; ++bj) { EPI_ACC8(v, ai, bj, m); float s[8]; unpack8(*(const u32x4*)(SG + (size_t)(row >> 11) * BLKE + (size_t)(row & 2047) * 2048 + sgoff + colt + bj * HALF), s);
                    bf16_t* p = TM + (size_t)(row >> 11) * BLKE + (size_t)(row & 2047) * 1024 + colt + bj * HALF;
                    if (MODE == 1) { float t[8]; unpack8(*(const u32x4*)p, t);
#pragma unroll
                        for (int e = 0; e < 8; ++e) v[e] = t[e] + s[e] * v[e]; }
                    else {
#pragma unroll
                        for (int e = 0; e < 8; ++e) v[e] = s[e] * v[e]; }
                    *(u32x4*)p = pack8(v); } }
    }
};
template <bool RESB> struct EpiResid {
    static constexpr bool PERM = true, AFTER_DRAIN = false, TWICE_OK = false; static __device__ __forceinline__ bool twice(const Unit&) { return false; }
    const void* res; bf16_t* xb; float* ssq;
    __device__ __forceinline__ void operator()(const f32x4 (&acc)[2][2][4][2], const Unit& u, int wr, int wc, int fr, int fq) const {
        const int rowt = u.pm * BM + wr * 64 + fr, colt = u.pn * BM + wc * 32 + 8 * fq;
#pragma unroll
        for (int ai = 0; ai < 2; ++ai)
#pragma unroll
            for (int m = 0; m < 4; ++m) { const int row = rowt + ai * HALF + m * 16; float q = 0.f;
#pragma unroll
                for (int bj = 0; bj < 2; ++bj) { EPI_ACC8(v, ai, bj, m); const size_t off = (size_t)row * 1024 + colt + bj * HALF;
                    if (RESB) { float r[8]; unpack8(*(const u32x4*)((const bf16_t*)res + off), r);
#pragma unroll
                        for (int e = 0; e < 8; ++e) { v[e] += r[e]; q += v[e] * v[e]; } }
                    else { const f32x4 r0 = *(const f32x4*)((const float*)res + off), r1 = *(const f32x4*)((const float*)res + off + 4);
#pragma unroll
                        for (int e = 0; e < 8; ++e) { v[e] += e < 4 ? r0[e & 3] : r1[e & 3]; q += v[e] * v[e]; } }
                    *(u32x4*)(xb + off) = pack8(v); }
                q += __shfl_xor(q, 16); q += __shfl_xor(q, 32); if (fq == 0) atomicAdd(ssq + row, q);
                if (m & 1) asm volatile("" ::: "memory"); }
    }
};
struct EpiFinal {
    static constexpr bool PERM = true, AFTER_DRAIN = false, TWICE_OK = false; static __device__ __forceinline__ bool twice(const Unit&) { return false; }
    float* out; const bf16_t* GT; const bf16_t* xb;
    __device__ __forceinline__ void operator()(const f32x4 (&acc)[2][2][4][2], const Unit& u, int wr, int wc, int fr, int fq) const {
        const int rowt = u.pm * BM + wr * 64 + fr, colt = u.pn * BM + wc * 32 + 8 * fq;
#pragma unroll
        for (int ai = 0; ai < 2; ++ai)
#pragma unroll
            for (int m = 0; m < 4; ++m) { const int row = rowt + ai * HALF + m * 16;
#pragma unroll
                for (int bj = 0; bj < 2; ++bj) { EPI_ACC8(v, ai, bj, m); const size_t off = (size_t)row * 1024 + colt + bj * HALF; float gt[8], r[8]; unpack8(*(const u32x4*)(GT + off), gt); unpack8(*(const u32x4*)(xb + off), r);
#pragma unroll
                    for (int e = 0; e < 8; ++e) v[e] = r[e] + gt[e] * v[e];
                    *(f32x4*)(out + off) = (f32x4){v[0], v[1], v[2], v[3]}; *(f32x4*)(out + off + 4) = (f32x4){v[4], v[5], v[6], v[7]}; }
                if (m & 1) asm volatile("" ::: "memory"); }
    }
};
template <class Epi, class Sched, bool ALIGN_EPI = false, bool SP2 = false>
__device__ __forceinline__ void gemm_phase(PG8_LAS unsigned char* lds, const Gemm g, const Sched& S, const Epi& E) {
    int tid = threadIdx.x; asm volatile("" : "+v"(tid));
    const int wid = __builtin_amdgcn_readfirstlane(tid >> 6), lane = tid & 63, wr = wid >> 2, wc = wid & 3, fr = lane & 15, fq = lane >> 4;
    int K = g.K; if (g.K < 512) asm volatile("" : "+s"(K));
    const int nt = K / BK;
    unsigned voffA[2], voffB[2];
#pragma unroll
    for (int i = 0; i < 2; ++i) { int R, C; stage_rc(tid * 16 + i * 8192, R, C); const int Rb = Epi::PERM ? ((R & ~31) + perm32(R & 31)) : R;
        voffA[i] = (unsigned)(R * g.lda + C) * 2u; voffB[i] = (unsigned)(Rb * g.ldb + C) * 2u; }
    const size_t kstep = (size_t)(BK * 2);
    const size_t hstepA = (size_t)HALF * g.lda * 2, hstepB = (size_t)HALF * g.ldb * 2;
    const size_t tstepA = 2 * hstepA, tstepB = 2 * hstepB;
    const unsigned ldsw = (unsigned)wid * 1024u;
    const int aoff = lds_byte(wr * 64 + fr, fq * 8), boff = lds_byte(wc * 32 + fr, fq * 8);
#define PG8_SA(b, h) (((b) * 2 + (h)) * HTB)
#define PG8_SB(b, h) ((4 + (b) * 2 + (h)) * HTB)
#define PG8_STAGE(bufoff, gbase, voff) do { _Pragma("unroll") for (int _i = 0; _i < 2; ++_i) \
        __builtin_amdgcn_global_load_lds((const unsigned*)((const char*)(gbase) + (voff)[_i]), (PG8_LAS unsigned*)(lds + (bufoff) + ldsw + _i * 8192), 16, 0, 0); } while (0)
#define PG8_LDA(dst, b, h) do { _Pragma("unroll") for (int m = 0; m < 4; ++m) _Pragma("unroll") for (int k = 0; k < 2; ++k) dst[m][k] = *(const PG8_LAS bf16x8*)(lds + PG8_SA(b, h) + aoff + m * 2048 + k * 1024); } while (0)
#define PG8_LDB(dst, b, h) do { _Pragma("unroll") for (int n = 0; n < 2; ++n) _Pragma("unroll") for (int k = 0; k < 2; ++k) dst[n][k] = *(const PG8_LAS bf16x8*)(lds + PG8_SB(b, h) + boff + n * 2048 + k * 1024); } while (0)
#define PG8_MMA(ai, bj, At, Bt) do { __builtin_amdgcn_s_setprio(1); _Pragma("unroll") for (int m = 0; m < 4; ++m) _Pragma("unroll") for (int n = 0; n < 2; ++n) _Pragma("unroll") for (int k = 0; k < 2; ++k) \
        acc[ai][bj][m][n] = __builtin_amdgcn_mfma_f32_16x16x32_bf16(Bt[n][k], At[m][k], acc[ai][bj][m][n], 0, 0, 0); __builtin_amdgcn_s_setprio(0); } while (0)
#define PG8_WAIT_V(n) asm volatile("s_waitcnt vmcnt(" #n ")" ::: "memory")
#define PG8_WAIT_L(n) asm volatile("s_waitcnt lgkmcnt(" #n ")" ::: "memory")
#define PG8_BAR __builtin_amdgcn_s_barrier()
#define PG8_SCHED __builtin_amdgcn_sched_barrier(0)
    Unit cur, nxt; int ui = 0;
    if (!S.next(0, cur)) return;
    f32x4 acc[2][2][4][2];
#pragma unroll
    for (int a = 0; a < 2; ++a)
#pragma unroll
        for (int b = 0; b < 2; ++b)
#pragma unroll
            for (int m = 0; m < 4; ++m)
#pragma unroll
                for (int n = 0; n < 2; ++n) acc[a][b][m][n] = (f32x4){0.f, 0.f, 0.f, 0.f};
    bf16x8 At[4][2], B0[2][2], B1[2][2];
#define PG8_AROW(pm_) ((const char*)g.A + (g.gsA ? (size_t)((pm_) >> 3) * g.gsA + (size_t)((pm_) & 7) * tstepA : (size_t)(pm_) * tstepA))
    const char* cA = PG8_AROW(cur.pm); const char* cB = (const char*)g.Bt + (size_t)cur.pn * tstepB;
    S.a_ready(cur);
    if constexpr (SP2) {
        PG8_STAGE(PG8_SB(0, 0), cB, voffB); PG8_STAGE(PG8_SB(0, 1), cB + hstepB, voffB); PG8_STAGE(PG8_SA(0, 0), cA, voffA); PG8_STAGE(PG8_SA(0, 1), cA + hstepA, voffA);
        if (wr == 1) PG8_BAR;
        PG8_WAIT_V(2); PG8_BAR;
        PG8_STAGE(PG8_SB(1, 0), cB + kstep, voffB); PG8_STAGE(PG8_SA(1, 0), cA + kstep, voffA); PG8_STAGE(PG8_SB(1, 1), cB + hstepB + kstep, voffB);
        PG8_WAIT_V(6); PG8_BAR;
    } else {
        PG8_STAGE(PG8_SB(0, 0), cB, voffB); PG8_STAGE(PG8_SA(0, 0), cA, voffA); PG8_STAGE(PG8_SB(0, 1), cB + hstepB, voffB); PG8_STAGE(PG8_SA(0, 1), cA + hstepA, voffA);
        if (wr == 1) PG8_BAR;
        PG8_WAIT_V(4); PG8_BAR;
        PG8_STAGE(PG8_SB(1, 0), cB + kstep, voffB); PG8_STAGE(PG8_SA(1, 0), cA + kstep, voffA); PG8_STAGE(PG8_SB(1, 1), cB + hstepB + kstep, voffB);
        PG8_WAIT_V(6); PG8_BAR;
    }
    for (;;) {
        const bool has_next = S.next(ui + 1, nxt);
        const char* nA = has_next ? PG8_AROW(nxt.pm) : cA; const char* nB = has_next ? (const char*)g.Bt + (size_t)nxt.pn * tstepB : cB;
        for (int t = 0; t < nt; t += 2) {
            const bool last = (t == nt - 2);
            const char* a1 = cA + (size_t)(t + 1) * kstep;
            const char* a2 = last ? nA : cA + (size_t)(t + 2) * kstep; const char* b2 = last ? nB : cB + (size_t)(t + 2) * kstep;
            const char* a3 = a2 + kstep; const char* b3 = b2 + kstep;
            if (last && has_next) S.a_ready(nxt);
            if constexpr (SP2) {
            PG8_LDB(B0, 0, 0); PG8_LDB(B1, 0, 1); PG8_SCHED; PG8_LDA(At, 0, 0); PG8_STAGE(PG8_SA(1, 1), a1 + hstepA, voffA);
            PG8_WAIT_V(8); PG8_WAIT_L(0); PG8_BAR; PG8_MMA(0, 0, At, B0); PG8_MMA(0, 1, At, B1); PG8_BAR; PG8_SCHED;
            PG8_LDA(At, 0, 1); PG8_STAGE(PG8_SB(0, 0), b2, voffB); PG8_STAGE(PG8_SB(0, 1), b2 + hstepB, voffB); PG8_STAGE(PG8_SA(0, 0), a2, voffA);
            PG8_WAIT_V(8); PG8_WAIT_L(0); PG8_BAR; PG8_MMA(1, 0, At, B0); PG8_MMA(1, 1, At, B1); PG8_BAR; PG8_SCHED;
            PG8_LDB(B0, 1, 0); PG8_LDB(B1, 1, 1); PG8_SCHED; PG8_LDA(At, 1, 0); PG8_STAGE(PG8_SA(0, 1), a2 + hstepA, voffA);
            PG8_WAIT_V(8); PG8_WAIT_L(0); PG8_BAR; PG8_MMA(0, 0, At, B0); PG8_MMA(0, 1, At, B1); PG8_BAR; PG8_SCHED;
            PG8_LDA(At, 1, 1); PG8_STAGE(PG8_SB(1, 0), b3, voffB); PG8_STAGE(PG8_SB(1, 1), b3 + hstepB, voffB); PG8_STAGE(PG8_SA(1, 0), a3, voffA);
            PG8_WAIT_V(8); PG8_WAIT_L(0); PG8_BAR; PG8_MMA(1, 0, At, B0); PG8_MMA(1, 1, At, B1); PG8_BAR; PG8_SCHED;
            } else {
            PG8_LDB(B0, 0, 0); PG8_SCHED; PG8_LDA(At, 0, 0); PG8_STAGE(PG8_SA(1, 1), a1 + hstepA, voffA);
            PG8_WAIT_L(8); PG8_BAR; PG8_WAIT_L(0); PG8_MMA(0, 0, At, B0); PG8_BAR; PG8_SCHED;
            PG8_LDB(B1, 0, 1); PG8_STAGE(PG8_SB(0, 0), b2, voffB);
            PG8_BAR; PG8_WAIT_L(0); PG8_MMA(0, 1, At, B1); PG8_BAR;
            PG8_LDA(At, 0, 1); PG8_STAGE(PG8_SA(0, 0), a2, voffA);
            PG8_BAR; PG8_WAIT_L(0); PG8_MMA(1, 0, At, B0); PG8_BAR; PG8_SCHED;
            PG8_STAGE(PG8_SB(0, 1), b2 + hstepB, voffB);
            PG8_WAIT_V(6); PG8_BAR; PG8_MMA(1, 1, At, B1); PG8_BAR;
            PG8_LDB(B0, 1, 0); PG8_SCHED; PG8_LDA(At, 1, 0); PG8_STAGE(PG8_SA(0, 1), a2 + hstepA, voffA);
            PG8_WAIT_L(8); PG8_BAR; PG8_WAIT_L(0); PG8_MMA(0, 0, At, B0); PG8_BAR; PG8_SCHED;
            PG8_LDB(B1, 1, 1); PG8_STAGE(PG8_SB(1, 0), b3, voffB);
            PG8_BAR; PG8_WAIT_L(0); PG8_MMA(0, 1, At, B1); PG8_BAR;
            PG8_LDA(At, 1, 1); PG8_STAGE(PG8_SA(1, 0), a3, voffA);
            PG8_BAR; PG8_WAIT_L(0); PG8_MMA(1, 0, At, B0); PG8_BAR; PG8_SCHED;
            PG8_STAGE(PG8_SB(1, 1), b3 + hstepB, voffB);
            PG8_WAIT_V(6); PG8_BAR; PG8_MMA(1, 1, At, B1); PG8_BAR;
            }
        }
        if constexpr (ALIGN_EPI) { if (wr == 0) PG8_BAR; }
        if constexpr (!Epi::AFTER_DRAIN) { E(acc, cur, wr, wc, fr, fq);
#ifdef EPI_TWICE
            if constexpr (Epi::TWICE_OK) { asm volatile("" ::: "memory"); if (Epi::twice(cur)) E(acc, cur, wr, wc, fr, fq); }
#endif
            S.done(cur); }
        if (!has_next) break;
#pragma unroll
        for (int a = 0; a < 2; ++a)
#pragma unroll
            for (int b = 0; b < 2; ++b)
#pragma unroll
                for (int m = 0; m < 4; ++m)
#pragma unroll
                    for (int n = 0; n < 2; ++n) acc[a][b][m][n] = (f32x4){0.f, 0.f, 0.f, 0.f};
        cur = nxt; cA = nA; cB = nB; ++ui;
        if constexpr (ALIGN_EPI) { if (wr == 1) PG8_BAR; }
    }
    PG8_WAIT_V(0);
    if constexpr (!ALIGN_EPI) { if (wr == 0) PG8_BAR; }
    PG8_BAR;
    if constexpr (Epi::AFTER_DRAIN) { E.fused(acc, cur, wr, wc, fr, fq, lds, wid, lane); S.done(cur); }
#undef PG8_AROW
#undef PG8_SA
#undef PG8_SB
#undef PG8_STAGE
#undef PG8_LDA
#undef PG8_LDB
#undef PG8_MMA
#undef PG8_WAIT_V
#undef PG8_WAIT_L
#undef PG8_BAR
#undef PG8_SCHED
}
}
#define GAS __attribute__((address_space(1)))
#define LAS __attribute__((address_space(3)))
typedef unsigned short bf16;
typedef unsigned v4u __attribute__((ext_vector_type(4)));
typedef float f32x4 __attribute__((ext_vector_type(4)));
typedef short bf16x8 __attribute__((ext_vector_type(8)));
typedef GAS unsigned gu32;
typedef GAS unsigned long long gu64;
#define RLX_AGENT __ATOMIC_RELAXED, __HIP_MEMORY_SCOPE_AGENT
#define LDS_WAIT() asm volatile("s_waitcnt lgkmcnt(0)" ::: "memory")
#define VM_WAIT() asm volatile("s_waitcnt vmcnt(0)" ::: "memory")
__device__ __forceinline__ unsigned long long rt() { return __builtin_amdgcn_s_memrealtime(); }
__device__ __forceinline__ unsigned f2bf(float f) { unsigned u = __builtin_bit_cast(unsigned, f); return (u + 0x7fffu + ((u >> 16) & 1u)) >> 16; }
__device__ __forceinline__ unsigned pk2(float lo, float hi) { return f2bf(lo) | (f2bf(hi) << 16); }

#define XB_TMO      128
#define XB_XCNT(j)  (256  + 64 * (j))
#define XB_XSUB(j)  (1280 + 64 * (j))
#define XB_XGEN(j)  (2304 + 64 * (j))
#define XB_TOP      3328
#define XB_TOPGEN   3392
#define XCD_BAR_WORDS 3456
#define XB_SPIN_CAP (1u << 18)

__device__ __forceinline__ unsigned xb_ld(unsigned* p)              { return __hip_atomic_load(p, __ATOMIC_RELAXED, __HIP_MEMORY_SCOPE_AGENT); }
__device__ __forceinline__ unsigned xb_add(unsigned* p, unsigned v) { return __hip_atomic_fetch_add(p, v, __ATOMIC_RELAXED, __HIP_MEMORY_SCOPE_AGENT); }
__device__ __forceinline__ unsigned xb_xcc_id() { return (unsigned)__builtin_amdgcn_s_getreg((3 << 11) | 20) & 0xFu; }
#define XB_SPIN(cond, bar) do { unsigned _sp = 0; while (cond) { __builtin_amdgcn_s_sleep(1); \
    if ((++_sp & 255u) == 0u) { if (xb_ld(&(bar)[XB_TMO])) break; if (_sp > XB_SPIN_CAP) { atomicAdd(&(bar)[XB_TMO], 1u); break; } } } } while (0)

struct XcdBarrier {
    unsigned* bar; unsigned x;
    volatile LAS unsigned* st;
};

__device__ __forceinline__ XcdBarrier xcd_barrier_post(unsigned* bar, volatile LAS unsigned* st) {
    XcdBarrier b; b.bar = bar; b.x = xb_xcc_id(); b.st = st;
    if (threadIdx.x == 0) st[2] = xb_add(&bar[XB_XCNT(b.x)], 1u);
    return b;
}
__device__ __forceinline__ void xcd_barrier_complete(unsigned* bar, unsigned x, unsigned& nloc, unsigned& nx) {
    const unsigned G = gridDim.x * gridDim.y * gridDim.z;
    unsigned sum, cnt, mine, sp = 0u;
    for (;;) {
        sum = 0u; cnt = 0u; mine = 0u;
#pragma unroll
        for (unsigned j = 0; j < 16; ++j) { const unsigned c = xb_ld(&bar[XB_XCNT(j)]); sum += c; cnt += (c > 0u) ? 1u : 0u; mine = (j == x) ? c : mine; }
        if (sum == G) break;
        __builtin_amdgcn_s_sleep(1);
        if ((++sp & 255u) == 0u) { if (xb_ld(&bar[XB_TMO])) break; if (sp > XB_SPIN_CAP) { atomicAdd(&bar[XB_TMO], 1u); break; } }
    }
    nloc = mine > 0u ? mine : 1u; nx = cnt > 0u ? cnt : 1u;
}

__device__ __forceinline__ void xcd_barrier(const XcdBarrier& b) {
    asm volatile("s_waitcnt vmcnt(0)" ::: "memory");
    __syncthreads();
    if (threadIdx.x == 0) {
        unsigned* bar = b.bar;
        __builtin_amdgcn_s_waitcnt(0);
        unsigned nloc = b.st[0], nx = b.st[1];
        if (nloc == 0u) { xcd_barrier_complete(bar, b.x, nloc, nx); b.st[0] = nloc; b.st[1] = nx; }
        const unsigned old = xb_add(&bar[XB_XSUB(b.x)], 1u);
        const unsigned gen = old / nloc;
        if (old + 1u == (gen + 1u) * nloc) {
            __builtin_amdgcn_fence(__ATOMIC_RELEASE, "agent");
            asm volatile("s_waitcnt vmcnt(0)" ::: "memory");
            const unsigned og = xb_add(&bar[XB_TOP], 1u);
            const unsigned tg = og / nx;
            if (og + 1u == (tg + 1u) * nx) xb_add(&bar[XB_TOPGEN], 1u);
            else XB_SPIN(xb_ld(&bar[XB_TOPGEN]) == tg, bar);
            __builtin_amdgcn_fence(__ATOMIC_ACQUIRE, "agent");
            xb_add(&bar[XB_XGEN(b.x)], 1u);
            asm volatile("s_waitcnt vmcnt(0)" ::: "memory");
        } else {
            XB_SPIN(xb_ld(&bar[XB_XGEN(b.x)]) == gen, bar);
            __builtin_amdgcn_fence(__ATOMIC_ACQUIRE, "agent");
            asm volatile("s_waitcnt vmcnt(0)" ::: "memory");
        }
    }
    __syncthreads();
}


#define XB_LSUB(j)  (3520 + 64 * (j))
#define XB_LGEN(j)  (4544 + 64 * (j))
#define XCD_BAR_WORDS_ALL 5632
__device__ __forceinline__ void xcd_local_barrier(const XcdBarrier& b) {
    asm volatile("s_waitcnt vmcnt(0)" ::: "memory");
    __syncthreads();
    if (threadIdx.x == 0) {
        unsigned* bar = b.bar; __builtin_amdgcn_s_waitcnt(0);
        const unsigned nloc = b.st[0];
        const unsigned old = xb_add(&bar[XB_LSUB(b.x)], 1u), gen = old / nloc;
        if (old + 1u == (gen + 1u) * nloc) { __builtin_amdgcn_fence(__ATOMIC_ACQUIRE, "agent"); xb_add(&bar[XB_LGEN(b.x)], 1u); asm volatile("s_waitcnt vmcnt(0)" ::: "memory"); }
        else { XB_SPIN(xb_ld(&bar[XB_LGEN(b.x)]) == gen, bar); __builtin_amdgcn_fence(__ATOMIC_ACQUIRE, "agent"); asm volatile("s_waitcnt vmcnt(0)" ::: "memory"); }
    }
    __syncthreads();
}

typedef float f32x2 __attribute__((ext_vector_type(2)));
constexpr int NWAVES = 8;
constexpr int BATCH = 4, SEQ = 4096, DM = 1024, MTOK = BATCH * SEQ;
constexpr int NIN1 = 5120;
constexpr int LATW = 640;
constexpr float C2Q = 0.07216878364870323f * 1.4426950408889634f;

constexpr size_t MiB = 1u << 20, KiB = 1u << 10;
constexpr size_t WS_CTL = 0, CTL_ZERO_BYTES = 64 * KiB;
constexpr size_t WS_SMALL = 1 * MiB;
constexpr size_t SM_RSTDX = 0, SM_SSQ_CQ = 64 * KiB, SM_SSQ_CKV = 128 * KiB, SM_SSQ1 = 192 * KiB, SM_SSQ2 = 256 * KiB, SM_SSQ_KR = 320 * KiB, SM_END = 384 * KiB;
constexpr size_t WS_WIN = 2 * MiB;
constexpr size_t WS_SSQP = 10 * MiB;
constexpr size_t WS_WUQ = 20 * MiB;
constexpr size_t WS_WUKV = WS_WUQ + (size_t)2048 * 384 * 2;
constexpr size_t WS_KR = 22 * MiB + 512 * KiB;
constexpr size_t WS_XB = 25 * MiB;
constexpr size_t WS_CS = 57 * MiB;
constexpr size_t WS_LAT = 73 * MiB;
constexpr size_t WS_RQ = 94 * MiB, WS_RK = 126 * MiB, WS_RKDT = 158 * MiB, WS_RVT = 190 * MiB;
constexpr size_t WS_QP = 94 * MiB, WS_KF = 142 * MiB, WS_VV = 190 * MiB;
constexpr size_t WS_MO = 222 * MiB;
constexpr size_t WS_BLK = 16 * MiB;
constexpr size_t WS_SG = 57 * MiB, WS_TM = 57 * MiB + 8 * MiB;
constexpr size_t WS_WBR = 190 * MiB, WS_WBM = 194 * MiB, WS_WO = 196 * MiB, WS_WUP = 198 * MiB, WS_WDOWN = 206 * MiB, WS_WPG = 214 * MiB, WS_WPLE = 18 * MiB;
constexpr size_t WS_PB = 10 * MiB;
constexpr size_t WS_H = 57 * MiB;
constexpr size_t WS_GT = 222 * MiB;
constexpr size_t WS_CSM = 254 * MiB;
constexpr size_t WS_END = 256 * MiB;
static_assert(SM_SSQ_CKV == SM_SSQ_CQ + 65536, "ssq_lat layout");
static_assert(WS_WIN + (size_t)9216 * 2048 <= WS_WUQ && WS_WUKV + (size_t)2048 * 256 * 2 <= WS_KR && WS_KR + 2 * MiB <= WS_XB && WS_LAT + 20 * MiB <= WS_RQ && WS_RVT + 64 * MiB <= WS_END && WS_H + 128 * MiB <= WS_WBR && WS_PB + 8 * MiB <= WS_WPLE && WS_WPLE + 512 * KiB <= WS_WUQ && WS_WPG + 2 * MiB <= WS_GT && WS_GT + 32 * MiB <= WS_CSM && WS_VV + 32 * MiB <= WS_MO, "d_ws map");
constexpr int CW_BAR = 1024;

constexpr int RING_OFF = 0, RING_BYTES = 131072;
constexpr int XS_OFF = RING_BYTES, XS_BYTES = 8 * 2304;
constexpr int MISC_OFF = XS_OFF + XS_BYTES;
constexpr int LDS_BYTES = 160 * 1024;
static_assert(MISC_OFF + 128 <= LDS_BYTES, "LDS map");

struct Frame {
    LAS unsigned char* lds; volatile LAS unsigned* MISC; int tid, lane, wave, G, vcu;
    float* out; unsigned char* ws;
};
__device__ __forceinline__ float wave_sum(float v) {
#pragma unroll
    for (int o = 1; o < 64; o <<= 1) v += __shfl_xor(v, o);
    return v;
}
__device__ __forceinline__ void p0_transpose_item(const float* W, int ldw, int K, int src_col, bf16* WT, int dst_row, int ncols, const float* gain, LAS float* scr, int item, int lane) {
    const int nblk = ncols / 32, kb = item / nblk, nb = item % nblk, k0 = 64 * kb, n0 = 32 * nb;
#pragma unroll 16
    for (int i = 0; i < 32; ++i) { const int kk = 2 * i + (lane >> 5); const float gk = gain ? gain[k0 + kk] : 1.0f; scr[kk * 33 + (lane & 31)] = W[(size_t)(k0 + kk) * ldw + src_col + n0 + (lane & 31)] * gk; }
    LDS_WAIT(); asm volatile("" ::: "memory");
    const int c = lane & 7;
#pragma unroll
    for (int j = 0; j < 4; ++j) { const int n = (lane >> 3) + 8 * j; const LAS float* s = scr + (8 * c) * 33 + n;
        v4u o; o.x = pk2(s[0 * 33], s[1 * 33]); o.y = pk2(s[2 * 33], s[3 * 33]); o.z = pk2(s[4 * 33], s[5 * 33]); o.w = pk2(s[6 * 33], s[7 * 33]);
        *(GAS v4u*)(WT + (size_t)(dst_row + n0 + n) * K + k0 + 8 * c) = o; }
    LDS_WAIT(); asm volatile("" ::: "memory");
}
struct XT { const float* src; bf16* dst; const float* gain; int ldw, K; };
#define XT_SEG(W_, ldw_, K_, src_, WT_, dst_, ncols_, gain_) { const int n_ = ((K_) / 64) * ((ncols_) / 128); if (r < n_) { const int nblk_ = (ncols_) / 128, kb_ = r / nblk_, nb_ = r - kb_ * nblk_; \
        x.src = (W_) + (size_t)(64 * kb_) * (ldw_) + (src_) + 128 * nb_; x.dst = (WT_) + (size_t)((dst_) + 128 * nb_) * (K_) + 64 * kb_; x.gain = (gain_) ? (gain_) + 64 * kb_ : (const float*)nullptr; x.ldw = (ldw_); x.K = (K_); return x; } r -= n_; }
__device__ __forceinline__ void xt_load(const XT& x, int tid, f32x4 (&v)[4], float (&g)[4]) {
#pragma unroll
    for (int i = 0; i < 4; ++i) { const int row = i * 16 + (tid >> 5); v[i] = *(const GAS f32x4*)(x.src + (size_t)row * x.ldw + 4 * (tid & 31)); g[i] = x.gain ? x.gain[row] : 1.0f; }
}
template <class Dec> __device__ __forceinline__ void xt_run(Frame& F, int ntiles, const Dec& dec) {
    LAS float* scr = (LAS float*)(F.lds + RING_OFF);
    const int tid = F.tid; int t = F.vcu; if (t >= ntiles) return;
    XT cur = dec(t); f32x4 v[4]; float g[4]; xt_load(cur, tid, v, g);
    for (;;) {
        const int tn = t + F.G; const bool has = tn < ntiles; const XT nxt = has ? dec(tn) : cur;
        __syncthreads();
#pragma unroll
        for (int i = 0; i < 4; ++i) *(LAS f32x4*)(scr + (i * 16 + (tid >> 5)) * 132 + 4 * (tid & 31)) = v[i] * g[i];
        if (has) xt_load(nxt, tid, v, g);
        __syncthreads();
        const int n = tid >> 2, kq = tid & 3;
#pragma unroll
        for (int j = 0; j < 2; ++j) { const int kc = kq + 4 * j; const LAS float* s = scr + (8 * kc) * 132 + n;
            v4u o; o.x = pk2(s[0 * 132], s[1 * 132]); o.y = pk2(s[2 * 132], s[3 * 132]); o.z = pk2(s[4 * 132], s[5 * 132]); o.w = pk2(s[6 * 132], s[7 * 132]);
            *(GAS v4u*)(cur.dst + (size_t)n * cur.K + 8 * kc) = o; }
        if (!has) break;
        cur = nxt; t = tn;
    }
    __syncthreads();
}
#define P0_SEG(W, ldw, K, src, WT, dst, ncols, gain) { const int n_ = ((K) / 64) * ((ncols) / 32); if (r < n_) { p0_transpose_item(W, ldw, K, src, WT, dst, ncols, gain, scr, r, F.lane); continue; } r -= n_; }
__device__ __forceinline__ void phase_p0(Frame& F, const float* x, const int* pos, const float* g_mix, const float* w_in, const float* g_qlat, const float* g_kvlat, const float* w_uq, const float* w_ukv) {
    LAS float* scr = (LAS float*)(F.lds + RING_OFF + F.wave * 16384);
    const int gw = F.vcu * NWAVES + F.wave, NGW = F.G * NWAVES;
    bf16* WinT = (bf16*)(F.ws + WS_WIN); bf16* WuqT = (bf16*)(F.ws + WS_WUQ); bf16* WukvT = (bf16*)(F.ws + WS_WUKV);
    struct Dec0 { const float *w_in, *g_mix, *w_uq, *g_qlat, *w_ukv, *g_kvlat; bf16 *WinT, *WuqT, *WukvT;
        __device__ __forceinline__ XT operator()(int r) const { XT x;
            XT_SEG(w_in, 8896, 1024, 6848, WinT, 0, 2048, g_mix)
            XT_SEG(w_in, 8896, 1024, 4096, WinT, 2048, 2048, g_mix)
            XT_SEG(w_in, 8896, 1024, 0, WinT, 4096, 4096, g_mix)
            XT_SEG(w_in, 8896, 1024, 6144, WinT, 8192, 640, g_mix)
            XT_SEG(w_ukv, 2048, 256, 0, WukvT, 0, 2048, g_kvlat)
            x.src = w_in; x.dst = WinT; x.gain = nullptr; x.ldw = 8896; x.K = 1024; return x; } };
    { const Dec0 d{w_in, g_mix, w_uq, g_qlat, w_ukv, g_kvlat, WinT, WuqT, WukvT}; xt_run(F, 16 * 16 * 2 + 16 * 32 + 16 * 5 + 4 * 16, d); }
    for (int it = gw; it < 32 + 8 * 36; it += NGW) {
        int r = it;
        P0_SEG(w_in, 8896, 1024, 6784, WinT, 8960, 32, g_mix)
        P0_SEG(w_in, 8896, 1024, 6816, WinT, 8960 + 128, 32, g_mix)
        { const int hh = r / 36; r -= hh * 36;
          P0_SEG(w_uq, 1536, 384, hh * 192, WuqT, hh * 256, 96, g_qlat)
          P0_SEG(w_uq, 1536, 384, hh * 192 + 128, WuqT, hh * 256 + 96, 32, g_qlat)
          P0_SEG(w_uq, 1536, 384, hh * 192 + 96, WuqT, hh * 256 + 128, 32, g_qlat)
          P0_SEG(w_uq, 1536, 384, hh * 192 + 160, WuqT, hh * 256 + 224, 32, g_qlat) }
    }
    for (int gt = F.vcu * 512 + F.tid; gt < 24576; gt += F.G * 512) { const int hh = gt / 3072, rem = gt - hh * 3072; *(GAS v4u*)((unsigned char*)(WuqT + (size_t)(hh * 256 + 160) * 384) + (size_t)rem * 16) = (v4u){0u, 0u, 0u, 0u}; }
    for (int gt = F.vcu * 512 + F.tid; gt < 40960; gt += F.G * 512) { const int row = gt >> 7, piece = gt & 127; const int wrow = row < 128 ? 8832 + row : (row < 224 ? 8992 + (row - 128) : 9120 + (row - 224));
        *(GAS v4u*)((unsigned char*)(WinT + (size_t)wrow * 1024) + (size_t)piece * 16) = (v4u){0u, 0u, 0u, 0u}; }
    { bf16* XB = (bf16*)(F.ws + WS_XB); float* rstdx = (float*)(F.ws + WS_SMALL + SM_RSTDX);
      for (int m0 = 2 * gw; m0 < MTOK; m0 += 2 * NGW) {
          f32x4 v[2][4]; float s[2] = {0.f, 0.f};
#pragma unroll
          for (int u = 0; u < 2; ++u) { const GAS f32x4* xr = (const GAS f32x4*)(x + (size_t)(m0 + u) * DM) + F.lane;
#pragma unroll
              for (int j = 0; j < 4; ++j) v[u][j] = xr[64 * j]; }
#pragma unroll
          for (int u = 0; u < 2; ++u) {
#pragma unroll
              for (int j = 0; j < 4; ++j) s[u] += (v[u][j].x * v[u][j].x + v[u][j].y * v[u][j].y) + (v[u][j].z * v[u][j].z + v[u][j].w * v[u][j].w);
              s[u] = wave_sum(s[u]);
              GAS unsigned long long* o8 = (GAS unsigned long long*)(XB + (size_t)(m0 + u) * DM) + F.lane;
#pragma unroll
              for (int j = 0; j < 4; ++j) o8[64 * j] = (unsigned long long)pk2(v[u][j].x, v[u][j].y) | ((unsigned long long)pk2(v[u][j].z, v[u][j].w) << 32);
              if (F.lane == 0) rstdx[m0 + u] = 1.0f / sqrtf(s[u] * (1.0f / DM) + 1e-6f); }
      } }
    { f32x2* cs = (f32x2*)(F.ws + WS_CS);
      for (int e = F.vcu * 512 + F.tid; e < MTOK * 128; e += F.G * 512) { const int row = e >> 7, i = e & 127;
          const float inv = __builtin_amdgcn_exp2f(-(float)i * (13.287712379549449f / 128.0f));
          double rev = (double)pos[row] * (double)inv * 0.15915494309189535; rev -= __builtin_rint(rev);
          const float rf = (float)rev; cs[e] = (f32x2){__builtin_amdgcn_cosf(rf), __builtin_amdgcn_sinf(rf)}; } }
    { typedef _Float16 h2_t __attribute__((ext_vector_type(2))); h2_t* csm = (h2_t*)(F.ws + WS_CSM);
      for (int e = F.vcu * 512 + F.tid; e < MTOK * 32; e += F.G * 512) { const int row = e >> 5, i = e & 31;
          const float inv = __builtin_amdgcn_exp2f(-(float)(4 * i) * (13.287712379549449f / 128.0f));
          double rev = (double)pos[row] * (double)inv * 0.15915494309189535; rev -= __builtin_rint(rev);
          const float rf = (float)rev; csm[e] = (h2_t){(_Float16)__builtin_amdgcn_cosf(rf), (_Float16)__builtin_amdgcn_sinf(rf)}; } }
    { float* z = (float*)(F.ws + WS_SMALL + SM_SSQ_CQ); for (int e = F.vcu * 512 + F.tid; e < (int)((SM_END - SM_SSQ_CQ) / 4); e += F.G * 512) z[e] = 0.f; }
}
__device__ __forceinline__ void phase_late_weights(Frame& F, const float* p, const float* w_br, const float* w_bm, const float* w_o, const float* g_mlp, const float* w_up, const float* w_down, const float* g_ple, const float* w_pg, const float* w_ple) {
    struct Dec1 { const float *w_br, *w_bm, *w_o, *g_mlp, *w_up, *w_down, *g_ple, *w_pg, *w_ple; unsigned char* ws;
        __device__ __forceinline__ XT operator()(int r) const { XT x; const float* nog = nullptr;
            XT_SEG(w_br, 1024, 2048, 0, (bf16*)(ws + WS_WBR), 0, 1024, nog)
            XT_SEG(w_bm, 1024, 1024, 0, (bf16*)(ws + WS_WBM), 0, 1024, nog)
            XT_SEG(w_o, 1024, 1024, 0, (bf16*)(ws + WS_WO), 0, 1024, nog)
            XT_SEG(w_up, 4096, 1024, 0, (bf16*)(ws + WS_WUP), 0, 4096, g_mlp)
            XT_SEG(w_down, 1024, 4096, 0, (bf16*)(ws + WS_WDOWN), 0, 1024, nog)
            XT_SEG(w_pg, 1024, 1024, 0, (bf16*)(ws + WS_WPG), 0, 1024, g_ple)
            XT_SEG(w_ple, 1024, 256, 0, (bf16*)(ws + WS_WPLE), 0, 1024, nog)
            x.src = w_br; x.dst = (bf16*)(ws + WS_WBR); x.gain = nullptr; x.ldw = 1024; x.K = 2048; return x; } };
    { const Dec1 d{w_br, w_bm, w_o, g_mlp, w_up, w_down, g_ple, w_pg, w_ple, F.ws}; xt_run(F, 32 * 8 + 16 * 8 * 2 + 16 * 32 + 64 * 8 + 16 * 8 + 4 * 8, d); }
    { bf16* PB = (bf16*)(F.ws + WS_PB);
      for (int e = F.vcu * 512 + F.tid; e < MTOK * 256 / 8; e += F.G * 512) { const f32x4 a = *(const GAS f32x4*)(p + (size_t)e * 8), b = *(const GAS f32x4*)(p + (size_t)e * 8 + 4);
          *(GAS v4u*)(PB + (size_t)e * 8) = (v4u){pk2(a.x, a.y), pk2(a.z, a.w), pk2(b.x, b.y), pk2(b.z, b.w)}; } }
}

typedef float f32x16 __attribute__((ext_vector_type(16)));
typedef unsigned u32x2 __attribute__((ext_vector_type(2)));
typedef short v4i16_t __attribute__((ext_vector_type(4)));
__device__ __forceinline__ int crow(int r, int hi) { return (r & 3) + 8 * (r >> 2) + 4 * hi; }
typedef __bf16 bf16x2m_t __attribute__((ext_vector_type(2)));
__device__ __forceinline__ unsigned cvtpk(float lo, float hi) { f32x2 v = {lo, hi}; bf16x2m_t b = __builtin_convertvector(v, bf16x2m_t); return __builtin_bit_cast(unsigned, b); }
__device__ __forceinline__ bf16x8 pack8f(const f32x16& p, int b) { v4u w = {cvtpk(p[b], p[b + 1]), cvtpk(p[b + 2], p[b + 3]), cvtpk(p[b + 4], p[b + 5]), cvtpk(p[b + 6], p[b + 7])}; return __builtin_bit_cast(bf16x8, w); }
__device__ __forceinline__ float bf2f(bf16 v) { return __uint_as_float((unsigned)v << 16); }
__device__ __forceinline__ float log2_gamma(int h) { return __builtin_amdgcn_logf(1.0f - __builtin_amdgcn_exp2f(-5.0f - (float)h)); }


__device__ __forceinline__ void phase_r0p(Frame& F) {
    const bf16* RQ = (const bf16*)(F.ws + WS_RQ); bf16* RK = (bf16*)(F.ws + WS_RK);
    const int lane = F.lane, w = F.wave, l31 = lane & 31, hi = lane >> 5, tq = w & 3, dh = w >> 2;
    for (int unit = F.vcu; unit < 512; unit += F.G) {
        const int bh = unit >> 5, c = unit & 31, h = bh & 3; const size_t blk = (size_t)bh * 32 + c;
        const float lg2 = log2_gamma(h);
        bf16x8 qf[16];
#pragma unroll
        for (int ks = 0; ks < 16; ++ks) qf[ks] = *(const bf16x8*)(RQ + ((blk * 32 + 2 * ks + hi) * 128 + 32 * tq + l31) * 8);
        f32x16 s[2] = {};
#pragma unroll
        for (int x = 0; x < 2; ++x) { const int tb = 2 * dh + x;
            if (tb <= tq) {
#pragma unroll
                for (int ks = 0; ks < 16; ++ks) { const bf16x8 kf = *(const bf16x8*)(RK + ((blk * 32 + 2 * ks + hi) * 128 + 32 * tb + l31) * 8); s[x] = __builtin_amdgcn_mfma_f32_32x32x16_bf16(kf, qf[ks], s[x], 0, 0, 0); }
#pragma unroll
                for (int r = 0; r < 16; ++r) { const int d = (32 * tq + l31) - (32 * tb + crow(r, hi)); s[x][r] = d >= 0 ? s[x][r] * __builtin_amdgcn_exp2f((float)d * lg2) : 0.f; }
            } }
        VM_WAIT(); __syncthreads();
#pragma unroll
        for (int x = 0; x < 2; ++x) { const int tb = 2 * dh + x;
            if (tb <= tq) {
#pragma unroll
                for (int g = 0; g < 4; ++g) *(u32x2*)(RK + ((blk * 32 + 4 * tb + g) * 128 + 32 * tq + l31) * 8 + 4 * hi) = (u32x2){cvtpk(s[x][4 * g], s[x][4 * g + 1]), cvtpk(s[x][4 * g + 2], s[x][4 * g + 3])};
            } }
    }
}
__device__ __forceinline__ void phase_r1p(Frame& F) {
    const bf16* RQ = (const bf16*)(F.ws + WS_RQ); const bf16* RP = (const bf16*)(F.ws + WS_RK); const bf16* RKDT = (const bf16*)(F.ws + WS_RKDT); const bf16* RVT = (const bf16*)(F.ws + WS_RVT); bf16* RO = (bf16*)F.out;
    float* ssqp = (float*)(F.ws + WS_SSQP);
    const int lane = F.lane, w = F.wave, l15 = lane & 15, lq = lane >> 4;
    constexpr int SROW = 528, SBUF = 32 * SROW;
    LAS unsigned char* ost = F.lds + 2 * SBUF + 1024 + w * 1024;
    const int nkp = (w >> 1) + 1;
    for (int unit = F.vcu; unit < 256; unit += F.G) {
        const int bh = unit >> 4, j = unit & 15, b = bh >> 2, h = bh & 3;
        const float lg2 = log2_gamma(h), gC = __builtin_amdgcn_exp2f(128.0f * lg2);
        float qd[4];
#pragma unroll
        for (int i = 0; i < 4; ++i) qd[i] = __builtin_amdgcn_exp2f((float)(16 * w + 4 * lq + i + 1) * lg2);
        f32x4 S[2][2];
#pragma unroll
        for (int mb = 0; mb < 2; ++mb)
#pragma unroll
            for (int nb = 0; nb < 2; ++nb) S[mb][nb] = (f32x4){0.f, 0.f, 0.f, 0.f};
        __syncthreads();
#pragma unroll
        for (int mb = 0; mb < 2; ++mb)
#pragma unroll
            for (int nb = 0; nb < 2; ++nb) *(LAS u32x2*)(F.lds + (16 * nb + l15) * SROW + (32 * w + 16 * mb + 4 * lq) * 2) = (u32x2){0u, 0u};
        const bf16* qp = RQ + (((size_t)bh * 32 * 32 + lq) * 128 + 16 * w + l15) * 8;
        const bf16* pp = RP + (((size_t)bh * 32 * 32 + lq) * 128 + 16 * w + l15) * 8;
        const bf16* kp = RKDT + (((size_t)bh * 32 * 16 + lq) * 256 + 32 * w + l15) * 8;
        const bf16* vp = RVT + (((size_t)bh * 32 * 16 + (F.tid >> 5)) * 512 + 32 * j + (F.tid & 31)) * 8;
        constexpr size_t QC = 32 * 128 * 8, QK = 4 * 128 * 8, KC = 16 * 256 * 8, KK = 4 * 256 * 8, VC = 16 * 512 * 8;
        bf16x8 QA[8], PA[4], KA[2][4], vpre;
        LAS unsigned char* vl = F.lds + 2 * SBUF + 1024 + 8 * 1024;
#pragma unroll
        for (int ks = 0; ks < 8; ++ks) QA[ks] = *(const bf16x8*)(qp + QK * ks);
#pragma unroll
        for (int ks = 0; ks < 4; ++ks) { PA[ks] = (bf16x8){0, 0, 0, 0, 0, 0, 0, 0}; if (ks < nkp) PA[ks] = *(const bf16x8*)(pp + QK * ks); }
#pragma unroll
        for (int mb = 0; mb < 2; ++mb)
#pragma unroll
            for (int ks = 0; ks < 4; ++ks) KA[mb][ks] = *(const bf16x8*)(kp + mb * 128 + KK * ks);
        vpre = *(const bf16x8*)vp;
        *(LAS bf16x8*)(vl + F.tid * 16) = vpre;
#pragma unroll 1
        for (int c = 0; c < 32; ++c) {
            const int cur = c & 1, cn = c < 31 ? c + 1 : 31; const size_t tok0 = (size_t)b * SEQ + c * 128;
            __syncthreads();
            vpre = *(const bf16x8*)(vp + VC * cn);
            bf16x8 VB[2][4];
#pragma unroll
            for (int nb = 0; nb < 2; ++nb)
#pragma unroll
                for (int ks = 0; ks < 4; ++ks) VB[nb][ks] = *(const LAS bf16x8*)(vl + cur * 8192 + ((4 * ks + lq) * 32 + 16 * nb + l15) * 16);
            f32x4 oc[2] = {(f32x4){0.f, 0.f, 0.f, 0.f}, (f32x4){0.f, 0.f, 0.f, 0.f}};
#pragma unroll
            for (int ks = 0; ks < 8; ++ks)
#pragma unroll
                for (int nb = 0; nb < 2; ++nb) { const bf16x8 bq = *(const LAS bf16x8*)(F.lds + cur * SBUF + (16 * nb + l15) * SROW + (32 * ks + 8 * lq) * 2);
                    oc[nb] = __builtin_amdgcn_mfma_f32_16x16x32_bf16(QA[ks], bq, oc[nb], 0, 0, 0); }
#pragma unroll
            for (int ks = 0; ks < 8; ++ks) QA[ks] = *(const bf16x8*)(qp + QC * cn + QK * ks);
#pragma unroll
            for (int nb = 0; nb < 2; ++nb)
#pragma unroll
                for (int i = 0; i < 4; ++i) oc[nb][i] *= qd[i];
#pragma unroll
            for (int ks = 0; ks < 4; ++ks)
                if (ks < nkp) {
#pragma unroll
                    for (int nb = 0; nb < 2; ++nb) oc[nb] = __builtin_amdgcn_mfma_f32_16x16x32_bf16(PA[ks], VB[nb][ks], oc[nb], 0, 0, 0); }
#pragma unroll
            for (int ks = 0; ks < 4; ++ks) if (ks < nkp) PA[ks] = *(const bf16x8*)(pp + QC * cn + QK * ks);
#pragma unroll
            for (int mb = 0; mb < 2; ++mb)
#pragma unroll
                for (int nb = 0; nb < 2; ++nb) { S[mb][nb] *= gC;
#pragma unroll
                    for (int ks = 0; ks < 4; ++ks) S[mb][nb] = __builtin_amdgcn_mfma_f32_16x16x32_bf16(KA[mb][ks], VB[nb][ks], S[mb][nb], 0, 0, 0); }
#pragma unroll
            for (int mb = 0; mb < 2; ++mb)
#pragma unroll
                for (int ks = 0; ks < 4; ++ks) KA[mb][ks] = *(const bf16x8*)(kp + mb * 128 + KC * cn + KK * ks);
#pragma unroll
            for (int i = 0; i < 4; ++i) { float q = 0.f;
#pragma unroll
                for (int nb = 0; nb < 2; ++nb) { const float v = oc[nb][i]; q += v * v; *(LAS unsigned short*)(ost + ((4 * lq + i) * 32 + 16 * nb + l15) * 2) = (unsigned short)f2bf(v); }
                q += __shfl_xor(q, 1); q += __shfl_xor(q, 2); q += __shfl_xor(q, 4); q += __shfl_xor(q, 8);
                if (l15 == 0) ssqp[((tok0 + 16 * w + 4 * lq + i) * 4 + h) * 16 + j] = q; }
            LDS_WAIT();
            { const v4u ov = *(const LAS v4u*)(ost + lane * 16); *(v4u*)(RO + (tok0 + 16 * w + (lane >> 2)) * 2048 + h * 512 + 32 * j + (lane & 3) * 8) = ov; }
            *(LAS bf16x8*)(vl + (cur ^ 1) * 8192 + F.tid * 16) = vpre;
#pragma unroll
            for (int mb = 0; mb < 2; ++mb)
#pragma unroll
                for (int nb = 0; nb < 2; ++nb) *(LAS u32x2*)(F.lds + (cur ^ 1) * SBUF + (16 * nb + l15) * SROW + (32 * w + 16 * mb + 4 * lq) * 2) = (u32x2){cvtpk(S[mb][nb][0], S[mb][nb][1]), cvtpk(S[mb][nb][2], S[mb][nb][3])};
        }
    }
    __syncthreads();
}

namespace attn2 {
typedef float f32x16 __attribute__((ext_vector_type(16)));
typedef short s16x4 __attribute__((ext_vector_type(4)));
constexpr int NW = 8, QBLK = 32, KVBLK = 64, QB = NW * QBLK;
constexpr int QS = 1536, KS = 1536, VS = 1024, OS = 1024;
constexpr int SHM_V = KVBLK * 128 * 2, SHM_K = KVBLK * 512;
constexpr int OFF_V = 0, OFF_K = 2 * SHM_V, OFF_WS = OFF_K + 2 * SHM_K, OFF_QR = OFF_WS + NW * 64 * 4, LDS_NEED = OFF_QR + NW * 4096;
constexpr float THR2 = 8.0f * 1.4426950408889634f;
#define A2_SBAR() __builtin_amdgcn_sched_barrier(0)
__device__ __forceinline__ int v_st(int k, int c) { const int kk = (k & ~0xC) | ((k & 4) << 1) | ((k & 8) >> 1); return ((kk >> 3) * 4 + (c >> 5)) * 512 + ((kk & 7) * 32 + (c & 31)) * 2; }
__device__ __forceinline__ int v_rd_base(int lane) { return ((lane & 3) << 3) | (((lane >> 2) & 3) << 6) | (((lane >> 4) & 1) << 5) | (((lane >> 5) & 1) << 8); }
constexpr int v_rd_off(int d0, int ks, int half) { return d0 * 512 + ks * 4096 + half * 2048; }
__device__ __forceinline__ int crow(int r, int hi) { return (r & 3) + 8 * (r >> 2) + 4 * hi; }
typedef __bf16 bf16x2a_t __attribute__((ext_vector_type(2)));
__device__ __forceinline__ unsigned cvtpk(float lo, float hi) { f32x2 v = {lo, hi}; bf16x2a_t b = __builtin_convertvector(v, bf16x2a_t); return __builtin_bit_cast(unsigned, b); }
__device__ __forceinline__ bf16x8 load8(const bf16* p) { return *reinterpret_cast<const bf16x8*>(p); }
__device__ __forceinline__ void mask_tile(f32x16& p0, f32x16& p1, int dq) {
    const float NEG = -__builtin_inff();
#pragma unroll
    for (int r = 0; r < 16; ++r) { const int c = (r & 3) + 8 * (r >> 2); if (dq - c < 0) p0[r] = NEG; if (dq - c - 32 < 0) p1[r] = NEG; }
}
__device__ __forceinline__ void partialSM(f32x16& p0, f32x16& p1, float& m_reg, float& mn, float& alpha) {
    float pmax = p0[0];
#pragma unroll
    for (int r = 1; r < 16; ++r) pmax = fmaxf(pmax, p0[r]);
#pragma unroll
    for (int r = 0; r < 16; ++r) pmax = fmaxf(pmax, p1[r]);
    { auto rr = __builtin_amdgcn_permlane32_swap(__float_as_uint(pmax), __float_as_uint(pmax), false, false); pmax = fmaxf(__uint_as_float(rr[0]), __uint_as_float(rr[1])); }
    if (__builtin_expect(__all((pmax - m_reg) <= THR2), 1)) { mn = m_reg; alpha = 1.f; }
    else { mn = fmaxf(m_reg, pmax); alpha = __builtin_amdgcn_exp2f(m_reg - mn); m_reg = mn; }
#pragma unroll
    for (int r = 0; r < 16; ++r) { p0[r] -= mn; p1[r] -= mn; }
#pragma unroll
    for (int r = 0; r < 16; ++r) p0[r] = __builtin_amdgcn_exp2f(p0[r]);
}
__device__ __forceinline__ void finishSM(f32x16& p0, f32x16& p1, float alpha, float& l_reg, bf16x8& pa0, bf16x8& pa1, bf16x8& pa2, bf16x8& pa3) {
#pragma unroll
    for (int r = 0; r < 16; ++r) p1[r] = __builtin_amdgcn_exp2f(p1[r]);
    float ps = 0;
#pragma unroll
    for (int r = 0; r < 16; ++r) ps += p0[r];
#pragma unroll
    for (int r = 0; r < 16; ++r) ps += p1[r];
    { auto rr = __builtin_amdgcn_permlane32_swap(__float_as_uint(ps), __float_as_uint(ps), false, false); ps = __uint_as_float(rr[0]) + __uint_as_float(rr[1]); }
    l_reg = l_reg * alpha + ps;
#define A2_PK4(P, B_, OUT) do { unsigned a0 = cvtpk(P[B_+0], P[B_+1]), a1 = cvtpk(P[B_+2], P[B_+3]); unsigned b0 = cvtpk(P[B_+4], P[B_+5]), b1 = cvtpk(P[B_+6], P[B_+7]); \
        auto r0 = __builtin_amdgcn_permlane32_swap(a0, b0, false, false); auto r1 = __builtin_amdgcn_permlane32_swap(a1, b1, false, false); \
        v4u w = {r0[0], r1[0], r0[1], r1[1]}; OUT = __builtin_bit_cast(bf16x8, w); } while (0)
    A2_PK4(p0, 0, pa0); A2_PK4(p0, 8, pa1); A2_PK4(p1, 0, pa2); A2_PK4(p1, 8, pa3);
#undef A2_PK4
}
template <int KB>
__device__ __forceinline__ void qkt(f32x16& p0, f32x16& p1, const char* K_lds, const char* qr_lds, int r32, int hi, const bf16x8* qr) {
    p0 = f32x16{}; p1 = f32x16{};
    const char* kbase = K_lds + KB * SHM_K + r32 * 512; const int x = r32 & 15;
#pragma unroll
    for (int d = 0; d < 12; ++d) { const char* a = kbase + ((((2 * d + hi) & 15) ^ x) << 4) + (d >= 8 ? 256 : 0);
        const bf16x8 b0 = *reinterpret_cast<const bf16x8*>(a), b1 = *reinterpret_cast<const bf16x8*>(a + 32 * 512);
        const bf16x8 q = d < 8 ? qr[d < 8 ? d : 0] : *reinterpret_cast<const bf16x8*>(qr_lds + (((d - 8) * 2 + hi) * 32 + r32) * 16);
        p0 = __builtin_amdgcn_mfma_f32_32x32x16_bf16(b0, q, p0, 0, 0, 0);
        p1 = __builtin_amdgcn_mfma_f32_32x32x16_bf16(b1, q, p1, 0, 0, 0); }
}
template <int VB>
__device__ __forceinline__ void pv_tile(f32x16* o, int vb0, bf16x8 pa0, bf16x8 pa1, bf16x8 pa2, bf16x8 pa3) {
#define A2_TRRD(dst, off) asm volatile("ds_read_b64_tr_b16 %0, %1 offset:%2" : "=&v"(dst) : "v"(vb0), "i"(off) : "memory")
#define A2_PV_D0(d0) do { s16x4 l0, l1, l2, l3, h0, h1, h2, h3; constexpr int b_ = VB * SHM_V + v_rd_off(d0, 0, 0); \
        A2_TRRD(l0, b_); A2_TRRD(h0, b_ + 2048); A2_TRRD(l1, b_ + 4096); A2_TRRD(h1, b_ + 6144); A2_TRRD(l2, b_ + 8192); A2_TRRD(h2, b_ + 10240); A2_TRRD(l3, b_ + 12288); A2_TRRD(h3, b_ + 14336); \
        asm volatile("s_waitcnt lgkmcnt(0)" ::: "memory"); A2_SBAR(); \
        o[d0] = __builtin_amdgcn_mfma_f32_32x32x16_bf16(pa0, (bf16x8){l0[0], l0[1], l0[2], l0[3], h0[0], h0[1], h0[2], h0[3]}, o[d0], 0, 0, 0); \
        o[d0] = __builtin_amdgcn_mfma_f32_32x32x16_bf16(pa1, (bf16x8){l1[0], l1[1], l1[2], l1[3], h1[0], h1[1], h1[2], h1[3]}, o[d0], 0, 0, 0); \
        o[d0] = __builtin_amdgcn_mfma_f32_32x32x16_bf16(pa2, (bf16x8){l2[0], l2[1], l2[2], l2[3], h2[0], h2[1], h2[2], h2[3]}, o[d0], 0, 0, 0); \
        o[d0] = __builtin_amdgcn_mfma_f32_32x32x16_bf16(pa3, (bf16x8){l3[0], l3[1], l3[2], l3[3], h3[0], h3[1], h3[2], h3[3]}, o[d0], 0, 0, 0); } while (0)
    A2_PV_D0(0); A2_PV_D0(1); A2_PV_D0(2); A2_PV_D0(3);
#undef A2_PV_D0
#undef A2_TRRD
}
struct BlockRef { const bf16* Q; const bf16* K; const bf16* V; bf16* O; int P0; };
struct Seam { bf16x8 qr[8]; bf16x8 st_v0, st_v1, st_k0, st_k1, st_k2; };
#define A2_VMW() asm volatile("s_waitcnt vmcnt(0)" ::: "memory")
#define A2_VMWN(n) asm volatile("s_waitcnt vmcnt(%0)" :: "i"(n) : "memory")
#define A2_SLOAD(Kp, Vp, k0) do { S.st_v0 = load8((Vp) + (size_t)((k0) + sr) * VS + sc); S.st_v1 = load8((Vp) + (size_t)((k0) + 32 + sr) * VS + sc); \
        const bf16* kp_ = (Kp) + (size_t)((k0) + krow) * KS + kc * 8; S.st_k0 = load8(kp_); S.st_k1 = load8(kp_ + 64); S.st_k2 = load8(kp_ + 128); } while (0)
#define A2_SWRITE_K(bf) do { *(bf16x8*)(K_lds + (bf) * SHM_K + kw0) = S.st_k0; *(bf16x8*)(K_lds + (bf) * SHM_K + kw1) = S.st_k1; *(bf16x8*)(K_lds + (bf) * SHM_K + kw0 + 256) = S.st_k2; } while (0)
#define A2_SWRITE_V(bf) do { *(bf16x8*)(V_lds + (bf) * SHM_V + vst0) = S.st_v0; *(bf16x8*)(V_lds + (bf) * SHM_V + vst1) = S.st_v1; } while (0)
#define A2_SWRITE(bf) do { A2_SWRITE_V(bf); A2_SWRITE_K(bf); } while (0)
#define A2_IDX int tid = threadIdx.x; asm volatile("" : "+v"(tid)); const int wid = __builtin_amdgcn_readfirstlane(tid >> 6), lane = tid & 63, r32 = lane & 31, hi = lane >> 5; \
    const int sr = tid >> 4, sc = (tid & 15) * 8, krow = tid >> 3, kc = tid & 7, kw0 = krow * 512 + ((kc ^ (krow & 15)) << 4), kw1 = krow * 512 + (((kc + 8) ^ (krow & 15)) << 4); \
    char* V_lds = lds + OFF_V; char* K_lds = lds + OFF_K; (void)lane; (void)r32; (void)hi; (void)sr; (void)sc; (void)V_lds
__device__ __forceinline__ void attn_prime(const BlockRef& cur, char* lds, Seam& S) {
    A2_IDX;
#pragma unroll
    for (int d0 = 0; d0 < 8; ++d0) S.qr[d0] = load8(cur.Q + (size_t)(wid * QBLK + r32) * QS + d0 * 16 + hi * 8);
    A2_SLOAD(cur.K, cur.V, 0); A2_VMW(); A2_SWRITE_K(0);
}
__device__ __forceinline__ void attn_block(const BlockRef& cur, const BlockRef& nxt, char* lds, Seam& S) {
    A2_IDX;
    const int NT = (cur.P0 + QB) / KVBLK;
    const int qlo = cur.P0 + wid * QBLK, qm = qlo + r32 - 4 * hi;
    float* ws = (float*)(lds + OFF_WS) + wid * 64; float* li_l = ws, * al_l = ws + 32;
    char* qr_lds = lds + OFF_QR + wid * 4096;
    float m_reg = -1e30f, l_reg = 0; f32x16 o[4] = {};
    const int vst0 = v_st(sr, sc), vst1 = v_st(32 + sr, sc);
    const int vb0 = (int)(uintptr_t)V_lds + v_rd_base(lane);
    const bf16* Kh = cur.K; const bf16* Vh = cur.V;
    { bf16x8 t4[4];
#pragma unroll
      for (int d = 0; d < 4; ++d) t4[d] = load8(cur.Q + (size_t)(wid * QBLK + r32) * QS + 128 + d * 16 + hi * 8);
#pragma unroll
      for (int d = 0; d < 4; ++d) *(bf16x8*)(qr_lds + ((d * 2 + hi) * 32 + r32) * 16) = t4[d]; }
    A2_SWRITE_V(0);
    __syncthreads();
    f32x16 p0, p1; float mn, al; bf16x8 pa0, pa1, pa2, pa3;
#define A2_STEP(t, BUF) do { const bool lastt = (t) + 1 >= NT; \
        A2_SBAR(); { const bf16* Kn = lastt ? nxt.K : Kh; const bf16* Vn = lastt ? nxt.V : Vh; const int k0n = lastt ? 0 : ((t) + 1) * KVBLK; A2_SLOAD(Kn, Vn, k0n); } A2_SBAR(); \
        qkt<BUF>(p0, p1, K_lds, qr_lds, r32, hi, S.qr); \
        if (lastt) { A2_SBAR(); _Pragma("unroll") for (int d0 = 0; d0 < 8; ++d0) S.qr[d0] = load8(nxt.Q + (size_t)(wid * QBLK + r32) * QS + d0 * 16 + hi * 8); A2_SBAR(); } \
        { const int kb_ = (t) * KVBLK; if (kb_ + KVBLK - 1 > qlo) mask_tile(p0, p1, qm - kb_); } \
        partialSM(p0, p1, m_reg, mn, al); finishSM(p0, p1, al, l_reg, pa0, pa1, pa2, pa3); \
        if (__any(al < 1.f)) { if (hi == 0) al_l[r32] = al; asm volatile("s_waitcnt lgkmcnt(0)" ::: "memory"); \
            for (int d_ = 0; d_ < 4; ++d_) for (int r = 0; r < 16; ++r) o[d_][r] *= al_l[crow(r, hi)]; } \
        A2_SBAR(); pv_tile<BUF>(o, vb0, pa0, pa1, pa2, pa3); A2_SBAR(); \
        if (lastt) { A2_VMWN(8); A2_SWRITE_K(0); } else { A2_VMW(); A2_SWRITE((BUF) ^ 1); } \
        __syncthreads(); } while (0)
    for (int t = 0; t < NT; t += 2) { A2_STEP(t, 0); A2_STEP(t + 1, 1); }
#undef A2_STEP
    if (hi == 0) li_l[r32] = l_reg; asm volatile("s_waitcnt lgkmcnt(0)" ::: "memory");
    float rli[16];
#pragma unroll
    for (int r = 0; r < 16; ++r) rli[r] = __builtin_amdgcn_rcpf(li_l[crow(r, hi)]);
    bf16* Ow = cur.O + (size_t)(wid * QBLK) * OS;
#pragma unroll
    for (int r = 0; r < 16; ++r) { const int orow = crow(r, hi);
#pragma unroll
        for (int d0 = 0; d0 < 4; ++d0) { const float v = o[d0][r] * rli[r]; const float vn = __shfl_xor(v, 1);
            if ((r32 & 1) == 0) *(unsigned*)(Ow + (size_t)orow * OS + d0 * 32 + r32) = cvtpk(v, vn); } }
    asm volatile("s_waitcnt lgkmcnt(0)" ::: "memory");
}
}
__device__ __forceinline__ attn2::BlockRef attn2_ref(unsigned char* ws, int v, int pass) {
    const int bh = v >> 3, b = bh >> 3, h = bh & 7, x = v & 7, qb = pass ? 15 - x : x;
    attn2::BlockRef r;
    r.Q = (const bf16*)(ws + WS_QP) + ((size_t)b * SEQ + qb * 256) * 1536 + h * 192; r.K = (const bf16*)(ws + WS_KF) + (size_t)b * SEQ * 1536 + h * 192;
    r.V = (const bf16*)(ws + WS_VV) + (size_t)b * SEQ * 1024 + h * 128; r.O = (bf16*)(ws + WS_MO) + ((size_t)b * SEQ + qb * 256) * 1024 + h * 128; r.P0 = qb * 256;
    return r;
}
__device__ __forceinline__ void phase_attn2(Frame& F, char* lds) {
    int L = F.vcu; if (L >= 256) return;
    attn2::Seam S; int pass = 0;
    attn2::BlockRef cur = attn2_ref(F.ws, L, 0);
    attn2::attn_prime(cur, lds, S);
    for (;;) {
        const bool more_pass = pass == 0, more_item = L + F.G < 256, last = !more_pass && !more_item;
        int passn = pass + 1, Ln = L;
        if (!more_pass) { passn = 0; Ln = more_item ? L + F.G : L; }
        const attn2::BlockRef nxt = last ? cur : attn2_ref(F.ws, Ln, passn);
        attn2::attn_block(cur, nxt, lds, S);
        if (last) break;
        cur = nxt; pass = passn; L = Ln;
    }
}

static_assert(pg8::EpiInProj::O_RSTDX == WS_SMALL + SM_RSTDX && pg8::EpiInProj::O_SSQ_LAT == WS_SMALL + SM_SSQ_CQ && pg8::EpiInProj::O_SSQ_KR == WS_SMALL + SM_SSQ_KR && pg8::EpiInProj::O_CS == WS_CS && pg8::EpiInProj::O_CSM == WS_CSM && pg8::EpiInProj::O_RQ == WS_RQ && pg8::EpiInProj::O_RK == WS_RK && pg8::EpiInProj::O_RKDT == WS_RKDT && pg8::EpiInProj::O_RVT == WS_RVT && pg8::EpiInProj::O_LAT == WS_LAT && pg8::EpiInProj::O_KR == WS_KR, "EpiInProj offsets");
static_assert(pg8::EpiKVup::O_KF == WS_KF && pg8::EpiKVup::O_VV == WS_VV && pg8::EpiKVup::O_KR == WS_KR && pg8::EpiKVup::O_SSQ_CKV == WS_SMALL + SM_SSQ_CKV && pg8::EpiKVup::O_SSQ_KR == WS_SMALL + SM_SSQ_KR, "EpiKVup offsets");
#ifndef MK_N_LAUNCHES
#define MK_N_LAUNCHES 12
#endif
constexpr int N_PHASES = 12;
constexpr int N_LAUNCHES = MK_N_LAUNCHES;
struct Args { const float* in[21]; float* out; unsigned char* ws; int ph_lo, ph_hi; };
#ifndef PG8_SP2
#define PG8_SP2 true
#endif
#define PG8_ALIGN true
template <class Epi> __device__ __forceinline__ void run_gemm(Frame& F, const pg8::bf16_t* A, int lda, const pg8::bf16_t* Bt, int ldb, int N, int K, const Epi& E, int c = -1, size_t gsA = 0) {
    __syncthreads();
    pg8::Gemm g{A, Bt, MTOK, N, K, lda, ldb, gsA}; pg8::StaticOrder S; S.init(MTOK, N, F.G, c < 0 ? (int)blockIdx.x : c);
    pg8::gemm_phase<Epi, pg8::StaticOrder, PG8_ALIGN, PG8_SP2>(F.lds + RING_OFF, g, S, E);
}
__global__ void __launch_bounds__(NWAVES * 64, 2) mk_fwd(Args args) {
    extern __shared__ __attribute__((aligned(16))) unsigned char lds[];
    Frame F;
    F.lds = (LAS unsigned char*)lds; F.MISC = (volatile LAS unsigned*)(F.lds + MISC_OFF);
    F.tid = threadIdx.x; F.lane = F.tid & 63; F.wave = __builtin_amdgcn_readfirstlane(F.tid >> 6);
    F.G = gridDim.x; { const int bx = blockIdx.x; F.vcu = (F.G % 8 == 0) ? (bx % 8) * (F.G / 8) + bx / 8 : bx; }
    F.out = args.out; F.ws = args.ws;
    unsigned char* ws = args.ws;
    if (F.tid < 32) F.MISC[F.tid] = 0u;
    __syncthreads();
    if (N_LAUNCHES == 1) (void)xcd_barrier_post((unsigned*)(ws + WS_CTL) + CW_BAR, F.MISC + 8);
    const int lo = args.ph_lo, hi = args.ph_hi;
    int ctile = (int)blockIdx.x;
    bool xlocal = false;
#ifndef PH_MASK
#define PH_MASK 0xfff
#endif
#define IN(k) (((PH_MASK >> (k)) & 1) && lo <= (k) && (k) < hi)
#define BAR_NOW() XcdBarrier bar_; bar_.bar = (unsigned*)(args.ws + WS_CTL) + CW_BAR; bar_.x = xb_xcc_id(); bar_.st = (volatile LAS unsigned*)((LAS unsigned char*)lds + MISC_OFF) + 8
#define SEAM(k) do { asm volatile("; SEAM_MARK %0" :: "i"(k)); if (IN(k) && IN((k) + 1)) { BAR_NOW(); xcd_barrier(bar_); } } while (0)
#define SEAM_L(k) do { if (IN(k) && IN((k) + 1)) { BAR_NOW(); if (xlocal) xcd_local_barrier(bar_); else xcd_barrier(bar_); } } while (0)
#ifdef SUBSTRETCH
#define SUB_T0(n) const unsigned long long ts0_##n = __builtin_amdgcn_s_memrealtime()
#define SUB_ST(n) do { if (SUBSTRETCH == (n)) { const unsigned long long t1_ = __builtin_amdgcn_s_memrealtime(); const unsigned long long d_ = t1_ - ts0_##n; while (__builtin_amdgcn_s_memrealtime() - t1_ < d_) __builtin_amdgcn_s_sleep(8); } } while (0)
#else
#define SUB_T0(n) do {} while (0)
#define SUB_ST(n) do {} while (0)
#endif
#define PH_IDX() do { int t_ = threadIdx.x; asm volatile("" : "+v"(t_)); F.tid = t_; F.lane = t_ & 63; F.wave = __builtin_amdgcn_readfirstlane(t_ >> 6); } while (0)
#ifdef STRETCH_MASK
#define PH_T0() PH_IDX(); const unsigned long long t0_ = __builtin_amdgcn_s_memrealtime()
#define PH_STRETCH(k) do { if ((STRETCH_MASK >> (k)) & 1) { const unsigned long long t1_ = __builtin_amdgcn_s_memrealtime(); const unsigned long long d_ = (t1_ - t0_) * STRETCH_MULT; while (__builtin_amdgcn_s_memrealtime() - t1_ < d_) __builtin_amdgcn_s_sleep(8); } } while (0)
#else
#define PH_T0() PH_IDX()
#define PH_STRETCH(k) do {} while (0)
#endif
    float* sm = (float*)(ws + WS_SMALL);
    const float* rstdx = sm + SM_RSTDX / 4; float* ssq_cq = sm + SM_SSQ_CQ / 4; float* ssq_ckv = sm + SM_SSQ_CKV / 4; float* ssq1 = sm + SM_SSQ1 / 4; float* ssq2 = sm + SM_SSQ2 / 4;
    typedef pg8::bf16_t b16;
    b16* WinT = (b16*)(ws + WS_WIN); b16* XB = (b16*)(ws + WS_XB); b16* LATb = (b16*)(ws + WS_LAT); b16* ROb = (b16*)args.out;

    if (IN(0)) { PH_T0(); phase_p0(F, args.in[0], (const int*)args.in[2], args.in[3], args.in[4], args.in[6], args.in[7], args.in[8], args.in[9]); PH_STRETCH(0); } SEAM(0);
    if (IN(1)) { PH_T0();
        pg8::EpiInProj E{ws, args.in[11], (PG8_LAS unsigned char*)(F.lds + XS_OFF)};
        run_gemm(F, XB, 1024, WinT + (size_t)4096 * 1024, 1024, NIN1, 1024, E);
    PH_STRETCH(1); } SEAM(1);
    if (IN(2)) { PH_T0(); phase_r0p(F);
    PH_STRETCH(2); } SEAM(2);
    if (IN(3)) { PH_T0(); phase_r1p(F); PH_STRETCH(3); } SEAM(3);
    if (IN(4)) { PH_T0();
        SUB_T0(1); { pg8::EpiRetGate E{ROb, rstdx, (const float*)(ws + WS_SSQP), args.in[5]}; run_gemm(F, XB, 1024, WinT + (size_t)2048 * 1024, 1024, 2048, 1024, E); } SUB_ST(1);
        asm volatile("; SEAM_MARK 41");
        SUB_T0(2); { pg8::EpiQup E{(b16*)(ws + WS_QP), ssq_cq, args.in[10], (const void*)(ws + WS_CSM), (PG8_LAS float*)(F.lds + XS_OFF), C2Q}; run_gemm(F, LATb, LATW, (const b16*)(ws + WS_WUQ), 384, 2048, 384, E);
#ifdef QUP_TWICE
          run_gemm(F, LATb, LATW, (const b16*)(ws + WS_WUQ), 384, 2048, 384, E);
#endif
        } SUB_ST(2);
        asm volatile("; SEAM_MARK 42");
        SUB_T0(3); { pg8::EpiKVup E{ws, args.in[11], (PG8_LAS float*)(F.lds + XS_OFF)}; run_gemm(F, LATb + 384, LATW, (const b16*)(ws + WS_WUKV), 256, 2048, 256, E);
#ifdef KVUP_TWICE
          run_gemm(F, LATb + 384, LATW, (const b16*)(ws + WS_WUKV), 256, 2048, 256, E);
#endif
        } SUB_ST(3);
    PH_STRETCH(4); } SEAM(4);
    if (IN(5)) { PH_T0(); phase_attn2(F, (char*)lds); PH_STRETCH(5); } SEAM(5);
    if (IN(6)) { PH_T0();
        phase_late_weights(F, args.in[1], args.in[12], args.in[13], args.in[14], args.in[15], args.in[16], args.in[17], args.in[18], args.in[19], args.in[20]);
        { pg8::EpiRowAct<1> E{(b16*)(ws + WS_SG), 2048, rstdx, 0.f, (unsigned)(WS_BLK / 2)}; run_gemm(F, XB, 1024, WinT, 1024, 2048, 1024, E); }
    PH_STRETCH(6); } SEAM(6);
#ifndef NO_XLOCAL
    if (N_LAUNCHES == 1 && IN(7)) {
        if (F.tid == 0) { unsigned ok = (F.G == 256) ? 1u : 0u;
            for (unsigned j = 0; j < 16; ++j) { const unsigned c = xb_ld((unsigned*)(args.ws + WS_CTL) + CW_BAR + XB_XCNT(j)); ok &= (j < 8 ? (c == 32u) : (c == 0u)) ? 1u : 0u; }
            F.MISC[12] = ok; }
        __syncthreads();
        xlocal = F.MISC[12] != 0u; if (xlocal) ctile = (int)(F.MISC[10] * 8u + xb_xcc_id());
    }
#endif
    if (IN(7)) { PH_T0();
        { pg8::EpiGateMix<0> E{(b16*)(ws + WS_TM), (const b16*)(ws + WS_SG), 0}; run_gemm(F, ROb, 2048, (const b16*)(ws + WS_WBR), 2048, 1024, 2048, E, ctile); }
        VM_WAIT(); __syncthreads(); __builtin_amdgcn_fence(__ATOMIC_ACQUIRE, "agent"); VM_WAIT(); __syncthreads();
        { pg8::EpiGateMix<1> E{(b16*)(ws + WS_TM), (const b16*)(ws + WS_SG), 1024}; run_gemm(F, (const b16*)(ws + WS_MO), 1024, (const b16*)(ws + WS_WBM), 1024, 1024, 1024, E, ctile); }
    PH_STRETCH(7); } SEAM_L(7);
    if (IN(8)) { PH_T0(); pg8::EpiResid<false> E{(const void*)args.in[0], XB, ssq1}; run_gemm(F, (const b16*)(ws + WS_TM), 1024, (const b16*)(ws + WS_WO), 1024, 1024, 1024, E, ctile, WS_BLK); PH_STRETCH(8); } SEAM_L(8);
    if (IN(9)) { PH_T0(); pg8::EpiRowAct<2> E{(b16*)(ws + WS_H), 4096, ssq1, 1.0f / 1024.0f, 0u}; run_gemm(F, XB, 1024, (const b16*)(ws + WS_WUP), 1024, 4096, 1024, E, ctile); PH_STRETCH(9); } SEAM_L(9);
    if (IN(10)) { PH_T0(); pg8::EpiResid<true> E{(const void*)XB, XB, ssq2}; run_gemm(F, (const b16*)(ws + WS_H), 4096, (const b16*)(ws + WS_WDOWN), 4096, 1024, 4096, E, ctile); PH_STRETCH(10); } SEAM_L(10);
    if (IN(11)) { PH_T0();
        { pg8::EpiRowAct<1> E{(b16*)(ws + WS_GT), 1024, ssq2, 1.0f / 1024.0f, 0u}; run_gemm(F, XB, 1024, (const b16*)(ws + WS_WPG), 1024, 1024, 1024, E, ctile); }
        VM_WAIT(); __syncthreads(); __builtin_amdgcn_fence(__ATOMIC_ACQUIRE, "agent"); VM_WAIT(); __syncthreads();
        { pg8::EpiFinal E{args.out, (const b16*)(ws + WS_GT), XB}; run_gemm(F, (const b16*)(ws + WS_PB), 256, (const b16*)(ws + WS_WPLE), 256, 1024, 256, E, ctile); }
    PH_STRETCH(11); }
#undef IN
#undef SEAM
}


#ifdef DUMPK
struct DumpArgs { const unsigned* reg[6]; unsigned nw[6]; unsigned* out; int own; int pad; };
__global__ void dump_hash(DumpArgs d) {
    for (unsigned i = blockIdx.x * blockDim.x + threadIdx.x; i < (unsigned)MTOK * DM; i += gridDim.x * blockDim.x) {
        float s = 0.f;
        if (d.own) { const unsigned w = d.out[i]; s += __uint_as_float(w << 16) + __uint_as_float(w & 0xffff0000u); }
        for (int r = 0; r < 6; ++r) if (d.reg[r] && i < d.nw[r] * 2u) { const unsigned short v = ((const unsigned short*)d.reg[r])[i]; s += __uint_as_float((unsigned)v << 16); }
        ((float*)d.out)[i] = s;
    }
}
#endif
extern "C" void kernel_launch(void* const* d_in, const int* in_sizes, int n_in, void* d_out, int out_size, void* d_ws, size_t ws_size, hipStream_t stream) {
    static int grid = 0;
    if (grid == 0) {
        if (n_in != 21 || in_sizes[0] != MTOK * DM || out_size != MTOK * DM || ws_size < WS_END) { fprintf(stderr, "kernel_launch: unexpected shapes (n_in %d in0 %d out %d ws %zu)\n", n_in, n_in > 0 ? in_sizes[0] : -1, out_size, ws_size); grid = -1; return; }
        int dev = 0, cus = 0, per_cu = 0;
        if (hipGetDevice(&dev) != hipSuccess || hipDeviceGetAttribute(&cus, hipDeviceAttributeMultiprocessorCount, dev) != hipSuccess) { grid = -1; return; }
        if (hipFuncSetAttribute((const void*)mk_fwd, hipFuncAttributeMaxDynamicSharedMemorySize, LDS_BYTES) != hipSuccess) { fprintf(stderr, "kernel_launch: hipFuncSetAttribute failed\n"); grid = -1; return; }
        if (hipOccupancyMaxActiveBlocksPerMultiprocessor(&per_cu, (const void*)mk_fwd, NWAVES * 64, LDS_BYTES) != hipSuccess || per_cu < 1) { fprintf(stderr, "kernel_launch: occupancy query says %d workgroups per CU\n", per_cu); (void)hipGetLastError(); grid = -1; return; }
        grid = cus;
    }
    if (grid < 0) return;
    (void)hipMemsetAsync((char*)d_ws + WS_CTL, 0, CTL_ZERO_BYTES, stream);
    Args a{};
    for (int i = 0; i < 21; ++i) a.in[i] = (const float*)d_in[i];
    a.out = (float*)d_out; a.ws = (unsigned char*)d_ws;
    if (N_LAUNCHES == 1) { a.ph_lo = 0; a.ph_hi = N_PHASES; hipLaunchKernelGGL(mk_fwd, dim3(grid), dim3(NWAVES * 64), LDS_BYTES, stream, a); }
    else for (int ph = 0; ph < N_PHASES; ++ph) {
#ifdef DUMPK
        if (ph > DUMPK) break;
#endif
        a.ph_lo = ph; a.ph_hi = ph + 1; hipLaunchKernelGGL(mk_fwd, dim3(grid), dim3(NWAVES * 64), LDS_BYTES, stream, a); }
#ifdef DUMPK
    { DumpArgs d{}; d.out = (unsigned*)d_out; d.own = DUMP_OWN; const size_t offs[6] = DUMP_OFFS; const size_t len[6] = DUMP_LENS;
      for (int r = 0; r < 6; ++r) if (len[r]) { d.reg[r] = (const unsigned*)((const char*)d_ws + offs[r]); d.nw[r] = (unsigned)(len[r] / 4); }
      hipLaunchKernelGGL(dump_hash, dim3(2048), dim3(256), 0, stream, d); }
#endif
}
```

```cpp
#define MK_N_LAUNCHES 1
#include <hip/hip_runtime.h>
#include <hip/hip_bf16.h>
#include <cstdio>
#include <cstdint>
__device__ __forceinline__ int mk_lane() { int l; asm volatile("v_mbcnt_lo_u32_b32 %0, -1, 0\n\tv_mbcnt_hi_u32_b32 %0, -1, %0" : "=v"(l)); return l; }
namespace pg8 {
#define PG8_LAS __attribute__((address_space(3)))
typedef unsigned short bf16_t;
typedef short bf16x8 __attribute__((ext_vector_type(8)));
typedef float f32x4 __attribute__((ext_vector_type(4)));
typedef unsigned u32x4 __attribute__((ext_vector_type(4)));
constexpr int BM = 256, BK = 64, HALF = 128, HTB = HALF * BK * 2  , STAGE_BYTES = 8 * HTB, NXCD = 8, WGM = 8;

__host__ __device__ __forceinline__ int lds_byte(int r, int c) { const int st = (r >> 4) * 2 + (c >> 5), rr = r & 15, cc = c & 31, ob = rr * 64 + cc * 2; return st * 1024 + (ob ^ (((ob >> 9) & 1) << 5)); }
__host__ __device__ __forceinline__ void stage_rc(int b, int& R, int& C) { const int st = b / 1024, sb = b % 1024, swz = sb ^ (((sb >> 9) & 1) << 5); R = (st >> 1) * 16 + swz / 64; C = (st & 1) * 32 + (swz % 64) / 2; }
__host__ __device__ __forceinline__ int perm32(int rho) { const int n = rho >> 4, i = rho & 15; return 8 * (i >> 2) + 4 * n + (i & 3); }

struct Unit { int pm, pn; };
struct Gemm { const bf16_t* A; const bf16_t* Bt; int M, N, K, lda, ldb; size_t gsA; int wv; };

struct StaticOrder {
    int nM, nN, nwg, G, c;
    __host__ __device__ void init(int M, int N, int G_, int c_) { nM = M / BM; nN = N / BM; nwg = nM * nN; G = G_; c = c_; }
    __host__ __device__ bool next(int i, Unit& u) const {
        const long L = (long)i * G + c; if (L >= nwg) return false;
        int wgid = (int)L; { const int q = nwg / NXCD, r = nwg % NXCD, xcd = wgid % NXCD, off = wgid / NXCD; wgid = (xcd < r ? xcd * (q + 1) : r * (q + 1) + (xcd - r) * q) + off; }
        const int nig = WGM * nN, gid = wgid / nig, fm = gid * WGM, gsz = (nM - fm) < WGM ? (nM - fm) : WGM;
        u.pm = fm + ((wgid % nig) % gsz); u.pn = (wgid % nig) / gsz; return true;
    }
    __device__ __forceinline__ void a_ready(const Unit&) const {}
    __device__ __forceinline__ void done(const Unit&) const {}
};


typedef float f32x2 __attribute__((ext_vector_type(2)));
typedef unsigned u32x2 __attribute__((ext_vector_type(2)));
typedef __bf16 bf16x2_t __attribute__((ext_vector_type(2)));
__device__ __forceinline__ unsigned cvt_pk_bf16(float lo, float hi) { f32x2 v = {lo, hi}; bf16x2_t b = __builtin_convertvector(v, bf16x2_t); return __builtin_bit_cast(unsigned, b); }
__device__ __forceinline__ float bflo(unsigned w) { return __uint_as_float(w << 16); }
__device__ __forceinline__ float bfhi(unsigned w) { return __uint_as_float(w & 0xffff0000u); }
__device__ __forceinline__ u32x4 pack8(const float (&v)[8]) { u32x4 w; w.x = cvt_pk_bf16(v[0], v[1]); w.y = cvt_pk_bf16(v[2], v[3]); w.z = cvt_pk_bf16(v[4], v[5]); w.w = cvt_pk_bf16(v[6], v[7]); return w; }
__device__ __forceinline__ void unpack8(const u32x4 w, float (&v)[8]) { v[0] = bflo(w.x); v[1] = bfhi(w.x); v[2] = bflo(w.y); v[3] = bfhi(w.y); v[4] = bflo(w.z); v[5] = bfhi(w.z); v[6] = bflo(w.w); v[7] = bfhi(w.w); }
__device__ __forceinline__ float sigmoidf_(float x) { return __builtin_amdgcn_rcpf(1.0f + __builtin_amdgcn_exp2f(-1.4426950408889634f * x)); }
constexpr float RMS_EPS_ = 1e-6f;
typedef _Float16 h2x4_t __attribute__((ext_vector_type(8)));
__device__ __forceinline__ void rope8(const void* csm, unsigned row, unsigned i0, float (&c)[8], float (&s)[8]) {
    const h2x4_t* p = (const h2x4_t*)csm + (row * 8u + (i0 >> 2)); const h2x4_t a = p[0], b = p[1];
#pragma unroll
    for (int e = 0; e < 4; ++e) { c[e] = (float)a[2 * e]; s[e] = (float)a[2 * e + 1]; c[4 + e] = (float)b[2 * e]; s[4 + e] = (float)b[2 * e + 1]; }
}
__device__ __forceinline__ void st16(bf16_t* p, const u32x4 v) {
#ifdef ST_SC1
    asm volatile("global_store_dwordx4 %0, %1, off sc1\n\ts_nop 1" :: "v"(p), "v"(v) : "memory");
#else
    *(u32x4*)p = v;
#endif
}

#define EPI_ACC8(v, ai, bj, m) float v[8]; { const f32x4 a0_ = acc[ai][bj][m][0], a1_ = acc[ai][bj][m][1]; v[0] = a0_[0]; v[1] = a0_[1]; v[2] = a0_[2]; v[3] = a0_[3]; v[4] = a1_[0]; v[5] = a1_[1]; v[6] = a1_[2]; v[7] = a1_[3]; }

__device__ __forceinline__ void xpose_store(PG8_LAS unsigned char* st, const unsigned (&pk)[4][4], bf16_t* dst, int R, int lane, int fr, int fq) {
#pragma unroll
    for (int pass = 0; pass < 2; ++pass) {
        if ((fq >> 1) == pass) {
#pragma unroll
            for (int m = 0; m < 4; ++m)
#pragma unroll
                for (int q = 0; q < 4; ++q) { const unsigned w = pk[m][q]; const int c = (fq & 1) * 8 + 2 * q;
                    *(PG8_LAS unsigned short*)(st + c * 144 + (16 * m + fr) * 2) = (unsigned short)(w & 0xffffu);
                    *(PG8_LAS unsigned short*)(st + (c + 1) * 144 + (16 * m + fr) * 2) = (unsigned short)(w >> 16); }
        }
        asm volatile("s_waitcnt lgkmcnt(0)" ::: "memory");
#pragma unroll
        for (int k = 0; k < 2; ++k) { const int idx = lane + 64 * k, c = idx & 15, ch = idx >> 4;
            const u32x4 v = *(const PG8_LAS u32x4*)(st + c * 144 + ch * 16);
            *(u32x4*)(dst + ((size_t)ch * R + pass * 16 + c) * 8) = v; }
        asm volatile("s_waitcnt lgkmcnt(0)" ::: "memory");
    }
}

struct EpiInProj {
    static constexpr bool PERM = true, AFTER_DRAIN = false, TWICE_OK = false; static __device__ __forceinline__ bool twice(const Unit& u) { return u.pn < 16; }
    unsigned char* ws; const float* k_norm; PG8_LAS unsigned char* xs;
    static constexpr size_t O_RSTDX = (size_t)1 << 20, O_SSQ_LAT = ((size_t)1 << 20) + (64 << 10), O_SSQ_KR = ((size_t)1 << 20) + (320 << 10), O_CS = (size_t)57 << 20, O_CSM = (size_t)254 << 20,
        O_RQ = (size_t)94 << 20, O_RK = (size_t)126 << 20, O_RKDT = (size_t)158 << 20, O_RVT = (size_t)190 << 20, O_LAT = (size_t)73 << 20, O_KR = ((size_t)22 << 20) + (512 << 10);
    __device__ __forceinline__ void operator()(const f32x4 (&acc)[2][2][4][2], const Unit& u, int wr, int wc, int fr, int fq) const {
        const int pn = u.pn, lane = fq * 16 + fr, wid = wr * 4 + wc;
        const float* rstdx = (const float*)(ws + O_RSTDX); const f32x4* cs = (const f32x4*)(ws + O_CS); const void* csm = (const void*)(ws + O_CSM); float* ssq_lat = (float*)(ws + O_SSQ_LAT); float* ssq_kr = (float*)(ws + O_SSQ_KR);
        bf16_t* RQ = (bf16_t*)(ws + O_RQ); bf16_t* RK = (bf16_t*)(ws + O_RK); bf16_t* RKDT = (bf16_t*)(ws + O_RKDT); bf16_t* RVT = (bf16_t*)(ws + O_RVT); bf16_t* LAT = (bf16_t*)(ws + O_LAT); bf16_t* KR = (bf16_t*)(ws + O_KR);
        PG8_LAS unsigned char* st = xs + wid * 2304;
        const int rowt = u.pm * BM + wr * 64 + fr;
        const int bidx = (u.pm * BM) >> 12, s0 = (u.pm * BM) & 4095;
        if (pn < 8) {
            const bool isk = pn >= 4; const int head = pn & 3;
            const float lg2 = __builtin_amdgcn_logf(1.0f - __builtin_amdgcn_exp2f(-5.0f - (float)head));
            bf16_t* O = isk ? RK : RQ;
#pragma unroll
            for (int ai = 0; ai < 2; ++ai) {
                unsigned pk0[4][4], pk1[4][4];
#pragma unroll
                for (int m = 0; m < 4; ++m) {
                    const int row = rowt + ai * HALF + m * 16; const float rs = rstdx[row] * (isk ? 0.0625f : 1.0f);
                    const f32x4* cp = cs + ((unsigned)row * 64u + (unsigned)(wc * 16 + fq * 4));
                    const f32x4 c0 = cp[0], c1 = cp[1], c2 = cp[2], c3 = cp[3];
                    const float cc[8] = {c0[0], c0[2], c1[0], c1[2], c2[0], c2[2], c3[0], c3[2]}, ss[8] = {c0[1], c0[3], c1[1], c1[3], c2[1], c2[3], c3[1], c3[3]};
                    EPI_ACC8(x1, ai, 0, m); EPI_ACC8(x2, ai, 1, m);
                    float o1[8], o2[8];
#pragma unroll
                    for (int e = 0; e < 8; ++e) { const float a = x1[e] * rs, b = x2[e] * rs; o1[e] = a * cc[e] - b * ss[e]; o2[e] = b * cc[e] + a * ss[e]; }
                    bf16_t* rp = O + ((((size_t)(bidx * 4 + head) * 32 + (s0 >> 7) + ai) * 32 + wc * 4 + fq) * 128 + wr * 64 + m * 16 + fr) * 8;
                    *(u32x4*)rp = pack8(o1); *(u32x4*)(rp + (size_t)16 * 128 * 8) = pack8(o2);
                    if (isk) { const float kdm = __builtin_amdgcn_exp2f((float)(127 - (wr * 64 + m * 16 + fr)) * lg2);
#pragma unroll
                        for (int q = 0; q < 4; ++q) { pk0[m][q] = cvt_pk_bf16(o1[2 * q] * kdm, o1[2 * q + 1] * kdm); pk1[m][q] = cvt_pk_bf16(o2[2 * q] * kdm, o2[2 * q + 1] * kdm); }
                    }
                }
                if (isk) {
                    bf16_t* d0 = RKDT + ((((size_t)(bidx * 4 + head) * 32 + (s0 >> 7) + ai) * 16 + wr * 8) * 256 + wc * 32) * 8;
                    xpose_store(st, pk0, d0, 256, lane, fr, fq);
                    xpose_store(st, pk1, d0 + (size_t)HALF * 8, 256, lane, fr, fq);
                }
            }
        } else if (pn < 16) {
            const int head = (pn - 8) >> 1, dvb = ((pn - 8) & 1) * 256;
#pragma unroll
            for (int ai = 0; ai < 2; ++ai)
#pragma unroll
                for (int bj = 0; bj < 2; ++bj) {
                    unsigned pk[4][4];
#pragma unroll
                    for (int m = 0; m < 4; ++m) { const float rs = rstdx[rowt + ai * HALF + m * 16]; EPI_ACC8(v, ai, bj, m);
#pragma unroll
                        for (int q = 0; q < 4; ++q) pk[m][q] = cvt_pk_bf16(v[2 * q] * rs, v[2 * q + 1] * rs); }
                    bf16_t* d0 = RVT + ((((size_t)(bidx * 4 + head) * 32 + (s0 >> 7) + ai) * 16 + wr * 8) * 512 + dvb + bj * HALF + wc * 32) * 8;
                    xpose_store(st, pk, d0, 512, lane, fr, fq);
                }
        } else if (pn < 19) {
            const int lt = pn - 16; int fqo = fq; asm volatile("" : "+v"(fqo));
#pragma unroll
            for (int ai = 0; ai < 2; ++ai)
#pragma unroll
                for (int m = 0; m < 4; ++m) { const int row = rowt + ai * HALF + m * 16; const float rs = rstdx[row];
#pragma unroll
                    for (int bj = 0; bj < 2; ++bj) { if (lt == 2 && bj == 1) continue;
                        EPI_ACC8(v, ai, bj, m); float q = 0.f;
#pragma unroll
                        for (int e = 0; e < 8; ++e) { v[e] *= rs; q += v[e] * v[e]; }
                        *(u32x4*)(LAT + ((unsigned)row * 640u + lt * 256 + bj * HALF + wc * 32 + 8 * fqo)) = pack8(v);
                        const int kind = (lt == 0) ? 0 : (lt == 1 ? (bj == 0 ? 0 : 1) : 1);
                        q += __shfl_xor(q, 16); q += __shfl_xor(q, 32); if (fq == 0) atomicAdd(ssq_lat + kind * 16384 + row, q); } }
        } else if (wc == 0) {
#pragma unroll
            for (int ai = 0; ai < 2; ++ai)
#pragma unroll
                for (int m = 0; m < 4; ++m) { const int row = rowt + ai * HALF + m * 16; const float rs = rstdx[row];
                    float q = 0.f; unsigned w1[4], w2[4]; const h2x4_t* cp = (const h2x4_t*)csm + ((unsigned)row * 8u + 2u * (unsigned)fq);
#pragma unroll
                    for (int hh = 0; hh < 2; ++hh) { const f32x4 xa = acc[ai][0][m][hh] * rs, xb = acc[ai][1][m][hh] * rs; const f32x4 ga = *(const f32x4*)(k_norm + 128 + 8 * fq + 4 * hh), gb = *(const f32x4*)(k_norm + 160 + 8 * fq + 4 * hh);
                        const h2x4_t t4 = cp[hh]; float oa[4], ob[4];
#pragma unroll
                        for (int e = 0; e < 4; ++e) { q += xa[e] * xa[e] + xb[e] * xb[e]; const float ya = xa[e] * ga[e], yb = xb[e] * gb[e], c_ = (float)t4[2 * e], s_ = (float)t4[2 * e + 1];
                            oa[e] = ya * c_ - yb * s_; ob[e] = yb * c_ + ya * s_; }
                        w1[2 * hh] = cvt_pk_bf16(oa[0], oa[1]); w1[2 * hh + 1] = cvt_pk_bf16(oa[2], oa[3]); w2[2 * hh] = cvt_pk_bf16(ob[0], ob[1]); w2[2 * hh + 1] = cvt_pk_bf16(ob[2], ob[3]); }
                    *(u32x4*)(KR + ((unsigned)row * 64u + 8u * fq)) = (u32x4){w1[0], w1[1], w1[2], w1[3]}; *(u32x4*)(KR + ((unsigned)row * 64u + 32u + 8u * fq)) = (u32x4){w2[0], w2[1], w2[2], w2[3]};
                    q += __shfl_xor(q, 16); q += __shfl_xor(q, 32); if (fq == 0) ssq_kr[row] = q;
                    asm volatile("" ::: "memory"); }
        }
    }
};

struct EpiKVup {
    static constexpr bool PERM = true, AFTER_DRAIN = false, TWICE_OK = false; static __device__ __forceinline__ bool twice(const Unit&) { return false; }
    unsigned char* ws; const float* k_norm; PG8_LAS float* xr;
    static constexpr size_t O_KF = (size_t)142 << 20, O_VV = (size_t)190 << 20, O_KR = ((size_t)22 << 20) + (512 << 10), O_SSQ_CKV = ((size_t)1 << 20) + (128 << 10), O_SSQ_KR = ((size_t)1 << 20) + (320 << 10);
    __device__ __forceinline__ void operator()(const f32x4 (&acc)[2][2][4][2], const Unit& u, int wr, int wc, int fr, int fq) const {
        const unsigned rowt = u.pm * BM + wr * 64 + fr, head = u.pn, d0 = wc * 32 + 8 * fq;
        bf16_t* KF = (bf16_t*)(ws + O_KF); bf16_t* VV = (bf16_t*)(ws + O_VV); const bf16_t* KR = (const bf16_t*)(ws + O_KR); const float* ssq_ckv = (const float*)(ws + O_SSQ_CKV); const float* ssq_kr = (const float*)(ws + O_SSQ_KR);
        float rs8[2][4], kr8[2][4];
#pragma unroll
        for (int ai = 0; ai < 2; ++ai)
#pragma unroll
            for (int m = 0; m < 4; ++m) { rs8[ai][m] = __builtin_amdgcn_rsqf(ssq_ckv[rowt + ai * HALF + m * 16] * (1.0f / 256.0f) + RMS_EPS_); kr8[ai][m] = ssq_kr[rowt + ai * HALF + m * 16]; }
#pragma unroll
        for (int ai = 0; ai < 2; ++ai)
#pragma unroll
            for (int m = 0; m < 4; ++m) { const float rs = rs8[ai][m];
                const f32x4 a0 = acc[ai][0][m][0] * rs, a1 = acc[ai][0][m][1] * rs;
                float q = (a0[0] * a0[0] + a0[1] * a0[1]) + (a0[2] * a0[2] + a0[3] * a0[3]) + (a1[0] * a1[0] + a1[1] * a1[1]) + (a1[2] * a1[2] + a1[3] * a1[3]);
                q += __shfl_xor(q, 16); q += __shfl_xor(q, 32);
                if (fq == 0) xr[(ai * HALF + wr * 64 + m * 16 + fr) * 4 + wc] = q; }
        asm volatile("s_waitcnt lgkmcnt(0)\n\ts_barrier" ::: "memory");
        const f32x4 g0 = *(const f32x4*)(k_norm + d0), g1 = *(const f32x4*)(k_norm + d0 + 4);
#pragma unroll
        for (int ai = 0; ai < 2; ++ai)
#pragma unroll
            for (int m = 0; m < 4; ++m) { const unsigned row = rowt + ai * HALF + m * 16; const float rs = rs8[ai][m];
                const f32x4 p4 = *(const PG8_LAS f32x4*)(xr + (ai * HALF + wr * 64 + m * 16 + fr) * 4);
                const float sk = __builtin_amdgcn_rsqf(((p4[0] + p4[1]) + (p4[2] + p4[3]) + kr8[ai][m]) * (1.0f / 192.0f) + RMS_EPS_), rk = rs * sk;
                { EPI_ACC8(v, ai, 0, m);
#pragma unroll
                  for (int e = 0; e < 8; ++e) v[e] *= rk * (e < 4 ? g0[e & 3] : g1[e & 3]);
                  *(u32x4*)(KF + (row * 1536u + head * 192u + d0)) = pack8(v); }
                { EPI_ACC8(v, ai, 1, m);
#pragma unroll
                  for (int e = 0; e < 8; ++e) v[e] *= rs;
                  *(u32x4*)(VV + (row * 1024u + head * 128u + d0)) = pack8(v); }
                { const u32x2 kr = *(const u32x2*)(KR + (row * 64u + 16 * wc + 4 * fq));
                  *(u32x2*)(KF + (row * 1536u + head * 192u + 128 + 16 * wc + 4 * fq)) = (u32x2){cvt_pk_bf16(bflo(kr.x) * sk, bfhi(kr.x) * sk), cvt_pk_bf16(bflo(kr.y) * sk, bfhi(kr.y) * sk)}; } }
    }
};

struct EpiQup {
    static constexpr bool PERM = true, AFTER_DRAIN = false, TWICE_OK = false; static __device__ __forceinline__ bool twice(const Unit&) { return false; }
    bf16_t* QP; const float* ssq_cq; const float* q_norm; const void* csm; PG8_LAS float* xr; float c2q;
    __device__ __forceinline__ void operator()(const f32x4 (&acc)[2][2][4][2], const Unit& u, int wr, int wc, int fr, int fq) const {
        const unsigned rowt = u.pm * BM + wr * 64 + fr, head = u.pn;
#pragma unroll
        for (int ai = 0; ai < 2; ++ai)
#pragma unroll
            for (int m = 0; m < 4; ++m) { const float rs = __builtin_amdgcn_rsqf(ssq_cq[rowt + ai * HALF + m * 16] * (1.0f / 384.0f) + RMS_EPS_);
                const f32x4 a0 = acc[ai][0][m][0] * rs, a1 = acc[ai][0][m][1] * rs, b0 = acc[ai][1][m][0] * rs, b1 = acc[ai][1][m][1] * rs;
                float q = ((a0[0] * a0[0] + a0[1] * a0[1]) + (a0[2] * a0[2] + a0[3] * a0[3])) + ((a1[0] * a1[0] + a1[1] * a1[1]) + (a1[2] * a1[2] + a1[3] * a1[3]))
                        + ((b0[0] * b0[0] + b0[1] * b0[1]) + (b0[2] * b0[2] + b0[3] * b0[3])) + ((b1[0] * b1[0] + b1[1] * b1[1]) + (b1[2] * b1[2] + b1[3] * b1[3]));
                q += __shfl_xor(q, 16); q += __shfl_xor(q, 32);
                if (fq == 0) xr[(ai * HALF + wr * 64 + m * 16 + fr) * 4 + wc] = q; }
        asm volatile("s_waitcnt lgkmcnt(0)\n\ts_barrier" ::: "memory");
        const unsigned dA = wc < 3 ? wc * 32 + 8 * fq : 128 + 8 * fq, dB = wc == 0 ? 96 + 8 * fq : 160 + 8 * fq;
        const f32x4 gA0 = *(const f32x4*)(q_norm + dA), gA1 = *(const f32x4*)(q_norm + dA + 4), gB0 = *(const f32x4*)(q_norm + dB), gB1 = *(const f32x4*)(q_norm + dB + 4);
#pragma unroll
        for (int ai = 0; ai < 2; ++ai)
#pragma unroll
            for (int m = 0; m < 4; ++m) { const unsigned row = rowt + ai * HALF + m * 16; const float rs = __builtin_amdgcn_rsqf(ssq_cq[row] * (1.0f / 384.0f) + RMS_EPS_);
                const f32x4 p4 = *(const PG8_LAS f32x4*)(xr + (ai * HALF + wr * 64 + m * 16 + fr) * 4);
                const float sc = __builtin_amdgcn_rsqf(((p4[0] + p4[1]) + (p4[2] + p4[3])) * (1.0f / 192.0f) + RMS_EPS_) * rs * c2q;
                EPI_ACC8(va, ai, 0, m); EPI_ACC8(vb, ai, 1, m);
#pragma unroll
                for (int e = 0; e < 8; ++e) { va[e] *= sc * (e < 4 ? gA0[e & 3] : gA1[e & 3]); vb[e] *= sc * (e < 4 ? gB0[e & 3] : gB1[e & 3]); }
                bf16_t* qrow = QP + (row * 1536u + head * 192u);
                if (wc == 3) {
                    float cc[8], sn[8]; rope8(csm, row, 8 * fq, cc, sn);
#pragma unroll
                    for (int e = 0; e < 8; ++e) { const float a_ = va[e], b_ = vb[e]; va[e] = a_ * cc[e] - b_ * sn[e]; vb[e] = b_ * cc[e] + a_ * sn[e]; }
                }
                *(u32x4*)(qrow + dA) = pack8(va);
                if (wc == 0 || wc == 3) *(u32x4*)(qrow + dB) = pack8(vb); }
    }
};

template <int MODE> struct EpiRowAct {
    static constexpr bool PERM = true, AFTER_DRAIN = false, TWICE_OK = false; static __device__ __forceinline__ bool twice(const Unit&) { return true; }
    bf16_t* O; int ldo; const float* rsrc; float inv_dim; unsigned gso;
    __device__ __forceinline__ void operator()(const f32x4 (&acc)[2][2][4][2], const Unit& u, int wr, int wc, int fr, int fq) const {
        const int rowt = u.pm * BM + wr * 64 + fr, colt = u.pn * BM + wc * 32 + 8 * fq;
#pragma unroll
        for (int ai = 0; ai < 2; ++ai)
#pragma unroll
            for (int m = 0; m < 4; ++m) { const int row = rowt + ai * HALF + m * 16; const float r0 = rsrc[row]; const float rs = inv_dim == 0.f ? r0 : __builtin_amdgcn_rsqf(r0 * inv_dim + RMS_EPS_);
#pragma unroll
                for (int bj = 0; bj < 2; ++bj) { EPI_ACC8(v, ai, bj, m);
#pragma unroll
                    for (int e = 0; e < 8; ++e) { float x = v[e] * rs; if (MODE == 1) x = sigmoidf_(x); if (MODE == 2) { x = fmaxf(x, 0.f); x = x * x; } v[e] = x; }
                    st16(O + (gso ? (size_t)(row >> 11) * gso + (size_t)(row & 2047) * ldo : (size_t)row * ldo) + colt + bj * HALF, pack8(v)); } }
    }
};
struct EpiRetGate {
    static constexpr bool PERM = true, AFTER_DRAIN = false, TWICE_OK = false; static __device__ __forceinline__ bool twice(const Unit&) { return false; }
    bf16_t* RO; const float* rstdx; const float* ssq_ro; const float* ret_norm;
    __device__ __forceinline__ void operator()(const f32x4 (&acc)[2][2][4][2], const Unit& u, int wr, int wc, int fr, int fq) const {
        const int rowt = u.pm * BM + wr * 64 + fr, colt = u.pn * BM + wc * 32 + 8 * fq, head = u.pn >> 1;
        f32x4 g[2][2];
#pragma unroll
        for (int bj = 0; bj < 2; ++bj) { g[bj][0] = *(const f32x4*)(ret_norm + colt + bj * HALF); g[bj][1] = *(const f32x4*)(ret_norm + colt + bj * HALF + 4); }
#pragma unroll
        for (int ai = 0; ai < 2; ++ai)
#pragma unroll
            for (int m = 0; m < 4; ++m) { const int row = rowt + ai * HALF + m * 16; const float rs = rstdx[row]; const f32x4* sp = (const f32x4*)(ssq_ro + ((size_t)row * 4 + head) * 16); const f32x4 s4 = (sp[0] + sp[1]) + (sp[2] + sp[3]);
                const float rr = __builtin_amdgcn_rsqf(((s4[0] + s4[1]) + (s4[2] + s4[3])) * (1.0f / 512.0f) + RMS_EPS_);
#pragma unroll
                for (int bj = 0; bj < 2; ++bj) { EPI_ACC8(v, ai, bj, m); bf16_t* p = RO + (size_t)row * 2048 + colt + bj * HALF; float o[8]; unpack8(*(const u32x4*)p, o);
#pragma unroll
                    for (int e = 0; e < 8; ++e) { const float x = v[e] * rs; const float gg = e < 4 ? g[bj][0][e & 3] : g[bj][1][e & 3]; v[e] = o[e] * rr * gg * x * sigmoidf_(x); }
                    *(u32x4*)p = pack8(v); } }
    }
};
template <int MODE> struct EpiGateMix {
    static constexpr bool PERM = true, AFTER_DRAIN = false, TWICE_OK = false; static __device__ __forceinline__ bool twice(const Unit&) { return false; }
    bf16_t* TM; const bf16_t* SG; int sgoff; static constexpr size_t BLKE = (size_t)8 << 20;
    __device__ __forceinline__ void operator()(const f32x4 (&acc)[2][2][4][2], const Unit& u, int wr, int wc, int fr, int fq) const {
        const int rowt = u.pm * BM + wr * 64 + fr, colt = u.pn * BM + wc * 32 + 8 * fq;
#pragma unroll
        for (int ai = 0; ai < 2; ++ai)
#pragma unroll
            for (int m = 0; m < 4; ++m) { const int row = rowt + ai * HALF + m * 16;
#pragma unroll
                for (int bj = 0; bj < 2; ++bj) { EPI_ACC8(v, ai, bj, m); float s[8]; unpack8(*(const u32x4*)(SG + (size_t)(row >> 11) * BLKE + (size_t)(row & 2047) * 2048 + sgoff + colt + bj * HALF), s);
                    bf16_t* p = TM + (size_t)(row >> 11) * BLKE + (size_t)(row & 2047) * 1024 + colt + bj * HALF;
                    if (MODE == 1) { float t[8]; unpack8(*(const u32x4*)p, t);
#pragma unroll
                        for (int e = 0; e < 8; ++e) v[e] = t[e] + s[e] * v[e]; }
                    else {
#pragma unroll
                        for (int e = 0; e < 8; ++e) v[e] = s[e] * v[e]; }
                    *(u32x4*)p = pack8(v); } }
    }
};
template <bool RESB> struct EpiResid {
    static constexpr bool PERM = true, AFTER_DRAIN = false, TWICE_OK = false; static __device__ __forceinline__ bool twice(const Unit&) { return false; }
    const void* res; bf16_t* xb; float* ssq;
    __device__ __forceinline__ void operator()(const f32x4 (&acc)[2][2][4][2], const Unit& u, int wr, int wc, int fr, int fq) const {
        const int rowt = u.pm * BM + wr * 64 + fr, colt = u.pn * BM + wc * 32 + 8 * fq;
#pragma unroll
        for (int ai = 0; ai < 2; ++ai)
#pragma unroll
            for (int m = 0; m < 4; ++m) { const int row = rowt + ai * HALF + m * 16; float q = 0.f;
#pragma unroll
                for (int bj = 0; bj < 2; ++bj) { EPI_ACC8(v, ai, bj, m); const size_t off = (size_t)row * 1024 + colt + bj * HALF;
                    if (RESB) { float r[8]; unpack8(*(const u32x4*)((const bf16_t*)res + off), r);
#pragma unroll
                        for (int e = 0; e < 8; ++e) { v[e] += r[e]; q += v[e] * v[e]; } }
                    else { const f32x4 r0 = *(const f32x4*)((const float*)res + off), r1 = *(const f32x4*)((const float*)res + off + 4);
#pragma unroll
                        for (int e = 0; e < 8; ++e) { v[e] += e < 4 ? r0[e & 3] : r1[e & 3]; q += v[e] * v[e]; } }
                    *(u32x4*)(xb + off) = pack8(v); }
                q += __shfl_xor(q, 16); q += __shfl_xor(q, 32); if (fq == 0) atomicAdd(ssq + row, q);
                if (m & 1) asm volatile("" ::: "memory"); }
    }
};
struct EpiFinal {
    static constexpr bool PERM = true, AFTER_DRAIN = false, TWICE_OK = false; static __device__ __forceinline__ bool twice(const Unit&) { return false; }
    float* out; const bf16_t* GT; const bf16_t* xb;
    __device__ __forceinline__ void operator()(const f32x4 (&acc)[2][2][4][2], const Unit& u, int wr, int wc, int fr, int fq) const {
        const int rowt = u.pm * BM + wr * 64 + fr, colt = u.pn * BM + wc * 32 + 8 * fq;
#pragma unroll
        for (int ai = 0; ai < 2; ++ai)
#pragma unroll
            for (int m = 0; m < 4; ++m) { const int row = rowt + ai * HALF + m * 16;
#pragma unroll
                for (int bj = 0; bj < 2; ++bj) { EPI_ACC8(v, ai, bj, m); const size_t off = (size_t)row * 1024 + colt + bj * HALF; float gt[8], r[8]; unpack8(*(const u32x4*)(GT + off), gt); unpack8(*(const u32x4*)(xb + off), r);
#pragma unroll
                    for (int e = 0; e < 8; ++e) v[e] = r[e] + gt[e] * v[e];
                    *(f32x4*)(out + off) = (f32x4){v[0], v[1], v[2], v[3]}; *(f32x4*)(out + off + 4) = (f32x4){v[4], v[5], v[6], v[7]}; }
                if (m & 1) asm volatile("" ::: "memory"); }
    }
};
template <class Epi, class Sched, bool ALIGN_EPI = false, bool SP2 = false>
__device__ __forceinline__ void gemm_phase(PG8_LAS unsigned char* lds, const Gemm g, const Sched& S, const Epi& E) {
    int tid = g.wv * 64 + mk_lane();
    const int wid = __builtin_amdgcn_readfirstlane(tid >> 6), lane = tid & 63, wr = wid >> 2, wc = wid & 3, fr = lane & 15, fq = lane >> 4;
    int K = g.K; if (g.K < 512) asm volatile("" : "+s"(K));
    const int nt = K / BK;
    unsigned voffA[2], voffB[2];
#pragma unroll
    for (int i = 0; i < 2; ++i) { int R, C; stage_rc(tid * 16 + i * 8192, R, C); const int Rb = Epi::PERM ? ((R & ~31) + perm32(R & 31)) : R;
        voffA[i] = (unsigned)(R * g.lda + C) * 2u; voffB[i] = (unsigned)(Rb * g.ldb + C) * 2u; }
    const size_t kstep = (size_t)(BK * 2);
    const size_t hstepA = (size_t)HALF * g.lda * 2, hstepB = (size_t)HALF * g.ldb * 2;
    const size_t tstepA = 2 * hstepA, tstepB = 2 * hstepB;
    const unsigned ldsw = (unsigned)wid * 1024u;
    const int aoff = lds_byte(wr * 64 + fr, fq * 8), boff = lds_byte(wc * 32 + fr, fq * 8);
#define PG8_SA(b, h) (((b) * 2 + (h)) * HTB)
#define PG8_SB(b, h) ((4 + (b) * 2 + (h)) * HTB)
#define PG8_STAGE(bufoff, gbase, voff) do { _Pragma("unroll") for (int _i = 0; _i < 2; ++_i) \
        __builtin_amdgcn_global_load_lds((const unsigned*)((const char*)(gbase) + (voff)[_i]), (PG8_LAS unsigned*)(lds + (bufoff) + ldsw + _i * 8192), 16, 0, 0); } while (0)
#define PG8_LDA(dst, b, h) do { _Pragma("unroll") for (int m = 0; m < 4; ++m) _Pragma("unroll") for (int k = 0; k < 2; ++k) dst[m][k] = *(const PG8_LAS bf16x8*)(lds + PG8_SA(b, h) + aoff + m * 2048 + k * 1024); } while (0)
#define PG8_LDB(dst, b, h) do { _Pragma("unroll") for (int n = 0; n < 2; ++n) _Pragma("unroll") for (int k = 0; k < 2; ++k) dst[n][k] = *(const PG8_LAS bf16x8*)(lds + PG8_SB(b, h) + boff + n * 2048 + k * 1024); } while (0)
#define PG8_MMA(ai, bj, At, Bt) do { __builtin_amdgcn_s_setprio(1); _Pragma("unroll") for (int m = 0; m < 4; ++m) _Pragma("unroll") for (int n = 0; n < 2; ++n) _Pragma("unroll") for (int k = 0; k < 2; ++k) \
        acc[ai][bj][m][n] = __builtin_amdgcn_mfma_f32_16x16x32_bf16(Bt[n][k], At[m][k], acc[ai][bj][m][n], 0, 0, 0); __builtin_amdgcn_s_setprio(0); } while (0)
#define PG8_WAIT_V(n) asm volatile("s_waitcnt vmcnt(" #n ")" ::: "memory")
#define PG8_WAIT_L(n) asm volatile("s_waitcnt lgkmcnt(" #n ")" ::: "memory")
#define PG8_BAR __builtin_amdgcn_s_barrier()
#define PG8_SCHED __builtin_amdgcn_sched_barrier(0)
    Unit cur, nxt; int ui = 0;
    if (!S.next(0, cur)) return;
    f32x4 acc[2][2][4][2];
#pragma unroll
    for (int a = 0; a < 2; ++a)
#pragma unroll
        for (int b = 0; b < 2; ++b)
#pragma unroll
            for (int m = 0; m < 4; ++m)
#pragma unroll
                for (int n = 0; n < 2; ++n) acc[a][b][m][n] = (f32x4){0.f, 0.f, 0.f, 0.f};
    bf16x8 At[4][2], B0[2][2], B1[2][2];
#define PG8_AROW(pm_) ((const char*)g.A + (g.gsA ? (size_t)((pm_) >> 3) * g.gsA + (size_t)((pm_) & 7) * tstepA : (size_t)(pm_) * tstepA))
    const char* cA = PG8_AROW(cur.pm); const char* cB = (const char*)g.Bt + (size_t)cur.pn * tstepB;
    S.a_ready(cur);
    if constexpr (SP2) {
        PG8_STAGE(PG8_SB(0, 0), cB, voffB); PG8_STAGE(PG8_SB(0, 1), cB + hstepB, voffB); PG8_STAGE(PG8_SA(0, 0), cA, voffA); PG8_STAGE(PG8_SA(0, 1), cA + hstepA, voffA);
        if (wr == 1) PG8_BAR;
        PG8_WAIT_V(2); PG8_BAR;
        PG8_STAGE(PG8_SB(1, 0), cB + kstep, voffB); PG8_STAGE(PG8_SA(1, 0), cA + kstep, voffA); PG8_STAGE(PG8_SB(1, 1), cB + hstepB + kstep, voffB);
        PG8_WAIT_V(6); PG8_BAR;
    } else {
        PG8_STAGE(PG8_SB(0, 0), cB, voffB); PG8_STAGE(PG8_SA(0, 0), cA, voffA); PG8_STAGE(PG8_SB(0, 1), cB + hstepB, voffB); PG8_STAGE(PG8_SA(0, 1), cA + hstepA, voffA);
        if (wr == 1) PG8_BAR;
        PG8_WAIT_V(4); PG8_BAR;
        PG8_STAGE(PG8_SB(1, 0), cB + kstep, voffB); PG8_STAGE(PG8_SA(1, 0), cA + kstep, voffA); PG8_STAGE(PG8_SB(1, 1), cB + hstepB + kstep, voffB);
        PG8_WAIT_V(6); PG8_BAR;
    }
    for (;;) {
        const bool has_next = S.next(ui + 1, nxt);
        const char* nA = has_next ? PG8_AROW(nxt.pm) : cA; const char* nB = has_next ? (const char*)g.Bt + (size_t)nxt.pn * tstepB : cB;
        for (int t = 0; t < nt; t += 2) {
            const bool last = (t == nt - 2);
            const char* a1 = cA + (size_t)(t + 1) * kstep;
            const char* a2 = last ? nA : cA + (size_t)(t + 2) * kstep; const char* b2 = last ? nB : cB + (size_t)(t + 2) * kstep;
            const char* a3 = a2 + kstep; const char* b3 = b2 + kstep;
            if (last && has_next) S.a_ready(nxt);
            if constexpr (SP2) {
            PG8_LDB(B0, 0, 0); PG8_LDB(B1, 0, 1); PG8_SCHED; PG8_LDA(At, 0, 0); PG8_STAGE(PG8_SA(1, 1), a1 + hstepA, voffA);
            PG8_WAIT_V(8); PG8_WAIT_L(0); PG8_BAR; PG8_MMA(0, 0, At, B0); PG8_MMA(0, 1, At, B1); PG8_BAR; PG8_SCHED;
            PG8_LDA(At, 0, 1); PG8_STAGE(PG8_SB(0, 0), b2, voffB); PG8_STAGE(PG8_SB(0, 1), b2 + hstepB, voffB); PG8_STAGE(PG8_SA(0, 0), a2, voffA);
            PG8_WAIT_V(8); PG8_WAIT_L(0); PG8_BAR; PG8_MMA(1, 0, At, B0); PG8_MMA(1, 1, At, B1); PG8_BAR; PG8_SCHED;
            PG8_LDB(B0, 1, 0); PG8_LDB(B1, 1, 1); PG8_SCHED; PG8_LDA(At, 1, 0); PG8_STAGE(PG8_SA(0, 1), a2 + hstepA, voffA);
            PG8_WAIT_V(8); PG8_WAIT_L(0); PG8_BAR; PG8_MMA(0, 0, At, B0); PG8_MMA(0, 1, At, B1); PG8_BAR; PG8_SCHED;
            PG8_LDA(At, 1, 1); PG8_STAGE(PG8_SB(1, 0), b3, voffB); PG8_STAGE(PG8_SB(1, 1), b3 + hstepB, voffB); PG8_STAGE(PG8_SA(1, 0), a3, voffA);
            PG8_WAIT_V(8); PG8_WAIT_L(0); PG8_BAR; PG8_MMA(1, 0, At, B0); PG8_MMA(1, 1, At, B1); PG8_BAR; PG8_SCHED;
            } else {
            PG8_LDB(B0, 0, 0); PG8_SCHED; PG8_LDA(At, 0, 0); PG8_STAGE(PG8_SA(1, 1), a1 + hstepA, voffA);
            PG8_WAIT_L(8); PG8_BAR; PG8_WAIT_L(0); PG8_MMA(0, 0, At, B0); PG8_BAR; PG8_SCHED;
            PG8_LDB(B1, 0, 1); PG8_STAGE(PG8_SB(0, 0), b2, voffB);
            PG8_BAR; PG8_WAIT_L(0); PG8_MMA(0, 1, At, B1); PG8_BAR;
            PG8_LDA(At, 0, 1); PG8_STAGE(PG8_SA(0, 0), a2, voffA);
            PG8_BAR; PG8_WAIT_L(0); PG8_MMA(1, 0, At, B0); PG8_BAR; PG8_SCHED;
            PG8_STAGE(PG8_SB(0, 1), b2 + hstepB, voffB);
            PG8_WAIT_V(6); PG8_BAR; PG8_MMA(1, 1, At, B1); PG8_BAR;
            PG8_LDB(B0, 1, 0); PG8_SCHED; PG8_LDA(At, 1, 0); PG8_STAGE(PG8_SA(0, 1), a2 + hstepA, voffA);
            PG8_WAIT_L(8); PG8_BAR; PG8_WAIT_L(0); PG8_MMA(0, 0, At, B0); PG8_BAR; PG8_SCHED;
            PG8_LDB(B1, 1, 1); PG8_STAGE(PG8_SB(1, 0), b3, voffB);
            PG8_BAR; PG8_WAIT_L(0); PG8_MMA(0, 1, At, B1); PG8_BAR;
            PG8_LDA(At, 1, 1); PG8_STAGE(PG8_SA(1, 0), a3, voffA);
            PG8_BAR; PG8_WAIT_L(0); PG8_MMA(1, 0, At, B0); PG8_BAR; PG8_SCHED;
            PG8_STAGE(PG8_SB(1, 1), b3 + hstepB, voffB);
            PG8_WAIT_V(6); PG8_BAR; PG8_MMA(1, 1, At, B1); PG8_BAR;
            }
        }
        if constexpr (ALIGN_EPI) { if (wr == 0) PG8_BAR; }
        if constexpr (!Epi::AFTER_DRAIN) { E(acc, cur, wr, wc, fr, fq);
#ifdef EPI_TWICE
            if constexpr (Epi::TWICE_OK) { asm volatile("" ::: "memory"); if (Epi::twice(cur)) E(acc, cur, wr, wc, fr, fq); }
#endif
            S.done(cur); }
        if (!has_next) break;
#pragma unroll
        for (int a = 0; a < 2; ++a)
#pragma unroll
            for (int b = 0; b < 2; ++b)
#pragma unroll
                for (int m = 0; m < 4; ++m)
#pragma unroll
                    for (int n = 0; n < 2; ++n) acc[a][b][m][n] = (f32x4){0.f, 0.f, 0.f, 0.f};
        cur = nxt; cA = nA; cB = nB; ++ui;
        if constexpr (ALIGN_EPI) { if (wr == 1) PG8_BAR; }
    }
    PG8_WAIT_V(0);
    if constexpr (!ALIGN_EPI) { if (wr == 0) PG8_BAR; }
    PG8_BAR;
    if constexpr (Epi::AFTER_DRAIN) { E.fused(acc, cur, wr, wc, fr, fq, lds, wid, lane); S.done(cur); }
#undef PG8_AROW
#undef PG8_SA
#undef PG8_SB
#undef PG8_STAGE
#undef PG8_LDA
#undef PG8_LDB
#undef PG8_MMA
#undef PG8_WAIT_V
#undef PG8_WAIT_L
#undef PG8_BAR
#undef PG8_SCHED
}
}
#define GAS __attribute__((address_space(1)))
#define LAS __attribute__((address_space(3)))
typedef unsigned short bf16;
typedef unsigned v4u __attribute__((ext_vector_type(4)));
typedef float f32x4 __attribute__((ext_vector_type(4)));
typedef short bf16x8 __attribute__((ext_vector_type(8)));
typedef GAS unsigned gu32;
typedef GAS unsigned long long gu64;
#define RLX_AGENT __ATOMIC_RELAXED, __HIP_MEMORY_SCOPE_AGENT
#define LDS_WAIT() asm volatile("s_waitcnt lgkmcnt(0)" ::: "memory")
#define VM_WAIT() asm volatile("s_waitcnt vmcnt(0)" ::: "memory")
__device__ __forceinline__ unsigned long long rt() { return __builtin_amdgcn_s_memrealtime(); }
__device__ __forceinline__ unsigned f2bf(float f) { unsigned u = __builtin_bit_cast(unsigned, f); return (u + 0x7fffu + ((u >> 16) & 1u)) >> 16; }
__device__ __forceinline__ unsigned pk2(float lo, float hi) { return f2bf(lo) | (f2bf(hi) << 16); }

#define XB_TMO      128
#define XB_XCNT(j)  (256  + 64 * (j))
#define XB_XSUB(j)  (1280 + 64 * (j))
#define XB_XGEN(j)  (2304 + 64 * (j))
#define XB_TOP      3328
#define XB_TOPGEN   3392
#define XCD_BAR_WORDS 3456
#define XB_SPIN_CAP (1u << 18)

__device__ __forceinline__ unsigned xb_ld(unsigned* p)              { return __hip_atomic_load(p, __ATOMIC_RELAXED, __HIP_MEMORY_SCOPE_AGENT); }
__device__ __forceinline__ unsigned xb_add(unsigned* p, unsigned v) { return __hip_atomic_fetch_add(p, v, __ATOMIC_RELAXED, __HIP_MEMORY_SCOPE_AGENT); }
__device__ __forceinline__ unsigned xb_xcc_id() { return (unsigned)__builtin_amdgcn_s_getreg((3 << 11) | 20) & 0xFu; }
#define XB_SPIN(cond, bar) do { unsigned _sp = 0; while (cond) { __builtin_amdgcn_s_sleep(1); \
    if ((++_sp & 255u) == 0u) { if (xb_ld(&(bar)[XB_TMO])) break; if (_sp > XB_SPIN_CAP) { atomicAdd(&(bar)[XB_TMO], 1u); break; } } } } while (0)

struct XcdBarrier {
    unsigned* bar; unsigned x, w;
    volatile LAS unsigned* st;
};

__device__ __forceinline__ XcdBarrier xcd_barrier_post(unsigned* bar, volatile LAS unsigned* st) {
    XcdBarrier b; b.bar = bar; b.x = xb_xcc_id(); b.st = st;
    if (threadIdx.x == 0) st[2] = xb_add(&bar[XB_XCNT(b.x)], 1u);
    return b;
}
__device__ __forceinline__ void xcd_barrier_complete(unsigned* bar, unsigned x, unsigned& nloc, unsigned& nx) {
    const unsigned G = gridDim.x * gridDim.y * gridDim.z;
    unsigned sum, cnt, mine, sp = 0u;
    for (;;) {
        sum = 0u; cnt = 0u; mine = 0u;
#pragma unroll
        for (unsigned j = 0; j < 16; ++j) { const unsigned c = xb_ld(&bar[XB_XCNT(j)]); sum += c; cnt += (c > 0u) ? 1u : 0u; mine = (j == x) ? c : mine; }
        if (sum == G) break;
        __builtin_amdgcn_s_sleep(1);
        if ((++sp & 255u) == 0u) { if (xb_ld(&bar[XB_TMO])) break; if (sp > XB_SPIN_CAP) { atomicAdd(&bar[XB_TMO], 1u); break; } }
    }
    nloc = mine > 0u ? mine : 1u; nx = cnt > 0u ? cnt : 1u;
}

__device__ __forceinline__ void xcd_barrier(const XcdBarrier& b) {
    asm volatile("s_waitcnt vmcnt(0)" ::: "memory");
    __syncthreads();
    if ((int)b.w * 64 + mk_lane() == 0) {
        unsigned* bar = b.bar;
        __builtin_amdgcn_s_waitcnt(0);
        unsigned nloc = b.st[0], nx = b.st[1];
        if (nloc == 0u) { xcd_barrier_complete(bar, b.x, nloc, nx); b.st[0] = nloc; b.st[1] = nx; }
        const unsigned old = xb_add(&bar[XB_XSUB(b.x)], 1u);
        const unsigned gen = old / nloc;
        if (old + 1u == (gen + 1u) * nloc) {
            __builtin_amdgcn_fence(__ATOMIC_RELEASE, "agent");
            asm volatile("s_waitcnt vmcnt(0)" ::: "memory");
            const unsigned og = xb_add(&bar[XB_TOP], 1u);
            const unsigned tg = og / nx;
            if (og + 1u == (tg + 1u) * nx) xb_add(&bar[XB_TOPGEN], 1u);
            else XB_SPIN(xb_ld(&bar[XB_TOPGEN]) == tg, bar);
            __builtin_amdgcn_fence(__ATOMIC_ACQUIRE, "agent");
            xb_add(&bar[XB_XGEN(b.x)], 1u);
            asm volatile("s_waitcnt vmcnt(0)" ::: "memory");
        } else {
            XB_SPIN(xb_ld(&bar[XB_XGEN(b.x)]) == gen, bar);
            __builtin_amdgcn_fence(__ATOMIC_ACQUIRE, "agent");
            asm volatile("s_waitcnt vmcnt(0)" ::: "memory");
        }
    }
    __syncthreads();
}


#define XB_LSUB(j)  (3520 + 64 * (j))
#define XB_LGEN(j)  (4544 + 64 * (j))
#define XCD_BAR_WORDS_ALL 5632
__device__ __forceinline__ void xcd_local_barrier(const XcdBarrier& b) {
    asm volatile("s_waitcnt vmcnt(0)" ::: "memory");
    __syncthreads();
    if ((int)b.w * 64 + mk_lane() == 0) {
        unsigned* bar = b.bar; __builtin_amdgcn_s_waitcnt(0);
        const unsigned nloc = b.st[0];
        const unsigned old = xb_add(&bar[XB_LSUB(b.x)], 1u), gen = old / nloc;
        if (old + 1u == (gen + 1u) * nloc) { __builtin_amdgcn_fence(__ATOMIC_ACQUIRE, "agent"); xb_add(&bar[XB_LGEN(b.x)], 1u); asm volatile("s_waitcnt vmcnt(0)" ::: "memory"); }
        else { XB_SPIN(xb_ld(&bar[XB_LGEN(b.x)]) == gen, bar); __builtin_amdgcn_fence(__ATOMIC_ACQUIRE, "agent"); asm volatile("s_waitcnt vmcnt(0)" ::: "memory"); }
    }
    __syncthreads();
}

typedef float f32x2 __attribute__((ext_vector_type(2)));
constexpr int NWAVES = 8;
constexpr int BATCH = 4, SEQ = 4096, DM = 1024, MTOK = BATCH * SEQ;
constexpr int NIN1 = 5120;
constexpr int LATW = 640;
constexpr float C2Q = 0.07216878364870323f * 1.4426950408889634f;

constexpr size_t MiB = 1u << 20, KiB = 1u << 10;
constexpr size_t WS_CTL = 0, CTL_ZERO_BYTES = 64 * KiB;
constexpr size_t WS_SMALL = 1 * MiB;
constexpr size_t SM_RSTDX = 0, SM_SSQ_CQ = 64 * KiB, SM_SSQ_CKV = 128 * KiB, SM_SSQ1 = 192 * KiB, SM_SSQ2 = 256 * KiB, SM_SSQ_KR = 320 * KiB, SM_END = 384 * KiB, SM_BOUND = 384 * KiB;
constexpr size_t WS_WIN = 2 * MiB;
constexpr size_t WS_SSQP = 10 * MiB;
constexpr size_t WS_WUQ = 20 * MiB;
constexpr size_t WS_WUKV = WS_WUQ + (size_t)2048 * 384 * 2;
constexpr size_t WS_KR = 22 * MiB + 512 * KiB;
constexpr size_t WS_XB = 25 * MiB;
constexpr size_t WS_CS = 57 * MiB;
constexpr size_t WS_LAT = 73 * MiB;
constexpr size_t WS_RQ = 94 * MiB, WS_RK = 126 * MiB, WS_RKDT = 158 * MiB, WS_RVT = 190 * MiB;
constexpr size_t WS_QP = 94 * MiB, WS_KF = 142 * MiB, WS_VV = 190 * MiB;
constexpr size_t WS_MO = 222 * MiB;
constexpr size_t WS_BLK = 16 * MiB;
constexpr size_t WS_SG = 57 * MiB, WS_TM = 57 * MiB + 8 * MiB;
constexpr size_t WS_WBR = 190 * MiB, WS_WBM = 194 * MiB, WS_WO = 196 * MiB, WS_WUP = 198 * MiB, WS_WDOWN = 206 * MiB, WS_WPG = 214 * MiB, WS_WPLE = 18 * MiB;
constexpr size_t WS_PB = 10 * MiB;
constexpr size_t WS_H = 57 * MiB;
constexpr size_t WS_GT = 222 * MiB;
constexpr size_t WS_CSM = 254 * MiB;
constexpr size_t WS_END = 256 * MiB;
static_assert(SM_SSQ_CKV == SM_SSQ_CQ + 65536, "ssq_lat layout");
static_assert(WS_WIN + (size_t)9216 * 2048 <= WS_WUQ && WS_WUKV + (size_t)2048 * 256 * 2 <= WS_KR && WS_KR + 2 * MiB <= WS_XB && WS_LAT + 20 * MiB <= WS_RQ && WS_RVT + 64 * MiB <= WS_END && WS_H + 128 * MiB <= WS_WBR && WS_PB + 8 * MiB <= WS_WPLE && WS_WPLE + 512 * KiB <= WS_WUQ && WS_WPG + 2 * MiB <= WS_GT && WS_GT + 32 * MiB <= WS_CSM && WS_VV + 32 * MiB <= WS_MO, "d_ws map");
constexpr int CW_BAR = 1024;

constexpr int RING_OFF = 0, RING_BYTES = 131072;
constexpr int XS_OFF = RING_BYTES, XS_BYTES = 8 * 2304;
constexpr int MISC_OFF = XS_OFF + XS_BYTES;
constexpr int LDS_BYTES = 160 * 1024;
static_assert(MISC_OFF + 128 <= LDS_BYTES, "LDS map");

struct Frame {
    LAS unsigned char* lds; volatile LAS unsigned* MISC; int tid, lane, wave, G, vcu, wv0;
    float* out; unsigned char* ws;
};
__device__ __forceinline__ float wave_sum(float v) {
#pragma unroll
    for (int o = 1; o < 64; o <<= 1) v += __shfl_xor(v, o);
    return v;
}
__device__ __forceinline__ void p0_transpose_item(const float* W, int ldw, int K, int src_col, bf16* WT, int dst_row, int ncols, const float* gain, LAS float* scr, int item, int lane) {
    const int nblk = ncols / 32, kb = item / nblk, nb = item % nblk, k0 = 64 * kb, n0 = 32 * nb;
#pragma unroll 16
    for (int i = 0; i < 32; ++i) { const int kk = 2 * i + (lane >> 5); const float gk = gain ? gain[k0 + kk] : 1.0f; scr[kk * 33 + (lane & 31)] = W[(size_t)(k0 + kk) * ldw + src_col + n0 + (lane & 31)] * gk; }
    LDS_WAIT(); asm volatile("" ::: "memory");
    const int c = lane & 7;
#pragma unroll
    for (int j = 0; j < 4; ++j) { const int n = (lane >> 3) + 8 * j; const LAS float* s = scr + (8 * c) * 33 + n;
        v4u o; o.x = pk2(s[0 * 33], s[1 * 33]); o.y = pk2(s[2 * 33], s[3 * 33]); o.z = pk2(s[4 * 33], s[5 * 33]); o.w = pk2(s[6 * 33], s[7 * 33]);
        *(GAS v4u*)(WT + (size_t)(dst_row + n0 + n) * K + k0 + 8 * c) = o; }
    LDS_WAIT(); asm volatile("" ::: "memory");
}
struct XT { const float* src; bf16* dst; const float* gain; int ldw, K; };
#define XT_SEG(W_, ldw_, K_, src_, WT_, dst_, ncols_, gain_) { const int n_ = ((K_) / 64) * ((ncols_) / 128); if (r < n_) { const int nblk_ = (ncols_) / 128, kb_ = r / nblk_, nb_ = r - kb_ * nblk_; \
        x.src = (W_) + (size_t)(64 * kb_) * (ldw_) + (src_) + 128 * nb_; x.dst = (WT_) + (size_t)((dst_) + 128 * nb_) * (K_) + 64 * kb_; x.gain = (gain_) ? (gain_) + 64 * kb_ : (const float*)nullptr; x.ldw = (ldw_); x.K = (K_); return x; } r -= n_; }
__device__ __forceinline__ void xt_load(const XT& x, int tid, f32x4 (&v)[4], float (&g)[4]) {
#pragma unroll
    for (int i = 0; i < 4; ++i) { const int row = i * 16 + (tid >> 5); v[i] = *(const GAS f32x4*)(x.src + (size_t)row * x.ldw + 4 * (tid & 31)); g[i] = x.gain ? x.gain[row] : 1.0f; }
}
template <class Dec> __device__ __forceinline__ void xt_run(Frame& F, int ntiles, const Dec& dec) {
    LAS float* scr = (LAS float*)(F.lds + RING_OFF);
    const int tid = F.tid; int t = F.vcu; if (t >= ntiles) return;
    XT cur = dec(t); f32x4 v[4]; float g[4]; xt_load(cur, tid, v, g);
    for (;;) {
        const int tn = t + F.G; const bool has = tn < ntiles; const XT nxt = has ? dec(tn) : cur;
        __syncthreads();
#pragma unroll
        for (int i = 0; i < 4; ++i) *(LAS f32x4*)(scr + (i * 16 + (tid >> 5)) * 132 + 4 * (tid & 31)) = v[i] * g[i];
        if (has) xt_load(nxt, tid, v, g);
        __syncthreads();
        const int n = tid >> 2, kq = tid & 3;
#pragma unroll
        for (int j = 0; j < 2; ++j) { const int kc = kq + 4 * j; const LAS float* s = scr + (8 * kc) * 132 + n;
            v4u o; o.x = pk2(s[0 * 132], s[1 * 132]); o.y = pk2(s[2 * 132], s[3 * 132]); o.z = pk2(s[4 * 132], s[5 * 132]); o.w = pk2(s[6 * 132], s[7 * 132]);
            *(GAS v4u*)(cur.dst + (size_t)n * cur.K + 8 * kc) = o; }
        if (!has) break;
        cur = nxt; t = tn;
    }
    __syncthreads();
}
#define P0_SEG(W, ldw, K, src, WT, dst, ncols, gain) { const int n_ = ((K) / 64) * ((ncols) / 32); if (r < n_) { p0_transpose_item(W, ldw, K, src, WT, dst, ncols, gain, scr, r, F.lane); continue; } r -= n_; }
__device__ __forceinline__ void phase_p0(Frame& F, const float* x, const int* pos, const float* g_mix, const float* w_in, const float* g_qlat, const float* g_kvlat, const float* w_uq, const float* w_ukv, const float* qn, const float* kn) {
    LAS float* scr = (LAS float*)(F.lds + RING_OFF + F.wave * 16384);
    const int gw = F.vcu * NWAVES + F.wave, NGW = F.G * NWAVES;
    bf16* WinT = (bf16*)(F.ws + WS_WIN); bf16* WuqT = (bf16*)(F.ws + WS_WUQ); bf16* WukvT = (bf16*)(F.ws + WS_WUKV);
    struct Dec0 { const float *w_in, *g_mix, *w_uq, *g_qlat, *w_ukv, *g_kvlat; bf16 *WinT, *WuqT, *WukvT;
        __device__ __forceinline__ XT operator()(int r) const { XT x;
            XT_SEG(w_in, 8896, 1024, 6848, WinT, 0, 2048, g_mix)
            XT_SEG(w_in, 8896, 1024, 4096, WinT, 2048, 2048, g_mix)
            XT_SEG(w_in, 8896, 1024, 0, WinT, 4096, 4096, g_mix)
            XT_SEG(w_in, 8896, 1024, 6144, WinT, 8192, 640, g_mix)
            XT_SEG(w_ukv, 2048, 256, 0, WukvT, 0, 2048, g_kvlat)
            x.src = w_in; x.dst = WinT; x.gain = nullptr; x.ldw = 8896; x.K = 1024; return x; } };
    { const Dec0 d{w_in, g_mix, w_uq, g_qlat, w_ukv, g_kvlat, WinT, WuqT, WukvT}; xt_run(F, 16 * 16 * 2 + 16 * 32 + 16 * 5 + 4 * 16, d); }
    for (int it = gw; it < 32 + 8 * 36; it += NGW) {
        int r = it;
        P0_SEG(w_in, 8896, 1024, 6784, WinT, 8960, 32, g_mix)
        P0_SEG(w_in, 8896, 1024, 6816, WinT, 8960 + 128, 32, g_mix)
        { const int hh = r / 36; r -= hh * 36;
          P0_SEG(w_uq, 1536, 384, hh * 192, WuqT, hh * 256, 96, g_qlat)
          P0_SEG(w_uq, 1536, 384, hh * 192 + 128, WuqT, hh * 256 + 96, 32, g_qlat)
          P0_SEG(w_uq, 1536, 384, hh * 192 + 96, WuqT, hh * 256 + 128, 32, g_qlat)
          P0_SEG(w_uq, 1536, 384, hh * 192 + 160, WuqT, hh * 256 + 224, 32, g_qlat) }
    }
    for (int gt = F.vcu * 512 + F.tid; gt < 24576; gt += F.G * 512) { const int hh = gt / 3072, rem = gt - hh * 3072; *(GAS v4u*)((unsigned char*)(WuqT + (size_t)(hh * 256 + 160) * 384) + (size_t)rem * 16) = (v4u){0u, 0u, 0u, 0u}; }
    for (int gt = F.vcu * 512 + F.tid; gt < 40960; gt += F.G * 512) { const int row = gt >> 7, piece = gt & 127; const int wrow = row < 128 ? 8832 + row : (row < 224 ? 8992 + (row - 128) : 9120 + (row - 224));
        *(GAS v4u*)((unsigned char*)(WinT + (size_t)wrow * 1024) + (size_t)piece * 16) = (v4u){0u, 0u, 0u, 0u}; }
    { bf16* XB = (bf16*)(F.ws + WS_XB); float* rstdx = (float*)(F.ws + WS_SMALL + SM_RSTDX);
      for (int m0 = 2 * gw; m0 < MTOK; m0 += 2 * NGW) {
          f32x4 v[2][4]; float s[2] = {0.f, 0.f};
#pragma unroll
          for (int u = 0; u < 2; ++u) { const GAS f32x4* xr = (const GAS f32x4*)(x + (size_t)(m0 + u) * DM) + F.lane;
#pragma unroll
              for (int j = 0; j < 4; ++j) v[u][j] = xr[64 * j]; }
#pragma unroll
          for (int u = 0; u < 2; ++u) {
#pragma unroll
              for (int j = 0; j < 4; ++j) s[u] += (v[u][j].x * v[u][j].x + v[u][j].y * v[u][j].y) + (v[u][j].z * v[u][j].z + v[u][j].w * v[u][j].w);
              s[u] = wave_sum(s[u]);
              GAS unsigned long long* o8 = (GAS unsigned long long*)(XB + (size_t)(m0 + u) * DM) + F.lane;
#pragma unroll
              for (int j = 0; j < 4; ++j) o8[64 * j] = (unsigned long long)pk2(v[u][j].x, v[u][j].y) | ((unsigned long long)pk2(v[u][j].z, v[u][j].w) << 32);
              if (F.lane == 0) rstdx[m0 + u] = 1.0f / sqrtf(s[u] * (1.0f / DM) + 1e-6f); }
      } }
    { f32x2* cs = (f32x2*)(F.ws + WS_CS);
      for (int e = F.vcu * 512 + F.tid; e < MTOK * 128; e += F.G * 512) { const int row = e >> 7, i = e & 127;
          const float inv = __builtin_amdgcn_exp2f(-(float)i * (13.287712379549449f / 128.0f));
          double rev = (double)pos[row] * (double)inv * 0.15915494309189535; rev -= __builtin_rint(rev);
          const float rf = (float)rev; cs[e] = (f32x2){__builtin_amdgcn_cosf(rf), __builtin_amdgcn_sinf(rf)}; } }
    { typedef _Float16 h2_t __attribute__((ext_vector_type(2))); h2_t* csm = (h2_t*)(F.ws + WS_CSM);
      for (int e = F.vcu * 512 + F.tid; e < MTOK * 32; e += F.G * 512) { const int row = e >> 5, i = e & 31;
          const float inv = __builtin_amdgcn_exp2f(-(float)(4 * i) * (13.287712379549449f / 128.0f));
          double rev = (double)pos[row] * (double)inv * 0.15915494309189535; rev -= __builtin_rint(rev);
          const float rf = (float)rev; csm[e] = (h2_t){(_Float16)__builtin_amdgcn_cosf(rf), (_Float16)__builtin_amdgcn_sinf(rf)}; } }
    if (F.vcu == 0 && F.wave == 0) { float mq = 0.f, mk = 0.f;
#pragma unroll
        for (int j = 0; j < 3; ++j) { mq = fmaxf(mq, fabsf(qn[F.lane + 64 * j])); mk = fmaxf(mk, fabsf(kn[F.lane + 64 * j])); }
#pragma unroll
        for (int o = 1; o < 64; o <<= 1) { mq = fmaxf(mq, __shfl_xor(mq, o)); mk = fmaxf(mk, __shfl_xor(mk, o)); }
        if (F.lane == 0) *(float*)(F.ws + WS_SMALL + SM_BOUND) = 1.02f * 1.4426950408889634f * 13.856406460551018f * mq * mk; }
    { float* z = (float*)(F.ws + WS_SMALL + SM_SSQ_CQ); for (int e = F.vcu * 512 + F.tid; e < (int)((SM_END - SM_SSQ_CQ) / 4); e += F.G * 512) z[e] = 0.f; }
}
__device__ __forceinline__ void phase_late_weights(Frame& F, const float* p, const float* w_br, const float* w_bm, const float* w_o, const float* g_mlp, const float* w_up, const float* w_down, const float* g_ple, const float* w_pg, const float* w_ple) {
    struct Dec1 { const float *w_br, *w_bm, *w_o, *g_mlp, *w_up, *w_down, *g_ple, *w_pg, *w_ple; unsigned char* ws;
        __device__ __forceinline__ XT operator()(int r) const { XT x; const float* nog = nullptr;
            XT_SEG(w_br, 1024, 2048, 0, (bf16*)(ws + WS_WBR), 0, 1024, nog)
            XT_SEG(w_bm, 1024, 1024, 0, (bf16*)(ws + WS_WBM), 0, 1024, nog)
            XT_SEG(w_o, 1024, 1024, 0, (bf16*)(ws + WS_WO), 0, 1024, nog)
            XT_SEG(w_up, 4096, 1024, 0, (bf16*)(ws + WS_WUP), 0, 4096, g_mlp)
            XT_SEG(w_down, 1024, 4096, 0, (bf16*)(ws + WS_WDOWN), 0, 1024, nog)
            XT_SEG(w_pg, 1024, 1024, 0, (bf16*)(ws + WS_WPG), 0, 1024, g_ple)
            XT_SEG(w_ple, 1024, 256, 0, (bf16*)(ws + WS_WPLE), 0, 1024, nog)
            x.src = w_br; x.dst = (bf16*)(ws + WS_WBR); x.gain = nullptr; x.ldw = 1024; x.K = 2048; return x; } };
    { const Dec1 d{w_br, w_bm, w_o, g_mlp, w_up, w_down, g_ple, w_pg, w_ple, F.ws}; xt_run(F, 32 * 8 + 16 * 8 * 2 + 16 * 32 + 64 * 8 + 16 * 8 + 4 * 8, d); }
    { bf16* PB = (bf16*)(F.ws + WS_PB);
      for (int e = F.vcu * 512 + F.tid; e < MTOK * 256 / 8; e += F.G * 512) { const f32x4 a = *(const GAS f32x4*)(p + (size_t)e * 8), b = *(const GAS f32x4*)(p + (size_t)e * 8 + 4);
          *(GAS v4u*)(PB + (size_t)e * 8) = (v4u){pk2(a.x, a.y), pk2(a.z, a.w), pk2(b.x, b.y), pk2(b.z, b.w)}; } }
}

typedef float f32x16 __attribute__((ext_vector_type(16)));
typedef unsigned u32x2 __attribute__((ext_vector_type(2)));
typedef short v4i16_t __attribute__((ext_vector_type(4)));
__device__ __forceinline__ int crow(int r, int hi) { return (r & 3) + 8 * (r >> 2) + 4 * hi; }
typedef __bf16 bf16x2m_t __attribute__((ext_vector_type(2)));
__device__ __forceinline__ unsigned cvtpk(float lo, float hi) { f32x2 v = {lo, hi}; bf16x2m_t b = __builtin_convertvector(v, bf16x2m_t); return __builtin_bit_cast(unsigned, b); }
__device__ __forceinline__ bf16x8 pack8f(const f32x16& p, int b) { v4u w = {cvtpk(p[b], p[b + 1]), cvtpk(p[b + 2], p[b + 3]), cvtpk(p[b + 4], p[b + 5]), cvtpk(p[b + 6], p[b + 7])}; return __builtin_bit_cast(bf16x8, w); }
__device__ __forceinline__ float bf2f(bf16 v) { return __uint_as_float((unsigned)v << 16); }
__device__ __forceinline__ float log2_gamma(int h) { return __builtin_amdgcn_logf(1.0f - __builtin_amdgcn_exp2f(-5.0f - (float)h)); }


__device__ __forceinline__ void phase_r0p(Frame& F) {
    const bf16* RQ = (const bf16*)(F.ws + WS_RQ); bf16* RK = (bf16*)(F.ws + WS_RK);
    const int lane = F.lane, w = F.wave, l31 = lane & 31, hi = lane >> 5, tq = w & 3, dh = w >> 2;
    for (int unit = F.vcu; unit < 512; unit += F.G) {
        const int bh = unit >> 5, c = unit & 31, h = bh & 3; const size_t blk = (size_t)bh * 32 + c;
        const float lg2 = log2_gamma(h);
        bf16x8 qf[16];
#pragma unroll
        for (int ks = 0; ks < 16; ++ks) qf[ks] = *(const bf16x8*)(RQ + ((blk * 32 + 2 * ks + hi) * 128 + 32 * tq + l31) * 8);
        f32x16 s[2] = {};
#pragma unroll
        for (int x = 0; x < 2; ++x) { const int tb = 2 * dh + x;
            if (tb <= tq) {
#pragma unroll
                for (int ks = 0; ks < 16; ++ks) { const bf16x8 kf = *(const bf16x8*)(RK + ((blk * 32 + 2 * ks + hi) * 128 + 32 * tb + l31) * 8); s[x] = __builtin_amdgcn_mfma_f32_32x32x16_bf16(kf, qf[ks], s[x], 0, 0, 0); }
#pragma unroll
                for (int r = 0; r < 16; ++r) { const int d = (32 * tq + l31) - (32 * tb + crow(r, hi)); s[x][r] = d >= 0 ? s[x][r] * __builtin_amdgcn_exp2f((float)d * lg2) : 0.f; }
            } }
        VM_WAIT(); __syncthreads();
#pragma unroll
        for (int x = 0; x < 2; ++x) { const int tb = 2 * dh + x;
            if (tb <= tq) {
#pragma unroll
                for (int g = 0; g < 4; ++g) *(u32x2*)(RK + ((blk * 32 + 4 * tb + g) * 128 + 32 * tq + l31) * 8 + 4 * hi) = (u32x2){cvtpk(s[x][4 * g], s[x][4 * g + 1]), cvtpk(s[x][4 * g + 2], s[x][4 * g + 3])};
            } }
    }
}
__device__ __forceinline__ void phase_r1p(Frame& F) {
    const bf16* RQ = (const bf16*)(F.ws + WS_RQ); const bf16* RP = (const bf16*)(F.ws + WS_RK); const bf16* RKDT = (const bf16*)(F.ws + WS_RKDT); const bf16* RVT = (const bf16*)(F.ws + WS_RVT); bf16* RO = (bf16*)F.out;
    float* ssqp = (float*)(F.ws + WS_SSQP);
    const int lane = F.lane, w = F.wave, l15 = lane & 15, lq = lane >> 4;
    constexpr int SROW = 528, SBUF = 32 * SROW;
    LAS unsigned char* ost = F.lds + 2 * SBUF + 1024 + w * 1024;
    const int nkp = (w >> 1) + 1;
    for (int unit = F.vcu; unit < 256; unit += F.G) {
        const int bh = unit >> 4, j = unit & 15, b = bh >> 2, h = bh & 3;
        const float lg2 = log2_gamma(h), gC = __builtin_amdgcn_exp2f(128.0f * lg2);
        float qd[4];
#pragma unroll
        for (int i = 0; i < 4; ++i) qd[i] = __builtin_amdgcn_exp2f((float)(16 * w + 4 * lq + i + 1) * lg2);
        f32x4 S[2][2];
#pragma unroll
        for (int mb = 0; mb < 2; ++mb)
#pragma unroll
            for (int nb = 0; nb < 2; ++nb) S[mb][nb] = (f32x4){0.f, 0.f, 0.f, 0.f};
        __syncthreads();
#pragma unroll
        for (int mb = 0; mb < 2; ++mb)
#pragma unroll
            for (int nb = 0; nb < 2; ++nb) *(LAS u32x2*)(F.lds + (16 * nb + l15) * SROW + (32 * w + 16 * mb + 4 * lq) * 2) = (u32x2){0u, 0u};
        const bf16* qp = RQ + (((size_t)bh * 32 * 32 + lq) * 128 + 16 * w + l15) * 8;
        const bf16* pp = RP + (((size_t)bh * 32 * 32 + lq) * 128 + 16 * w + l15) * 8;
        const bf16* kp = RKDT + (((size_t)bh * 32 * 16 + lq) * 256 + 32 * w + l15) * 8;
        const bf16* vp = RVT + (((size_t)bh * 32 * 16 + (F.tid >> 5)) * 512 + 32 * j + (F.tid & 31)) * 8;
        constexpr size_t QC = 32 * 128 * 8, QK = 4 * 128 * 8, KC = 16 * 256 * 8, KK = 4 * 256 * 8, VC = 16 * 512 * 8;
        bf16x8 QA[8], PA[4], KA[2][4], vpre;
        LAS unsigned char* vl = F.lds + 2 * SBUF + 1024 + 8 * 1024;
#pragma unroll
        for (int ks = 0; ks < 8; ++ks) QA[ks] = *(const bf16x8*)(qp + QK * ks);
#pragma unroll
        for (int ks = 0; ks < 4; ++ks) { PA[ks] = (bf16x8){0, 0, 0, 0, 0, 0, 0, 0}; if (ks < nkp) PA[ks] = *(const bf16x8*)(pp + QK * ks); }
#pragma unroll
        for (int mb = 0; mb < 2; ++mb)
#pragma unroll
            for (int ks = 0; ks < 4; ++ks) KA[mb][ks] = *(const bf16x8*)(kp + mb * 128 + KK * ks);
        vpre = *(const bf16x8*)vp;
        *(LAS bf16x8*)(vl + F.tid * 16) = vpre;
#pragma unroll 1
        for (int c = 0; c < 32; ++c) {
            const int cur = c & 1, cn = c < 31 ? c + 1 : 31; const size_t tok0 = (size_t)b * SEQ + c * 128;
            __syncthreads();
            vpre = *(const bf16x8*)(vp + VC * cn);
            bf16x8 VB[2][4];
#pragma unroll
            for (int nb = 0; nb < 2; ++nb)
#pragma unroll
                for (int ks = 0; ks < 4; ++ks) VB[nb][ks] = *(const LAS bf16x8*)(vl + cur * 8192 + ((4 * ks + lq) * 32 + 16 * nb + l15) * 16);
            f32x4 oc[2] = {(f32x4){0.f, 0.f, 0.f, 0.f}, (f32x4){0.f, 0.f, 0.f, 0.f}};
#pragma unroll
            for (int ks = 0; ks < 8; ++ks)
#pragma unroll
                for (int nb = 0; nb < 2; ++nb) { const bf16x8 bq = *(const LAS bf16x8*)(F.lds + cur * SBUF + (16 * nb + l15) * SROW + (32 * ks + 8 * lq) * 2);
                    oc[nb] = __builtin_amdgcn_mfma_f32_16x16x32_bf16(QA[ks], bq, oc[nb], 0, 0, 0); }
#pragma unroll
            for (int ks = 0; ks < 8; ++ks) QA[ks] = *(const bf16x8*)(qp + QC * cn + QK * ks);
#pragma unroll
            for (int nb = 0; nb < 2; ++nb)
#pragma unroll
                for (int i = 0; i < 4; ++i) oc[nb][i] *= qd[i];
#pragma unroll
            for (int ks = 0; ks < 4; ++ks)
                if (ks < nkp) {
#pragma unroll
                    for (int nb = 0; nb < 2; ++nb) oc[nb] = __builtin_amdgcn_mfma_f32_16x16x32_bf16(PA[ks], VB[nb][ks], oc[nb], 0, 0, 0); }
#pragma unroll
            for (int ks = 0; ks < 4; ++ks) if (ks < nkp) PA[ks] = *(const bf16x8*)(pp + QC * cn + QK * ks);
#pragma unroll
            for (int mb = 0; mb < 2; ++mb)
#pragma unroll
                for (int nb = 0; nb < 2; ++nb) { S[mb][nb] *= gC;
#pragma unroll
                    for (int ks = 0; ks < 4; ++ks) S[mb][nb] = __builtin_amdgcn_mfma_f32_16x16x32_bf16(KA[mb][ks], VB[nb][ks], S[mb][nb], 0, 0, 0); }
#pragma unroll
            for (int mb = 0; mb < 2; ++mb)
#pragma unroll
                for (int ks = 0; ks < 4; ++ks) KA[mb][ks] = *(const bf16x8*)(kp + mb * 128 + KC * cn + KK * ks);
#pragma unroll
            for (int i = 0; i < 4; ++i) { float q = 0.f;
#pragma unroll
                for (int nb = 0; nb < 2; ++nb) { const float v = oc[nb][i]; q += v * v; *(LAS unsigned short*)(ost + ((4 * lq + i) * 32 + 16 * nb + l15) * 2) = (unsigned short)f2bf(v); }
                q += __shfl_xor(q, 1); q += __shfl_xor(q, 2); q += __shfl_xor(q, 4); q += __shfl_xor(q, 8);
                if (l15 == 0) ssqp[((tok0 + 16 * w + 4 * lq + i) * 4 + h) * 16 + j] = q; }
            LDS_WAIT();
            { const v4u ov = *(const LAS v4u*)(ost + lane * 16); *(v4u*)(RO + (tok0 + 16 * w + (lane >> 2)) * 2048 + h * 512 + 32 * j + (lane & 3) * 8) = ov; }
            *(LAS bf16x8*)(vl + (cur ^ 1) * 8192 + F.tid * 16) = vpre;
#pragma unroll
            for (int mb = 0; mb < 2; ++mb)
#pragma unroll
                for (int nb = 0; nb < 2; ++nb) *(LAS u32x2*)(F.lds + (cur ^ 1) * SBUF + (16 * nb + l15) * SROW + (32 * w + 16 * mb + 4 * lq) * 2) = (u32x2){cvtpk(S[mb][nb][0], S[mb][nb][1]), cvtpk(S[mb][nb][2], S[mb][nb][3])};
        }
    }
    __syncthreads();
}

namespace attn2 {
typedef float f32x16 __attribute__((ext_vector_type(16)));
typedef short s16x4 __attribute__((ext_vector_type(4)));
constexpr int NW = 8, QBLK = 32, KVBLK = 64, QB = NW * QBLK;
constexpr int QS = 1536, KS = 1536, VS = 1024, OS = 1024;
constexpr int SHM_V = KVBLK * 128 * 2, SHM_K = KVBLK * 512;
constexpr int OFF_V = 0, OFF_K = 2 * SHM_V, OFF_WS = OFF_K + 2 * SHM_K, OFF_QR = OFF_WS + NW * 64 * 4, LDS_NEED = OFF_QR + NW * 4096;
constexpr float THR2 = 8.0f * 1.4426950408889634f;
#define A2_SBAR() __builtin_amdgcn_sched_barrier(0)
__device__ __forceinline__ int v_st(int k, int c) { const int kk = (k & ~0xC) | ((k & 4) << 1) | ((k & 8) >> 1); return ((kk >> 3) * 4 + (c >> 5)) * 512 + ((kk & 7) * 32 + (c & 31)) * 2; }
__device__ __forceinline__ int v_rd_base(int lane) { return ((lane & 3) << 3) | (((lane >> 2) & 3) << 6) | (((lane >> 4) & 1) << 5) | (((lane >> 5) & 1) << 8); }
constexpr int v_rd_off(int d0, int ks, int half) { return d0 * 512 + ks * 4096 + half * 2048; }
__device__ __forceinline__ int crow(int r, int hi) { return (r & 3) + 8 * (r >> 2) + 4 * hi; }
typedef __bf16 bf16x2a_t __attribute__((ext_vector_type(2)));
__device__ __forceinline__ unsigned cvtpk(float lo, float hi) { f32x2 v = {lo, hi}; bf16x2a_t b = __builtin_convertvector(v, bf16x2a_t); return __builtin_bit_cast(unsigned, b); }
__device__ __forceinline__ bf16x8 load8(const bf16* p) { return *reinterpret_cast<const bf16x8*>(p); }
__device__ __forceinline__ void mask_tile(f32x16& p0, f32x16& p1, int dq) {
    const float NEG = -__builtin_inff();
#pragma unroll
    for (int r = 0; r < 16; ++r) { const int c = (r & 3) + 8 * (r >> 2); if (dq - c < 0) p0[r] = NEG; if (dq - c - 32 < 0) p1[r] = NEG; }
}
__device__ __forceinline__ void partialSM(f32x16& p0, f32x16& p1, float& m_reg, float& mn, float& alpha) {
    float pmax = p0[0];
#pragma unroll
    for (int r = 1; r < 16; ++r) pmax = fmaxf(pmax, p0[r]);
#pragma unroll
    for (int r = 0; r < 16; ++r) pmax = fmaxf(pmax, p1[r]);
    { auto rr = __builtin_amdgcn_permlane32_swap(__float_as_uint(pmax), __float_as_uint(pmax), false, false); pmax = fmaxf(__uint_as_float(rr[0]), __uint_as_float(rr[1])); }
    if (__builtin_expect(__all((pmax - m_reg) <= THR2), 1)) { mn = m_reg; alpha = 1.f; }
    else { mn = fmaxf(m_reg, pmax); alpha = __builtin_amdgcn_exp2f(m_reg - mn); m_reg = mn; }
#pragma unroll
    for (int r = 0; r < 16; ++r) { p0[r] -= mn; p1[r] -= mn; }
#pragma unroll
    for (int r = 0; r < 16; ++r) p0[r] = __builtin_amdgcn_exp2f(p0[r]);
}
__device__ __forceinline__ void finishSM(f32x16& p0, f32x16& p1, float alpha, float& l_reg, bf16x8& pa0, bf16x8& pa1, bf16x8& pa2, bf16x8& pa3) {
#pragma unroll
    for (int r = 0; r < 16; ++r) p1[r] = __builtin_amdgcn_exp2f(p1[r]);
    float ps = 0;
#pragma unroll
    for (int r = 0; r < 16; ++r) ps += p0[r];
#pragma unroll
    for (int r = 0; r < 16; ++r) ps += p1[r];
    { auto rr = __builtin_amdgcn_permlane32_swap(__float_as_uint(ps), __float_as_uint(ps), false, false); ps = __uint_as_float(rr[0]) + __uint_as_float(rr[1]); }
    l_reg = l_reg * alpha + ps;
#define A2_PK4(P, B_, OUT) do { unsigned a0 = cvtpk(P[B_+0], P[B_+1]), a1 = cvtpk(P[B_+2], P[B_+3]); unsigned b0 = cvtpk(P[B_+4], P[B_+5]), b1 = cvtpk(P[B_+6], P[B_+7]); \
        auto r0 = __builtin_amdgcn_permlane32_swap(a0, b0, false, false); auto r1 = __builtin_amdgcn_permlane32_swap(a1, b1, false, false); \
        v4u w = {r0[0], r1[0], r0[1], r1[1]}; OUT = __builtin_bit_cast(bf16x8, w); } while (0)
    A2_PK4(p0, 0, pa0); A2_PK4(p0, 8, pa1); A2_PK4(p1, 0, pa2); A2_PK4(p1, 8, pa3);
#undef A2_PK4
}
__device__ __forceinline__ void softmax_fixed(f32x16& p0, f32x16& p1, float& l_reg, bf16x8& pa0, bf16x8& pa1, bf16x8& pa2, bf16x8& pa3) {
#define A2_PK4(P, B_, OUT) do { unsigned a0 = cvtpk(P[B_+0], P[B_+1]), a1 = cvtpk(P[B_+2], P[B_+3]); unsigned b0 = cvtpk(P[B_+4], P[B_+5]), b1 = cvtpk(P[B_+6], P[B_+7]); \
        auto r0 = __builtin_amdgcn_permlane32_swap(a0, b0, false, false); auto r1 = __builtin_amdgcn_permlane32_swap(a1, b1, false, false); \
        v4u w = {r0[0], r1[0], r0[1], r1[1]}; OUT = __builtin_bit_cast(bf16x8, w); } while (0)
    float ps = 0;
#pragma unroll
    for (int r = 0; r < 16; ++r) { p0[r] = __builtin_amdgcn_exp2f(p0[r]); ps += p0[r]; }
    A2_PK4(p0, 0, pa0); A2_PK4(p0, 8, pa1); A2_SBAR();
#pragma unroll
    for (int r = 0; r < 16; ++r) { p1[r] = __builtin_amdgcn_exp2f(p1[r]); ps += p1[r]; }
    A2_PK4(p1, 0, pa2); A2_PK4(p1, 8, pa3);
    l_reg += ps;
#undef A2_PK4
}
template <int KB>
__device__ __forceinline__ void qkt(f32x16& p0, f32x16& p1, const char* K_lds, const char* qr_lds, int r32, int hi, const bf16x8* qr) {
    p0 = f32x16{}; p1 = f32x16{};
    const char* kbase = K_lds + KB * SHM_K + r32 * 512; const int x = r32 & 15;
#pragma unroll
    for (int d = 0; d < 12; ++d) { const char* a = kbase + ((((2 * d + hi) & 15) ^ x) << 4) + (d >= 8 ? 256 : 0);
        const bf16x8 b0 = *reinterpret_cast<const bf16x8*>(a), b1 = *reinterpret_cast<const bf16x8*>(a + 32 * 512);
        const bf16x8 q = d < 8 ? qr[d < 8 ? d : 0] : *reinterpret_cast<const bf16x8*>(qr_lds + (((d - 8) * 2 + hi) * 32 + r32) * 16);
        p0 = __builtin_amdgcn_mfma_f32_32x32x16_bf16(b0, q, p0, 0, 0, 0);
        p1 = __builtin_amdgcn_mfma_f32_32x32x16_bf16(b1, q, p1, 0, 0, 0); }
}
template <int VB>
__device__ __forceinline__ void pv_tile(f32x16* o, int vb0, bf16x8 pa0, bf16x8 pa1, bf16x8 pa2, bf16x8 pa3) {
#define A2_TRRD(dst, off) asm volatile("ds_read_b64_tr_b16 %0, %1 offset:%2" : "=&v"(dst) : "v"(vb0), "i"(off) : "memory")
#define A2_PV_D0(d0) do { s16x4 l0, l1, l2, l3, h0, h1, h2, h3; constexpr int b_ = VB * SHM_V + v_rd_off(d0, 0, 0); \
        A2_TRRD(l0, b_); A2_TRRD(h0, b_ + 2048); A2_TRRD(l1, b_ + 4096); A2_TRRD(h1, b_ + 6144); A2_TRRD(l2, b_ + 8192); A2_TRRD(h2, b_ + 10240); A2_TRRD(l3, b_ + 12288); A2_TRRD(h3, b_ + 14336); \
        asm volatile("s_waitcnt lgkmcnt(0)" ::: "memory"); A2_SBAR(); \
        o[d0] = __builtin_amdgcn_mfma_f32_32x32x16_bf16(pa0, (bf16x8){l0[0], l0[1], l0[2], l0[3], h0[0], h0[1], h0[2], h0[3]}, o[d0], 0, 0, 0); \
        o[d0] = __builtin_amdgcn_mfma_f32_32x32x16_bf16(pa1, (bf16x8){l1[0], l1[1], l1[2], l1[3], h1[0], h1[1], h1[2], h1[3]}, o[d0], 0, 0, 0); \
        o[d0] = __builtin_amdgcn_mfma_f32_32x32x16_bf16(pa2, (bf16x8){l2[0], l2[1], l2[2], l2[3], h2[0], h2[1], h2[2], h2[3]}, o[d0], 0, 0, 0); \
        o[d0] = __builtin_amdgcn_mfma_f32_32x32x16_bf16(pa3, (bf16x8){l3[0], l3[1], l3[2], l3[3], h3[0], h3[1], h3[2], h3[3]}, o[d0], 0, 0, 0); } while (0)
    A2_PV_D0(0); A2_PV_D0(1); A2_PV_D0(2); A2_PV_D0(3);
#undef A2_PV_D0
#undef A2_TRRD
}
struct BlockRef { const bf16* Q; const bf16* K; const bf16* V; bf16* O; int P0; };
struct Seam { bf16x8 qr[8]; bf16x8 st_v0, st_v1, st_k0, st_k1, st_k2; int wv; };
#define A2_VMW() asm volatile("s_waitcnt vmcnt(0)" ::: "memory")
#define A2_VMWN(n) asm volatile("s_waitcnt vmcnt(%0)" :: "i"(n) : "memory")
#define A2_SLOAD(Kp, Vp, k0) do { S.st_v0 = load8((Vp) + (size_t)((k0) + sr) * VS + sc); S.st_v1 = load8((Vp) + (size_t)((k0) + 32 + sr) * VS + sc); \
        const bf16* kp_ = (Kp) + (size_t)((k0) + krow) * KS + kc * 8; S.st_k0 = load8(kp_); S.st_k1 = load8(kp_ + 64); S.st_k2 = load8(kp_ + 128); } while (0)
#define A2_SWRITE_K(bf) do { *(bf16x8*)(K_lds + (bf) * SHM_K + kw0) = S.st_k0; *(bf16x8*)(K_lds + (bf) * SHM_K + kw1) = S.st_k1; *(bf16x8*)(K_lds + (bf) * SHM_K + kw0 + 256) = S.st_k2; } while (0)
#define A2_SWRITE_V(bf) do { *(bf16x8*)(V_lds + (bf) * SHM_V + vst0) = S.st_v0; *(bf16x8*)(V_lds + (bf) * SHM_V + vst1) = S.st_v1; } while (0)
#define A2_SWRITE(bf) do { A2_SWRITE_V(bf); A2_SWRITE_K(bf); } while (0)
#define A2_IDX const int wid = S.wv, lane = mk_lane(), tid = wid * 64 + lane, r32 = lane & 31, hi = lane >> 5; \
    const int sr = tid >> 4, sc = (tid & 15) * 8, krow = tid >> 3, kc = tid & 7, kw0 = krow * 512 + ((kc ^ (krow & 15)) << 4), kw1 = krow * 512 + (((kc + 8) ^ (krow & 15)) << 4); \
    char* V_lds = lds + OFF_V; char* K_lds = lds + OFF_K; (void)lane; (void)r32; (void)hi; (void)sr; (void)sc; (void)V_lds
__device__ __forceinline__ void attn_prime(const BlockRef& cur, char* lds, Seam& S) {
    A2_IDX;
#pragma unroll
    for (int d0 = 0; d0 < 8; ++d0) S.qr[d0] = load8(cur.Q + (size_t)(wid * QBLK + r32) * QS + d0 * 16 + hi * 8);
    A2_SLOAD(cur.K, cur.V, 0); A2_VMW(); A2_SWRITE_K(0);
}
__device__ __forceinline__ void attn_block(const BlockRef& cur, const BlockRef& nxt, char* lds, Seam& S) {
    A2_IDX;
    const int NT = (cur.P0 + QB) / KVBLK;
    const int qlo = cur.P0 + wid * QBLK, qm = qlo + r32 - 4 * hi;
    float* ws = (float*)(lds + OFF_WS) + wid * 64; float* li_l = ws;
    char* qr_lds = lds + OFF_QR + wid * 4096;
    float l_reg = 0; f32x16 o[4] = {};
    const int vst0 = v_st(sr, sc), vst1 = v_st(32 + sr, sc);
    const int vb0 = (int)(uintptr_t)V_lds + v_rd_base(lane);
    const bf16* Kh = cur.K; const bf16* Vh = cur.V;
    { bf16x8 t4[4];
#pragma unroll
      for (int d = 0; d < 4; ++d) t4[d] = load8(cur.Q + (size_t)(wid * QBLK + r32) * QS + 128 + d * 16 + hi * 8);
#pragma unroll
      for (int d = 0; d < 4; ++d) *(bf16x8*)(qr_lds + ((d * 2 + hi) * 32 + r32) * 16) = t4[d]; }
    A2_SWRITE_V(0);
    __syncthreads();
    f32x16 p0, p1; bf16x8 pa0, pa1, pa2, pa3;
#define A2_STEP(t, BUF) do { const bool lastt = (t) + 1 >= NT; \
        A2_SBAR(); { const bf16* Kn = lastt ? nxt.K : Kh; const bf16* Vn = lastt ? nxt.V : Vh; const int k0n = lastt ? 0 : ((t) + 1) * KVBLK; A2_SLOAD(Kn, Vn, k0n); } A2_SBAR(); \
        qkt<BUF>(p0, p1, K_lds, qr_lds, r32, hi, S.qr); \
        if (lastt) { A2_SBAR(); _Pragma("unroll") for (int d0 = 0; d0 < 8; ++d0) S.qr[d0] = load8(nxt.Q + (size_t)(wid * QBLK + r32) * QS + d0 * 16 + hi * 8); A2_SBAR(); } \
        { const int kb_ = (t) * KVBLK; if (kb_ + KVBLK - 1 > qlo) mask_tile(p0, p1, qm - kb_); } \
        softmax_fixed(p0, p1, l_reg, pa0, pa1, pa2, pa3); \
        A2_SBAR(); pv_tile<BUF>(o, vb0, pa0, pa1, pa2, pa3); A2_SBAR(); \
        if (lastt) { A2_VMWN(8); A2_SWRITE_K(0); } else { A2_VMW(); A2_SWRITE((BUF) ^ 1); } \
        __syncthreads(); } while (0)
    for (int t = 0; t < NT; t += 2) { A2_STEP(t, 0); A2_STEP(t + 1, 1); }
#undef A2_STEP
    { auto rr = __builtin_amdgcn_permlane32_swap(__float_as_uint(l_reg), __float_as_uint(l_reg), false, false); l_reg = __uint_as_float(rr[0]) + __uint_as_float(rr[1]); }
    if (hi == 0) li_l[r32] = l_reg; asm volatile("s_waitcnt lgkmcnt(0)" ::: "memory");
    float rli[16];
#pragma unroll
    for (int r = 0; r < 16; ++r) rli[r] = __builtin_amdgcn_rcpf(li_l[crow(r, hi)]);
    bf16* Ow = cur.O + (size_t)(wid * QBLK) * OS;
#pragma unroll
    for (int r = 0; r < 16; ++r) { const int orow = crow(r, hi);
#pragma unroll
        for (int d0 = 0; d0 < 4; ++d0) { const float v = o[d0][r] * rli[r]; const float vn = __shfl_xor(v, 1);
            if ((r32 & 1) == 0) *(unsigned*)(Ow + (size_t)orow * OS + d0 * 32 + r32) = cvtpk(v, vn); } }
    asm volatile("s_waitcnt lgkmcnt(0)" ::: "memory");
}
}
__device__ __forceinline__ attn2::BlockRef attn2_ref(unsigned char* ws, int v, int pass) {
    const int bh = v >> 3, b = bh >> 3, h = bh & 7, x = v & 7, qb = pass ? 15 - x : x;
    attn2::BlockRef r;
    r.Q = (const bf16*)(ws + WS_QP) + ((size_t)b * SEQ + qb * 256) * 1536 + h * 192; r.K = (const bf16*)(ws + WS_KF) + (size_t)b * SEQ * 1536 + h * 192;
    r.V = (const bf16*)(ws + WS_VV) + (size_t)b * SEQ * 1024 + h * 128; r.O = (bf16*)(ws + WS_MO) + ((size_t)b * SEQ + qb * 256) * 1024 + h * 128; r.P0 = qb * 256;
    return r;
}
__device__ __forceinline__ void attn2_run(Frame& F, char* lds) {
    int L = F.vcu; if (L >= 256) return;
    attn2::Seam S; S.wv = F.wv0; int pass = 0;
    attn2::BlockRef cur = attn2_ref(F.ws, L, 0);
    attn2::attn_prime(cur, lds, S);
    for (;;) {
        const bool more_pass = pass == 0, more_item = L + F.G < 256, last = !more_pass && !more_item;
        int passn = pass + 1, Ln = L;
        if (!more_pass) { passn = 0; Ln = more_item ? L + F.G : L; }
        const attn2::BlockRef nxt = last ? cur : attn2_ref(F.ws, Ln, passn);
        attn2::attn_block(cur, nxt, lds, S);
        if (last) break;
        cur = nxt; pass = passn; L = Ln;
    }
}
__device__ __forceinline__ void phase_attn_slow(Frame& F) {
    const bf16* QP = (const bf16*)(F.ws + WS_QP); const bf16* VV = (const bf16*)(F.ws + WS_VV); const bf16* KF = (const bf16*)(F.ws + WS_KF); bf16* MO = (bf16*)(F.ws + WS_MO);
    int t_ = F.wv0 * 64 + mk_lane();
    const int lane = t_ & 63, w = F.wv0, l31 = lane & 31, hi = lane >> 5;
    LAS unsigned char* vst = F.lds + w * 9216; LAS float* al = (LAS float*)(vst + 8704); LAS float* li = al + 32;
    constexpr int VROW = 272;
    const int trb = (4 * hi + ((lane & 15) >> 2)) * VROW + (16 * ((lane >> 4) & 1) + 4 * (lane & 3)) * 2;
    for (int v = F.vcu; v < 256; v += F.G) {
#pragma unroll 1
        for (int half = 0; half < 2; ++half) {
            const int qb = half == 0 ? 15 - (v >> 5) : (v >> 5), bh = v & 31, b = bh >> 3, h = bh & 7;
            const int q0 = qb * 256 + 32 * w; const size_t tb = (size_t)b * SEQ;
            bf16x8 qr[12];
#pragma unroll
            for (int d = 0; d < 12; ++d) qr[d] = *(const bf16x8*)(QP + (tb + q0 + l31) * 1536 + h * 192 + 16 * d + 8 * hi);
            float m_run = -1e30f, l_run = 0.f; attn2::f32x16 o[4] = {};
            const int nkt = q0 / 32 + 1;
#pragma unroll 1
            for (int kt = 0; kt < nkt; ++kt) {
                const int k0 = kt * 32;
#pragma unroll
                for (int i = 0; i < 4; ++i) { const int idx = lane + 64 * i, row = idx >> 3, ch = idx & 7;
                    const v4u v0 = *(const v4u*)(VV + (tb + k0 + row) * 1024 + h * 128 + ch * 16), v1 = *(const v4u*)(VV + (tb + k0 + row) * 1024 + h * 128 + ch * 16 + 8);
                    *(LAS v4u*)(vst + row * VROW + ch * 32) = v0; *(LAS v4u*)(vst + row * VROW + ch * 32 + 16) = v1; }
                attn2::f32x16 p = {};
#pragma unroll
                for (int d = 0; d < 12; ++d) { const bf16x8 kf = *(const bf16x8*)(KF + (tb + k0 + l31) * 1536 + h * 192 + 16 * d + 8 * hi); p = __builtin_amdgcn_mfma_f32_32x32x16_bf16(kf, qr[d], p, 0, 0, 0); }
                if (kt == nkt - 1) {
#pragma unroll
                    for (int r = 0; r < 16; ++r) if (attn2::crow(r, hi) > l31) p[r] = -__builtin_inff();
                }
                float pmax = p[0];
#pragma unroll
                for (int r = 1; r < 16; ++r) pmax = fmaxf(pmax, p[r]);
                pmax = fmaxf(pmax, __shfl_xor(pmax, 32));
                const float mn = fmaxf(m_run, pmax), alpha = __builtin_amdgcn_exp2f(m_run - mn); m_run = mn;
                float ps = 0.f;
#pragma unroll
                for (int r = 0; r < 16; ++r) { p[r] = __builtin_amdgcn_exp2f(p[r] - mn); ps += p[r]; }
                ps += __shfl_xor(ps, 32); l_run = l_run * alpha + ps;
                if (hi == 0) al[l31] = alpha;
                const bf16x8 pa0 = pack8f(p, 0), pa1 = pack8f(p, 8);
                LDS_WAIT();
#pragma unroll
                for (int r = 0; r < 16; ++r) { const float a_ = al[attn2::crow(r, hi)];
#pragma unroll
                    for (int db = 0; db < 4; ++db) o[db][r] *= a_; }
#pragma unroll
                for (int db = 0; db < 4; ++db)
#pragma unroll
                    for (int s2 = 0; s2 < 2; ++s2) { LAS unsigned char* ap = vst + trb + (16 * s2) * VROW + db * 64;
                        const v4i16_t lo = __builtin_amdgcn_ds_read_tr16_b64_v4i16((LAS v4i16_t*)ap), hh = __builtin_amdgcn_ds_read_tr16_b64_v4i16((LAS v4i16_t*)(ap + 8 * VROW));
                        const bf16x8 bfv = (bf16x8){lo[0], lo[1], lo[2], lo[3], hh[0], hh[1], hh[2], hh[3]};
                        o[db] = __builtin_amdgcn_mfma_f32_32x32x16_bf16(s2 == 0 ? pa0 : pa1, bfv, o[db], 0, 0, 0); }
                LDS_WAIT();
            }
            if (hi == 0) li[l31] = l_run;
            LDS_WAIT();
#pragma unroll
            for (int r = 0; r < 16; ++r) { const float il = 1.0f / li[attn2::crow(r, hi)];
#pragma unroll
                for (int db = 0; db < 4; ++db) MO[(tb + q0 + attn2::crow(r, hi)) * 1024 + h * 128 + 32 * db + l31] = (bf16)f2bf(o[db][r] * il); }
            LDS_WAIT();
        }
    }
}
__device__ __forceinline__ void phase_attn2(Frame& F, char* lds) {
    const float bound = *(const float*)(F.ws + WS_SMALL + SM_BOUND);
    if (bound <= 40.0f) attn2_run(F, lds); else phase_attn_slow(F);
}

static_assert(pg8::EpiInProj::O_RSTDX == WS_SMALL + SM_RSTDX && pg8::EpiInProj::O_SSQ_LAT == WS_SMALL + SM_SSQ_CQ && pg8::EpiInProj::O_SSQ_KR == WS_SMALL + SM_SSQ_KR && pg8::EpiInProj::O_CS == WS_CS && pg8::EpiInProj::O_CSM == WS_CSM && pg8::EpiInProj::O_RQ == WS_RQ && pg8::EpiInProj::O_RK == WS_RK && pg8::EpiInProj::O_RKDT == WS_RKDT && pg8::EpiInProj::O_RVT == WS_RVT && pg8::EpiInProj::O_LAT == WS_LAT && pg8::EpiInProj::O_KR == WS_KR, "EpiInProj offsets");
static_assert(pg8::EpiKVup::O_KF == WS_KF && pg8::EpiKVup::O_VV == WS_VV && pg8::EpiKVup::O_KR == WS_KR && pg8::EpiKVup::O_SSQ_CKV == WS_SMALL + SM_SSQ_CKV && pg8::EpiKVup::O_SSQ_KR == WS_SMALL + SM_SSQ_KR, "EpiKVup offsets");
#ifndef MK_N_LAUNCHES
#define MK_N_LAUNCHES 12
#endif
constexpr int N_PHASES = 12;
constexpr int N_LAUNCHES = MK_N_LAUNCHES;
struct Args { const float* in[21]; float* out; unsigned char* ws; int ph_lo, ph_hi; };
#ifndef PG8_SP2
#define PG8_SP2 true
#endif
#define PG8_ALIGN true
template <class Epi> __device__ __forceinline__ void run_gemm(Frame& F, const pg8::bf16_t* A, int lda, const pg8::bf16_t* Bt, int ldb, int N, int K, const Epi& E, int c = -1, size_t gsA = 0) {
    __syncthreads();
    pg8::Gemm g{A, Bt, MTOK, N, K, lda, ldb, gsA, F.wv0}; pg8::StaticOrder S; S.init(MTOK, N, F.G, c < 0 ? (int)blockIdx.x : c);
    pg8::gemm_phase<Epi, pg8::StaticOrder, PG8_ALIGN, PG8_SP2>(F.lds + RING_OFF, g, S, E);
}
__global__ void __launch_bounds__(NWAVES * 64, 2) mk_fwd(Args args) {
    extern __shared__ __attribute__((aligned(16))) unsigned char lds[];
    Frame F;
    F.lds = (LAS unsigned char*)lds; F.MISC = (volatile LAS unsigned*)(F.lds + MISC_OFF);
    F.tid = threadIdx.x; F.lane = F.tid & 63; F.wave = __builtin_amdgcn_readfirstlane(F.tid >> 6); F.wv0 = F.wave;
    F.G = gridDim.x; { const int bx = blockIdx.x; F.vcu = (F.G % 8 == 0) ? (bx % 8) * (F.G / 8) + bx / 8 : bx; }
    F.out = args.out; F.ws = args.ws;
    if (F.tid < 32) F.MISC[F.tid] = 0u;
    __syncthreads();
    if (N_LAUNCHES == 1) (void)xcd_barrier_post((unsigned*)(args.ws + WS_CTL) + CW_BAR, F.MISC + 8);
    const int lo = args.ph_lo, hi = args.ph_hi;
    int ctile = (int)blockIdx.x;
    bool xlocal = false;
#ifndef PH_MASK
#define PH_MASK 0xfff
#endif
#define IN(k) (((PH_MASK >> (k)) & 1) && lo <= (k) && (k) < hi)
#define BAR_NOW() XcdBarrier bar_; bar_.bar = (unsigned*)(args.ws + WS_CTL) + CW_BAR; bar_.x = xb_xcc_id(); bar_.w = (unsigned)F.wv0; bar_.st = (volatile LAS unsigned*)((LAS unsigned char*)lds + MISC_OFF) + 8
#define SEAM(k) do { asm volatile("; SEAM_MARK %0" :: "i"(k)); if (IN(k) && IN((k) + 1)) { BAR_NOW(); xcd_barrier(bar_); } } while (0)
#define SEAM_L(k) do { if (IN(k) && IN((k) + 1)) { BAR_NOW(); if (xlocal) xcd_local_barrier(bar_); else xcd_barrier(bar_); } } while (0)
#ifdef SUBSTRETCH
#define SUB_T0(n) const unsigned long long ts0_##n = __builtin_amdgcn_s_memrealtime()
#define SUB_ST(n) do { if (SUBSTRETCH == (n)) { const unsigned long long t1_ = __builtin_amdgcn_s_memrealtime(); const unsigned long long d_ = t1_ - ts0_##n; while (__builtin_amdgcn_s_memrealtime() - t1_ < d_) __builtin_amdgcn_s_sleep(8); } } while (0)
#else
#define SUB_T0(n) do {} while (0)
#define SUB_ST(n) do {} while (0)
#endif
#define PH_IDX() do { int w_ = F.wv0; asm volatile("" : "+s"(w_)); const int l_ = mk_lane(); F.tid = w_ * 64 + l_; F.lane = l_; F.wave = w_; } while (0)
#ifdef STRETCH_MASK
#define PH_T0() PH_IDX(); const unsigned long long t0_ = __builtin_amdgcn_s_memrealtime()
#define PH_STRETCH(k) do { if ((STRETCH_MASK >> (k)) & 1) { const unsigned long long t1_ = __builtin_amdgcn_s_memrealtime(); const unsigned long long d_ = (t1_ - t0_) * STRETCH_MULT; while (__builtin_amdgcn_s_memrealtime() - t1_ < d_) __builtin_amdgcn_s_sleep(8); } } while (0)
#else
#define PH_T0() PH_IDX()
#define PH_STRETCH(k) do {} while (0)
#endif
#define sm ((float*)(args.ws + WS_SMALL))
#define rstdx ((const float*)(args.ws + WS_SMALL + SM_RSTDX))
#define ssq_cq ((float*)(args.ws + WS_SMALL + SM_SSQ_CQ))
#define ssq_ckv ((float*)(args.ws + WS_SMALL + SM_SSQ_CKV))
#define ssq1 ((float*)(args.ws + WS_SMALL + SM_SSQ1))
#define ssq2 ((float*)(args.ws + WS_SMALL + SM_SSQ2))
    typedef pg8::bf16_t b16;
#define WinT ((b16*)(args.ws + WS_WIN))
#define XB ((b16*)(args.ws + WS_XB))
#define LATb ((b16*)(args.ws + WS_LAT))
#define ROb ((b16*)args.out)
    if (IN(0)) { PH_T0(); phase_p0(F, args.in[0], (const int*)args.in[2], args.in[3], args.in[4], args.in[6], args.in[7], args.in[8], args.in[9], args.in[10], args.in[11]); PH_STRETCH(0); } SEAM(0);
    if (IN(1)) { PH_T0();
        pg8::EpiInProj E{args.ws, args.in[11], (PG8_LAS unsigned char*)(F.lds + XS_OFF)};
        run_gemm(F, XB, 1024, WinT + (size_t)4096 * 1024, 1024, NIN1, 1024, E);
    PH_STRETCH(1); } SEAM(1);
    if (IN(2)) { PH_T0(); phase_r0p(F);
    PH_STRETCH(2); } SEAM(2);
    if (IN(3)) { PH_T0(); phase_r1p(F); PH_STRETCH(3); } SEAM(3);
    if (IN(4)) { PH_T0();
        SUB_T0(1); { pg8::EpiRetGate E{ROb, rstdx, (const float*)(args.ws + WS_SSQP), args.in[5]}; run_gemm(F, XB, 1024, WinT + (size_t)2048 * 1024, 1024, 2048, 1024, E); } SUB_ST(1);
        asm volatile("; SEAM_MARK 41");
        SUB_T0(2); { pg8::EpiQup E{(b16*)(args.ws + WS_QP), ssq_cq, args.in[10], (const void*)(args.ws + WS_CSM), (PG8_LAS float*)(F.lds + XS_OFF), C2Q}; run_gemm(F, LATb, LATW, (const b16*)(args.ws + WS_WUQ), 384, 2048, 384, E);
#ifdef QUP_TWICE
          run_gemm(F, LATb, LATW, (const b16*)(args.ws + WS_WUQ), 384, 2048, 384, E);
#endif
        } SUB_ST(2);
        asm volatile("; SEAM_MARK 42");
        SUB_T0(3); { pg8::EpiKVup E{args.ws, args.in[11], (PG8_LAS float*)(F.lds + XS_OFF)}; run_gemm(F, LATb + 384, LATW, (const b16*)(args.ws + WS_WUKV), 256, 2048, 256, E);
#ifdef KVUP_TWICE
          run_gemm(F, LATb + 384, LATW, (const b16*)(args.ws + WS_WUKV), 256, 2048, 256, E);
#endif
        } SUB_ST(3);
    PH_STRETCH(4); } SEAM(4);
    if (IN(5)) { PH_T0(); phase_attn2(F, (char*)lds); PH_STRETCH(5); } SEAM(5);
    if (IN(6)) { PH_T0();
        phase_late_weights(F, args.in[1], args.in[12], args.in[13], args.in[14], args.in[15], args.in[16], args.in[17], args.in[18], args.in[19], args.in[20]);
        { pg8::EpiRowAct<1> E{(b16*)(args.ws + WS_SG), 2048, rstdx, 0.f, (unsigned)(WS_BLK / 2)}; run_gemm(F, XB, 1024, WinT, 1024, 2048, 1024, E); }
    PH_STRETCH(6); } SEAM(6);
#ifndef NO_XLOCAL
    if (N_LAUNCHES == 1 && IN(7)) {
        if (F.tid == 0) { unsigned ok = (F.G == 256) ? 1u : 0u;
            for (unsigned j = 0; j < 16; ++j) { const unsigned c = xb_ld((unsigned*)(args.ws + WS_CTL) + CW_BAR + XB_XCNT(j)); ok &= (j < 8 ? (c == 32u) : (c == 0u)) ? 1u : 0u; }
            F.MISC[12] = ok; }
        __syncthreads();
        xlocal = F.MISC[12] != 0u; if (xlocal) ctile = (int)(F.MISC[10] * 8u + xb_xcc_id());
    }
#endif
    if (IN(7)) { PH_T0();
        { pg8::EpiGateMix<0> E{(b16*)(args.ws + WS_TM), (const b16*)(args.ws + WS_SG), 0}; run_gemm(F, ROb, 2048, (const b16*)(args.ws + WS_WBR), 2048, 1024, 2048, E, ctile); }
        VM_WAIT(); __syncthreads(); __builtin_amdgcn_fence(__ATOMIC_ACQUIRE, "agent"); VM_WAIT(); __syncthreads();
        { pg8::EpiGateMix<1> E{(b16*)(args.ws + WS_TM), (const b16*)(args.ws + WS_SG), 1024}; run_gemm(F, (const b16*)(args.ws + WS_MO), 1024, (const b16*)(args.ws + WS_WBM), 1024, 1024, 1024, E, ctile); }
    PH_STRETCH(7); } SEAM_L(7);
    if (IN(8)) { PH_T0(); pg8::EpiResid<false> E{(const void*)args.in[0], XB, ssq1}; run_gemm(F, (const b16*)(args.ws + WS_TM), 1024, (const b16*)(args.ws + WS_WO), 1024, 1024, 1024, E, ctile, WS_BLK); PH_STRETCH(8); } SEAM_L(8);
    if (IN(9)) { PH_T0(); pg8::EpiRowAct<2> E{(b16*)(args.ws + WS_H), 4096, ssq1, 1.0f / 1024.0f, 0u}; run_gemm(F, XB, 1024, (const b16*)(args.ws + WS_WUP), 1024, 4096, 1024, E, ctile); PH_STRETCH(9); } SEAM_L(9);
    if (IN(10)) { PH_T0(); pg8::EpiResid<true> E{(const void*)XB, XB, ssq2}; run_gemm(F, (const b16*)(args.ws + WS_H), 4096, (const b16*)(args.ws + WS_WDOWN), 4096, 1024, 4096, E, ctile); PH_STRETCH(10); } SEAM_L(10);
    if (IN(11)) { PH_T0();
        { pg8::EpiRowAct<1> E{(b16*)(args.ws + WS_GT), 1024, ssq2, 1.0f / 1024.0f, 0u}; run_gemm(F, XB, 1024, (const b16*)(args.ws + WS_WPG), 1024, 1024, 1024, E, ctile); }
        VM_WAIT(); __syncthreads(); __builtin_amdgcn_fence(__ATOMIC_ACQUIRE, "agent"); VM_WAIT(); __syncthreads();
        { pg8::EpiFinal E{args.out, (const b16*)(args.ws + WS_GT), XB}; run_gemm(F, (const b16*)(args.ws + WS_PB), 256, (const b16*)(args.ws + WS_WPLE), 256, 1024, 256, E, ctile); }
    PH_STRETCH(11); }
#undef IN
#undef sm
#undef rstdx
#undef ssq_cq
#undef ssq_ckv
#undef ssq1
#undef ssq2
#undef WinT
#undef XB
#undef LATb
#undef ROb
#undef SEAM
}


#ifdef DUMPK
struct DumpArgs { const unsigned* reg[6]; unsigned nw[6]; unsigned* out; int own; int pad; };
__global__ void dump_hash(DumpArgs d) {
    for (unsigned i = blockIdx.x * blockDim.x + threadIdx.x; i < (unsigned)MTOK * DM; i += gridDim.x * blockDim.x) {
        float s = 0.f;
        if (d.own) { const unsigned w = d.out[i]; s += __uint_as_float(w << 16) + __uint_as_float(w & 0xffff0000u); }
        for (int r = 0; r < 6; ++r) if (d.reg[r] && i < d.nw[r] * 2u) { const unsigned short v = ((const unsigned short*)d.reg[r])[i]; s += __uint_as_float((unsigned)v << 16); }
        ((float*)d.out)[i] = s;
    }
}
#endif
extern "C" void kernel_launch(void* const* d_in, const int* in_sizes, int n_in, void* d_out, int out_size, void* d_ws, size_t ws_size, hipStream_t stream) {
    static int grid = 0;
    if (grid == 0) {
        if (n_in != 21 || in_sizes[0] != MTOK * DM || out_size != MTOK * DM || ws_size < WS_END) { fprintf(stderr, "kernel_launch: unexpected shapes (n_in %d in0 %d out %d ws %zu)\n", n_in, n_in > 0 ? in_sizes[0] : -1, out_size, ws_size); grid = -1; return; }
        int dev = 0, cus = 0, per_cu = 0;
        if (hipGetDevice(&dev) != hipSuccess || hipDeviceGetAttribute(&cus, hipDeviceAttributeMultiprocessorCount, dev) != hipSuccess) { grid = -1; return; }
        if (hipFuncSetAttribute((const void*)mk_fwd, hipFuncAttributeMaxDynamicSharedMemorySize, LDS_BYTES) != hipSuccess) { fprintf(stderr, "kernel_launch: hipFuncSetAttribute failed\n"); grid = -1; return; }
        if (hipOccupancyMaxActiveBlocksPerMultiprocessor(&per_cu, (const void*)mk_fwd, NWAVES * 64, LDS_BYTES) != hipSuccess || per_cu < 1) { fprintf(stderr, "kernel_launch: occupancy query says %d workgroups per CU\n", per_cu); (void)hipGetLastError(); grid = -1; return; }
        grid = cus;
    }
    if (grid < 0) return;
    (void)hipMemsetAsync((char*)d_ws + WS_CTL, 0, CTL_ZERO_BYTES, stream);
    Args a{};
    for (int i = 0; i < 21; ++i) a.in[i] = (const float*)d_in[i];
    a.out = (float*)d_out; a.ws = (unsigned char*)d_ws;
    if (N_LAUNCHES == 1) { a.ph_lo = 0; a.ph_hi = N_PHASES; hipLaunchKernelGGL(mk_fwd, dim3(grid), dim3(NWAVES * 64), LDS_BYTES, stream, a); }
    else for (int ph = 0; ph < N_PHASES; ++ph) {
#ifdef DUMPK
        if (ph > DUMPK) break;
#endif
        a.ph_lo = ph; a.ph_hi = ph + 1; hipLaunchKernelGGL(mk_fwd, dim3(grid), dim3(NWAVES * 64), LDS_BYTES, stream, a); }
#ifdef DUMPK
    { DumpArgs d{}; d.out = (unsigned*)d_out; d.own = DUMP_OWN; const size_t offs[6] = DUMP_OFFS; const size_t len[6] = DUMP_LENS;
      for (int r = 0; r < 6; ++r) if (len[r]) { d.reg[r] = (const unsigned*)((const char*)d_ws + offs[r]); d.nw[r] = (unsigned)(len[r] / 4); }
      hipLaunchKernelGGL(dump_hash, dim3(2048), dim3(256), 0, stream, d); }
#endif
}
```

```cpp
#define MK_N_LAUNCHES 1
#include <hip/hip_runtime.h>
#include <hip/hip_bf16.h>
#include <cstdio>
#include <cstdint>
__device__ __forceinline__ int mk_lane() { int l; asm volatile("v_mbcnt_lo_u32_b32 %0, -1, 0\n\tv_mbcnt_hi_u32_b32 %0, -1, %0" : "=v"(l)); return l; }
namespace pg8 {
#define PG8_LAS __attribute__((address_space(3)))
typedef unsigned short bf16_t;
typedef short bf16x8 __attribute__((ext_vector_type(8)));
typedef float f32x4 __attribute__((ext_vector_type(4)));
typedef unsigned u32x4 __attribute__((ext_vector_type(4)));
constexpr int BM = 256, BK = 64, HALF = 128, HTB = HALF * BK * 2  , STAGE_BYTES = 8 * HTB, NXCD = 8, WGM = 8;

__host__ __device__ __forceinline__ int lds_byte(int r, int c) { const int st = (r >> 4) * 2 + (c >> 5), rr = r & 15, cc = c & 31, ob = rr * 64 + cc * 2; return st * 1024 + (ob ^ (((ob >> 9) & 1) << 5)); }
__host__ __device__ __forceinline__ void stage_rc(int b, int& R, int& C) { const int st = b / 1024, sb = b % 1024, swz = sb ^ (((sb >> 9) & 1) << 5); R = (st >> 1) * 16 + swz / 64; C = (st & 1) * 32 + (swz % 64) / 2; }
__host__ __device__ __forceinline__ int perm32(int rho) { const int n = rho >> 4, i = rho & 15; return 8 * (i >> 2) + 4 * n + (i & 3); }

struct Unit { int pm, pn; };
struct Gemm { const bf16_t* A; const bf16_t* Bt; int M, N, K, lda, ldb; size_t gsA; int wv; };

struct StaticOrder {
    int nM, nN, nwg, G, c;
    __host__ __device__ void init(int M, int N, int G_, int c_) { nM = M / BM; nN = N / BM; nwg = nM * nN; G = G_; c = c_; }
    __host__ __device__ bool next(int i, Unit& u) const {
        const long L = (long)i * G + c; if (L >= nwg) return false;
        int wgid = (int)L; { const int q = nwg / NXCD, r = nwg % NXCD, xcd = wgid % NXCD, off = wgid / NXCD; wgid = (xcd < r ? xcd * (q + 1) : r * (q + 1) + (xcd - r) * q) + off; }
        const int nig = WGM * nN, gid = wgid / nig, fm = gid * WGM, gsz = (nM - fm) < WGM ? (nM - fm) : WGM;
        u.pm = fm + ((wgid % nig) % gsz); u.pn = (wgid % nig) / gsz; return true;
    }
    __device__ __forceinline__ void a_ready(const Unit&) const {}
    __device__ __forceinline__ void done(const Unit&) const {}
};


typedef float f32x2 __attribute__((ext_vector_type(2)));
typedef unsigned u32x2 __attribute__((ext_vector_type(2)));
typedef __bf16 bf16x2_t __attribute__((ext_vector_type(2)));
__device__ __forceinline__ unsigned cvt_pk_bf16(float lo, float hi) { f32x2 v = {lo, hi}; bf16x2_t b = __builtin_convertvector(v, bf16x2_t); return __builtin_bit_cast(unsigned, b); }
__device__ __forceinline__ float bflo(unsigned w) { return __uint_as_float(w << 16); }
__device__ __forceinline__ float bfhi(unsigned w) { return __uint_as_float(w & 0xffff0000u); }
__device__ __forceinline__ u32x4 pack8(const float (&v)[8]) { u32x4 w; w.x = cvt_pk_bf16(v[0], v[1]); w.y = cvt_pk_bf16(v[2], v[3]); w.z = cvt_pk_bf16(v[4], v[5]); w.w = cvt_pk_bf16(v[6], v[7]); return w; }
__device__ __forceinline__ void unpack8(const u32x4 w, float (&v)[8]) { v[0] = bflo(w.x); v[1] = bfhi(w.x); v[2] = bflo(w.y); v[3] = bfhi(w.y); v[4] = bflo(w.z); v[5] = bfhi(w.z); v[6] = bflo(w.w); v[7] = bfhi(w.w); }
__device__ __forceinline__ float sigmoidf_(float x) { return __builtin_amdgcn_rcpf(1.0f + __builtin_amdgcn_exp2f(-1.4426950408889634f * x)); }
constexpr float RMS_EPS_ = 1e-6f;
typedef _Float16 h2x4_t __attribute__((ext_vector_type(8)));
__device__ __forceinline__ void rope8(const void* csm, unsigned row, unsigned i0, float (&c)[8], float (&s)[8]) {
    const h2x4_t* p = (const h2x4_t*)csm + (row * 8u + (i0 >> 2)); const h2x4_t a = p[0], b = p[1];
#pragma unroll
    for (int e = 0; e < 4; ++e) { c[e] = (float)a[2 * e]; s[e] = (float)a[2 * e + 1]; c[4 + e] = (float)b[2 * e]; s[4 + e] = (float)b[2 * e + 1]; }
}
__device__ __forceinline__ void st16(bf16_t* p, const u32x4 v) {
#ifdef ST_SC1
    asm volatile("global_store_dwordx4 %0, %1, off sc1\n\ts_nop 1" :: "v"(p), "v"(v) : "memory");
#else
    *(u32x4*)p = v;
#endif
}

#define EPI_ACC8(v, ai, bj, m) float v[8]; { const f32x4 a0_ = acc[ai][bj][m][0], a1_ = acc[ai][bj][m][1]; v[0] = a0_[0]; v[1] = a0_[1]; v[2] = a0_[2]; v[3] = a0_[3]; v[4] = a1_[0]; v[5] = a1_[1]; v[6] = a1_[2]; v[7] = a1_[3]; }

__device__ __forceinline__ void xpose_store(PG8_LAS unsigned char* st, const unsigned (&pk)[4][4], bf16_t* dst, int R, int lane, int fr, int fq) {
#pragma unroll
    for (int pass = 0; pass < 2; ++pass) {
        if ((fq >> 1) == pass) {
#pragma unroll
            for (int m = 0; m < 4; ++m)
#pragma unroll
                for (int q = 0; q < 4; ++q) { const unsigned w = pk[m][q]; const int c = (fq & 1) * 8 + 2 * q;
                    *(PG8_LAS unsigned short*)(st + c * 144 + (16 * m + fr) * 2) = (unsigned short)(w & 0xffffu);
                    *(PG8_LAS unsigned short*)(st + (c + 1) * 144 + (16 * m + fr) * 2) = (unsigned short)(w >> 16); }
        }
        asm volatile("s_waitcnt lgkmcnt(0)" ::: "memory");
#pragma unroll
        for (int k = 0; k < 2; ++k) { const int idx = lane + 64 * k, c = idx & 15, ch = idx >> 4;
            const u32x4 v = *(const PG8_LAS u32x4*)(st + c * 144 + ch * 16);
            *(u32x4*)(dst + ((size_t)ch * R + pass * 16 + c) * 8) = v; }
        asm volatile("s_waitcnt lgkmcnt(0)" ::: "memory");
    }
}

struct EpiInProj {
    static constexpr bool PERM = true, AFTER_DRAIN = false, TWICE_OK = false; static __device__ __forceinline__ bool twice(const Unit& u) { return u.pn < 16; }
    unsigned char* ws; const float* k_norm; PG8_LAS unsigned char* xs;
    static constexpr size_t O_RSTDX = (size_t)1 << 20, O_SSQ_LAT = ((size_t)1 << 20) + (64 << 10), O_SSQ_KR = ((size_t)1 << 20) + (320 << 10), O_CS = (size_t)57 << 20, O_CSM = (size_t)254 << 20,
        O_RQ = (size_t)94 << 20, O_RK = (size_t)126 << 20, O_RKDT = (size_t)158 << 20, O_RVT = (size_t)190 << 20, O_LAT = (size_t)73 << 20, O_KR = ((size_t)22 << 20) + (512 << 10);
    __device__ __forceinline__ void operator()(const f32x4 (&acc)[2][2][4][2], const Unit& u, int wr, int wc, int fr, int fq) const {
        const int pn = u.pn, lane = fq * 16 + fr, wid = wr * 4 + wc;
        const float* rstdx = (const float*)(ws + O_RSTDX); const f32x4* cs = (const f32x4*)(ws + O_CS); const void* csm = (const void*)(ws + O_CSM); float* ssq_lat = (float*)(ws + O_SSQ_LAT); float* ssq_kr = (float*)(ws + O_SSQ_KR);
        bf16_t* RQ = (bf16_t*)(ws + O_RQ); bf16_t* RK = (bf16_t*)(ws + O_RK); bf16_t* RKDT = (bf16_t*)(ws + O_RKDT); bf16_t* RVT = (bf16_t*)(ws + O_RVT); bf16_t* LAT = (bf16_t*)(ws + O_LAT); bf16_t* KR = (bf16_t*)(ws + O_KR);
        PG8_LAS unsigned char* st = xs + wid * 2304;
        const int rowt = u.pm * BM + wr * 64 + fr;
        const int bidx = (u.pm * BM) >> 12, s0 = (u.pm * BM) & 4095;
        if (pn < 8) {
            const bool isk = pn >= 4; const int head = pn & 3;
            const float lg2 = __builtin_amdgcn_logf(1.0f - __builtin_amdgcn_exp2f(-5.0f - (float)head));
            bf16_t* O = isk ? RK : RQ;
#pragma unroll
            for (int ai = 0; ai < 2; ++ai) {
                unsigned pk0[4][4], pk1[4][4];
#pragma unroll
                for (int m = 0; m < 4; ++m) {
                    const int row = rowt + ai * HALF + m * 16; const float rs = rstdx[row] * (isk ? 0.0625f : 1.0f);
                    const f32x4* cp = cs + ((unsigned)row * 64u + (unsigned)(wc * 16 + fq * 4));
                    const f32x4 c0 = cp[0], c1 = cp[1], c2 = cp[2], c3 = cp[3];
                    const float cc[8] = {c0[0], c0[2], c1[0], c1[2], c2[0], c2[2], c3[0], c3[2]}, ss[8] = {c0[1], c0[3], c1[1], c1[3], c2[1], c2[3], c3[1], c3[3]};
                    EPI_ACC8(x1, ai, 0, m); EPI_ACC8(x2, ai, 1, m);
                    float o1[8], o2[8];
#pragma unroll
                    for (int e = 0; e < 8; ++e) { const float a = x1[e] * rs, b = x2[e] * rs; o1[e] = a * cc[e] - b * ss[e]; o2[e] = b * cc[e] + a * ss[e]; }
                    bf16_t* rp = O + ((((size_t)(bidx * 4 + head) * 32 + (s0 >> 7) + ai) * 32 + wc * 4 + fq) * 128 + wr * 64 + m * 16 + fr) * 8;
                    *(u32x4*)rp = pack8(o1); *(u32x4*)(rp + (size_t)16 * 128 * 8) = pack8(o2);
                    if (isk) { const float kdm = __builtin_amdgcn_exp2f((float)(127 - (wr * 64 + m * 16 + fr)) * lg2);
#pragma unroll
                        for (int q = 0; q < 4; ++q) { pk0[m][q] = cvt_pk_bf16(o1[2 * q] * kdm, o1[2 * q + 1] * kdm); pk1[m][q] = cvt_pk_bf16(o2[2 * q] * kdm, o2[2 * q + 1] * kdm); }
                    }
                }
                if (isk) {
                    bf16_t* d0 = RKDT + ((((size_t)(bidx * 4 + head) * 32 + (s0 >> 7) + ai) * 16 + wr * 8) * 256 + wc * 32) * 8;
                    xpose_store(st, pk0, d0, 256, lane, fr, fq);
                    xpose_store(st, pk1, d0 + (size_t)HALF * 8, 256, lane, fr, fq);
                }
            }
        } else if (pn < 16) {
            const int head = (pn - 8) >> 1, dvb = ((pn - 8) & 1) * 256;
#pragma unroll
            for (int ai = 0; ai < 2; ++ai)
#pragma unroll
                for (int bj = 0; bj < 2; ++bj) {
                    unsigned pk[4][4];
#pragma unroll
                    for (int m = 0; m < 4; ++m) { const float rs = rstdx[rowt + ai * HALF + m * 16]; EPI_ACC8(v, ai, bj, m);
#pragma unroll
                        for (int q = 0; q < 4; ++q) pk[m][q] = cvt_pk_bf16(v[2 * q] * rs, v[2 * q + 1] * rs); }
                    bf16_t* d0 = RVT + ((((size_t)(bidx * 4 + head) * 32 + (s0 >> 7) + ai) * 16 + wr * 8) * 512 + dvb + bj * HALF + wc * 32) * 8;
                    xpose_store(st, pk, d0, 512, lane, fr, fq);
                }
        } else if (pn < 19) {
            const int lt = pn - 16; int fqo = fq; asm volatile("" : "+v"(fqo));
#pragma unroll
            for (int ai = 0; ai < 2; ++ai)
#pragma unroll
                for (int m = 0; m < 4; ++m) { const int row = rowt + ai * HALF + m * 16; const float rs = rstdx[row];
#pragma unroll
                    for (int bj = 0; bj < 2; ++bj) { if (lt == 2 && bj == 1) continue;
                        EPI_ACC8(v, ai, bj, m); float q = 0.f;
#pragma unroll
                        for (int e = 0; e < 8; ++e) { v[e] *= rs; q += v[e] * v[e]; }
                        *(u32x4*)(LAT + ((unsigned)row * 640u + lt * 256 + bj * HALF + wc * 32 + 8 * fqo)) = pack8(v);
                        const int kind = (lt == 0) ? 0 : (lt == 1 ? (bj == 0 ? 0 : 1) : 1);
                        q += __shfl_xor(q, 16); q += __shfl_xor(q, 32); if (fq == 0) atomicAdd(ssq_lat + kind * 16384 + row, q); } }
        } else if (wc == 0) {
#pragma unroll
            for (int ai = 0; ai < 2; ++ai)
#pragma unroll
                for (int m = 0; m < 4; ++m) { const int row = rowt + ai * HALF + m * 16; const float rs = rstdx[row];
                    float q = 0.f; unsigned w1[4], w2[4]; const h2x4_t* cp = (const h2x4_t*)csm + ((unsigned)row * 8u + 2u * (unsigned)fq);
#pragma unroll
                    for (int hh = 0; hh < 2; ++hh) { const f32x4 xa = acc[ai][0][m][hh] * rs, xb = acc[ai][1][m][hh] * rs; const f32x4 ga = *(const f32x4*)(k_norm + 128 + 8 * fq + 4 * hh), gb = *(const f32x4*)(k_norm + 160 + 8 * fq + 4 * hh);
                        const h2x4_t t4 = cp[hh]; float oa[4], ob[4];
#pragma unroll
                        for (int e = 0; e < 4; ++e) { q += xa[e] * xa[e] + xb[e] * xb[e]; const float ya = xa[e] * ga[e], yb = xb[e] * gb[e], c_ = (float)t4[2 * e], s_ = (float)t4[2 * e + 1];
                            oa[e] = ya * c_ - yb * s_; ob[e] = yb * c_ + ya * s_; }
                        w1[2 * hh] = cvt_pk_bf16(oa[0], oa[1]); w1[2 * hh + 1] = cvt_pk_bf16(oa[2], oa[3]); w2[2 * hh] = cvt_pk_bf16(ob[0], ob[1]); w2[2 * hh + 1] = cvt_pk_bf16(ob[2], ob[3]); }
                    *(u32x4*)(KR + ((unsigned)row * 64u + 8u * fq)) = (u32x4){w1[0], w1[1], w1[2], w1[3]}; *(u32x4*)(KR + ((unsigned)row * 64u + 32u + 8u * fq)) = (u32x4){w2[0], w2[1], w2[2], w2[3]};
                    q += __shfl_xor(q, 16); q += __shfl_xor(q, 32); if (fq == 0) ssq_kr[row] = q;
                    asm volatile("" ::: "memory"); }
        }
    }
};

struct EpiKVup {
    static constexpr bool PERM = true, AFTER_DRAIN = false, TWICE_OK = false; static __device__ __forceinline__ bool twice(const Unit&) { return false; }
    unsigned char* ws; const float* k_norm; PG8_LAS float* xr;
    static constexpr size_t O_KF = (size_t)142 << 20, O_VV = (size_t)190 << 20, O_KR = ((size_t)22 << 20) + (512 << 10), O_SSQ_CKV = ((size_t)1 << 20) + (128 << 10), O_SSQ_KR = ((size_t)1 << 20) + (320 << 10);
    __device__ __forceinline__ void operator()(const f32x4 (&acc)[2][2][4][2], const Unit& u, int wr, int wc, int fr, int fq) const {
        const unsigned rowt = u.pm * BM + wr * 64 + fr, head = u.pn, d0 = wc * 32 + 8 * fq;
        bf16_t* KF = (bf16_t*)(ws + O_KF); bf16_t* VV = (bf16_t*)(ws + O_VV); const bf16_t* KR = (const bf16_t*)(ws + O_KR); const float* ssq_ckv = (const float*)(ws + O_SSQ_CKV); const float* ssq_kr = (const float*)(ws + O_SSQ_KR);
        float rs8[2][4], kr8[2][4];
#pragma unroll
        for (int ai = 0; ai < 2; ++ai)
#pragma unroll
            for (int m = 0; m < 4; ++m) { rs8[ai][m] = __builtin_amdgcn_rsqf(ssq_ckv[rowt + ai * HALF + m * 16] * (1.0f / 256.0f) + RMS_EPS_); kr8[ai][m] = ssq_kr[rowt + ai * HALF + m * 16]; }
#pragma unroll
        for (int ai = 0; ai < 2; ++ai)
#pragma unroll
            for (int m = 0; m < 4; ++m) { const float rs = rs8[ai][m];
                const f32x4 a0 = acc[ai][0][m][0] * rs, a1 = acc[ai][0][m][1] * rs;
                float q = (a0[0] * a0[0] + a0[1] * a0[1]) + (a0[2] * a0[2] + a0[3] * a0[3]) + (a1[0] * a1[0] + a1[1] * a1[1]) + (a1[2] * a1[2] + a1[3] * a1[3]);
                q += __shfl_xor(q, 16); q += __shfl_xor(q, 32);
                if (fq == 0) xr[(ai * HALF + wr * 64 + m * 16 + fr) * 4 + wc] = q; }
        asm volatile("s_waitcnt lgkmcnt(0)\n\ts_barrier" ::: "memory");
        const f32x4 g0 = *(const f32x4*)(k_norm + d0), g1 = *(const f32x4*)(k_norm + d0 + 4);
#pragma unroll
        for (int ai = 0; ai < 2; ++ai)
#pragma unroll
            for (int m = 0; m < 4; ++m) { const unsigned row = rowt + ai * HALF + m * 16; const float rs = rs8[ai][m];
                const f32x4 p4 = *(const PG8_LAS f32x4*)(xr + (ai * HALF + wr * 64 + m * 16 + fr) * 4);
                const float sk = __builtin_amdgcn_rsqf(((p4[0] + p4[1]) + (p4[2] + p4[3]) + kr8[ai][m]) * (1.0f / 192.0f) + RMS_EPS_), rk = rs * sk;
                { EPI_ACC8(v, ai, 0, m);
#pragma unroll
                  for (int e = 0; e < 8; ++e) v[e] *= rk * (e < 4 ? g0[e & 3] : g1[e & 3]);
                  *(u32x4*)(KF + (row * 1536u + head * 192u + d0)) = pack8(v); }
                { EPI_ACC8(v, ai, 1, m);
#pragma unroll
                  for (int e = 0; e < 8; ++e) v[e] *= rs;
                  *(u32x4*)(VV + (row * 1024u + head * 128u + d0)) = pack8(v); }
                { const u32x2 kr = *(const u32x2*)(KR + (row * 64u + 16 * wc + 4 * fq));
                  *(u32x2*)(KF + (row * 1536u + head * 192u + 128 + 16 * wc + 4 * fq)) = (u32x2){cvt_pk_bf16(bflo(kr.x) * sk, bfhi(kr.x) * sk), cvt_pk_bf16(bflo(kr.y) * sk, bfhi(kr.y) * sk)}; } }
    }
};

struct EpiQup {
    static constexpr bool PERM = true, AFTER_DRAIN = false, TWICE_OK = false; static __device__ __forceinline__ bool twice(const Unit&) { return false; }
    bf16_t* QP; const float* ssq_cq; const float* q_norm; const void* csm; PG8_LAS float* xr; float c2q;
    __device__ __forceinline__ void operator()(const f32x4 (&acc)[2][2][4][2], const Unit& u, int wr, int wc, int fr, int fq) const {
        const unsigned rowt = u.pm * BM + wr * 64 + fr, head = u.pn;
#pragma unroll
        for (int ai = 0; ai < 2; ++ai)
#pragma unroll
            for (int m = 0; m < 4; ++m) { const float rs = __builtin_amdgcn_rsqf(ssq_cq[rowt + ai * HALF + m * 16] * (1.0f / 384.0f) + RMS_EPS_);
                const f32x4 a0 = acc[ai][0][m][0] * rs, a1 = acc[ai][0][m][1] * rs, b0 = acc[ai][1][m][0] * rs, b1 = acc[ai][1][m][1] * rs;
                float q = ((a0[0] * a0[0] + a0[1] * a0[1]) + (a0[2] * a0[2] + a0[3] * a0[3])) + ((a1[0] * a1[0] + a1[1] * a1[1]) + (a1[2] * a1[2] + a1[3] * a1[3]))
                        + ((b0[0] * b0[0] + b0[1] * b0[1]) + (b0[2] * b0[2] + b0[3] * b0[3])) + ((b1[0] * b1[0] + b1[1] * b1[1]) + (b1[2] * b1[2] + b1[3] * b1[3]));
                q += __shfl_xor(q, 16); q += __shfl_xor(q, 32);
                if (fq == 0) xr[(ai * HALF + wr * 64 + m * 16 + fr) * 4 + wc] = q; }
        asm volatile("s_waitcnt lgkmcnt(0)\n\ts_barrier" ::: "memory");
        const unsigned dA = wc < 3 ? wc * 32 + 8 * fq : 128 + 8 * fq, dB = wc == 0 ? 96 + 8 * fq : 160 + 8 * fq;
        const f32x4 gA0 = *(const f32x4*)(q_norm + dA), gA1 = *(const f32x4*)(q_norm + dA + 4), gB0 = *(const f32x4*)(q_norm + dB), gB1 = *(const f32x4*)(q_norm + dB + 4);
#pragma unroll
        for (int ai = 0; ai < 2; ++ai)
#pragma unroll
            for (int m = 0; m < 4; ++m) { const unsigned row = rowt + ai * HALF + m * 16; const float rs = __builtin_amdgcn_rsqf(ssq_cq[row] * (1.0f / 384.0f) + RMS_EPS_);
                const f32x4 p4 = *(const PG8_LAS f32x4*)(xr + (ai * HALF + wr * 64 + m * 16 + fr) * 4);
                const float sc = __builtin_amdgcn_rsqf(((p4[0] + p4[1]) + (p4[2] + p4[3])) * (1.0f / 192.0f) + RMS_EPS_) * rs * c2q;
                EPI_ACC8(va, ai, 0, m); EPI_ACC8(vb, ai, 1, m);
#pragma unroll
                for (int e = 0; e < 8; ++e) { va[e] *= sc * (e < 4 ? gA0[e & 3] : gA1[e & 3]); vb[e] *= sc * (e < 4 ? gB0[e & 3] : gB1[e & 3]); }
                bf16_t* qrow = QP + (row * 1536u + head * 192u);
                if (wc == 3) {
                    float cc[8], sn[8]; rope8(csm, row, 8 * fq, cc, sn);
#pragma unroll
                    for (int e = 0; e < 8; ++e) { const float a_ = va[e], b_ = vb[e]; va[e] = a_ * cc[e] - b_ * sn[e]; vb[e] = b_ * cc[e] + a_ * sn[e]; }
                }
                *(u32x4*)(qrow + dA) = pack8(va);
                if (wc == 0 || wc == 3) *(u32x4*)(qrow + dB) = pack8(vb); }
    }
};

template <int MODE> struct EpiRowAct {
    static constexpr bool PERM = true, AFTER_DRAIN = false, TWICE_OK = false; static __device__ __forceinline__ bool twice(const Unit&) { return true; }
    bf16_t* O; int ldo; const float* rsrc; float inv_dim; unsigned gso;
    __device__ __forceinline__ void operator()(const f32x4 (&acc)[2][2][4][2], const Unit& u, int wr, int wc, int fr, int fq) const {
        const int rowt = u.pm * BM + wr * 64 + fr, colt = u.pn * BM + wc * 32 + 8 * fq;
#pragma unroll
        for (int ai = 0; ai < 2; ++ai)
#pragma unroll
            for (int m = 0; m < 4; ++m) { const int row = rowt + ai * HALF + m * 16; const float r0 = rsrc[row]; const float rs = inv_dim == 0.f ? r0 : __builtin_amdgcn_rsqf(r0 * inv_dim + RMS_EPS_);
#pragma unroll
                for (int bj = 0; bj < 2; ++bj) { EPI_ACC8(v, ai, bj, m);
#pragma unroll
                    for (int e = 0; e < 8; ++e) { float x = v[e] * rs; if (MODE == 1) x = sigmoidf_(x); if (MODE == 2) { x = fmaxf(x, 0.f); x = x * x; } v[e] = x; }
                    st16(O + (gso ? (size_t)(row >> 11) * gso + (size_t)(row & 2047) * ldo : (size_t)row * ldo) + colt + bj * HALF, pack8(v)); } }
    }
};
struct EpiRetGate {
    static constexpr bool PERM = true, AFTER_DRAIN = false, TWICE_OK = false; static __device__ __forceinline__ bool twice(const Unit&) { return false; }
    bf16_t* RO; const float* rstdx; const float* ssq_ro; const float* ret_norm;
    __device__ __forceinline__ void operator()(const f32x4 (&acc)[2][2][4][2], const Unit& u, int wr, int wc, int fr, int fq) const {
        const int rowt = u.pm * BM + wr * 64 + fr, colt = u.pn * BM + wc * 32 + 8 * fq, head = u.pn >> 1;
        f32x4 g[2][2];
#pragma unroll
        for (int bj = 0; bj < 2; ++bj) { g[bj][0] = *(const f32x4*)(ret_norm + colt + bj * HALF); g[bj][1] = *(const f32x4*)(ret_norm + colt + bj * HALF + 4); }
#pragma unroll
        for (int ai = 0; ai < 2; ++ai)
#pragma unroll
            for (int m = 0; m < 4; ++m) { const int row = rowt + ai * HALF + m * 16; const float rs = rstdx[row]; const f32x4* sp = (const f32x4*)(ssq_ro + ((size_t)row * 4 + head) * 16); const f32x4 s4 = (sp[0] + sp[1]) + (sp[2] + sp[3]);
                const float rr = __builtin_amdgcn_rsqf(((s4[0] + s4[1]) + (s4[2] + s4[3])) * (1.0f / 512.0f) + RMS_EPS_);
#pragma unroll
                for (int bj = 0; bj < 2; ++bj) { EPI_ACC8(v, ai, bj, m); bf16_t* p = RO + (size_t)row * 2048 + colt + bj * HALF; float o[8]; unpack8(*(const u32x4*)p, o);
#pragma unroll
                    for (int e = 0; e < 8; ++e) { const float x = v[e] * rs; const float gg = e < 4 ? g[bj][0][e & 3] : g[bj][1][e & 3]; v[e] = o[e] * rr * gg * x * sigmoidf_(x); }
                    *(u32x4*)p = pack8(v); } }
    }
};
template <int MODE> struct EpiGateMix {
    static constexpr bool PERM = true, AFTER_DRAIN = false, TWICE_OK = false; static __device__ __forceinline__ bool twice(const Unit&) { return false; }
    bf16_t* TM; const bf16_t* SG; int sgoff; static constexpr size_t BLKE = (size_t)8 << 20;
    __device__ __forceinline__ void operator()(const f32x4 (&acc)[2][2][4][2], const Unit& u, int wr, int wc, int fr, int fq) const {
        const int rowt = u.pm * BM + wr * 64 + fr, colt = u.pn * BM + wc * 32 + 8 * fq;
#pragma unroll
        for (int ai = 0; ai < 2; ++ai)
#pragma unroll
            for (int m = 0; m < 4; ++m) { const int row = rowt + ai * HALF + m * 16;
#pragma unroll
                for (int bj = 0; bj < 2; ++bj) { EPI_ACC8(v, ai, bj, m); float s[8]; unpack8(*(const u32x4*)(SG + (size_t)(row >> 11) * BLKE + (size_t)(row & 2047) * 2048 + sgoff + colt + bj * HALF), s);
                    bf16_t* p = TM + (size_t)(row >> 11) * BLKE + (size_t)(row & 2047) * 1024 + colt + bj * HALF;
                    if (MODE == 1) { float t[8]; unpack8(*(const u32x4*)p, t);
#pragma unroll
                        for (int e = 0; e < 8; ++e) v[e] = t[e] + s[e] * v[e]; }
                    else {
#pragma unroll
                        for (int e = 0; e < 8; ++e) v[e] = s[e] * v[e]; }
                    *(u32x4*)p = pack8(v); } }
    }
};
template <bool RESB> struct EpiResid {
    static constexpr bool PERM = true, AFTER_DRAIN = false, TWICE_OK = false; static __device__ __forceinline__ bool twice(const Unit&) { return false; }
    const void* res; bf16_t* xb; float* ssq;
    __device__ __forceinline__ void operator()(const f32x4 (&acc)[2][2][4][2], const Unit& u, int wr, int wc, int fr, int fq) const {
        const int rowt = u.pm * BM + wr * 64 + fr, colt = u.pn * BM + wc * 32 + 8 * fq;
#pragma unroll
        for (int ai = 0; ai < 2; ++ai)
#pragma unroll
            for (int m = 0; m < 4; ++m) { const int row = rowt + ai * HALF + m * 16; float q = 0.f;
#pragma unroll
                for (int bj = 0; bj < 2; ++bj) { EPI_ACC8(v, ai, bj, m); const size_t off = (size_t)row * 1024 + colt + bj * HALF;
                    if (RESB) { float r[8]; unpack8(*(const u32x4*)((const bf16_t*)res + off), r);
#pragma unroll
                        for (int e = 0; e < 8; ++e) { v[e] += r[e]; q += v[e] * v[e]; } }
                    else { const f32x4 r0 = *(const f32x4*)((const float*)res + off), r1 = *(const f32x4*)((const float*)res + off + 4);
#pragma unroll
                        for (int e = 0; e < 8; ++e) { v[e] += e < 4 ? r0[e & 3] : r1[e & 3]; q += v[e] * v[e]; } }
                    *(u32x4*)(xb + off) = pack8(v); }
                q += __shfl_xor(q, 16); q += __shfl_xor(q, 32); if (fq == 0) atomicAdd(ssq + row, q);
                if (m & 1) asm volatile("" ::: "memory"); }
    }
};
struct EpiFinal {
    static constexpr bool PERM = true, AFTER_DRAIN = false, TWICE_OK = false; static __device__ __forceinline__ bool twice(const Unit&) { return false; }
    float* out; const bf16_t* GT; const bf16_t* xb;
    __device__ __forceinline__ void operator()(const f32x4 (&acc)[2][2][4][2], const Unit& u, int wr, int wc, int fr, int fq) const {
        const int rowt = u.pm * BM + wr * 64 + fr, colt = u.pn * BM + wc * 32 + 8 * fq;
#pragma unroll
        for (int ai = 0; ai < 2; ++ai)
#pragma unroll
            for (int m = 0; m < 4; ++m) { const int row = rowt + ai * HALF + m * 16;
#pragma unroll
                for (int bj = 0; bj < 2; ++bj) { EPI_ACC8(v, ai, bj, m); const size_t off = (size_t)row * 1024 + colt + bj * HALF; float gt[8], r[8]; unpack8(*(const u32x4*)(GT + off), gt); unpack8(*(const u32x4*)(xb + off), r);
#pragma unroll
                    for (int e = 0; e < 8; ++e) v[e] = r[e] + gt[e] * v[e];
                    *(f32x4*)(out + off) = (f32x4){v[0], v[1], v[2], v[3]}; *(f32x4*)(out + off + 4) = (f32x4){v[4], v[5], v[6], v[7]}; }
                if (m & 1) asm volatile("" ::: "memory"); }
    }
};
template <class Epi, class Sched, bool ALIGN_EPI = false, bool SP2 = false>
__device__ __forceinline__ void gemm_phase(PG8_LAS unsigned char* lds, const Gemm g, const Sched& S, const Epi& E) {
    int tid = g.wv * 64 + mk_lane();
    const int wid = __builtin_amdgcn_readfirstlane(tid >> 6), lane = tid & 63, wr = wid >> 2, wc = wid & 3, fr = lane & 15, fq = lane >> 4;
    int K = g.K; if (g.K < 512) asm volatile("" : "+s"(K));
    const int nt = K / BK;
    unsigned voffA[2], voffB[2];
#pragma unroll
    for (int i = 0; i < 2; ++i) { int R, C; stage_rc(tid * 16 + i * 8192, R, C); const int Rb = Epi::PERM ? ((R & ~31) + perm32(R & 31)) : R;
        voffA[i] = (unsigned)(R * g.lda + C) * 2u; voffB[i] = (unsigned)(Rb * g.ldb + C) * 2u; }
    const size_t kstep = (size_t)(BK * 2);
    const size_t hstepA = (size_t)HALF * g.lda * 2, hstepB = (size_t)HALF * g.ldb * 2;
    const size_t tstepA = 2 * hstepA, tstepB = 2 * hstepB;
    const unsigned ldsw = (unsigned)wid * 1024u;
    const int aoff = lds_byte(wr * 64 + fr, fq * 8), boff = lds_byte(wc * 32 + fr, fq * 8);
#define PG8_SA(b, h) (((b) * 2 + (h)) * HTB)
#define PG8_SB(b, h) ((4 + (b) * 2 + (h)) * HTB)
#define PG8_STAGE(bufoff, gbase, voff) do { _Pragma("unroll") for (int _i = 0; _i < 2; ++_i) \
        __builtin_amdgcn_global_load_lds((const unsigned*)((const char*)(gbase) + (voff)[_i]), (PG8_LAS unsigned*)(lds + (bufoff) + ldsw + _i * 8192), 16, 0, 0); } while (0)
#define PG8_LDA(dst, b, h) do { _Pragma("unroll") for (int m = 0; m < 4; ++m) _Pragma("unroll") for (int k = 0; k < 2; ++k) dst[m][k] = *(const PG8_LAS bf16x8*)(lds + PG8_SA(b, h) + aoff + m * 2048 + k * 1024); } while (0)
#define PG8_LDB(dst, b, h) do { _Pragma("unroll") for (int n = 0; n < 2; ++n) _Pragma("unroll") for (int k = 0; k < 2; ++k) dst[n][k] = *(const PG8_LAS bf16x8*)(lds + PG8_SB(b, h) + boff + n * 2048 + k * 1024); } while (0)
#define PG8_MMA(ai, bj, At, Bt) do { __builtin_amdgcn_s_setprio(1); _Pragma("unroll") for (int m = 0; m < 4; ++m) _Pragma("unroll") for (int n = 0; n < 2; ++n) _Pragma("unroll") for (int k = 0; k < 2; ++k) \
        acc[ai][bj][m][n] = __builtin_amdgcn_mfma_f32_16x16x32_bf16(Bt[n][k], At[m][k], acc[ai][bj][m][n], 0, 0, 0); __builtin_amdgcn_s_setprio(0); } while (0)
#define PG8_WAIT_V(n) asm volatile("s_waitcnt vmcnt(" #n ")" ::: "memory")
#define PG8_WAIT_L(n) asm volatile("s_waitcnt lgkmcnt(" #n ")" ::: "memory")
#define PG8_BAR __builtin_amdgcn_s_barrier()
#define PG8_SCHED __builtin_amdgcn_sched_barrier(0)
    Unit cur, nxt; int ui = 0;
    if (!S.next(0, cur)) return;
    f32x4 acc[2][2][4][2];
#pragma unroll
    for (int a = 0; a < 2; ++a)
#pragma unroll
        for (int b = 0; b < 2; ++b)
#pragma unroll
            for (int m = 0; m < 4; ++m)
#pragma unroll
                for (int n = 0; n < 2; ++n) acc[a][b][m][n] = (f32x4){0.f, 0.f, 0.f, 0.f};
    bf16x8 At[4][2], B0[2][2], B1[2][2];
#define PG8_AROW(pm_) ((const char*)g.A + (g.gsA ? (size_t)((pm_) >> 3) * g.gsA + (size_t)((pm_) & 7) * tstepA : (size_t)(pm_) * tstepA))
    const char* cA = PG8_AROW(cur.pm); const char* cB = (const char*)g.Bt + (size_t)cur.pn * tstepB;
    S.a_ready(cur);
    if constexpr (SP2) {
        PG8_STAGE(PG8_SB(0, 0), cB, voffB); PG8_STAGE(PG8_SB(0, 1), cB + hstepB, voffB); PG8_STAGE(PG8_SA(0, 0), cA, voffA); PG8_STAGE(PG8_SA(0, 1), cA + hstepA, voffA);
        if (wr == 1) PG8_BAR;
        PG8_WAIT_V(2); PG8_BAR;
        PG8_STAGE(PG8_SB(1, 0), cB + kstep, voffB); PG8_STAGE(PG8_SA(1, 0), cA + kstep, voffA); PG8_STAGE(PG8_SB(1, 1), cB + hstepB + kstep, voffB);
        PG8_WAIT_V(6); PG8_BAR;
    } else {
        PG8_STAGE(PG8_SB(0, 0), cB, voffB); PG8_STAGE(PG8_SA(0, 0), cA, voffA); PG8_STAGE(PG8_SB(0, 1), cB + hstepB, voffB); PG8_STAGE(PG8_SA(0, 1), cA + hstepA, voffA);
        if (wr == 1) PG8_BAR;
        PG8_WAIT_V(4); PG8_BAR;
        PG8_STAGE(PG8_SB(1, 0), cB + kstep, voffB); PG8_STAGE(PG8_SA(1, 0), cA + kstep, voffA); PG8_STAGE(PG8_SB(1, 1), cB + hstepB + kstep, voffB);
        PG8_WAIT_V(6); PG8_BAR;
    }
    for (;;) {
        const bool has_next = S.next(ui + 1, nxt);
        const char* nA = has_next ? PG8_AROW(nxt.pm) : cA; const char* nB = has_next ? (const char*)g.Bt + (size_t)nxt.pn * tstepB : cB;
        for (int t = 0; t < nt; t += 2) {
            const bool last = (t == nt - 2);
            const char* a1 = cA + (size_t)(t + 1) * kstep;
            const char* a2 = last ? nA : cA + (size_t)(t + 2) * kstep; const char* b2 = last ? nB : cB + (size_t)(t + 2) * kstep;
            const char* a3 = a2 + kstep; const char* b3 = b2 + kstep;
            if (last && has_next) S.a_ready(nxt);
            if constexpr (SP2) {
            PG8_LDB(B0, 0, 0); PG8_LDB(B1, 0, 1); PG8_SCHED; PG8_LDA(At, 0, 0); PG8_STAGE(PG8_SA(1, 1), a1 + hstepA, voffA);
            PG8_WAIT_V(8); PG8_WAIT_L(0); PG8_BAR; PG8_MMA(0, 0, At, B0); PG8_MMA(0, 1, At, B1); PG8_BAR; PG8_SCHED;
            PG8_LDA(At, 0, 1); PG8_STAGE(PG8_SB(0, 0), b2, voffB); PG8_STAGE(PG8_SB(0, 1), b2 + hstepB, voffB); PG8_STAGE(PG8_SA(0, 0), a2, voffA);
            PG8_WAIT_V(8); PG8_WAIT_L(0); PG8_BAR; PG8_MMA(1, 0, At, B0); PG8_MMA(1, 1, At, B1); PG8_BAR; PG8_SCHED;
            PG8_LDB(B0, 1, 0); PG8_LDB(B1, 1, 1); PG8_SCHED; PG8_LDA(At, 1, 0); PG8_STAGE(PG8_SA(0, 1), a2 + hstepA, voffA);
            PG8_WAIT_V(8); PG8_WAIT_L(0); PG8_BAR; PG8_MMA(0, 0, At, B0); PG8_MMA(0, 1, At, B1); PG8_BAR; PG8_SCHED;
            PG8_LDA(At, 1, 1); PG8_STAGE(PG8_SB(1, 0), b3, voffB); PG8_STAGE(PG8_SB(1, 1), b3 + hstepB, voffB); PG8_STAGE(PG8_SA(1, 0), a3, voffA);
            PG8_WAIT_V(8); PG8_WAIT_L(0); PG8_BAR; PG8_MMA(1, 0, At, B0); PG8_MMA(1, 1, At, B1); PG8_BAR; PG8_SCHED;
            } else {
            PG8_LDB(B0, 0, 0); PG8_SCHED; PG8_LDA(At, 0, 0); PG8_STAGE(PG8_SA(1, 1), a1 + hstepA, voffA);
            PG8_WAIT_L(8); PG8_BAR; PG8_WAIT_L(0); PG8_MMA(0, 0, At, B0); PG8_BAR; PG8_SCHED;
            PG8_LDB(B1, 0, 1); PG8_STAGE(PG8_SB(0, 0), b2, voffB);
            PG8_BAR; PG8_WAIT_L(0); PG8_MMA(0, 1, At, B1); PG8_BAR;
            PG8_LDA(At, 0, 1); PG8_STAGE(PG8_SA(0, 0), a2, voffA);
            PG8_BAR; PG8_WAIT_L(0); PG8_MMA(1, 0, At, B0); PG8_BAR; PG8_SCHED;
            PG8_STAGE(PG8_SB(0, 1), b2 + hstepB, voffB);
            PG8_WAIT_V(6); PG8_BAR; PG8_MMA(1, 1, At, B1); PG8_BAR;
            PG8_LDB(B0, 1, 0); PG8_SCHED; PG8_LDA(At, 1, 0); PG8_STAGE(PG8_SA(0, 1), a2 + hstepA, voffA);
            PG8_WAIT_L(8); PG8_BAR; PG8_WAIT_L(0); PG8_MMA(0, 0, At, B0); PG8_BAR; PG8_SCHED;
            PG8_LDB(B1, 1, 1); PG8_STAGE(PG8_SB(1, 0), b3, voffB);
            PG8_BAR; PG8_WAIT_L(0); PG8_MMA(0, 1, At, B1); PG8_BAR;
            PG8_LDA(At, 1, 1); PG8_STAGE(PG8_SA(1, 0), a3, voffA);
            PG8_BAR; PG8_WAIT_L(0); PG8_MMA(1, 0, At, B0); PG8_BAR; PG8_SCHED;
            PG8_STAGE(PG8_SB(1, 1), b3 + hstepB, voffB);
            PG8_WAIT_V(6); PG8_BAR; PG8_MMA(1, 1, At, B1); PG8_BAR;
            }
        }
        if constexpr (ALIGN_EPI) { if (wr == 0) PG8_BAR; }
        if constexpr (!Epi::AFTER_DRAIN) { E(acc, cur, wr, wc, fr, fq);
#ifdef EPI_TWICE
            if constexpr (Epi::TWICE_OK) { asm volatile("" ::: "memory"); if (Epi::twice(cur)) E(acc, cur, wr, wc, fr, fq); }
#endif
            S.done(cur); }
        if (!has_next) break;
#pragma unroll
        for (int a = 0; a < 2; ++a)
#pragma unroll
            for (int b = 0; b < 2; ++b)
#pragma unroll
                for (int m = 0; m < 4; ++m)
#pragma unroll
                    for (int n = 0; n < 2; ++n) acc[a][b][m][n] = (f32x4){0.f, 0.f, 0.f, 0.f};
        cur = nxt; cA = nA; cB = nB; ++ui;
        if constexpr (ALIGN_EPI) { if (wr == 1) PG8_BAR; }
    }
    PG8_WAIT_V(0);
    if constexpr (!ALIGN_EPI) { if (wr == 0) PG8_BAR; }
    PG8_BAR;
    if constexpr (Epi::AFTER_DRAIN) { E.fused(acc, cur, wr, wc, fr, fq, lds, wid, lane); S.done(cur); }
#undef PG8_AROW
#undef PG8_SA
#undef PG8_SB
#undef PG8_STAGE
#undef PG8_LDA
#undef PG8_LDB
#undef PG8_MMA
#undef PG8_WAIT_V
#undef PG8_WAIT_L
#undef PG8_BAR
#undef PG8_SCHED
}
}
#define GAS __attribute__((address_space(1)))
#define LAS __attribute__((address_space(3)))
typedef unsigned short bf16;
typedef unsigned v4u __attribute__((ext_vector_type(4)));
typedef float f32x4 __attribute__((ext_vector_type(4)));
typedef short bf16x8 __attribute__((ext_vector_type(8)));
typedef GAS unsigned gu32;
typedef GAS unsigned long long gu64;
#define RLX_AGENT __ATOMIC_RELAXED, __HIP_MEMORY_SCOPE_AGENT
#define LDS_WAIT() asm volatile("s_waitcnt lgkmcnt(0)" ::: "memory")
#define VM_WAIT() asm volatile("s_waitcnt vmcnt(0)" ::: "memory")
__device__ __forceinline__ unsigned long long rt() { return __builtin_amdgcn_s_memrealtime(); }
__device__ __forceinline__ unsigned f2bf(float f) { unsigned u = __builtin_bit_cast(unsigned, f); return (u + 0x7fffu + ((u >> 16) & 1u)) >> 16; }
__device__ __forceinline__ unsigned pk2(float lo, float hi) { return f2bf(lo) | (f2bf(hi) << 16); }

#define XB_TMO      128
#define XB_XCNT(j)  (256  + 64 * (j))
#define XB_XSUB(j)  (1280 + 64 * (j))
#define XB_XGEN(j)  (2304 + 64 * (j))
#define XB_TOP      3328
#define XB_TOPGEN   3392
#define XCD_BAR_WORDS 3456
#define XB_SPIN_CAP (1u << 18)

__device__ __forceinline__ unsigned xb_ld(unsigned* p)              { return __hip_atomic_load(p, __ATOMIC_RELAXED, __HIP_MEMORY_SCOPE_AGENT); }
__device__ __forceinline__ unsigned xb_add(unsigned* p, unsigned v) { return __hip_atomic_fetch_add(p, v, __ATOMIC_RELAXED, __HIP_MEMORY_SCOPE_AGENT); }
__device__ __forceinline__ unsigned xb_xcc_id() { return (unsigned)__builtin_amdgcn_s_getreg((3 << 11) | 20) & 0xFu; }
#define XB_SPIN(cond, bar) do { unsigned _sp = 0; while (cond) { __builtin_amdgcn_s_sleep(1); \
    if ((++_sp & 255u) == 0u) { if (xb_ld(&(bar)[XB_TMO])) break; if (_sp > XB_SPIN_CAP) { atomicAdd(&(bar)[XB_TMO], 1u); break; } } } } while (0)

struct XcdBarrier {
    unsigned* bar; unsigned x, w;
    volatile LAS unsigned* st;
};

__device__ __forceinline__ XcdBarrier xcd_barrier_post(unsigned* bar, volatile LAS unsigned* st) {
    XcdBarrier b; b.bar = bar; b.x = xb_xcc_id(); b.st = st;
    if (threadIdx.x == 0) st[2] = xb_add(&bar[XB_XCNT(b.x)], 1u);
    return b;
}
__device__ __forceinline__ void xcd_barrier_complete(unsigned* bar, unsigned x, unsigned& nloc, unsigned& nx) {
    const unsigned G = gridDim.x * gridDim.y * gridDim.z;
    unsigned sum, cnt, mine, sp = 0u;
    for (;;) {
        sum = 0u; cnt = 0u; mine = 0u;
#pragma unroll
        for (unsigned j = 0; j < 16; ++j) { const unsigned c = xb_ld(&bar[XB_XCNT(j)]); sum += c; cnt += (c > 0u) ? 1u : 0u; mine = (j == x) ? c : mine; }
        if (sum == G) break;
        __builtin_amdgcn_s_sleep(1);
        if ((++sp & 255u) == 0u) { if (xb_ld(&bar[XB_TMO])) break; if (sp > XB_SPIN_CAP) { atomicAdd(&bar[XB_TMO], 1u); break; } }
    }
    nloc = mine > 0u ? mine : 1u; nx = cnt > 0u ? cnt : 1u;
}

__device__ __forceinline__ void xcd_barrier(const XcdBarrier& b) {
    asm volatile("s_waitcnt vmcnt(0)" ::: "memory");
    __syncthreads();
    if ((int)b.w * 64 + mk_lane() == 0) {
        unsigned* bar = b.bar;
        __builtin_amdgcn_s_waitcnt(0);
        unsigned nloc = b.st[0], nx = b.st[1];
        if (nloc == 0u) { xcd_barrier_complete(bar, b.x, nloc, nx); b.st[0] = nloc; b.st[1] = nx; }
        const unsigned old = xb_add(&bar[XB_XSUB(b.x)], 1u);
        const unsigned gen = old / nloc;
        if (old + 1u == (gen + 1u) * nloc) {
            __builtin_amdgcn_fence(__ATOMIC_RELEASE, "agent");
            asm volatile("s_waitcnt vmcnt(0)" ::: "memory");
            const unsigned og = xb_add(&bar[XB_TOP], 1u);
            const unsigned tg = og / nx;
            if (og + 1u == (tg + 1u) * nx) xb_add(&bar[XB_TOPGEN], 1u);
            else XB_SPIN(xb_ld(&bar[XB_TOPGEN]) == tg, bar);
            __builtin_amdgcn_fence(__ATOMIC_ACQUIRE, "agent");
            xb_add(&bar[XB_XGEN(b.x)], 1u);
            asm volatile("s_waitcnt vmcnt(0)" ::: "memory");
        } else {
            XB_SPIN(xb_ld(&bar[XB_XGEN(b.x)]) == gen, bar);
            __builtin_amdgcn_fence(__ATOMIC_ACQUIRE, "agent");
            asm volatile("s_waitcnt vmcnt(0)" ::: "memory");
        }
    }
    __syncthreads();
}


#define XB_LSUB(j)  (3520 + 64 * (j))
#define XB_LGEN(j)  (4544 + 64 * (j))
#define XCD_BAR_WORDS_ALL 5632
__device__ __forceinline__ void xcd_local_barrier(const XcdBarrier& b) {
    asm volatile("s_waitcnt vmcnt(0)" ::: "memory");
    __syncthreads();
    if ((int)b.w * 64 + mk_lane() == 0) {
        unsigned* bar = b.bar; __builtin_amdgcn_s_waitcnt(0);
        const unsigned nloc = b.st[0];
        const unsigned old = xb_add(&bar[XB_LSUB(b.x)], 1u), gen = old / nloc;
        if (old + 1u == (gen + 1u) * nloc) { __builtin_amdgcn_fence(__ATOMIC_ACQUIRE, "agent"); xb_add(&bar[XB_LGEN(b.x)], 1u); asm volatile("s_waitcnt vmcnt(0)" ::: "memory"); }
        else { XB_SPIN(xb_ld(&bar[XB_LGEN(b.x)]) == gen, bar); __builtin_amdgcn_fence(__ATOMIC_ACQUIRE, "agent"); asm volatile("s_waitcnt vmcnt(0)" ::: "memory"); }
    }
    __syncthreads();
}

typedef float f32x2 __attribute__((ext_vector_type(2)));
constexpr int NWAVES = 8;
constexpr int BATCH = 4, SEQ = 4096, DM = 1024, MTOK = BATCH * SEQ;
constexpr int NIN1 = 5120;
constexpr int LATW = 640;
constexpr float C2Q = 0.07216878364870323f * 1.4426950408889634f;

constexpr size_t MiB = 1u << 20, KiB = 1u << 10;
constexpr size_t WS_CTL = 0, CTL_ZERO_BYTES = 64 * KiB;
constexpr size_t WS_SMALL = 1 * MiB;
constexpr size_t SM_RSTDX = 0, SM_SSQ_CQ = 64 * KiB, SM_SSQ_CKV = 128 * KiB, SM_SSQ1 = 192 * KiB, SM_SSQ2 = 256 * KiB, SM_SSQ_KR = 320 * KiB, SM_END = 384 * KiB, SM_BOUND = 384 * KiB;
constexpr size_t WS_WIN = 2 * MiB;
constexpr size_t WS_SSQP = 10 * MiB;
constexpr size_t WS_WUQ = 20 * MiB;
constexpr size_t WS_WUKV = WS_WUQ + (size_t)2048 * 384 * 2;
constexpr size_t WS_KR = 22 * MiB + 512 * KiB;
constexpr size_t WS_XB = 25 * MiB;
constexpr size_t WS_CS = 57 * MiB;
constexpr size_t WS_LAT = 73 * MiB;
constexpr size_t WS_RQ = 94 * MiB, WS_RK = 126 * MiB, WS_RKDT = 158 * MiB, WS_RVT = 190 * MiB;
constexpr size_t WS_QP = 94 * MiB, WS_KF = 142 * MiB, WS_VV = 190 * MiB;
constexpr size_t WS_MO = 222 * MiB;
constexpr size_t WS_BLK = 16 * MiB;
constexpr size_t WS_SG = 57 * MiB, WS_TM = 57 * MiB + 8 * MiB;
constexpr size_t WS_WBR = 190 * MiB, WS_WBM = 194 * MiB, WS_WO = 196 * MiB, WS_WUP = 198 * MiB, WS_WDOWN = 206 * MiB, WS_WPG = 214 * MiB, WS_WPLE = 18 * MiB;
constexpr size_t WS_PB = 10 * MiB;
constexpr size_t WS_H = 57 * MiB;
constexpr size_t WS_GT = 222 * MiB;
constexpr size_t WS_CSM = 254 * MiB;
constexpr size_t WS_END = 256 * MiB;
static_assert(SM_SSQ_CKV == SM_SSQ_CQ + 65536, "ssq_lat layout");
static_assert(WS_WIN + (size_t)9216 * 2048 <= WS_WUQ && WS_WUKV + (size_t)2048 * 256 * 2 <= WS_KR && WS_KR + 2 * MiB <= WS_XB && WS_LAT + 20 * MiB <= WS_RQ && WS_RVT + 64 * MiB <= WS_END && WS_H + 128 * MiB <= WS_WBR && WS_PB + 8 * MiB <= WS_WPLE && WS_WPLE + 512 * KiB <= WS_WUQ && WS_WPG + 2 * MiB <= WS_GT && WS_GT + 32 * MiB <= WS_CSM && WS_VV + 32 * MiB <= WS_MO, "d_ws map");
constexpr int CW_BAR = 1024;

constexpr int RING_OFF = 0, RING_BYTES = 131072;
constexpr int XS_OFF = RING_BYTES, XS_BYTES = 8 * 2304;
constexpr int MISC_OFF = XS_OFF + XS_BYTES;
constexpr int LDS_BYTES = 160 * 1024;
static_assert(MISC_OFF + 128 <= LDS_BYTES, "LDS map");

struct Frame {
    LAS unsigned char* lds; volatile LAS unsigned* MISC; int tid, lane, wave, G, vcu, wv0;
    float* out; unsigned char* ws;
};
__device__ __forceinline__ float wave_sum(float v) {
#pragma unroll
    for (int o = 1; o < 64; o <<= 1) v += __shfl_xor(v, o);
    return v;
}
__device__ __forceinline__ void p0_transpose_item(const float* W, int ldw, int K, int src_col, bf16* WT, int dst_row, int ncols, const float* gain, LAS float* scr, int item, int lane) {
    const int nblk = ncols / 32, kb = item / nblk, nb = item % nblk, k0 = 64 * kb, n0 = 32 * nb;
    f32x4 v[8]; float gk[8];
#pragma unroll
    for (int i = 0; i < 8; ++i) { const int kk = 8 * i + (lane >> 3); v[i] = *(const GAS f32x4*)(W + (size_t)(k0 + kk) * ldw + src_col + n0 + 4 * (lane & 7)); gk[i] = gain ? gain[k0 + kk] : 1.0f; }
#pragma unroll
    for (int i = 0; i < 8; ++i) { const int kk = 8 * i + (lane >> 3); LAS float* d = scr + kk * 33 + 4 * (lane & 7); d[0] = v[i].x * gk[i]; d[1] = v[i].y * gk[i]; d[2] = v[i].z * gk[i]; d[3] = v[i].w * gk[i]; }
    LDS_WAIT(); asm volatile("" ::: "memory");
    const int c = lane & 7;
#pragma unroll
    for (int j = 0; j < 4; ++j) { const int n = (lane >> 3) + 8 * j; const LAS float* s = scr + (8 * c) * 33 + n;
        v4u o; o.x = pk2(s[0 * 33], s[1 * 33]); o.y = pk2(s[2 * 33], s[3 * 33]); o.z = pk2(s[4 * 33], s[5 * 33]); o.w = pk2(s[6 * 33], s[7 * 33]);
        *(GAS v4u*)(WT + (size_t)(dst_row + n0 + n) * K + k0 + 8 * c) = o; }
    LDS_WAIT(); asm volatile("" ::: "memory");
}
struct XT { const float* src; bf16* dst; const float* gain; int ldw, K; };
#define XT_SEG(W_, ldw_, K_, src_, WT_, dst_, ncols_, gain_) { const int n_ = ((K_) / 64) * ((ncols_) / 128); if (r < n_) { const int nblk_ = (ncols_) / 128, kb_ = r / nblk_, nb_ = r - kb_ * nblk_; \
        x.src = (W_) + (size_t)(64 * kb_) * (ldw_) + (src_) + 128 * nb_; x.dst = (WT_) + (size_t)((dst_) + 128 * nb_) * (K_) + 64 * kb_; x.gain = (gain_) ? (gain_) + 64 * kb_ : (const float*)nullptr; x.ldw = (ldw_); x.K = (K_); return x; } r -= n_; }
__device__ __forceinline__ void xt_load(const XT& x, int tid, f32x4 (&v)[4], float (&g)[4]) {
#pragma unroll
    for (int i = 0; i < 4; ++i) { const int row = i * 16 + (tid >> 5); v[i] = *(const GAS f32x4*)(x.src + (size_t)row * x.ldw + 4 * (tid & 31)); g[i] = x.gain ? x.gain[row] : 1.0f; }
}
template <class Dec> __device__ __forceinline__ void xt_run(Frame& F, int ntiles, const Dec& dec) {
    LAS float* scr = (LAS float*)(F.lds + RING_OFF);
    const int tid = F.tid; int t = F.vcu; if (t >= ntiles) return;
    XT cur = dec(t); f32x4 v[4]; float g[4]; xt_load(cur, tid, v, g);
    for (;;) {
        const int tn = t + F.G; const bool has = tn < ntiles; const XT nxt = has ? dec(tn) : cur;
        __syncthreads();
#pragma unroll
        for (int i = 0; i < 4; ++i) *(LAS f32x4*)(scr + (i * 16 + (tid >> 5)) * 132 + 4 * (tid & 31)) = v[i] * g[i];
        if (has) xt_load(nxt, tid, v, g);
        __syncthreads();
        const int n = tid >> 2, kq = tid & 3;
#pragma unroll
        for (int j = 0; j < 2; ++j) { const int kc = kq + 4 * j; const LAS float* s = scr + (8 * kc) * 132 + n;
            v4u o; o.x = pk2(s[0 * 132], s[1 * 132]); o.y = pk2(s[2 * 132], s[3 * 132]); o.z = pk2(s[4 * 132], s[5 * 132]); o.w = pk2(s[6 * 132], s[7 * 132]);
            *(GAS v4u*)(cur.dst + (size_t)n * cur.K + 8 * kc) = o; }
        if (!has) break;
        cur = nxt; t = tn;
    }
    __syncthreads();
}
#ifdef P0STRETCH
#define P0_T0(n) const unsigned long long pt0_##n = __builtin_amdgcn_s_memrealtime()
#define P0_ST(n) do { if (P0STRETCH == (n)) { const unsigned long long t1_ = __builtin_amdgcn_s_memrealtime(); const unsigned long long d_ = t1_ - pt0_##n; while (__builtin_amdgcn_s_memrealtime() - t1_ < d_) __builtin_amdgcn_s_sleep(8); } } while (0)
#else
#define P0_T0(n) do {} while (0)
#define P0_ST(n) do {} while (0)
#endif
#define P0_SEG(W, ldw, K, src, WT, dst, ncols, gain) { const int n_ = ((K) / 64) * ((ncols) / 32); if (r < n_) { p0_transpose_item(W, ldw, K, src, WT, dst, ncols, gain, scr, r, F.lane); continue; } r -= n_; }
__device__ __forceinline__ void phase_p0(Frame& F, const float* x, const int* pos, const float* g_mix, const float* w_in, const float* g_qlat, const float* g_kvlat, const float* w_uq, const float* w_ukv, const float* qn, const float* kn) {
    LAS float* scr = (LAS float*)(F.lds + RING_OFF + F.wave * 16384);
    const int gw = F.vcu * NWAVES + F.wave, NGW = F.G * NWAVES;
    bf16* WinT = (bf16*)(F.ws + WS_WIN); bf16* WuqT = (bf16*)(F.ws + WS_WUQ); bf16* WukvT = (bf16*)(F.ws + WS_WUKV);
    struct Dec0 { const float *w_in, *g_mix, *w_uq, *g_qlat, *w_ukv, *g_kvlat; bf16 *WinT, *WuqT, *WukvT;
        __device__ __forceinline__ XT operator()(int r) const { XT x;
            XT_SEG(w_in, 8896, 1024, 6848, WinT, 0, 2048, g_mix)
            XT_SEG(w_in, 8896, 1024, 4096, WinT, 2048, 2048, g_mix)
            XT_SEG(w_in, 8896, 1024, 0, WinT, 4096, 4096, g_mix)
            XT_SEG(w_in, 8896, 1024, 6144, WinT, 8192, 640, g_mix)
            XT_SEG(w_ukv, 2048, 256, 0, WukvT, 0, 2048, g_kvlat)
            x.src = w_in; x.dst = WinT; x.gain = nullptr; x.ldw = 8896; x.K = 1024; return x; } };
    P0_T0(1); { const Dec0 d{w_in, g_mix, w_uq, g_qlat, w_ukv, g_kvlat, WinT, WuqT, WukvT}; xt_run(F, 16 * 16 * 2 + 16 * 32 + 16 * 5 + 4 * 16, d); } P0_ST(1);
    P0_T0(2);
    for (int it = gw; it < 32 + 8 * 36; it += NGW) {
        int r = it;
        P0_SEG(w_in, 8896, 1024, 6784, WinT, 8960, 32, g_mix)
        P0_SEG(w_in, 8896, 1024, 6816, WinT, 8960 + 128, 32, g_mix)
        { const int hh = r / 36; r -= hh * 36;
          P0_SEG(w_uq, 1536, 384, hh * 192, WuqT, hh * 256, 96, g_qlat)
          P0_SEG(w_uq, 1536, 384, hh * 192 + 128, WuqT, hh * 256 + 96, 32, g_qlat)
          P0_SEG(w_uq, 1536, 384, hh * 192 + 96, WuqT, hh * 256 + 128, 32, g_qlat)
          P0_SEG(w_uq, 1536, 384, hh * 192 + 160, WuqT, hh * 256 + 224, 32, g_qlat) }
    }
    for (int gt = F.vcu * 512 + F.tid; gt < 24576; gt += F.G * 512) { const int hh = gt / 3072, rem = gt - hh * 3072; *(GAS v4u*)((unsigned char*)(WuqT + (size_t)(hh * 256 + 160) * 384) + (size_t)rem * 16) = (v4u){0u, 0u, 0u, 0u}; }
    for (int gt = F.vcu * 512 + F.tid; gt < 40960; gt += F.G * 512) { const int row = gt >> 7, piece = gt & 127; const int wrow = row < 128 ? 8832 + row : (row < 224 ? 8992 + (row - 128) : 9120 + (row - 224));
        *(GAS v4u*)((unsigned char*)(WinT + (size_t)wrow * 1024) + (size_t)piece * 16) = (v4u){0u, 0u, 0u, 0u}; }
    P0_ST(2); P0_T0(3);
    { bf16* XB = (bf16*)(F.ws + WS_XB); float* rstdx = (float*)(F.ws + WS_SMALL + SM_RSTDX);
      for (int m0 = 2 * gw; m0 < MTOK; m0 += 2 * NGW) {
          f32x4 v[2][4]; float s[2] = {0.f, 0.f};
#pragma unroll
          for (int u = 0; u < 2; ++u) { const GAS f32x4* xr = (const GAS f32x4*)(x + (size_t)(m0 + u) * DM) + F.lane;
#pragma unroll
              for (int j = 0; j < 4; ++j) v[u][j] = xr[64 * j]; }
#pragma unroll
          for (int u = 0; u < 2; ++u) {
#pragma unroll
              for (int j = 0; j < 4; ++j) s[u] += (v[u][j].x * v[u][j].x + v[u][j].y * v[u][j].y) + (v[u][j].z * v[u][j].z + v[u][j].w * v[u][j].w);
              s[u] = wave_sum(s[u]);
              GAS unsigned long long* o8 = (GAS unsigned long long*)(XB + (size_t)(m0 + u) * DM) + F.lane;
#pragma unroll
              for (int j = 0; j < 4; ++j) o8[64 * j] = (unsigned long long)pk2(v[u][j].x, v[u][j].y) | ((unsigned long long)pk2(v[u][j].z, v[u][j].w) << 32);
              if (F.lane == 0) rstdx[m0 + u] = 1.0f / sqrtf(s[u] * (1.0f / DM) + 1e-6f); }
      } }
    P0_ST(3); P0_T0(4);
    { f32x2* cs = (f32x2*)(F.ws + WS_CS);
      for (int e = F.vcu * 512 + F.tid; e < MTOK * 128; e += F.G * 512) { const int row = e >> 7, i = e & 127;
          const float inv = __builtin_amdgcn_exp2f(-(float)i * (13.287712379549449f / 128.0f));
          double rev = (double)pos[row] * (double)inv * 0.15915494309189535; rev -= __builtin_rint(rev);
          const float rf = (float)rev; cs[e] = (f32x2){__builtin_amdgcn_cosf(rf), __builtin_amdgcn_sinf(rf)}; } }
    { typedef _Float16 h2_t __attribute__((ext_vector_type(2))); h2_t* csm = (h2_t*)(F.ws + WS_CSM);
      for (int e = F.vcu * 512 + F.tid; e < MTOK * 32; e += F.G * 512) { const int row = e >> 5, i = e & 31;
          const float inv = __builtin_amdgcn_exp2f(-(float)(4 * i) * (13.287712379549449f / 128.0f));
          double rev = (double)pos[row] * (double)inv * 0.15915494309189535; rev -= __builtin_rint(rev);
          const float rf = (float)rev; csm[e] = (h2_t){(_Float16)__builtin_amdgcn_cosf(rf), (_Float16)__builtin_amdgcn_sinf(rf)}; } }
    P0_ST(4);
    if (F.vcu == 0 && F.wave == 0) { float mq = 0.f, mk = 0.f;
#pragma unroll
        for (int j = 0; j < 3; ++j) { mq = fmaxf(mq, fabsf(qn[F.lane + 64 * j])); mk = fmaxf(mk, fabsf(kn[F.lane + 64 * j])); }
#pragma unroll
        for (int o = 1; o < 64; o <<= 1) { mq = fmaxf(mq, __shfl_xor(mq, o)); mk = fmaxf(mk, __shfl_xor(mk, o)); }
        if (F.lane == 0) *(float*)(F.ws + WS_SMALL + SM_BOUND) = 1.02f * 1.4426950408889634f * 13.856406460551018f * mq * mk; }
    { float* z = (float*)(F.ws + WS_SMALL + SM_SSQ_CQ); for (int e = F.vcu * 512 + F.tid; e < (int)((SM_END - SM_SSQ_CQ) / 4); e += F.G * 512) z[e] = 0.f; }
}
__device__ __forceinline__ void phase_late_weights(Frame& F, const float* p, const float* w_br, const float* w_bm, const float* w_o, const float* g_mlp, const float* w_up, const float* w_down, const float* g_ple, const float* w_pg, const float* w_ple) {
    struct Dec1 { const float *w_br, *w_bm, *w_o, *g_mlp, *w_up, *w_down, *g_ple, *w_pg, *w_ple; unsigned char* ws;
        __device__ __forceinline__ XT operator()(int r) const { XT x; const float* nog = nullptr;
            XT_SEG(w_br, 1024, 2048, 0, (bf16*)(ws + WS_WBR), 0, 1024, nog)
            XT_SEG(w_bm, 1024, 1024, 0, (bf16*)(ws + WS_WBM), 0, 1024, nog)
            XT_SEG(w_o, 1024, 1024, 0, (bf16*)(ws + WS_WO), 0, 1024, nog)
            XT_SEG(w_up, 4096, 1024, 0, (bf16*)(ws + WS_WUP), 0, 4096, g_mlp)
            XT_SEG(w_down, 1024, 4096, 0, (bf16*)(ws + WS_WDOWN), 0, 1024, nog)
            XT_SEG(w_pg, 1024, 1024, 0, (bf16*)(ws + WS_WPG), 0, 1024, g_ple)
            XT_SEG(w_ple, 1024, 256, 0, (bf16*)(ws + WS_WPLE), 0, 1024, nog)
            x.src = w_br; x.dst = (bf16*)(ws + WS_WBR); x.gain = nullptr; x.ldw = 1024; x.K = 2048; return x; } };
    { const Dec1 d{w_br, w_bm, w_o, g_mlp, w_up, w_down, g_ple, w_pg, w_ple, F.ws}; xt_run(F, 32 * 8 + 16 * 8 * 2 + 16 * 32 + 64 * 8 + 16 * 8 + 4 * 8, d); }
    { bf16* PB = (bf16*)(F.ws + WS_PB);
      for (int e = F.vcu * 512 + F.tid; e < MTOK * 256 / 8; e += F.G * 512) { const f32x4 a = *(const GAS f32x4*)(p + (size_t)e * 8), b = *(const GAS f32x4*)(p + (size_t)e * 8 + 4);
          *(GAS v4u*)(PB + (size_t)e * 8) = (v4u){pk2(a.x, a.y), pk2(a.z, a.w), pk2(b.x, b.y), pk2(b.z, b.w)}; } }
}

typedef float f32x16 __attribute__((ext_vector_type(16)));
typedef unsigned u32x2 __attribute__((ext_vector_type(2)));
typedef short v4i16_t __attribute__((ext_vector_type(4)));
__device__ __forceinline__ int crow(int r, int hi) { return (r & 3) + 8 * (r >> 2) + 4 * hi; }
typedef __bf16 bf16x2m_t __attribute__((ext_vector_type(2)));
__device__ __forceinline__ unsigned cvtpk(float lo, float hi) { f32x2 v = {lo, hi}; bf16x2m_t b = __builtin_convertvector(v, bf16x2m_t); return __builtin_bit_cast(unsigned, b); }
__device__ __forceinline__ bf16x8 pack8f(const f32x16& p, int b) { v4u w = {cvtpk(p[b], p[b + 1]), cvtpk(p[b + 2], p[b + 3]), cvtpk(p[b + 4], p[b + 5]), cvtpk(p[b + 6], p[b + 7])}; return __builtin_bit_cast(bf16x8, w); }
__device__ __forceinline__ float bf2f(bf16 v) { return __uint_as_float((unsigned)v << 16); }
__device__ __forceinline__ float log2_gamma(int h) { return __builtin_amdgcn_logf(1.0f - __builtin_amdgcn_exp2f(-5.0f - (float)h)); }


__device__ __forceinline__ void phase_r0p(Frame& F) {
    const bf16* RQ = (const bf16*)(F.ws + WS_RQ); bf16* RK = (bf16*)(F.ws + WS_RK);
    const int lane = F.lane, w = F.wave, l31 = lane & 31, hi = lane >> 5, tq = w & 3, dh = w >> 2;
    for (int unit = F.vcu; unit < 512; unit += F.G) {
        const int bh = unit >> 5, c = unit & 31, h = bh & 3; const size_t blk = (size_t)bh * 32 + c;
        const float lg2 = log2_gamma(h);
        bf16x8 qf[16];
#pragma unroll
        for (int ks = 0; ks < 16; ++ks) qf[ks] = *(const bf16x8*)(RQ + ((blk * 32 + 2 * ks + hi) * 128 + 32 * tq + l31) * 8);
        f32x16 s[2] = {};
#pragma unroll
        for (int x = 0; x < 2; ++x) { const int tb = 2 * dh + x;
            if (tb <= tq) {
#pragma unroll
                for (int ks = 0; ks < 16; ++ks) { const bf16x8 kf = *(const bf16x8*)(RK + ((blk * 32 + 2 * ks + hi) * 128 + 32 * tb + l31) * 8); s[x] = __builtin_amdgcn_mfma_f32_32x32x16_bf16(kf, qf[ks], s[x], 0, 0, 0); }
#pragma unroll
                for (int r = 0; r < 16; ++r) { const int d = (32 * tq + l31) - (32 * tb + crow(r, hi)); s[x][r] = d >= 0 ? s[x][r] * __builtin_amdgcn_exp2f((float)d * lg2) : 0.f; }
            } }
        VM_WAIT(); __syncthreads();
#pragma unroll
        for (int x = 0; x < 2; ++x) { const int tb = 2 * dh + x;
            if (tb <= tq) {
#pragma unroll
                for (int g = 0; g < 4; ++g) *(u32x2*)(RK + ((blk * 32 + 4 * tb + g) * 128 + 32 * tq + l31) * 8 + 4 * hi) = (u32x2){cvtpk(s[x][4 * g], s[x][4 * g + 1]), cvtpk(s[x][4 * g + 2], s[x][4 * g + 3])};
            } }
    }
}
__device__ __forceinline__ void phase_r1p(Frame& F) {
    const bf16* RQ = (const bf16*)(F.ws + WS_RQ); const bf16* RP = (const bf16*)(F.ws + WS_RK); const bf16* RKDT = (const bf16*)(F.ws + WS_RKDT); const bf16* RVT = (const bf16*)(F.ws + WS_RVT); bf16* RO = (bf16*)F.out;
    float* ssqp = (float*)(F.ws + WS_SSQP);
    const int lane = F.lane, w = F.wave, l15 = lane & 15, lq = lane >> 4;
    constexpr int SROW = 528, SBUF = 32 * SROW;
    LAS unsigned char* ost = F.lds + 2 * SBUF + 1024 + w * 1024;
    const int nkp = (w >> 1) + 1;
    for (int unit = F.vcu; unit < 256; unit += F.G) {
        const int bh = unit >> 4, j = unit & 15, b = bh >> 2, h = bh & 3;
        const float lg2 = log2_gamma(h), gC = __builtin_amdgcn_exp2f(128.0f * lg2);
        float qd[4];
#pragma unroll
        for (int i = 0; i < 4; ++i) qd[i] = __builtin_amdgcn_exp2f((float)(16 * w + 4 * lq + i + 1) * lg2);
        f32x4 S[2][2];
#pragma unroll
        for (int mb = 0; mb < 2; ++mb)
#pragma unroll
            for (int nb = 0; nb < 2; ++nb) S[mb][nb] = (f32x4){0.f, 0.f, 0.f, 0.f};
        __syncthreads();
#pragma unroll
        for (int mb = 0; mb < 2; ++mb)
#pragma unroll
            for (int nb = 0; nb < 2; ++nb) *(LAS u32x2*)(F.lds + (16 * nb + l15) * SROW + (32 * w + 16 * mb + 4 * lq) * 2) = (u32x2){0u, 0u};
        const bf16* qp = RQ + (((size_t)bh * 32 * 32 + lq) * 128 + 16 * w + l15) * 8;
        const bf16* pp = RP + (((size_t)bh * 32 * 32 + lq) * 128 + 16 * w + l15) * 8;
        const bf16* kp = RKDT + (((size_t)bh * 32 * 16 + lq) * 256 + 32 * w + l15) * 8;
        const bf16* vp = RVT + (((size_t)bh * 32 * 16 + (F.tid >> 5)) * 512 + 32 * j + (F.tid & 31)) * 8;
        constexpr size_t QC = 32 * 128 * 8, QK = 4 * 128 * 8, KC = 16 * 256 * 8, KK = 4 * 256 * 8, VC = 16 * 512 * 8;
        bf16x8 QA[8], PA[4], KA[2][4], vpre;
        LAS unsigned char* vl = F.lds + 2 * SBUF + 1024 + 8 * 1024;
#pragma unroll
        for (int ks = 0; ks < 8; ++ks) QA[ks] = *(const bf16x8*)(qp + QK * ks);
#pragma unroll
        for (int ks = 0; ks < 4; ++ks) { PA[ks] = (bf16x8){0, 0, 0, 0, 0, 0, 0, 0}; if (ks < nkp) PA[ks] = *(const bf16x8*)(pp + QK * ks); }
#pragma unroll
        for (int mb = 0; mb < 2; ++mb)
#pragma unroll
            for (int ks = 0; ks < 4; ++ks) KA[mb][ks] = *(const bf16x8*)(kp + mb * 128 + KK * ks);
        vpre = *(const bf16x8*)vp;
        *(LAS bf16x8*)(vl + F.tid * 16) = vpre;
#pragma unroll 1
        for (int c = 0; c < 32; ++c) {
            const int cur = c & 1, cn = c < 31 ? c + 1 : 31; const size_t tok0 = (size_t)b * SEQ + c * 128;
            __syncthreads();
            vpre = *(const bf16x8*)(vp + VC * cn);
            bf16x8 VB[2][4];
#pragma unroll
            for (int nb = 0; nb < 2; ++nb)
#pragma unroll
                for (int ks = 0; ks < 4; ++ks) VB[nb][ks] = *(const LAS bf16x8*)(vl + cur * 8192 + ((4 * ks + lq) * 32 + 16 * nb + l15) * 16);
            f32x4 oc[2] = {(f32x4){0.f, 0.f, 0.f, 0.f}, (f32x4){0.f, 0.f, 0.f, 0.f}};
#pragma unroll
            for (int ks = 0; ks < 8; ++ks)
#pragma unroll
                for (int nb = 0; nb < 2; ++nb) { const bf16x8 bq = *(const LAS bf16x8*)(F.lds + cur * SBUF + (16 * nb + l15) * SROW + (32 * ks + 8 * lq) * 2);
                    oc[nb] = __builtin_amdgcn_mfma_f32_16x16x32_bf16(QA[ks], bq, oc[nb], 0, 0, 0); }
#pragma unroll
            for (int ks = 0; ks < 8; ++ks) QA[ks] = *(const bf16x8*)(qp + QC * cn + QK * ks);
#pragma unroll
            for (int nb = 0; nb < 2; ++nb)
#pragma unroll
                for (int i = 0; i < 4; ++i) oc[nb][i] *= qd[i];
#pragma unroll
            for (int ks = 0; ks < 4; ++ks)
                if (ks < nkp) {
#pragma unroll
                    for (int nb = 0; nb < 2; ++nb) oc[nb] = __builtin_amdgcn_mfma_f32_16x16x32_bf16(PA[ks], VB[nb][ks], oc[nb], 0, 0, 0); }
#pragma unroll
            for (int ks = 0; ks < 4; ++ks) if (ks < nkp) PA[ks] = *(const bf16x8*)(pp + QC * cn + QK * ks);
#pragma unroll
            for (int mb = 0; mb < 2; ++mb)
#pragma unroll
                for (int nb = 0; nb < 2; ++nb) { S[mb][nb] *= gC;
#pragma unroll
                    for (int ks = 0; ks < 4; ++ks) S[mb][nb] = __builtin_amdgcn_mfma_f32_16x16x32_bf16(KA[mb][ks], VB[nb][ks], S[mb][nb], 0, 0, 0); }
#pragma unroll
            for (int mb = 0; mb < 2; ++mb)
#pragma unroll
                for (int ks = 0; ks < 4; ++ks) KA[mb][ks] = *(const bf16x8*)(kp + mb * 128 + KC * cn + KK * ks);
#pragma unroll
            for (int i = 0; i < 4; ++i) { float q = 0.f;
#pragma unroll
                for (int nb = 0; nb < 2; ++nb) { const float v = oc[nb][i]; q += v * v; *(LAS unsigned short*)(ost + ((4 * lq + i) * 32 + 16 * nb + l15) * 2) = (unsigned short)f2bf(v); }
                q += __shfl_xor(q, 1); q += __shfl_xor(q, 2); q += __shfl_xor(q, 4); q += __shfl_xor(q, 8);
                if (l15 == 0) ssqp[((tok0 + 16 * w + 4 * lq + i) * 4 + h) * 16 + j] = q; }
            LDS_WAIT();
            { const v4u ov = *(const LAS v4u*)(ost + lane * 16); *(v4u*)(RO + (tok0 + 16 * w + (lane >> 2)) * 2048 + h * 512 + 32 * j + (lane & 3) * 8) = ov; }
            *(LAS bf16x8*)(vl + (cur ^ 1) * 8192 + F.tid * 16) = vpre;
#pragma unroll
            for (int mb = 0; mb < 2; ++mb)
#pragma unroll
                for (int nb = 0; nb < 2; ++nb) *(LAS u32x2*)(F.lds + (cur ^ 1) * SBUF + (16 * nb + l15) * SROW + (32 * w + 16 * mb + 4 * lq) * 2) = (u32x2){cvtpk(S[mb][nb][0], S[mb][nb][1]), cvtpk(S[mb][nb][2], S[mb][nb][3])};
        }
    }
    __syncthreads();
}

namespace attn2 {
typedef float f32x16 __attribute__((ext_vector_type(16)));
typedef short s16x4 __attribute__((ext_vector_type(4)));
constexpr int NW = 8, QBLK = 32, KVBLK = 64, QB = NW * QBLK;
constexpr int QS = 1536, KS = 1536, VS = 1024, OS = 1024;
constexpr int SHM_V = KVBLK * 128 * 2, SHM_K = KVBLK * 512;
constexpr int OFF_V = 0, OFF_K = 2 * SHM_V, OFF_WS = OFF_K + 2 * SHM_K, OFF_QR = OFF_WS + NW * 64 * 4, LDS_NEED = OFF_QR + NW * 4096;
constexpr float THR2 = 8.0f * 1.4426950408889634f;
#define A2_SBAR() __builtin_amdgcn_sched_barrier(0)
__device__ __forceinline__ int v_st(int k, int c) { const int kk = (k & ~0xC) | ((k & 4) << 1) | ((k & 8) >> 1); return ((kk >> 3) * 4 + (c >> 5)) * 512 + ((kk & 7) * 32 + (c & 31)) * 2; }
__device__ __forceinline__ int v_rd_base(int lane) { return ((lane & 3) << 3) | (((lane >> 2) & 3) << 6) | (((lane >> 4) & 1) << 5) | (((lane >> 5) & 1) << 8); }
constexpr int v_rd_off(int d0, int ks, int half) { return d0 * 512 + ks * 4096 + half * 2048; }
__device__ __forceinline__ int crow(int r, int hi) { return (r & 3) + 8 * (r >> 2) + 4 * hi; }
typedef __bf16 bf16x2a_t __attribute__((ext_vector_type(2)));
__device__ __forceinline__ unsigned cvtpk(float lo, float hi) { f32x2 v = {lo, hi}; bf16x2a_t b = __builtin_convertvector(v, bf16x2a_t); return __builtin_bit_cast(unsigned, b); }
__device__ __forceinline__ bf16x8 load8(const bf16* p) { return *reinterpret_cast<const bf16x8*>(p); }
__device__ __forceinline__ void mask_tile(f32x16& p0, f32x16& p1, int dq) {
    const float NEG = -__builtin_inff();
#pragma unroll
    for (int r = 0; r < 16; ++r) { const int c = (r & 3) + 8 * (r >> 2); if (dq - c < 0) p0[r] = NEG; if (dq - c - 32 < 0) p1[r] = NEG; }
}
__device__ __forceinline__ void partialSM(f32x16& p0, f32x16& p1, float& m_reg, float& mn, float& alpha) {
    float pmax = p0[0];
#pragma unroll
    for (int r = 1; r < 16; ++r) pmax = fmaxf(pmax, p0[r]);
#pragma unroll
    for (int r = 0; r < 16; ++r) pmax = fmaxf(pmax, p1[r]);
    { auto rr = __builtin_amdgcn_permlane32_swap(__float_as_uint(pmax), __float_as_uint(pmax), false, false); pmax = fmaxf(__uint_as_float(rr[0]), __uint_as_float(rr[1])); }
    if (__builtin_expect(__all((pmax - m_reg) <= THR2), 1)) { mn = m_reg; alpha = 1.f; }
    else { mn = fmaxf(m_reg, pmax); alpha = __builtin_amdgcn_exp2f(m_reg - mn); m_reg = mn; }
#pragma unroll
    for (int r = 0; r < 16; ++r) { p0[r] -= mn; p1[r] -= mn; }
#pragma unroll
    for (int r = 0; r < 16; ++r) p0[r] = __builtin_amdgcn_exp2f(p0[r]);
}
__device__ __forceinline__ void finishSM(f32x16& p0, f32x16& p1, float alpha, float& l_reg, bf16x8& pa0, bf16x8& pa1, bf16x8& pa2, bf16x8& pa3) {
#pragma unroll
    for (int r = 0; r < 16; ++r) p1[r] = __builtin_amdgcn_exp2f(p1[r]);
    float ps = 0;
#pragma unroll
    for (int r = 0; r < 16; ++r) ps += p0[r];
#pragma unroll
    for (int r = 0; r < 16; ++r) ps += p1[r];
    { auto rr = __builtin_amdgcn_permlane32_swap(__float_as_uint(ps), __float_as_uint(ps), false, false); ps = __uint_as_float(rr[0]) + __uint_as_float(rr[1]); }
    l_reg = l_reg * alpha + ps;
#define A2_PK4(P, B_, OUT) do { unsigned a0 = cvtpk(P[B_+0], P[B_+1]), a1 = cvtpk(P[B_+2], P[B_+3]); unsigned b0 = cvtpk(P[B_+4], P[B_+5]), b1 = cvtpk(P[B_+6], P[B_+7]); \
        auto r0 = __builtin_amdgcn_permlane32_swap(a0, b0, false, false); auto r1 = __builtin_amdgcn_permlane32_swap(a1, b1, false, false); \
        v4u w = {r0[0], r1[0], r0[1], r1[1]}; OUT = __builtin_bit_cast(bf16x8, w); } while (0)
    A2_PK4(p0, 0, pa0); A2_PK4(p0, 8, pa1); A2_PK4(p1, 0, pa2); A2_PK4(p1, 8, pa3);
#undef A2_PK4
}
__device__ __forceinline__ void softmax_fixed(f32x16& p0, f32x16& p1, float& l_reg, bf16x8& pa0, bf16x8& pa1, bf16x8& pa2, bf16x8& pa3) {
#define A2_PK4(P, B_, OUT) do { unsigned a0 = cvtpk(P[B_+0], P[B_+1]), a1 = cvtpk(P[B_+2], P[B_+3]); unsigned b0 = cvtpk(P[B_+4], P[B_+5]), b1 = cvtpk(P[B_+6], P[B_+7]); \
        auto r0 = __builtin_amdgcn_permlane32_swap(a0, b0, false, false); auto r1 = __builtin_amdgcn_permlane32_swap(a1, b1, false, false); \
        v4u w = {r0[0], r1[0], r0[1], r1[1]}; OUT = __builtin_bit_cast(bf16x8, w); } while (0)
    float ps = 0;
#pragma unroll
    for (int r = 0; r < 16; ++r) { p0[r] = __builtin_amdgcn_exp2f(p0[r]); ps += p0[r]; }
    A2_PK4(p0, 0, pa0); A2_PK4(p0, 8, pa1); A2_SBAR();
#pragma unroll
    for (int r = 0; r < 16; ++r) { p1[r] = __builtin_amdgcn_exp2f(p1[r]); ps += p1[r]; }
    A2_PK4(p1, 0, pa2); A2_PK4(p1, 8, pa3);
    l_reg += ps;
#undef A2_PK4
}
template <int KB>
__device__ __forceinline__ void qkt(f32x16& p0, f32x16& p1, const char* K_lds, const char* qr_lds, int r32, int hi, const bf16x8* qr) {
    p0 = f32x16{}; p1 = f32x16{};
    const char* kbase = K_lds + KB * SHM_K + r32 * 512; const int x = r32 & 15;
#pragma unroll
    for (int d = 0; d < 12; ++d) { const char* a = kbase + ((((2 * d + hi) & 15) ^ x) << 4) + (d >= 8 ? 256 : 0);
        const bf16x8 b0 = *reinterpret_cast<const bf16x8*>(a), b1 = *reinterpret_cast<const bf16x8*>(a + 32 * 512);
        const bf16x8 q = d < 8 ? qr[d < 8 ? d : 0] : *reinterpret_cast<const bf16x8*>(qr_lds + (((d - 8) * 2 + hi) * 32 + r32) * 16);
        p0 = __builtin_amdgcn_mfma_f32_32x32x16_bf16(b0, q, p0, 0, 0, 0);
        p1 = __builtin_amdgcn_mfma_f32_32x32x16_bf16(b1, q, p1, 0, 0, 0); }
}
template <int VB>
__device__ __forceinline__ void pv_tile(f32x16* o, int vb0, bf16x8 pa0, bf16x8 pa1, bf16x8 pa2, bf16x8 pa3) {
#define A2_TRRD(dst, off) asm volatile("ds_read_b64_tr_b16 %0, %1 offset:%2" : "=&v"(dst) : "v"(vb0), "i"(off) : "memory")
#define A2_PV_D0(d0) do { s16x4 l0, l1, l2, l3, h0, h1, h2, h3; constexpr int b_ = VB * SHM_V + v_rd_off(d0, 0, 0); \
        A2_TRRD(l0, b_); A2_TRRD(h0, b_ + 2048); A2_TRRD(l1, b_ + 4096); A2_TRRD(h1, b_ + 6144); A2_TRRD(l2, b_ + 8192); A2_TRRD(h2, b_ + 10240); A2_TRRD(l3, b_ + 12288); A2_TRRD(h3, b_ + 14336); \
        asm volatile("s_waitcnt lgkmcnt(0)" ::: "memory"); A2_SBAR(); \
        o[d0] = __builtin_amdgcn_mfma_f32_32x32x16_bf16(pa0, (bf16x8){l0[0], l0[1], l0[2], l0[3], h0[0], h0[1], h0[2], h0[3]}, o[d0], 0, 0, 0); \
        o[d0] = __builtin_amdgcn_mfma_f32_32x32x16_bf16(pa1, (bf16x8){l1[0], l1[1], l1[2], l1[3], h1[0], h1[1], h1[2], h1[3]}, o[d0], 0, 0, 0); \
        o[d0] = __builtin_amdgcn_mfma_f32_32x32x16_bf16(pa2, (bf16x8){l2[0], l2[1], l2[2], l2[3], h2[0], h2[1], h2[2], h2[3]}, o[d0], 0, 0, 0); \
        o[d0] = __builtin_amdgcn_mfma_f32_32x32x16_bf16(pa3, (bf16x8){l3[0], l3[1], l3[2], l3[3], h3[0], h3[1], h3[2], h3[3]}, o[d0], 0, 0, 0); } while (0)
    A2_PV_D0(0); A2_PV_D0(1); A2_PV_D0(2); A2_PV_D0(3);
#undef A2_PV_D0
#undef A2_TRRD
}
struct BlockRef { const bf16* Q; const bf16* K; const bf16* V; bf16* O; int P0; };
struct Seam { bf16x8 qr[8]; bf16x8 st_v0, st_v1, st_k0, st_k1, st_k2; int wv; };
#define A2_VMW() asm volatile("s_waitcnt vmcnt(0)" ::: "memory")
#define A2_VMWN(n) asm volatile("s_waitcnt vmcnt(%0)" :: "i"(n) : "memory")
#define A2_SLOAD(Kp, Vp, k0) do { S.st_v0 = load8((Vp) + (size_t)((k0) + sr) * VS + sc); S.st_v1 = load8((Vp) + (size_t)((k0) + 32 + sr) * VS + sc); \
        const bf16* kp_ = (Kp) + (size_t)((k0) + krow) * KS + kc * 8; S.st_k0 = load8(kp_); S.st_k1 = load8(kp_ + 64); S.st_k2 = load8(kp_ + 128); } while (0)
#define A2_SWRITE_K(bf) do { *(bf16x8*)(K_lds + (bf) * SHM_K + kw0) = S.st_k0; *(bf16x8*)(K_lds + (bf) * SHM_K + kw1) = S.st_k1; *(bf16x8*)(K_lds + (bf) * SHM_K + kw0 + 256) = S.st_k2; } while (0)
#define A2_SWRITE_V(bf) do { *(bf16x8*)(V_lds + (bf) * SHM_V + vst0) = S.st_v0; *(bf16x8*)(V_lds + (bf) * SHM_V + vst1) = S.st_v1; } while (0)
#define A2_SWRITE(bf) do { A2_SWRITE_V(bf); A2_SWRITE_K(bf); } while (0)
#define A2_IDX const int wid = S.wv, lane = mk_lane(), tid = wid * 64 + lane, r32 = lane & 31, hi = lane >> 5; \
    const int sr = tid >> 4, sc = (tid & 15) * 8, krow = tid >> 3, kc = tid & 7, kw0 = krow * 512 + ((kc ^ (krow & 15)) << 4), kw1 = krow * 512 + (((kc + 8) ^ (krow & 15)) << 4); \
    char* V_lds = lds + OFF_V; char* K_lds = lds + OFF_K; (void)lane; (void)r32; (void)hi; (void)sr; (void)sc; (void)V_lds
__device__ __forceinline__ void attn_prime(const BlockRef& cur, char* lds, Seam& S) {
    A2_IDX;
#pragma unroll
    for (int d0 = 0; d0 < 8; ++d0) S.qr[d0] = load8(cur.Q + (size_t)(wid * QBLK + r32) * QS + d0 * 16 + hi * 8);
    A2_SLOAD(cur.K, cur.V, 0); A2_VMW(); A2_SWRITE_K(0);
}
#ifdef ASTRETCH
#define A2_T0(n) unsigned long long at0_##n = 0; if (ASTRETCH == (n)) { A2_SBAR(); at0_##n = __builtin_amdgcn_s_memtime(); A2_SBAR(); }
#define A2_ST(n, dep) if (ASTRETCH == (n)) { A2_SBAR(); { float dp_ = (dep); asm volatile("" :: "v"(dp_)); } A2_SBAR(); const unsigned long long t1_ = __builtin_amdgcn_s_memtime(); const unsigned long long d_ = t1_ - at0_##n; while (__builtin_amdgcn_s_memtime() - t1_ < d_) {} A2_SBAR(); }
#else
#define A2_T0(n)
#define A2_ST(n, dep)
#endif
__device__ __forceinline__ void attn_block(const BlockRef& cur, const BlockRef& nxt, char* lds, Seam& S) {
    A2_IDX;
    const int NT = (cur.P0 + QB) / KVBLK;
    const int qlo = cur.P0 + wid * QBLK, qm = qlo + r32 - 4 * hi;
    float* ws = (float*)(lds + OFF_WS) + wid * 64; float* li_l = ws;
    char* qr_lds = lds + OFF_QR + wid * 4096;
    float l_reg = 0; f32x16 o[4] = {};
    A2_T0(6)
    const int vst0 = v_st(sr, sc), vst1 = v_st(32 + sr, sc);
    const int vb0 = (int)(uintptr_t)V_lds + v_rd_base(lane);
    const bf16* Kh = cur.K; const bf16* Vh = cur.V;
    { bf16x8 t4[4];
#pragma unroll
      for (int d = 0; d < 4; ++d) t4[d] = load8(cur.Q + (size_t)(wid * QBLK + r32) * QS + 128 + d * 16 + hi * 8);
#pragma unroll
      for (int d = 0; d < 4; ++d) *(bf16x8*)(qr_lds + ((d * 2 + hi) * 32 + r32) * 16) = t4[d]; }
    A2_SWRITE_V(0);
    __syncthreads();
    A2_ST(6, 0.f)
    f32x16 p0, p1; bf16x8 pa0, pa1, pa2, pa3;
#define A2_STEP(t, BUF) do { const bool lastt = (t) + 1 >= NT; \
        A2_T0(1) \
        A2_SBAR(); { const bf16* Kn = lastt ? nxt.K : Kh; const bf16* Vn = lastt ? nxt.V : Vh; const int k0n = lastt ? 0 : ((t) + 1) * KVBLK; A2_SLOAD(Kn, Vn, k0n); } A2_SBAR(); \
        const int kb_ = (t) * KVBLK; const bool live_ = kb_ <= qlo + QBLK - 1;        \
        if (live_) qkt<BUF>(p0, p1, K_lds, qr_lds, r32, hi, S.qr); \
        A2_ST(1, p0[15] + p1[15]) \
        if (lastt) { A2_SBAR(); _Pragma("unroll") for (int d0 = 0; d0 < 8; ++d0) S.qr[d0] = load8(nxt.Q + (size_t)(wid * QBLK + r32) * QS + d0 * 16 + hi * 8); A2_SBAR(); } \
        A2_T0(2) \
        if (live_) { if (kb_ + KVBLK - 1 > qlo) mask_tile(p0, p1, qm - kb_); \
            softmax_fixed(p0, p1, l_reg, pa0, pa1, pa2, pa3); } \
        A2_ST(2, l_reg) \
        A2_T0(3) \
        if (live_) { A2_SBAR(); pv_tile<BUF>(o, vb0, pa0, pa1, pa2, pa3); A2_SBAR(); } \
        A2_ST(3, o[3][15]) \
        A2_T0(4) \
        if (lastt) { A2_VMWN(8); A2_SWRITE_K(0); } else { A2_VMW(); A2_SWRITE((BUF) ^ 1); } \
        A2_ST(4, 0.f) \
        A2_T0(5) \
        __syncthreads(); \
        A2_ST(5, 0.f) \
        } while (0)
    for (int t = 0; t < NT; t += 2) { A2_STEP(t, 0); A2_STEP(t + 1, 1); }
#undef A2_STEP
    A2_T0(7)
    { auto rr = __builtin_amdgcn_permlane32_swap(__float_as_uint(l_reg), __float_as_uint(l_reg), false, false); l_reg = __uint_as_float(rr[0]) + __uint_as_float(rr[1]); }
    if (hi == 0) li_l[r32] = l_reg; asm volatile("s_waitcnt lgkmcnt(0)" ::: "memory");
    float rli[16];
#pragma unroll
    for (int r = 0; r < 16; ++r) rli[r] = __builtin_amdgcn_rcpf(li_l[crow(r, hi)]);
    bf16* Ow = cur.O + (size_t)(wid * QBLK) * OS;
#pragma unroll
    for (int r = 0; r < 16; ++r) { const int orow = crow(r, hi);
#pragma unroll
        for (int d0 = 0; d0 < 4; ++d0) { const float v = o[d0][r] * rli[r]; const float vn = __shfl_xor(v, 1);
            if ((r32 & 1) == 0) *(unsigned*)(Ow + (size_t)orow * OS + d0 * 32 + r32) = cvtpk(v, vn); } }
    asm volatile("s_waitcnt lgkmcnt(0)" ::: "memory");
    A2_ST(7, 0.f)
}
}
__device__ __forceinline__ attn2::BlockRef attn2_ref(unsigned char* ws, int v, int pass) {
    const int bh = v >> 3, b = bh >> 3, h = bh & 7, x = v & 7, qb = pass ? 15 - x : x;
    attn2::BlockRef r;
    r.Q = (const bf16*)(ws + WS_QP) + ((size_t)b * SEQ + qb * 256) * 1536 + h * 192; r.K = (const bf16*)(ws + WS_KF) + (size_t)b * SEQ * 1536 + h * 192;
    r.V = (const bf16*)(ws + WS_VV) + (size_t)b * SEQ * 1024 + h * 128; r.O = (bf16*)(ws + WS_MO) + ((size_t)b * SEQ + qb * 256) * 1024 + h * 128; r.P0 = qb * 256;
    return r;
}
#ifndef A2_PRIO_HI
#define A2_PRIO_HI 0
#endif
__device__ __forceinline__ void attn2_run(Frame& F, char* lds) {
    int L = F.vcu; if (L >= 256) return;
    attn2::Seam S; S.wv = F.wv0; int pass = 0;
    attn2::BlockRef cur = attn2_ref(F.ws, L, 0);
    if (A2_PRIO_HI && S.wv >= 4) __builtin_amdgcn_s_setprio(1);
    attn2::attn_prime(cur, lds, S);
    for (;;) {
        const bool more_pass = pass == 0, more_item = L + F.G < 256, last = !more_pass && !more_item;
        int passn = pass + 1, Ln = L;
        if (!more_pass) { passn = 0; Ln = more_item ? L + F.G : L; }
        const attn2::BlockRef nxt = last ? cur : attn2_ref(F.ws, Ln, passn);
        attn2::attn_block(cur, nxt, lds, S);
        if (last) break;
        cur = nxt; pass = passn; L = Ln;
    }
    if (A2_PRIO_HI) __builtin_amdgcn_s_setprio(0);
}
__device__ __forceinline__ void phase_attn_slow(Frame& F) {
    const bf16* QP = (const bf16*)(F.ws + WS_QP); const bf16* VV = (const bf16*)(F.ws + WS_VV); const bf16* KF = (const bf16*)(F.ws + WS_KF); bf16* MO = (bf16*)(F.ws + WS_MO);
    int t_ = F.wv0 * 64 + mk_lane();
    const int lane = t_ & 63, w = F.wv0, l31 = lane & 31, hi = lane >> 5;
    LAS unsigned char* vst = F.lds + w * 9216; LAS float* al = (LAS float*)(vst + 8704); LAS float* li = al + 32;
    constexpr int VROW = 272;
    const int trb = (4 * hi + ((lane & 15) >> 2)) * VROW + (16 * ((lane >> 4) & 1) + 4 * (lane & 3)) * 2;
    for (int v = F.vcu; v < 256; v += F.G) {
#pragma unroll 1
        for (int half = 0; half < 2; ++half) {
            const int qb = half == 0 ? 15 - (v >> 5) : (v >> 5), bh = v & 31, b = bh >> 3, h = bh & 7;
            const int q0 = qb * 256 + 32 * w; const size_t tb = (size_t)b * SEQ;
            bf16x8 qr[12];
#pragma unroll
            for (int d = 0; d < 12; ++d) qr[d] = *(const bf16x8*)(QP + (tb + q0 + l31) * 1536 + h * 192 + 16 * d + 8 * hi);
            float m_run = -1e30f, l_run = 0.f; attn2::f32x16 o[4] = {};
            const int nkt = q0 / 32 + 1;
#pragma unroll 1
            for (int kt = 0; kt < nkt; ++kt) {
                const int k0 = kt * 32;
#pragma unroll
                for (int i = 0; i < 4; ++i) { const int idx = lane + 64 * i, row = idx >> 3, ch = idx & 7;
                    const v4u v0 = *(const v4u*)(VV + (tb + k0 + row) * 1024 + h * 128 + ch * 16), v1 = *(const v4u*)(VV + (tb + k0 + row) * 1024 + h * 128 + ch * 16 + 8);
                    *(LAS v4u*)(vst + row * VROW + ch * 32) = v0; *(LAS v4u*)(vst + row * VROW + ch * 32 + 16) = v1; }
                attn2::f32x16 p = {};
#pragma unroll
                for (int d = 0; d < 12; ++d) { const bf16x8 kf = *(const bf16x8*)(KF + (tb + k0 + l31) * 1536 + h * 192 + 16 * d + 8 * hi); p = __builtin_amdgcn_mfma_f32_32x32x16_bf16(kf, qr[d], p, 0, 0, 0); }
                if (kt == nkt - 1) {
#pragma unroll
                    for (int r = 0; r < 16; ++r) if (attn2::crow(r, hi) > l31) p[r] = -__builtin_inff();
                }
                float pmax = p[0];
#pragma unroll
                for (int r = 1; r < 16; ++r) pmax = fmaxf(pmax, p[r]);
                pmax = fmaxf(pmax, __shfl_xor(pmax, 32));
                const float mn = fmaxf(m_run, pmax), alpha = __builtin_amdgcn_exp2f(m_run - mn); m_run = mn;
                float ps = 0.f;
#pragma unroll
                for (int r = 0; r < 16; ++r) { p[r] = __builtin_amdgcn_exp2f(p[r] - mn); ps += p[r]; }
                ps += __shfl_xor(ps, 32); l_run = l_run * alpha + ps;
                if (hi == 0) al[l31] = alpha;
                const bf16x8 pa0 = pack8f(p, 0), pa1 = pack8f(p, 8);
                LDS_WAIT();
#pragma unroll
                for (int r = 0; r < 16; ++r) { const float a_ = al[attn2::crow(r, hi)];
#pragma unroll
                    for (int db = 0; db < 4; ++db) o[db][r] *= a_; }
#pragma unroll
                for (int db = 0; db < 4; ++db)
#pragma unroll
                    for (int s2 = 0; s2 < 2; ++s2) { LAS unsigned char* ap = vst + trb + (16 * s2) * VROW + db * 64;
                        const v4i16_t lo = __builtin_amdgcn_ds_read_tr16_b64_v4i16((LAS v4i16_t*)ap), hh = __builtin_amdgcn_ds_read_tr16_b64_v4i16((LAS v4i16_t*)(ap + 8 * VROW));
                        const bf16x8 bfv = (bf16x8){lo[0], lo[1], lo[2], lo[3], hh[0], hh[1], hh[2], hh[3]};
                        o[db] = __builtin_amdgcn_mfma_f32_32x32x16_bf16(s2 == 0 ? pa0 : pa1, bfv, o[db], 0, 0, 0); }
                LDS_WAIT();
            }
            if (hi == 0) li[l31] = l_run;
            LDS_WAIT();
#pragma unroll
            for (int r = 0; r < 16; ++r) { const float il = 1.0f / li[attn2::crow(r, hi)];
#pragma unroll
                for (int db = 0; db < 4; ++db) MO[(tb + q0 + attn2::crow(r, hi)) * 1024 + h * 128 + 32 * db + l31] = (bf16)f2bf(o[db][r] * il); }
            LDS_WAIT();
        }
    }
}
__device__ __forceinline__ void phase_attn2(Frame& F, char* lds) {
    const float bound = *(const float*)(F.ws + WS_SMALL + SM_BOUND);
    if (bound <= 40.0f) attn2_run(F, lds); else phase_attn_slow(F);
}

static_assert(pg8::EpiInProj::O_RSTDX == WS_SMALL + SM_RSTDX && pg8::EpiInProj::O_SSQ_LAT == WS_SMALL + SM_SSQ_CQ && pg8::EpiInProj::O_SSQ_KR == WS_SMALL + SM_SSQ_KR && pg8::EpiInProj::O_CS == WS_CS && pg8::EpiInProj::O_CSM == WS_CSM && pg8::EpiInProj::O_RQ == WS_RQ && pg8::EpiInProj::O_RK == WS_RK && pg8::EpiInProj::O_RKDT == WS_RKDT && pg8::EpiInProj::O_RVT == WS_RVT && pg8::EpiInProj::O_LAT == WS_LAT && pg8::EpiInProj::O_KR == WS_KR, "EpiInProj offsets");
static_assert(pg8::EpiKVup::O_KF == WS_KF && pg8::EpiKVup::O_VV == WS_VV && pg8::EpiKVup::O_KR == WS_KR && pg8::EpiKVup::O_SSQ_CKV == WS_SMALL + SM_SSQ_CKV && pg8::EpiKVup::O_SSQ_KR == WS_SMALL + SM_SSQ_KR, "EpiKVup offsets");
#ifndef MK_N_LAUNCHES
#define MK_N_LAUNCHES 12
#endif
constexpr int N_PHASES = 12;
constexpr int N_LAUNCHES = MK_N_LAUNCHES;
struct Args { const float* in[21]; float* out; unsigned char* ws; int ph_lo, ph_hi; };
#ifndef PG8_SP2
#define PG8_SP2 true
#endif
#define PG8_ALIGN true
template <class Epi> __device__ __forceinline__ void run_gemm(Frame& F, const pg8::bf16_t* A, int lda, const pg8::bf16_t* Bt, int ldb, int N, int K, const Epi& E, int c = -1, size_t gsA = 0) {
    __syncthreads();
    pg8::Gemm g{A, Bt, MTOK, N, K, lda, ldb, gsA, F.wv0}; pg8::StaticOrder S; S.init(MTOK, N, F.G, c < 0 ? (int)blockIdx.x : c);
    pg8::gemm_phase<Epi, pg8::StaticOrder, PG8_ALIGN, PG8_SP2>(F.lds + RING_OFF, g, S, E);
}
__global__ void __launch_bounds__(NWAVES * 64, 2) mk_fwd(Args args) {
    extern __shared__ __attribute__((aligned(16))) unsigned char lds[];
    Frame F;
    F.lds = (LAS unsigned char*)lds; F.MISC = (volatile LAS unsigned*)(F.lds + MISC_OFF);
    F.tid = threadIdx.x; F.lane = F.tid & 63; F.wave = __builtin_amdgcn_readfirstlane(F.tid >> 6); F.wv0 = F.wave;
    F.G = gridDim.x; { const int bx = blockIdx.x; F.vcu = (F.G % 8 == 0) ? (bx % 8) * (F.G / 8) + bx / 8 : bx; }
    F.out = args.out; F.ws = args.ws;
    if (F.tid < 32) F.MISC[F.tid] = 0u;
    __syncthreads();
    if (N_LAUNCHES == 1) (void)xcd_barrier_post((unsigned*)(args.ws + WS_CTL) + CW_BAR, F.MISC + 8);
    const int lo = args.ph_lo, hi = args.ph_hi;
    int ctile = (int)blockIdx.x;
    bool xlocal = false;
#ifndef PH_MASK
#define PH_MASK 0xfff
#endif
#define IN(k) (((PH_MASK >> (k)) & 1) && lo <= (k) && (k) < hi)
#define BAR_NOW() XcdBarrier bar_; bar_.bar = (unsigned*)(args.ws + WS_CTL) + CW_BAR; bar_.x = xb_xcc_id(); bar_.w = (unsigned)F.wv0; bar_.st = (volatile LAS unsigned*)((LAS unsigned char*)lds + MISC_OFF) + 8
#define SEAM(k) do { asm volatile("; SEAM_MARK %0" :: "i"(k)); if (IN(k) && IN((k) + 1)) { BAR_NOW(); xcd_barrier(bar_); } } while (0)
#define SEAM_L(k) do { if (IN(k) && IN((k) + 1)) { BAR_NOW(); if (xlocal) xcd_local_barrier(bar_); else xcd_barrier(bar_); } } while (0)
#ifdef SUBSTRETCH
#define SUB_T0(n) const unsigned long long ts0_##n = __builtin_amdgcn_s_memrealtime()
#define SUB_ST(n) do { if (SUBSTRETCH == (n)) { const unsigned long long t1_ = __builtin_amdgcn_s_memrealtime(); const unsigned long long d_ = t1_ - ts0_##n; while (__builtin_amdgcn_s_memrealtime() - t1_ < d_) __builtin_amdgcn_s_sleep(8); } } while (0)
#else
#define SUB_T0(n) do {} while (0)
#define SUB_ST(n) do {} while (0)
#endif
#define PH_IDX() do { int w_ = F.wv0; asm volatile("" : "+s"(w_)); const int l_ = mk_lane(); F.tid = w_ * 64 + l_; F.lane = l_; F.wave = w_; } while (0)
#ifdef STRETCH_MASK
#define PH_T0() PH_IDX(); const unsigned long long t0_ = __builtin_amdgcn_s_memrealtime()
#define PH_STRETCH(k) do { if ((STRETCH_MASK >> (k)) & 1) { const unsigned long long t1_ = __builtin_amdgcn_s_memrealtime(); const unsigned long long d_ = (t1_ - t0_) * STRETCH_MULT; while (__builtin_amdgcn_s_memrealtime() - t1_ < d_) __builtin_amdgcn_s_sleep(8); } } while (0)
#else
#define PH_T0() PH_IDX()
#define PH_STRETCH(k) do {} while (0)
#endif
#define sm ((float*)(args.ws + WS_SMALL))
#define rstdx ((const float*)(args.ws + WS_SMALL + SM_RSTDX))
#define ssq_cq ((float*)(args.ws + WS_SMALL + SM_SSQ_CQ))
#define ssq_ckv ((float*)(args.ws + WS_SMALL + SM_SSQ_CKV))
#define ssq1 ((float*)(args.ws + WS_SMALL + SM_SSQ1))
#define ssq2 ((float*)(args.ws + WS_SMALL + SM_SSQ2))
    typedef pg8::bf16_t b16;
#define WinT ((b16*)(args.ws + WS_WIN))
#define XB ((b16*)(args.ws + WS_XB))
#define LATb ((b16*)(args.ws + WS_LAT))
#define ROb ((b16*)args.out)
    if (IN(0)) { PH_T0(); phase_p0(F, args.in[0], (const int*)args.in[2], args.in[3], args.in[4], args.in[6], args.in[7], args.in[8], args.in[9], args.in[10], args.in[11]); PH_STRETCH(0); } SEAM(0);
    if (IN(1)) { PH_T0();
        pg8::EpiInProj E{args.ws, args.in[11], (PG8_LAS unsigned char*)(F.lds + XS_OFF)};
        run_gemm(F, XB, 1024, WinT + (size_t)4096 * 1024, 1024, NIN1, 1024, E);
    PH_STRETCH(1); } SEAM(1);
    if (IN(2)) { PH_T0(); phase_r0p(F);
    PH_STRETCH(2); } SEAM(2);
    if (IN(3)) { PH_T0(); phase_r1p(F); PH_STRETCH(3); } SEAM(3);
    if (IN(4)) { PH_T0();
        SUB_T0(1); { pg8::EpiRetGate E{ROb, rstdx, (const float*)(args.ws + WS_SSQP), args.in[5]}; run_gemm(F, XB, 1024, WinT + (size_t)2048 * 1024, 1024, 2048, 1024, E); } SUB_ST(1);
        asm volatile("; SEAM_MARK 41");
        SUB_T0(2); { pg8::EpiQup E{(b16*)(args.ws + WS_QP), ssq_cq, args.in[10], (const void*)(args.ws + WS_CSM), (PG8_LAS float*)(F.lds + XS_OFF), C2Q}; run_gemm(F, LATb, LATW, (const b16*)(args.ws + WS_WUQ), 384, 2048, 384, E);
#ifdef QUP_TWICE
          run_gemm(F, LATb, LATW, (const b16*)(args.ws + WS_WUQ), 384, 2048, 384, E);
#endif
        } SUB_ST(2);
        asm volatile("; SEAM_MARK 42");
        SUB_T0(3); { pg8::EpiKVup E{args.ws, args.in[11], (PG8_LAS float*)(F.lds + XS_OFF)}; run_gemm(F, LATb + 384, LATW, (const b16*)(args.ws + WS_WUKV), 256, 2048, 256, E);
#ifdef KVUP_TWICE
          run_gemm(F, LATb + 384, LATW, (const b16*)(args.ws + WS_WUKV), 256, 2048, 256, E);
#endif
        } SUB_ST(3);
    PH_STRETCH(4); } SEAM(4);
    if (IN(5)) { PH_T0(); phase_attn2(F, (char*)lds); PH_STRETCH(5); } SEAM(5);
    if (IN(6)) { PH_T0();
        SUB_T0(4); phase_late_weights(F, args.in[1], args.in[12], args.in[13], args.in[14], args.in[15], args.in[16], args.in[17], args.in[18], args.in[19], args.in[20]); SUB_ST(4);
        { pg8::EpiRowAct<1> E{(b16*)(args.ws + WS_SG), 2048, rstdx, 0.f, (unsigned)(WS_BLK / 2)}; run_gemm(F, XB, 1024, WinT, 1024, 2048, 1024, E); }
    PH_STRETCH(6); } SEAM(6);
#ifndef NO_XLOCAL
    if (N_LAUNCHES == 1 && IN(7)) {
        if (F.tid == 0) { unsigned ok = (F.G == 256) ? 1u : 0u;
            for (unsigned j = 0; j < 16; ++j) { const unsigned c = xb_ld((unsigned*)(args.ws + WS_CTL) + CW_BAR + XB_XCNT(j)); ok &= (j < 8 ? (c == 32u) : (c == 0u)) ? 1u : 0u; }
            F.MISC[12] = ok; }
        __syncthreads();
        xlocal = F.MISC[12] != 0u; if (xlocal) ctile = (int)(F.MISC[10] * 8u + xb_xcc_id());
    }
#endif
    if (IN(7)) { PH_T0();
        { pg8::EpiGateMix<0> E{(b16*)(args.ws + WS_TM), (const b16*)(args.ws + WS_SG), 0}; run_gemm(F, ROb, 2048, (const b16*)(args.ws + WS_WBR), 2048, 1024, 2048, E, ctile); }
        VM_WAIT(); __syncthreads(); __builtin_amdgcn_fence(__ATOMIC_ACQUIRE, "agent"); VM_WAIT(); __syncthreads();
        { pg8::EpiGateMix<1> E{(b16*)(args.ws + WS_TM), (const b16*)(args.ws + WS_SG), 1024}; run_gemm(F, (const b16*)(args.ws + WS_MO), 1024, (const b16*)(args.ws + WS_WBM), 1024, 1024, 1024, E, ctile); }
    PH_STRETCH(7); } SEAM_L(7);
    if (IN(8)) { PH_T0();
#ifdef T5_F32RES
        pg8::EpiResid<false> E{(const void*)args.in[0], XB, ssq1};
#else
        pg8::EpiResid<true> E{(const void*)XB, XB, ssq1};
#endif
        run_gemm(F, (const b16*)(args.ws + WS_TM), 1024, (const b16*)(args.ws + WS_WO), 1024, 1024, 1024, E, ctile, WS_BLK); PH_STRETCH(8); } SEAM_L(8);
    if (IN(9)) { PH_T0(); pg8::EpiRowAct<2> E{(b16*)(args.ws + WS_H), 4096, ssq1, 1.0f / 1024.0f, 0u}; run_gemm(F, XB, 1024, (const b16*)(args.ws + WS_WUP), 1024, 4096, 1024, E, ctile); PH_STRETCH(9); } SEAM_L(9);
    if (IN(10)) { PH_T0(); pg8::EpiResid<true> E{(const void*)XB, XB, ssq2}; run_gemm(F, (const b16*)(args.ws + WS_H), 4096, (const b16*)(args.ws + WS_WDOWN), 4096, 1024, 4096, E, ctile); PH_STRETCH(10); } SEAM_L(10);
    if (IN(11)) { PH_T0();
        { pg8::EpiRowAct<1> E{(b16*)(args.ws + WS_GT), 1024, ssq2, 1.0f / 1024.0f, 0u}; run_gemm(F, XB, 1024, (const b16*)(args.ws + WS_WPG), 1024, 1024, 1024, E, ctile); }
        VM_WAIT(); __syncthreads(); __builtin_amdgcn_fence(__ATOMIC_ACQUIRE, "agent"); VM_WAIT(); __syncthreads();
        { pg8::EpiFinal E{args.out, (const b16*)(args.ws + WS_GT), XB}; run_gemm(F, (const b16*)(args.ws + WS_PB), 256, (const b16*)(args.ws + WS_WPLE), 256, 1024, 256, E, ctile); }
    PH_STRETCH(11); }
#undef IN
#undef sm
#undef rstdx
#undef ssq_cq
#undef ssq_ckv
#undef ssq1
#undef ssq2
#undef WinT
#undef XB
#undef LATb
#undef ROb
#undef SEAM
}


#ifdef DUMPK
struct DumpArgs { const unsigned* reg[6]; unsigned nw[6]; unsigned* out; int own; int pad; };
__global__ void dump_hash(DumpArgs d) {
    for (unsigned i = blockIdx.x * blockDim.x + threadIdx.x; i < (unsigned)MTOK * DM; i += gridDim.x * blockDim.x) {
        float s = 0.f;
        if (d.own) { const unsigned w = d.out[i]; s += __uint_as_float(w << 16) + __uint_as_float(w & 0xffff0000u); }
        for (int r = 0; r < 6; ++r) if (d.reg[r] && i < d.nw[r] * 2u) { const unsigned short v = ((const unsigned short*)d.reg[r])[i]; s += __uint_as_float((unsigned)v << 16); }
        ((float*)d.out)[i] = s;
    }
}
#endif
extern "C" void kernel_launch(void* const* d_in, const int* in_sizes, int n_in, void* d_out, int out_size, void* d_ws, size_t ws_size, hipStream_t stream) {
    static int grid = 0;
    if (grid == 0) {
        if (n_in != 21 || in_sizes[0] != MTOK * DM || out_size != MTOK * DM || ws_size < WS_END) { fprintf(stderr, "kernel_launch: unexpected shapes (n_in %d in0 %d out %d ws %zu)\n", n_in, n_in > 0 ? in_sizes[0] : -1, out_size, ws_size); grid = -1; return; }
        int dev = 0, cus = 0, per_cu = 0;
        if (hipGetDevice(&dev) != hipSuccess || hipDeviceGetAttribute(&cus, hipDeviceAttributeMultiprocessorCount, dev) != hipSuccess) { grid = -1; return; }
        if (hipFuncSetAttribute((const void*)mk_fwd, hipFuncAttributeMaxDynamicSharedMemorySize, LDS_BYTES) != hipSuccess) { fprintf(stderr, "kernel_launch: hipFuncSetAttribute failed\n"); grid = -1; return; }
        if (hipOccupancyMaxActiveBlocksPerMultiprocessor(&per_cu, (const void*)mk_fwd, NWAVES * 64, LDS_BYTES) != hipSuccess || per_cu < 1) { fprintf(stderr, "kernel_launch: occupancy query says %d workgroups per CU\n", per_cu); (void)hipGetLastError(); grid = -1; return; }
        grid = cus;
    }
    if (grid < 0) return;
    (void)hipMemsetAsync((char*)d_ws + WS_CTL, 0, CTL_ZERO_BYTES, stream);
    Args a{};
    for (int i = 0; i < 21; ++i) a.in[i] = (const float*)d_in[i];
    a.out = (float*)d_out; a.ws = (unsigned char*)d_ws;
    if (N_LAUNCHES == 1) { a.ph_lo = 0; a.ph_hi = N_PHASES; hipLaunchKernelGGL(mk_fwd, dim3(grid), dim3(NWAVES * 64), LDS_BYTES, stream, a); }
    else for (int ph = 0; ph < N_PHASES; ++ph) {
#ifdef DUMPK
        if (ph > DUMPK) break;
#endif
        a.ph_lo = ph; a.ph_hi = ph + 1; hipLaunchKernelGGL(mk_fwd, dim3(grid), dim3(NWAVES * 64), LDS_BYTES, stream, a); }
#ifdef DUMPK
    { DumpArgs d{}; d.out = (unsigned*)d_out; d.own = DUMP_OWN; const size_t offs[6] = DUMP_OFFS; const size_t len[6] = DUMP_LENS;
      for (int r = 0; r < 6; ++r) if (len[r]) { d.reg[r] = (const unsigned*)((const char*)d_ws + offs[r]); d.nw[r] = (unsigned)(len[r] / 4); }
      hipLaunchKernelGGL(dump_hash, dim3(2048), dim3(256), 0, stream, d); }
#endif
}
```

```cpp
#define MK_N_LAUNCHES 1
#define R1_PRIO 1
#define A2_MPRIO 3
#include <hip/hip_runtime.h>
#include <hip/hip_bf16.h>
#include <cstdio>
#include <cstdint>
#ifndef PG8_WGM
#define PG8_WGM 8
#endif
__device__ __forceinline__ int mk_lane() { int l; asm volatile("v_mbcnt_lo_u32_b32 %0, -1, 0\n\tv_mbcnt_hi_u32_b32 %0, -1, %0" : "=v"(l)); return l; }
namespace pg8 {
#define PG8_LAS __attribute__((address_space(3)))
typedef unsigned short bf16_t;
typedef short bf16x8 __attribute__((ext_vector_type(8)));
typedef float f32x4 __attribute__((ext_vector_type(4)));
typedef unsigned u32x4 __attribute__((ext_vector_type(4)));
constexpr int BM = 256, BK = 64, HALF = 128, HTB = HALF * BK * 2  , STAGE_BYTES = 8 * HTB, NXCD = 8, WGM = PG8_WGM;

__host__ __device__ __forceinline__ int lds_byte(int r, int c) { const int st = (r >> 4) * 2 + (c >> 5), rr = r & 15, cc = c & 31, ob = rr * 64 + cc * 2; return st * 1024 + (ob ^ (((ob >> 9) & 1) << 5)); }
__host__ __device__ __forceinline__ void stage_rc(int b, int& R, int& C) { const int st = b / 1024, sb = b % 1024, swz = sb ^ (((sb >> 9) & 1) << 5); R = (st >> 1) * 16 + swz / 64; C = (st & 1) * 32 + (swz % 64) / 2; }
__host__ __device__ __forceinline__ int perm32(int rho) { const int n = rho >> 4, i = rho & 15; return 8 * (i >> 2) + 4 * n + (i & 3); }

struct Unit { int pm, pn; };
struct Gemm { const bf16_t* A; const bf16_t* Bt; int M, N, K, lda, ldb; size_t gsA; int wv; };

struct StaticOrder {
    int nM, nN, nwg, G, c, rev;
    __host__ __device__ void init(int M, int N, int G_, int c_, int rev_ = 0) { nM = M / BM; nN = N / BM; nwg = nM * nN; G = G_; c = c_; rev = (rev_ && nwg % G_ == 0) ? 1 : 0; }
    __host__ __device__ bool next(int i, Unit& u) const {
        if (rev) { const int nr = nwg / G; if (i >= nr) return false; i = nr - 1 - i; }
        const long L = (long)i * G + c; if (L >= nwg) return false;
        int wgid = (int)L; { const int q = nwg / NXCD, r = nwg % NXCD, xcd = wgid % NXCD, off = wgid / NXCD; wgid = (xcd < r ? xcd * (q + 1) : r * (q + 1) + (xcd - r) * q) + off; }
        const int nig = WGM * nN, gid = wgid / nig, fm = gid * WGM, gsz = (nM - fm) < WGM ? (nM - fm) : WGM;
        u.pm = fm + ((wgid % nig) % gsz); u.pn = (wgid % nig) / gsz; return true;
    }
    __device__ __forceinline__ void a_ready(const Unit&) const {}
    __device__ __forceinline__ void done(const Unit&) const {}
};

#ifndef EPI_BLK_SKEW
#ifdef WS_BLK_SKEW
#define EPI_BLK_SKEW WS_BLK_SKEW
#else
#define EPI_BLK_SKEW 0
#endif
#endif
#ifndef EPI_TWICE_SEL
#define EPI_TWICE_SEL 0
#endif

typedef float f32x2 __attribute__((ext_vector_type(2)));
typedef unsigned u32x2 __attribute__((ext_vector_type(2)));
typedef __bf16 bf16x2_t __attribute__((ext_vector_type(2)));
__device__ __forceinline__ unsigned cvt_pk_bf16(float lo, float hi) { f32x2 v = {lo, hi}; bf16x2_t b = __builtin_convertvector(v, bf16x2_t); return __builtin_bit_cast(unsigned, b); }
__device__ __forceinline__ float bflo(unsigned w) { return __uint_as_float(w << 16); }
__device__ __forceinline__ float bfhi(unsigned w) { return __uint_as_float(w & 0xffff0000u); }
__device__ __forceinline__ u32x4 pack8(const float (&v)[8]) { u32x4 w; w.x = cvt_pk_bf16(v[0], v[1]); w.y = cvt_pk_bf16(v[2], v[3]); w.z = cvt_pk_bf16(v[4], v[5]); w.w = cvt_pk_bf16(v[6], v[7]); return w; }
__device__ __forceinline__ void unpack8(const u32x4 w, float (&v)[8]) { v[0] = bflo(w.x); v[1] = bfhi(w.x); v[2] = bflo(w.y); v[3] = bfhi(w.y); v[4] = bflo(w.z); v[5] = bfhi(w.z); v[6] = bflo(w.w); v[7] = bfhi(w.w); }
__device__ __forceinline__ float sigmoidf_(float x) { return __builtin_amdgcn_rcpf(1.0f + __builtin_amdgcn_exp2f(-1.4426950408889634f * x)); }
constexpr float RMS_EPS_ = 1e-6f;
typedef _Float16 h2x4_t __attribute__((ext_vector_type(8)));
__device__ __forceinline__ void rope8(const void* csm, unsigned row, unsigned i0, float (&c)[8], float (&s)[8]) {
    const h2x4_t* p = (const h2x4_t*)csm + (row * 8u + (i0 >> 2)); const h2x4_t a = p[0], b = p[1];
#pragma unroll
    for (int e = 0; e < 4; ++e) { c[e] = (float)a[2 * e]; s[e] = (float)a[2 * e + 1]; c[4 + e] = (float)b[2 * e]; s[4 + e] = (float)b[2 * e + 1]; }
}
__device__ __forceinline__ void st16(bf16_t* p, const u32x4 v) {
#ifdef ST_SC1
    asm volatile("global_store_dwordx4 %0, %1, off sc1\n\ts_nop 1" :: "v"(p), "v"(v) : "memory");
#else
    *(u32x4*)p = v;
#endif
}

#ifndef EPI_NTS
#define EPI_NTS 0
#endif
#define EPI_ST(bit, p, v) do { if (((EPI_NTS) >> (bit)) & 1) __builtin_nontemporal_store((v), (p)); else *(p) = (v); } while (0)
#ifndef EPI_NT
#define EPI_NT 0
#endif
#define EPI_LD1(bit, p) (((EPI_NT) >> (bit)) & 1 ? __builtin_nontemporal_load(p) : *(p))
#ifndef EPI_FB
#define EPI_FB 2
#endif
#ifndef GM_FENCE
#define GM_FENCE 0
#endif
#define EPI_FENCE_ROWS(m) ((((m) + 1) % EPI_FB) == 0)
#define EPI_ACC8(v, ai, bj, m) float v[8]; { const f32x4 a0_ = acc[ai][bj][m][0], a1_ = acc[ai][bj][m][1]; v[0] = a0_[0]; v[1] = a0_[1]; v[2] = a0_[2]; v[3] = a0_[3]; v[4] = a1_[0]; v[5] = a1_[1]; v[6] = a1_[2]; v[7] = a1_[3]; }

__device__ __forceinline__ void xpose_store(PG8_LAS unsigned char* st, const unsigned (&pk)[4][4], bf16_t* dst, int R, int lane, int fr, int fq) {
#pragma unroll
    for (int pass = 0; pass < 2; ++pass) {
        if ((fq >> 1) == pass) {
#pragma unroll
            for (int m = 0; m < 4; ++m)
#pragma unroll
                for (int q = 0; q < 4; ++q) { const unsigned w = pk[m][q]; const int c = (fq & 1) * 8 + 2 * q;
                    *(PG8_LAS unsigned short*)(st + c * 144 + (16 * m + fr) * 2) = (unsigned short)(w & 0xffffu);
                    *(PG8_LAS unsigned short*)(st + (c + 1) * 144 + (16 * m + fr) * 2) = (unsigned short)(w >> 16); }
        }
        asm volatile("s_waitcnt lgkmcnt(0)" ::: "memory");
#pragma unroll
        for (int k = 0; k < 2; ++k) { const int idx = lane + 64 * k, c = idx & 15, ch = idx >> 4;
            const u32x4 v = *(const PG8_LAS u32x4*)(st + c * 144 + ch * 16);
            EPI_ST(0, (u32x4*)(dst + ((size_t)ch * R + pass * 16 + c) * 8), v); }
        asm volatile("s_waitcnt lgkmcnt(0)" ::: "memory");
    }
}

struct EpiInProj {
    static constexpr bool PERM = true, AFTER_DRAIN = false, TWICE_OK = (EPI_TWICE_SEL == 1); static __device__ __forceinline__ bool twice(const Unit& u) { return u.pn < 16; }
    unsigned char* ws; const float* k_norm; PG8_LAS unsigned char* xs;
    static constexpr size_t O_RSTDX = (size_t)1 << 20, O_SSQ_LAT = ((size_t)1 << 20) + (64 << 10), O_SSQ_KR = ((size_t)1 << 20) + (320 << 10), O_CS = (size_t)57 << 20, O_CSM = (size_t)254 << 20,
        O_RQ = (size_t)94 << 20, O_RK = (size_t)126 << 20, O_RKDT = (size_t)158 << 20, O_RVT = (size_t)190 << 20, O_LAT = (size_t)73 << 20, O_KR = ((size_t)22 << 20) + (512 << 10);
    __device__ __forceinline__ void operator()(const f32x4 (&acc)[2][2][4][2], const Unit& u, int wr, int wc, int fr, int fq) const {
        const int pn = u.pn, lane = fq * 16 + fr, wid = wr * 4 + wc;
        const float* rstdx = (const float*)(ws + O_RSTDX); const h2x4_t* cs = (const h2x4_t*)(ws + O_CS); const void* csm = (const void*)(ws + O_CSM); float* ssq_lat = (float*)(ws + O_SSQ_LAT); float* ssq_kr = (float*)(ws + O_SSQ_KR);
        bf16_t* RQ = (bf16_t*)(ws + O_RQ); bf16_t* RK = (bf16_t*)(ws + O_RK); bf16_t* RKDT = (bf16_t*)(ws + O_RKDT); bf16_t* RVT = (bf16_t*)(ws + O_RVT); bf16_t* LAT = (bf16_t*)(ws + O_LAT); bf16_t* KR = (bf16_t*)(ws + O_KR);
        PG8_LAS unsigned char* st = xs + wid * 2304;
        const int rowt = u.pm * BM + wr * 64 + fr;
        const int bidx = (u.pm * BM) >> 12, s0 = (u.pm * BM) & 4095;
        if (pn < 8) {
            const bool isk = pn >= 4; const int head = pn & 3;
            const float lg2 = __builtin_amdgcn_logf(1.0f - __builtin_amdgcn_exp2f(-5.0f - (float)head));
            bf16_t* O = isk ? RK : RQ;
#pragma unroll
            for (int ai = 0; ai < 2; ++ai) {
                unsigned pk0[4][4], pk1[4][4];
#pragma unroll
                for (int m = 0; m < 4; ++m) {
                    const int row = rowt + ai * HALF + m * 16; const float rs = rstdx[row] * (isk ? 0.0625f : 1.0f);
                    const h2x4_t* cp = cs + ((unsigned)row * 32u + (unsigned)(wc * 8 + fq * 2));
                    const h2x4_t c0 = cp[0], c1 = cp[1];
                    const float cc[8] = {(float)c0[0], (float)c0[2], (float)c0[4], (float)c0[6], (float)c1[0], (float)c1[2], (float)c1[4], (float)c1[6]},
                                ss[8] = {(float)c0[1], (float)c0[3], (float)c0[5], (float)c0[7], (float)c1[1], (float)c1[3], (float)c1[5], (float)c1[7]};
                    EPI_ACC8(x1, ai, 0, m); EPI_ACC8(x2, ai, 1, m);
                    float o1[8], o2[8];
#pragma unroll
                    for (int e = 0; e < 8; ++e) { const float a = x1[e] * rs, b = x2[e] * rs; o1[e] = a * cc[e] - b * ss[e]; o2[e] = b * cc[e] + a * ss[e]; }
                    bf16_t* rp = O + ((((size_t)(bidx * 4 + head) * 32 + (s0 >> 7) + ai) * 32 + wc * 4 + fq) * 128 + wr * 64 + m * 16 + fr) * 8;
                    EPI_ST(0, (u32x4*)rp, pack8(o1)); EPI_ST(0, (u32x4*)(rp + (size_t)16 * 128 * 8), pack8(o2));
                    if (isk) { const float kdm = __builtin_amdgcn_exp2f((float)(127 - (wr * 64 + m * 16 + fr)) * lg2);
#pragma unroll
                        for (int q = 0; q < 4; ++q) { pk0[m][q] = cvt_pk_bf16(o1[2 * q] * kdm, o1[2 * q + 1] * kdm); pk1[m][q] = cvt_pk_bf16(o2[2 * q] * kdm, o2[2 * q + 1] * kdm); }
                    }
                }
                if (isk) {
                    bf16_t* d0 = RKDT + ((((size_t)(bidx * 4 + head) * 32 + (s0 >> 7) + ai) * 16 + wr * 8) * 256 + wc * 32) * 8;
                    xpose_store(st, pk0, d0, 256, lane, fr, fq);
                    xpose_store(st, pk1, d0 + (size_t)HALF * 8, 256, lane, fr, fq);
                }
            }
        } else if (pn < 16) {
            const int head = (pn - 8) >> 1, dvb = ((pn - 8) & 1) * 256;
#pragma unroll
            for (int ai = 0; ai < 2; ++ai)
#pragma unroll
                for (int bj = 0; bj < 2; ++bj) {
                    unsigned pk[4][4];
#pragma unroll
                    for (int m = 0; m < 4; ++m) { const float rs = rstdx[rowt + ai * HALF + m * 16]; EPI_ACC8(v, ai, bj, m);
#pragma unroll
                        for (int q = 0; q < 4; ++q) pk[m][q] = cvt_pk_bf16(v[2 * q] * rs, v[2 * q + 1] * rs); }
                    bf16_t* d0 = RVT + ((((size_t)(bidx * 4 + head) * 32 + (s0 >> 7) + ai) * 16 + wr * 8) * 512 + dvb + bj * HALF + wc * 32) * 8;
                    xpose_store(st, pk, d0, 512, lane, fr, fq);
                }
        } else if (pn < 19) {
            const int lt = pn - 16; int fqo = fq; asm volatile("" : "+v"(fqo));
            PG8_LAS float* xq = (PG8_LAS float*)xs;
            const int lo = mk_lane(), fro = lo & 15;
#pragma unroll
            for (int ai = 0; ai < 2; ++ai)
#pragma unroll
                for (int m = 0; m < 4; ++m) { const int row = rowt + ai * HALF + m * 16; const float rs = rstdx[row];
#pragma unroll
                    for (int bj = 0; bj < 2; ++bj) { if (lt == 2 && bj == 1) continue;
                        EPI_ACC8(v, ai, bj, m); float q = 0.f;
#pragma unroll
                        for (int e = 0; e < 8; ++e) { v[e] *= rs; q += v[e] * v[e]; }
                        EPI_ST(0, (u32x4*)(LAT + ((unsigned)row * 640u + lt * 256 + bj * HALF + wc * 32 + 8 * fqo)), pack8(v));
                        q += __shfl_xor(q, 16); q += __shfl_xor(q, 32); if (fq == 0) xq[((bj * 256) + ai * HALF + wr * 64 + m * 16 + fro) * 4 + wc] = q; } }
            asm volatile("s_waitcnt lgkmcnt(0)\n\ts_barrier" ::: "memory");
            if (wc < 2) { const int rl = wr * 128 + wc * 64 + lo;
#pragma unroll
                for (int bj = 0; bj < 2; ++bj) { if (lt == 2 && bj == 1) continue;
                    const int kind = (lt == 0) ? 0 : (lt == 1 ? (bj == 0 ? 0 : 1) : 1);
                    const f32x4 p4 = *(const PG8_LAS f32x4*)(xq + ((bj * 256) + rl) * 4);
                    atomicAdd(ssq_lat + kind * 16384 + u.pm * BM + rl, (p4[0] + p4[1]) + (p4[2] + p4[3])); } }
        } else if (wc == 0) {
#pragma unroll
            for (int ai = 0; ai < 2; ++ai)
#pragma unroll
                for (int m = 0; m < 4; ++m) { const int row = rowt + ai * HALF + m * 16; const float rs = rstdx[row];
                    float q = 0.f; unsigned w1[4], w2[4]; const h2x4_t* cp = (const h2x4_t*)csm + ((unsigned)row * 8u + 2u * (unsigned)fq);
#pragma unroll
                    for (int hh = 0; hh < 2; ++hh) { const f32x4 xa = acc[ai][0][m][hh] * rs, xb = acc[ai][1][m][hh] * rs; const f32x4 ga = *(const f32x4*)(k_norm + 128 + 8 * fq + 4 * hh), gb = *(const f32x4*)(k_norm + 160 + 8 * fq + 4 * hh);
                        const h2x4_t t4 = cp[hh]; float oa[4], ob[4];
#pragma unroll
                        for (int e = 0; e < 4; ++e) { q += xa[e] * xa[e] + xb[e] * xb[e]; const float ya = xa[e] * ga[e], yb = xb[e] * gb[e], c_ = (float)t4[2 * e], s_ = (float)t4[2 * e + 1];
                            oa[e] = ya * c_ - yb * s_; ob[e] = yb * c_ + ya * s_; }
                        w1[2 * hh] = cvt_pk_bf16(oa[0], oa[1]); w1[2 * hh + 1] = cvt_pk_bf16(oa[2], oa[3]); w2[2 * hh] = cvt_pk_bf16(ob[0], ob[1]); w2[2 * hh + 1] = cvt_pk_bf16(ob[2], ob[3]); }
                    *(u32x4*)(KR + ((unsigned)row * 64u + 8u * fq)) = (u32x4){w1[0], w1[1], w1[2], w1[3]}; *(u32x4*)(KR + ((unsigned)row * 64u + 32u + 8u * fq)) = (u32x4){w2[0], w2[1], w2[2], w2[3]};
                    q += __shfl_xor(q, 16); q += __shfl_xor(q, 32); if (fq == 0) ssq_kr[row] = q;
                    asm volatile("" ::: "memory"); }
        }
    }
};

struct EpiKVup {
    static constexpr bool PERM = true, AFTER_DRAIN = false, TWICE_OK = (EPI_TWICE_SEL == 2); static __device__ __forceinline__ bool twice(const Unit&) { return true; }
    unsigned char* ws; const float* k_norm; PG8_LAS float* xr;
    static constexpr size_t O_KF = (size_t)142 << 20, O_VV = (size_t)190 << 20, O_KR = ((size_t)22 << 20) + (512 << 10), O_SSQ_CKV = ((size_t)1 << 20) + (128 << 10), O_SSQ_KR = ((size_t)1 << 20) + (320 << 10);
    __device__ __forceinline__ void operator()(const f32x4 (&acc)[2][2][4][2], const Unit& u, int wr, int wc, int fr, int fq) const {
        const unsigned rowt = u.pm * BM + wr * 64 + fr, head = u.pn, d0 = wc * 32 + 8 * fq;
        bf16_t* KF = (bf16_t*)(ws + O_KF); bf16_t* VV = (bf16_t*)(ws + O_VV); const bf16_t* KR = (const bf16_t*)(ws + O_KR); const float* ssq_ckv = (const float*)(ws + O_SSQ_CKV); const float* ssq_kr = (const float*)(ws + O_SSQ_KR);
        float rs8[2][4], kr8[2][4]; u32x2 krp[2][4];
#pragma unroll
        for (int ai = 0; ai < 2; ++ai)
#pragma unroll
            for (int m = 0; m < 4; ++m) { rs8[ai][m] = __builtin_amdgcn_rsqf(ssq_ckv[rowt + ai * HALF + m * 16] * (1.0f / 256.0f) + RMS_EPS_); kr8[ai][m] = ssq_kr[rowt + ai * HALF + m * 16]; krp[ai][m] = *(const u32x2*)(KR + ((rowt + ai * HALF + m * 16) * 64u + 16 * wc + 4 * fq)); }
#pragma unroll
        for (int ai = 0; ai < 2; ++ai)
#pragma unroll
            for (int m = 0; m < 4; ++m) { const float rs = rs8[ai][m];
                const f32x4 a0 = acc[ai][0][m][0] * rs, a1 = acc[ai][0][m][1] * rs;
                float q = (a0[0] * a0[0] + a0[1] * a0[1]) + (a0[2] * a0[2] + a0[3] * a0[3]) + (a1[0] * a1[0] + a1[1] * a1[1]) + (a1[2] * a1[2] + a1[3] * a1[3]);
                q += __shfl_xor(q, 16); q += __shfl_xor(q, 32);
                if (fq == 0) xr[(ai * HALF + wr * 64 + m * 16 + fr) * 4 + wc] = q; }
        asm volatile("s_waitcnt lgkmcnt(0)\n\ts_barrier" ::: "memory");
        const f32x4 g0 = *(const f32x4*)(k_norm + d0), g1 = *(const f32x4*)(k_norm + d0 + 4);
#pragma unroll
        for (int ai = 0; ai < 2; ++ai)
#pragma unroll
            for (int m = 0; m < 4; ++m) { const unsigned row = rowt + ai * HALF + m * 16; const float rs = rs8[ai][m];
                const f32x4 p4 = *(const PG8_LAS f32x4*)(xr + (ai * HALF + wr * 64 + m * 16 + fr) * 4);
                const float sk = __builtin_amdgcn_rsqf(((p4[0] + p4[1]) + (p4[2] + p4[3]) + kr8[ai][m]) * (1.0f / 192.0f) + RMS_EPS_), rk = rs * sk;
                { EPI_ACC8(v, ai, 0, m);
#pragma unroll
                  for (int e = 0; e < 8; ++e) v[e] *= rk * (e < 4 ? g0[e & 3] : g1[e & 3]);
                  EPI_ST(2, (u32x4*)(KF + (row * 1536u + head * 192u + d0)), pack8(v)); }
                { EPI_ACC8(v, ai, 1, m);
#pragma unroll
                  for (int e = 0; e < 8; ++e) v[e] *= rs;
                  EPI_ST(2, (u32x4*)(VV + (row * 1024u + head * 128u + d0)), pack8(v)); }
                { const u32x2 kr = krp[ai][m];
                  EPI_ST(2, (u32x2*)(KF + (row * 1536u + head * 192u + 128 + 16 * wc + 4 * fq)), ((u32x2){cvt_pk_bf16(bflo(kr.x) * sk, bfhi(kr.x) * sk), cvt_pk_bf16(bflo(kr.y) * sk, bfhi(kr.y) * sk)})); } }
    }
};

struct EpiQup {
    static constexpr bool PERM = true, AFTER_DRAIN = false, TWICE_OK = (EPI_TWICE_SEL == 3); static __device__ __forceinline__ bool twice(const Unit&) { return true; }
    bf16_t* QP; const float* ssq_cq; const float* q_norm; const void* csm; PG8_LAS float* xr; float c2q;
    __device__ __forceinline__ void operator()(const f32x4 (&acc)[2][2][4][2], const Unit& u, int wr, int wc, int fr, int fq) const {
        const unsigned rowt = u.pm * BM + wr * 64 + fr, head = u.pn;
        float rs8[2][4];
#pragma unroll
        for (int ai = 0; ai < 2; ++ai)
#pragma unroll
            for (int m = 0; m < 4; ++m) { const float rs = __builtin_amdgcn_rsqf(ssq_cq[rowt + ai * HALF + m * 16] * (1.0f / 384.0f) + RMS_EPS_); rs8[ai][m] = rs;
                const f32x4 a0 = acc[ai][0][m][0] * rs, a1 = acc[ai][0][m][1] * rs, b0 = acc[ai][1][m][0] * rs, b1 = acc[ai][1][m][1] * rs;
                float q = ((a0[0] * a0[0] + a0[1] * a0[1]) + (a0[2] * a0[2] + a0[3] * a0[3])) + ((a1[0] * a1[0] + a1[1] * a1[1]) + (a1[2] * a1[2] + a1[3] * a1[3]))
                        + ((b0[0] * b0[0] + b0[1] * b0[1]) + (b0[2] * b0[2] + b0[3] * b0[3])) + ((b1[0] * b1[0] + b1[1] * b1[1]) + (b1[2] * b1[2] + b1[3] * b1[3]));
                q += __shfl_xor(q, 16); q += __shfl_xor(q, 32);
                if (fq == 0) xr[(ai * HALF + wr * 64 + m * 16 + fr) * 4 + wc] = q; }
        asm volatile("s_waitcnt lgkmcnt(0)\n\ts_barrier" ::: "memory");
        const unsigned dA = wc < 3 ? wc * 32 + 8 * fq : 128 + 8 * fq, dB = wc == 0 ? 96 + 8 * fq : 160 + 8 * fq;
        const f32x4 gA0 = *(const f32x4*)(q_norm + dA), gA1 = *(const f32x4*)(q_norm + dA + 4), gB0 = *(const f32x4*)(q_norm + dB), gB1 = *(const f32x4*)(q_norm + dB + 4);
#pragma unroll
        for (int ai = 0; ai < 2; ++ai)
#pragma unroll
            for (int m = 0; m < 4; ++m) { const unsigned row = rowt + ai * HALF + m * 16; const float rs = rs8[ai][m];
                const f32x4 p4 = *(const PG8_LAS f32x4*)(xr + (ai * HALF + wr * 64 + m * 16 + fr) * 4);
                const float sc = __builtin_amdgcn_rsqf(((p4[0] + p4[1]) + (p4[2] + p4[3])) * (1.0f / 192.0f) + RMS_EPS_) * rs * c2q;
                EPI_ACC8(va, ai, 0, m); EPI_ACC8(vb, ai, 1, m);
#pragma unroll
                for (int e = 0; e < 8; ++e) { va[e] *= sc * (e < 4 ? gA0[e & 3] : gA1[e & 3]); vb[e] *= sc * (e < 4 ? gB0[e & 3] : gB1[e & 3]); }
                bf16_t* qrow = QP + (row * 1536u + head * 192u);
                if (wc == 3) {
                    float cc[8], sn[8]; rope8(csm, row, 8 * fq, cc, sn);
#pragma unroll
                    for (int e = 0; e < 8; ++e) { const float a_ = va[e], b_ = vb[e]; va[e] = a_ * cc[e] - b_ * sn[e]; vb[e] = b_ * cc[e] + a_ * sn[e]; }
                }
                EPI_ST(1, (u32x4*)(qrow + dA), pack8(va));
                if (wc == 0 || wc == 3) EPI_ST(1, (u32x4*)(qrow + dB), pack8(vb)); }
    }
};

template <int MODE> struct EpiRowAct {
    static constexpr bool PERM = true, AFTER_DRAIN = false, TWICE_OK = (EPI_TWICE_SEL == 4); static __device__ __forceinline__ bool twice(const Unit&) { return true; }
    bf16_t* O; int ldo; const float* rsrc; float inv_dim; unsigned gso;
    __device__ __forceinline__ void operator()(const f32x4 (&acc)[2][2][4][2], const Unit& u, int wr, int wc, int fr, int fq) const {
        const int rowt = u.pm * BM + wr * 64 + fr, colt = u.pn * BM + wc * 32 + 8 * fq;
#pragma unroll
        for (int ai = 0; ai < 2; ++ai)
#pragma unroll
            for (int m = 0; m < 4; ++m) { const int row = rowt + ai * HALF + m * 16; const float r0 = rsrc[row]; const float rs = inv_dim == 0.f ? r0 : __builtin_amdgcn_rsqf(r0 * inv_dim + RMS_EPS_);
#pragma unroll
                for (int bj = 0; bj < 2; ++bj) { EPI_ACC8(v, ai, bj, m);
#pragma unroll
                    for (int e = 0; e < 8; ++e) { float x = v[e] * rs; if (MODE == 1 || MODE == 3) x = sigmoidf_(x); if (MODE == 2) { x = fmaxf(x, 0.f); x = x * x; } v[e] = x; }
                    if (MODE == 3) { unsigned b[8];
#pragma unroll
                        for (int e = 0; e < 8; ++e) b[e] = (unsigned)(v[e] * 255.0f + 0.5f);
                        { u32x2* gp_ = (u32x2*)((unsigned char*)O + (gso ? (size_t)(row >> 11) * gso * 2 + (size_t)(row & 2047) * ldo : (size_t)row * ldo) + colt + bj * HALF); const u32x2 gv_ = {b[0] | (b[1] << 8) | (b[2] << 16) | (b[3] << 24), b[4] | (b[5] << 8) | (b[6] << 16) | (b[7] << 24)};
                        if ((((EPI_NTS) >> 4) & 1) && gso) __builtin_nontemporal_store(gv_, gp_); else *gp_ = gv_; } }
#ifdef NT_H
                    else if (MODE == 2) __builtin_nontemporal_store(pack8(v), (u32x4*)(O + (size_t)row * ldo + colt + bj * HALF));
#endif
                    else st16(O + (gso ? (size_t)(row >> 11) * gso + (size_t)(row & 2047) * ldo : (size_t)row * ldo) + colt + bj * HALF, pack8(v)); } }
    }
};
struct EpiRetGate {
    static constexpr bool PERM = true, AFTER_DRAIN = false, TWICE_OK = (EPI_TWICE_SEL == 5); static __device__ __forceinline__ bool twice(const Unit&) { return false; }
    bf16_t* RO; const float* rstdx; const float* ssq_ro; const float* ret_norm; PG8_LAS float* xs;
    __device__ __forceinline__ void operator()(const f32x4 (&acc)[2][2][4][2], const Unit& u, int wr, int wc, int fr, int fq) const {
        const int rowt = u.pm * BM + wr * 64 + fr, colt = u.pn * BM + wc * 32 + 8 * fq, head = u.pn >> 1;
        { const int rl = wr * 128 + (wc & 1) * 64 + fq * 16 + fr, hf = wc >> 1, grow = u.pm * BM + rl;
          const f32x4* sp = (const f32x4*)(ssq_ro + ((size_t)grow * 4 + head) * 16) + 2 * hf; const f32x4 s4 = sp[0] + sp[1];
          const float rsx = rstdx[grow];
          xs[hf * 256 + rl] = (s4[0] + s4[1]) + (s4[2] + s4[3]); if (hf == 0) xs[512 + rl] = rsx; }
        f32x4 g[2][2];
#pragma unroll
        for (int bj = 0; bj < 2; ++bj) { g[bj][0] = *(const f32x4*)(ret_norm + colt + bj * HALF); g[bj][1] = *(const f32x4*)(ret_norm + colt + bj * HALF + 4); }
        asm volatile("s_waitcnt lgkmcnt(0)\n\ts_barrier" ::: "memory");
#pragma unroll
        for (int ai = 0; ai < 2; ++ai) {
            u32x4 ro[4][2];
#pragma unroll
            for (int m = 0; m < 4; ++m)
#pragma unroll
                for (int bj = 0; bj < 2; ++bj) ro[m][bj] = EPI_LD1(2, (const u32x4*)(RO + (size_t)(rowt + ai * HALF + m * 16) * 2048 + colt + bj * HALF));
#pragma unroll
            for (int m = 0; m < 4; ++m) { const int row = rowt + ai * HALF + m * 16, r = ai * HALF + wr * 64 + m * 16 + fr; const float rs = xs[512 + r];
                const float rr = __builtin_amdgcn_rsqf((xs[r] + xs[256 + r]) * (1.0f / 512.0f) + RMS_EPS_);
#pragma unroll
                for (int bj = 0; bj < 2; ++bj) { EPI_ACC8(v, ai, bj, m); bf16_t* p = RO + (size_t)row * 2048 + colt + bj * HALF; float o[8]; unpack8(ro[m][bj], o);
#pragma unroll
                    for (int e = 0; e < 8; ++e) { const float x = v[e] * rs; const float gg = e < 4 ? g[bj][0][e & 3] : g[bj][1][e & 3]; v[e] = o[e] * rr * gg * x * sigmoidf_(x); }
                    EPI_ST(3, (u32x4*)p, pack8(v)); } } }
    }
};
template <int MODE> struct EpiGateMix {
    static constexpr bool PERM = true, AFTER_DRAIN = false, TWICE_OK = (EPI_TWICE_SEL == 6); static __device__ __forceinline__ bool twice(const Unit&) { return false; }
    bf16_t* TM; const unsigned char* SG; int sgoff; static constexpr size_t BLKE = ((size_t)16 << 20) / 2 + (size_t)(EPI_BLK_SKEW) * 512;
    __device__ __forceinline__ void operator()(const f32x4 (&acc)[2][2][4][2], const Unit& u, int wr, int wc, int fr, int fq) const {
        const int rowt = u.pm * BM + wr * 64 + fr, colt = u.pn * BM + wc * 32 + 8 * fq;
#pragma unroll
        for (int ai = 0; ai < 2; ++ai)
#pragma unroll
            for (int m = 0; m < 4; ++m) { const int row = rowt + ai * HALF + m * 16;
#pragma unroll
                for (int bj = 0; bj < 2; ++bj) { EPI_ACC8(v, ai, bj, m); float s[8]; { const u32x2 g2 = EPI_LD1(3, (const u32x2*)(SG + (size_t)(row >> 11) * (BLKE * 2) + (size_t)(row & 2047) * 2048 + sgoff + colt + bj * HALF));
#pragma unroll
                        for (int e = 0; e < 8; ++e) s[e] = (float)(((e < 4 ? g2[0] : g2[1]) >> (8 * (e & 3))) & 0xffu) * (1.0f / 255.0f); }
                    bf16_t* p = TM + (size_t)(row >> 11) * BLKE + (size_t)(row & 2047) * 1024 + colt + bj * HALF;
                    if (MODE == 1) { float t[8]; unpack8(EPI_LD1(3, (const u32x4*)p), t);
#pragma unroll
                        for (int e = 0; e < 8; ++e) v[e] = t[e] + s[e] * v[e]; }
                    else {
#pragma unroll
                        for (int e = 0; e < 8; ++e) v[e] = s[e] * v[e]; }
                    *(u32x4*)p = pack8(v); }
                if (GM_FENCE && EPI_FENCE_ROWS(m)) asm volatile("" ::: "memory"); }
    }
};
template <bool RESB> struct EpiResid {
    static constexpr bool PERM = true, AFTER_DRAIN = false, TWICE_OK = (EPI_TWICE_SEL == 7); static __device__ __forceinline__ bool twice(const Unit&) { return false; }
    const void* res; bf16_t* xb; float* ssq; PG8_LAS float* xq;
    __device__ __forceinline__ void operator()(const f32x4 (&acc)[2][2][4][2], const Unit& u, int wr, int wc, int fr, int fq) const {
        const int rowt = u.pm * BM + wr * 64 + fr, colt = u.pn * BM + wc * 32 + 8 * fq;
#pragma unroll
        for (int ai = 0; ai < 2; ++ai)
#pragma unroll
            for (int m = 0; m < 4; ++m) { const int row = rowt + ai * HALF + m * 16; float q = 0.f;
#pragma unroll
                for (int bj = 0; bj < 2; ++bj) { EPI_ACC8(v, ai, bj, m); const size_t off = (size_t)row * 1024 + colt + bj * HALF;
                    if (RESB) { float r[8]; unpack8(EPI_LD1(1, (const u32x4*)((const bf16_t*)res + off)), r);
#pragma unroll
                        for (int e = 0; e < 8; ++e) { v[e] += r[e]; q += v[e] * v[e]; } }
                    else { const f32x4 r0 = *(const f32x4*)((const float*)res + off), r1 = *(const f32x4*)((const float*)res + off + 4);
#pragma unroll
                        for (int e = 0; e < 8; ++e) { v[e] += e < 4 ? r0[e & 3] : r1[e & 3]; q += v[e] * v[e]; } }
                    *(u32x4*)(xb + off) = pack8(v); }
                q += __shfl_xor(q, 16); q += __shfl_xor(q, 32); if (fq == 0) xq[(ai * HALF + wr * 64 + m * 16 + fr) * 4 + wc] = q;
                if (EPI_FENCE_ROWS(m)) asm volatile("" ::: "memory"); }
        asm volatile("s_waitcnt lgkmcnt(0)\n\ts_barrier" ::: "memory");
        if (wc < 2) { const int rl = wr * 128 + wc * 64 + fq * 16 + fr; const f32x4 p4 = *(const PG8_LAS f32x4*)(xq + rl * 4); atomicAdd(ssq + u.pm * BM + rl, (p4[0] + p4[1]) + (p4[2] + p4[3])); }
    }
};
struct EpiFinal {
    static constexpr bool PERM = true, AFTER_DRAIN = false, TWICE_OK = (EPI_TWICE_SEL == 8); static __device__ __forceinline__ bool twice(const Unit&) { return false; }
    float* out; const unsigned char* GT; const bf16_t* xb;
    __device__ __forceinline__ void operator()(const f32x4 (&acc)[2][2][4][2], const Unit& u, int wr, int wc, int fr, int fq) const {
        const int rowt = u.pm * BM + wr * 64 + fr, colt = u.pn * BM + wc * 32 + 8 * fq;
#pragma unroll
        for (int ai = 0; ai < 2; ++ai)
#pragma unroll
            for (int m = 0; m < 4; ++m) { const int row = rowt + ai * HALF + m * 16;
#pragma unroll
                for (int bj = 0; bj < 2; ++bj) { EPI_ACC8(v, ai, bj, m); const size_t off = (size_t)row * 1024 + colt + bj * HALF; float gt[8], r[8]; { const u32x2 g2 = EPI_LD1(0, (const u32x2*)(GT + off));
#pragma unroll
                        for (int e = 0; e < 8; ++e) gt[e] = (float)(((e < 4 ? g2[0] : g2[1]) >> (8 * (e & 3))) & 0xffu) * (1.0f / 255.0f); }
                    unpack8(EPI_LD1(0, (const u32x4*)(xb + off)), r);
#pragma unroll
                    for (int e = 0; e < 8; ++e) v[e] = r[e] + gt[e] * v[e];
#ifdef NT_OUT
                    __builtin_nontemporal_store((f32x4){v[0], v[1], v[2], v[3]}, (f32x4*)(out + off)); __builtin_nontemporal_store((f32x4){v[4], v[5], v[6], v[7]}, (f32x4*)(out + off + 4)); }
#else
                    *(f32x4*)(out + off) = (f32x4){v[0], v[1], v[2], v[3]}; *(f32x4*)(out + off + 4) = (f32x4){v[4], v[5], v[6], v[7]}; }
#endif
                if (EPI_FENCE_ROWS(m)) asm volatile("" ::: "memory"); }
    }
};
template <class Epi, class Sched, bool ALIGN_EPI = false, bool SP2 = false>
__device__ __forceinline__ void gemm_phase(PG8_LAS unsigned char* lds, const Gemm g, const Sched& S, const Epi& E) {
    int tid = g.wv * 64 + mk_lane();
    const int wid = __builtin_amdgcn_readfirstlane(tid >> 6), lane = tid & 63, wr = wid >> 2, wc = wid & 3, fr = lane & 15, fq = lane >> 4;
    int K = g.K; if (g.K < 512) asm volatile("" : "+s"(K));
    const int nt = K / BK;
    unsigned voffA[2], voffB[2];
#pragma unroll
    for (int i = 0; i < 2; ++i) { int R, C; stage_rc(tid * 16 + i * 8192, R, C); const int Rb = Epi::PERM ? ((R & ~31) + perm32(R & 31)) : R;
        voffA[i] = (unsigned)(R * g.lda + C) * 2u; voffB[i] = (unsigned)(Rb * g.ldb + C) * 2u; }
    const size_t kstep = (size_t)(BK * 2);
    const size_t hstepA = (size_t)HALF * g.lda * 2, hstepB = (size_t)HALF * g.ldb * 2;
    const size_t tstepA = 2 * hstepA, tstepB = 2 * hstepB;
    const unsigned ldsw = (unsigned)wid * 1024u;
    const int aoff = lds_byte(wr * 64 + fr, fq * 8), boff = lds_byte(wc * 32 + fr, fq * 8);
#define PG8_SA(b, h) (((b) * 2 + (h)) * HTB)
#define PG8_SB(b, h) ((4 + (b) * 2 + (h)) * HTB)
#ifndef PG8_AUX_A
#define PG8_AUX_A 0
#endif
#ifndef PG8_AUX_B
#define PG8_AUX_B 0
#endif
#define PG8_STAGE_X(bufoff, gbase, voff, AUX) do { _Pragma("unroll") for (int _i = 0; _i < 2; ++_i) \
        __builtin_amdgcn_global_load_lds((const unsigned*)((const char*)(gbase) + (voff)[_i]), (PG8_LAS unsigned*)(lds + (bufoff) + ldsw + _i * 8192), 16, 0, AUX); } while (0)
#define PG8_STAGE(bufoff, gbase, voff) do { if (&(voff)[0] == &voffA[0]) PG8_STAGE_X(bufoff, gbase, voff, PG8_AUX_A); else PG8_STAGE_X(bufoff, gbase, voff, PG8_AUX_B); } while (0)
#define PG8_LDA(dst, b, h) do { _Pragma("unroll") for (int m = 0; m < 4; ++m) _Pragma("unroll") for (int k = 0; k < 2; ++k) dst[m][k] = *(const PG8_LAS bf16x8*)(lds + PG8_SA(b, h) + aoff + m * 2048 + k * 1024); } while (0)
#define PG8_LDB(dst, b, h) do { _Pragma("unroll") for (int n = 0; n < 2; ++n) _Pragma("unroll") for (int k = 0; k < 2; ++k) dst[n][k] = *(const PG8_LAS bf16x8*)(lds + PG8_SB(b, h) + boff + n * 2048 + k * 1024); } while (0)
#ifndef PG8_PRIO
#define PG8_PRIO 1
#endif
#define PG8_MMA(ai, bj, At, Bt) do { if (PG8_PRIO) __builtin_amdgcn_s_setprio(1); _Pragma("unroll") for (int m = 0; m < 4; ++m) _Pragma("unroll") for (int n = 0; n < 2; ++n) _Pragma("unroll") for (int k = 0; k < 2; ++k) \
        acc[ai][bj][m][n] = __builtin_amdgcn_mfma_f32_16x16x32_bf16(Bt[n][k], At[m][k], acc[ai][bj][m][n], 0, 0, 0); if (PG8_PRIO) __builtin_amdgcn_s_setprio(0); } while (0)
#define PG8_WAIT_V(n) asm volatile("s_waitcnt vmcnt(" #n ")" ::: "memory")
#define PG8_WAIT_L(n) asm volatile("s_waitcnt lgkmcnt(" #n ")" ::: "memory")
#define PG8_BAR __builtin_amdgcn_s_barrier()
#define PG8_SCHED __builtin_amdgcn_sched_barrier(0)
    Unit cur, nxt; int ui = 0;
    if (!S.next(0, cur)) return;
    f32x4 acc[2][2][4][2];
#pragma unroll
    for (int a = 0; a < 2; ++a)
#pragma unroll
        for (int b = 0; b < 2; ++b)
#pragma unroll
            for (int m = 0; m < 4; ++m)
#pragma unroll
                for (int n = 0; n < 2; ++n) acc[a][b][m][n] = (f32x4){0.f, 0.f, 0.f, 0.f};
    bf16x8 At[4][2], B0[2][2], B1[2][2];
#define PG8_AROW(pm_) ((const char*)g.A + (g.gsA ? (size_t)((pm_) >> 3) * g.gsA + (size_t)((pm_) & 7) * tstepA : (size_t)(pm_) * tstepA))
    const char* cA = PG8_AROW(cur.pm); const char* cB = (const char*)g.Bt + (size_t)cur.pn * tstepB;
    S.a_ready(cur);
    if constexpr (SP2) {
        PG8_STAGE(PG8_SB(0, 0), cB, voffB); PG8_STAGE(PG8_SB(0, 1), cB + hstepB, voffB); PG8_STAGE(PG8_SA(0, 0), cA, voffA); PG8_STAGE(PG8_SA(0, 1), cA + hstepA, voffA);
        if (wr == 1) PG8_BAR;
        PG8_WAIT_V(2); PG8_BAR;
        PG8_STAGE(PG8_SB(1, 0), cB + kstep, voffB); PG8_STAGE(PG8_SA(1, 0), cA + kstep, voffA); PG8_STAGE(PG8_SB(1, 1), cB + hstepB + kstep, voffB);
        PG8_WAIT_V(6); PG8_BAR;
    } else {
        PG8_STAGE(PG8_SB(0, 0), cB, voffB); PG8_STAGE(PG8_SA(0, 0), cA, voffA); PG8_STAGE(PG8_SB(0, 1), cB + hstepB, voffB); PG8_STAGE(PG8_SA(0, 1), cA + hstepA, voffA);
        if (wr == 1) PG8_BAR;
        PG8_WAIT_V(4); PG8_BAR;
        PG8_STAGE(PG8_SB(1, 0), cB + kstep, voffB); PG8_STAGE(PG8_SA(1, 0), cA + kstep, voffA); PG8_STAGE(PG8_SB(1, 1), cB + hstepB + kstep, voffB);
        PG8_WAIT_V(6); PG8_BAR;
    }
    for (;;) {
        const bool has_next = S.next(ui + 1, nxt);
        const char* nA = has_next ? PG8_AROW(nxt.pm) : cA; const char* nB = has_next ? (const char*)g.Bt + (size_t)nxt.pn * tstepB : cB;
        for (int t = 0; t < nt; t += 2) {
            const bool last = (t == nt - 2);
            const char* a1 = cA + (size_t)(t + 1) * kstep;
            const char* a2 = last ? nA : cA + (size_t)(t + 2) * kstep; const char* b2 = last ? nB : cB + (size_t)(t + 2) * kstep;
            const char* a3 = a2 + kstep; const char* b3 = b2 + kstep;
            if (last && has_next) S.a_ready(nxt);
            if constexpr (SP2) {
            PG8_LDB(B0, 0, 0); PG8_LDB(B1, 0, 1); PG8_SCHED; PG8_LDA(At, 0, 0); PG8_STAGE(PG8_SA(1, 1), a1 + hstepA, voffA);
            PG8_WAIT_V(8); PG8_WAIT_L(0); PG8_BAR; PG8_MMA(0, 0, At, B0); PG8_MMA(0, 1, At, B1); PG8_BAR; PG8_SCHED;
            PG8_LDA(At, 0, 1); PG8_STAGE(PG8_SB(0, 0), b2, voffB); PG8_STAGE(PG8_SB(0, 1), b2 + hstepB, voffB); PG8_STAGE(PG8_SA(0, 0), a2, voffA);
            PG8_WAIT_V(8); PG8_WAIT_L(0); PG8_BAR; PG8_MMA(1, 0, At, B0); PG8_MMA(1, 1, At, B1); PG8_BAR; PG8_SCHED;
            PG8_LDB(B0, 1, 0); PG8_LDB(B1, 1, 1); PG8_SCHED; PG8_LDA(At, 1, 0); PG8_STAGE(PG8_SA(0, 1), a2 + hstepA, voffA);
            PG8_WAIT_V(8); PG8_WAIT_L(0); PG8_BAR; PG8_MMA(0, 0, At, B0); PG8_MMA(0, 1, At, B1); PG8_BAR; PG8_SCHED;
            PG8_LDA(At, 1, 1); PG8_STAGE(PG8_SB(1, 0), b3, voffB); PG8_STAGE(PG8_SB(1, 1), b3 + hstepB, voffB); PG8_STAGE(PG8_SA(1, 0), a3, voffA);
            PG8_WAIT_V(8); PG8_WAIT_L(0); PG8_BAR; PG8_MMA(1, 0, At, B0); PG8_MMA(1, 1, At, B1); PG8_BAR; PG8_SCHED;
            } else {
            PG8_LDB(B0, 0, 0); PG8_SCHED; PG8_LDA(At, 0, 0); PG8_STAGE(PG8_SA(1, 1), a1 + hstepA, voffA);
            PG8_WAIT_L(8); PG8_BAR; PG8_WAIT_L(0); PG8_MMA(0, 0, At, B0); PG8_BAR; PG8_SCHED;
            PG8_LDB(B1, 0, 1); PG8_STAGE(PG8_SB(0, 0), b2, voffB);
            PG8_BAR; PG8_WAIT_L(0); PG8_MMA(0, 1, At, B1); PG8_BAR;
            PG8_LDA(At, 0, 1); PG8_STAGE(PG8_SA(0, 0), a2, voffA);
            PG8_BAR; PG8_WAIT_L(0); PG8_MMA(1, 0, At, B0); PG8_BAR; PG8_SCHED;
            PG8_STAGE(PG8_SB(0, 1), b2 + hstepB, voffB);
            PG8_WAIT_V(6); PG8_BAR; PG8_MMA(1, 1, At, B1); PG8_BAR;
            PG8_LDB(B0, 1, 0); PG8_SCHED; PG8_LDA(At, 1, 0); PG8_STAGE(PG8_SA(0, 1), a2 + hstepA, voffA);
            PG8_WAIT_L(8); PG8_BAR; PG8_WAIT_L(0); PG8_MMA(0, 0, At, B0); PG8_BAR; PG8_SCHED;
            PG8_LDB(B1, 1, 1); PG8_STAGE(PG8_SB(1, 0), b3, voffB);
            PG8_BAR; PG8_WAIT_L(0); PG8_MMA(0, 1, At, B1); PG8_BAR;
            PG8_LDA(At, 1, 1); PG8_STAGE(PG8_SA(1, 0), a3, voffA);
            PG8_BAR; PG8_WAIT_L(0); PG8_MMA(1, 0, At, B0); PG8_BAR; PG8_SCHED;
            PG8_STAGE(PG8_SB(1, 1), b3 + hstepB, voffB);
            PG8_WAIT_V(6); PG8_BAR; PG8_MMA(1, 1, At, B1); PG8_BAR;
            }
        }
        if constexpr (ALIGN_EPI) { if (wr == 0) PG8_BAR; }
#ifndef PG8_LATE_DRAIN
        if constexpr (!Epi::AFTER_DRAIN) { if (!has_next) PG8_WAIT_V(0); }
#endif
        if constexpr (!Epi::AFTER_DRAIN) {
#ifdef EPI_STRETCH
            const unsigned long long et0_ = __builtin_amdgcn_s_memrealtime();
#endif
            E(acc, cur, wr, wc, fr, fq);
#ifdef EPI_STRETCH
            if constexpr (Epi::TWICE_OK) { asm volatile("s_waitcnt vmcnt(0)" ::: "memory"); const unsigned long long et1_ = __builtin_amdgcn_s_memrealtime(); const unsigned long long ed_ = et1_ - et0_; while (__builtin_amdgcn_s_memrealtime() - et1_ < ed_) __builtin_amdgcn_s_sleep(2); }
#endif

#ifdef EPI_TWICE
            if constexpr (Epi::TWICE_OK) { asm volatile("" ::: "memory"); if (Epi::twice(cur)) E(acc, cur, wr, wc, fr, fq); }
#endif
            S.done(cur); }
        if (!has_next) break;
#pragma unroll
        for (int a = 0; a < 2; ++a)
#pragma unroll
            for (int b = 0; b < 2; ++b)
#pragma unroll
                for (int m = 0; m < 4; ++m)
#pragma unroll
                    for (int n = 0; n < 2; ++n) acc[a][b][m][n] = (f32x4){0.f, 0.f, 0.f, 0.f};
        cur = nxt; cA = nA; cB = nB; ++ui;
        if constexpr (ALIGN_EPI) { if (wr == 1) PG8_BAR; }
    }
#ifdef PG8_LATE_DRAIN
    PG8_WAIT_V(0);
#else
    if constexpr (Epi::AFTER_DRAIN) PG8_WAIT_V(0);
#endif
    if constexpr (!ALIGN_EPI) { if (wr == 0) PG8_BAR; }
    PG8_BAR;
    if constexpr (Epi::AFTER_DRAIN) { E.fused(acc, cur, wr, wc, fr, fq, lds, wid, lane); S.done(cur); }
#undef PG8_AROW
#undef PG8_SA
#undef PG8_SB
#undef PG8_STAGE
#undef PG8_STAGE_X
#undef PG8_LDA
#undef PG8_LDB
#undef PG8_MMA
#undef PG8_WAIT_V
#undef PG8_WAIT_L
#undef PG8_BAR
#undef PG8_SCHED
}
}
#define GAS __attribute__((address_space(1)))
#define LAS __attribute__((address_space(3)))
typedef unsigned short bf16;
typedef unsigned v4u __attribute__((ext_vector_type(4)));
typedef float f32x4 __attribute__((ext_vector_type(4)));
typedef short bf16x8 __attribute__((ext_vector_type(8)));
typedef GAS unsigned gu32;
typedef GAS unsigned long long gu64;
#define RLX_AGENT __ATOMIC_RELAXED, __HIP_MEMORY_SCOPE_AGENT
#define LDS_WAIT() asm volatile("s_waitcnt lgkmcnt(0)" ::: "memory")
#define VM_WAIT() asm volatile("s_waitcnt vmcnt(0)" ::: "memory")
__device__ __forceinline__ unsigned long long rt() { return __builtin_amdgcn_s_memrealtime(); }
__device__ __forceinline__ unsigned f2bf(float f) { unsigned u = __builtin_bit_cast(unsigned, f); return (u + 0x7fffu + ((u >> 16) & 1u)) >> 16; }
__device__ __forceinline__ unsigned pk2(float lo, float hi) { return f2bf(lo) | (f2bf(hi) << 16); }

#define XB_TMO      128
#define XB_XCNT(j)  (256  + 64 * (j))
#define XB_XSUB(j)  (1280 + 64 * (j))
#define XB_XGEN(j)  (2304 + 64 * (j))
#define XB_TOP      3328
#define XB_TOPGEN   3392
#define XCD_BAR_WORDS 3456
#define XB_SPIN_CAP (1u << 18)

__device__ __forceinline__ unsigned xb_ld(unsigned* p)              { return __hip_atomic_load(p, __ATOMIC_RELAXED, __HIP_MEMORY_SCOPE_AGENT); }
__device__ __forceinline__ unsigned xb_add(unsigned* p, unsigned v) { return __hip_atomic_fetch_add(p, v, __ATOMIC_RELAXED, __HIP_MEMORY_SCOPE_AGENT); }
__device__ __forceinline__ unsigned xb_xcc_id() { return (unsigned)__builtin_amdgcn_s_getreg((3 << 11) | 20) & 0xFu; }
#ifndef XB_SLEEP
#define XB_SLEEP 1
#endif
#define XB_SPIN(cond, bar) do { unsigned _sp = 0; while (cond) { if (XB_SLEEP) __builtin_amdgcn_s_sleep(XB_SLEEP); \
    if ((++_sp & 255u) == 0u) { if (xb_ld(&(bar)[XB_TMO])) break; if (_sp > XB_SPIN_CAP) { atomicAdd(&(bar)[XB_TMO], 1u); break; } } } } while (0)

struct XcdBarrier {
    unsigned* bar; unsigned x, w;
    volatile LAS unsigned* st;
};

__device__ __forceinline__ XcdBarrier xcd_barrier_post(unsigned* bar, volatile LAS unsigned* st) {
    XcdBarrier b; b.bar = bar; b.x = xb_xcc_id(); b.st = st;
    if (threadIdx.x == 0) st[2] = xb_add(&bar[XB_XCNT(b.x)], 1u);
    return b;
}
__device__ __forceinline__ void xcd_barrier_complete(unsigned* bar, unsigned x, unsigned& nloc, unsigned& nx) {
    const unsigned G = gridDim.x * gridDim.y * gridDim.z;
    unsigned sum, cnt, mine, sp = 0u;
    for (;;) {
        sum = 0u; cnt = 0u; mine = 0u;
#pragma unroll
        for (unsigned j = 0; j < 16; ++j) { const unsigned c = xb_ld(&bar[XB_XCNT(j)]); sum += c; cnt += (c > 0u) ? 1u : 0u; mine = (j == x) ? c : mine; }
        if (sum == G) break;
        __builtin_amdgcn_s_sleep(1);
        if ((++sp & 255u) == 0u) { if (xb_ld(&bar[XB_TMO])) break; if (sp > XB_SPIN_CAP) { atomicAdd(&bar[XB_TMO], 1u); break; } }
    }
    nloc = mine > 0u ? mine : 1u; nx = cnt > 0u ? cnt : 1u;
}

template <bool FENCES> __device__ __forceinline__ void xcd_barrier_t(const XcdBarrier& b) {
    asm volatile("s_waitcnt vmcnt(0)" ::: "memory");
    __syncthreads();
    if ((int)b.w * 64 + mk_lane() == 0) {
        unsigned* bar = b.bar;
        __builtin_amdgcn_s_waitcnt(0);
        unsigned nloc = b.st[0], nx = b.st[1];
        if (nloc == 0u) { xcd_barrier_complete(bar, b.x, nloc, nx); b.st[0] = nloc; b.st[1] = nx; }
        const unsigned old = xb_add(&bar[XB_XSUB(b.x)], 1u);
        const unsigned gen = old / nloc;
        if (old + 1u == (gen + 1u) * nloc) {
            if (FENCES) __builtin_amdgcn_fence(__ATOMIC_RELEASE, "agent");
            asm volatile("s_waitcnt vmcnt(0)" ::: "memory");
            const unsigned og = xb_add(&bar[XB_TOP], 1u);
            const unsigned tg = og / nx;
            if (og + 1u == (tg + 1u) * nx) xb_add(&bar[XB_TOPGEN], 1u);
            else XB_SPIN(xb_ld(&bar[XB_TOPGEN]) == tg, bar);
            if (FENCES) __builtin_amdgcn_fence(__ATOMIC_ACQUIRE, "agent");
            xb_add(&bar[XB_XGEN(b.x)], 1u);
            asm volatile("s_waitcnt vmcnt(0)" ::: "memory");
        } else {
            XB_SPIN(xb_ld(&bar[XB_XGEN(b.x)]) == gen, bar);
            if (FENCES) __builtin_amdgcn_fence(__ATOMIC_ACQUIRE, "agent");
            asm volatile("s_waitcnt vmcnt(0)" ::: "memory");
        }
    }
    __syncthreads();
}


__device__ __forceinline__ void xcd_barrier(const XcdBarrier& b) { xcd_barrier_t<true>(b); }
#define XB_LSUB(j)  (3520 + 64 * (j))
#define XB_LGEN(j)  (4544 + 64 * (j))
#define XCD_BAR_WORDS_ALL 5632
__device__ __forceinline__ void xcd_local_barrier(const XcdBarrier& b) {
    asm volatile("s_waitcnt vmcnt(0)" ::: "memory");
    __syncthreads();
    if ((int)b.w * 64 + mk_lane() == 0) {
        unsigned* bar = b.bar; __builtin_amdgcn_s_waitcnt(0);
        const unsigned nloc = b.st[0];
        const unsigned old = xb_add(&bar[XB_LSUB(b.x)], 1u), gen = old / nloc;
        if (old + 1u == (gen + 1u) * nloc) { __builtin_amdgcn_fence(__ATOMIC_ACQUIRE, "agent"); xb_add(&bar[XB_LGEN(b.x)], 1u); asm volatile("s_waitcnt vmcnt(0)" ::: "memory"); }
        else { XB_SPIN(xb_ld(&bar[XB_LGEN(b.x)]) == gen, bar); __builtin_amdgcn_fence(__ATOMIC_ACQUIRE, "agent"); asm volatile("s_waitcnt vmcnt(0)" ::: "memory"); }
    }
    __syncthreads();
}
#ifndef IN_NT
#define IN_NT 3
#endif
#if IN_NT & 1
#define XB_LOAD(p) __builtin_nontemporal_load(p)
#else
#define XB_LOAD(p) (*(p))
#endif
#if IN_NT & 2
#define W_LOAD(p) __builtin_nontemporal_load(p)
#else
#define W_LOAD(p) (*(p))
#endif

typedef float f32x2 __attribute__((ext_vector_type(2)));
constexpr int NWAVES = 8;
constexpr int BATCH = 4, SEQ = 4096, DM = 1024, MTOK = BATCH * SEQ;
constexpr int NIN1 = 5120;
constexpr int LATW = 640;
constexpr float C2Q = 0.07216878364870323f * 1.4426950408889634f;

constexpr size_t MiB = 1u << 20, KiB = 1u << 10;
constexpr size_t WS_CTL = 0, CTL_ZERO_BYTES = 64 * KiB;
constexpr size_t WS_SMALL = 1 * MiB;
constexpr size_t SM_RSTDX = 0, SM_SSQ_CQ = 64 * KiB, SM_SSQ_CKV = 128 * KiB, SM_SSQ1 = 192 * KiB, SM_SSQ2 = 256 * KiB, SM_SSQ_KR = 320 * KiB, SM_END = 384 * KiB, SM_BOUND = 384 * KiB;
constexpr size_t WS_WIN = 2 * MiB;
constexpr size_t WS_SSQP = 10 * MiB;
constexpr size_t WS_WUQ = 20 * MiB;
constexpr size_t WS_WUKV = WS_WUQ + (size_t)2048 * 384 * 2;
constexpr size_t WS_KR = 22 * MiB + 512 * KiB;
constexpr size_t WS_XB = 25 * MiB;
constexpr size_t WS_CS = 57 * MiB;
constexpr size_t WS_LAT = 73 * MiB;
constexpr size_t WS_RQ = 94 * MiB, WS_RK = 126 * MiB, WS_RKDT = 158 * MiB, WS_RVT = 190 * MiB;
constexpr size_t WS_QP = 94 * MiB, WS_KF = 142 * MiB, WS_VV = 190 * MiB;
constexpr size_t WS_MO = 222 * MiB;
#ifndef WS_BLK_SKEW
#define WS_BLK_SKEW 0
#endif
constexpr size_t WS_BLK = 16 * MiB + (size_t)(WS_BLK_SKEW) * 1024;
constexpr size_t WS_SG = 57 * MiB, WS_TM = 57 * MiB + 8 * MiB;
constexpr size_t WS_WBR = 190 * MiB, WS_WBM = 194 * MiB, WS_WO = 196 * MiB, WS_WUP = 198 * MiB, WS_WDOWN = 206 * MiB, WS_WPG = 214 * MiB, WS_WPLE = 18 * MiB;
constexpr size_t WS_PB = 10 * MiB;
constexpr size_t WS_H = 57 * MiB;
constexpr size_t WS_GT = 222 * MiB;
constexpr size_t WS_CSM = 254 * MiB;
constexpr size_t WS_END = 256 * MiB;
static_assert(SM_SSQ_CKV == SM_SSQ_CQ + 65536, "ssq_lat layout");
static_assert(WS_WIN + (size_t)9216 * 2048 <= WS_WUQ && WS_WUKV + (size_t)2048 * 256 * 2 <= WS_KR && WS_KR + 2 * MiB <= WS_XB && WS_LAT + 20 * MiB <= WS_RQ && WS_RVT + 64 * MiB <= WS_END && WS_H + 8 * WS_BLK <= WS_WBR && WS_PB + 8 * MiB <= WS_WPLE && WS_WPLE + 512 * KiB <= WS_WUQ && WS_WPG + 2 * MiB <= WS_GT && WS_GT + 32 * MiB <= WS_CSM && WS_VV + 32 * MiB <= WS_MO, "d_ws map");
constexpr int CW_BAR = 1024;

constexpr int RING_OFF = 0, RING_BYTES = 131072;
constexpr int XS_OFF = RING_BYTES, XS_BYTES = 8 * 2304;
constexpr int MISC_OFF = XS_OFF + XS_BYTES;
constexpr int LDS_BYTES = 160 * 1024;
static_assert(MISC_OFF + 128 <= LDS_BYTES, "LDS map");

struct Frame {
    LAS unsigned char* lds; volatile LAS unsigned* MISC; int tid, lane, wave, G, vcu, wv0;
    float* out; unsigned char* ws;
};
__device__ __forceinline__ float wave_sum(float v) {
#pragma unroll
    for (int o = 1; o < 64; o <<= 1) v += __shfl_xor(v, o);
    return v;
}
__device__ __forceinline__ void p0_transpose_item(const float* W, int ldw, int K, int src_col, bf16* WT, int dst_row, int ncols, const float* gain, LAS float* scr, int item, int lane) {
    const int nblk = ncols / 32, kb = item / nblk, nb = item % nblk, k0 = 64 * kb, n0 = 32 * nb;
    f32x4 v[8]; float gk[8];
#pragma unroll
    for (int i = 0; i < 8; ++i) { const int kk = 8 * i + (lane >> 3); v[i] = W_LOAD((const GAS f32x4*)(W + (size_t)(k0 + kk) * ldw + src_col + n0 + 4 * (lane & 7))); gk[i] = gain ? gain[k0 + kk] : 1.0f; }
#pragma unroll
    for (int i = 0; i < 8; ++i) { const int kk = 8 * i + (lane >> 3); LAS float* d = scr + kk * 33 + 4 * (lane & 7); d[0] = v[i].x * gk[i]; d[1] = v[i].y * gk[i]; d[2] = v[i].z * gk[i]; d[3] = v[i].w * gk[i]; }
    LDS_WAIT(); asm volatile("" ::: "memory");
    const int c = lane & 7;
#pragma unroll
    for (int j = 0; j < 4; ++j) { const int n = (lane >> 3) + 8 * j; const LAS float* s = scr + (8 * c) * 33 + n;
        v4u o; o.x = pk2(s[0 * 33], s[1 * 33]); o.y = pk2(s[2 * 33], s[3 * 33]); o.z = pk2(s[4 * 33], s[5 * 33]); o.w = pk2(s[6 * 33], s[7 * 33]);
        *(GAS v4u*)(WT + (size_t)(dst_row + n0 + n) * K + k0 + 8 * c) = o; }
    LDS_WAIT(); asm volatile("" ::: "memory");
}
struct XT { const float* src; bf16* dst; const float* gain; int ldw, K; };
#define XT_SEG(W_, ldw_, K_, src_, WT_, dst_, ncols_, gain_) { const int n_ = ((K_) / 64) * ((ncols_) / 128); if (r < n_) { const int nblk_ = (ncols_) / 128, kb_ = r / nblk_, nb_ = r - kb_ * nblk_; \
        x.src = (W_) + (size_t)(64 * kb_) * (ldw_) + (src_) + 128 * nb_; x.dst = (WT_) + (size_t)((dst_) + 128 * nb_) * (K_) + 64 * kb_; x.gain = (gain_) ? (gain_) + 64 * kb_ : (const float*)nullptr; x.ldw = (ldw_); x.K = (K_); return x; } r -= n_; }
__device__ __forceinline__ void xt_load(const XT& x, int tid, f32x4 (&v)[4], float (&g)[4]) {
#pragma unroll
    for (int i = 0; i < 4; ++i) { const int row = i * 16 + (tid >> 5); v[i] = W_LOAD((const GAS f32x4*)(x.src + (size_t)row * x.ldw + 4 * (tid & 31))); g[i] = x.gain ? x.gain[row] : 1.0f; }
}
template <class Dec> __device__ __forceinline__ void xt_run(Frame& F, int ntiles, const Dec& dec) {
    LAS float* scr = (LAS float*)(F.lds + RING_OFF);
    const int tid = F.tid; int t = F.vcu; if (t >= ntiles) return;
    XT cur = dec(t); f32x4 v[4]; float g[4]; xt_load(cur, tid, v, g);
    for (;;) {
        const int tn = t + F.G; const bool has = tn < ntiles; const XT nxt = has ? dec(tn) : cur;
        __syncthreads();
#pragma unroll
        for (int i = 0; i < 4; ++i) *(LAS f32x4*)(scr + (i * 16 + (tid >> 5)) * 132 + 4 * (tid & 31)) = v[i] * g[i];
        if (has) xt_load(nxt, tid, v, g);
        __syncthreads();
        const int n = tid >> 2, kq = tid & 3;
#pragma unroll
        for (int j = 0; j < 2; ++j) { const int kc = kq + 4 * j; const LAS float* s = scr + (8 * kc) * 132 + n;
            v4u o; o.x = pk2(s[0 * 132], s[1 * 132]); o.y = pk2(s[2 * 132], s[3 * 132]); o.z = pk2(s[4 * 132], s[5 * 132]); o.w = pk2(s[6 * 132], s[7 * 132]);
            if (IN_NT & 8) __builtin_nontemporal_store(o, (GAS v4u*)(cur.dst + (size_t)n * cur.K + 8 * kc)); else *(GAS v4u*)(cur.dst + (size_t)n * cur.K + 8 * kc) = o; }
        if (!has) break;
        cur = nxt; t = tn;
    }
    __syncthreads();
}
#ifdef P0STRETCH
#define P0_T0(n) const unsigned long long pt0_##n = __builtin_amdgcn_s_memrealtime()
#define P0_ST(n) do { if (P0STRETCH == (n)) { const unsigned long long t1_ = __builtin_amdgcn_s_memrealtime(); const unsigned long long d_ = t1_ - pt0_##n; while (__builtin_amdgcn_s_memrealtime() - t1_ < d_) __builtin_amdgcn_s_sleep(8); } } while (0)
#else
#define P0_T0(n) do {} while (0)
#define P0_ST(n) do {} while (0)
#endif
#define P0_SEG(W, ldw, K, src, WT, dst, ncols, gain) { const int n_ = ((K) / 64) * ((ncols) / 32); if (r < n_) { p0_transpose_item(W, ldw, K, src, WT, dst, ncols, gain, scr, r, F.lane); continue; } r -= n_; }
__device__ __forceinline__ void phase_p0(Frame& F, const float* x, const int* pos, const float* g_mix, const float* w_in, const float* g_qlat, const float* g_kvlat, const float* w_uq, const float* w_ukv, const float* qn, const float* kn) {
    P0_T0(5); P0_T0(7); P0_T0(8); P0_T0(9);
    LAS float* scr = (LAS float*)(F.lds + RING_OFF + F.wave * 16384);
    const int gw = F.vcu * NWAVES + F.wave, NGW = F.G * NWAVES;
    bf16* WinT = (bf16*)(F.ws + WS_WIN); bf16* WuqT = (bf16*)(F.ws + WS_WUQ); bf16* WukvT = (bf16*)(F.ws + WS_WUKV);
    struct Dec0 { const float *w_in, *g_mix, *w_uq, *g_qlat, *w_ukv, *g_kvlat; bf16 *WinT, *WuqT, *WukvT;
        __device__ __forceinline__ XT operator()(int r) const { XT x;
            XT_SEG(w_in, 8896, 1024, 6848, WinT, 0, 2048, g_mix)
            XT_SEG(w_in, 8896, 1024, 4096, WinT, 2048, 2048, g_mix)
            XT_SEG(w_in, 8896, 1024, 0, WinT, 4096, 4096, g_mix)
            XT_SEG(w_in, 8896, 1024, 6144, WinT, 8192, 640, g_mix)
            XT_SEG(w_ukv, 2048, 256, 0, WukvT, 0, 2048, g_kvlat)
            x.src = w_in; x.dst = WinT; x.gain = nullptr; x.ldw = 8896; x.K = 1024; return x; } };
    auto p0_weights = [&]() {
    { const Dec0 d{w_in, g_mix, w_uq, g_qlat, w_ukv, g_kvlat, WinT, WuqT, WukvT}; xt_run(F, 16 * 16 * 2 + 16 * 32 + 16 * 5 + 4 * 16, d); }

    for (int it = gw; it < 32 + 8 * 36; it += NGW) {
        int r = it;
        P0_SEG(w_in, 8896, 1024, 6784, WinT, 8960, 32, g_mix)
        P0_SEG(w_in, 8896, 1024, 6816, WinT, 8960 + 128, 32, g_mix)
        { const int hh = r / 36; r -= hh * 36;
          P0_SEG(w_uq, 1536, 384, hh * 192, WuqT, hh * 256, 96, g_qlat)
          P0_SEG(w_uq, 1536, 384, hh * 192 + 128, WuqT, hh * 256 + 96, 32, g_qlat)
          P0_SEG(w_uq, 1536, 384, hh * 192 + 96, WuqT, hh * 256 + 128, 32, g_qlat)
          P0_SEG(w_uq, 1536, 384, hh * 192 + 160, WuqT, hh * 256 + 224, 32, g_qlat) }
    }
    for (int gt = F.vcu * 512 + F.tid; gt < 24576; gt += F.G * 512) { const int hh = gt / 3072, rem = gt - hh * 3072; *(GAS v4u*)((unsigned char*)(WuqT + (size_t)(hh * 256 + 160) * 384) + (size_t)rem * 16) = (v4u){0u, 0u, 0u, 0u}; }
    for (int gt = F.vcu * 512 + F.tid; gt < 40960; gt += F.G * 512) { const int row = gt >> 7, piece = gt & 127; const int wrow = row < 128 ? 8832 + row : (row < 224 ? 8992 + (row - 128) : 9120 + (row - 224));
        *(GAS v4u*)((unsigned char*)(WinT + (size_t)wrow * 1024) + (size_t)piece * 16) = (v4u){0u, 0u, 0u, 0u}; }
    };
    auto p0_rows = [&]() {
    { bf16* XB = (bf16*)(F.ws + WS_XB); float* rstdx = (float*)(F.ws + WS_SMALL + SM_RSTDX);
      for (int m0 = 2 * gw; m0 < MTOK; m0 += 2 * NGW) {
          f32x4 v[2][4]; float s[2] = {0.f, 0.f};
#pragma unroll
          for (int u = 0; u < 2; ++u) { const GAS f32x4* xr = (const GAS f32x4*)(x + (size_t)(m0 + u) * DM) + F.lane;
#pragma unroll
              for (int j = 0; j < 4; ++j) v[u][j] = XB_LOAD(xr + 64 * j); }
#pragma unroll
          for (int u = 0; u < 2; ++u) {
#pragma unroll
              for (int j = 0; j < 4; ++j) s[u] += (v[u][j].x * v[u][j].x + v[u][j].y * v[u][j].y) + (v[u][j].z * v[u][j].z + v[u][j].w * v[u][j].w);
              s[u] = wave_sum(s[u]);
              GAS unsigned long long* o8 = (GAS unsigned long long*)(XB + (size_t)(m0 + u) * DM) + F.lane;
#pragma unroll
              for (int j = 0; j < 4; ++j) { const unsigned long long w8_ = (unsigned long long)pk2(v[u][j].x, v[u][j].y) | ((unsigned long long)pk2(v[u][j].z, v[u][j].w) << 32); if (IN_NT & 4) __builtin_nontemporal_store(w8_, o8 + 64 * j); else o8[64 * j] = w8_; }
              if (F.lane == 0) rstdx[m0 + u] = 1.0f / sqrtf(s[u] * (1.0f / DM) + 1e-6f); }
      } }

    { typedef _Float16 h2c_t __attribute__((ext_vector_type(2))); h2c_t* cs = (h2c_t*)(F.ws + WS_CS);
      for (int e = F.vcu * 512 + F.tid; e < MTOK * 128; e += F.G * 512) { const int row = e >> 7, i = e & 127;
          const float inv = __builtin_amdgcn_exp2f(-(float)i * (13.287712379549449f / 128.0f));
          double rev = (double)pos[row] * (double)inv * 0.15915494309189535; rev -= __builtin_rint(rev);
          const float rf = (float)rev; cs[e] = (h2c_t){(_Float16)__builtin_amdgcn_cosf(rf), (_Float16)__builtin_amdgcn_sinf(rf)}; } }
    { typedef _Float16 h2_t __attribute__((ext_vector_type(2))); h2_t* csm = (h2_t*)(F.ws + WS_CSM);
      for (int e = F.vcu * 512 + F.tid; e < MTOK * 32; e += F.G * 512) { const int row = e >> 5, i = e & 31;
          const float inv = __builtin_amdgcn_exp2f(-(float)(4 * i) * (13.287712379549449f / 128.0f));
          double rev = (double)pos[row] * (double)inv * 0.15915494309189535; rev -= __builtin_rint(rev);
          const float rf = (float)rev; csm[e] = (h2_t){(_Float16)__builtin_amdgcn_cosf(rf), (_Float16)__builtin_amdgcn_sinf(rf)}; } }
    };
#ifndef P0_ROT
#define P0_ROT 0
#endif
    if (P0_ROT && (F.vcu & 1)) { p0_rows(); p0_weights(); } else { p0_weights(); p0_rows(); }
    P0_T0(6);
    if (F.vcu == 0 && F.wave == 0) { float mq = 0.f, mk = 0.f;
#pragma unroll
        for (int j = 0; j < 3; ++j) { mq = fmaxf(mq, fabsf(qn[F.lane + 64 * j])); mk = fmaxf(mk, fabsf(kn[F.lane + 64 * j])); }
#pragma unroll
        for (int o = 1; o < 64; o <<= 1) { mq = fmaxf(mq, __shfl_xor(mq, o)); mk = fmaxf(mk, __shfl_xor(mk, o)); }
        if (F.lane == 0) *(float*)(F.ws + WS_SMALL + SM_BOUND) = 1.02f * 1.4426950408889634f * 13.856406460551018f * mq * mk; }
    { float* z = (float*)(F.ws + WS_SMALL + SM_SSQ_CQ); for (int e = F.vcu * 512 + F.tid; e < (int)((SM_END - SM_SSQ_CQ) / 4); e += F.G * 512) z[e] = 0.f; }
    P0_ST(6); P0_ST(5);
}
__device__ __forceinline__ void phase_late_weights(Frame& F, const float* p, const float* w_br, const float* w_bm, const float* w_o, const float* g_mlp, const float* w_up, const float* w_down, const float* g_ple, const float* w_pg, const float* w_ple) {
    struct Dec1 { const float *w_br, *w_bm, *w_o, *g_mlp, *w_up, *w_down, *g_ple, *w_pg, *w_ple; unsigned char* ws;
        __device__ __forceinline__ XT operator()(int r) const { XT x; const float* nog = nullptr;
            XT_SEG(w_br, 1024, 2048, 0, (bf16*)(ws + WS_WBR), 0, 1024, nog)
            XT_SEG(w_bm, 1024, 1024, 0, (bf16*)(ws + WS_WBM), 0, 1024, nog)
            XT_SEG(w_o, 1024, 1024, 0, (bf16*)(ws + WS_WO), 0, 1024, nog)
            XT_SEG(w_up, 4096, 1024, 0, (bf16*)(ws + WS_WUP), 0, 4096, g_mlp)
            XT_SEG(w_down, 1024, 4096, 0, (bf16*)(ws + WS_WDOWN), 0, 1024, nog)
            XT_SEG(w_pg, 1024, 1024, 0, (bf16*)(ws + WS_WPG), 0, 1024, g_ple)
            XT_SEG(w_ple, 1024, 256, 0, (bf16*)(ws + WS_WPLE), 0, 1024, nog)
            x.src = w_br; x.dst = (bf16*)(ws + WS_WBR); x.gain = nullptr; x.ldw = 1024; x.K = 2048; return x; } };
    { const Dec1 d{w_br, w_bm, w_o, g_mlp, w_up, w_down, g_ple, w_pg, w_ple, F.ws}; xt_run(F, 32 * 8 + 16 * 8 * 2 + 16 * 32 + 64 * 8 + 16 * 8 + 4 * 8, d); }
    { bf16* PB = (bf16*)(F.ws + WS_PB);
      for (int e = F.vcu * 512 + F.tid; e < MTOK * 256 / 8; e += F.G * 512) { const f32x4 a = W_LOAD((const GAS f32x4*)(p + (size_t)e * 8)), b = W_LOAD((const GAS f32x4*)(p + (size_t)e * 8 + 4));
          *(GAS v4u*)(PB + (size_t)e * 8) = (v4u){pk2(a.x, a.y), pk2(a.z, a.w), pk2(b.x, b.y), pk2(b.z, b.w)}; } }
}

typedef float f32x16 __attribute__((ext_vector_type(16)));
typedef unsigned u32x2 __attribute__((ext_vector_type(2)));
typedef short v4i16_t __attribute__((ext_vector_type(4)));
__device__ __forceinline__ int crow(int r, int hi) { return (r & 3) + 8 * (r >> 2) + 4 * hi; }
typedef __bf16 bf16x2m_t __attribute__((ext_vector_type(2)));
__device__ __forceinline__ unsigned cvtpk(float lo, float hi) { f32x2 v = {lo, hi}; bf16x2m_t b = __builtin_convertvector(v, bf16x2m_t); return __builtin_bit_cast(unsigned, b); }
__device__ __forceinline__ bf16x8 pack8f(const f32x16& p, int b) { v4u w = {cvtpk(p[b], p[b + 1]), cvtpk(p[b + 2], p[b + 3]), cvtpk(p[b + 4], p[b + 5]), cvtpk(p[b + 6], p[b + 7])}; return __builtin_bit_cast(bf16x8, w); }
__device__ __forceinline__ float bf2f(bf16 v) { return __uint_as_float((unsigned)v << 16); }
__device__ __forceinline__ float log2_gamma(int h) { return __builtin_amdgcn_logf(1.0f - __builtin_amdgcn_exp2f(-5.0f - (float)h)); }

#ifndef R1_PRIO
#define R1_PRIO 0
#endif
#ifndef R1_UNROLL
#define R1_UNROLL 1
#endif
#ifndef RET_NT
#define RET_NT 3
#endif
#if RET_NT & 1
#define RET_LD1(p) __builtin_nontemporal_load(p)
#else
#define RET_LD1(p) (*(p))
#endif

__device__ __forceinline__ void phase_r0p(Frame& F, int vx) {
    const bf16* RQ = (const bf16*)(F.ws + WS_RQ); bf16* RK = (bf16*)(F.ws + WS_RK);
    const int lane = F.lane, w = F.wave, l31 = lane & 31, hi = lane >> 5, tq = w & 3, dh = w >> 2;
    for (int unit = vx >= 0 ? vx : F.vcu, kk = 0; vx >= 0 ? kk < 2 : unit < 512; unit += F.G, ++kk) {
        const int bh = vx >= 0 ? 2 * (vx >> 5) + kk : unit >> 5, c = vx >= 0 ? (vx & 31) : (unit & 31), h = bh & 3; const size_t blk = (size_t)bh * 32 + c;
        const float lg2 = log2_gamma(h);
        bf16x8 qf[16];
#pragma unroll
        for (int ks = 0; ks < 16; ++ks) qf[ks] = (RET_NT & 16) ? __builtin_nontemporal_load((const bf16x8*)(RQ + ((blk * 32 + 2 * ks + hi) * 128 + 32 * tq + l31) * 8)) : *(const bf16x8*)(RQ + ((blk * 32 + 2 * ks + hi) * 128 + 32 * tq + l31) * 8);
        f32x16 s[2] = {};
#pragma unroll
        for (int x = 0; x < 2; ++x) { const int tb = 2 * dh + x;
            if (tb <= tq) {
#pragma unroll
                for (int ks = 0; ks < 16; ++ks) { const bf16x8 kf = (RET_NT & 16) ? __builtin_nontemporal_load((const bf16x8*)(RK + ((blk * 32 + 2 * ks + hi) * 128 + 32 * tb + l31) * 8)) : *(const bf16x8*)(RK + ((blk * 32 + 2 * ks + hi) * 128 + 32 * tb + l31) * 8); s[x] = __builtin_amdgcn_mfma_f32_32x32x16_bf16(kf, qf[ks], s[x], 0, 0, 0); }
#pragma unroll
                for (int r = 0; r < 16; ++r) { const int d = (32 * tq + l31) - (32 * tb + crow(r, hi)); s[x][r] = d >= 0 ? s[x][r] * __builtin_amdgcn_exp2f((float)d * lg2) : 0.f; }
            } }
        VM_WAIT(); __syncthreads();
#pragma unroll
        for (int x = 0; x < 2; ++x) { const int tb = 2 * dh + x;
            if (tb <= tq) {
#pragma unroll
                for (int g = 0; g < 4; ++g) { u32x2* pp_ = (u32x2*)(RK + ((blk * 32 + 4 * tb + g) * 128 + 32 * tq + l31) * 8 + 4 * hi); const u32x2 pv_ = {cvtpk(s[x][4 * g], s[x][4 * g + 1]), cvtpk(s[x][4 * g + 2], s[x][4 * g + 3])}; if (RET_NT & 8) __builtin_nontemporal_store(pv_, pp_); else *pp_ = pv_; }
            } }
    }
}
__device__ __forceinline__ void phase_r1p(Frame& F, int vx) {
    const bf16* RQ = (const bf16*)(F.ws + WS_RQ); const bf16* RP = (const bf16*)(F.ws + WS_RK); const bf16* RKDT = (const bf16*)(F.ws + WS_RKDT); const bf16* RVT = (const bf16*)(F.ws + WS_RVT); bf16* RO = (bf16*)F.out;
    float* ssqp = (float*)(F.ws + WS_SSQP);
    const int lane = F.lane, w = F.wave, l15 = lane & 15, lq = lane >> 4;
    constexpr int SROW = 528, SBUF = 32 * SROW;
    LAS unsigned char* ost = F.lds + 2 * SBUF + 1024 + w * 1024;
    const int nkp = (w >> 1) + 1;
    for (int unit = vx >= 0 ? vx : F.vcu; unit < 256; unit += F.G) {
        const int bh = unit >> 4, j = unit & 15, b = bh >> 2, h = bh & 3;
        const float lg2 = log2_gamma(h), gC = __builtin_amdgcn_exp2f(128.0f * lg2);
        float qd[4];
#pragma unroll
        for (int i = 0; i < 4; ++i) qd[i] = __builtin_amdgcn_exp2f((float)(16 * w + 4 * lq + i + 1) * lg2);
        f32x4 S[2][2];
#pragma unroll
        for (int mb = 0; mb < 2; ++mb)
#pragma unroll
            for (int nb = 0; nb < 2; ++nb) S[mb][nb] = (f32x4){0.f, 0.f, 0.f, 0.f};
        __syncthreads();
#pragma unroll
        for (int mb = 0; mb < 2; ++mb)
#pragma unroll
            for (int nb = 0; nb < 2; ++nb) *(LAS u32x2*)(F.lds + (16 * nb + l15) * SROW + (32 * w + 16 * mb + 4 * lq) * 2) = (u32x2){0u, 0u};
        const bf16* qp = RQ + (((size_t)bh * 32 * 32 + lq) * 128 + 16 * w + l15) * 8;
        const bf16* pp = RP + (((size_t)bh * 32 * 32 + lq) * 128 + 16 * w + l15) * 8;
        const bf16* kp = RKDT + (((size_t)bh * 32 * 16 + lq) * 256 + 32 * w + l15) * 8;
        const bf16* vp = RVT + (((size_t)bh * 32 * 16 + (F.tid >> 5)) * 512 + 32 * j + (F.tid & 31)) * 8;
        constexpr size_t QC = 32 * 128 * 8, QK = 4 * 128 * 8, KC = 16 * 256 * 8, KK = 4 * 256 * 8, VC = 16 * 512 * 8;
        bf16x8 QA[8], PA[4], KA[2][4], vpre;
        LAS unsigned char* vl = F.lds + 2 * SBUF + 1024 + 8 * 1024;
#pragma unroll
        for (int ks = 0; ks < 8; ++ks) QA[ks] = *(const bf16x8*)(qp + QK * ks);
#pragma unroll
        for (int ks = 0; ks < 4; ++ks) { PA[ks] = (bf16x8){0, 0, 0, 0, 0, 0, 0, 0}; if (ks < nkp) PA[ks] = *(const bf16x8*)(pp + QK * ks); }
#pragma unroll
        for (int mb = 0; mb < 2; ++mb)
#pragma unroll
            for (int ks = 0; ks < 4; ++ks) KA[mb][ks] = *(const bf16x8*)(kp + mb * 128 + KK * ks);
        vpre = *(const bf16x8*)vp;
        *(LAS bf16x8*)(vl + F.tid * 16) = vpre;
#pragma unroll R1_UNROLL
        for (int c = 0; c < 32; ++c) {
            const int cur = c & 1, cn = c < 31 ? c + 1 : 31; const size_t tok0 = (size_t)b * SEQ + c * 128;
            __syncthreads();
            vpre = RET_LD1((const bf16x8*)(vp + VC * cn));
            bf16x8 VB[2][4];
#pragma unroll
            for (int nb = 0; nb < 2; ++nb)
#pragma unroll
                for (int ks = 0; ks < 4; ++ks) VB[nb][ks] = *(const LAS bf16x8*)(vl + cur * 8192 + ((4 * ks + lq) * 32 + 16 * nb + l15) * 16);
            if (R1_PRIO) __builtin_amdgcn_s_setprio(1);
            f32x4 oc[2] = {(f32x4){0.f, 0.f, 0.f, 0.f}, (f32x4){0.f, 0.f, 0.f, 0.f}};
#pragma unroll
            for (int ks = 0; ks < 8; ++ks)
#pragma unroll
                for (int nb = 0; nb < 2; ++nb) { const bf16x8 bq = *(const LAS bf16x8*)(F.lds + cur * SBUF + (16 * nb + l15) * SROW + (32 * ks + 8 * lq) * 2);
                    oc[nb] = __builtin_amdgcn_mfma_f32_16x16x32_bf16(QA[ks], bq, oc[nb], 0, 0, 0); }
#pragma unroll
            for (int ks = 0; ks < 8; ++ks) QA[ks] = *(const bf16x8*)(qp + QC * cn + QK * ks);
#ifdef R1_DUPLOAD
            { const bf16* qp2 = RQ + (((size_t)(bh ^ 1) * 32 * 32 + lq) * 128 + 16 * w + l15) * 8;
#pragma unroll
              for (int ks = 0; ks < 8; ++ks) { const bf16x8 dq = *(const bf16x8*)(qp2 + QC * cn + QK * ks); asm volatile("" :: "v"(dq)); } }
#endif
#pragma unroll
            for (int nb = 0; nb < 2; ++nb)
#pragma unroll
                for (int i = 0; i < 4; ++i) oc[nb][i] *= qd[i];
#pragma unroll
            for (int ks = 0; ks < 4; ++ks)
                if (ks < nkp) {
#pragma unroll
                    for (int nb = 0; nb < 2; ++nb) oc[nb] = __builtin_amdgcn_mfma_f32_16x16x32_bf16(PA[ks], VB[nb][ks], oc[nb], 0, 0, 0); }
#pragma unroll
            for (int ks = 0; ks < 4; ++ks) if (ks < nkp) PA[ks] = *(const bf16x8*)(pp + QC * cn + QK * ks);
#pragma unroll
            for (int mb = 0; mb < 2; ++mb)
#pragma unroll
                for (int nb = 0; nb < 2; ++nb) { S[mb][nb] *= gC;
#pragma unroll
                    for (int ks = 0; ks < 4; ++ks) S[mb][nb] = __builtin_amdgcn_mfma_f32_16x16x32_bf16(KA[mb][ks], VB[nb][ks], S[mb][nb], 0, 0, 0); }
#pragma unroll
            for (int mb = 0; mb < 2; ++mb)
#pragma unroll
                for (int ks = 0; ks < 4; ++ks) KA[mb][ks] = *(const bf16x8*)(kp + mb * 128 + KC * cn + KK * ks);
            if (R1_PRIO) __builtin_amdgcn_s_setprio(0);
#pragma unroll
            for (int i = 0; i < 4; ++i) { float q = 0.f;
#pragma unroll
                for (int nb = 0; nb < 2; ++nb) { const float v = oc[nb][i]; q += v * v; *(LAS unsigned short*)(ost + ((4 * lq + i) * 32 + 16 * nb + l15) * 2) = (unsigned short)f2bf(v); }
                q += __shfl_xor(q, 1); q += __shfl_xor(q, 2); q += __shfl_xor(q, 4); q += __shfl_xor(q, 8);
                if (l15 == 0) { float* sp_ = ssqp + ((tok0 + 16 * w + 4 * lq + i) * 4 + h) * 16 + j; if (RET_NT & 4) __builtin_nontemporal_store(q, sp_); else *sp_ = q; } }
            LDS_WAIT();
            { const v4u ov = *(const LAS v4u*)(ost + lane * 16); { v4u* op_ = (v4u*)(RO + (tok0 + 16 * w + (lane >> 2)) * 2048 + h * 512 + 32 * j + (lane & 3) * 8); if (RET_NT & 2) __builtin_nontemporal_store(ov, op_); else *op_ = ov; } }
            *(LAS bf16x8*)(vl + (cur ^ 1) * 8192 + F.tid * 16) = vpre;
#pragma unroll
            for (int mb = 0; mb < 2; ++mb)
#pragma unroll
                for (int nb = 0; nb < 2; ++nb) *(LAS u32x2*)(F.lds + (cur ^ 1) * SBUF + (16 * nb + l15) * SROW + (32 * w + 16 * mb + 4 * lq) * 2) = (u32x2){cvtpk(S[mb][nb][0], S[mb][nb][1]), cvtpk(S[mb][nb][2], S[mb][nb][3])};
        }
    }
    __syncthreads();
}
#ifndef A2_LONG_FIRST
#define A2_LONG_FIRST 1
#endif
#ifndef A2_O_LDS
#define A2_O_LDS 1
#endif
#ifndef A2_MPRIO
#define A2_MPRIO 0
#endif
#ifndef A2_NT_O
#define A2_NT_O 0
#endif

namespace attn2 {
typedef float f32x16 __attribute__((ext_vector_type(16)));
typedef short s16x4 __attribute__((ext_vector_type(4)));
constexpr int NW = 8, QBLK = 32, KVBLK = 64, QB = NW * QBLK;
constexpr int QS = 1536, KS = 1536, VS = 1024, OS = 1024;
constexpr int SHM_V = KVBLK * 128 * 2, SHM_K = KVBLK * 512;
constexpr int OFF_V = 0, OFF_K = 2 * SHM_V, OFF_WS = OFF_K + 2 * SHM_K, OFF_QR = OFF_WS + NW * 64 * 4, LDS_NEED = OFF_QR + NW * 4096;
constexpr float THR2 = 8.0f * 1.4426950408889634f;
#define A2_SBAR() __builtin_amdgcn_sched_barrier(0)
__device__ __forceinline__ int v_st(int k, int c) { const int kk = (k & ~0xC) | ((k & 4) << 1) | ((k & 8) >> 1); return ((kk >> 3) * 4 + (c >> 5)) * 512 + ((kk & 7) * 32 + (c & 31)) * 2; }
__device__ __forceinline__ int v_rd_base(int lane) { return ((lane & 3) << 3) | (((lane >> 2) & 3) << 6) | (((lane >> 4) & 1) << 5) | (((lane >> 5) & 1) << 8); }
constexpr int v_rd_off(int d0, int ks, int half) { return d0 * 512 + ks * 4096 + half * 2048; }
__device__ __forceinline__ int crow(int r, int hi) { return (r & 3) + 8 * (r >> 2) + 4 * hi; }
typedef __bf16 bf16x2a_t __attribute__((ext_vector_type(2)));
__device__ __forceinline__ unsigned cvtpk(float lo, float hi) { f32x2 v = {lo, hi}; bf16x2a_t b = __builtin_convertvector(v, bf16x2a_t); return __builtin_bit_cast(unsigned, b); }
__device__ __forceinline__ bf16x8 load8(const bf16* p) { return *reinterpret_cast<const bf16x8*>(p); }
__device__ __forceinline__ void mask_tile(f32x16& p0, f32x16& p1, int dq) {
    const float NEG = -__builtin_inff();
#pragma unroll
    for (int r = 0; r < 16; ++r) { const int c = (r & 3) + 8 * (r >> 2); if (dq - c < 0) p0[r] = NEG; if (dq - c - 32 < 0) p1[r] = NEG; }
}
__device__ __forceinline__ void partialSM(f32x16& p0, f32x16& p1, float& m_reg, float& mn, float& alpha) {
    float pmax = p0[0];
#pragma unroll
    for (int r = 1; r < 16; ++r) pmax = fmaxf(pmax, p0[r]);
#pragma unroll
    for (int r = 0; r < 16; ++r) pmax = fmaxf(pmax, p1[r]);
    { auto rr = __builtin_amdgcn_permlane32_swap(__float_as_uint(pmax), __float_as_uint(pmax), false, false); pmax = fmaxf(__uint_as_float(rr[0]), __uint_as_float(rr[1])); }
    if (__builtin_expect(__all((pmax - m_reg) <= THR2), 1)) { mn = m_reg; alpha = 1.f; }
    else { mn = fmaxf(m_reg, pmax); alpha = __builtin_amdgcn_exp2f(m_reg - mn); m_reg = mn; }
#pragma unroll
    for (int r = 0; r < 16; ++r) { p0[r] -= mn; p1[r] -= mn; }
#pragma unroll
    for (int r = 0; r < 16; ++r) p0[r] = __builtin_amdgcn_exp2f(p0[r]);
}
__device__ __forceinline__ void finishSM(f32x16& p0, f32x16& p1, float alpha, float& l_reg, bf16x8& pa0, bf16x8& pa1, bf16x8& pa2, bf16x8& pa3) {
#pragma unroll
    for (int r = 0; r < 16; ++r) p1[r] = __builtin_amdgcn_exp2f(p1[r]);
    float ps = 0;
#pragma unroll
    for (int r = 0; r < 16; ++r) ps += p0[r];
#pragma unroll
    for (int r = 0; r < 16; ++r) ps += p1[r];
    { auto rr = __builtin_amdgcn_permlane32_swap(__float_as_uint(ps), __float_as_uint(ps), false, false); ps = __uint_as_float(rr[0]) + __uint_as_float(rr[1]); }
    l_reg = l_reg * alpha + ps;
#define A2_PK4(P, B_, OUT) do { unsigned a0 = cvtpk(P[B_+0], P[B_+1]), a1 = cvtpk(P[B_+2], P[B_+3]); unsigned b0 = cvtpk(P[B_+4], P[B_+5]), b1 = cvtpk(P[B_+6], P[B_+7]); \
        auto r0 = __builtin_amdgcn_permlane32_swap(a0, b0, false, false); auto r1 = __builtin_amdgcn_permlane32_swap(a1, b1, false, false); \
        v4u w = {r0[0], r1[0], r0[1], r1[1]}; OUT = __builtin_bit_cast(bf16x8, w); } while (0)
    A2_PK4(p0, 0, pa0); A2_PK4(p0, 8, pa1); A2_PK4(p1, 0, pa2); A2_PK4(p1, 8, pa3);
#undef A2_PK4
}
__device__ __forceinline__ void softmax_fixed(f32x16& p0, f32x16& p1, float& l_reg, bf16x8& pa0, bf16x8& pa1, bf16x8& pa2, bf16x8& pa3) {
#define A2_PK4(P, B_, OUT) do { unsigned a0 = cvtpk(P[B_+0], P[B_+1]), a1 = cvtpk(P[B_+2], P[B_+3]); unsigned b0 = cvtpk(P[B_+4], P[B_+5]), b1 = cvtpk(P[B_+6], P[B_+7]); \
        auto r0 = __builtin_amdgcn_permlane32_swap(a0, b0, false, false); auto r1 = __builtin_amdgcn_permlane32_swap(a1, b1, false, false); \
        v4u w = {r0[0], r1[0], r0[1], r1[1]}; OUT = __builtin_bit_cast(bf16x8, w); } while (0)
    float ps = 0;
#pragma unroll
    for (int r = 0; r < 16; ++r) { p0[r] = __builtin_amdgcn_exp2f(p0[r]); ps += p0[r]; }
    A2_PK4(p0, 0, pa0); A2_PK4(p0, 8, pa1); A2_SBAR();
#pragma unroll
    for (int r = 0; r < 16; ++r) { p1[r] = __builtin_amdgcn_exp2f(p1[r]); ps += p1[r]; }
    A2_PK4(p1, 0, pa2); A2_PK4(p1, 8, pa3);
    l_reg += ps;
#undef A2_PK4
}
template <int KB>
__device__ __forceinline__ void qkt(f32x16& p0, f32x16& p1, const char* K_lds, const char* qr_lds, int r32, int hi, const bf16x8* qr) {
#ifdef A2_QK_SIMPLE
    p0 = f32x16{}; p1 = f32x16{};
    const char* kbase = K_lds + KB * SHM_K + r32 * 512; const int x = r32 & 15;
#pragma unroll
    for (int d = 0; d < 12; ++d) { const char* a = kbase + ((((2 * d + hi) & 15) ^ x) << 4) + (d >= 8 ? 256 : 0);
        const bf16x8 b0 = *reinterpret_cast<const bf16x8*>(a), b1 = *reinterpret_cast<const bf16x8*>(a + 32 * 512);
        const bf16x8 q = d < 8 ? qr[d < 8 ? d : 0] : *reinterpret_cast<const bf16x8*>(qr_lds + (((d - 8) * 2 + hi) * 32 + r32) * 16);
        p0 = __builtin_amdgcn_mfma_f32_32x32x16_bf16(b0, q, p0, 0, 0, 0);
        p1 = __builtin_amdgcn_mfma_f32_32x32x16_bf16(b1, q, p1, 0, 0, 0); }
#else
    p0 = f32x16{}; p1 = f32x16{};
    const int kb_ = (int)(uintptr_t)K_lds + r32 * 512, x = r32 & 15, qb_ = (int)(uintptr_t)qr_lds + (hi * 32 + r32) * 16;
    int ka[8];
#pragma unroll
    for (int d = 0; d < 8; ++d) ka[d] = kb_ + ((((2 * d + hi) & 15) ^ x) << 4);
    bf16x8 f0[5], f1[5], fq[5];
#define A2_KRD(dst, addr, off) asm volatile("ds_read_b128 %0, %1 offset:%2" : "=&v"(dst) : "v"(addr), "i"(off) : "memory")
#define A2_LGK(n) asm volatile("s_waitcnt lgkmcnt(%0)" :: "i"(n) : "memory")
    A2_KRD(f0[0], ka[0], KB * SHM_K + 0); A2_KRD(f1[0], ka[0], KB * SHM_K + 0 + 16384); A2_KRD(f0[1], ka[1], KB * SHM_K + 0); A2_KRD(f1[1], ka[1], KB * SHM_K + 0 + 16384); A2_KRD(f0[2], ka[2], KB * SHM_K + 0); A2_KRD(f1[2], ka[2], KB * SHM_K + 0 + 16384); A2_KRD(f0[3], ka[3], KB * SHM_K + 0); A2_KRD(f1[3], ka[3], KB * SHM_K + 0 + 16384);
    A2_KRD(f0[4], ka[4], KB * SHM_K + 0); A2_KRD(f1[4], ka[4], KB * SHM_K + 0 + 16384); A2_LGK(8); A2_SBAR(); p0 = __builtin_amdgcn_mfma_f32_32x32x16_bf16(f0[0], qr[0], p0, 0, 0, 0); p1 = __builtin_amdgcn_mfma_f32_32x32x16_bf16(f1[0], qr[0], p1, 0, 0, 0); A2_SBAR();
    A2_KRD(f0[0], ka[5], KB * SHM_K + 0); A2_KRD(f1[0], ka[5], KB * SHM_K + 0 + 16384); A2_LGK(8); A2_SBAR(); p0 = __builtin_amdgcn_mfma_f32_32x32x16_bf16(f0[1], qr[1], p0, 0, 0, 0); p1 = __builtin_amdgcn_mfma_f32_32x32x16_bf16(f1[1], qr[1], p1, 0, 0, 0); A2_SBAR();
    A2_KRD(f0[1], ka[6], KB * SHM_K + 0); A2_KRD(f1[1], ka[6], KB * SHM_K + 0 + 16384); A2_LGK(8); A2_SBAR(); p0 = __builtin_amdgcn_mfma_f32_32x32x16_bf16(f0[2], qr[2], p0, 0, 0, 0); p1 = __builtin_amdgcn_mfma_f32_32x32x16_bf16(f1[2], qr[2], p1, 0, 0, 0); A2_SBAR();
    A2_KRD(f0[2], ka[7], KB * SHM_K + 0); A2_KRD(f1[2], ka[7], KB * SHM_K + 0 + 16384); A2_LGK(8); A2_SBAR(); p0 = __builtin_amdgcn_mfma_f32_32x32x16_bf16(f0[3], qr[3], p0, 0, 0, 0); p1 = __builtin_amdgcn_mfma_f32_32x32x16_bf16(f1[3], qr[3], p1, 0, 0, 0); A2_SBAR();
    A2_KRD(f0[3], ka[0], KB * SHM_K + 256); A2_KRD(f1[3], ka[0], KB * SHM_K + 256 + 16384); A2_KRD(fq[3], qb_, 0); A2_LGK(9); A2_SBAR(); p0 = __builtin_amdgcn_mfma_f32_32x32x16_bf16(f0[4], qr[4], p0, 0, 0, 0); p1 = __builtin_amdgcn_mfma_f32_32x32x16_bf16(f1[4], qr[4], p1, 0, 0, 0); A2_SBAR();
    A2_KRD(f0[4], ka[1], KB * SHM_K + 256); A2_KRD(f1[4], ka[1], KB * SHM_K + 256 + 16384); A2_KRD(fq[4], qb_, 1024); A2_LGK(10); A2_SBAR(); p0 = __builtin_amdgcn_mfma_f32_32x32x16_bf16(f0[0], qr[5], p0, 0, 0, 0); p1 = __builtin_amdgcn_mfma_f32_32x32x16_bf16(f1[0], qr[5], p1, 0, 0, 0); A2_SBAR();
    A2_KRD(f0[0], ka[2], KB * SHM_K + 256); A2_KRD(f1[0], ka[2], KB * SHM_K + 256 + 16384); A2_KRD(fq[0], qb_, 2048); A2_LGK(11); A2_SBAR(); p0 = __builtin_amdgcn_mfma_f32_32x32x16_bf16(f0[1], qr[6], p0, 0, 0, 0); p1 = __builtin_amdgcn_mfma_f32_32x32x16_bf16(f1[1], qr[6], p1, 0, 0, 0); A2_SBAR();
    A2_KRD(f0[1], ka[3], KB * SHM_K + 256); A2_KRD(f1[1], ka[3], KB * SHM_K + 256 + 16384); A2_KRD(fq[1], qb_, 3072); A2_LGK(12); A2_SBAR(); p0 = __builtin_amdgcn_mfma_f32_32x32x16_bf16(f0[2], qr[7], p0, 0, 0, 0); p1 = __builtin_amdgcn_mfma_f32_32x32x16_bf16(f1[2], qr[7], p1, 0, 0, 0); A2_SBAR();
     A2_LGK(9); A2_SBAR(); p0 = __builtin_amdgcn_mfma_f32_32x32x16_bf16(f0[3], fq[3], p0, 0, 0, 0); p1 = __builtin_amdgcn_mfma_f32_32x32x16_bf16(f1[3], fq[3], p1, 0, 0, 0); A2_SBAR();
     A2_LGK(6); A2_SBAR(); p0 = __builtin_amdgcn_mfma_f32_32x32x16_bf16(f0[4], fq[4], p0, 0, 0, 0); p1 = __builtin_amdgcn_mfma_f32_32x32x16_bf16(f1[4], fq[4], p1, 0, 0, 0); A2_SBAR();
     A2_LGK(3); A2_SBAR(); p0 = __builtin_amdgcn_mfma_f32_32x32x16_bf16(f0[0], fq[0], p0, 0, 0, 0); p1 = __builtin_amdgcn_mfma_f32_32x32x16_bf16(f1[0], fq[0], p1, 0, 0, 0); A2_SBAR();
     A2_LGK(0); A2_SBAR(); p0 = __builtin_amdgcn_mfma_f32_32x32x16_bf16(f0[1], fq[1], p0, 0, 0, 0); p1 = __builtin_amdgcn_mfma_f32_32x32x16_bf16(f1[1], fq[1], p1, 0, 0, 0); A2_SBAR();
#undef A2_KRD
#undef A2_LGK
#endif
}
template <int VB>
__device__ __forceinline__ void pv_tile(f32x16* o, int vb0, bf16x8 pa0, bf16x8 pa1, bf16x8 pa2, bf16x8 pa3) {
#define A2_TRRD(dst, off) asm volatile("ds_read_b64_tr_b16 %0, %1 offset:%2" : "=&v"(dst) : "v"(vb0), "i"(off) : "memory")
#define A2_LGK(n) asm volatile("s_waitcnt lgkmcnt(%0)" :: "i"(n) : "memory")
#ifdef A2_PV_SIMPLE
#define A2_PV_D0(d0) do { s16x4 l0, l1, l2, l3, h0, h1, h2, h3; constexpr int b_ = VB * SHM_V + v_rd_off(d0, 0, 0); \
        A2_TRRD(l0, b_); A2_TRRD(h0, b_ + 2048); A2_TRRD(l1, b_ + 4096); A2_TRRD(h1, b_ + 6144); A2_TRRD(l2, b_ + 8192); A2_TRRD(h2, b_ + 10240); A2_TRRD(l3, b_ + 12288); A2_TRRD(h3, b_ + 14336); \
        asm volatile("s_waitcnt lgkmcnt(0)" ::: "memory"); A2_SBAR(); \
        o[d0] = __builtin_amdgcn_mfma_f32_32x32x16_bf16(pa0, (bf16x8){l0[0], l0[1], l0[2], l0[3], h0[0], h0[1], h0[2], h0[3]}, o[d0], 0, 0, 0); \
        o[d0] = __builtin_amdgcn_mfma_f32_32x32x16_bf16(pa1, (bf16x8){l1[0], l1[1], l1[2], l1[3], h1[0], h1[1], h1[2], h1[3]}, o[d0], 0, 0, 0); \
        o[d0] = __builtin_amdgcn_mfma_f32_32x32x16_bf16(pa2, (bf16x8){l2[0], l2[1], l2[2], l2[3], h2[0], h2[1], h2[2], h2[3]}, o[d0], 0, 0, 0); \
        o[d0] = __builtin_amdgcn_mfma_f32_32x32x16_bf16(pa3, (bf16x8){l3[0], l3[1], l3[2], l3[3], h3[0], h3[1], h3[2], h3[3]}, o[d0], 0, 0, 0); } while (0)
    A2_PV_D0(0); A2_PV_D0(1); A2_PV_D0(2); A2_PV_D0(3);
#undef A2_PV_D0
#else
    s16x4 rl[4][2], rh[4][2];
    A2_TRRD(rl[0][0], VB * SHM_V + 0); A2_TRRD(rh[0][0], VB * SHM_V + 2048); A2_TRRD(rl[0][1], VB * SHM_V + 4096); A2_TRRD(rh[0][1], VB * SHM_V + 6144); A2_TRRD(rl[1][0], VB * SHM_V + 8192); A2_TRRD(rh[1][0], VB * SHM_V + 10240); A2_TRRD(rl[1][1], VB * SHM_V + 12288); A2_TRRD(rh[1][1], VB * SHM_V + 14336);
    A2_TRRD(rl[2][0], VB * SHM_V + 512); A2_TRRD(rh[2][0], VB * SHM_V + 2560); A2_TRRD(rl[2][1], VB * SHM_V + 4608); A2_TRRD(rh[2][1], VB * SHM_V + 6656);
    A2_LGK(8); A2_SBAR(); o[0] = __builtin_amdgcn_mfma_f32_32x32x16_bf16(pa0, (bf16x8){rl[0][0][0], rl[0][0][1], rl[0][0][2], rl[0][0][3], rh[0][0][0], rh[0][0][1], rh[0][0][2], rh[0][0][3]}, o[0], 0, 0, 0); o[0] = __builtin_amdgcn_mfma_f32_32x32x16_bf16(pa1, (bf16x8){rl[0][1][0], rl[0][1][1], rl[0][1][2], rl[0][1][3], rh[0][1][0], rh[0][1][1], rh[0][1][2], rh[0][1][3]}, o[0], 0, 0, 0); A2_SBAR(); A2_TRRD(rl[3][0], VB * SHM_V + 8704); A2_TRRD(rh[3][0], VB * SHM_V + 10752); A2_TRRD(rl[3][1], VB * SHM_V + 12800); A2_TRRD(rh[3][1], VB * SHM_V + 14848);
    A2_LGK(8); A2_SBAR(); o[0] = __builtin_amdgcn_mfma_f32_32x32x16_bf16(pa2, (bf16x8){rl[1][0][0], rl[1][0][1], rl[1][0][2], rl[1][0][3], rh[1][0][0], rh[1][0][1], rh[1][0][2], rh[1][0][3]}, o[0], 0, 0, 0); o[0] = __builtin_amdgcn_mfma_f32_32x32x16_bf16(pa3, (bf16x8){rl[1][1][0], rl[1][1][1], rl[1][1][2], rl[1][1][3], rh[1][1][0], rh[1][1][1], rh[1][1][2], rh[1][1][3]}, o[0], 0, 0, 0); A2_SBAR(); A2_TRRD(rl[0][0], VB * SHM_V + 1024); A2_TRRD(rh[0][0], VB * SHM_V + 3072); A2_TRRD(rl[0][1], VB * SHM_V + 5120); A2_TRRD(rh[0][1], VB * SHM_V + 7168);
    A2_LGK(8); A2_SBAR(); o[1] = __builtin_amdgcn_mfma_f32_32x32x16_bf16(pa0, (bf16x8){rl[2][0][0], rl[2][0][1], rl[2][0][2], rl[2][0][3], rh[2][0][0], rh[2][0][1], rh[2][0][2], rh[2][0][3]}, o[1], 0, 0, 0); o[1] = __builtin_amdgcn_mfma_f32_32x32x16_bf16(pa1, (bf16x8){rl[2][1][0], rl[2][1][1], rl[2][1][2], rl[2][1][3], rh[2][1][0], rh[2][1][1], rh[2][1][2], rh[2][1][3]}, o[1], 0, 0, 0); A2_SBAR(); A2_TRRD(rl[1][0], VB * SHM_V + 9216); A2_TRRD(rh[1][0], VB * SHM_V + 11264); A2_TRRD(rl[1][1], VB * SHM_V + 13312); A2_TRRD(rh[1][1], VB * SHM_V + 15360);
    A2_LGK(8); A2_SBAR(); o[1] = __builtin_amdgcn_mfma_f32_32x32x16_bf16(pa2, (bf16x8){rl[3][0][0], rl[3][0][1], rl[3][0][2], rl[3][0][3], rh[3][0][0], rh[3][0][1], rh[3][0][2], rh[3][0][3]}, o[1], 0, 0, 0); o[1] = __builtin_amdgcn_mfma_f32_32x32x16_bf16(pa3, (bf16x8){rl[3][1][0], rl[3][1][1], rl[3][1][2], rl[3][1][3], rh[3][1][0], rh[3][1][1], rh[3][1][2], rh[3][1][3]}, o[1], 0, 0, 0); A2_SBAR(); A2_TRRD(rl[2][0], VB * SHM_V + 1536); A2_TRRD(rh[2][0], VB * SHM_V + 3584); A2_TRRD(rl[2][1], VB * SHM_V + 5632); A2_TRRD(rh[2][1], VB * SHM_V + 7680);
    A2_LGK(8); A2_SBAR(); o[2] = __builtin_amdgcn_mfma_f32_32x32x16_bf16(pa0, (bf16x8){rl[0][0][0], rl[0][0][1], rl[0][0][2], rl[0][0][3], rh[0][0][0], rh[0][0][1], rh[0][0][2], rh[0][0][3]}, o[2], 0, 0, 0); o[2] = __builtin_amdgcn_mfma_f32_32x32x16_bf16(pa1, (bf16x8){rl[0][1][0], rl[0][1][1], rl[0][1][2], rl[0][1][3], rh[0][1][0], rh[0][1][1], rh[0][1][2], rh[0][1][3]}, o[2], 0, 0, 0); A2_SBAR(); A2_TRRD(rl[3][0], VB * SHM_V + 9728); A2_TRRD(rh[3][0], VB * SHM_V + 11776); A2_TRRD(rl[3][1], VB * SHM_V + 13824); A2_TRRD(rh[3][1], VB * SHM_V + 15872);
    A2_LGK(8); A2_SBAR(); o[2] = __builtin_amdgcn_mfma_f32_32x32x16_bf16(pa2, (bf16x8){rl[1][0][0], rl[1][0][1], rl[1][0][2], rl[1][0][3], rh[1][0][0], rh[1][0][1], rh[1][0][2], rh[1][0][3]}, o[2], 0, 0, 0); o[2] = __builtin_amdgcn_mfma_f32_32x32x16_bf16(pa3, (bf16x8){rl[1][1][0], rl[1][1][1], rl[1][1][2], rl[1][1][3], rh[1][1][0], rh[1][1][1], rh[1][1][2], rh[1][1][3]}, o[2], 0, 0, 0); A2_SBAR();
    A2_LGK(4); A2_SBAR(); o[3] = __builtin_amdgcn_mfma_f32_32x32x16_bf16(pa0, (bf16x8){rl[2][0][0], rl[2][0][1], rl[2][0][2], rl[2][0][3], rh[2][0][0], rh[2][0][1], rh[2][0][2], rh[2][0][3]}, o[3], 0, 0, 0); o[3] = __builtin_amdgcn_mfma_f32_32x32x16_bf16(pa1, (bf16x8){rl[2][1][0], rl[2][1][1], rl[2][1][2], rl[2][1][3], rh[2][1][0], rh[2][1][1], rh[2][1][2], rh[2][1][3]}, o[3], 0, 0, 0); A2_SBAR();
    A2_LGK(0); A2_SBAR(); o[3] = __builtin_amdgcn_mfma_f32_32x32x16_bf16(pa2, (bf16x8){rl[3][0][0], rl[3][0][1], rl[3][0][2], rl[3][0][3], rh[3][0][0], rh[3][0][1], rh[3][0][2], rh[3][0][3]}, o[3], 0, 0, 0); o[3] = __builtin_amdgcn_mfma_f32_32x32x16_bf16(pa3, (bf16x8){rl[3][1][0], rl[3][1][1], rl[3][1][2], rl[3][1][3], rh[3][1][0], rh[3][1][1], rh[3][1][2], rh[3][1][3]}, o[3], 0, 0, 0); A2_SBAR();
#endif
#undef A2_LGK
#undef A2_TRRD
}
struct BlockRef { const bf16* Q; const bf16* K; const bf16* V; bf16* O; int P0; };
struct Seam { bf16x8 qr[8]; bf16x8 st_v0, st_v1, st_k0, st_k1, st_k2; int wv; };
#define A2_VMW() asm volatile("s_waitcnt vmcnt(0)" ::: "memory")
#define A2_VMWN(n) asm volatile("s_waitcnt vmcnt(%0)" :: "i"(n) : "memory")
#define A2_SLOAD(Kp, Vp, k0) do { S.st_v0 = load8((Vp) + (size_t)((k0) + sr) * VS + sc); S.st_v1 = load8((Vp) + (size_t)((k0) + 32 + sr) * VS + sc); \
        const bf16* kp_ = (Kp) + (size_t)((k0) + krow) * KS + kc * 8; S.st_k0 = load8(kp_); S.st_k1 = load8(kp_ + 64); S.st_k2 = load8(kp_ + 128); } while (0)
#define A2_SWRITE_K(bf) do { *(bf16x8*)(K_lds + (bf) * SHM_K + kw0) = S.st_k0; *(bf16x8*)(K_lds + (bf) * SHM_K + kw1) = S.st_k1; *(bf16x8*)(K_lds + (bf) * SHM_K + kw0 + 256) = S.st_k2; } while (0)
#define A2_SWRITE_V(bf) do { *(bf16x8*)(V_lds + (bf) * SHM_V + vst0) = S.st_v0; *(bf16x8*)(V_lds + (bf) * SHM_V + vst1) = S.st_v1; } while (0)
#define A2_SWRITE(bf) do { A2_SWRITE_V(bf); A2_SWRITE_K(bf); } while (0)
#define A2_IDX const int wid = S.wv, lane = mk_lane(), tid = wid * 64 + lane, r32 = lane & 31, hi = lane >> 5; \
    const int sr = tid >> 4, sc = (tid & 15) * 8, krow = tid >> 3, kc = tid & 7, kw0 = krow * 512 + ((kc ^ (krow & 15)) << 4), kw1 = krow * 512 + (((kc + 8) ^ (krow & 15)) << 4); \
    char* V_lds = lds + OFF_V; char* K_lds = lds + OFF_K; (void)lane; (void)r32; (void)hi; (void)sr; (void)sc; (void)V_lds
__device__ __forceinline__ void attn_prime(const BlockRef& cur, char* lds, Seam& S) {
    A2_IDX;
#pragma unroll
    for (int d0 = 0; d0 < 8; ++d0) S.qr[d0] = load8(cur.Q + (size_t)(wid * QBLK + r32) * QS + d0 * 16 + hi * 8);
    A2_SLOAD(cur.K, cur.V, 0); A2_VMW(); A2_SWRITE_K(0);
}
#ifdef ASTRETCH
#define A2_T0(n) unsigned long long at0_##n = 0; if (ASTRETCH == (n)) { A2_SBAR(); at0_##n = __builtin_amdgcn_s_memtime(); A2_SBAR(); }
#define A2_ST(n, dep) if (ASTRETCH == (n)) { A2_SBAR(); { float dp_ = (dep); asm volatile("" :: "v"(dp_)); } A2_SBAR(); const unsigned long long t1_ = __builtin_amdgcn_s_memtime(); const unsigned long long d_ = t1_ - at0_##n; while (__builtin_amdgcn_s_memtime() - t1_ < d_) {} A2_SBAR(); }
#else
#define A2_T0(n)
#define A2_ST(n, dep)
#endif
__device__ __forceinline__ void attn_block(const BlockRef& cur, const BlockRef& nxt, char* lds, Seam& S) {
    A2_IDX;
    const int NT = (cur.P0 + QB) / KVBLK;
    const int qlo = cur.P0 + wid * QBLK, qm = qlo + r32 - 4 * hi;
    float* ws = (float*)(lds + OFF_WS) + wid * 64; float* li_l = ws;
    char* qr_lds = lds + OFF_QR + wid * 4096;
    float l_reg = 0; f32x16 o[4] = {};
    A2_T0(6)
    const int vst0 = v_st(sr, sc), vst1 = v_st(32 + sr, sc);
    const int vb0 = (int)(uintptr_t)V_lds + v_rd_base(lane);
    const bf16* Kh = cur.K; const bf16* Vh = cur.V;
    { bf16x8 t4[4];
#pragma unroll
      for (int d = 0; d < 4; ++d) t4[d] = load8(cur.Q + (size_t)(wid * QBLK + r32) * QS + 128 + d * 16 + hi * 8);
#pragma unroll
      for (int d = 0; d < 4; ++d) *(bf16x8*)(qr_lds + ((d * 2 + hi) * 32 + r32) * 16) = t4[d]; }
    A2_SWRITE_V(0);
    __syncthreads();
    A2_ST(6, 0.f)
    f32x16 p0, p1; bf16x8 pa0, pa1, pa2, pa3;
#define A2_STEP(t, BUF) do { const bool lastt = (t) + 1 >= NT; \
        A2_T0(1) \
        A2_SBAR(); { const bf16* Kn = lastt ? nxt.K : Kh; const bf16* Vn = lastt ? nxt.V : Vh; const int k0n = lastt ? 0 : ((t) + 1) * KVBLK; A2_SLOAD(Kn, Vn, k0n); } A2_SBAR(); \
        const int kb_ = (t) * KVBLK; const bool live_ = kb_ <= qlo + QBLK - 1;        \
        if (live_) { if (A2_MPRIO) __builtin_amdgcn_s_setprio(1); qkt<BUF>(p0, p1, K_lds, qr_lds, r32, hi, S.qr); if (A2_MPRIO) __builtin_amdgcn_s_setprio(0); } \
        A2_ST(1, p0[15] + p1[15]) \
        if (lastt) { A2_SBAR(); _Pragma("unroll") for (int d0 = 0; d0 < 8; ++d0) S.qr[d0] = load8(nxt.Q + (size_t)(wid * QBLK + r32) * QS + d0 * 16 + hi * 8); A2_SBAR(); } \
        A2_T0(2) \
        if (live_) { if (kb_ + KVBLK - 1 > qlo) mask_tile(p0, p1, qm - kb_); \
            if (A2_MPRIO & 4) __builtin_amdgcn_s_setprio(1); softmax_fixed(p0, p1, l_reg, pa0, pa1, pa2, pa3); if (A2_MPRIO & 4) __builtin_amdgcn_s_setprio(0); } \
        A2_ST(2, l_reg) \
        A2_T0(3) \
        if (live_) { A2_SBAR(); if (A2_MPRIO & 2) __builtin_amdgcn_s_setprio(1); pv_tile<BUF>(o, vb0, pa0, pa1, pa2, pa3); if (A2_MPRIO & 2) __builtin_amdgcn_s_setprio(0); A2_SBAR(); } \
        A2_ST(3, o[3][15]) \
        A2_T0(4) \
        if (lastt) { A2_VMWN(8); A2_SWRITE_K(0); } else { A2_VMW(); A2_SWRITE((BUF) ^ 1); } \
        A2_ST(4, 0.f) \
        A2_T0(5) \
        __syncthreads(); \
        A2_ST(5, 0.f) \
        } while (0)
    for (int t = 0; t < NT; t += 2) { A2_STEP(t, 0); A2_STEP(t + 1, 1); }
#undef A2_STEP
    A2_T0(7)
    { auto rr = __builtin_amdgcn_permlane32_swap(__float_as_uint(l_reg), __float_as_uint(l_reg), false, false); l_reg = __uint_as_float(rr[0]) + __uint_as_float(rr[1]); }
    if (hi == 0) li_l[r32] = l_reg; asm volatile("s_waitcnt lgkmcnt(0)" ::: "memory");
    float rli[16];
#pragma unroll
    for (int r = 0; r < 16; ++r) rli[r] = __builtin_amdgcn_rcpf(li_l[crow(r, hi)]);
    bf16* Ow = cur.O + (size_t)(wid * QBLK) * OS;
#if A2_O_LDS
#pragma unroll
    for (int h2 = 0; h2 < 2; ++h2) {
#pragma unroll
        for (int r = 0; r < 16; ++r) { const int orow = crow(r, hi);
#pragma unroll
            for (int dd = 0; dd < 2; ++dd) { const float v = o[2 * h2 + dd][r] * rli[r];
                *(unsigned short*)(qr_lds + orow * 128 + (dd * 32 + r32) * 2) = (unsigned short)(cvtpk(v, v) & 0xffffu); } }
#pragma unroll
        for (int k = 0; k < 4; ++k) { const int q = lane + 64 * k, row = q >> 3, c8 = q & 7;
            const v4u ov = *(const v4u*)(qr_lds + q * 16); *(v4u*)(Ow + (size_t)row * OS + h2 * 64 + c8 * 8) = ov; }
    }
#else
#pragma unroll
    for (int r = 0; r < 16; ++r) { const int orow = crow(r, hi);
#pragma unroll
        for (int d0 = 0; d0 < 4; ++d0) { const float v = o[d0][r] * rli[r]; const float vn = __shfl_xor(v, 1);
            if ((r32 & 1) == 0) { unsigned* op_ = (unsigned*)(Ow + (size_t)orow * OS + d0 * 32 + r32); if (A2_NT_O) __builtin_nontemporal_store(cvtpk(v, vn), op_); else *op_ = cvtpk(v, vn); } } }
#endif
    asm volatile("s_waitcnt lgkmcnt(0)" ::: "memory");
    A2_ST(7, 0.f)
}
}
__device__ __forceinline__ attn2::BlockRef attn2_ref(unsigned char* ws, int v, int pass) {
    const int bh = v >> 3, b = bh >> 3, h = bh & 7, x = v & 7, qb = (pass != 0) == (A2_LONG_FIRST == 0) ? 15 - x : x;
    attn2::BlockRef r;
    r.Q = (const bf16*)(ws + WS_QP) + ((size_t)b * SEQ + qb * 256) * 1536 + h * 192; r.K = (const bf16*)(ws + WS_KF) + (size_t)b * SEQ * 1536 + h * 192;
    r.V = (const bf16*)(ws + WS_VV) + (size_t)b * SEQ * 1024 + h * 128; r.O = (bf16*)(ws + WS_MO) + ((size_t)b * SEQ + qb * 256) * 1024 + h * 128; r.P0 = qb * 256;
    return r;
}
#ifndef A2_BOUND_MAX
#define A2_BOUND_MAX 40.0f
#endif
#ifndef A2_PRIO_HI
#define A2_PRIO_HI 0
#endif
__device__ __forceinline__ void attn2_run(Frame& F, char* lds) {
    int L = F.vcu; if (L >= 256) return;
    attn2::Seam S; S.wv = F.wv0; int pass = 0;
    attn2::BlockRef cur = attn2_ref(F.ws, L, 0);
    if (A2_PRIO_HI && S.wv >= 4) __builtin_amdgcn_s_setprio(1);
    attn2::attn_prime(cur, lds, S);
    for (;;) {
        const bool more_pass = pass == 0, more_item = L + F.G < 256, last = !more_pass && !more_item;
        int passn = pass + 1, Ln = L;
        if (!more_pass) { passn = 0; Ln = more_item ? L + F.G : L; }
        const attn2::BlockRef nxt = last ? cur : attn2_ref(F.ws, Ln, passn);
        attn2::attn_block(cur, nxt, lds, S);
        if (last) break;
        cur = nxt; pass = passn; L = Ln;
    }
    if (A2_PRIO_HI) __builtin_amdgcn_s_setprio(0);
}
__device__ __forceinline__ void phase_attn_slow(Frame& F) {
    const bf16* QP = (const bf16*)(F.ws + WS_QP); const bf16* VV = (const bf16*)(F.ws + WS_VV); const bf16* KF = (const bf16*)(F.ws + WS_KF); bf16* MO = (bf16*)(F.ws + WS_MO);
    int t_ = F.wv0 * 64 + mk_lane();
    const int lane = t_ & 63, w = F.wv0, l31 = lane & 31, hi = lane >> 5;
    LAS unsigned char* vst = F.lds + w * 9216; LAS float* al = (LAS float*)(vst + 8704); LAS float* li = al + 32;
    constexpr int VROW = 272;
    const int trb = (4 * hi + ((lane & 15) >> 2)) * VROW + (16 * ((lane >> 4) & 1) + 4 * (lane & 3)) * 2;
    for (int v = F.vcu; v < 256; v += F.G) {
#pragma unroll 1
        for (int half = 0; half < 2; ++half) {
            const int qb = half == 0 ? 15 - (v >> 5) : (v >> 5), bh = v & 31, b = bh >> 3, h = bh & 7;
            const int q0 = qb * 256 + 32 * w; const size_t tb = (size_t)b * SEQ;
            bf16x8 qr[12];
#pragma unroll
            for (int d = 0; d < 12; ++d) qr[d] = *(const bf16x8*)(QP + (tb + q0 + l31) * 1536 + h * 192 + 16 * d + 8 * hi);
            float m_run = -1e30f, l_run = 0.f; attn2::f32x16 o[4] = {};
            const int nkt = q0 / 32 + 1;
#pragma unroll 1
            for (int kt = 0; kt < nkt; ++kt) {
                const int k0 = kt * 32;
#pragma unroll
                for (int i = 0; i < 4; ++i) { const int idx = lane + 64 * i, row = idx >> 3, ch = idx & 7;
                    const v4u v0 = *(const v4u*)(VV + (tb + k0 + row) * 1024 + h * 128 + ch * 16), v1 = *(const v4u*)(VV + (tb + k0 + row) * 1024 + h * 128 + ch * 16 + 8);
                    *(LAS v4u*)(vst + row * VROW + ch * 32) = v0; *(LAS v4u*)(vst + row * VROW + ch * 32 + 16) = v1; }
                attn2::f32x16 p = {};
#pragma unroll
                for (int d = 0; d < 12; ++d) { const bf16x8 kf = *(const bf16x8*)(KF + (tb + k0 + l31) * 1536 + h * 192 + 16 * d + 8 * hi); p = __builtin_amdgcn_mfma_f32_32x32x16_bf16(kf, qr[d], p, 0, 0, 0); }
                if (kt == nkt - 1) {
#pragma unroll
                    for (int r = 0; r < 16; ++r) if (attn2::crow(r, hi) > l31) p[r] = -__builtin_inff();
                }
                float pmax = p[0];
#pragma unroll
                for (int r = 1; r < 16; ++r) pmax = fmaxf(pmax, p[r]);
                pmax = fmaxf(pmax, __shfl_xor(pmax, 32));
                const float mn = fmaxf(m_run, pmax), alpha = __builtin_amdgcn_exp2f(m_run - mn); m_run = mn;
                float ps = 0.f;
#pragma unroll
                for (int r = 0; r < 16; ++r) { p[r] = __builtin_amdgcn_exp2f(p[r] - mn); ps += p[r]; }
                ps += __shfl_xor(ps, 32); l_run = l_run * alpha + ps;
                if (hi == 0) al[l31] = alpha;
                const bf16x8 pa0 = pack8f(p, 0), pa1 = pack8f(p, 8);
                LDS_WAIT();
#pragma unroll
                for (int r = 0; r < 16; ++r) { const float a_ = al[attn2::crow(r, hi)];
#pragma unroll
                    for (int db = 0; db < 4; ++db) o[db][r] *= a_; }
#pragma unroll
                for (int db = 0; db < 4; ++db)
#pragma unroll
                    for (int s2 = 0; s2 < 2; ++s2) { LAS unsigned char* ap = vst + trb + (16 * s2) * VROW + db * 64;
                        const v4i16_t lo = __builtin_amdgcn_ds_read_tr16_b64_v4i16((LAS v4i16_t*)ap), hh = __builtin_amdgcn_ds_read_tr16_b64_v4i16((LAS v4i16_t*)(ap + 8 * VROW));
                        const bf16x8 bfv = (bf16x8){lo[0], lo[1], lo[2], lo[3], hh[0], hh[1], hh[2], hh[3]};
                        o[db] = __builtin_amdgcn_mfma_f32_32x32x16_bf16(s2 == 0 ? pa0 : pa1, bfv, o[db], 0, 0, 0); }
                LDS_WAIT();
            }
            if (hi == 0) li[l31] = l_run;
            LDS_WAIT();
#pragma unroll
            for (int r = 0; r < 16; ++r) { const float il = 1.0f / li[attn2::crow(r, hi)];
#pragma unroll
                for (int db = 0; db < 4; ++db) MO[(tb + q0 + attn2::crow(r, hi)) * 1024 + h * 128 + 32 * db + l31] = (bf16)f2bf(o[db][r] * il); }
            LDS_WAIT();
        }
    }
}
__device__ __forceinline__ void phase_attn2(Frame& F, char* lds) {
    const float bound = *(const float*)(F.ws + WS_SMALL + SM_BOUND);
    if (bound <= A2_BOUND_MAX) attn2_run(F, lds); else phase_attn_slow(F);
}

static_assert(pg8::EpiInProj::O_RSTDX == WS_SMALL + SM_RSTDX && pg8::EpiInProj::O_SSQ_LAT == WS_SMALL + SM_SSQ_CQ && pg8::EpiInProj::O_SSQ_KR == WS_SMALL + SM_SSQ_KR && pg8::EpiInProj::O_CS == WS_CS && pg8::EpiInProj::O_CSM == WS_CSM && pg8::EpiInProj::O_RQ == WS_RQ && pg8::EpiInProj::O_RK == WS_RK && pg8::EpiInProj::O_RKDT == WS_RKDT && pg8::EpiInProj::O_RVT == WS_RVT && pg8::EpiInProj::O_LAT == WS_LAT && pg8::EpiInProj::O_KR == WS_KR, "EpiInProj offsets");
static_assert(pg8::EpiKVup::O_KF == WS_KF && pg8::EpiKVup::O_VV == WS_VV && pg8::EpiKVup::O_KR == WS_KR && pg8::EpiKVup::O_SSQ_CKV == WS_SMALL + SM_SSQ_CKV && pg8::EpiKVup::O_SSQ_KR == WS_SMALL + SM_SSQ_KR, "EpiKVup offsets");
static_assert(pg8::EpiGateMix<0>::BLKE * 2 == WS_BLK, "block stride of SG / TM");
#ifndef MK_N_LAUNCHES
#define MK_N_LAUNCHES 12
#endif
constexpr int N_PHASES = 12;
constexpr int N_LAUNCHES = MK_N_LAUNCHES;
struct Args { const float* in[21]; float* out; unsigned char* ws; int ph_lo, ph_hi; };
#ifndef PG8_SP2
#define PG8_SP2 true
#endif
#define PG8_ALIGN true
template <class Epi> __device__ __forceinline__ void run_gemm(Frame& F, const pg8::bf16_t* A, int lda, const pg8::bf16_t* Bt, int ldb, int N, int K, const Epi& E, int c = -1, size_t gsA = 0, int rev = 0) {
    asm volatile("s_waitcnt lgkmcnt(0)\n\ts_barrier" ::: "memory");
    pg8::Gemm g{A, Bt, MTOK, N, K, lda, ldb, gsA, F.wv0}; pg8::StaticOrder S; S.init(MTOK, N, F.G, c < 0 ? (int)blockIdx.x : c, rev);
    pg8::gemm_phase<Epi, pg8::StaticOrder, PG8_ALIGN, PG8_SP2>(F.lds + RING_OFF, g, S, E);
}
__global__ void __launch_bounds__(NWAVES * 64, 2) mk_fwd(Args args) {
    extern __shared__ __attribute__((aligned(16))) unsigned char lds[];
    Frame F;
    F.lds = (LAS unsigned char*)lds; F.MISC = (volatile LAS unsigned*)(F.lds + MISC_OFF);
    F.tid = threadIdx.x; F.lane = F.tid & 63; F.wave = __builtin_amdgcn_readfirstlane(F.tid >> 6); F.wv0 = F.wave;
    F.G = gridDim.x; { const int bx = blockIdx.x; F.vcu = (F.G % 8 == 0) ? (bx % 8) * (F.G / 8) + bx / 8 : bx; }
    F.out = args.out; F.ws = args.ws;
    if (F.tid < 32) F.MISC[F.tid] = 0u;
    __syncthreads();
    if (N_LAUNCHES == 1) (void)xcd_barrier_post((unsigned*)(args.ws + WS_CTL) + CW_BAR, F.MISC + 8);
    const int lo = args.ph_lo, hi = args.ph_hi;
    int ctile = (int)blockIdx.x;
    bool xlocal = false;
#ifndef R1_W
#define R1_W 32
#endif
#ifndef P1_REV
#define P1_REV 0
#endif
#ifndef SEAM5_LIGHT
#define SEAM5_LIGHT 0
#endif
#ifndef T6_REV
#define T6_REV 1
#endif
#ifndef PH_MASK
#define PH_MASK 0xfff
#endif
#define IN(k) (((PH_MASK >> (k)) & 1) && lo <= (k) && (k) < hi)
#define BAR_NOW() XcdBarrier bar_; bar_.bar = (unsigned*)(args.ws + WS_CTL) + CW_BAR; bar_.x = xb_xcc_id(); bar_.w = (unsigned)F.wv0; bar_.st = (volatile LAS unsigned*)((LAS unsigned char*)lds + MISC_OFF) + 8
#ifndef SEAM_TWICE
#define SEAM_TWICE -1
#endif
#define SEAM(k) do { asm volatile("; SEAM_MARK %0" :: "i"(k)); if (IN(k) && IN((k) + 1)) { BAR_NOW(); xcd_barrier(bar_); if (SEAM_TWICE == (k)) xcd_barrier(bar_); } } while (0)
#define SEAM_L(k) do { if (IN(k) && IN((k) + 1)) { BAR_NOW(); if (xlocal) { xcd_local_barrier(bar_); if (SEAM_TWICE == (k)) xcd_local_barrier(bar_); } else xcd_barrier(bar_); } } while (0)
#ifdef SUBSTRETCH
#define SUB_T0(n) const unsigned long long ts0_##n = __builtin_amdgcn_s_memrealtime()
#define SUB_ST(n) do { if (SUBSTRETCH == (n)) { const unsigned long long t1_ = __builtin_amdgcn_s_memrealtime(); const unsigned long long d_ = t1_ - ts0_##n; while (__builtin_amdgcn_s_memrealtime() - t1_ < d_) __builtin_amdgcn_s_sleep(8); } } while (0)
#else
#define SUB_T0(n) do {} while (0)
#define SUB_ST(n) do {} while (0)
#endif
#define PH_IDX() do { int w_ = F.wv0; asm volatile("" : "+s"(w_)); const int l_ = mk_lane(); F.tid = w_ * 64 + l_; F.lane = l_; F.wave = w_; } while (0)
#ifdef STRETCH_MASK
#define PH_T0() PH_IDX(); const unsigned long long t0_ = __builtin_amdgcn_s_memrealtime()
#define PH_STRETCH(k) do { if ((STRETCH_MASK >> (k)) & 1) { const unsigned long long t1_ = __builtin_amdgcn_s_memrealtime(); const unsigned long long d_ = (t1_ - t0_) * STRETCH_MULT; while (__builtin_amdgcn_s_memrealtime() - t1_ < d_) __builtin_amdgcn_s_sleep(8); } } while (0)
#else
#define PH_T0() PH_IDX()
#define PH_STRETCH(k) do {} while (0)
#endif
#define sm ((float*)(args.ws + WS_SMALL))
#define rstdx ((const float*)(args.ws + WS_SMALL + SM_RSTDX))
#define ssq_cq ((float*)(args.ws + WS_SMALL + SM_SSQ_CQ))
#define ssq_ckv ((float*)(args.ws + WS_SMALL + SM_SSQ_CKV))
#define ssq1 ((float*)(args.ws + WS_SMALL + SM_SSQ1))
#define ssq2 ((float*)(args.ws + WS_SMALL + SM_SSQ2))
    typedef pg8::bf16_t b16;
#define WinT ((b16*)(args.ws + WS_WIN))
#define XB ((b16*)(args.ws + WS_XB))
#define LATb ((b16*)(args.ws + WS_LAT))
#define ROb ((b16*)args.out)
    if (IN(0)) { PH_T0(); phase_p0(F, args.in[0], (const int*)args.in[2], args.in[3], args.in[4], args.in[6], args.in[7], args.in[8], args.in[9], args.in[10], args.in[11]); PH_STRETCH(0); } SEAM(0);
    if (IN(1)) { PH_T0();
        pg8::EpiInProj E{args.ws, args.in[11], (PG8_LAS unsigned char*)(F.lds + XS_OFF)};
        run_gemm(F, XB, 1024, WinT + (size_t)4096 * 1024, 1024, NIN1, 1024, E, -1, 0, P1_REV);
    PH_STRETCH(1); } SEAM(1);
#ifndef NO_XLOCAL2
    if (N_LAUNCHES == 1 && IN(2)) {
        if (F.tid == 0) { unsigned ok = (F.G == 256) ? 1u : 0u;
            for (unsigned j = 0; j < 16; ++j) { const unsigned c = xb_ld((unsigned*)(args.ws + WS_CTL) + CW_BAR + XB_XCNT(j)); ok &= (j < 8 ? (c == 32u) : (c == 0u)) ? 1u : 0u; }
            F.MISC[13] = ok; }
        __syncthreads();
    }
#endif
#define RET_XL() (N_LAUNCHES == 1 && F.MISC[13] != 0u)
#define RET_VX() (RET_XL() ? (int)(xb_xcc_id() * 32u + F.MISC[10]) : -1)
    if (IN(2)) { PH_T0(); phase_r0p(F, RET_VX());
    PH_STRETCH(2); } do { if (IN(2) && IN(3)) { BAR_NOW(); if (RET_XL()) xcd_local_barrier(bar_); else xcd_barrier(bar_); } } while (0);
    if (IN(3)) { PH_T0(); phase_r1p(F, RET_VX()); PH_STRETCH(3); } SEAM(3);
    if (IN(4)) { PH_T0();
#define PH4_RG() do { SUB_T0(1); { pg8::EpiRetGate E{ROb, rstdx, (const float*)(args.ws + WS_SSQP), args.in[5], (PG8_LAS float*)(F.lds + XS_OFF)}; run_gemm(F, XB, 1024, WinT + (size_t)2048 * 1024, 1024, 2048, 1024, E); } SUB_ST(1); } while (0)
#define PH4_QUP() do { SUB_T0(2); { pg8::EpiQup E{(b16*)(args.ws + WS_QP), ssq_cq, args.in[10], (const void*)(args.ws + WS_CSM), (PG8_LAS float*)(F.lds + XS_OFF), C2Q}; run_gemm(F, LATb, LATW, (const b16*)(args.ws + WS_WUQ), 384, 2048, 384, E); } SUB_ST(2); } while (0)
#define PH4_KVUP() do { SUB_T0(3); { pg8::EpiKVup E{args.ws, args.in[11], (PG8_LAS float*)(F.lds + XS_OFF)}; run_gemm(F, LATb + 384, LATW, (const b16*)(args.ws + WS_WUKV), 256, 2048, 256, E); } SUB_ST(3); } while (0)
#ifndef PH4_ROT
#define PH4_ROT 0
#endif
        if (PH4_ROT && (F.vcu & 1)) { PH4_QUP(); asm volatile("; SEAM_MARK 43"); PH4_KVUP(); asm volatile("; SEAM_MARK 44"); PH4_RG(); }
        else { PH4_RG(); asm volatile("; SEAM_MARK 41"); PH4_QUP(); asm volatile("; SEAM_MARK 42"); PH4_KVUP(); }
    PH_STRETCH(4); } SEAM(4);
    if (IN(5)) { PH_T0(); phase_attn2(F, (char*)lds); PH_STRETCH(5); }
    do { if (IN(5) && IN(6)) { BAR_NOW(); if (SEAM5_LIGHT) xcd_barrier_t<false>(bar_); else xcd_barrier(bar_); } } while (0);
    if (IN(6)) { PH_T0();
#define PH6_LW() do { SUB_T0(4); phase_late_weights(F, args.in[1], args.in[12], args.in[13], args.in[14], args.in[15], args.in[16], args.in[17], args.in[18], args.in[19], args.in[20]); SUB_ST(4); } while (0)
#define PH6_SG() do { pg8::EpiRowAct<3> E{(b16*)(args.ws + WS_SG), 2048, rstdx, 0.f, (unsigned)(WS_BLK / 2)}; run_gemm(F, XB, 1024, WinT, 1024, 2048, 1024, E); } while (0)
#ifndef PH6_ROT
#define PH6_ROT 1
#endif
        if ((PH6_ROT == 1 && (F.vcu & 1)) || PH6_ROT == 2 || (PH6_ROT == 3 && (F.vcu & 3) != 0)) { PH6_SG(); __syncthreads(); PH6_LW(); }
        else { PH6_LW(); PH6_SG(); }
    PH_STRETCH(6); } SEAM(6);
#ifndef NO_XLOCAL
    if (N_LAUNCHES == 1 && IN(7)) {
        if (F.tid == 0) { unsigned ok = (F.G == 256) ? 1u : 0u;
            for (unsigned j = 0; j < 16; ++j) { const unsigned c = xb_ld((unsigned*)(args.ws + WS_CTL) + CW_BAR + XB_XCNT(j)); ok &= (j < 8 ? (c == 32u) : (c == 0u)) ? 1u : 0u; }
            F.MISC[12] = ok; }
        __syncthreads();
        xlocal = F.MISC[12] != 0u; if (xlocal) ctile = (int)(F.MISC[10] * 8u + xb_xcc_id());
    }
#endif
    if (IN(7)) { PH_T0();
        SUB_T0(7); { pg8::EpiGateMix<0> E{(b16*)(args.ws + WS_TM), (const unsigned char*)(args.ws + WS_SG), 0}; run_gemm(F, ROb, 2048, (const b16*)(args.ws + WS_WBR), 2048, 1024, 2048, E, ctile); } SUB_ST(7);
#ifdef MIDFENCE
        VM_WAIT(); __syncthreads(); __builtin_amdgcn_fence(__ATOMIC_ACQUIRE, "agent"); VM_WAIT(); __syncthreads();
#endif
        SUB_T0(8); { pg8::EpiGateMix<1> E{(b16*)(args.ws + WS_TM), (const unsigned char*)(args.ws + WS_SG), 1024}; run_gemm(F, (const b16*)(args.ws + WS_MO), 1024, (const b16*)(args.ws + WS_WBM), 1024, 1024, 1024, E, ctile); } SUB_ST(8);
    PH_STRETCH(7); } SEAM_L(7);
    if (IN(8)) { PH_T0();
#ifdef T5_F32RES
        pg8::EpiResid<false> E{(const void*)args.in[0], XB, ssq1, (PG8_LAS float*)(F.lds + XS_OFF)};
#else
        pg8::EpiResid<true> E{(const void*)XB, XB, ssq1, (PG8_LAS float*)(F.lds + XS_OFF)};
#endif
        run_gemm(F, (const b16*)(args.ws + WS_TM), 1024, (const b16*)(args.ws + WS_WO), 1024, 1024, 1024, E, ctile, WS_BLK); PH_STRETCH(8); } SEAM_L(8);
    if (IN(9)) { PH_T0(); pg8::EpiRowAct<2> E{(b16*)(args.ws + WS_H), 4096, ssq1, 1.0f / 1024.0f, (unsigned)(WS_BLK / 2)}; run_gemm(F, XB, 1024, (const b16*)(args.ws + WS_WUP), 1024, 4096, 1024, E, ctile, 0, T6_REV); PH_STRETCH(9); } SEAM_L(9);
    if (IN(10)) { PH_T0(); pg8::EpiResid<true> E{(const void*)XB, XB, ssq2, (PG8_LAS float*)(F.lds + XS_OFF)}; run_gemm(F, (const b16*)(args.ws + WS_H), 4096, (const b16*)(args.ws + WS_WDOWN), 4096, 1024, 4096, E, ctile, WS_BLK); PH_STRETCH(10); } SEAM_L(10);
    if (IN(11)) { PH_T0();
        SUB_T0(5); { pg8::EpiRowAct<3> E{(b16*)(args.ws + WS_GT), 1024, ssq2, 1.0f / 1024.0f, 0u}; run_gemm(F, XB, 1024, (const b16*)(args.ws + WS_WPG), 1024, 1024, 1024, E, ctile); } SUB_ST(5);
#ifdef MIDFENCE
        VM_WAIT(); __syncthreads(); __builtin_amdgcn_fence(__ATOMIC_ACQUIRE, "agent"); VM_WAIT(); __syncthreads();
#endif
        SUB_T0(6); { pg8::EpiFinal E{args.out, (const unsigned char*)(args.ws + WS_GT), XB}; run_gemm(F, (const b16*)(args.ws + WS_PB), 256, (const b16*)(args.ws + WS_WPLE), 256, 1024, 256, E, ctile); } SUB_ST(6);
    PH_STRETCH(11); }
#undef IN
#undef sm
#undef rstdx
#undef ssq_cq
#undef ssq_ckv
#undef ssq1
#undef ssq2
#undef WinT
#undef XB
#undef LATb
#undef ROb
#undef SEAM
}


#ifdef DUMPK
struct DumpArgs { const unsigned* reg[6]; unsigned nw[6]; unsigned* out; int own; int pad; };
__global__ void dump_hash(DumpArgs d) {
    for (unsigned i = blockIdx.x * blockDim.x + threadIdx.x; i < (unsigned)MTOK * DM; i += gridDim.x * blockDim.x) {
        float s = 0.f;
        if (d.own) { const unsigned w = d.out[i]; s += __uint_as_float(w << 16) + __uint_as_float(w & 0xffff0000u); }
        for (int r = 0; r < 6; ++r) if (d.reg[r] && i < d.nw[r] * 2u) { const unsigned short v = ((const unsigned short*)d.reg[r])[i]; s += __uint_as_float((unsigned)v << 16); }
        ((float*)d.out)[i] = s;
    }
}
#endif
extern "C" void kernel_launch(void* const* d_in, const int* in_sizes, int n_in, void* d_out, int out_size, void* d_ws, size_t ws_size, hipStream_t stream) {
    static int grid = 0;
    if (grid == 0) {
        if (n_in != 21 || in_sizes[0] != MTOK * DM || out_size != MTOK * DM || ws_size < WS_END) { fprintf(stderr, "kernel_launch: unexpected shapes (n_in %d in0 %d out %d ws %zu)\n", n_in, n_in > 0 ? in_sizes[0] : -1, out_size, ws_size); grid = -1; return; }
        int dev = 0, cus = 0, per_cu = 0;
        if (hipGetDevice(&dev) != hipSuccess || hipDeviceGetAttribute(&cus, hipDeviceAttributeMultiprocessorCount, dev) != hipSuccess) { grid = -1; return; }
        if (hipFuncSetAttribute((const void*)mk_fwd, hipFuncAttributeMaxDynamicSharedMemorySize, LDS_BYTES) != hipSuccess) { fprintf(stderr, "kernel_launch: hipFuncSetAttribute failed\n"); grid = -1; return; }
        if (hipOccupancyMaxActiveBlocksPerMultiprocessor(&per_cu, (const void*)mk_fwd, NWAVES * 64, LDS_BYTES) != hipSuccess || per_cu < 1) { fprintf(stderr, "kernel_launch: occupancy query says %d workgroups per CU\n", per_cu); (void)hipGetLastError(); grid = -1; return; }
        grid = cus;
    }
    if (grid < 0) return;
    (void)hipMemsetAsync((char*)d_ws + WS_CTL, 0, CTL_ZERO_BYTES, stream);
    Args a{};
    for (int i = 0; i < 21; ++i) a.in[i] = (const float*)d_in[i];
    a.out = (float*)d_out; a.ws = (unsigned char*)d_ws;
    if (N_LAUNCHES == 1) { a.ph_lo = 0; a.ph_hi = N_PHASES; hipLaunchKernelGGL(mk_fwd, dim3(grid), dim3(NWAVES * 64), LDS_BYTES, stream, a); }
    else for (int ph = 0; ph < N_PHASES; ++ph) {
#ifdef DUMPK
        if (ph > DUMPK) break;
#endif
        a.ph_lo = ph; a.ph_hi = ph + 1; hipLaunchKernelGGL(mk_fwd, dim3(grid), dim3(NWAVES * 64), LDS_BYTES, stream, a); }
#ifdef DUMPK
    { DumpArgs d{}; d.out = (unsigned*)d_out; d.own = DUMP_OWN; const size_t offs[6] = DUMP_OFFS; const size_t len[6] = DUMP_LENS;
      for (int r = 0; r < 6; ++r) if (len[r]) { d.reg[r] = (const unsigned*)((const char*)d_ws + offs[r]); d.nw[r] = (unsigned)(len[r] / 4); }
      hipLaunchKernelGGL(dump_hash, dim3(2048), dim3(256), 0, stream, d); }
#endif
}
```
